# Optimizing an MI355X kernel written in HIP

```python
import math
import jax
import jax.numpy as jnp
from jax import lax
import numpy as np

D_MODEL = 1024
BATCH = 16
SEQ = 2048
DEPTH = 2

HEAD_DIM = 64
ATTN_HEADS = 8
DILATED_GROUPS = ((128, 1), (512, 4), (2048, 16))
N_GROUPS = len(DILATED_GROUPS)
ATTN_WIDTH = ATTN_HEADS * HEAD_DIM
ROPE_THETA = 10000.0
NEG_INF = -1e30
HYENA_WIDTH = D_MODEL // 2
SHORT_CONV = 3
FILTER_BANDS = 16
FILTER_EMB_DIM = 1 + 2 * FILTER_BANDS
FILTER_HIDDEN = 64
FILTER_INNER = 2
DECAY_TARGET = 1e-2
FAST_DECAY_PCT = 0.3
SLOW_DECAY_PCT = 1.5
N_BRANCHES = 2
HY_IN_WIDTH = 3 * HYENA_WIDTH
QKV_WIDTH = N_GROUPS * 3 * ATTN_WIDTH
IN_WIDTH = HY_IN_WIDTH + QKV_WIDTH + N_BRANCHES * D_MODEL
D_FF = 4 * D_MODEL
RMS_EPS = 1e-6

kernel_name = "hyena_dilated_attn_gated_hybrid"


def rmsnorm(x, gain):
    xf = x.astype(jnp.float32)
    y = xf * lax.rsqrt(jnp.mean(jnp.square(xf), axis=-1, keepdims=True) + RMS_EPS)
    return (y * gain.astype(jnp.float32)).astype(x.dtype)


def rotary(t, positions):
    half = t.shape[-1] // 2
    inv_freq = ROPE_THETA ** (-jnp.arange(half, dtype=jnp.float32) / half)
    ang = positions.astype(jnp.float32)[:, None] * inv_freq[None, :]
    cos = jnp.cos(ang)[None, :, None, :]
    sin = jnp.sin(ang)[None, :, None, :]
    tf = t.astype(jnp.float32)
    t1, t2 = tf[..., :half], tf[..., half:]
    return jnp.concatenate([t1 * cos - t2 * sin, t2 * cos + t1 * sin], axis=-1).astype(t.dtype)


def short_conv_centred(u, w, b):
    k_width = w.shape[0]
    s = u.shape[1]
    pad = k_width // 2
    up = jnp.pad(u, ((0, 0), (pad, k_width - 1 - pad), (0, 0)))
    out = b
    for tap in range(k_width):
        out = out + up[:, tap:tap + s] * w[tap]
    return out


def hyena_filters(length, w1, b1, w_inner, b_inner, w_out, freq):
    f32 = lambda a: a.astype(jnp.float32)
    n = jnp.arange(length, dtype=jnp.float32)
    t = n / max(length - 1, 1)
    bands = jnp.linspace(1e-4, FILTER_BANDS - 1, FILTER_BANDS, dtype=jnp.float32)
    ang = (2.0 * math.pi / length) * n[:, None] * bands[None, :]
    z = jnp.concatenate([t[:, None], jnp.cos(ang), -jnp.sin(ang)], axis=-1)
    fr = f32(freq)
    hid = jnp.sin(fr * (z @ f32(w1) + f32(b1)))
    for i in range(FILTER_INNER):
        hid = jnp.sin(fr * (hid @ f32(w_inner[i]) + f32(b_inner[i])))
    filt = (hid @ f32(w_out)).reshape(length, 2, HYENA_WIDTH)
    max_decay = math.log(DECAY_TARGET) / FAST_DECAY_PCT
    min_decay = math.log(DECAY_TARGET) / SLOW_DECAY_PCT
    deltas = jnp.abs(jnp.linspace(min_decay, max_decay, HYENA_WIDTH, dtype=jnp.float32))
    window = jnp.exp(-t[:, None] * deltas[None, :])
    filt = filt * window[:, None, :]
    return filt[:, 0], filt[:, 1]


def bidir_fftconv(u, h_fwd, h_bwd, d_skip):
    length, chans = u.shape[1], u.shape[2]
    n_fft = 2 * length
    kern = jnp.concatenate([h_fwd, jnp.zeros((1, chans), jnp.float32), h_bwd[:0:-1]], axis=0)
    uf = u.astype(jnp.float32)
    u_f = jnp.fft.rfft(uf, n=n_fft, axis=1)
    k_f = jnp.fft.rfft(kern, n=n_fft, axis=0)
    y = jnp.fft.irfft(u_f * k_f[None], n=n_fft, axis=1)[:, :length]
    return (y + uf * d_skip.astype(jnp.float32)).astype(u.dtype)


def dilated_window_attention(q, k, v, dilation, radius):
    b, s, h, e = q.shape
    n = s // dilation
    blk = radius
    nb = -(-n // blk)
    n_pad = nb * blk

    def to_sub(t):
        return t.reshape(b, n, dilation, h, e).transpose(0, 2, 1, 3, 4)

    def band(t):
        tp = jnp.pad(t, ((0, 0), (0, 0), (blk, n_pad - n + blk), (0, 0), (0, 0)))
        tp = tp.reshape(b, dilation, nb + 2, blk, h, e)
        return jnp.concatenate([tp[:, :, :-2], tp[:, :, 1:-1], tp[:, :, 2:]], axis=3)

    qs = jnp.pad(to_sub(q) * (HEAD_DIM ** -0.5), ((0, 0), (0, 0), (0, n_pad - n), (0, 0), (0, 0)))
    qb = qs.reshape(b, dilation, nb, blk, h, e)
    kb = band(to_sub(k))
    vb = band(to_sub(v))
    q_idx = jnp.arange(nb)[:, None] * blk + jnp.arange(blk)[None, :]
    k_idx = (jnp.arange(nb)[:, None] - 1) * blk + jnp.arange(3 * blk)[None, :]
    rel = k_idx[:, None, :] - q_idx[:, :, None]
    valid = (jnp.abs(rel) <= radius) & (k_idx[:, None, :] >= 0) & (k_idx[:, None, :] < n)
    scores = jnp.einsum('bdnqhe,bdnkhe->bdnhqk', qb, kb).astype(jnp.float32)
    scores = jnp.where(valid[None, None, :, None], scores, NEG_INF)
    lse = jax.nn.logsumexp(scores, axis=-1)
    probs = jnp.exp(scores - lse[..., None]).astype(v.dtype)
    out = jnp.einsum('bdnhqk,bdnkhe->bdnqhe', probs, vb)
    out = out.reshape(b, dilation, n_pad, h, e)[:, :, :n].transpose(0, 2, 1, 3, 4).reshape(b, s, h, e)
    lse = lse.transpose(0, 1, 2, 4, 3).reshape(b, dilation, n_pad, h)[:, :, :n]
    lse = lse.transpose(0, 2, 1, 3).reshape(b, s, h)
    return out, lse


def hybrid_mixer(hn, w_in, conv_w, conv_b, filt_w1, filt_b1, filt_w_inner, filt_b_inner,
                 filt_w_out, filt_freq, hy_skip, p_hy, p_att, w_o):
    b, s, _ = hn.shape
    proj = hn @ w_in
    hy_in = proj[..., :HY_IN_WIDTH]
    qkv = proj[..., HY_IN_WIDTH:HY_IN_WIDTH + QKV_WIDTH]
    gate_logits = proj[..., HY_IN_WIDTH + QKV_WIDTH:]

    u = short_conv_centred(hy_in, conv_w, conv_b)
    x0, x1, hv = jnp.split(u, 3, axis=-1)
    h_fwd, h_bwd = hyena_filters(s, filt_w1, filt_b1, filt_w_inner, filt_b_inner, filt_w_out, filt_freq)
    y_hy = x0 * bidir_fftconv(x1 * hv, h_fwd, h_bwd, hy_skip)

    qkv = qkv.reshape(b, s, N_GROUPS, 3, ATTN_HEADS, HEAD_DIM)
    positions = jnp.arange(s)
    outs, lses = [], []
    for g, (window, dilation) in enumerate(DILATED_GROUPS):
        q = rotary(qkv[:, :, g, 0], positions)
        k = rotary(qkv[:, :, g, 1], positions)
        o_g, lse_g = dilated_window_attention(q, k, qkv[:, :, g, 2], dilation, window // (2 * dilation))
        outs.append(o_g)
        lses.append(lse_g)
    group_w = jax.nn.softmax(jnp.stack(lses, axis=0), axis=0).astype(hn.dtype)
    y_att = jnp.einsum('gbsh,gbshe->bshe', group_w, jnp.stack(outs, axis=0)).reshape(b, s, ATTN_WIDTH)

    gates = jax.nn.sigmoid(gate_logits)
    g_hy, g_att = gates[..., :D_MODEL], gates[..., D_MODEL:]
    merged = g_hy * (y_hy @ p_hy) + g_att * (y_att @ p_att)
    return merged @ w_o


def setup_inputs(seed: int = 0) -> dict:
    key = jax.random.key(seed)
    ks = jax.random.split(key, 20)

    def normal(k, shape, scale):
        return jax.random.normal(k, shape, jnp.float32) * scale

    return {
        "x": normal(ks[0], (BATCH, SEQ, D_MODEL), 1.0),
        "norm_mix": 1.0 + normal(ks[1], (DEPTH, D_MODEL), 0.02),
        "w_in": normal(ks[2], (DEPTH, D_MODEL, IN_WIDTH), D_MODEL ** -0.5),
        "conv_w": normal(ks[3], (DEPTH, SHORT_CONV, HY_IN_WIDTH), SHORT_CONV ** -0.5),
        "conv_b": normal(ks[4], (DEPTH, HY_IN_WIDTH), 0.02),
        "filt_w1": normal(ks[5], (DEPTH, FILTER_EMB_DIM, FILTER_HIDDEN), FILTER_EMB_DIM ** -0.5),
        "filt_b1": normal(ks[6], (DEPTH, FILTER_HIDDEN), 0.02),
        "filt_w_inner": normal(ks[7], (DEPTH, FILTER_INNER, FILTER_HIDDEN, FILTER_HIDDEN), FILTER_HIDDEN ** -0.5),
        "filt_b_inner": normal(ks[8], (DEPTH, FILTER_INNER, FILTER_HIDDEN), 0.02),
        "filt_w_out": normal(ks[9], (DEPTH, FILTER_HIDDEN, 2 * HYENA_WIDTH), 0.1 * FILTER_HIDDEN ** -0.5),
        "filt_freq": 1.0 + normal(ks[10], (DEPTH, FILTER_HIDDEN), 0.02),
        "hy_skip": normal(ks[11], (DEPTH, HYENA_WIDTH), 0.5),
        "p_hy": normal(ks[12], (DEPTH, HYENA_WIDTH, D_MODEL), HYENA_WIDTH ** -0.5),
        "p_att": normal(ks[13], (DEPTH, ATTN_WIDTH, D_MODEL), ATTN_WIDTH ** -0.5),
        "w_o": normal(ks[14], (DEPTH, D_MODEL, D_MODEL), D_MODEL ** -0.5),
        "norm_ffn": 1.0 + normal(ks[15], (DEPTH, D_MODEL), 0.02),
        "w_ff1": normal(ks[16], (DEPTH, D_MODEL, D_FF), D_MODEL ** -0.5),
        "w_ff2": normal(ks[17], (DEPTH, D_FF, D_MODEL), D_FF ** -0.5),
        "norm_final": 1.0 + normal(ks[18], (D_MODEL,), 0.02),
    }


def reference(x, norm_mix, w_in, conv_w, conv_b, filt_w1, filt_b1, filt_w_inner, filt_b_inner,
              filt_w_out, filt_freq, hy_skip, p_hy, p_att, w_o, norm_ffn, w_ff1, w_ff2, norm_final):
    for layer in range(DEPTH):
        hn = rmsnorm(x, norm_mix[layer])
        x = x + hybrid_mixer(hn, w_in[layer], conv_w[layer], conv_b[layer], filt_w1[layer], filt_b1[layer],
                             filt_w_inner[layer], filt_b_inner[layer], filt_w_out[layer], filt_freq[layer],
                             hy_skip[layer], p_hy[layer], p_att[layer], w_o[layer])
        hn = rmsnorm(x, norm_ffn[layer])
        x = x + jnp.square(jax.nn.relu(hn @ w_ff1[layer])) @ w_ff2[layer]
    return rmsnorm(x, norm_final)
```

```cpp
#include <hip/hip_runtime.h>
#include <hip/hip_cooperative_groups.h>
#include <cstdio>
#include <cstdint>
namespace cg = cooperative_groups;

namespace pg8 {
#define PG8_LAS __attribute__((address_space(3)))
typedef unsigned short bf16_t;
typedef short bf16x8 __attribute__((ext_vector_type(8)));
typedef float f32x4 __attribute__((ext_vector_type(4)));
typedef unsigned u32x4 __attribute__((ext_vector_type(4)));
constexpr int BM = 256, BK = 64, HALF = 128, HTB = HALF * BK * 2  , STAGE_BYTES = 8 * HTB, NXCD = 8, WGM = 8;

__host__ __device__ __forceinline__ int lds_byte(int r, int c) { const int st = (r >> 4) * 2 + (c >> 5), rr = r & 15, cc = c & 31, ob = rr * 64 + cc * 2; return st * 1024 + (ob ^ (((ob >> 9) & 1) << 5)); }
__host__ __device__ __forceinline__ void stage_rc(int b, int& R, int& C) { const int st = b / 1024, sb = b % 1024, swz = sb ^ (((sb >> 9) & 1) << 5); R = (st >> 1) * 16 + swz / 64; C = (st & 1) * 32 + (swz % 64) / 2; }
__host__ __device__ __forceinline__ int perm32(int rho) { const int n = rho >> 4, i = rho & 15; return 8 * (i >> 2) + 4 * n + (i & 3); }

struct Unit { int pm, pn, z; };
struct Gemm { const bf16_t* A; const bf16_t* Bt; const bf16_t* A1; const bf16_t* Bt1; int M, N, K; };

struct StaticOrder {
    int nM, nN, nwg, G, c;
    __host__ __device__ void init(int M, int N, int G_, int c_) { nM = M / BM; nN = N / BM; nwg = nM * nN; G = G_; c = c_; }
    __host__ __device__ bool next(int i, Unit& u) const {
        const long L = (long)i * G + c; if (L >= nwg) return false;
        int wgid = (int)L; { const int q = nwg / NXCD, r = nwg % NXCD, xcd = wgid % NXCD, off = wgid / NXCD; wgid = (xcd < r ? xcd * (q + 1) : r * (q + 1) + (xcd - r) * q) + off; }
        const int nig = WGM * nN, gid = wgid / nig, fm = gid * WGM, gsz = (nM - fm) < WGM ? (nM - fm) : WGM;
        u.pm = fm + ((wgid % nig) % gsz); u.pn = (wgid % nig) / gsz; return true;
    }
    __device__ __forceinline__ void a_ready(const Unit&) const {}
    __device__ __forceinline__ void done(const Unit&) const {}
};


__device__ __forceinline__ unsigned cvt_pk_bf16(float lo, float hi) { unsigned r; asm volatile("v_cvt_pk_bf16_f32 %0, %1, %2" : "=v"(r) : "v"(lo), "v"(hi)); return r; }
__device__ __forceinline__ float bf_lo(unsigned w) { return __uint_as_float(w << 16); }
__device__ __forceinline__ float bf_hi(unsigned w) { return __uint_as_float(w & 0xffff0000u); }

struct RectOrder {
    int nN, nwg, G, c, pm0, pn0;
    __device__ __forceinline__ void init(int nM_, int nN_, int pm0_, int pn0_, int G_, int c_) { nN = nN_; nwg = nM_ * nN_; G = G_; c = c_; pm0 = pm0_; pn0 = pn0_; }
    __device__ __forceinline__ int count() const { return nwg > c ? (nwg - c + G - 1) / G : 0; }
    __device__ __forceinline__ bool next(int i, Unit& u) const {
        const long L = (long)i * G + c; if (L >= nwg) return false;
        const int w = (int)L, nig = 8 * nN, gid = w / nig, r = w % nig;
        u.pm = pm0 + gid * 8 + (r & 7); u.pn = pn0 + (r >> 3); u.z = 0; return true;
    }
    __device__ __forceinline__ void a_ready(const Unit&) const {}
    __device__ __forceinline__ void done(const Unit&) const {}
};
struct TwoRect {
    RectOrder a, b; int na;
    __device__ __forceinline__ bool next(int i, Unit& u) const { return i < na ? a.next(i, u) : b.next(i - na, u); }
    __device__ __forceinline__ void a_ready(const Unit&) const {}
    __device__ __forceinline__ void done(const Unit&) const {}
};
struct PairOrder {
    RectOrder r;
    __device__ __forceinline__ bool next(int i, Unit& u) const { const bool ok = r.next(i >> 1, u); u.z = i & 1; return ok; }
    __device__ __forceinline__ void a_ready(const Unit&) const {}
    __device__ __forceinline__ void done(const Unit&) const {}
};

constexpr float RMS_EPS = 1e-6f;
constexpr float QSCALE = 0.125f * 1.44269504088896341f;

__device__ __forceinline__ float row_rstd(const float* ssq, int row) {
    const f32x4* p = (const f32x4*)(ssq + (size_t)row * 16);
    const f32x4 a = p[0], b = p[1], c = p[2], d = p[3];
    const float s = ((a[0] + a[1]) + (a[2] + a[3])) + ((b[0] + b[1]) + (b[2] + b[3])) + ((c[0] + c[1]) + (c[2] + c[3])) + ((d[0] + d[1]) + (d[2] + d[3]));
    return 1.0f / sqrtf(s * (1.0f / 1024.0f) + RMS_EPS);
}

struct EpiIn {
    static constexpr bool PERM = true, AFTER_DRAIN = false;
    bf16_t* hy; bf16_t* q; bf16_t* kv; bf16_t* gates; const float* ssq; const float* rcos; const float* rsin; int kv_row0;
    __device__ __forceinline__ bool operator()(f32x4 (&acc)[2][2][4][2], const Unit& u, int wr, int wc, int fr, int fq) const {
        const int pn = u.pn; int type, ldc, colt, rowoff = 0; bf16_t* base;
        if (pn < 6) { type = 0; base = hy; ldc = 1536; colt = pn * 256; }
        else if (pn < 12) { type = 1; base = q; ldc = 1536; colt = (pn - 6) * 256; }
        else if (pn < 24) { const int idx = pn - 12; type = ((idx >> 1) & 1) ? 0 : 2; base = kv; ldc = 3072; colt = idx * 256; rowoff = kv_row0; }
        else { type = 3; base = gates; ldc = 2048; colt = (pn - 24) * 256; }
#pragma unroll
        for (int ai = 0; ai < 2; ++ai)
#pragma unroll
            for (int m = 0; m < 4; ++m) {
                const int row = u.pm * BM + ai * HALF + wr * 64 + m * 16 + fr;
                const float rs = row_rstd(ssq, row);
                bf16_t* rowp = base + (size_t)(row - rowoff) * ldc + colt;
                f32x4 v00 = acc[ai][0][m][0] * rs, v01 = acc[ai][0][m][1] * rs, v10 = acc[ai][1][m][0] * rs, v11 = acc[ai][1][m][1] * rs;
                if (type == 1 || type == 2) {
                    const int pos = row & 2047;
                    const f32x4 c0 = *(const f32x4*)(rcos + pos * 32 + 8 * fq), c1 = *(const f32x4*)(rcos + pos * 32 + 8 * fq + 4);
                    const f32x4 s0 = *(const f32x4*)(rsin + pos * 32 + 8 * fq), s1 = *(const f32x4*)(rsin + pos * 32 + 8 * fq + 4);
                    const float sc = (type == 1) ? QSCALE : 1.0f;
                    const f32x4 o00 = (v00 * c0 - v10 * s0) * sc, o01 = (v01 * c1 - v11 * s1) * sc;
                    const f32x4 o10 = (v10 * c0 + v00 * s0) * sc, o11 = (v11 * c1 + v01 * s1) * sc;
                    u32x4 w0, w1;
                    w0.x = cvt_pk_bf16(o00[0], o00[1]); w0.y = cvt_pk_bf16(o00[2], o00[3]); w0.z = cvt_pk_bf16(o01[0], o01[1]); w0.w = cvt_pk_bf16(o01[2], o01[3]);
                    w1.x = cvt_pk_bf16(o10[0], o10[1]); w1.y = cvt_pk_bf16(o10[2], o10[3]); w1.z = cvt_pk_bf16(o11[0], o11[1]); w1.w = cvt_pk_bf16(o11[2], o11[3]);
                    *(u32x4*)(rowp + wc * 64 + 8 * fq) = w0;
                    *(u32x4*)(rowp + wc * 64 + 8 * fq + 32) = w1;
                } else {
                    if (type == 3) {
#pragma unroll
                        for (int e = 0; e < 4; ++e) {
                            v00[e] = 1.0f / (1.0f + __expf(-v00[e])); v01[e] = 1.0f / (1.0f + __expf(-v01[e]));
                            v10[e] = 1.0f / (1.0f + __expf(-v10[e])); v11[e] = 1.0f / (1.0f + __expf(-v11[e]));
                        }
                    }
                    u32x4 w0, w1;
                    w0.x = cvt_pk_bf16(v00[0], v00[1]); w0.y = cvt_pk_bf16(v00[2], v00[3]); w0.z = cvt_pk_bf16(v01[0], v01[1]); w0.w = cvt_pk_bf16(v01[2], v01[3]);
                    w1.x = cvt_pk_bf16(v10[0], v10[1]); w1.y = cvt_pk_bf16(v10[2], v10[3]); w1.z = cvt_pk_bf16(v11[0], v11[1]); w1.w = cvt_pk_bf16(v11[2], v11[3]);
                    *(u32x4*)(rowp + wc * 32 + 8 * fq) = w0;
                    *(u32x4*)(rowp + wc * 32 + 8 * fq + HALF) = w1;
                }
            }
        return false;
    }
};

struct EpiGate {
    static constexpr bool PERM = true, AFTER_DRAIN = false;
    const bf16_t* gates; bf16_t* merged;
    __device__ __forceinline__ bool operator()(f32x4 (&acc)[2][2][4][2], const Unit& u, int wr, int wc, int fr, int fq) const {
#pragma unroll
        for (int ai = 0; ai < 2; ++ai)
#pragma unroll
            for (int m = 0; m < 4; ++m) {
                const int row = u.pm * BM + ai * HALF + wr * 64 + m * 16 + fr;
                const int col0 = u.pn * BM + wc * 32 + 8 * fq;
#pragma unroll
                for (int bj = 0; bj < 2; ++bj) {
                    const u32x4 ga = *(const u32x4*)(gates + (size_t)row * 2048 + 1024 + col0 + bj * HALF);
                    f32x4 a0 = (f32x4){bf_lo(ga.x), bf_hi(ga.x), bf_lo(ga.y), bf_hi(ga.y)}, a1 = (f32x4){bf_lo(ga.z), bf_hi(ga.z), bf_lo(ga.w), bf_hi(ga.w)};
                    if (u.z == 0) {
                        const u32x4 gh = *(const u32x4*)(gates + (size_t)row * 2048 + col0 + bj * HALF);
                        const f32x4 h0 = (f32x4){bf_lo(gh.x), bf_hi(gh.x), bf_lo(gh.y), bf_hi(gh.y)}, h1 = (f32x4){bf_lo(gh.z), bf_hi(gh.z), bf_lo(gh.w), bf_hi(gh.w)};
#pragma unroll
                        for (int e = 0; e < 4; ++e) { a0[e] = fmaxf(a0[e], 1e-30f); a1[e] = fmaxf(a1[e], 1e-30f); }
                        acc[ai][bj][m][0] = acc[ai][bj][m][0] * (h0 / a0);
                        acc[ai][bj][m][1] = acc[ai][bj][m][1] * (h1 / a1);
                    } else {
                        const f32x4 v0 = acc[ai][bj][m][0] * a0, v1 = acc[ai][bj][m][1] * a1;
                        u32x4 w; w.x = cvt_pk_bf16(v0[0], v0[1]); w.y = cvt_pk_bf16(v0[2], v0[3]); w.z = cvt_pk_bf16(v1[0], v1[1]); w.w = cvt_pk_bf16(v1[2], v1[3]);
                        *(u32x4*)(merged + (size_t)row * 1024 + col0 + bj * HALF) = w;
                    }
                }
            }
        return u.z == 0;
    }
};

struct EpiRes {
    static constexpr bool PERM = false, AFTER_DRAIN = false;
    const float* base; float* out; bf16_t* xb; float* ssq;
    __device__ __forceinline__ bool operator()(f32x4 (&acc)[2][2][4][2], const Unit& u, int wr, int wc, int fr, int fq) const {
        typedef unsigned u32x2v __attribute__((ext_vector_type(2)));
        int rl = wr * 64 + fr, cl = wc * 32 + 4 * fq;
        asm volatile("" : "+v"(rl), "+v"(cl));
#pragma unroll
        for (int ai = 0; ai < 2; ++ai)
#pragma unroll
            for (int m = 0; m < 4; ++m) {
                const int row = u.pm * BM + ai * HALF + m * 16 + rl;
                const size_t off = (size_t)row * 1024 + u.pn * BM + cl;
                float s = 0.f;
#pragma unroll
                for (int bj = 0; bj < 2; ++bj)
#pragma unroll
                    for (int n = 0; n < 2; ++n) {
                        const f32x4 o = *(const f32x4*)(base + off + bj * HALF + n * 16) + acc[ai][bj][m][n];
                        *(f32x4*)(out + off + bj * HALF + n * 16) = o;
                        u32x2v w; w.x = cvt_pk_bf16(o[0], o[1]); w.y = cvt_pk_bf16(o[2], o[3]);
                        *(u32x2v*)(xb + off + bj * HALF + n * 16) = w;
                        s += (o[0] * o[0] + o[1] * o[1]) + (o[2] * o[2] + o[3] * o[3]);
                    }
                s += __shfl_xor(s, 16); s += __shfl_xor(s, 32);
                if (fq == 0) ssq[(size_t)row * 16 + u.pn * 4 + wc] = s;
                asm volatile("" ::: "memory");
            }
        return false;
    }
};

struct EpiFF1 {
    static constexpr bool PERM = true, AFTER_DRAIN = false;
    bf16_t* h; const float* ssq;
    __device__ __forceinline__ bool operator()(f32x4 (&acc)[2][2][4][2], const Unit& u, int wr, int wc, int fr, int fq) const {
#pragma unroll
        for (int ai = 0; ai < 2; ++ai)
#pragma unroll
            for (int m = 0; m < 4; ++m) {
                const int row = u.pm * BM + ai * HALF + wr * 64 + m * 16 + fr;
                const float rs = row_rstd(ssq, row);
                bf16_t* rowp = h + (size_t)row * 4096 + u.pn * BM + wc * 32 + 8 * fq;
#pragma unroll
                for (int bj = 0; bj < 2; ++bj) {
                    f32x4 v0 = acc[ai][bj][m][0] * rs, v1 = acc[ai][bj][m][1] * rs;
#pragma unroll
                    for (int e = 0; e < 4; ++e) { v0[e] = fmaxf(v0[e], 0.f); v1[e] = fmaxf(v1[e], 0.f); }
                    v0 = v0 * v0; v1 = v1 * v1;
                    u32x4 w; w.x = cvt_pk_bf16(v0[0], v0[1]); w.y = cvt_pk_bf16(v0[2], v0[3]); w.z = cvt_pk_bf16(v1[0], v1[1]); w.w = cvt_pk_bf16(v1[2], v1[3]);
                    *(u32x4*)(rowp + bj * HALF) = w;
                }
            }
        return false;
    }
};

template <class Epi, class Sched, bool ALIGN_EPI = false, bool SP2 = false>
__device__ __forceinline__ void gemm_phase(PG8_LAS unsigned char* lds, const Gemm g, const Sched& S, const Epi& E) {
    int tid_ = threadIdx.x; asm volatile("" : "+v"(tid_));
    const int tid = tid_, wid = __builtin_amdgcn_readfirstlane(tid >> 6), lane = tid & 63, wr = wid >> 2, wc = wid & 3, fr = lane & 15, fq = lane >> 4;
    const int K = g.K, nt = K / BK;
    unsigned voffA[2], voffB[2];
#pragma unroll
    for (int i = 0; i < 2; ++i) { int R, C; stage_rc(tid * 16 + i * 8192, R, C); const int Rb = Epi::PERM ? ((R & ~31) + perm32(R & 31)) : R;
        voffA[i] = (unsigned)(R * K + C) * 2u; voffB[i] = (unsigned)(Rb * K + C) * 2u; }
    const size_t kstep = (size_t)(BK * 2);
    const size_t hstep = (size_t)HALF * K * 2;
    const size_t tstep = 2 * hstep;
    const unsigned ldsw = (unsigned)wid * 1024u;
    const int aoff = lds_byte(wr * 64 + fr, fq * 8), boff = lds_byte(wc * 32 + fr, fq * 8);
#define PG8_SA(b, h) (((b) * 2 + (h)) * HTB)
#define PG8_SB(b, h) ((4 + (b) * 2 + (h)) * HTB)
#define PG8_STAGE(bufoff, gbase, voff) do { _Pragma("unroll") for (int _i = 0; _i < 2; ++_i) \
        __builtin_amdgcn_global_load_lds((const unsigned*)((const char*)(gbase) + (voff)[_i]), (PG8_LAS unsigned*)(lds + (bufoff) + ldsw + _i * 8192), 16, 0, 0); } while (0)
#define PG8_LDA(dst, b, h) do { _Pragma("unroll") for (int m = 0; m < 4; ++m) _Pragma("unroll") for (int k = 0; k < 2; ++k) dst[m][k] = *(const PG8_LAS bf16x8*)(lds + PG8_SA(b, h) + aoff + m * 2048 + k * 1024); } while (0)
#define PG8_LDB(dst, b, h) do { _Pragma("unroll") for (int n = 0; n < 2; ++n) _Pragma("unroll") for (int k = 0; k < 2; ++k) dst[n][k] = *(const PG8_LAS bf16x8*)(lds + PG8_SB(b, h) + boff + n * 2048 + k * 1024); } while (0)
#define PG8_MMA(ai, bj, At, Bt) do { __builtin_amdgcn_s_setprio(1); _Pragma("unroll") for (int m = 0; m < 4; ++m) _Pragma("unroll") for (int n = 0; n < 2; ++n) _Pragma("unroll") for (int k = 0; k < 2; ++k) \
        acc[ai][bj][m][n] = __builtin_amdgcn_mfma_f32_16x16x32_bf16(Bt[n][k], At[m][k], acc[ai][bj][m][n], 0, 0, 0); __builtin_amdgcn_s_setprio(0); } while (0)
#define PG8_WAIT_V(n) asm volatile("s_waitcnt vmcnt(" #n ")" ::: "memory")
#define PG8_WAIT_L(n) asm volatile("s_waitcnt lgkmcnt(" #n ")" ::: "memory")
#define PG8_BAR __builtin_amdgcn_s_barrier()
#define PG8_SCHED __builtin_amdgcn_sched_barrier(0)
    Unit cur, nxt; int ui = 0;
    if (!S.next(0, cur)) return;
    f32x4 acc[2][2][4][2];
#pragma unroll
    for (int a = 0; a < 2; ++a)
#pragma unroll
        for (int b = 0; b < 2; ++b)
#pragma unroll
            for (int m = 0; m < 4; ++m)
#pragma unroll
                for (int n = 0; n < 2; ++n) acc[a][b][m][n] = (f32x4){0.f, 0.f, 0.f, 0.f};
    bf16x8 At[4][2], B0[2][2], B1[2][2];
    const char* cA = (const char*)(cur.z ? g.A1 : g.A) + (size_t)cur.pm * tstep; const char* cB = (const char*)(cur.z ? g.Bt1 : g.Bt) + (size_t)cur.pn * tstep;
    S.a_ready(cur);
    if constexpr (SP2) {
        PG8_STAGE(PG8_SB(0, 0), cB, voffB); PG8_STAGE(PG8_SB(0, 1), cB + hstep, voffB); PG8_STAGE(PG8_SA(0, 0), cA, voffA); PG8_STAGE(PG8_SA(0, 1), cA + hstep, voffA);
        if (wr == 1) PG8_BAR;
        PG8_WAIT_V(2); PG8_BAR;
        PG8_STAGE(PG8_SB(1, 0), cB + kstep, voffB); PG8_STAGE(PG8_SA(1, 0), cA + kstep, voffA); PG8_STAGE(PG8_SB(1, 1), cB + hstep + kstep, voffB);
        PG8_WAIT_V(6); PG8_BAR;
    } else {
        PG8_STAGE(PG8_SB(0, 0), cB, voffB); PG8_STAGE(PG8_SA(0, 0), cA, voffA); PG8_STAGE(PG8_SB(0, 1), cB + hstep, voffB); PG8_STAGE(PG8_SA(0, 1), cA + hstep, voffA);
        if (wr == 1) PG8_BAR;
        PG8_WAIT_V(4); PG8_BAR;
        PG8_STAGE(PG8_SB(1, 0), cB + kstep, voffB); PG8_STAGE(PG8_SA(1, 0), cA + kstep, voffA); PG8_STAGE(PG8_SB(1, 1), cB + hstep + kstep, voffB);
        PG8_WAIT_V(6); PG8_BAR;
    }
    for (;;) {
        const bool has_next = S.next(ui + 1, nxt);
        const char* nA = has_next ? (const char*)(nxt.z ? g.A1 : g.A) + (size_t)nxt.pm * tstep : cA; const char* nB = has_next ? (const char*)(nxt.z ? g.Bt1 : g.Bt) + (size_t)nxt.pn * tstep : cB;
        for (int t = 0; t < nt; t += 2) {
            const bool last = (t == nt - 2);
            const char* a1 = cA + (size_t)(t + 1) * kstep;
            const char* a2 = last ? nA : cA + (size_t)(t + 2) * kstep; const char* b2 = last ? nB : cB + (size_t)(t + 2) * kstep;
            const char* a3 = a2 + kstep; const char* b3 = b2 + kstep;
            if (last && has_next) S.a_ready(nxt);
            if constexpr (SP2) {
            PG8_LDB(B0, 0, 0); PG8_LDB(B1, 0, 1); PG8_SCHED; PG8_LDA(At, 0, 0); PG8_STAGE(PG8_SA(1, 1), a1 + hstep, voffA);
            PG8_WAIT_V(8); PG8_WAIT_L(0); PG8_BAR; PG8_MMA(0, 0, At, B0); PG8_MMA(0, 1, At, B1); PG8_BAR; PG8_SCHED;
            PG8_LDA(At, 0, 1); PG8_STAGE(PG8_SB(0, 0), b2, voffB); PG8_STAGE(PG8_SB(0, 1), b2 + hstep, voffB); PG8_STAGE(PG8_SA(0, 0), a2, voffA);
            PG8_WAIT_V(8); PG8_WAIT_L(0); PG8_BAR; PG8_MMA(1, 0, At, B0); PG8_MMA(1, 1, At, B1); PG8_BAR; PG8_SCHED;
            PG8_LDB(B0, 1, 0); PG8_LDB(B1, 1, 1); PG8_SCHED; PG8_LDA(At, 1, 0); PG8_STAGE(PG8_SA(0, 1), a2 + hstep, voffA);
            PG8_WAIT_V(8); PG8_WAIT_L(0); PG8_BAR; PG8_MMA(0, 0, At, B0); PG8_MMA(0, 1, At, B1); PG8_BAR; PG8_SCHED;
            PG8_LDA(At, 1, 1); PG8_STAGE(PG8_SB(1, 0), b3, voffB); PG8_STAGE(PG8_SB(1, 1), b3 + hstep, voffB); PG8_STAGE(PG8_SA(1, 0), a3, voffA);
            PG8_WAIT_V(8); PG8_WAIT_L(0); PG8_BAR; PG8_MMA(1, 0, At, B0); PG8_MMA(1, 1, At, B1); PG8_BAR; PG8_SCHED;
            } else {
            PG8_LDB(B0, 0, 0); PG8_SCHED; PG8_LDA(At, 0, 0); PG8_STAGE(PG8_SA(1, 1), a1 + hstep, voffA);
            PG8_WAIT_L(8); PG8_BAR; PG8_WAIT_L(0); PG8_MMA(0, 0, At, B0); PG8_BAR; PG8_SCHED;
            PG8_LDB(B1, 0, 1); PG8_STAGE(PG8_SB(0, 0), b2, voffB);
            PG8_BAR; PG8_WAIT_L(0); PG8_MMA(0, 1, At, B1); PG8_BAR;
            PG8_LDA(At, 0, 1); PG8_STAGE(PG8_SA(0, 0), a2, voffA);
            PG8_BAR; PG8_WAIT_L(0); PG8_MMA(1, 0, At, B0); PG8_BAR; PG8_SCHED;
            PG8_STAGE(PG8_SB(0, 1), b2 + hstep, voffB);
            PG8_WAIT_V(6); PG8_BAR; PG8_MMA(1, 1, At, B1); PG8_BAR;
            PG8_LDB(B0, 1, 0); PG8_SCHED; PG8_LDA(At, 1, 0); PG8_STAGE(PG8_SA(0, 1), a2 + hstep, voffA);
            PG8_WAIT_L(8); PG8_BAR; PG8_WAIT_L(0); PG8_MMA(0, 0, At, B0); PG8_BAR; PG8_SCHED;
            PG8_LDB(B1, 1, 1); PG8_STAGE(PG8_SB(1, 0), b3, voffB);
            PG8_BAR; PG8_WAIT_L(0); PG8_MMA(0, 1, At, B1); PG8_BAR;
            PG8_LDA(At, 1, 1); PG8_STAGE(PG8_SA(1, 0), a3, voffA);
            PG8_BAR; PG8_WAIT_L(0); PG8_MMA(1, 0, At, B0); PG8_BAR; PG8_SCHED;
            PG8_STAGE(PG8_SB(1, 1), b3 + hstep, voffB);
            PG8_WAIT_V(6); PG8_BAR; PG8_MMA(1, 1, At, B1); PG8_BAR;
            }
        }
        if constexpr (ALIGN_EPI) { if (wr == 0) PG8_BAR; }
        bool keep_acc = false; if constexpr (!Epi::AFTER_DRAIN) { keep_acc = E(acc, cur, wr, wc, fr, fq); S.done(cur); }
        if (!has_next) break;
        if (!keep_acc) {
#pragma unroll
        for (int a = 0; a < 2; ++a)
#pragma unroll
            for (int b = 0; b < 2; ++b)
#pragma unroll
                for (int m = 0; m < 4; ++m)
#pragma unroll
                    for (int n = 0; n < 2; ++n) acc[a][b][m][n] = (f32x4){0.f, 0.f, 0.f, 0.f};
        }
        cur = nxt; cA = nA; cB = nB; ++ui;
        if constexpr (ALIGN_EPI) { if (wr == 1) PG8_BAR; }
    }
    PG8_WAIT_V(0);
    if constexpr (!ALIGN_EPI) { if (wr == 0) PG8_BAR; }
    PG8_BAR;
    if constexpr (Epi::AFTER_DRAIN) { E.fused(acc, cur, wr, wc, fr, fq, lds, wid, lane); S.done(cur); }
#undef PG8_SA
#undef PG8_SB
#undef PG8_STAGE
#undef PG8_LDA
#undef PG8_LDB
#undef PG8_MMA
#undef PG8_WAIT_V
#undef PG8_WAIT_L
#undef PG8_BAR
#undef PG8_SCHED
}
}

#define LAS __attribute__((address_space(3)))
typedef unsigned short bf16;
typedef float f32x4 __attribute__((ext_vector_type(4)));
typedef unsigned v4u __attribute__((ext_vector_type(4)));
constexpr int NWAVES = 8, NTHR = 512;
constexpr int MTOK = 32768, DM = 1024, SEQ = 2048, NBATCH = 16, NIN = 8192, DFF = 4096, HYW = 512, HALF_TOK = 16384;
constexpr size_t MiB = (size_t)1 << 20;
constexpr size_t WS_SSQA = 0, WS_SSQB = 2 * MiB, WS_ROPE = 4 * MiB, WS_LSE = 5 * MiB, WS_GF = 8 * MiB, WS_W = 16 * MiB, WS_XB = 52 * MiB,
                 WS_HY = 116 * MiB, WS_UT = 212 * MiB, WS_GATES = 116 * MiB, WS_Q = 244 * MiB, WS_KV = 340 * MiB, WS_YHY = 436 * MiB, WS_YATT = 468 * MiB,
                 WS_MERGED = 340 * MiB, WS_H = 116 * MiB, WS_END = 500 * MiB;
constexpr size_t W_IN = 0, W_PHY = 16 * MiB, W_PATT = 17 * MiB, W_O = 18 * MiB, W_FF1 = 20 * MiB, W_FF2 = 28 * MiB;
constexpr int LDS_BYTES = 139264;

struct Args {
    const float* in[19]; float* out; unsigned char* ws; int pad0, pad1;
};

__device__ __forceinline__ unsigned f2bf(float f) { unsigned u = __float_as_uint(f); return (u + 0x7fffu + ((u >> 16) & 1u)) >> 16; }
__device__ __forceinline__ unsigned pk2(float lo, float hi) { return f2bf(lo) | (f2bf(hi) << 16); }
__device__ __forceinline__ float bf2f(unsigned short b) { return __uint_as_float((unsigned)b << 16); }
__device__ __forceinline__ float wave_sum(float v) {
#pragma unroll
    for (int o = 1; o < 64; o <<= 1) v += __shfl_xor(v, o);
    return v;
}

__device__ __forceinline__ int win_src_col(int n) {
    const int t = n >> 8, j = n & 255;
    if (t < 6) return n;
    if (t >= 24) return 6144 + (n - 6144);
    int g, w, half;
    if (t < 12) { const int i = t - 6; g = i >> 1; w = 0; half = i & 1; }
    else { const int i = t - 12; g = i >> 2; w = 1 + ((i >> 1) & 1); half = i & 1; }
    int hh, d;
    if (w == 2) { hh = j >> 6; d = j & 63; }
    else { hh = (j & 127) >> 5; d = (j & 31) + ((j >> 7) << 5); }
    return 1536 + g * 1536 + w * 512 + (half * 4 + hh) * 64 + d;
}

__device__ __forceinline__ void transpose_item(const float* W, int K, int Nsrc, int s0, bf16* WT, int n0, int k0, const float* gain, LAS float* scr, int lane) {
#pragma unroll 8
    for (int i = 0; i < 32; ++i) { const int kk = 2 * i + (lane >> 5); float v = W[(size_t)(k0 + kk) * Nsrc + s0 + (lane & 31)]; if (gain) v *= gain[k0 + kk]; scr[kk * 33 + (lane & 31)] = v; }
    asm volatile("s_waitcnt lgkmcnt(0)" ::: "memory");
    const int c = lane & 7;
#pragma unroll
    for (int j = 0; j < 4; ++j) { const int n = (lane >> 3) + 8 * j; const LAS float* s = scr + (8 * c) * 33 + n;
        v4u o; o.x = pk2(s[0 * 33], s[1 * 33]); o.y = pk2(s[2 * 33], s[3 * 33]); o.z = pk2(s[4 * 33], s[5 * 33]); o.w = pk2(s[6 * 33], s[7 * 33]);
        *(v4u*)(WT + (size_t)(n0 + n) * K + k0 + 8 * c) = o; }
    asm volatile("s_waitcnt lgkmcnt(0)" ::: "memory");
}

__device__ __forceinline__ void phase_prep_weights(const Args& a, int L, LAS unsigned char* lds, int tid, int lane, int wave, int G) {
    unsigned char* ws = a.ws;
    {
        LAS float* z = (LAS float*)lds; LAS float* h0 = z + 64; LAS float* h1 = z + 128;
        const float* w1 = a.in[5] + (size_t)L * 33 * 64; const float* b1 = a.in[6] + L * 64;
        const float* wi = a.in[7] + (size_t)L * 2 * 64 * 64; const float* bi = a.in[8] + L * 2 * 64;
        const float* wout = a.in[9] + (size_t)L * 64 * 1024; const float* fr = a.in[10] + L * 64; const float* skip = a.in[11] + L * 512;
        float* Gf = (float*)(ws + WS_GF);
        const float min_decay = logf(1e-2f) / 1.5f, max_decay = logf(1e-2f) / 0.3f;
        for (int n = blockIdx.x; n < SEQ; n += G) {
            const float t = (float)n / 2047.0f;
            if (tid < 33) {
                float v;
                if (tid == 0) v = t;
                else { const int k = (tid - 1) & 15; const float band = 1e-4f + (float)k * ((15.0f - 1e-4f) / 15.0f); const float ang = ((float)(2.0 * 3.14159265358979323846 / 2048.0) * (float)n) * band;
                       v = (tid <= 16) ? cosf(ang) : -sinf(ang); }
                z[tid] = v;
            }
            __syncthreads();
            if (tid < 64) { float s = 0.f;
_Pragma("unroll 3")
 for (int e = 0; e < 33; ++e) s += z[e] * w1[e * 64 + tid]; h0[tid] = sinf(fr[tid] * (s + b1[tid])); }
            __syncthreads();
            if (tid < 64) { float s = 0.f;
_Pragma("unroll 4")
 for (int e = 0; e < 64; ++e) s += h0[e] * wi[e * 64 + tid]; h1[tid] = sinf(fr[tid] * (s + bi[tid])); }
            __syncthreads();
            if (tid < 64) { float s = 0.f;
_Pragma("unroll 4")
 for (int e = 0; e < 64; ++e) s += h1[e] * wi[4096 + e * 64 + tid]; h0[tid] = sinf(fr[tid] * (s + bi[64 + tid])); }
            __syncthreads();
            for (int col = tid; col < 1024; col += NTHR) {
                float s = 0.f;
_Pragma("unroll 4")
 for (int e = 0; e < 64; ++e) s += h0[e] * wout[e * 1024 + col];
                const int c = col & 511, dir = col >> 9;
                const float delta = fabsf(min_decay + (float)c * ((max_decay - min_decay) / 511.0f));
                float val = s * expf(-t * delta);
                if (dir == 0) { if (n == 0) val += skip[c]; Gf[(size_t)c * 4096 + 2048 + n] = val; }
                else if (n > 0) Gf[(size_t)c * 4096 + 2048 - n] = val;
            }
            __syncthreads();
        }
    }
    {
        LAS float* scr = (LAS float*)(lds + 1024 + wave * 8704);
        const int gw = blockIdx.x * NWAVES + wave, NGW = G * NWAVES;
        bf16* Wb = (bf16*)(ws + WS_W);
        const float* w_in = a.in[2] + (size_t)L * DM * NIN; const float* p_hy = a.in[12] + (size_t)L * 512 * DM; const float* p_att = a.in[13] + (size_t)L * 512 * DM;
        const float* w_o = a.in[14] + (size_t)L * DM * DM; const float* w1 = a.in[16] + (size_t)L * DM * DFF; const float* w2 = a.in[17] + (size_t)L * DFF * DM;
        const float* g_mix = a.in[1] + L * DM; const float* g_ffn = a.in[15] + L * DM;
        constexpr int I_IN = 16 * 256, I_P = 8 * 32, I_O = 16 * 32, I_1 = 16 * 128, I_2 = 64 * 32;
        constexpr int NITEMS = I_IN + 2 * I_P + I_O + I_1 + I_2;
        for (int it = gw; it < NITEMS; it += NGW) {
            int r = it;
            if (r < I_IN) { const int kb = r / 256, nb = r % 256; transpose_item(w_in, DM, NIN, win_src_col(nb * 32), Wb + W_IN / 2, nb * 32, kb * 64, g_mix, scr, lane); continue; } r -= I_IN;
            if (r < I_P) { const int kb = r / 32, nb = r % 32; transpose_item(p_hy, 512, DM, nb * 32, Wb + W_PHY / 2, nb * 32, kb * 64, nullptr, scr, lane); continue; } r -= I_P;
            if (r < I_P) { const int kb = r / 32, nb = r % 32; transpose_item(p_att, 512, DM, nb * 32, Wb + W_PATT / 2, nb * 32, kb * 64, nullptr, scr, lane); continue; } r -= I_P;
            if (r < I_O) { const int kb = r / 32, nb = r % 32; transpose_item(w_o, DM, DM, nb * 32, Wb + W_O / 2, nb * 32, kb * 64, nullptr, scr, lane); continue; } r -= I_O;
            if (r < I_1) { const int kb = r / 128, nb = r % 128; transpose_item(w1, DM, DFF, nb * 32, Wb + W_FF1 / 2, nb * 32, kb * 64, g_ffn, scr, lane); continue; } r -= I_1;
            { const int kb = r / 32, nb = r % 32; transpose_item(w2, DFF, DM, nb * 32, Wb + W_FF2 / 2, nb * 32, kb * 64, nullptr, scr, lane); }
        }
        if (L == 0) {
            const float* x = a.in[0]; bf16* xb = (bf16*)(ws + WS_XB); float* ssq = (float*)(ws + WS_SSQA);
            for (int m = gw; m < MTOK; m += NGW) {
                const f32x4* xr = (const f32x4*)(x + (size_t)m * DM) + lane;
                f32x4 v[4]; float s = 0.f;
#pragma unroll
                for (int j = 0; j < 4; ++j) { v[j] = xr[64 * j]; s += (v[j][0] * v[j][0] + v[j][1] * v[j][1]) + (v[j][2] * v[j][2] + v[j][3] * v[j][3]); }
                s = wave_sum(s);
                unsigned long long* o8 = (unsigned long long*)(xb + (size_t)m * DM) + lane;
#pragma unroll
                for (int j = 0; j < 4; ++j) o8[64 * j] = (unsigned long long)pk2(v[j][0], v[j][1]) | ((unsigned long long)pk2(v[j][2], v[j][3]) << 32);
                if (lane < 16) ssq[(size_t)m * 16 + lane] = (lane == 0) ? s : 0.f;
            }
            float* rc = (float*)(ws + WS_ROPE); float* rsn = rc + 65536;
            for (int i = blockIdx.x * NTHR + tid; i < 65536; i += G * NTHR) {
                const int pos = i >> 5, f = i & 31;
                const float inv = powf(10000.0f, -(float)f / 32.0f);
                const float ang = (float)pos * inv;
                rc[i] = cosf(ang); rsn[i] = sinf(ang);
            }
        }
    }
}

__device__ __forceinline__ void phase_prep_u(const Args& a, int L, LAS unsigned char* lds, int tid, int G) {
    const bf16* hy = (const bf16*)(a.ws + WS_HY); bf16* ut = (bf16*)(a.ws + WS_UT);
    const float* cw = a.in[3] + (size_t)L * 3 * 1536; const float* cb = a.in[4] + L * 1536;
    LAS unsigned short* tile = (LAS unsigned short*)lds;
    for (int item = blockIdx.x; item < 4096; item += G) {
        const int cc = item & 7, mc = (item >> 3) & 31, b = item >> 8;
        const int cl = tid & 63, mr = tid >> 6, c = cc * 64 + cl;
        const float w10 = cw[512 + c], w11 = cw[1536 + 512 + c], w12 = cw[3072 + 512 + c], b1 = cb[512 + c];
        const float wv0 = cw[1024 + c], wv1 = cw[1536 + 1024 + c], wv2 = cw[3072 + 1024 + c], bv = cb[1024 + c];
#pragma unroll
        for (int p = 0; p < 8; ++p) {
            const int ml = p * 8 + mr, m = mc * 64 + ml;
            const bf16* r = hy + (size_t)(b * SEQ + m) * 1536;
            const float x1m = (m > 0) ? bf2f(r[-1536 + 512 + c]) : 0.f, x1c = bf2f(r[512 + c]), x1p = (m < SEQ - 1) ? bf2f(r[1536 + 512 + c]) : 0.f;
            const float vm = (m > 0) ? bf2f(r[-1536 + 1024 + c]) : 0.f, vc = bf2f(r[1024 + c]), vp = (m < SEQ - 1) ? bf2f(r[1536 + 1024 + c]) : 0.f;
            const float u1 = b1 + w10 * x1m + w11 * x1c + w12 * x1p;
            const float uv = bv + wv0 * vm + wv1 * vc + wv2 * vp;
            tile[cl * 72 + ml] = (unsigned short)f2bf(u1 * uv);
        }
        __syncthreads();
        {
            const int c2 = tid >> 3, ch = tid & 7;
            const LAS unsigned short* s = tile + c2 * 72 + ch * 8;
            v4u o; o.x = s[0] | ((unsigned)s[1] << 16); o.y = s[2] | ((unsigned)s[3] << 16); o.z = s[4] | ((unsigned)s[5] << 16); o.w = s[6] | ((unsigned)s[7] << 16);
            *(v4u*)(ut + ((size_t)(cc * 64 + c2) * NBATCH + b) * SEQ + mc * 64 + ch * 8) = o;
        }
        __syncthreads();
    }
}

__device__ __forceinline__ void phase_hyena_naive(const Args& a, int L, LAS unsigned char* lds, int tid, int G) {
    const bf16* hy = (const bf16*)(a.ws + WS_HY); const bf16* ut = (const bf16*)(a.ws + WS_UT); const float* Gf = (const float*)(a.ws + WS_GF);
    bf16* yhy = (bf16*)(a.ws + WS_YHY);
    const float* cw = a.in[3] + (size_t)L * 3 * 1536; const float* cb = a.in[4] + L * 1536;
    LAS float* Gs = (LAS float*)lds;
    LAS float* Us = Gs + 4096;
    for (int item = blockIdx.x; item < 2048; item += G) {
        const int c = item >> 2, bq = item & 3;
        for (int i = tid; i < 4096; i += NTHR) Gs[i] = (i == 0) ? 0.f : Gf[(size_t)c * 4096 + i];
        for (int i = tid; i < 8192; i += NTHR) { const int bl = i >> 11, m = i & 2047; Us[i] = bf2f(ut[((size_t)c * NBATCH + bq * 4 + bl) * SEQ + m]); }
        __syncthreads();
        const int bl = tid >> 7, tn = tid & 127;
        float acc[16];
#pragma unroll
        for (int i = 0; i < 16; ++i) acc[i] = 0.f;
        const LAS float* up = Us + bl * 2048;
        for (int m = 0; m < SEQ; ++m) {
            const float u = up[m];
            const LAS float* gp = Gs + (tn - m + 2048);
#pragma unroll
            for (int i = 0; i < 16; ++i) acc[i] += gp[128 * i] * u;
        }
        const int b = bq * 4 + bl;
        const float w0 = cw[c], w1 = cw[1536 + c], w2 = cw[3072 + c], b0 = cb[c];
#pragma unroll
        for (int i = 0; i < 16; ++i) {
            const int n = tn + 128 * i;
            const bf16* r = hy + (size_t)(b * SEQ + n) * 1536 + c;
            const float xm = (n > 0) ? bf2f(r[-1536]) : 0.f, xc = bf2f(r[0]), xp = (n < SEQ - 1) ? bf2f(r[1536]) : 0.f;
            const float x0 = b0 + w0 * xm + w1 * xc + w2 * xp;
            yhy[(size_t)(b * SEQ + n) * 512 + c] = (bf16)f2bf(x0 * acc[i]);
        }
        __syncthreads();
    }
}

__device__ __forceinline__ void phase_attn_naive(const Args& a, int half, int tid, int G) {
    bf16* Q = (bf16*)(a.ws + WS_Q); const bf16* KV = (const bf16*)(a.ws + WS_KV); float* lse = (float*)(a.ws + WS_LSE);
    for (int idx = blockIdx.x * NTHR + tid; idx < 3 * 8 * HALF_TOK; idx += G * NTHR) {
        const int g = idx / (8 * HALF_TOK), t = idx % (8 * HALF_TOK), h = t / HALF_TOK, tokl = t % HALF_TOK;
        const int dil = (g == 0) ? 1 : (g == 1 ? 4 : 16);
        const int token = half * HALF_TOK + tokl, s = token & 2047;
        bf16* qp = Q + (size_t)token * 1536 + g * 512 + h * 64;
        float q[64], o[64];
#pragma unroll
        for (int i = 0; i < 8; ++i) { const v4u w = *(const v4u*)(qp + 8 * i);
            q[8 * i + 0] = __uint_as_float(w.x << 16); q[8 * i + 1] = __uint_as_float(w.x & 0xffff0000u); q[8 * i + 2] = __uint_as_float(w.y << 16); q[8 * i + 3] = __uint_as_float(w.y & 0xffff0000u);
            q[8 * i + 4] = __uint_as_float(w.z << 16); q[8 * i + 5] = __uint_as_float(w.z & 0xffff0000u); q[8 * i + 6] = __uint_as_float(w.w << 16); q[8 * i + 7] = __uint_as_float(w.w & 0xffff0000u); }
#pragma unroll
        for (int i = 0; i < 64; ++i) o[i] = 0.f;
        float mx = -1e30f, l = 0.f;
        for (int j = -64; j <= 64; ++j) {
            const int sp = s + j * dil;
            if (sp < 0 || sp >= SEQ) continue;
            const bf16* kp = KV + (size_t)(tokl + j * dil) * 3072 + g * 1024 + h * 64;
            float sc = 0.f;
#pragma unroll
            for (int i = 0; i < 8; ++i) { const v4u w = *(const v4u*)(kp + 8 * i);
                sc += q[8 * i + 0] * __uint_as_float(w.x << 16) + q[8 * i + 1] * __uint_as_float(w.x & 0xffff0000u) + q[8 * i + 2] * __uint_as_float(w.y << 16) + q[8 * i + 3] * __uint_as_float(w.y & 0xffff0000u)
                    + q[8 * i + 4] * __uint_as_float(w.z << 16) + q[8 * i + 5] * __uint_as_float(w.z & 0xffff0000u) + q[8 * i + 6] * __uint_as_float(w.w << 16) + q[8 * i + 7] * __uint_as_float(w.w & 0xffff0000u); }
            const float mn = fmaxf(mx, sc), corr = exp2f(mx - mn), p = exp2f(sc - mn);
            l = l * corr + p; mx = mn;
            const bf16* vp = kp + 512;
#pragma unroll
            for (int i = 0; i < 8; ++i) { const v4u w = *(const v4u*)(vp + 8 * i);
                o[8 * i + 0] = o[8 * i + 0] * corr + p * __uint_as_float(w.x << 16); o[8 * i + 1] = o[8 * i + 1] * corr + p * __uint_as_float(w.x & 0xffff0000u);
                o[8 * i + 2] = o[8 * i + 2] * corr + p * __uint_as_float(w.y << 16); o[8 * i + 3] = o[8 * i + 3] * corr + p * __uint_as_float(w.y & 0xffff0000u);
                o[8 * i + 4] = o[8 * i + 4] * corr + p * __uint_as_float(w.z << 16); o[8 * i + 5] = o[8 * i + 5] * corr + p * __uint_as_float(w.z & 0xffff0000u);
                o[8 * i + 6] = o[8 * i + 6] * corr + p * __uint_as_float(w.w << 16); o[8 * i + 7] = o[8 * i + 7] * corr + p * __uint_as_float(w.w & 0xffff0000u); }
        }
        const float inv = 1.0f / l;
#pragma unroll
        for (int i = 0; i < 8; ++i) { v4u w; w.x = pk2(o[8 * i] * inv, o[8 * i + 1] * inv); w.y = pk2(o[8 * i + 2] * inv, o[8 * i + 3] * inv); w.z = pk2(o[8 * i + 4] * inv, o[8 * i + 5] * inv); w.w = pk2(o[8 * i + 6] * inv, o[8 * i + 7] * inv);
            *(v4u*)(qp + 8 * i) = w; }
        lse[((size_t)g * MTOK + token) * 8 + h] = mx + log2f(l);
    }
}

__device__ __forceinline__ void phase_combine(const Args& a, int tid, int G) {
    const bf16* Q = (const bf16*)(a.ws + WS_Q); const float* lse = (const float*)(a.ws + WS_LSE); bf16* ya = (bf16*)(a.ws + WS_YATT);
    for (int idx = blockIdx.x * NTHR + tid; idx < MTOK * 64; idx += G * NTHR) {
        const int token = idx >> 6, ch = idx & 63, h = ch >> 3;
        const float l0 = lse[((size_t)0 * MTOK + token) * 8 + h], l1 = lse[((size_t)1 * MTOK + token) * 8 + h], l2 = lse[((size_t)2 * MTOK + token) * 8 + h];
        const float mx = fmaxf(l0, fmaxf(l1, l2));
        float w0 = exp2f(l0 - mx), w1 = exp2f(l1 - mx), w2 = exp2f(l2 - mx);
        const float inv = 1.0f / (w0 + w1 + w2); w0 *= inv; w1 *= inv; w2 *= inv;
        const bf16* p = Q + (size_t)token * 1536 + ch * 8;
        const v4u a0 = *(const v4u*)p, a1 = *(const v4u*)(p + 512), a2 = *(const v4u*)(p + 1024);
        v4u o;
#define CMB(f) pk2(w0 * __uint_as_float(a0.f << 16) + w1 * __uint_as_float(a1.f << 16) + w2 * __uint_as_float(a2.f << 16), \
                   w0 * __uint_as_float(a0.f & 0xffff0000u) + w1 * __uint_as_float(a1.f & 0xffff0000u) + w2 * __uint_as_float(a2.f & 0xffff0000u))
        o.x = CMB(x); o.y = CMB(y); o.z = CMB(z); o.w = CMB(w);
#undef CMB
        *(v4u*)(ya + (size_t)token * 512 + ch * 8) = o;
    }
}

__device__ __forceinline__ void phase_final_norm(const Args& a, int lane, int wave, int G) {
    float* x = a.out; const float* gain = a.in[18];
    const int gw = blockIdx.x * NWAVES + wave, NGW = G * NWAVES;
    for (int m = gw; m < MTOK; m += NGW) {
        f32x4* xr = (f32x4*)(x + (size_t)m * DM) + lane;
        f32x4 v[4]; float s = 0.f;
#pragma unroll
        for (int j = 0; j < 4; ++j) { v[j] = xr[64 * j]; s += (v[j][0] * v[j][0] + v[j][1] * v[j][1]) + (v[j][2] * v[j][2] + v[j][3] * v[j][3]); }
        s = wave_sum(s);
        const float rs = 1.0f / sqrtf(s * (1.0f / 1024.0f) + 1e-6f);
#pragma unroll
        for (int j = 0; j < 4; ++j) { const f32x4 gn = *((const f32x4*)gain + lane + 64 * j); xr[64 * j] = v[j] * rs * gn; }
    }
}

#define GEMM_CALL(EPI, SCHED, g, S, E) pg8::gemm_phase<EPI, SCHED, true, true>(lds, g, S, E)

typedef const __attribute__((address_space(4))) Args* KArgs;
__device__ __forceinline__ Args load_args() {
#if defined(__HIP_DEVICE_COMPILE__)
    KArgs p = (KArgs)__builtin_amdgcn_kernarg_segment_ptr();
    asm volatile("" : "+s"(p));
    return *p;
#else
    return Args{};
#endif
}
__global__ void __launch_bounds__(NTHR, 2) fwd_megakernel(Args a_unused) {
    extern __shared__ __attribute__((aligned(16))) unsigned char lds_raw[];
    LAS unsigned char* lds = (LAS unsigned char*)lds_raw;
    cg::grid_group grid = cg::this_grid();
    const int tid0 = threadIdx.x, G0 = gridDim.x, bx0 = blockIdx.x;
#define PTRS() const Args a = load_args(); int tid = tid0, G = G0, bx = bx0; asm volatile("" : "+v"(tid), "+s"(G), "+s"(bx)); const int lane = tid & 63, wave = __builtin_amdgcn_readfirstlane(tid >> 6); (void)lane; (void)wave; unsigned char* ws = a.ws; bf16* Wb = (bf16*)(ws + WS_W); const pg8::bf16_t* xb = (const pg8::bf16_t*)(ws + WS_XB); \
    const float* rcos = (const float*)(ws + WS_ROPE); const float* rsin = rcos + 65536; float* ssqA = (float*)(ws + WS_SSQA); float* ssqB = (float*)(ws + WS_SSQB); \
    (void)Wb; (void)xb; (void)rcos; (void)rsin; (void)ssqA; (void)ssqB;
#define GIN() pg8::Gemm gin{xb, (const pg8::bf16_t*)(Wb + W_IN / 2), nullptr, nullptr, MTOK, NIN, DM}; \
    pg8::EpiIn Ein{(pg8::bf16_t*)(ws + WS_HY), (pg8::bf16_t*)(ws + WS_Q), (pg8::bf16_t*)(ws + WS_KV), (pg8::bf16_t*)(ws + WS_GATES), ssqA, rcos, rsin, 0};

#pragma unroll 1
    for (int L = 0; L < 2; ++L) {
        { PTRS(); phase_prep_weights(a, L, lds, tid, lane, wave, G); }
        grid.sync();
        {
            PTRS(); GIN();
            pg8::TwoRect S; S.a.init(128, 12, 0, 0, G, bx); S.b.init(64, 12, 0, 12, G, bx); S.na = S.a.count();
            GEMM_CALL(pg8::EpiIn, pg8::TwoRect, gin, S, Ein);
        }
        grid.sync();
        { PTRS(); phase_attn_naive(a, 0, tid, G); phase_prep_u(a, L, lds, tid, G); }
        grid.sync();
        {
            PTRS(); GIN();
            pg8::RectOrder S; S.init(64, 12, 64, 12, G, bx);
            Ein.kv_row0 = HALF_TOK;
            GEMM_CALL(pg8::EpiIn, pg8::RectOrder, gin, S, Ein);
        }
        { PTRS(); phase_hyena_naive(a, L, lds, tid, G); }
        grid.sync();
        { PTRS(); phase_attn_naive(a, 1, tid, G); }
        {
            PTRS(); GIN();
            pg8::RectOrder S; S.init(128, 8, 0, 24, G, bx);
            GEMM_CALL(pg8::EpiIn, pg8::RectOrder, gin, S, Ein);
        }
        grid.sync();
        { PTRS(); phase_combine(a, tid, G); }
        grid.sync();
        {
            PTRS();
            pg8::Gemm g{(const pg8::bf16_t*)(ws + WS_YHY), (const pg8::bf16_t*)(Wb + W_PHY / 2), (const pg8::bf16_t*)(ws + WS_YATT), (const pg8::bf16_t*)(Wb + W_PATT / 2), MTOK, DM, 512};
            pg8::PairOrder S; S.r.init(128, 4, 0, 0, G, bx);
            pg8::EpiGate E{(const pg8::bf16_t*)(ws + WS_GATES), (pg8::bf16_t*)(ws + WS_MERGED)};
            GEMM_CALL(pg8::EpiGate, pg8::PairOrder, g, S, E);
        }
        grid.sync();
        {
            PTRS();
            pg8::Gemm g{(const pg8::bf16_t*)(ws + WS_MERGED), (const pg8::bf16_t*)(Wb + W_O / 2), nullptr, nullptr, MTOK, DM, DM};
            pg8::RectOrder S; S.init(128, 4, 0, 0, G, bx);
            pg8::EpiRes E{L == 0 ? a.in[0] : a.out, a.out, (pg8::bf16_t*)(ws + WS_XB), ssqB};
            GEMM_CALL(pg8::EpiRes, pg8::RectOrder, g, S, E);
        }
        grid.sync();
        {
            PTRS();
            pg8::Gemm g{xb, (const pg8::bf16_t*)(Wb + W_FF1 / 2), nullptr, nullptr, MTOK, DFF, DM};
            pg8::RectOrder S; S.init(128, 16, 0, 0, G, bx);
            pg8::EpiFF1 E{(pg8::bf16_t*)(ws + WS_H), ssqB};
            GEMM_CALL(pg8::EpiFF1, pg8::RectOrder, g, S, E);
        }
        grid.sync();
        {
            PTRS();
            pg8::Gemm g{(const pg8::bf16_t*)(ws + WS_H), (const pg8::bf16_t*)(Wb + W_FF2 / 2), nullptr, nullptr, MTOK, DM, DFF};
            pg8::RectOrder S; S.init(128, 4, 0, 0, G, bx);
            pg8::EpiRes E{a.out, a.out, (pg8::bf16_t*)(ws + WS_XB), ssqA};
            GEMM_CALL(pg8::EpiRes, pg8::RectOrder, g, S, E);
        }
        grid.sync();
    }
    { PTRS(); phase_final_norm(a, lane, wave, G); }
}

extern "C" void kernel_launch(void* const* d_in, const int* in_sizes, int n_in, void* d_out, int out_size, void* d_ws, size_t ws_size, hipStream_t stream) {
    static int grid = 0;
    if (grid == 0) {
        if (n_in != 19 || in_sizes[0] != MTOK * DM || out_size != MTOK * DM || ws_size < WS_END) {
            fprintf(stderr, "kernel_launch: unexpected shapes / workspace (n_in %d, ws %zu, need %zu); nothing launched\n", n_in, ws_size, (size_t)WS_END); grid = -1; return; }
        int dev = 0, cus = 0, per_cu = 0;
        (void)hipGetDevice(&dev); (void)hipDeviceGetAttribute(&cus, hipDeviceAttributeMultiprocessorCount, dev);
        if (hipFuncSetAttribute((const void*)fwd_megakernel, hipFuncAttributeMaxDynamicSharedMemorySize, LDS_BYTES) != hipSuccess) { fprintf(stderr, "kernel_launch: hipFuncSetAttribute failed\n"); grid = -1; return; }
        if (hipOccupancyMaxActiveBlocksPerMultiprocessor(&per_cu, (const void*)fwd_megakernel, NTHR, LDS_BYTES) != hipSuccess || per_cu < 1) { fprintf(stderr, "kernel_launch: occupancy query gives %d\n", per_cu); per_cu = 1; }
        (void)hipGetLastError();
        grid = cus * 1;
        if (grid % 8 != 0 || grid > 256) grid = (grid > 256) ? 256 : (grid / 8) * 8;
    }
    if (grid < 0) return;
    Args a{};
    for (int i = 0; i < 19; ++i) a.in[i] = (const float*)d_in[i];
    a.out = (float*)d_out; a.ws = (unsigned char*)d_ws;
    void* args[] = {&a};
    hipError_t e = hipLaunchCooperativeKernel((const void*)fwd_megakernel, dim3(grid), dim3(NTHR), args, LDS_BYTES, stream);
    if (e != hipSuccess) fprintf(stderr, "cooperative launch failed: %s (grid %d)\n", hipGetErrorString(e), grid);
}
```

```cpp
#include <hip/hip_runtime.h>
#include <hip/hip_cooperative_groups.h>
#include <cstdio>
#include <cstdint>
namespace cg = cooperative_groups;

namespace pg8 {
#define PG8_LAS __attribute__((address_space(3)))
typedef unsigned short bf16_t;
typedef short bf16x8 __attribute__((ext_vector_type(8)));
typedef float f32x4 __attribute__((ext_vector_type(4)));
typedef unsigned u32x4 __attribute__((ext_vector_type(4)));
constexpr int BM = 256, BK = 64, HALF = 128, HTB = HALF * BK * 2  , STAGE_BYTES = 8 * HTB, NXCD = 8, WGM = 8;

__host__ __device__ __forceinline__ int lds_byte(int r, int c) { const int st = (r >> 4) * 2 + (c >> 5), rr = r & 15, cc = c & 31, ob = rr * 64 + cc * 2; return st * 1024 + (ob ^ (((ob >> 9) & 1) << 5)); }
__host__ __device__ __forceinline__ void stage_rc(int b, int& R, int& C) { const int st = b / 1024, sb = b % 1024, swz = sb ^ (((sb >> 9) & 1) << 5); R = (st >> 1) * 16 + swz / 64; C = (st & 1) * 32 + (swz % 64) / 2; }
__host__ __device__ __forceinline__ int perm32(int rho) { const int n = rho >> 4, i = rho & 15; return 8 * (i >> 2) + 4 * n + (i & 3); }

struct Unit { int pm, pn, z; };
struct Gemm { const bf16_t* A; const bf16_t* Bt; const bf16_t* A1; const bf16_t* Bt1; int M, N, K; };

struct StaticOrder {
    int nM, nN, nwg, G, c;
    __host__ __device__ void init(int M, int N, int G_, int c_) { nM = M / BM; nN = N / BM; nwg = nM * nN; G = G_; c = c_; }
    __host__ __device__ bool next(int i, Unit& u) const {
        const long L = (long)i * G + c; if (L >= nwg) return false;
        int wgid = (int)L; { const int q = nwg / NXCD, r = nwg % NXCD, xcd = wgid % NXCD, off = wgid / NXCD; wgid = (xcd < r ? xcd * (q + 1) : r * (q + 1) + (xcd - r) * q) + off; }
        const int nig = WGM * nN, gid = wgid / nig, fm = gid * WGM, gsz = (nM - fm) < WGM ? (nM - fm) : WGM;
        u.pm = fm + ((wgid % nig) % gsz); u.pn = (wgid % nig) / gsz; return true;
    }
    __device__ __forceinline__ void a_ready(const Unit&) const {}
    __device__ __forceinline__ void done(const Unit&) const {}
};


__device__ __forceinline__ unsigned cvt_pk_bf16(float lo, float hi) { unsigned r; asm volatile("v_cvt_pk_bf16_f32 %0, %1, %2" : "=v"(r) : "v"(lo), "v"(hi)); return r; }
__device__ __forceinline__ float bf_lo(unsigned w) { return __uint_as_float(w << 16); }
__device__ __forceinline__ float bf_hi(unsigned w) { return __uint_as_float(w & 0xffff0000u); }

struct RectOrder {
    int nN, nwg, G, c, pm0, pn0;
    __device__ __forceinline__ void init(int nM_, int nN_, int pm0_, int pn0_, int G_, int c_) { nN = nN_; nwg = nM_ * nN_; G = G_; c = c_; pm0 = pm0_; pn0 = pn0_; }
    __device__ __forceinline__ int count() const { return nwg > c ? (nwg - c + G - 1) / G : 0; }
    __device__ __forceinline__ bool next(int i, Unit& u) const {
        const long L = (long)i * G + c; if (L >= nwg) return false;
        const int w = (int)L, nig = 8 * nN, gid = w / nig, r = w % nig;
        u.pm = pm0 + gid * 8 + (r & 7); u.pn = pn0 + (r >> 3); u.z = 0; return true;
    }
    __device__ __forceinline__ void a_ready(const Unit&) const {}
    __device__ __forceinline__ void done(const Unit&) const {}
};
struct TwoRect {
    RectOrder a, b; int na;
    __device__ __forceinline__ bool next(int i, Unit& u) const { return i < na ? a.next(i, u) : b.next(i - na, u); }
    __device__ __forceinline__ void a_ready(const Unit&) const {}
    __device__ __forceinline__ void done(const Unit&) const {}
};
struct PairOrder {
    RectOrder r;
    __device__ __forceinline__ bool next(int i, Unit& u) const { const bool ok = r.next(i >> 1, u); u.z = i & 1; return ok; }
    __device__ __forceinline__ void a_ready(const Unit&) const {}
    __device__ __forceinline__ void done(const Unit&) const {}
};

constexpr float RMS_EPS = 1e-6f;
constexpr float QSCALE = 0.125f * 1.44269504088896341f;

__device__ __forceinline__ float row_rstd(const float* ssq, int row) {
    const f32x4* p = (const f32x4*)(ssq + (size_t)row * 16);
    const f32x4 a = p[0], b = p[1], c = p[2], d = p[3];
    const float s = ((a[0] + a[1]) + (a[2] + a[3])) + ((b[0] + b[1]) + (b[2] + b[3])) + ((c[0] + c[1]) + (c[2] + c[3])) + ((d[0] + d[1]) + (d[2] + d[3]));
    return 1.0f / sqrtf(s * (1.0f / 1024.0f) + RMS_EPS);
}

struct EpiIn {
    static constexpr bool PERM = true, AFTER_DRAIN = false;
    bf16_t* hy; bf16_t* q; bf16_t* kv; bf16_t* gates; const float* ssq; const float* rcos; const float* rsin; int kv_row0;
    __device__ __forceinline__ bool operator()(f32x4 (&acc)[2][2][4][2], const Unit& u, int wr, int wc, int fr, int fq) const {
        const int pn = u.pn; int type, ldc, colt, rowoff = 0; bf16_t* base;
        if (pn < 6) { type = 0; base = hy; ldc = 1536; colt = pn * 256; }
        else if (pn < 12) { type = 1; base = q; ldc = 1536; colt = (pn - 6) * 256; }
        else if (pn < 24) { const int idx = pn - 12; type = ((idx >> 1) & 1) ? 0 : 2; base = kv; ldc = 3072; colt = idx * 256; rowoff = kv_row0; }
        else { type = 3; base = gates; ldc = 2048; colt = (pn - 24) * 256; }
#pragma unroll
        for (int ai = 0; ai < 2; ++ai)
#pragma unroll
            for (int m = 0; m < 4; ++m) {
                const int row = u.pm * BM + ai * HALF + wr * 64 + m * 16 + fr;
                const float rs = row_rstd(ssq, row);
                bf16_t* rowp = base + (size_t)(row - rowoff) * ldc + colt;
                f32x4 v00 = acc[ai][0][m][0] * rs, v01 = acc[ai][0][m][1] * rs, v10 = acc[ai][1][m][0] * rs, v11 = acc[ai][1][m][1] * rs;
                if (type == 1 || type == 2) {
                    const int pos = row & 2047;
                    const f32x4 c0 = *(const f32x4*)(rcos + pos * 32 + 8 * fq), c1 = *(const f32x4*)(rcos + pos * 32 + 8 * fq + 4);
                    const f32x4 s0 = *(const f32x4*)(rsin + pos * 32 + 8 * fq), s1 = *(const f32x4*)(rsin + pos * 32 + 8 * fq + 4);
                    const float sc = (type == 1) ? QSCALE : 1.0f;
                    const f32x4 o00 = (v00 * c0 - v10 * s0) * sc, o01 = (v01 * c1 - v11 * s1) * sc;
                    const f32x4 o10 = (v10 * c0 + v00 * s0) * sc, o11 = (v11 * c1 + v01 * s1) * sc;
                    u32x4 w0, w1;
                    w0.x = cvt_pk_bf16(o00[0], o00[1]); w0.y = cvt_pk_bf16(o00[2], o00[3]); w0.z = cvt_pk_bf16(o01[0], o01[1]); w0.w = cvt_pk_bf16(o01[2], o01[3]);
                    w1.x = cvt_pk_bf16(o10[0], o10[1]); w1.y = cvt_pk_bf16(o10[2], o10[3]); w1.z = cvt_pk_bf16(o11[0], o11[1]); w1.w = cvt_pk_bf16(o11[2], o11[3]);
                    *(u32x4*)(rowp + wc * 64 + 8 * fq) = w0;
                    *(u32x4*)(rowp + wc * 64 + 8 * fq + 32) = w1;
                } else {
                    if (type == 3) {
#pragma unroll
                        for (int e = 0; e < 4; ++e) {
                            v00[e] = 1.0f / (1.0f + __expf(-v00[e])); v01[e] = 1.0f / (1.0f + __expf(-v01[e]));
                            v10[e] = 1.0f / (1.0f + __expf(-v10[e])); v11[e] = 1.0f / (1.0f + __expf(-v11[e]));
                        }
                    }
                    u32x4 w0, w1;
                    w0.x = cvt_pk_bf16(v00[0], v00[1]); w0.y = cvt_pk_bf16(v00[2], v00[3]); w0.z = cvt_pk_bf16(v01[0], v01[1]); w0.w = cvt_pk_bf16(v01[2], v01[3]);
                    w1.x = cvt_pk_bf16(v10[0], v10[1]); w1.y = cvt_pk_bf16(v10[2], v10[3]); w1.z = cvt_pk_bf16(v11[0], v11[1]); w1.w = cvt_pk_bf16(v11[2], v11[3]);
                    *(u32x4*)(rowp + wc * 32 + 8 * fq) = w0;
                    *(u32x4*)(rowp + wc * 32 + 8 * fq + HALF) = w1;
                }
            }
        return false;
    }
};

struct EpiGate {
    static constexpr bool PERM = true, AFTER_DRAIN = false;
    const bf16_t* gates; bf16_t* merged;
    __device__ __forceinline__ bool operator()(f32x4 (&acc)[2][2][4][2], const Unit& u, int wr, int wc, int fr, int fq) const {
#pragma unroll
        for (int ai = 0; ai < 2; ++ai)
#pragma unroll
            for (int m = 0; m < 4; ++m) {
                const int row = u.pm * BM + ai * HALF + wr * 64 + m * 16 + fr;
                const int col0 = u.pn * BM + wc * 32 + 8 * fq;
#pragma unroll
                for (int bj = 0; bj < 2; ++bj) {
                    const u32x4 ga = *(const u32x4*)(gates + (size_t)row * 2048 + 1024 + col0 + bj * HALF);
                    f32x4 a0 = (f32x4){bf_lo(ga.x), bf_hi(ga.x), bf_lo(ga.y), bf_hi(ga.y)}, a1 = (f32x4){bf_lo(ga.z), bf_hi(ga.z), bf_lo(ga.w), bf_hi(ga.w)};
                    if (u.z == 0) {
                        const u32x4 gh = *(const u32x4*)(gates + (size_t)row * 2048 + col0 + bj * HALF);
                        const f32x4 h0 = (f32x4){bf_lo(gh.x), bf_hi(gh.x), bf_lo(gh.y), bf_hi(gh.y)}, h1 = (f32x4){bf_lo(gh.z), bf_hi(gh.z), bf_lo(gh.w), bf_hi(gh.w)};
#pragma unroll
                        for (int e = 0; e < 4; ++e) { a0[e] = fmaxf(a0[e], 1e-30f); a1[e] = fmaxf(a1[e], 1e-30f); }
                        acc[ai][bj][m][0] = acc[ai][bj][m][0] * (h0 / a0);
                        acc[ai][bj][m][1] = acc[ai][bj][m][1] * (h1 / a1);
                    } else {
                        const f32x4 v0 = acc[ai][bj][m][0] * a0, v1 = acc[ai][bj][m][1] * a1;
                        u32x4 w; w.x = cvt_pk_bf16(v0[0], v0[1]); w.y = cvt_pk_bf16(v0[2], v0[3]); w.z = cvt_pk_bf16(v1[0], v1[1]); w.w = cvt_pk_bf16(v1[2], v1[3]);
                        *(u32x4*)(merged + (size_t)row * 1024 + col0 + bj * HALF) = w;
                    }
                }
            }
        return u.z == 0;
    }
};

struct EpiRes {
    static constexpr bool PERM = false, AFTER_DRAIN = false;
    const float* base; float* out; bf16_t* xb; float* ssq;
    __device__ __forceinline__ bool operator()(f32x4 (&acc)[2][2][4][2], const Unit& u, int wr, int wc, int fr, int fq) const {
        typedef unsigned u32x2v __attribute__((ext_vector_type(2)));
        int rl = wr * 64 + fr, cl = wc * 32 + 4 * fq;
        asm volatile("" : "+v"(rl), "+v"(cl));
#pragma unroll
        for (int ai = 0; ai < 2; ++ai)
#pragma unroll
            for (int m = 0; m < 4; ++m) {
                const int row = u.pm * BM + ai * HALF + m * 16 + rl;
                const size_t off = (size_t)row * 1024 + u.pn * BM + cl;
                float s = 0.f;
#pragma unroll
                for (int bj = 0; bj < 2; ++bj)
#pragma unroll
                    for (int n = 0; n < 2; ++n) {
                        const f32x4 o = *(const f32x4*)(base + off + bj * HALF + n * 16) + acc[ai][bj][m][n];
                        *(f32x4*)(out + off + bj * HALF + n * 16) = o;
                        u32x2v w; w.x = cvt_pk_bf16(o[0], o[1]); w.y = cvt_pk_bf16(o[2], o[3]);
                        *(u32x2v*)(xb + off + bj * HALF + n * 16) = w;
                        s += (o[0] * o[0] + o[1] * o[1]) + (o[2] * o[2] + o[3] * o[3]);
                    }
                s += __shfl_xor(s, 16); s += __shfl_xor(s, 32);
                if (fq == 0) ssq[(size_t)row * 16 + u.pn * 4 + wc] = s;
                asm volatile("" ::: "memory");
            }
        return false;
    }
};

struct EpiFF1 {
    static constexpr bool PERM = true, AFTER_DRAIN = false;
    bf16_t* h; const float* ssq;
    __device__ __forceinline__ bool operator()(f32x4 (&acc)[2][2][4][2], const Unit& u, int wr, int wc, int fr, int fq) const {
#pragma unroll
        for (int ai = 0; ai < 2; ++ai)
#pragma unroll
            for (int m = 0; m < 4; ++m) {
                const int row = u.pm * BM + ai * HALF + wr * 64 + m * 16 + fr;
                const float rs = row_rstd(ssq, row);
                bf16_t* rowp = h + (size_t)row * 4096 + u.pn * BM + wc * 32 + 8 * fq;
#pragma unroll
                for (int bj = 0; bj < 2; ++bj) {
                    f32x4 v0 = acc[ai][bj][m][0] * rs, v1 = acc[ai][bj][m][1] * rs;
#pragma unroll
                    for (int e = 0; e < 4; ++e) { v0[e] = fmaxf(v0[e], 0.f); v1[e] = fmaxf(v1[e], 0.f); }
                    v0 = v0 * v0; v1 = v1 * v1;
                    u32x4 w; w.x = cvt_pk_bf16(v0[0], v0[1]); w.y = cvt_pk_bf16(v0[2], v0[3]); w.z = cvt_pk_bf16(v1[0], v1[1]); w.w = cvt_pk_bf16(v1[2], v1[3]);
                    *(u32x4*)(rowp + bj * HALF) = w;
                }
            }
        return false;
    }
};

template <class Epi, class Sched, bool ALIGN_EPI = false, bool SP2 = false>
__device__ __forceinline__ void gemm_phase(PG8_LAS unsigned char* lds, const Gemm g, const Sched& S, const Epi& E) {
    int tid_ = threadIdx.x; asm volatile("" : "+v"(tid_));
    const int tid = tid_, wid = __builtin_amdgcn_readfirstlane(tid >> 6), lane = tid & 63, wr = wid >> 2, wc = wid & 3, fr = lane & 15, fq = lane >> 4;
    const int K = g.K, nt = K / BK;
    unsigned voffA[2], voffB[2];
#pragma unroll
    for (int i = 0; i < 2; ++i) { int R, C; stage_rc(tid * 16 + i * 8192, R, C); const int Rb = Epi::PERM ? ((R & ~31) + perm32(R & 31)) : R;
        voffA[i] = (unsigned)(R * K + C) * 2u; voffB[i] = (unsigned)(Rb * K + C) * 2u; }
    const size_t kstep = (size_t)(BK * 2);
    const size_t hstep = (size_t)HALF * K * 2;
    const size_t tstep = 2 * hstep;
    const unsigned ldsw = (unsigned)wid * 1024u;
    const int aoff = lds_byte(wr * 64 + fr, fq * 8), boff = lds_byte(wc * 32 + fr, fq * 8);
#define PG8_SA(b, h) (((b) * 2 + (h)) * HTB)
#define PG8_SB(b, h) ((4 + (b) * 2 + (h)) * HTB)
#define PG8_STAGE(bufoff, gbase, voff) do { _Pragma("unroll") for (int _i = 0; _i < 2; ++_i) \
        __builtin_amdgcn_global_load_lds((const unsigned*)((const char*)(gbase) + (voff)[_i]), (PG8_LAS unsigned*)(lds + (bufoff) + ldsw + _i * 8192), 16, 0, 0); } while (0)
#define PG8_LDA(dst, b, h) do { _Pragma("unroll") for (int m = 0; m < 4; ++m) _Pragma("unroll") for (int k = 0; k < 2; ++k) dst[m][k] = *(const PG8_LAS bf16x8*)(lds + PG8_SA(b, h) + aoff + m * 2048 + k * 1024); } while (0)
#define PG8_LDB(dst, b, h) do { _Pragma("unroll") for (int n = 0; n < 2; ++n) _Pragma("unroll") for (int k = 0; k < 2; ++k) dst[n][k] = *(const PG8_LAS bf16x8*)(lds + PG8_SB(b, h) + boff + n * 2048 + k * 1024); } while (0)
#define PG8_MMA(ai, bj, At, Bt) do { __builtin_amdgcn_s_setprio(1); _Pragma("unroll") for (int m = 0; m < 4; ++m) _Pragma("unroll") for (int n = 0; n < 2; ++n) _Pragma("unroll") for (int k = 0; k < 2; ++k) \
        acc[ai][bj][m][n] = __builtin_amdgcn_mfma_f32_16x16x32_bf16(Bt[n][k], At[m][k], acc[ai][bj][m][n], 0, 0, 0); __builtin_amdgcn_s_setprio(0); } while (0)
#define PG8_WAIT_V(n) asm volatile("s_waitcnt vmcnt(" #n ")" ::: "memory")
#define PG8_WAIT_L(n) asm volatile("s_waitcnt lgkmcnt(" #n ")" ::: "memory")
#define PG8_BAR __builtin_amdgcn_s_barrier()
#define PG8_SCHED __builtin_amdgcn_sched_barrier(0)
    Unit cur, nxt; int ui = 0;
    if (!S.next(0, cur)) return;
    f32x4 acc[2][2][4][2];
#pragma unroll
    for (int a = 0; a < 2; ++a)
#pragma unroll
        for (int b = 0; b < 2; ++b)
#pragma unroll
            for (int m = 0; m < 4; ++m)
#pragma unroll
                for (int n = 0; n < 2; ++n) acc[a][b][m][n] = (f32x4){0.f, 0.f, 0.f, 0.f};
    bf16x8 At[4][2], B0[2][2], B1[2][2];
    const char* cA = (const char*)(cur.z ? g.A1 : g.A) + (size_t)cur.pm * tstep; const char* cB = (const char*)(cur.z ? g.Bt1 : g.Bt) + (size_t)cur.pn * tstep;
    S.a_ready(cur);
    if constexpr (SP2) {
        PG8_STAGE(PG8_SB(0, 0), cB, voffB); PG8_STAGE(PG8_SB(0, 1), cB + hstep, voffB); PG8_STAGE(PG8_SA(0, 0), cA, voffA); PG8_STAGE(PG8_SA(0, 1), cA + hstep, voffA);
        if (wr == 1) PG8_BAR;
        PG8_WAIT_V(2); PG8_BAR;
        PG8_STAGE(PG8_SB(1, 0), cB + kstep, voffB); PG8_STAGE(PG8_SA(1, 0), cA + kstep, voffA); PG8_STAGE(PG8_SB(1, 1), cB + hstep + kstep, voffB);
        PG8_WAIT_V(6); PG8_BAR;
    } else {
        PG8_STAGE(PG8_SB(0, 0), cB, voffB); PG8_STAGE(PG8_SA(0, 0), cA, voffA); PG8_STAGE(PG8_SB(0, 1), cB + hstep, voffB); PG8_STAGE(PG8_SA(0, 1), cA + hstep, voffA);
        if (wr == 1) PG8_BAR;
        PG8_WAIT_V(4); PG8_BAR;
        PG8_STAGE(PG8_SB(1, 0), cB + kstep, voffB); PG8_STAGE(PG8_SA(1, 0), cA + kstep, voffA); PG8_STAGE(PG8_SB(1, 1), cB + hstep + kstep, voffB);
        PG8_WAIT_V(6); PG8_BAR;
    }
    for (;;) {
        const bool has_next = S.next(ui + 1, nxt);
        const char* nA = has_next ? (const char*)(nxt.z ? g.A1 : g.A) + (size_t)nxt.pm * tstep : cA; const char* nB = has_next ? (const char*)(nxt.z ? g.Bt1 : g.Bt) + (size_t)nxt.pn * tstep : cB;
        for (int t = 0; t < nt; t += 2) {
            const bool last = (t == nt - 2);
            const char* a1 = cA + (size_t)(t + 1) * kstep;
            const char* a2 = last ? nA : cA + (size_t)(t + 2) * kstep; const char* b2 = last ? nB : cB + (size_t)(t + 2) * kstep;
            const char* a3 = a2 + kstep; const char* b3 = b2 + kstep;
            if (last && has_next) S.a_ready(nxt);
            if constexpr (SP2) {
            PG8_LDB(B0, 0, 0); PG8_LDB(B1, 0, 1); PG8_SCHED; PG8_LDA(At, 0, 0); PG8_STAGE(PG8_SA(1, 1), a1 + hstep, voffA);
            PG8_WAIT_V(8); PG8_WAIT_L(0); PG8_BAR; PG8_MMA(0, 0, At, B0); PG8_MMA(0, 1, At, B1); PG8_BAR; PG8_SCHED;
            PG8_LDA(At, 0, 1); PG8_STAGE(PG8_SB(0, 0), b2, voffB); PG8_STAGE(PG8_SB(0, 1), b2 + hstep, voffB); PG8_STAGE(PG8_SA(0, 0), a2, voffA);
            PG8_WAIT_V(8); PG8_WAIT_L(0); PG8_BAR; PG8_MMA(1, 0, At, B0); PG8_MMA(1, 1, At, B1); PG8_BAR; PG8_SCHED;
            PG8_LDB(B0, 1, 0); PG8_LDB(B1, 1, 1); PG8_SCHED; PG8_LDA(At, 1, 0); PG8_STAGE(PG8_SA(0, 1), a2 + hstep, voffA);
            PG8_WAIT_V(8); PG8_WAIT_L(0); PG8_BAR; PG8_MMA(0, 0, At, B0); PG8_MMA(0, 1, At, B1); PG8_BAR; PG8_SCHED;
            PG8_LDA(At, 1, 1); PG8_STAGE(PG8_SB(1, 0), b3, voffB); PG8_STAGE(PG8_SB(1, 1), b3 + hstep, voffB); PG8_STAGE(PG8_SA(1, 0), a3, voffA);
            PG8_WAIT_V(8); PG8_WAIT_L(0); PG8_BAR; PG8_MMA(1, 0, At, B0); PG8_MMA(1, 1, At, B1); PG8_BAR; PG8_SCHED;
            } else {
            PG8_LDB(B0, 0, 0); PG8_SCHED; PG8_LDA(At, 0, 0); PG8_STAGE(PG8_SA(1, 1), a1 + hstep, voffA);
            PG8_WAIT_L(8); PG8_BAR; PG8_WAIT_L(0); PG8_MMA(0, 0, At, B0); PG8_BAR; PG8_SCHED;
            PG8_LDB(B1, 0, 1); PG8_STAGE(PG8_SB(0, 0), b2, voffB);
            PG8_BAR; PG8_WAIT_L(0); PG8_MMA(0, 1, At, B1); PG8_BAR;
            PG8_LDA(At, 0, 1); PG8_STAGE(PG8_SA(0, 0), a2, voffA);
            PG8_BAR; PG8_WAIT_L(0); PG8_MMA(1, 0, At, B0); PG8_BAR; PG8_SCHED;
            PG8_STAGE(PG8_SB(0, 1), b2 + hstep, voffB);
            PG8_WAIT_V(6); PG8_BAR; PG8_MMA(1, 1, At, B1); PG8_BAR;
            PG8_LDB(B0, 1, 0); PG8_SCHED; PG8_LDA(At, 1, 0); PG8_STAGE(PG8_SA(0, 1), a2 + hstep, voffA);
            PG8_WAIT_L(8); PG8_BAR; PG8_WAIT_L(0); PG8_MMA(0, 0, At, B0); PG8_BAR; PG8_SCHED;
            PG8_LDB(B1, 1, 1); PG8_STAGE(PG8_SB(1, 0), b3, voffB);
            PG8_BAR; PG8_WAIT_L(0); PG8_MMA(0, 1, At, B1); PG8_BAR;
            PG8_LDA(At, 1, 1); PG8_STAGE(PG8_SA(1, 0), a3, voffA);
            PG8_BAR; PG8_WAIT_L(0); PG8_MMA(1, 0, At, B0); PG8_BAR; PG8_SCHED;
            PG8_STAGE(PG8_SB(1, 1), b3 + hstep, voffB);
            PG8_WAIT_V(6); PG8_BAR; PG8_MMA(1, 1, At, B1); PG8_BAR;
            }
        }
        if constexpr (ALIGN_EPI) { if (wr == 0) PG8_BAR; }
        bool keep_acc = false; if constexpr (!Epi::AFTER_DRAIN) { keep_acc = E(acc, cur, wr, wc, fr, fq); S.done(cur); }
        if (!has_next) break;
        if (!keep_acc) {
#pragma unroll
        for (int a = 0; a < 2; ++a)
#pragma unroll
            for (int b = 0; b < 2; ++b)
#pragma unroll
                for (int m = 0; m < 4; ++m)
#pragma unroll
                    for (int n = 0; n < 2; ++n) acc[a][b][m][n] = (f32x4){0.f, 0.f, 0.f, 0.f};
        }
        cur = nxt; cA = nA; cB = nB; ++ui;
        if constexpr (ALIGN_EPI) { if (wr == 1) PG8_BAR; }
    }
    PG8_WAIT_V(0);
    if constexpr (!ALIGN_EPI) { if (wr == 0) PG8_BAR; }
    PG8_BAR;
    if constexpr (Epi::AFTER_DRAIN) { E.fused(acc, cur, wr, wc, fr, fq, lds, wid, lane); S.done(cur); }
#undef PG8_SA
#undef PG8_SB
#undef PG8_STAGE
#undef PG8_LDA
#undef PG8_LDB
#undef PG8_MMA
#undef PG8_WAIT_V
#undef PG8_WAIT_L
#undef PG8_BAR
#undef PG8_SCHED
}
}

#define LAS __attribute__((address_space(3)))
typedef unsigned short bf16;
typedef float f32x4 __attribute__((ext_vector_type(4)));
typedef unsigned v4u __attribute__((ext_vector_type(4)));
constexpr int NWAVES = 8, NTHR = 512;
constexpr int MTOK = 32768, DM = 1024, SEQ = 2048, NBATCH = 16, NIN = 8192, DFF = 4096, HYW = 512, HALF_TOK = 16384;
constexpr size_t MiB = (size_t)1 << 20;
constexpr size_t WS_SSQA = 0, WS_SSQB = 2 * MiB, WS_ROPE = 4 * MiB, WS_LSE = 5 * MiB, WS_GF = 8 * MiB, WS_W = 16 * MiB, WS_XB = 52 * MiB,
                 WS_HY = 116 * MiB, WS_UT = 212 * MiB, WS_GATES = 116 * MiB, WS_Q = 244 * MiB, WS_KV = 340 * MiB, WS_YHY = 436 * MiB, WS_YATT = 404 * MiB, WS_X0T = 468 * MiB,
                 WS_MERGED = 340 * MiB, WS_H = 116 * MiB, WS_END = 500 * MiB;
constexpr size_t W_IN = 0, W_PHY = 16 * MiB, W_PATT = 17 * MiB, W_O = 18 * MiB, W_FF1 = 20 * MiB, W_FF2 = 28 * MiB;
constexpr int LDS_BYTES = 139264;

struct Args {
    const float* in[19]; float* out; unsigned char* ws; int pad0, pad1;
};

__device__ __forceinline__ unsigned f2bf(float f) { unsigned u = __float_as_uint(f); return (u + 0x7fffu + ((u >> 16) & 1u)) >> 16; }
__device__ __forceinline__ unsigned pk2(float lo, float hi) { return f2bf(lo) | (f2bf(hi) << 16); }
__device__ __forceinline__ float bf2f(unsigned short b) { return __uint_as_float((unsigned)b << 16); }
__device__ __forceinline__ float wave_sum(float v) {
#pragma unroll
    for (int o = 1; o < 64; o <<= 1) v += __shfl_xor(v, o);
    return v;
}

__device__ __forceinline__ int win_src_col(int n) {
    const int t = n >> 8, j = n & 255;
    if (t < 6) return n;
    if (t >= 24) return 6144 + (n - 6144);
    int g, w, half;
    if (t < 12) { const int i = t - 6; g = i >> 1; w = 0; half = i & 1; }
    else { const int i = t - 12; g = i >> 2; w = 1 + ((i >> 1) & 1); half = i & 1; }
    int hh, d;
    if (w == 2) { hh = j >> 6; d = j & 63; }
    else { hh = (j & 127) >> 5; d = (j & 31) + ((j >> 7) << 5); }
    return 1536 + g * 1536 + w * 512 + (half * 4 + hh) * 64 + d;
}

__device__ __forceinline__ void transpose_item(const float* W, int K, int Nsrc, int s0, bf16* WT, int n0, int k0, const float* gain, LAS float* scr, int lane) {
#pragma unroll 8
    for (int i = 0; i < 32; ++i) { const int kk = 2 * i + (lane >> 5); float v = W[(size_t)(k0 + kk) * Nsrc + s0 + (lane & 31)]; if (gain) v *= gain[k0 + kk]; scr[kk * 33 + (lane & 31)] = v; }
    asm volatile("s_waitcnt lgkmcnt(0)" ::: "memory");
    const int c = lane & 7;
#pragma unroll
    for (int j = 0; j < 4; ++j) { const int n = (lane >> 3) + 8 * j; const LAS float* s = scr + (8 * c) * 33 + n;
        v4u o; o.x = pk2(s[0 * 33], s[1 * 33]); o.y = pk2(s[2 * 33], s[3 * 33]); o.z = pk2(s[4 * 33], s[5 * 33]); o.w = pk2(s[6 * 33], s[7 * 33]);
        *(v4u*)(WT + (size_t)(n0 + n) * K + k0 + 8 * c) = o; }
    asm volatile("s_waitcnt lgkmcnt(0)" ::: "memory");
}

__device__ __forceinline__ void phase_prep_weights(const Args& a, int L, LAS unsigned char* lds, int tid, int lane, int wave, int G) {
    unsigned char* ws = a.ws;
    {
        LAS float* z = (LAS float*)lds; LAS float* h0 = z + 64; LAS float* h1 = z + 128;
        const float* w1 = a.in[5] + (size_t)L * 33 * 64; const float* b1 = a.in[6] + L * 64;
        const float* wi = a.in[7] + (size_t)L * 2 * 64 * 64; const float* bi = a.in[8] + L * 2 * 64;
        const float* wout = a.in[9] + (size_t)L * 64 * 1024; const float* fr = a.in[10] + L * 64; const float* skip = a.in[11] + L * 512;
        bf16* Rg = (bf16*)(ws + WS_GF);
        const float min_decay = logf(1e-2f) / 1.5f, max_decay = logf(1e-2f) / 0.3f;
        for (int n = blockIdx.x; n < SEQ; n += G) {
            const float t = (float)n / 2047.0f;
            if (tid < 33) {
                float v;
                if (tid == 0) v = t;
                else { const int k = (tid - 1) & 15; const float band = 1e-4f + (float)k * ((15.0f - 1e-4f) / 15.0f); const float ang = ((float)(2.0 * 3.14159265358979323846 / 2048.0) * (float)n) * band;
                       v = (tid <= 16) ? cosf(ang) : -sinf(ang); }
                z[tid] = v;
            }
            __syncthreads();
            if (tid < 64) { float s = 0.f;
_Pragma("unroll 3")
 for (int e = 0; e < 33; ++e) s += z[e] * w1[e * 64 + tid]; h0[tid] = sinf(fr[tid] * (s + b1[tid])); }
            __syncthreads();
            if (tid < 64) { float s = 0.f;
_Pragma("unroll 4")
 for (int e = 0; e < 64; ++e) s += h0[e] * wi[e * 64 + tid]; h1[tid] = sinf(fr[tid] * (s + bi[tid])); }
            __syncthreads();
            if (tid < 64) { float s = 0.f;
_Pragma("unroll 4")
 for (int e = 0; e < 64; ++e) s += h1[e] * wi[4096 + e * 64 + tid]; h0[tid] = sinf(fr[tid] * (s + bi[64 + tid])); }
            __syncthreads();
            for (int col = tid; col < 1024; col += NTHR) {
                float s = 0.f;
_Pragma("unroll 4")
 for (int e = 0; e < 64; ++e) s += h0[e] * wout[e * 1024 + col];
                const int c = col & 511, dir = col >> 9;
                const float delta = fabsf(min_decay + (float)c * ((max_decay - min_decay) / 511.0f));
                float val = s * expf(-t * delta);
                int x = -1;
                if (dir == 0) { if (n == 0) val += skip[c]; x = 2048 - n; } else if (n > 0) x = 2048 + n;
                if (x >= 0) { const bf16 hv = (bf16)f2bf(val); Rg[((size_t)c * 2 + 0) * 4096 + x] = hv; Rg[((size_t)c * 2 + 1) * 4096 + x - 1] = hv; }
            }
            __syncthreads();
        }
    }
    {
        LAS float* scr = (LAS float*)(lds + 1024 + wave * 8704);
        const int gw = blockIdx.x * NWAVES + wave, NGW = G * NWAVES;
        bf16* Wb = (bf16*)(ws + WS_W);
        const float* w_in = a.in[2] + (size_t)L * DM * NIN; const float* p_hy = a.in[12] + (size_t)L * 512 * DM; const float* p_att = a.in[13] + (size_t)L * 512 * DM;
        const float* w_o = a.in[14] + (size_t)L * DM * DM; const float* w1 = a.in[16] + (size_t)L * DM * DFF; const float* w2 = a.in[17] + (size_t)L * DFF * DM;
        const float* g_mix = a.in[1] + L * DM; const float* g_ffn = a.in[15] + L * DM;
        constexpr int I_IN = 16 * 256, I_P = 8 * 32, I_O = 16 * 32, I_1 = 16 * 128, I_2 = 64 * 32;
        constexpr int NITEMS = I_IN + 2 * I_P + I_O + I_1 + I_2;
        for (int it = gw; it < NITEMS; it += NGW) {
            int r = it;
            if (r < I_IN) { const int kb = r / 256, nb = r % 256; transpose_item(w_in, DM, NIN, win_src_col(nb * 32), Wb + W_IN / 2, nb * 32, kb * 64, g_mix, scr, lane); continue; } r -= I_IN;
            if (r < I_P) { const int kb = r / 32, nb = r % 32; transpose_item(p_hy, 512, DM, nb * 32, Wb + W_PHY / 2, nb * 32, kb * 64, nullptr, scr, lane); continue; } r -= I_P;
            if (r < I_P) { const int kb = r / 32, nb = r % 32; transpose_item(p_att, 512, DM, nb * 32, Wb + W_PATT / 2, nb * 32, kb * 64, nullptr, scr, lane); continue; } r -= I_P;
            if (r < I_O) { const int kb = r / 32, nb = r % 32; transpose_item(w_o, DM, DM, nb * 32, Wb + W_O / 2, nb * 32, kb * 64, nullptr, scr, lane); continue; } r -= I_O;
            if (r < I_1) { const int kb = r / 128, nb = r % 128; transpose_item(w1, DM, DFF, nb * 32, Wb + W_FF1 / 2, nb * 32, kb * 64, g_ffn, scr, lane); continue; } r -= I_1;
            { const int kb = r / 32, nb = r % 32; transpose_item(w2, DFF, DM, nb * 32, Wb + W_FF2 / 2, nb * 32, kb * 64, nullptr, scr, lane); }
        }
        if (L == 0) {
            const float* x = a.in[0]; bf16* xb = (bf16*)(ws + WS_XB); float* ssq = (float*)(ws + WS_SSQA);
            for (int m = gw; m < MTOK; m += NGW) {
                const f32x4* xr = (const f32x4*)(x + (size_t)m * DM) + lane;
                f32x4 v[4]; float s = 0.f;
#pragma unroll
                for (int j = 0; j < 4; ++j) { v[j] = xr[64 * j]; s += (v[j][0] * v[j][0] + v[j][1] * v[j][1]) + (v[j][2] * v[j][2] + v[j][3] * v[j][3]); }
                s = wave_sum(s);
                unsigned long long* o8 = (unsigned long long*)(xb + (size_t)m * DM) + lane;
#pragma unroll
                for (int j = 0; j < 4; ++j) o8[64 * j] = (unsigned long long)pk2(v[j][0], v[j][1]) | ((unsigned long long)pk2(v[j][2], v[j][3]) << 32);
                if (lane < 16) ssq[(size_t)m * 16 + lane] = (lane == 0) ? s : 0.f;
            }
            float* rc = (float*)(ws + WS_ROPE); float* rsn = rc + 65536;
            for (int i = blockIdx.x * NTHR + tid; i < 65536; i += G * NTHR) {
                const int pos = i >> 5, f = i & 31;
                const float inv = powf(10000.0f, -(float)f / 32.0f);
                const float ang = (float)pos * inv;
                rc[i] = cosf(ang); rsn[i] = sinf(ang);
            }
        }
    }
}

__device__ __forceinline__ void phase_prep_u(const Args& a, int L, LAS unsigned char* lds, int tid, int G) {
    const bf16* hy = (const bf16*)(a.ws + WS_HY); bf16* ut = (bf16*)(a.ws + WS_UT); bf16* x0t = (bf16*)(a.ws + WS_X0T);
    const float* cw = a.in[3] + (size_t)L * 3 * 1536; const float* cb = a.in[4] + L * 1536;
    LAS unsigned short* tile = (LAS unsigned short*)lds;
    for (int item = blockIdx.x; item < 4096; item += G) {
        const int cc = item & 7, mc = (item >> 3) & 31, b = item >> 8;
        const int cl = tid & 63, mr = tid >> 6, c = cc * 64 + cl;
        const float w10 = cw[512 + c], w11 = cw[1536 + 512 + c], w12 = cw[3072 + 512 + c], b1 = cb[512 + c];
        const float wv0 = cw[1024 + c], wv1 = cw[1536 + 1024 + c], wv2 = cw[3072 + 1024 + c], bv = cb[1024 + c];
        const float w00 = cw[c], w01 = cw[1536 + c], w02 = cw[3072 + c], b0 = cb[c];
#pragma unroll
        for (int p = 0; p < 8; ++p) {
            const int ml = p * 8 + mr, m = mc * 64 + ml;
            const bf16* r = hy + (size_t)(b * SEQ + m) * 1536;
            const float x1m = (m > 0) ? bf2f(r[-1536 + 512 + c]) : 0.f, x1c = bf2f(r[512 + c]), x1p = (m < SEQ - 1) ? bf2f(r[1536 + 512 + c]) : 0.f;
            const float vm = (m > 0) ? bf2f(r[-1536 + 1024 + c]) : 0.f, vc = bf2f(r[1024 + c]), vp = (m < SEQ - 1) ? bf2f(r[1536 + 1024 + c]) : 0.f;
            const float u1 = b1 + w10 * x1m + w11 * x1c + w12 * x1p;
            const float uv = bv + wv0 * vm + wv1 * vc + wv2 * vp;
            tile[cl * 72 + ml] = (unsigned short)f2bf(u1 * uv);
            const float x0m = (m > 0) ? bf2f(r[-1536 + c]) : 0.f, x0c = bf2f(r[c]), x0p = (m < SEQ - 1) ? bf2f(r[1536 + c]) : 0.f;
            tile[4608 + cl * 72 + ml] = (unsigned short)f2bf(b0 + w00 * x0m + w01 * x0c + w02 * x0p);
        }
        __syncthreads();
        {
            const int c2 = tid >> 3, ch = tid & 7;
            const LAS unsigned short* s = tile + c2 * 72 + ch * 8;
            v4u o; o.x = s[0] | ((unsigned)s[1] << 16); o.y = s[2] | ((unsigned)s[3] << 16); o.z = s[4] | ((unsigned)s[5] << 16); o.w = s[6] | ((unsigned)s[7] << 16);
            *(v4u*)(ut + ((size_t)(cc * 64 + c2) * NBATCH + b) * SEQ + mc * 64 + ch * 8) = o;
            const LAS unsigned short* s2 = s + 4608;
            v4u o2; o2.x = s2[0] | ((unsigned)s2[1] << 16); o2.y = s2[2] | ((unsigned)s2[3] << 16); o2.z = s2[4] | ((unsigned)s2[5] << 16); o2.w = s2[6] | ((unsigned)s2[7] << 16);
            *(v4u*)(x0t + ((size_t)(cc * 64 + c2) * NBATCH + b) * SEQ + mc * 64 + ch * 8) = o2;
        }
        __syncthreads();
    }
}

__device__ __forceinline__ void phase_hyena_naive(const Args& a, int L, LAS unsigned char* lds, int tid, int G) {
    const bf16* hy = (const bf16*)(a.ws + WS_HY); const bf16* ut = (const bf16*)(a.ws + WS_UT); const float* Gf = (const float*)(a.ws + WS_GF);
    bf16* yhy = (bf16*)(a.ws + WS_YHY);
    const float* cw = a.in[3] + (size_t)L * 3 * 1536; const float* cb = a.in[4] + L * 1536;
    LAS float* Gs = (LAS float*)lds;
    LAS float* Us = Gs + 4096;
    for (int item = blockIdx.x; item < 2048; item += G) {
        const int c = item >> 2, bq = item & 3;
        for (int i = tid; i < 4096; i += NTHR) Gs[i] = (i == 0) ? 0.f : Gf[(size_t)c * 4096 + i];
        for (int i = tid; i < 8192; i += NTHR) { const int bl = i >> 11, m = i & 2047; Us[i] = bf2f(ut[((size_t)c * NBATCH + bq * 4 + bl) * SEQ + m]); }
        __syncthreads();
        const int bl = tid >> 7, tn = tid & 127;
        float acc[16];
#pragma unroll
        for (int i = 0; i < 16; ++i) acc[i] = 0.f;
        const LAS float* up = Us + bl * 2048;
        for (int m = 0; m < SEQ; ++m) {
            const float u = up[m];
            const LAS float* gp = Gs + (tn - m + 2048);
#pragma unroll
            for (int i = 0; i < 16; ++i) acc[i] += gp[128 * i] * u;
        }
        const int b = bq * 4 + bl;
        const float w0 = cw[c], w1 = cw[1536 + c], w2 = cw[3072 + c], b0 = cb[c];
#pragma unroll
        for (int i = 0; i < 16; ++i) {
            const int n = tn + 128 * i;
            const bf16* r = hy + (size_t)(b * SEQ + n) * 1536 + c;
            const float xm = (n > 0) ? bf2f(r[-1536]) : 0.f, xc = bf2f(r[0]), xp = (n < SEQ - 1) ? bf2f(r[1536]) : 0.f;
            const float x0 = b0 + w0 * xm + w1 * xc + w2 * xp;
            yhy[(size_t)(b * SEQ + n) * 512 + c] = (bf16)f2bf(x0 * acc[i]);
        }
        __syncthreads();
    }
}

__device__ __forceinline__ void phase_attn_naive(const Args& a, int half, int tid, int G) {
    bf16* Q = (bf16*)(a.ws + WS_Q); const bf16* KV = (const bf16*)(a.ws + WS_KV); float* lse = (float*)(a.ws + WS_LSE);
    for (int idx = blockIdx.x * NTHR + tid; idx < 3 * 8 * HALF_TOK; idx += G * NTHR) {
        const int g = idx / (8 * HALF_TOK), t = idx % (8 * HALF_TOK), h = t / HALF_TOK, tokl = t % HALF_TOK;
        const int dil = (g == 0) ? 1 : (g == 1 ? 4 : 16);
        const int token = half * HALF_TOK + tokl, s = token & 2047;
        bf16* qp = Q + (size_t)token * 1536 + g * 512 + h * 64;
        float q[64], o[64];
#pragma unroll
        for (int i = 0; i < 8; ++i) { const v4u w = *(const v4u*)(qp + 8 * i);
            q[8 * i + 0] = __uint_as_float(w.x << 16); q[8 * i + 1] = __uint_as_float(w.x & 0xffff0000u); q[8 * i + 2] = __uint_as_float(w.y << 16); q[8 * i + 3] = __uint_as_float(w.y & 0xffff0000u);
            q[8 * i + 4] = __uint_as_float(w.z << 16); q[8 * i + 5] = __uint_as_float(w.z & 0xffff0000u); q[8 * i + 6] = __uint_as_float(w.w << 16); q[8 * i + 7] = __uint_as_float(w.w & 0xffff0000u); }
#pragma unroll
        for (int i = 0; i < 64; ++i) o[i] = 0.f;
        float mx = -1e30f, l = 0.f;
        for (int j = -64; j <= 64; ++j) {
            const int sp = s + j * dil;
            if (sp < 0 || sp >= SEQ) continue;
            const bf16* kp = KV + (size_t)(tokl + j * dil) * 3072 + g * 1024 + h * 64;
            float sc = 0.f;
#pragma unroll
            for (int i = 0; i < 8; ++i) { const v4u w = *(const v4u*)(kp + 8 * i);
                sc += q[8 * i + 0] * __uint_as_float(w.x << 16) + q[8 * i + 1] * __uint_as_float(w.x & 0xffff0000u) + q[8 * i + 2] * __uint_as_float(w.y << 16) + q[8 * i + 3] * __uint_as_float(w.y & 0xffff0000u)
                    + q[8 * i + 4] * __uint_as_float(w.z << 16) + q[8 * i + 5] * __uint_as_float(w.z & 0xffff0000u) + q[8 * i + 6] * __uint_as_float(w.w << 16) + q[8 * i + 7] * __uint_as_float(w.w & 0xffff0000u); }
            const float mn = fmaxf(mx, sc), corr = exp2f(mx - mn), p = exp2f(sc - mn);
            l = l * corr + p; mx = mn;
            const bf16* vp = kp + 512;
#pragma unroll
            for (int i = 0; i < 8; ++i) { const v4u w = *(const v4u*)(vp + 8 * i);
                o[8 * i + 0] = o[8 * i + 0] * corr + p * __uint_as_float(w.x << 16); o[8 * i + 1] = o[8 * i + 1] * corr + p * __uint_as_float(w.x & 0xffff0000u);
                o[8 * i + 2] = o[8 * i + 2] * corr + p * __uint_as_float(w.y << 16); o[8 * i + 3] = o[8 * i + 3] * corr + p * __uint_as_float(w.y & 0xffff0000u);
                o[8 * i + 4] = o[8 * i + 4] * corr + p * __uint_as_float(w.z << 16); o[8 * i + 5] = o[8 * i + 5] * corr + p * __uint_as_float(w.z & 0xffff0000u);
                o[8 * i + 6] = o[8 * i + 6] * corr + p * __uint_as_float(w.w << 16); o[8 * i + 7] = o[8 * i + 7] * corr + p * __uint_as_float(w.w & 0xffff0000u); }
        }
        const float inv = 1.0f / l;
#pragma unroll
        for (int i = 0; i < 8; ++i) { v4u w; w.x = pk2(o[8 * i] * inv, o[8 * i + 1] * inv); w.y = pk2(o[8 * i + 2] * inv, o[8 * i + 3] * inv); w.z = pk2(o[8 * i + 4] * inv, o[8 * i + 5] * inv); w.w = pk2(o[8 * i + 6] * inv, o[8 * i + 7] * inv);
            *(v4u*)(qp + 8 * i) = w; }
        lse[((size_t)g * MTOK + token) * 8 + h] = mx + log2f(l);
    }
}

__device__ __forceinline__ void phase_combine(const Args& a, int tid, int G) {
    const bf16* Q = (const bf16*)(a.ws + WS_Q); const float* lse = (const float*)(a.ws + WS_LSE); bf16* ya = (bf16*)(a.ws + WS_YATT);
    for (int idx = blockIdx.x * NTHR + tid; idx < MTOK * 64; idx += G * NTHR) {
        const int token = idx >> 6, ch = idx & 63, h = ch >> 3;
        const float l0 = lse[((size_t)0 * MTOK + token) * 8 + h], l1 = lse[((size_t)1 * MTOK + token) * 8 + h], l2 = lse[((size_t)2 * MTOK + token) * 8 + h];
        const float mx = fmaxf(l0, fmaxf(l1, l2));
        float w0 = exp2f(l0 - mx), w1 = exp2f(l1 - mx), w2 = exp2f(l2 - mx);
        const float inv = 1.0f / (w0 + w1 + w2); w0 *= inv; w1 *= inv; w2 *= inv;
        const bf16* p = Q + (size_t)token * 1536 + ch * 8;
        const v4u a0 = *(const v4u*)p, a1 = *(const v4u*)(p + 512), a2 = *(const v4u*)(p + 1024);
        v4u o;
#define CMB(f) pk2(w0 * __uint_as_float(a0.f << 16) + w1 * __uint_as_float(a1.f << 16) + w2 * __uint_as_float(a2.f << 16), \
                   w0 * __uint_as_float(a0.f & 0xffff0000u) + w1 * __uint_as_float(a1.f & 0xffff0000u) + w2 * __uint_as_float(a2.f & 0xffff0000u))
        o.x = CMB(x); o.y = CMB(y); o.z = CMB(z); o.w = CMB(w);
#undef CMB
        *(v4u*)(ya + (size_t)token * 512 + ch * 8) = o;
    }
}

__device__ __forceinline__ void phase_final_norm(const Args& a, int lane, int wave, int G) {
    float* x = a.out; const float* gain = a.in[18];
    const int gw = blockIdx.x * NWAVES + wave, NGW = G * NWAVES;
    for (int m = gw; m < MTOK; m += NGW) {
        f32x4* xr = (f32x4*)(x + (size_t)m * DM) + lane;
        f32x4 v[4]; float s = 0.f;
#pragma unroll
        for (int j = 0; j < 4; ++j) { v[j] = xr[64 * j]; s += (v[j][0] * v[j][0] + v[j][1] * v[j][1]) + (v[j][2] * v[j][2] + v[j][3] * v[j][3]); }
        s = wave_sum(s);
        const float rs = 1.0f / sqrtf(s * (1.0f / 1024.0f) + 1e-6f);
#pragma unroll
        for (int j = 0; j < 4; ++j) { const f32x4 gn = *((const f32x4*)gain + lane + 64 * j); xr[64 * j] = v[j] * rs * gn; }
    }
}

typedef short bf16x8 __attribute__((ext_vector_type(8)));
typedef short s16x4 __attribute__((ext_vector_type(4)));
constexpr int HY_UROW = 4112, HY_ROFF = 16 * HY_UROW, HY_RSTRIDE = 8192 + 64;
__device__ __forceinline__ bf16x8 ld_frag4(const LAS unsigned char* p) {
    const LAS unsigned* q = (const LAS unsigned*)p; v4u d; d.x = q[0]; d.y = q[1]; d.z = q[2]; d.w = q[3]; return __builtin_bit_cast(bf16x8, d);
}
__device__ __forceinline__ void phase_hyena_mfma(const Args& a, LAS unsigned char* lds, int tid, int G) {
    const bf16* ut = (const bf16*)(a.ws + WS_UT); const bf16* Rg = (const bf16*)(a.ws + WS_GF); bf16* x0t = (bf16*)(a.ws + WS_X0T);
    const int lane = tid & 63, w = __builtin_amdgcn_readfirstlane(tid >> 6), i16 = lane & 15, kq = lane >> 4;
    const int base = (w >> 1) * 512 + (w & 1) * 16, cp = i16 & 1;
    const int lane_const = (2048 - base - i16 + 8 * kq - cp) >> 1;
    const LAS unsigned char* pA15 = lds + HY_ROFF + cp * HY_RSTRIDE + 4 * (lane_const - 240);
    const LAS unsigned char* pB = lds + i16 * HY_UROW + kq * 16;
    for (int ch = blockIdx.x; ch < HYW; ch += G) {
        for (int i = tid; i < 4096; i += NTHR) { const int b = i >> 8, ck = i & 255; *(LAS v4u*)(lds + b * HY_UROW + ck * 16) = *(const v4u*)(ut + ((size_t)ch * NBATCH + b) * SEQ + ck * 8); }
        for (int i = tid; i < 1024; i += NTHR) { const int c2 = i >> 9, ck = i & 511; *(LAS v4u*)(lds + HY_ROFF + c2 * HY_RSTRIDE + ck * 16) = *(const v4u*)(Rg + ((size_t)ch * 2 + c2) * 4096 + ck * 8); }
        __syncthreads();
        f32x4 acc[16]; bf16x8 W[16];
#pragma unroll
        for (int i = 0; i < 16; ++i) acc[i] = (f32x4){0.f, 0.f, 0.f, 0.f};
#pragma unroll
        for (int j = 1; j < 16; ++j) W[j] = ld_frag4(pA15 + 64 * (15 - j));
        W[0] = W[1];
#pragma unroll 1
        for (int tt = 0; tt < 4; ++tt) {
            const LAS unsigned char* pa = pA15 + 64 * 15 + 1024 * tt; const LAS unsigned char* pb = pB + 1024 * tt;
#pragma unroll
            for (int s = 0; s < 16; ++s) {
                W[(16 - s) & 15] = ld_frag4(pa + 64 * s);
                const bf16x8 Bf = *(const LAS bf16x8*)(pb + 64 * s);
#pragma unroll
                for (int i = 0; i < 16; ++i) acc[i] = __builtin_amdgcn_mfma_f32_16x16x32_bf16(W[(i - s) & 15], Bf, acc[i], 0, 0, 0);
            }
        }
        bf16* xo = x0t + ((size_t)ch * NBATCH + i16) * SEQ + base + 4 * kq;
#pragma unroll
        for (int i = 0; i < 16; ++i) {
            typedef unsigned u32x2v __attribute__((ext_vector_type(2)));
            const u32x2v xv = *(const u32x2v*)(xo + 32 * i);
            u32x2v o; o.x = pk2(__uint_as_float(xv.x << 16) * acc[i][0], __uint_as_float(xv.x & 0xffff0000u) * acc[i][1]);
            o.y = pk2(__uint_as_float(xv.y << 16) * acc[i][2], __uint_as_float(xv.y & 0xffff0000u) * acc[i][3]);
            *(u32x2v*)(xo + 32 * i) = o;
        }
        __syncthreads();
    }
}

__device__ __forceinline__ void phase_transpose_y(const Args& a, LAS unsigned char* lds, int tid, int G) {
    const bf16* yt = (const bf16*)(a.ws + WS_X0T); bf16* yhy = (bf16*)(a.ws + WS_YHY);
    LAS unsigned short* tile = (LAS unsigned short*)lds;
    for (int item = blockIdx.x; item < 4096; item += G) {
        const int cc = item & 7, mc = (item >> 3) & 31, b = item >> 8;
        { const int c2 = tid >> 3, ck = tid & 7;
          const v4u v = *(const v4u*)(yt + ((size_t)(cc * 64 + c2) * NBATCH + b) * SEQ + mc * 64 + ck * 8);
          LAS unsigned* t4 = (LAS unsigned*)(tile + c2 * 72 + ck * 8); t4[0] = v.x; t4[1] = v.y; t4[2] = v.z; t4[3] = v.w; }
        __syncthreads();
        { const int nl = tid >> 3, cg8 = tid & 7; const LAS unsigned short* s = tile + (cg8 * 8) * 72 + nl;
          v4u o; o.x = s[0] | ((unsigned)s[72] << 16); o.y = s[144] | ((unsigned)s[216] << 16); o.z = s[288] | ((unsigned)s[360] << 16); o.w = s[432] | ((unsigned)s[504] << 16);
          *(v4u*)(yhy + (size_t)(b * SEQ + mc * 64 + nl) * 512 + cc * 64 + cg8 * 8) = o; }
        __syncthreads();
    }
}

#define GEMM_CALL(EPI, SCHED, g, S, E) pg8::gemm_phase<EPI, SCHED, true, true>(lds, g, S, E)

typedef const __attribute__((address_space(4))) Args* KArgs;
__device__ __forceinline__ Args load_args() {
#if defined(__HIP_DEVICE_COMPILE__)
    KArgs p = (KArgs)__builtin_amdgcn_kernarg_segment_ptr();
    asm volatile("" : "+s"(p));
    return *p;
#else
    return Args{};
#endif
}
__global__ void __launch_bounds__(NTHR, 2) fwd_megakernel(Args a_unused) {
    extern __shared__ __attribute__((aligned(16))) unsigned char lds_raw[];
    LAS unsigned char* lds = (LAS unsigned char*)lds_raw;
    cg::grid_group grid = cg::this_grid();
    const int tid0 = threadIdx.x, G0 = gridDim.x, bx0 = blockIdx.x;
#define PTRS() const Args a = load_args(); int tid = tid0, G = G0, bx = bx0; asm volatile("" : "+v"(tid), "+s"(G), "+s"(bx)); const int lane = tid & 63, wave = __builtin_amdgcn_readfirstlane(tid >> 6); (void)lane; (void)wave; unsigned char* ws = a.ws; bf16* Wb = (bf16*)(ws + WS_W); const pg8::bf16_t* xb = (const pg8::bf16_t*)(ws + WS_XB); \
    const float* rcos = (const float*)(ws + WS_ROPE); const float* rsin = rcos + 65536; float* ssqA = (float*)(ws + WS_SSQA); float* ssqB = (float*)(ws + WS_SSQB); \
    (void)Wb; (void)xb; (void)rcos; (void)rsin; (void)ssqA; (void)ssqB;
#define GIN() pg8::Gemm gin{xb, (const pg8::bf16_t*)(Wb + W_IN / 2), nullptr, nullptr, MTOK, NIN, DM}; \
    pg8::EpiIn Ein{(pg8::bf16_t*)(ws + WS_HY), (pg8::bf16_t*)(ws + WS_Q), (pg8::bf16_t*)(ws + WS_KV), (pg8::bf16_t*)(ws + WS_GATES), ssqA, rcos, rsin, 0};

#pragma unroll 1
    for (int L = 0; L < 2; ++L) {
        { PTRS(); phase_prep_weights(a, L, lds, tid, lane, wave, G); }
        grid.sync();
        {
            PTRS(); GIN();
            pg8::TwoRect S; S.a.init(128, 12, 0, 0, G, bx); S.b.init(64, 12, 0, 12, G, bx); S.na = S.a.count();
            GEMM_CALL(pg8::EpiIn, pg8::TwoRect, gin, S, Ein);
        }
        grid.sync();
        { PTRS(); phase_attn_naive(a, 0, tid, G); phase_prep_u(a, L, lds, tid, G); }
        grid.sync();
        {
            PTRS(); GIN();
            pg8::RectOrder S; S.init(64, 12, 64, 12, G, bx);
            Ein.kv_row0 = HALF_TOK;
            GEMM_CALL(pg8::EpiIn, pg8::RectOrder, gin, S, Ein);
        }
        { PTRS(); phase_hyena_mfma(a, lds, tid, G); }
        grid.sync();
        { PTRS(); phase_attn_naive(a, 1, tid, G); }
        {
            PTRS(); GIN();
            pg8::RectOrder S; S.init(128, 8, 0, 24, G, bx);
            GEMM_CALL(pg8::EpiIn, pg8::RectOrder, gin, S, Ein);
        }
        grid.sync();
        { PTRS(); phase_combine(a, tid, G); phase_transpose_y(a, lds, tid, G); }
        grid.sync();
        {
            PTRS();
            pg8::Gemm g{(const pg8::bf16_t*)(ws + WS_YHY), (const pg8::bf16_t*)(Wb + W_PHY / 2), (const pg8::bf16_t*)(ws + WS_YATT), (const pg8::bf16_t*)(Wb + W_PATT / 2), MTOK, DM, 512};
            pg8::PairOrder S; S.r.init(128, 4, 0, 0, G, bx);
            pg8::EpiGate E{(const pg8::bf16_t*)(ws + WS_GATES), (pg8::bf16_t*)(ws + WS_MERGED)};
            GEMM_CALL(pg8::EpiGate, pg8::PairOrder, g, S, E);
        }
        grid.sync();
        {
            PTRS();
            pg8::Gemm g{(const pg8::bf16_t*)(ws + WS_MERGED), (const pg8::bf16_t*)(Wb + W_O / 2), nullptr, nullptr, MTOK, DM, DM};
            pg8::RectOrder S; S.init(128, 4, 0, 0, G, bx);
            pg8::EpiRes E{L == 0 ? a.in[0] : a.out, a.out, (pg8::bf16_t*)(ws + WS_XB), ssqB};
            GEMM_CALL(pg8::EpiRes, pg8::RectOrder, g, S, E);
        }
        grid.sync();
        {
            PTRS();
            pg8::Gemm g{xb, (const pg8::bf16_t*)(Wb + W_FF1 / 2), nullptr, nullptr, MTOK, DFF, DM};
            pg8::RectOrder S; S.init(128, 16, 0, 0, G, bx);
            pg8::EpiFF1 E{(pg8::bf16_t*)(ws + WS_H), ssqB};
            GEMM_CALL(pg8::EpiFF1, pg8::RectOrder, g, S, E);
        }
        grid.sync();
        {
            PTRS();
            pg8::Gemm g{(const pg8::bf16_t*)(ws + WS_H), (const pg8::bf16_t*)(Wb + W_FF2 / 2), nullptr, nullptr, MTOK, DM, DFF};
            pg8::RectOrder S; S.init(128, 4, 0, 0, G, bx);
            pg8::EpiRes E{a.out, a.out, (pg8::bf16_t*)(ws + WS_XB), ssqA};
            GEMM_CALL(pg8::EpiRes, pg8::RectOrder, g, S, E);
        }
        grid.sync();
    }
    { PTRS(); phase_final_norm(a, lane, wave, G); }
}

extern "C" void kernel_launch(void* const* d_in, const int* in_sizes, int n_in, void* d_out, int out_size, void* d_ws, size_t ws_size, hipStream_t stream) {
    static int grid = 0;
    if (grid == 0) {
        if (n_in != 19 || in_sizes[0] != MTOK * DM || out_size != MTOK * DM || ws_size < WS_END) {
            fprintf(stderr, "kernel_launch: unexpected shapes / workspace (n_in %d, ws %zu, need %zu); nothing launched\n", n_in, ws_size, (size_t)WS_END); grid = -1; return; }
        int dev = 0, cus = 0, per_cu = 0;
        (void)hipGetDevice(&dev); (void)hipDeviceGetAttribute(&cus, hipDeviceAttributeMultiprocessorCount, dev);
        if (hipFuncSetAttribute((const void*)fwd_megakernel, hipFuncAttributeMaxDynamicSharedMemorySize, LDS_BYTES) != hipSuccess) { fprintf(stderr, "kernel_launch: hipFuncSetAttribute failed\n"); grid = -1; return; }
        if (hipOccupancyMaxActiveBlocksPerMultiprocessor(&per_cu, (const void*)fwd_megakernel, NTHR, LDS_BYTES) != hipSuccess || per_cu < 1) { fprintf(stderr, "kernel_launch: occupancy query gives %d\n", per_cu); per_cu = 1; }
        (void)hipGetLastError();
        grid = cus * 1;
        if (grid % 8 != 0 || grid > 256) grid = (grid > 256) ? 256 : (grid / 8) * 8;
    }
    if (grid < 0) return;
    Args a{};
    for (int i = 0; i < 19; ++i) a.in[i] = (const float*)d_in[i];
    a.out = (float*)d_out; a.ws = (unsigned char*)d_ws;
    void* args[] = {&a};
    hipError_t e = hipLaunchCooperativeKernel((const void*)fwd_megakernel, dim3(grid), dim3(NTHR), args, LDS_BYTES, stream);
    if (e != hipSuccess) fprintf(stderr, "cooperative launch failed: %s (grid %d)\n", hipGetErrorString(e), grid);
}
```

```cpp
#include <hip/hip_runtime.h>
#include <hip/hip_cooperative_groups.h>
#include <cstdio>
#include <cstdint>
namespace cg = cooperative_groups;

namespace pg8 {
#define PG8_LAS __attribute__((address_space(3)))
typedef unsigned short bf16_t;
typedef short bf16x8 __attribute__((ext_vector_type(8)));
typedef float f32x4 __attribute__((ext_vector_type(4)));
typedef unsigned u32x4 __attribute__((ext_vector_type(4)));
constexpr int BM = 256, BK = 64, HALF = 128, HTB = HALF * BK * 2  , STAGE_BYTES = 8 * HTB, NXCD = 8, WGM = 8;

__host__ __device__ __forceinline__ int lds_byte(int r, int c) { const int st = (r >> 4) * 2 + (c >> 5), rr = r & 15, cc = c & 31, ob = rr * 64 + cc * 2; return st * 1024 + (ob ^ (((ob >> 9) & 1) << 5)); }
__host__ __device__ __forceinline__ void stage_rc(int b, int& R, int& C) { const int st = b / 1024, sb = b % 1024, swz = sb ^ (((sb >> 9) & 1) << 5); R = (st >> 1) * 16 + swz / 64; C = (st & 1) * 32 + (swz % 64) / 2; }
__host__ __device__ __forceinline__ int perm32(int rho) { const int n = rho >> 4, i = rho & 15; return 8 * (i >> 2) + 4 * n + (i & 3); }

struct Unit { int pm, pn, z; };
struct Gemm { const bf16_t* A; const bf16_t* Bt; const bf16_t* A1; const bf16_t* Bt1; int M, N, K; };

struct StaticOrder {
    int nM, nN, nwg, G, c;
    __host__ __device__ void init(int M, int N, int G_, int c_) { nM = M / BM; nN = N / BM; nwg = nM * nN; G = G_; c = c_; }
    __host__ __device__ bool next(int i, Unit& u) const {
        const long L = (long)i * G + c; if (L >= nwg) return false;
        int wgid = (int)L; { const int q = nwg / NXCD, r = nwg % NXCD, xcd = wgid % NXCD, off = wgid / NXCD; wgid = (xcd < r ? xcd * (q + 1) : r * (q + 1) + (xcd - r) * q) + off; }
        const int nig = WGM * nN, gid = wgid / nig, fm = gid * WGM, gsz = (nM - fm) < WGM ? (nM - fm) : WGM;
        u.pm = fm + ((wgid % nig) % gsz); u.pn = (wgid % nig) / gsz; return true;
    }
    __device__ __forceinline__ void a_ready(const Unit&) const {}
    __device__ __forceinline__ void done(const Unit&) const {}
};


__device__ __forceinline__ unsigned cvt_pk_bf16(float lo, float hi) { unsigned r; asm volatile("v_cvt_pk_bf16_f32 %0, %1, %2" : "=v"(r) : "v"(lo), "v"(hi)); return r; }
__device__ __forceinline__ float bf_lo(unsigned w) { return __uint_as_float(w << 16); }
__device__ __forceinline__ float bf_hi(unsigned w) { return __uint_as_float(w & 0xffff0000u); }

struct RectOrder {
    int nN, nwg, G, c, pm0, pn0;
    __device__ __forceinline__ void init(int nM_, int nN_, int pm0_, int pn0_, int G_, int c_) { nN = nN_; nwg = nM_ * nN_; G = G_; c = c_; pm0 = pm0_; pn0 = pn0_; }
    __device__ __forceinline__ int count() const { return nwg > c ? (nwg - c + G - 1) / G : 0; }
    __device__ __forceinline__ bool next(int i, Unit& u) const {
        const long L = (long)i * G + c; if (L >= nwg) return false;
        const int w = (int)L, nig = 8 * nN, gid = w / nig, r = w % nig;
        u.pm = pm0 + gid * 8 + (r & 7); u.pn = pn0 + (r >> 3); u.z = 0; return true;
    }
    __device__ __forceinline__ void a_ready(const Unit&) const {}
    __device__ __forceinline__ void done(const Unit&) const {}
};
struct TwoRect {
    RectOrder a, b; int na;
    __device__ __forceinline__ bool next(int i, Unit& u) const { return i < na ? a.next(i, u) : b.next(i - na, u); }
    __device__ __forceinline__ void a_ready(const Unit&) const {}
    __device__ __forceinline__ void done(const Unit&) const {}
};
struct PairOrder {
    RectOrder r;
    __device__ __forceinline__ bool next(int i, Unit& u) const { const bool ok = r.next(i >> 1, u); u.z = i & 1; return ok; }
    __device__ __forceinline__ void a_ready(const Unit&) const {}
    __device__ __forceinline__ void done(const Unit&) const {}
};

constexpr float RMS_EPS = 1e-6f;
constexpr float QSCALE = 0.125f * 1.44269504088896341f;

__device__ __forceinline__ float row_rstd(const float* ssq, int row) {
    const f32x4* p = (const f32x4*)(ssq + (size_t)row * 16);
    const f32x4 a = p[0], b = p[1], c = p[2], d = p[3];
    const float s = ((a[0] + a[1]) + (a[2] + a[3])) + ((b[0] + b[1]) + (b[2] + b[3])) + ((c[0] + c[1]) + (c[2] + c[3])) + ((d[0] + d[1]) + (d[2] + d[3]));
    return 1.0f / sqrtf(s * (1.0f / 1024.0f) + RMS_EPS);
}

struct EpiIn {
    static constexpr bool PERM = true, AFTER_DRAIN = false;
    bf16_t* hy; bf16_t* q; bf16_t* kv; bf16_t* gates; const float* ssq; const float* rcos; const float* rsin; int kv_row0;
    __device__ __forceinline__ bool operator()(f32x4 (&acc)[2][2][4][2], const Unit& u, int wr, int wc, int fr, int fq) const {
        const int pn = u.pn; int type, ldc, colt, rowoff = 0; bf16_t* base;
        if (pn < 6) { type = 0; base = hy; ldc = 1536; colt = pn * 256; }
        else if (pn < 12) { type = 1; base = q; ldc = 1536; colt = (pn - 6) * 256; }
        else if (pn < 24) { const int idx = pn - 12; type = ((idx >> 1) & 1) ? 0 : 2; base = kv; ldc = 3072; colt = idx * 256; rowoff = kv_row0; }
        else { type = 3; base = gates; ldc = 2048; colt = (pn - 24) * 256; }
#pragma unroll
        for (int ai = 0; ai < 2; ++ai)
#pragma unroll
            for (int m = 0; m < 4; ++m) {
                const int row = u.pm * BM + ai * HALF + wr * 64 + m * 16 + fr;
                const float rs = row_rstd(ssq, row);
                bf16_t* rowp = base + (size_t)(row - rowoff) * ldc + colt;
                f32x4 v00 = acc[ai][0][m][0] * rs, v01 = acc[ai][0][m][1] * rs, v10 = acc[ai][1][m][0] * rs, v11 = acc[ai][1][m][1] * rs;
                if (type == 1 || type == 2) {
                    const int pos = row & 2047;
                    const f32x4 c0 = *(const f32x4*)(rcos + pos * 32 + 8 * fq), c1 = *(const f32x4*)(rcos + pos * 32 + 8 * fq + 4);
                    const f32x4 s0 = *(const f32x4*)(rsin + pos * 32 + 8 * fq), s1 = *(const f32x4*)(rsin + pos * 32 + 8 * fq + 4);
                    const float sc = (type == 1) ? QSCALE : 1.0f;
                    const f32x4 o00 = (v00 * c0 - v10 * s0) * sc, o01 = (v01 * c1 - v11 * s1) * sc;
                    const f32x4 o10 = (v10 * c0 + v00 * s0) * sc, o11 = (v11 * c1 + v01 * s1) * sc;
                    u32x4 w0, w1;
                    w0.x = cvt_pk_bf16(o00[0], o00[1]); w0.y = cvt_pk_bf16(o00[2], o00[3]); w0.z = cvt_pk_bf16(o01[0], o01[1]); w0.w = cvt_pk_bf16(o01[2], o01[3]);
                    w1.x = cvt_pk_bf16(o10[0], o10[1]); w1.y = cvt_pk_bf16(o10[2], o10[3]); w1.z = cvt_pk_bf16(o11[0], o11[1]); w1.w = cvt_pk_bf16(o11[2], o11[3]);
                    *(u32x4*)(rowp + wc * 64 + 8 * fq) = w0;
                    *(u32x4*)(rowp + wc * 64 + 8 * fq + 32) = w1;
                } else {
                    if (type == 3) {
#pragma unroll
                        for (int e = 0; e < 4; ++e) {
                            v00[e] = 1.0f / (1.0f + __expf(-v00[e])); v01[e] = 1.0f / (1.0f + __expf(-v01[e]));
                            v10[e] = 1.0f / (1.0f + __expf(-v10[e])); v11[e] = 1.0f / (1.0f + __expf(-v11[e]));
                        }
                    }
                    u32x4 w0, w1;
                    w0.x = cvt_pk_bf16(v00[0], v00[1]); w0.y = cvt_pk_bf16(v00[2], v00[3]); w0.z = cvt_pk_bf16(v01[0], v01[1]); w0.w = cvt_pk_bf16(v01[2], v01[3]);
                    w1.x = cvt_pk_bf16(v10[0], v10[1]); w1.y = cvt_pk_bf16(v10[2], v10[3]); w1.z = cvt_pk_bf16(v11[0], v11[1]); w1.w = cvt_pk_bf16(v11[2], v11[3]);
                    *(u32x4*)(rowp + wc * 32 + 8 * fq) = w0;
                    *(u32x4*)(rowp + wc * 32 + 8 * fq + HALF) = w1;
                }
            }
        return false;
    }
};

struct EpiGate {
    static constexpr bool PERM = true, AFTER_DRAIN = false;
    const bf16_t* gates; bf16_t* merged;
    __device__ __forceinline__ bool operator()(f32x4 (&acc)[2][2][4][2], const Unit& u, int wr, int wc, int fr, int fq) const {
#pragma unroll
        for (int ai = 0; ai < 2; ++ai)
#pragma unroll
            for (int m = 0; m < 4; ++m) {
                const int row = u.pm * BM + ai * HALF + wr * 64 + m * 16 + fr;
                const int col0 = u.pn * BM + wc * 32 + 8 * fq;
#pragma unroll
                for (int bj = 0; bj < 2; ++bj) {
                    const u32x4 ga = *(const u32x4*)(gates + (size_t)row * 2048 + 1024 + col0 + bj * HALF);
                    f32x4 a0 = (f32x4){bf_lo(ga.x), bf_hi(ga.x), bf_lo(ga.y), bf_hi(ga.y)}, a1 = (f32x4){bf_lo(ga.z), bf_hi(ga.z), bf_lo(ga.w), bf_hi(ga.w)};
                    if (u.z == 0) {
                        const u32x4 gh = *(const u32x4*)(gates + (size_t)row * 2048 + col0 + bj * HALF);
                        const f32x4 h0 = (f32x4){bf_lo(gh.x), bf_hi(gh.x), bf_lo(gh.y), bf_hi(gh.y)}, h1 = (f32x4){bf_lo(gh.z), bf_hi(gh.z), bf_lo(gh.w), bf_hi(gh.w)};
#pragma unroll
                        for (int e = 0; e < 4; ++e) { a0[e] = fmaxf(a0[e], 1e-30f); a1[e] = fmaxf(a1[e], 1e-30f); }
                        acc[ai][bj][m][0] = acc[ai][bj][m][0] * (h0 / a0);
                        acc[ai][bj][m][1] = acc[ai][bj][m][1] * (h1 / a1);
                    } else {
                        const f32x4 v0 = acc[ai][bj][m][0] * a0, v1 = acc[ai][bj][m][1] * a1;
                        u32x4 w; w.x = cvt_pk_bf16(v0[0], v0[1]); w.y = cvt_pk_bf16(v0[2], v0[3]); w.z = cvt_pk_bf16(v1[0], v1[1]); w.w = cvt_pk_bf16(v1[2], v1[3]);
                        *(u32x4*)(merged + (size_t)row * 1024 + col0 + bj * HALF) = w;
                    }
                }
            }
        return u.z == 0;
    }
};

struct EpiRes {
    static constexpr bool PERM = false, AFTER_DRAIN = false;
    const float* base; float* out; bf16_t* xb; float* ssq;
    __device__ __forceinline__ bool operator()(f32x4 (&acc)[2][2][4][2], const Unit& u, int wr, int wc, int fr, int fq) const {
        typedef unsigned u32x2v __attribute__((ext_vector_type(2)));
        int rl = wr * 64 + fr, cl = wc * 32 + 4 * fq;
        asm volatile("" : "+v"(rl), "+v"(cl));
#pragma unroll
        for (int ai = 0; ai < 2; ++ai)
#pragma unroll
            for (int m = 0; m < 4; ++m) {
                const int row = u.pm * BM + ai * HALF + m * 16 + rl;
                const size_t off = (size_t)row * 1024 + u.pn * BM + cl;
                float s = 0.f;
#pragma unroll
                for (int bj = 0; bj < 2; ++bj)
#pragma unroll
                    for (int n = 0; n < 2; ++n) {
                        const f32x4 o = *(const f32x4*)(base + off + bj * HALF + n * 16) + acc[ai][bj][m][n];
                        *(f32x4*)(out + off + bj * HALF + n * 16) = o;
                        u32x2v w; w.x = cvt_pk_bf16(o[0], o[1]); w.y = cvt_pk_bf16(o[2], o[3]);
                        *(u32x2v*)(xb + off + bj * HALF + n * 16) = w;
                        s += (o[0] * o[0] + o[1] * o[1]) + (o[2] * o[2] + o[3] * o[3]);
                    }
                s += __shfl_xor(s, 16); s += __shfl_xor(s, 32);
                if (fq == 0) ssq[(size_t)row * 16 + u.pn * 4 + wc] = s;
                asm volatile("" ::: "memory");
            }
        return false;
    }
};

struct EpiFF1 {
    static constexpr bool PERM = true, AFTER_DRAIN = false;
    bf16_t* h; const float* ssq;
    __device__ __forceinline__ bool operator()(f32x4 (&acc)[2][2][4][2], const Unit& u, int wr, int wc, int fr, int fq) const {
#pragma unroll
        for (int ai = 0; ai < 2; ++ai)
#pragma unroll
            for (int m = 0; m < 4; ++m) {
                const int row = u.pm * BM + ai * HALF + wr * 64 + m * 16 + fr;
                const float rs = row_rstd(ssq, row);
                bf16_t* rowp = h + (size_t)row * 4096 + u.pn * BM + wc * 32 + 8 * fq;
#pragma unroll
                for (int bj = 0; bj < 2; ++bj) {
                    f32x4 v0 = acc[ai][bj][m][0] * rs, v1 = acc[ai][bj][m][1] * rs;
#pragma unroll
                    for (int e = 0; e < 4; ++e) { v0[e] = fmaxf(v0[e], 0.f); v1[e] = fmaxf(v1[e], 0.f); }
                    v0 = v0 * v0; v1 = v1 * v1;
                    u32x4 w; w.x = cvt_pk_bf16(v0[0], v0[1]); w.y = cvt_pk_bf16(v0[2], v0[3]); w.z = cvt_pk_bf16(v1[0], v1[1]); w.w = cvt_pk_bf16(v1[2], v1[3]);
                    *(u32x4*)(rowp + bj * HALF) = w;
                }
            }
        return false;
    }
};

template <class Epi, class Sched, bool ALIGN_EPI = false, bool SP2 = false>
__device__ __forceinline__ void gemm_phase(PG8_LAS unsigned char* lds, const Gemm g, const Sched& S, const Epi& E) {
    int tid_ = threadIdx.x; asm volatile("" : "+v"(tid_));
    const int tid = tid_, wid = __builtin_amdgcn_readfirstlane(tid >> 6), lane = tid & 63, wr = wid >> 2, wc = wid & 3, fr = lane & 15, fq = lane >> 4;
    const int K = g.K, nt = K / BK;
    unsigned voffA[2], voffB[2];
#pragma unroll
    for (int i = 0; i < 2; ++i) { int R, C; stage_rc(tid * 16 + i * 8192, R, C); const int Rb = Epi::PERM ? ((R & ~31) + perm32(R & 31)) : R;
        voffA[i] = (unsigned)(R * K + C) * 2u; voffB[i] = (unsigned)(Rb * K + C) * 2u; }
    const size_t kstep = (size_t)(BK * 2);
    const size_t hstep = (size_t)HALF * K * 2;
    const size_t tstep = 2 * hstep;
    const unsigned ldsw = (unsigned)wid * 1024u;
    const int aoff = lds_byte(wr * 64 + fr, fq * 8), boff = lds_byte(wc * 32 + fr, fq * 8);
#define PG8_SA(b, h) (((b) * 2 + (h)) * HTB)
#define PG8_SB(b, h) ((4 + (b) * 2 + (h)) * HTB)
#define PG8_STAGE(bufoff, gbase, voff) do { _Pragma("unroll") for (int _i = 0; _i < 2; ++_i) \
        __builtin_amdgcn_global_load_lds((const unsigned*)((const char*)(gbase) + (voff)[_i]), (PG8_LAS unsigned*)(lds + (bufoff) + ldsw + _i * 8192), 16, 0, 0); } while (0)
#define PG8_LDA(dst, b, h) do { _Pragma("unroll") for (int m = 0; m < 4; ++m) _Pragma("unroll") for (int k = 0; k < 2; ++k) dst[m][k] = *(const PG8_LAS bf16x8*)(lds + PG8_SA(b, h) + aoff + m * 2048 + k * 1024); } while (0)
#define PG8_LDB(dst, b, h) do { _Pragma("unroll") for (int n = 0; n < 2; ++n) _Pragma("unroll") for (int k = 0; k < 2; ++k) dst[n][k] = *(const PG8_LAS bf16x8*)(lds + PG8_SB(b, h) + boff + n * 2048 + k * 1024); } while (0)
#define PG8_MMA(ai, bj, At, Bt) do { __builtin_amdgcn_s_setprio(1); _Pragma("unroll") for (int m = 0; m < 4; ++m) _Pragma("unroll") for (int n = 0; n < 2; ++n) _Pragma("unroll") for (int k = 0; k < 2; ++k) \
        acc[ai][bj][m][n] = __builtin_amdgcn_mfma_f32_16x16x32_bf16(Bt[n][k], At[m][k], acc[ai][bj][m][n], 0, 0, 0); __builtin_amdgcn_s_setprio(0); } while (0)
#define PG8_WAIT_V(n) asm volatile("s_waitcnt vmcnt(" #n ")" ::: "memory")
#define PG8_WAIT_L(n) asm volatile("s_waitcnt lgkmcnt(" #n ")" ::: "memory")
#define PG8_BAR __builtin_amdgcn_s_barrier()
#define PG8_SCHED __builtin_amdgcn_sched_barrier(0)
    Unit cur, nxt; int ui = 0;
    if (!S.next(0, cur)) return;
    f32x4 acc[2][2][4][2];
#pragma unroll
    for (int a = 0; a < 2; ++a)
#pragma unroll
        for (int b = 0; b < 2; ++b)
#pragma unroll
            for (int m = 0; m < 4; ++m)
#pragma unroll
                for (int n = 0; n < 2; ++n) acc[a][b][m][n] = (f32x4){0.f, 0.f, 0.f, 0.f};
    bf16x8 At[4][2], B0[2][2], B1[2][2];
    const char* cA = (const char*)(cur.z ? g.A1 : g.A) + (size_t)cur.pm * tstep; const char* cB = (const char*)(cur.z ? g.Bt1 : g.Bt) + (size_t)cur.pn * tstep;
    S.a_ready(cur);
    if constexpr (SP2) {
        PG8_STAGE(PG8_SB(0, 0), cB, voffB); PG8_STAGE(PG8_SB(0, 1), cB + hstep, voffB); PG8_STAGE(PG8_SA(0, 0), cA, voffA); PG8_STAGE(PG8_SA(0, 1), cA + hstep, voffA);
        if (wr == 1) PG8_BAR;
        PG8_WAIT_V(2); PG8_BAR;
        PG8_STAGE(PG8_SB(1, 0), cB + kstep, voffB); PG8_STAGE(PG8_SA(1, 0), cA + kstep, voffA); PG8_STAGE(PG8_SB(1, 1), cB + hstep + kstep, voffB);
        PG8_WAIT_V(6); PG8_BAR;
    } else {
        PG8_STAGE(PG8_SB(0, 0), cB, voffB); PG8_STAGE(PG8_SA(0, 0), cA, voffA); PG8_STAGE(PG8_SB(0, 1), cB + hstep, voffB); PG8_STAGE(PG8_SA(0, 1), cA + hstep, voffA);
        if (wr == 1) PG8_BAR;
        PG8_WAIT_V(4); PG8_BAR;
        PG8_STAGE(PG8_SB(1, 0), cB + kstep, voffB); PG8_STAGE(PG8_SA(1, 0), cA + kstep, voffA); PG8_STAGE(PG8_SB(1, 1), cB + hstep + kstep, voffB);
        PG8_WAIT_V(6); PG8_BAR;
    }
    for (;;) {
        const bool has_next = S.next(ui + 1, nxt);
        const char* nA = has_next ? (const char*)(nxt.z ? g.A1 : g.A) + (size_t)nxt.pm * tstep : cA; const char* nB = has_next ? (const char*)(nxt.z ? g.Bt1 : g.Bt) + (size_t)nxt.pn * tstep : cB;
        for (int t = 0; t < nt; t += 2) {
            const bool last = (t == nt - 2);
            const char* a1 = cA + (size_t)(t + 1) * kstep;
            const char* a2 = last ? nA : cA + (size_t)(t + 2) * kstep; const char* b2 = last ? nB : cB + (size_t)(t + 2) * kstep;
            const char* a3 = a2 + kstep; const char* b3 = b2 + kstep;
            if (last && has_next) S.a_ready(nxt);
            if constexpr (SP2) {
            PG8_LDB(B0, 0, 0); PG8_LDB(B1, 0, 1); PG8_SCHED; PG8_LDA(At, 0, 0); PG8_STAGE(PG8_SA(1, 1), a1 + hstep, voffA);
            PG8_WAIT_V(8); PG8_WAIT_L(0); PG8_BAR; PG8_MMA(0, 0, At, B0); PG8_MMA(0, 1, At, B1); PG8_BAR; PG8_SCHED;
            PG8_LDA(At, 0, 1); PG8_STAGE(PG8_SB(0, 0), b2, voffB); PG8_STAGE(PG8_SB(0, 1), b2 + hstep, voffB); PG8_STAGE(PG8_SA(0, 0), a2, voffA);
            PG8_WAIT_V(8); PG8_WAIT_L(0); PG8_BAR; PG8_MMA(1, 0, At, B0); PG8_MMA(1, 1, At, B1); PG8_BAR; PG8_SCHED;
            PG8_LDB(B0, 1, 0); PG8_LDB(B1, 1, 1); PG8_SCHED; PG8_LDA(At, 1, 0); PG8_STAGE(PG8_SA(0, 1), a2 + hstep, voffA);
            PG8_WAIT_V(8); PG8_WAIT_L(0); PG8_BAR; PG8_MMA(0, 0, At, B0); PG8_MMA(0, 1, At, B1); PG8_BAR; PG8_SCHED;
            PG8_LDA(At, 1, 1); PG8_STAGE(PG8_SB(1, 0), b3, voffB); PG8_STAGE(PG8_SB(1, 1), b3 + hstep, voffB); PG8_STAGE(PG8_SA(1, 0), a3, voffA);
            PG8_WAIT_V(8); PG8_WAIT_L(0); PG8_BAR; PG8_MMA(1, 0, At, B0); PG8_MMA(1, 1, At, B1); PG8_BAR; PG8_SCHED;
            } else {
            PG8_LDB(B0, 0, 0); PG8_SCHED; PG8_LDA(At, 0, 0); PG8_STAGE(PG8_SA(1, 1), a1 + hstep, voffA);
            PG8_WAIT_L(8); PG8_BAR; PG8_WAIT_L(0); PG8_MMA(0, 0, At, B0); PG8_BAR; PG8_SCHED;
            PG8_LDB(B1, 0, 1); PG8_STAGE(PG8_SB(0, 0), b2, voffB);
            PG8_BAR; PG8_WAIT_L(0); PG8_MMA(0, 1, At, B1); PG8_BAR;
            PG8_LDA(At, 0, 1); PG8_STAGE(PG8_SA(0, 0), a2, voffA);
            PG8_BAR; PG8_WAIT_L(0); PG8_MMA(1, 0, At, B0); PG8_BAR; PG8_SCHED;
            PG8_STAGE(PG8_SB(0, 1), b2 + hstep, voffB);
            PG8_WAIT_V(6); PG8_BAR; PG8_MMA(1, 1, At, B1); PG8_BAR;
            PG8_LDB(B0, 1, 0); PG8_SCHED; PG8_LDA(At, 1, 0); PG8_STAGE(PG8_SA(0, 1), a2 + hstep, voffA);
            PG8_WAIT_L(8); PG8_BAR; PG8_WAIT_L(0); PG8_MMA(0, 0, At, B0); PG8_BAR; PG8_SCHED;
            PG8_LDB(B1, 1, 1); PG8_STAGE(PG8_SB(1, 0), b3, voffB);
            PG8_BAR; PG8_WAIT_L(0); PG8_MMA(0, 1, At, B1); PG8_BAR;
            PG8_LDA(At, 1, 1); PG8_STAGE(PG8_SA(1, 0), a3, voffA);
            PG8_BAR; PG8_WAIT_L(0); PG8_MMA(1, 0, At, B0); PG8_BAR; PG8_SCHED;
            PG8_STAGE(PG8_SB(1, 1), b3 + hstep, voffB);
            PG8_WAIT_V(6); PG8_BAR; PG8_MMA(1, 1, At, B1); PG8_BAR;
            }
        }
        if constexpr (ALIGN_EPI) { if (wr == 0) PG8_BAR; }
        bool keep_acc = false; if constexpr (!Epi::AFTER_DRAIN) { keep_acc = E(acc, cur, wr, wc, fr, fq); S.done(cur); }
        if (!has_next) break;
        if (!keep_acc) {
#pragma unroll
        for (int a = 0; a < 2; ++a)
#pragma unroll
            for (int b = 0; b < 2; ++b)
#pragma unroll
                for (int m = 0; m < 4; ++m)
#pragma unroll
                    for (int n = 0; n < 2; ++n) acc[a][b][m][n] = (f32x4){0.f, 0.f, 0.f, 0.f};
        }
        cur = nxt; cA = nA; cB = nB; ++ui;
        if constexpr (ALIGN_EPI) { if (wr == 1) PG8_BAR; }
    }
    PG8_WAIT_V(0);
    if constexpr (!ALIGN_EPI) { if (wr == 0) PG8_BAR; }
    PG8_BAR;
    if constexpr (Epi::AFTER_DRAIN) { E.fused(acc, cur, wr, wc, fr, fq, lds, wid, lane); S.done(cur); }
#undef PG8_SA
#undef PG8_SB
#undef PG8_STAGE
#undef PG8_LDA
#undef PG8_LDB
#undef PG8_MMA
#undef PG8_WAIT_V
#undef PG8_WAIT_L
#undef PG8_BAR
#undef PG8_SCHED
}
}

#define LAS __attribute__((address_space(3)))
typedef unsigned short bf16;
typedef float f32x4 __attribute__((ext_vector_type(4)));
typedef unsigned v4u __attribute__((ext_vector_type(4)));
constexpr int NWAVES = 8, NTHR = 512;
constexpr int MTOK = 32768, DM = 1024, SEQ = 2048, NBATCH = 16, NIN = 8192, DFF = 4096, HYW = 512, HALF_TOK = 16384;
constexpr size_t MiB = (size_t)1 << 20;
constexpr size_t WS_SSQA = 0, WS_SSQB = 2 * MiB, WS_ROPE = 4 * MiB, WS_LSE = 5 * MiB, WS_GF = 8 * MiB, WS_W = 16 * MiB, WS_XB = 52 * MiB,
                 WS_HY = 116 * MiB, WS_UT = 212 * MiB, WS_GATES = 116 * MiB, WS_Q = 244 * MiB, WS_KV = 340 * MiB, WS_YHY = 436 * MiB, WS_YATT = 404 * MiB, WS_X0T = 468 * MiB,
                 WS_MERGED = 340 * MiB, WS_H = 116 * MiB, WS_END = 500 * MiB;
constexpr size_t W_IN = 0, W_PHY = 16 * MiB, W_PATT = 17 * MiB, W_O = 18 * MiB, W_FF1 = 20 * MiB, W_FF2 = 28 * MiB;
constexpr int LDS_BYTES = 139264;

struct Args {
    const float* in[19]; float* out; unsigned char* ws; int pad0, pad1;
};

__device__ __forceinline__ unsigned f2bf(float f) { unsigned u = __float_as_uint(f); return (u + 0x7fffu + ((u >> 16) & 1u)) >> 16; }
__device__ __forceinline__ unsigned pk2(float lo, float hi) { return f2bf(lo) | (f2bf(hi) << 16); }
__device__ __forceinline__ float bf2f(unsigned short b) { return __uint_as_float((unsigned)b << 16); }
__device__ __forceinline__ float wave_sum(float v) {
#pragma unroll
    for (int o = 1; o < 64; o <<= 1) v += __shfl_xor(v, o);
    return v;
}

__device__ __forceinline__ int win_src_col(int n) {
    const int t = n >> 8, j = n & 255;
    if (t < 6) return n;
    if (t >= 24) return 6144 + (n - 6144);
    int g, w, half;
    if (t < 12) { const int i = t - 6; g = i >> 1; w = 0; half = i & 1; }
    else { const int i = t - 12; g = i >> 2; w = 1 + ((i >> 1) & 1); half = i & 1; }
    int hh, d;
    if (w == 2) { hh = j >> 6; d = j & 63; }
    else { hh = (j & 127) >> 5; d = (j & 31) + ((j >> 7) << 5); }
    return 1536 + g * 1536 + w * 512 + (half * 4 + hh) * 64 + d;
}

__device__ __forceinline__ void transpose_item(const float* W, int K, int Nsrc, int s0, bf16* WT, int n0, int k0, const float* gain, LAS float* scr, int lane) {
#pragma unroll 8
    for (int i = 0; i < 32; ++i) { const int kk = 2 * i + (lane >> 5); float v = W[(size_t)(k0 + kk) * Nsrc + s0 + (lane & 31)]; if (gain) v *= gain[k0 + kk]; scr[kk * 33 + (lane & 31)] = v; }
    asm volatile("s_waitcnt lgkmcnt(0)" ::: "memory");
    const int c = lane & 7;
#pragma unroll
    for (int j = 0; j < 4; ++j) { const int n = (lane >> 3) + 8 * j; const LAS float* s = scr + (8 * c) * 33 + n;
        v4u o; o.x = pk2(s[0 * 33], s[1 * 33]); o.y = pk2(s[2 * 33], s[3 * 33]); o.z = pk2(s[4 * 33], s[5 * 33]); o.w = pk2(s[6 * 33], s[7 * 33]);
        *(v4u*)(WT + (size_t)(n0 + n) * K + k0 + 8 * c) = o; }
    asm volatile("s_waitcnt lgkmcnt(0)" ::: "memory");
}

__device__ __forceinline__ void phase_prep_weights(const Args& a, int L, LAS unsigned char* lds, int tid, int lane, int wave, int G) {
    unsigned char* ws = a.ws;
    {
        LAS float* z = (LAS float*)lds; LAS float* h0 = z + 64; LAS float* h1 = z + 128;
        const float* w1 = a.in[5] + (size_t)L * 33 * 64; const float* b1 = a.in[6] + L * 64;
        const float* wi = a.in[7] + (size_t)L * 2 * 64 * 64; const float* bi = a.in[8] + L * 2 * 64;
        const float* wout = a.in[9] + (size_t)L * 64 * 1024; const float* fr = a.in[10] + L * 64; const float* skip = a.in[11] + L * 512;
        bf16* Rg = (bf16*)(ws + WS_GF);
        const float min_decay = logf(1e-2f) / 1.5f, max_decay = logf(1e-2f) / 0.3f;
        for (int n = blockIdx.x; n < SEQ; n += G) {
            const float t = (float)n / 2047.0f;
            if (tid < 33) {
                float v;
                if (tid == 0) v = t;
                else { const int k = (tid - 1) & 15; const float band = 1e-4f + (float)k * ((15.0f - 1e-4f) / 15.0f); const float ang = ((float)(2.0 * 3.14159265358979323846 / 2048.0) * (float)n) * band;
                       v = (tid <= 16) ? cosf(ang) : -sinf(ang); }
                z[tid] = v;
            }
            __syncthreads();
            if (tid < 64) { float s = 0.f;
_Pragma("unroll 3")
 for (int e = 0; e < 33; ++e) s += z[e] * w1[e * 64 + tid]; h0[tid] = sinf(fr[tid] * (s + b1[tid])); }
            __syncthreads();
            if (tid < 64) { float s = 0.f;
_Pragma("unroll 4")
 for (int e = 0; e < 64; ++e) s += h0[e] * wi[e * 64 + tid]; h1[tid] = sinf(fr[tid] * (s + bi[tid])); }
            __syncthreads();
            if (tid < 64) { float s = 0.f;
_Pragma("unroll 4")
 for (int e = 0; e < 64; ++e) s += h1[e] * wi[4096 + e * 64 + tid]; h0[tid] = sinf(fr[tid] * (s + bi[64 + tid])); }
            __syncthreads();
            for (int col = tid; col < 1024; col += NTHR) {
                float s = 0.f;
_Pragma("unroll 4")
 for (int e = 0; e < 64; ++e) s += h0[e] * wout[e * 1024 + col];
                const int c = col & 511, dir = col >> 9;
                const float delta = fabsf(min_decay + (float)c * ((max_decay - min_decay) / 511.0f));
                float val = s * expf(-t * delta);
                int x = -1;
                if (dir == 0) { if (n == 0) val += skip[c]; x = 2048 - n; } else if (n > 0) x = 2048 + n;
                if (x >= 0) { const bf16 hv = (bf16)f2bf(val); Rg[((size_t)c * 2 + 0) * 4096 + x] = hv; Rg[((size_t)c * 2 + 1) * 4096 + x - 1] = hv; }
            }
            __syncthreads();
        }
    }
    {
        LAS float* scr = (LAS float*)(lds + 1024 + wave * 8704);
        const int gw = blockIdx.x * NWAVES + wave, NGW = G * NWAVES;
        bf16* Wb = (bf16*)(ws + WS_W);
        const float* w_in = a.in[2] + (size_t)L * DM * NIN; const float* p_hy = a.in[12] + (size_t)L * 512 * DM; const float* p_att = a.in[13] + (size_t)L * 512 * DM;
        const float* w_o = a.in[14] + (size_t)L * DM * DM; const float* w1 = a.in[16] + (size_t)L * DM * DFF; const float* w2 = a.in[17] + (size_t)L * DFF * DM;
        const float* g_mix = a.in[1] + L * DM; const float* g_ffn = a.in[15] + L * DM;
        constexpr int I_IN = 16 * 256, I_P = 8 * 32, I_O = 16 * 32, I_1 = 16 * 128, I_2 = 64 * 32;
        constexpr int NITEMS = I_IN + 2 * I_P + I_O + I_1 + I_2;
        for (int it = gw; it < NITEMS; it += NGW) {
            int r = it;
            if (r < I_IN) { const int kb = r / 256, nb = r % 256; transpose_item(w_in, DM, NIN, win_src_col(nb * 32), Wb + W_IN / 2, nb * 32, kb * 64, g_mix, scr, lane); continue; } r -= I_IN;
            if (r < I_P) { const int kb = r / 32, nb = r % 32; transpose_item(p_hy, 512, DM, nb * 32, Wb + W_PHY / 2, nb * 32, kb * 64, nullptr, scr, lane); continue; } r -= I_P;
            if (r < I_P) { const int kb = r / 32, nb = r % 32; transpose_item(p_att, 512, DM, nb * 32, Wb + W_PATT / 2, nb * 32, kb * 64, nullptr, scr, lane); continue; } r -= I_P;
            if (r < I_O) { const int kb = r / 32, nb = r % 32; transpose_item(w_o, DM, DM, nb * 32, Wb + W_O / 2, nb * 32, kb * 64, nullptr, scr, lane); continue; } r -= I_O;
            if (r < I_1) { const int kb = r / 128, nb = r % 128; transpose_item(w1, DM, DFF, nb * 32, Wb + W_FF1 / 2, nb * 32, kb * 64, g_ffn, scr, lane); continue; } r -= I_1;
            { const int kb = r / 32, nb = r % 32; transpose_item(w2, DFF, DM, nb * 32, Wb + W_FF2 / 2, nb * 32, kb * 64, nullptr, scr, lane); }
        }
        if (L == 0) {
            const float* x = a.in[0]; bf16* xb = (bf16*)(ws + WS_XB); float* ssq = (float*)(ws + WS_SSQA);
            for (int m = gw; m < MTOK; m += NGW) {
                const f32x4* xr = (const f32x4*)(x + (size_t)m * DM) + lane;
                f32x4 v[4]; float s = 0.f;
#pragma unroll
                for (int j = 0; j < 4; ++j) { v[j] = xr[64 * j]; s += (v[j][0] * v[j][0] + v[j][1] * v[j][1]) + (v[j][2] * v[j][2] + v[j][3] * v[j][3]); }
                s = wave_sum(s);
                unsigned long long* o8 = (unsigned long long*)(xb + (size_t)m * DM) + lane;
#pragma unroll
                for (int j = 0; j < 4; ++j) o8[64 * j] = (unsigned long long)pk2(v[j][0], v[j][1]) | ((unsigned long long)pk2(v[j][2], v[j][3]) << 32);
                if (lane < 16) ssq[(size_t)m * 16 + lane] = (lane == 0) ? s : 0.f;
            }
            float* rc = (float*)(ws + WS_ROPE); float* rsn = rc + 65536;
            for (int i = blockIdx.x * NTHR + tid; i < 65536; i += G * NTHR) {
                const int pos = i >> 5, f = i & 31;
                const float inv = powf(10000.0f, -(float)f / 32.0f);
                const float ang = (float)pos * inv;
                rc[i] = cosf(ang); rsn[i] = sinf(ang);
            }
        }
    }
}

__device__ __forceinline__ void phase_prep_u(const Args& a, int L, LAS unsigned char* lds, int tid, int G) {
    const bf16* hy = (const bf16*)(a.ws + WS_HY); bf16* ut = (bf16*)(a.ws + WS_UT); bf16* x0t = (bf16*)(a.ws + WS_X0T);
    const float* cw = a.in[3] + (size_t)L * 3 * 1536; const float* cb = a.in[4] + L * 1536;
    LAS unsigned short* tile = (LAS unsigned short*)lds;
    for (int item = blockIdx.x; item < 4096; item += G) {
        const int cc = item & 7, mc = (item >> 3) & 31, b = item >> 8;
        const int cl = tid & 63, mr = tid >> 6, c = cc * 64 + cl;
        const float w10 = cw[512 + c], w11 = cw[1536 + 512 + c], w12 = cw[3072 + 512 + c], b1 = cb[512 + c];
        const float wv0 = cw[1024 + c], wv1 = cw[1536 + 1024 + c], wv2 = cw[3072 + 1024 + c], bv = cb[1024 + c];
        const float w00 = cw[c], w01 = cw[1536 + c], w02 = cw[3072 + c], b0 = cb[c];
#pragma unroll
        for (int p = 0; p < 8; ++p) {
            const int ml = p * 8 + mr, m = mc * 64 + ml;
            const bf16* r = hy + (size_t)(b * SEQ + m) * 1536;
            const float x1m = (m > 0) ? bf2f(r[-1536 + 512 + c]) : 0.f, x1c = bf2f(r[512 + c]), x1p = (m < SEQ - 1) ? bf2f(r[1536 + 512 + c]) : 0.f;
            const float vm = (m > 0) ? bf2f(r[-1536 + 1024 + c]) : 0.f, vc = bf2f(r[1024 + c]), vp = (m < SEQ - 1) ? bf2f(r[1536 + 1024 + c]) : 0.f;
            const float u1 = b1 + w10 * x1m + w11 * x1c + w12 * x1p;
            const float uv = bv + wv0 * vm + wv1 * vc + wv2 * vp;
            tile[cl * 72 + ml] = (unsigned short)f2bf(u1 * uv);
            const float x0m = (m > 0) ? bf2f(r[-1536 + c]) : 0.f, x0c = bf2f(r[c]), x0p = (m < SEQ - 1) ? bf2f(r[1536 + c]) : 0.f;
            tile[4608 + cl * 72 + ml] = (unsigned short)f2bf(b0 + w00 * x0m + w01 * x0c + w02 * x0p);
        }
        __syncthreads();
        {
            const int c2 = tid >> 3, ch = tid & 7;
            const LAS unsigned short* s = tile + c2 * 72 + ch * 8;
            v4u o; o.x = s[0] | ((unsigned)s[1] << 16); o.y = s[2] | ((unsigned)s[3] << 16); o.z = s[4] | ((unsigned)s[5] << 16); o.w = s[6] | ((unsigned)s[7] << 16);
            *(v4u*)(ut + ((size_t)(cc * 64 + c2) * NBATCH + b) * SEQ + mc * 64 + ch * 8) = o;
            const LAS unsigned short* s2 = s + 4608;
            v4u o2; o2.x = s2[0] | ((unsigned)s2[1] << 16); o2.y = s2[2] | ((unsigned)s2[3] << 16); o2.z = s2[4] | ((unsigned)s2[5] << 16); o2.w = s2[6] | ((unsigned)s2[7] << 16);
            *(v4u*)(x0t + ((size_t)(cc * 64 + c2) * NBATCH + b) * SEQ + mc * 64 + ch * 8) = o2;
        }
        __syncthreads();
    }
}

__device__ __forceinline__ void phase_hyena_naive(const Args& a, int L, LAS unsigned char* lds, int tid, int G) {
    const bf16* hy = (const bf16*)(a.ws + WS_HY); const bf16* ut = (const bf16*)(a.ws + WS_UT); const float* Gf = (const float*)(a.ws + WS_GF);
    bf16* yhy = (bf16*)(a.ws + WS_YHY);
    const float* cw = a.in[3] + (size_t)L * 3 * 1536; const float* cb = a.in[4] + L * 1536;
    LAS float* Gs = (LAS float*)lds;
    LAS float* Us = Gs + 4096;
    for (int item = blockIdx.x; item < 2048; item += G) {
        const int c = item >> 2, bq = item & 3;
        for (int i = tid; i < 4096; i += NTHR) Gs[i] = (i == 0) ? 0.f : Gf[(size_t)c * 4096 + i];
        for (int i = tid; i < 8192; i += NTHR) { const int bl = i >> 11, m = i & 2047; Us[i] = bf2f(ut[((size_t)c * NBATCH + bq * 4 + bl) * SEQ + m]); }
        __syncthreads();
        const int bl = tid >> 7, tn = tid & 127;
        float acc[16];
#pragma unroll
        for (int i = 0; i < 16; ++i) acc[i] = 0.f;
        const LAS float* up = Us + bl * 2048;
        for (int m = 0; m < SEQ; ++m) {
            const float u = up[m];
            const LAS float* gp = Gs + (tn - m + 2048);
#pragma unroll
            for (int i = 0; i < 16; ++i) acc[i] += gp[128 * i] * u;
        }
        const int b = bq * 4 + bl;
        const float w0 = cw[c], w1 = cw[1536 + c], w2 = cw[3072 + c], b0 = cb[c];
#pragma unroll
        for (int i = 0; i < 16; ++i) {
            const int n = tn + 128 * i;
            const bf16* r = hy + (size_t)(b * SEQ + n) * 1536 + c;
            const float xm = (n > 0) ? bf2f(r[-1536]) : 0.f, xc = bf2f(r[0]), xp = (n < SEQ - 1) ? bf2f(r[1536]) : 0.f;
            const float x0 = b0 + w0 * xm + w1 * xc + w2 * xp;
            yhy[(size_t)(b * SEQ + n) * 512 + c] = (bf16)f2bf(x0 * acc[i]);
        }
        __syncthreads();
    }
}

__device__ __forceinline__ void phase_attn_naive(const Args& a, int half, int tid, int G) {
    bf16* Q = (bf16*)(a.ws + WS_Q); const bf16* KV = (const bf16*)(a.ws + WS_KV); float* lse = (float*)(a.ws + WS_LSE);
    for (int idx = blockIdx.x * NTHR + tid; idx < 3 * 8 * HALF_TOK; idx += G * NTHR) {
        const int g = idx / (8 * HALF_TOK), t = idx % (8 * HALF_TOK), h = t / HALF_TOK, tokl = t % HALF_TOK;
        const int dil = (g == 0) ? 1 : (g == 1 ? 4 : 16);
        const int token = half * HALF_TOK + tokl, s = token & 2047;
        bf16* qp = Q + (size_t)token * 1536 + g * 512 + h * 64;
        float q[64], o[64];
#pragma unroll
        for (int i = 0; i < 8; ++i) { const v4u w = *(const v4u*)(qp + 8 * i);
            q[8 * i + 0] = __uint_as_float(w.x << 16); q[8 * i + 1] = __uint_as_float(w.x & 0xffff0000u); q[8 * i + 2] = __uint_as_float(w.y << 16); q[8 * i + 3] = __uint_as_float(w.y & 0xffff0000u);
            q[8 * i + 4] = __uint_as_float(w.z << 16); q[8 * i + 5] = __uint_as_float(w.z & 0xffff0000u); q[8 * i + 6] = __uint_as_float(w.w << 16); q[8 * i + 7] = __uint_as_float(w.w & 0xffff0000u); }
#pragma unroll
        for (int i = 0; i < 64; ++i) o[i] = 0.f;
        float mx = -1e30f, l = 0.f;
        for (int j = -64; j <= 64; ++j) {
            const int sp = s + j * dil;
            if (sp < 0 || sp >= SEQ) continue;
            const bf16* kp = KV + (size_t)(tokl + j * dil) * 3072 + g * 1024 + h * 64;
            float sc = 0.f;
#pragma unroll
            for (int i = 0; i < 8; ++i) { const v4u w = *(const v4u*)(kp + 8 * i);
                sc += q[8 * i + 0] * __uint_as_float(w.x << 16) + q[8 * i + 1] * __uint_as_float(w.x & 0xffff0000u) + q[8 * i + 2] * __uint_as_float(w.y << 16) + q[8 * i + 3] * __uint_as_float(w.y & 0xffff0000u)
                    + q[8 * i + 4] * __uint_as_float(w.z << 16) + q[8 * i + 5] * __uint_as_float(w.z & 0xffff0000u) + q[8 * i + 6] * __uint_as_float(w.w << 16) + q[8 * i + 7] * __uint_as_float(w.w & 0xffff0000u); }
            const float mn = fmaxf(mx, sc), corr = exp2f(mx - mn), p = exp2f(sc - mn);
            l = l * corr + p; mx = mn;
            const bf16* vp = kp + 512;
#pragma unroll
            for (int i = 0; i < 8; ++i) { const v4u w = *(const v4u*)(vp + 8 * i);
                o[8 * i + 0] = o[8 * i + 0] * corr + p * __uint_as_float(w.x << 16); o[8 * i + 1] = o[8 * i + 1] * corr + p * __uint_as_float(w.x & 0xffff0000u);
                o[8 * i + 2] = o[8 * i + 2] * corr + p * __uint_as_float(w.y << 16); o[8 * i + 3] = o[8 * i + 3] * corr + p * __uint_as_float(w.y & 0xffff0000u);
                o[8 * i + 4] = o[8 * i + 4] * corr + p * __uint_as_float(w.z << 16); o[8 * i + 5] = o[8 * i + 5] * corr + p * __uint_as_float(w.z & 0xffff0000u);
                o[8 * i + 6] = o[8 * i + 6] * corr + p * __uint_as_float(w.w << 16); o[8 * i + 7] = o[8 * i + 7] * corr + p * __uint_as_float(w.w & 0xffff0000u); }
        }
        const float inv = 1.0f / l;
#pragma unroll
        for (int i = 0; i < 8; ++i) { v4u w; w.x = pk2(o[8 * i] * inv, o[8 * i + 1] * inv); w.y = pk2(o[8 * i + 2] * inv, o[8 * i + 3] * inv); w.z = pk2(o[8 * i + 4] * inv, o[8 * i + 5] * inv); w.w = pk2(o[8 * i + 6] * inv, o[8 * i + 7] * inv);
            *(v4u*)(qp + 8 * i) = w; }
        lse[((size_t)g * MTOK + token) * 8 + h] = mx + log2f(l);
    }
}

__device__ __forceinline__ void phase_combine(const Args& a, int tid, int G) {
    const bf16* Q = (const bf16*)(a.ws + WS_Q); const float* lse = (const float*)(a.ws + WS_LSE); bf16* ya = (bf16*)(a.ws + WS_YATT);
    for (int idx = blockIdx.x * NTHR + tid; idx < MTOK * 64; idx += G * NTHR) {
        const int token = idx >> 6, ch = idx & 63, h = ch >> 3;
        const float l0 = lse[((size_t)0 * MTOK + token) * 8 + h], l1 = lse[((size_t)1 * MTOK + token) * 8 + h], l2 = lse[((size_t)2 * MTOK + token) * 8 + h];
        const float mx = fmaxf(l0, fmaxf(l1, l2));
        float w0 = exp2f(l0 - mx), w1 = exp2f(l1 - mx), w2 = exp2f(l2 - mx);
        const float inv = 1.0f / (w0 + w1 + w2); w0 *= inv; w1 *= inv; w2 *= inv;
        const bf16* p = Q + (size_t)token * 1536 + ch * 8;
        const v4u a0 = *(const v4u*)p, a1 = *(const v4u*)(p + 512), a2 = *(const v4u*)(p + 1024);
        v4u o;
#define CMB(f) pk2(w0 * __uint_as_float(a0.f << 16) + w1 * __uint_as_float(a1.f << 16) + w2 * __uint_as_float(a2.f << 16), \
                   w0 * __uint_as_float(a0.f & 0xffff0000u) + w1 * __uint_as_float(a1.f & 0xffff0000u) + w2 * __uint_as_float(a2.f & 0xffff0000u))
        o.x = CMB(x); o.y = CMB(y); o.z = CMB(z); o.w = CMB(w);
#undef CMB
        *(v4u*)(ya + (size_t)token * 512 + ch * 8) = o;
    }
}

__device__ __forceinline__ void phase_final_norm(const Args& a, int lane, int wave, int G) {
    float* x = a.out; const float* gain = a.in[18];
    const int gw = blockIdx.x * NWAVES + wave, NGW = G * NWAVES;
    for (int m = gw; m < MTOK; m += NGW) {
        f32x4* xr = (f32x4*)(x + (size_t)m * DM) + lane;
        f32x4 v[4]; float s = 0.f;
#pragma unroll
        for (int j = 0; j < 4; ++j) { v[j] = xr[64 * j]; s += (v[j][0] * v[j][0] + v[j][1] * v[j][1]) + (v[j][2] * v[j][2] + v[j][3] * v[j][3]); }
        s = wave_sum(s);
        const float rs = 1.0f / sqrtf(s * (1.0f / 1024.0f) + 1e-6f);
#pragma unroll
        for (int j = 0; j < 4; ++j) { const f32x4 gn = *((const f32x4*)gain + lane + 64 * j); xr[64 * j] = v[j] * rs * gn; }
    }
}

typedef short bf16x8 __attribute__((ext_vector_type(8)));
typedef short s16x4 __attribute__((ext_vector_type(4)));
constexpr int HY_UROW = 4112, HY_ROFF = 16 * HY_UROW, HY_RSTRIDE = 8192 + 64;
__device__ __forceinline__ bf16x8 ld_frag4(const LAS unsigned char* p) {
    const LAS unsigned* q = (const LAS unsigned*)p; v4u d; d.x = q[0]; d.y = q[1]; d.z = q[2]; d.w = q[3]; return __builtin_bit_cast(bf16x8, d);
}
__device__ __forceinline__ void phase_hyena_mfma(const Args& a, LAS unsigned char* lds, int tid, int G) {
    const bf16* ut = (const bf16*)(a.ws + WS_UT); const bf16* Rg = (const bf16*)(a.ws + WS_GF); bf16* x0t = (bf16*)(a.ws + WS_X0T);
    const int lane = tid & 63, w = __builtin_amdgcn_readfirstlane(tid >> 6), i16 = lane & 15, kq = lane >> 4;
    const int base = (w >> 1) * 512 + (w & 1) * 16, cp = i16 & 1;
    const int lane_const = (2048 - base - i16 + 8 * kq - cp) >> 1;
    const LAS unsigned char* pA15 = lds + HY_ROFF + cp * HY_RSTRIDE + 4 * (lane_const - 240);
    const LAS unsigned char* pB = lds + i16 * HY_UROW + kq * 16;
    for (int ch = blockIdx.x; ch < HYW; ch += G) {
        for (int i = tid; i < 4096; i += NTHR) { const int b = i >> 8, ck = i & 255; *(LAS v4u*)(lds + b * HY_UROW + ck * 16) = *(const v4u*)(ut + ((size_t)ch * NBATCH + b) * SEQ + ck * 8); }
        for (int i = tid; i < 1024; i += NTHR) { const int c2 = i >> 9, ck = i & 511; *(LAS v4u*)(lds + HY_ROFF + c2 * HY_RSTRIDE + ck * 16) = *(const v4u*)(Rg + ((size_t)ch * 2 + c2) * 4096 + ck * 8); }
        __syncthreads();
        f32x4 acc[16]; bf16x8 W[16];
#pragma unroll
        for (int i = 0; i < 16; ++i) acc[i] = (f32x4){0.f, 0.f, 0.f, 0.f};
#pragma unroll
        for (int j = 1; j < 16; ++j) W[j] = ld_frag4(pA15 + 64 * (15 - j));
        W[0] = W[1];
#pragma unroll 1
        for (int tt = 0; tt < 4; ++tt) {
            const LAS unsigned char* pa = pA15 + 64 * 15 + 1024 * tt; const LAS unsigned char* pb = pB + 1024 * tt;
#pragma unroll
            for (int s = 0; s < 16; ++s) {
                W[(16 - s) & 15] = ld_frag4(pa + 64 * s);
                const bf16x8 Bf = *(const LAS bf16x8*)(pb + 64 * s);
#pragma unroll
                for (int i = 0; i < 16; ++i) acc[i] = __builtin_amdgcn_mfma_f32_16x16x32_bf16(W[(i - s) & 15], Bf, acc[i], 0, 0, 0);
            }
        }
        bf16* xo = x0t + ((size_t)ch * NBATCH + i16) * SEQ + base + 4 * kq;
#pragma unroll
        for (int i = 0; i < 16; ++i) {
            typedef unsigned u32x2v __attribute__((ext_vector_type(2)));
            const u32x2v xv = *(const u32x2v*)(xo + 32 * i);
            u32x2v o; o.x = pk2(__uint_as_float(xv.x << 16) * acc[i][0], __uint_as_float(xv.x & 0xffff0000u) * acc[i][1]);
            o.y = pk2(__uint_as_float(xv.y << 16) * acc[i][2], __uint_as_float(xv.y & 0xffff0000u) * acc[i][3]);
            *(u32x2v*)(xo + 32 * i) = o;
        }
        __syncthreads();
    }
}

__device__ __forceinline__ void phase_transpose_y(const Args& a, LAS unsigned char* lds, int tid, int G) {
    const bf16* yt = (const bf16*)(a.ws + WS_X0T); bf16* yhy = (bf16*)(a.ws + WS_YHY);
    LAS unsigned short* tile = (LAS unsigned short*)lds;
    for (int item = blockIdx.x; item < 4096; item += G) {
        const int cc = item & 7, mc = (item >> 3) & 31, b = item >> 8;
        { const int c2 = tid >> 3, ck = tid & 7;
          const v4u v = *(const v4u*)(yt + ((size_t)(cc * 64 + c2) * NBATCH + b) * SEQ + mc * 64 + ck * 8);
          LAS unsigned* t4 = (LAS unsigned*)(tile + c2 * 72 + ck * 8); t4[0] = v.x; t4[1] = v.y; t4[2] = v.z; t4[3] = v.w; }
        __syncthreads();
        { const int nl = tid >> 3, cg8 = tid & 7; const LAS unsigned short* s = tile + (cg8 * 8) * 72 + nl;
          v4u o; o.x = s[0] | ((unsigned)s[72] << 16); o.y = s[144] | ((unsigned)s[216] << 16); o.z = s[288] | ((unsigned)s[360] << 16); o.w = s[432] | ((unsigned)s[504] << 16);
          *(v4u*)(yhy + (size_t)(b * SEQ + mc * 64 + nl) * 512 + cc * 64 + cg8 * 8) = o; }
        __syncthreads();
    }
}

constexpr int AT_ROWS = 272, AT_RS = 144, AT_VOFF = AT_ROWS * AT_RS;
__device__ __forceinline__ void phase_attn_mfma(const Args& a, int half, LAS unsigned char* lds, int tid, int G) {
    bf16* Q = (bf16*)(a.ws + WS_Q); const bf16* KV = (const bf16*)(a.ws + WS_KV); float* lse = (float*)(a.ws + WS_LSE);
    const int lane = tid & 63, w = __builtin_amdgcn_readfirstlane(tid >> 6), q16 = lane & 15, kq = lane >> 4;
    for (int unit = blockIdx.x; unit < 3072; unit += G) {
        const int g = unit >> 10, u = unit & 1023, sub = u & 15, h = (u >> 4) & 7, bl = u >> 7;
        int dil, n, r, qb;
        if (g == 0) { dil = 1; n = 2048; r = 0; qb = sub; } else if (g == 1) { dil = 4; n = 512; r = sub >> 2; qb = sub & 3; } else { dil = 16; n = 128; r = sub; qb = 0; }
        const int q0 = qb * 128, kb0 = q0 - 64;
        for (int i = tid; i < 2 * AT_ROWS * 8; i += NTHR) {
            const int which = (i >= AT_ROWS * 8) ? 1 : 0, j = i - which * AT_ROWS * 8, rr = j >> 3, ck = j & 7, key = kb0 + rr;
            v4u v = (v4u){0u, 0u, 0u, 0u};
            if (key >= 0 && key < n) v = *(const v4u*)(KV + (size_t)(bl * SEQ + key * dil + r) * 3072 + g * 1024 + which * 512 + h * 64 + ck * 8);
            *(LAS v4u*)(lds + which * AT_VOFF + rr * AT_RS + ck * 16) = v;
        }
        __syncthreads();
        {
            const int i0 = q0 + 16 * w;
            const int token = half * HALF_TOK + bl * SEQ + (i0 + q16) * dil + r;
            bf16* qp = Q + (size_t)token * 1536 + g * 512 + h * 64;
            const bf16x8 Qf0 = *(const bf16x8*)(qp + 8 * kq), Qf1 = *(const bf16x8*)(qp + 32 + 8 * kq);
            f32x4 acc[4];
#pragma unroll
            for (int dt = 0; dt < 4; ++dt) acc[dt] = (f32x4){0.f, 0.f, 0.f, 0.f};
            float mrun = -1e30f, lrun = 0.f;
            const LAS unsigned char* kbase = lds + (16 * w + q16) * AT_RS + 16 * kq;
            const LAS unsigned char* vbase = lds + AT_VOFF + (16 * w + 4 * kq + (q16 >> 2)) * AT_RS + 8 * (q16 & 3);
#pragma unroll 1
            for (int st = 0; st < 5; ++st) {
                f32x4 s[2];
#pragma unroll
                for (int hh = 0; hh < 2; ++hh) {
                    const int kt = 2 * st + hh;
                    const LAS unsigned char* kp = kbase + kt * 16 * AT_RS;
                    const bf16x8 K0 = *(const LAS bf16x8*)kp, K1 = *(const LAS bf16x8*)(kp + 64);
                    f32x4 z = (f32x4){0.f, 0.f, 0.f, 0.f};
                    z = __builtin_amdgcn_mfma_f32_16x16x32_bf16(K0, Qf0, z, 0, 0, 0);
                    z = __builtin_amdgcn_mfma_f32_16x16x32_bf16(K1, Qf1, z, 0, 0, 0);
#pragma unroll
                    for (int e = 0; e < 4; ++e) {
                        const int rel = 16 * kt - 64 + 4 * kq + e - q16, j = i0 + q16 + rel;
                        const bool ok = (rel >= -64) && (rel <= 64) && (j >= 0) && (j < n);
                        z[e] = ok ? z[e] : -1e30f;
                    }
                    s[hh] = z;
                }
                float mx = fmaxf(fmaxf(fmaxf(s[0][0], s[0][1]), fmaxf(s[0][2], s[0][3])), fmaxf(fmaxf(s[1][0], s[1][1]), fmaxf(s[1][2], s[1][3])));
                mx = fmaxf(mx, __shfl_xor(mx, 16)); mx = fmaxf(mx, __shfl_xor(mx, 32));
                const float mn = fmaxf(mrun, mx), corr = exp2f(mrun - mn);
                mrun = mn;
                float p[8], ps = 0.f;
#pragma unroll
                for (int e = 0; e < 4; ++e) { p[e] = exp2f(s[0][e] - mn); p[4 + e] = exp2f(s[1][e] - mn); ps += p[e] + p[4 + e]; }
                lrun = lrun * corr + ps;
                v4u pw; pw.x = pk2(p[0], p[1]); pw.y = pk2(p[2], p[3]); pw.z = pk2(p[4], p[5]); pw.w = pk2(p[6], p[7]);
                const bf16x8 Pf = __builtin_bit_cast(bf16x8, pw);
#pragma unroll
                for (int dt = 0; dt < 4; ++dt) {
                    const LAS unsigned char* vp = vbase + 32 * st * AT_RS + 32 * dt;
                    const s16x4 v0 = __builtin_amdgcn_ds_read_tr16_b64_v4i16((LAS s16x4*)vp);
                    const s16x4 v1 = __builtin_amdgcn_ds_read_tr16_b64_v4i16((LAS s16x4*)(vp + 16 * AT_RS));
                    const bf16x8 Vf = (bf16x8){v0[0], v0[1], v0[2], v0[3], v1[0], v1[1], v1[2], v1[3]};
                    acc[dt] = acc[dt] * corr;
                    acc[dt] = __builtin_amdgcn_mfma_f32_16x16x32_bf16(Vf, Pf, acc[dt], 0, 0, 0);
                }
            }
            lrun += __shfl_xor(lrun, 16); lrun += __shfl_xor(lrun, 32);
            const float inv = 1.0f / lrun;
            typedef unsigned u32x2v __attribute__((ext_vector_type(2)));
#pragma unroll
            for (int dt = 0; dt < 4; ++dt) {
                u32x2v o; o.x = pk2(acc[dt][0] * inv, acc[dt][1] * inv); o.y = pk2(acc[dt][2] * inv, acc[dt][3] * inv);
                *(u32x2v*)(qp + 16 * dt + 4 * kq) = o;
            }
            if (kq == 0) lse[((size_t)g * MTOK + token) * 8 + h] = mrun + log2f(lrun);
        }
        __syncthreads();
    }
}

#define GEMM_CALL(EPI, SCHED, g, S, E) pg8::gemm_phase<EPI, SCHED, true, true>(lds, g, S, E)

typedef const __attribute__((address_space(4))) Args* KArgs;
__device__ __forceinline__ Args load_args() {
#if defined(__HIP_DEVICE_COMPILE__)
    KArgs p = (KArgs)__builtin_amdgcn_kernarg_segment_ptr();
    asm volatile("" : "+s"(p));
    return *p;
#else
    return Args{};
#endif
}
__global__ void __launch_bounds__(NTHR, 2) fwd_megakernel(Args a_unused) {
    extern __shared__ __attribute__((aligned(16))) unsigned char lds_raw[];
    LAS unsigned char* lds = (LAS unsigned char*)lds_raw;
    cg::grid_group grid = cg::this_grid();
    const int tid0 = threadIdx.x, G0 = gridDim.x, bx0 = blockIdx.x;
#define PTRS() const Args a = load_args(); int tid = tid0, G = G0, bx = bx0; asm volatile("" : "+v"(tid), "+s"(G), "+s"(bx)); const int lane = tid & 63, wave = __builtin_amdgcn_readfirstlane(tid >> 6); (void)lane; (void)wave; unsigned char* ws = a.ws; bf16* Wb = (bf16*)(ws + WS_W); const pg8::bf16_t* xb = (const pg8::bf16_t*)(ws + WS_XB); \
    const float* rcos = (const float*)(ws + WS_ROPE); const float* rsin = rcos + 65536; float* ssqA = (float*)(ws + WS_SSQA); float* ssqB = (float*)(ws + WS_SSQB); \
    (void)Wb; (void)xb; (void)rcos; (void)rsin; (void)ssqA; (void)ssqB;
#define GIN() pg8::Gemm gin{xb, (const pg8::bf16_t*)(Wb + W_IN / 2), nullptr, nullptr, MTOK, NIN, DM}; \
    pg8::EpiIn Ein{(pg8::bf16_t*)(ws + WS_HY), (pg8::bf16_t*)(ws + WS_Q), (pg8::bf16_t*)(ws + WS_KV), (pg8::bf16_t*)(ws + WS_GATES), ssqA, rcos, rsin, 0};

#pragma unroll 1
    for (int L = 0; L < 2; ++L) {
        { PTRS(); phase_prep_weights(a, L, lds, tid, lane, wave, G); }
        grid.sync();
        {
            PTRS(); GIN();
            pg8::TwoRect S; S.a.init(128, 12, 0, 0, G, bx); S.b.init(64, 12, 0, 12, G, bx); S.na = S.a.count();
            GEMM_CALL(pg8::EpiIn, pg8::TwoRect, gin, S, Ein);
        }
        grid.sync();
        { PTRS(); phase_attn_mfma(a, 0, lds, tid, G); phase_prep_u(a, L, lds, tid, G); }
        grid.sync();
        {
            PTRS(); GIN();
            pg8::RectOrder S; S.init(64, 12, 64, 12, G, bx);
            Ein.kv_row0 = HALF_TOK;
            GEMM_CALL(pg8::EpiIn, pg8::RectOrder, gin, S, Ein);
        }
        { PTRS(); phase_hyena_mfma(a, lds, tid, G); }
        grid.sync();
        { PTRS(); phase_attn_mfma(a, 1, lds, tid, G); }
        {
            PTRS(); GIN();
            pg8::RectOrder S; S.init(128, 8, 0, 24, G, bx);
            GEMM_CALL(pg8::EpiIn, pg8::RectOrder, gin, S, Ein);
        }
        grid.sync();
        { PTRS(); phase_combine(a, tid, G); phase_transpose_y(a, lds, tid, G); }
        grid.sync();
        {
            PTRS();
            pg8::Gemm g{(const pg8::bf16_t*)(ws + WS_YHY), (const pg8::bf16_t*)(Wb + W_PHY / 2), (const pg8::bf16_t*)(ws + WS_YATT), (const pg8::bf16_t*)(Wb + W_PATT / 2), MTOK, DM, 512};
            pg8::PairOrder S; S.r.init(128, 4, 0, 0, G, bx);
            pg8::EpiGate E{(const pg8::bf16_t*)(ws + WS_GATES), (pg8::bf16_t*)(ws + WS_MERGED)};
            GEMM_CALL(pg8::EpiGate, pg8::PairOrder, g, S, E);
        }
        grid.sync();
        {
            PTRS();
            pg8::Gemm g{(const pg8::bf16_t*)(ws + WS_MERGED), (const pg8::bf16_t*)(Wb + W_O / 2), nullptr, nullptr, MTOK, DM, DM};
            pg8::RectOrder S; S.init(128, 4, 0, 0, G, bx);
            pg8::EpiRes E{L == 0 ? a.in[0] : a.out, a.out, (pg8::bf16_t*)(ws + WS_XB), ssqB};
            GEMM_CALL(pg8::EpiRes, pg8::RectOrder, g, S, E);
        }
        grid.sync();
        {
            PTRS();
            pg8::Gemm g{xb, (const pg8::bf16_t*)(Wb + W_FF1 / 2), nullptr, nullptr, MTOK, DFF, DM};
            pg8::RectOrder S; S.init(128, 16, 0, 0, G, bx);
            pg8::EpiFF1 E{(pg8::bf16_t*)(ws + WS_H), ssqB};
            GEMM_CALL(pg8::EpiFF1, pg8::RectOrder, g, S, E);
        }
        grid.sync();
        {
            PTRS();
            pg8::Gemm g{(const pg8::bf16_t*)(ws + WS_H), (const pg8::bf16_t*)(Wb + W_FF2 / 2), nullptr, nullptr, MTOK, DM, DFF};
            pg8::RectOrder S; S.init(128, 4, 0, 0, G, bx);
            pg8::EpiRes E{a.out, a.out, (pg8::bf16_t*)(ws + WS_XB), ssqA};
            GEMM_CALL(pg8::EpiRes, pg8::RectOrder, g, S, E);
        }
        grid.sync();
    }
    { PTRS(); phase_final_norm(a, lane, wave, G); }
}

extern "C" void kernel_launch(void* const* d_in, const int* in_sizes, int n_in, void* d_out, int out_size, void* d_ws, size_t ws_size, hipStream_t stream) {
    static int grid = 0;
    if (grid == 0) {
        if (n_in != 19 || in_sizes[0] != MTOK * DM || out_size != MTOK * DM || ws_size < WS_END) {
            fprintf(stderr, "kernel_launch: unexpected shapes / workspace (n_in %d, ws %zu, need %zu); nothing launched\n", n_in, ws_size, (size_t)WS_END); grid = -1; return; }
        int dev = 0, cus = 0, per_cu = 0;
        (void)hipGetDevice(&dev); (void)hipDeviceGetAttribute(&cus, hipDeviceAttributeMultiprocessorCount, dev);
        if (hipFuncSetAttribute((const void*)fwd_megakernel, hipFuncAttributeMaxDynamicSharedMemorySize, LDS_BYTES) != hipSuccess) { fprintf(stderr, "kernel_launch: hipFuncSetAttribute failed\n"); grid = -1; return; }
        if (hipOccupancyMaxActiveBlocksPerMultiprocessor(&per_cu, (const void*)fwd_megakernel, NTHR, LDS_BYTES) != hipSuccess || per_cu < 1) { fprintf(stderr, "kernel_launch: occupancy query gives %d\n", per_cu); per_cu = 1; }
        (void)hipGetLastError();
        grid = cus * 1;
        if (grid % 8 != 0 || grid > 256) grid = (grid > 256) ? 256 : (grid / 8) * 8;
    }
    if (grid < 0) return;
    Args a{};
    for (int i = 0; i < 19; ++i) a.in[i] = (const float*)d_in[i];
    a.out = (float*)d_out; a.ws = (unsigned char*)d_ws;
    void* args[] = {&a};
    hipError_t e = hipLaunchCooperativeKernel((const void*)fwd_megakernel, dim3(grid), dim3(NTHR), args, LDS_BYTES, stream);
    if (e != hipSuccess) fprintf(stderr, "cooperative launch failed: %s (grid %d)\n", hipGetErrorString(e), grid);
}
```

```cpp
#include <hip/hip_runtime.h>
#include <hip/hip_cooperative_groups.h>
#include <cstdio>
#include <cstdint>
namespace cg = cooperative_groups;

namespace pg8 {
#define PG8_LAS __attribute__((address_space(3)))
typedef unsigned short bf16_t;
typedef short bf16x8 __attribute__((ext_vector_type(8)));
typedef float f32x4 __attribute__((ext_vector_type(4)));
typedef unsigned u32x4 __attribute__((ext_vector_type(4)));
constexpr int BM = 256, BK = 64, HALF = 128, HTB = HALF * BK * 2  , STAGE_BYTES = 8 * HTB, NXCD = 8, WGM = 8;

__host__ __device__ __forceinline__ int lds_byte(int r, int c) { const int st = (r >> 4) * 2 + (c >> 5), rr = r & 15, cc = c & 31, ob = rr * 64 + cc * 2; return st * 1024 + (ob ^ (((ob >> 9) & 1) << 5)); }
__host__ __device__ __forceinline__ void stage_rc(int b, int& R, int& C) { const int st = b / 1024, sb = b % 1024, swz = sb ^ (((sb >> 9) & 1) << 5); R = (st >> 1) * 16 + swz / 64; C = (st & 1) * 32 + (swz % 64) / 2; }
__host__ __device__ __forceinline__ int perm32(int rho) { const int n = rho >> 4, i = rho & 15; return 8 * (i >> 2) + 4 * n + (i & 3); }

struct Unit { int pm, pn, z; };
struct Gemm { const bf16_t* A; const bf16_t* Bt; const bf16_t* A1; const bf16_t* Bt1; int M, N, K; };

struct StaticOrder {
    int nM, nN, nwg, G, c;
    __host__ __device__ void init(int M, int N, int G_, int c_) { nM = M / BM; nN = N / BM; nwg = nM * nN; G = G_; c = c_; }
    __host__ __device__ bool next(int i, Unit& u) const {
        const long L = (long)i * G + c; if (L >= nwg) return false;
        int wgid = (int)L; { const int q = nwg / NXCD, r = nwg % NXCD, xcd = wgid % NXCD, off = wgid / NXCD; wgid = (xcd < r ? xcd * (q + 1) : r * (q + 1) + (xcd - r) * q) + off; }
        const int nig = WGM * nN, gid = wgid / nig, fm = gid * WGM, gsz = (nM - fm) < WGM ? (nM - fm) : WGM;
        u.pm = fm + ((wgid % nig) % gsz); u.pn = (wgid % nig) / gsz; return true;
    }
    __device__ __forceinline__ void a_ready(const Unit&) const {}
    __device__ __forceinline__ void done(const Unit&) const {}
};


__device__ __forceinline__ unsigned cvt_pk_bf16(float lo, float hi) { unsigned r; asm volatile("v_cvt_pk_bf16_f32 %0, %1, %2" : "=v"(r) : "v"(lo), "v"(hi)); return r; }
__device__ __forceinline__ float bf_lo(unsigned w) { return __uint_as_float(w << 16); }
__device__ __forceinline__ float bf_hi(unsigned w) { return __uint_as_float(w & 0xffff0000u); }

struct RectOrder {
    int nN, nwg, G, c, pm0, pn0;
    __device__ __forceinline__ void init(int nM_, int nN_, int pm0_, int pn0_, int G_, int c_) { nN = nN_; nwg = nM_ * nN_; G = G_; c = c_; pm0 = pm0_; pn0 = pn0_; }
    __device__ __forceinline__ int count() const { return nwg > c ? (nwg - c + G - 1) / G : 0; }
    __device__ __forceinline__ bool next(int i, Unit& u) const {
        const long L = (long)i * G + c; if (L >= nwg) return false;
        const int w = (int)L, nig = 8 * nN, gid = w / nig, r = w % nig;
        u.pm = pm0 + gid * 8 + (r & 7); u.pn = pn0 + (r >> 3); u.z = 0; return true;
    }
    __device__ __forceinline__ void a_ready(const Unit&) const {}
    __device__ __forceinline__ void done(const Unit&) const {}
};
struct TwoRect {
    RectOrder a, b; int na;
    __device__ __forceinline__ bool next(int i, Unit& u) const { return i < na ? a.next(i, u) : b.next(i - na, u); }
    __device__ __forceinline__ void a_ready(const Unit&) const {}
    __device__ __forceinline__ void done(const Unit&) const {}
};
struct PairOrder {
    RectOrder r;
    __device__ __forceinline__ bool next(int i, Unit& u) const { const bool ok = r.next(i >> 1, u); u.z = i & 1; return ok; }
    __device__ __forceinline__ void a_ready(const Unit&) const {}
    __device__ __forceinline__ void done(const Unit&) const {}
};

constexpr float RMS_EPS = 1e-6f;
constexpr float QSCALE = 0.125f * 1.44269504088896341f;

__device__ __forceinline__ float row_rstd(const float* ssq, int row) {
    const f32x4* p = (const f32x4*)(ssq + (size_t)row * 16);
    const f32x4 a = p[0], b = p[1], c = p[2], d = p[3];
    const float s = ((a[0] + a[1]) + (a[2] + a[3])) + ((b[0] + b[1]) + (b[2] + b[3])) + ((c[0] + c[1]) + (c[2] + c[3])) + ((d[0] + d[1]) + (d[2] + d[3]));
    return 1.0f / sqrtf(s * (1.0f / 1024.0f) + RMS_EPS);
}

struct EpiIn {
    static constexpr bool PERM = true, AFTER_DRAIN = false;
    bf16_t* hy; bf16_t* q; bf16_t* kv; bf16_t* gates; const float* ssq; const float* rcos; const float* rsin; int kv_row0;
    __device__ __forceinline__ bool operator()(f32x4 (&acc)[2][2][4][2], const Unit& u, int wr, int wc, int fr, int fq) const {
        const int pn = u.pn; int type, ldc, colt, rowoff = 0; bf16_t* base;
        if (pn < 6) { type = 0; base = hy; ldc = 1536; colt = pn * 256; }
        else if (pn < 12) { type = 1; base = q; ldc = 1536; colt = (pn - 6) * 256; }
        else if (pn < 24) { const int idx = pn - 12; type = ((idx >> 1) & 1) ? 0 : 2; base = kv; ldc = 3072; colt = idx * 256; rowoff = kv_row0; }
        else { type = 3; base = gates; ldc = 2048; colt = (pn - 24) * 256; }
#pragma unroll
        for (int ai = 0; ai < 2; ++ai)
#pragma unroll
            for (int m = 0; m < 4; ++m) {
                const int row = u.pm * BM + ai * HALF + wr * 64 + m * 16 + fr;
                const float rs = row_rstd(ssq, row);
                bf16_t* rowp = base + (size_t)(row - rowoff) * ldc + colt;
                f32x4 v00 = acc[ai][0][m][0] * rs, v01 = acc[ai][0][m][1] * rs, v10 = acc[ai][1][m][0] * rs, v11 = acc[ai][1][m][1] * rs;
                if (type == 1 || type == 2) {
                    const int pos = row & 2047;
                    const f32x4 c0 = *(const f32x4*)(rcos + pos * 32 + 8 * fq), c1 = *(const f32x4*)(rcos + pos * 32 + 8 * fq + 4);
                    const f32x4 s0 = *(const f32x4*)(rsin + pos * 32 + 8 * fq), s1 = *(const f32x4*)(rsin + pos * 32 + 8 * fq + 4);
                    const float sc = (type == 1) ? QSCALE : 1.0f;
                    const f32x4 o00 = (v00 * c0 - v10 * s0) * sc, o01 = (v01 * c1 - v11 * s1) * sc;
                    const f32x4 o10 = (v10 * c0 + v00 * s0) * sc, o11 = (v11 * c1 + v01 * s1) * sc;
                    u32x4 w0, w1;
                    w0.x = cvt_pk_bf16(o00[0], o00[1]); w0.y = cvt_pk_bf16(o00[2], o00[3]); w0.z = cvt_pk_bf16(o01[0], o01[1]); w0.w = cvt_pk_bf16(o01[2], o01[3]);
                    w1.x = cvt_pk_bf16(o10[0], o10[1]); w1.y = cvt_pk_bf16(o10[2], o10[3]); w1.z = cvt_pk_bf16(o11[0], o11[1]); w1.w = cvt_pk_bf16(o11[2], o11[3]);
                    *(u32x4*)(rowp + wc * 64 + 8 * fq) = w0;
                    *(u32x4*)(rowp + wc * 64 + 8 * fq + 32) = w1;
                } else {
                    if (type == 3) {
#pragma unroll
                        for (int e = 0; e < 4; ++e) {
                            v00[e] = 1.0f / (1.0f + __expf(-v00[e])); v01[e] = 1.0f / (1.0f + __expf(-v01[e]));
                            v10[e] = 1.0f / (1.0f + __expf(-v10[e])); v11[e] = 1.0f / (1.0f + __expf(-v11[e]));
                        }
                    }
                    u32x4 w0, w1;
                    w0.x = cvt_pk_bf16(v00[0], v00[1]); w0.y = cvt_pk_bf16(v00[2], v00[3]); w0.z = cvt_pk_bf16(v01[0], v01[1]); w0.w = cvt_pk_bf16(v01[2], v01[3]);
                    w1.x = cvt_pk_bf16(v10[0], v10[1]); w1.y = cvt_pk_bf16(v10[2], v10[3]); w1.z = cvt_pk_bf16(v11[0], v11[1]); w1.w = cvt_pk_bf16(v11[2], v11[3]);
                    *(u32x4*)(rowp + wc * 32 + 8 * fq) = w0;
                    *(u32x4*)(rowp + wc * 32 + 8 * fq + HALF) = w1;
                }
            }
        return false;
    }
};

struct EpiGate {
    static constexpr bool PERM = true, AFTER_DRAIN = false;
    const bf16_t* gates; bf16_t* merged;
    __device__ __forceinline__ bool operator()(f32x4 (&acc)[2][2][4][2], const Unit& u, int wr, int wc, int fr, int fq) const {
#pragma unroll
        for (int ai = 0; ai < 2; ++ai)
#pragma unroll
            for (int m = 0; m < 4; ++m) {
                const int row = u.pm * BM + ai * HALF + wr * 64 + m * 16 + fr;
                const int col0 = u.pn * BM + wc * 32 + 8 * fq;
#pragma unroll
                for (int bj = 0; bj < 2; ++bj) {
                    const u32x4 ga = *(const u32x4*)(gates + (size_t)row * 2048 + 1024 + col0 + bj * HALF);
                    f32x4 a0 = (f32x4){bf_lo(ga.x), bf_hi(ga.x), bf_lo(ga.y), bf_hi(ga.y)}, a1 = (f32x4){bf_lo(ga.z), bf_hi(ga.z), bf_lo(ga.w), bf_hi(ga.w)};
                    if (u.z == 0) {
                        const u32x4 gh = *(const u32x4*)(gates + (size_t)row * 2048 + col0 + bj * HALF);
                        const f32x4 h0 = (f32x4){bf_lo(gh.x), bf_hi(gh.x), bf_lo(gh.y), bf_hi(gh.y)}, h1 = (f32x4){bf_lo(gh.z), bf_hi(gh.z), bf_lo(gh.w), bf_hi(gh.w)};
#pragma unroll
                        for (int e = 0; e < 4; ++e) { a0[e] = fmaxf(a0[e], 1e-30f); a1[e] = fmaxf(a1[e], 1e-30f); }
                        acc[ai][bj][m][0] = acc[ai][bj][m][0] * (h0 / a0);
                        acc[ai][bj][m][1] = acc[ai][bj][m][1] * (h1 / a1);
                    } else {
                        const f32x4 v0 = acc[ai][bj][m][0] * a0, v1 = acc[ai][bj][m][1] * a1;
                        u32x4 w; w.x = cvt_pk_bf16(v0[0], v0[1]); w.y = cvt_pk_bf16(v0[2], v0[3]); w.z = cvt_pk_bf16(v1[0], v1[1]); w.w = cvt_pk_bf16(v1[2], v1[3]);
                        *(u32x4*)(merged + (size_t)row * 1024 + col0 + bj * HALF) = w;
                    }
                }
            }
        return u.z == 0;
    }
};

struct EpiRes {
    static constexpr bool PERM = false, AFTER_DRAIN = false;
    const float* base; float* out; bf16_t* xb; float* ssq;
    __device__ __forceinline__ bool operator()(f32x4 (&acc)[2][2][4][2], const Unit& u, int wr, int wc, int fr, int fq) const {
        typedef unsigned u32x2v __attribute__((ext_vector_type(2)));
        int rl = wr * 64 + fr, cl = wc * 32 + 4 * fq;
        asm volatile("" : "+v"(rl), "+v"(cl));
#pragma unroll
        for (int ai = 0; ai < 2; ++ai)
#pragma unroll
            for (int m = 0; m < 4; ++m) {
                const int row = u.pm * BM + ai * HALF + m * 16 + rl;
                const size_t off = (size_t)row * 1024 + u.pn * BM + cl;
                float s = 0.f;
#pragma unroll
                for (int bj = 0; bj < 2; ++bj)
#pragma unroll
                    for (int n = 0; n < 2; ++n) {
                        const f32x4 o = *(const f32x4*)(base + off + bj * HALF + n * 16) + acc[ai][bj][m][n];
                        *(f32x4*)(out + off + bj * HALF + n * 16) = o;
                        u32x2v w; w.x = cvt_pk_bf16(o[0], o[1]); w.y = cvt_pk_bf16(o[2], o[3]);
                        *(u32x2v*)(xb + off + bj * HALF + n * 16) = w;
                        s += (o[0] * o[0] + o[1] * o[1]) + (o[2] * o[2] + o[3] * o[3]);
                    }
                s += __shfl_xor(s, 16); s += __shfl_xor(s, 32);
                if (fq == 0) ssq[(size_t)row * 16 + u.pn * 4 + wc] = s;
                asm volatile("" ::: "memory");
            }
        return false;
    }
};

struct EpiFF1 {
    static constexpr bool PERM = true, AFTER_DRAIN = false;
    bf16_t* h; const float* ssq;
    __device__ __forceinline__ bool operator()(f32x4 (&acc)[2][2][4][2], const Unit& u, int wr, int wc, int fr, int fq) const {
#pragma unroll
        for (int ai = 0; ai < 2; ++ai)
#pragma unroll
            for (int m = 0; m < 4; ++m) {
                const int row = u.pm * BM + ai * HALF + wr * 64 + m * 16 + fr;
                const float rs = row_rstd(ssq, row);
                bf16_t* rowp = h + (size_t)row * 4096 + u.pn * BM + wc * 32 + 8 * fq;
#pragma unroll
                for (int bj = 0; bj < 2; ++bj) {
                    f32x4 v0 = acc[ai][bj][m][0] * rs, v1 = acc[ai][bj][m][1] * rs;
#pragma unroll
                    for (int e = 0; e < 4; ++e) { v0[e] = fmaxf(v0[e], 0.f); v1[e] = fmaxf(v1[e], 0.f); }
                    v0 = v0 * v0; v1 = v1 * v1;
                    u32x4 w; w.x = cvt_pk_bf16(v0[0], v0[1]); w.y = cvt_pk_bf16(v0[2], v0[3]); w.z = cvt_pk_bf16(v1[0], v1[1]); w.w = cvt_pk_bf16(v1[2], v1[3]);
                    *(u32x4*)(rowp + bj * HALF) = w;
                }
            }
        return false;
    }
};

template <class Epi, class Sched, bool ALIGN_EPI = false, bool SP2 = false>
__device__ __forceinline__ void gemm_phase(PG8_LAS unsigned char* lds, const Gemm g, const Sched& S, const Epi& E) {
    int tid_ = threadIdx.x; asm volatile("" : "+v"(tid_));
    const int tid = tid_, wid = __builtin_amdgcn_readfirstlane(tid >> 6), lane = tid & 63, wr = wid >> 2, wc = wid & 3, fr = lane & 15, fq = lane >> 4;
    const int K = g.K, nt = K / BK;
    unsigned voffA[2], voffB[2];
#pragma unroll
    for (int i = 0; i < 2; ++i) { int R, C; stage_rc(tid * 16 + i * 8192, R, C); const int Rb = Epi::PERM ? ((R & ~31) + perm32(R & 31)) : R;
        voffA[i] = (unsigned)(R * K + C) * 2u; voffB[i] = (unsigned)(Rb * K + C) * 2u; }
    const size_t kstep = (size_t)(BK * 2);
    const size_t hstep = (size_t)HALF * K * 2;
    const size_t tstep = 2 * hstep;
    const unsigned ldsw = (unsigned)wid * 1024u;
    const int aoff = lds_byte(wr * 64 + fr, fq * 8), boff = lds_byte(wc * 32 + fr, fq * 8);
#define PG8_SA(b, h) (((b) * 2 + (h)) * HTB)
#define PG8_SB(b, h) ((4 + (b) * 2 + (h)) * HTB)
#define PG8_STAGE(bufoff, gbase, voff) do { _Pragma("unroll") for (int _i = 0; _i < 2; ++_i) \
        __builtin_amdgcn_global_load_lds((const unsigned*)((const char*)(gbase) + (voff)[_i]), (PG8_LAS unsigned*)(lds + (bufoff) + ldsw + _i * 8192), 16, 0, 0); } while (0)
#define PG8_LDA(dst, b, h) do { _Pragma("unroll") for (int m = 0; m < 4; ++m) _Pragma("unroll") for (int k = 0; k < 2; ++k) dst[m][k] = *(const PG8_LAS bf16x8*)(lds + PG8_SA(b, h) + aoff + m * 2048 + k * 1024); } while (0)
#define PG8_LDB(dst, b, h) do { _Pragma("unroll") for (int n = 0; n < 2; ++n) _Pragma("unroll") for (int k = 0; k < 2; ++k) dst[n][k] = *(const PG8_LAS bf16x8*)(lds + PG8_SB(b, h) + boff + n * 2048 + k * 1024); } while (0)
#define PG8_MMA(ai, bj, At, Bt) do { __builtin_amdgcn_s_setprio(1); _Pragma("unroll") for (int m = 0; m < 4; ++m) _Pragma("unroll") for (int n = 0; n < 2; ++n) _Pragma("unroll") for (int k = 0; k < 2; ++k) \
        acc[ai][bj][m][n] = __builtin_amdgcn_mfma_f32_16x16x32_bf16(Bt[n][k], At[m][k], acc[ai][bj][m][n], 0, 0, 0); __builtin_amdgcn_s_setprio(0); } while (0)
#define PG8_WAIT_V(n) asm volatile("s_waitcnt vmcnt(" #n ")" ::: "memory")
#define PG8_WAIT_L(n) asm volatile("s_waitcnt lgkmcnt(" #n ")" ::: "memory")
#define PG8_BAR __builtin_amdgcn_s_barrier()
#define PG8_SCHED __builtin_amdgcn_sched_barrier(0)
    Unit cur, nxt; int ui = 0;
    if (!S.next(0, cur)) return;
    f32x4 acc[2][2][4][2];
#pragma unroll
    for (int a = 0; a < 2; ++a)
#pragma unroll
        for (int b = 0; b < 2; ++b)
#pragma unroll
            for (int m = 0; m < 4; ++m)
#pragma unroll
                for (int n = 0; n < 2; ++n) acc[a][b][m][n] = (f32x4){0.f, 0.f, 0.f, 0.f};
    bf16x8 At[4][2], B0[2][2], B1[2][2];
    const char* cA = (const char*)(cur.z ? g.A1 : g.A) + (size_t)cur.pm * tstep; const char* cB = (const char*)(cur.z ? g.Bt1 : g.Bt) + (size_t)cur.pn * tstep;
    S.a_ready(cur);
    if constexpr (SP2) {
        PG8_STAGE(PG8_SB(0, 0), cB, voffB); PG8_STAGE(PG8_SB(0, 1), cB + hstep, voffB); PG8_STAGE(PG8_SA(0, 0), cA, voffA); PG8_STAGE(PG8_SA(0, 1), cA + hstep, voffA);
        if (wr == 1) PG8_BAR;
        PG8_WAIT_V(2); PG8_BAR;
        PG8_STAGE(PG8_SB(1, 0), cB + kstep, voffB); PG8_STAGE(PG8_SA(1, 0), cA + kstep, voffA); PG8_STAGE(PG8_SB(1, 1), cB + hstep + kstep, voffB);
        PG8_WAIT_V(6); PG8_BAR;
    } else {
        PG8_STAGE(PG8_SB(0, 0), cB, voffB); PG8_STAGE(PG8_SA(0, 0), cA, voffA); PG8_STAGE(PG8_SB(0, 1), cB + hstep, voffB); PG8_STAGE(PG8_SA(0, 1), cA + hstep, voffA);
        if (wr == 1) PG8_BAR;
        PG8_WAIT_V(4); PG8_BAR;
        PG8_STAGE(PG8_SB(1, 0), cB + kstep, voffB); PG8_STAGE(PG8_SA(1, 0), cA + kstep, voffA); PG8_STAGE(PG8_SB(1, 1), cB + hstep + kstep, voffB);
        PG8_WAIT_V(6); PG8_BAR;
    }
    for (;;) {
        const bool has_next = S.next(ui + 1, nxt);
        const char* nA = has_next ? (const char*)(nxt.z ? g.A1 : g.A) + (size_t)nxt.pm * tstep : cA; const char* nB = has_next ? (const char*)(nxt.z ? g.Bt1 : g.Bt) + (size_t)nxt.pn * tstep : cB;
        for (int t = 0; t < nt; t += 2) {
            const bool last = (t == nt - 2);
            const char* a1 = cA + (size_t)(t + 1) * kstep;
            const char* a2 = last ? nA : cA + (size_t)(t + 2) * kstep; const char* b2 = last ? nB : cB + (size_t)(t + 2) * kstep;
            const char* a3 = a2 + kstep; const char* b3 = b2 + kstep;
            if (last && has_next) S.a_ready(nxt);
            if constexpr (SP2) {
            PG8_LDB(B0, 0, 0); PG8_LDB(B1, 0, 1); PG8_SCHED; PG8_LDA(At, 0, 0); PG8_STAGE(PG8_SA(1, 1), a1 + hstep, voffA);
            PG8_WAIT_V(8); PG8_WAIT_L(0); PG8_BAR; PG8_MMA(0, 0, At, B0); PG8_MMA(0, 1, At, B1); PG8_BAR; PG8_SCHED;
            PG8_LDA(At, 0, 1); PG8_STAGE(PG8_SB(0, 0), b2, voffB); PG8_STAGE(PG8_SB(0, 1), b2 + hstep, voffB); PG8_STAGE(PG8_SA(0, 0), a2, voffA);
            PG8_WAIT_V(8); PG8_WAIT_L(0); PG8_BAR; PG8_MMA(1, 0, At, B0); PG8_MMA(1, 1, At, B1); PG8_BAR; PG8_SCHED;
            PG8_LDB(B0, 1, 0); PG8_LDB(B1, 1, 1); PG8_SCHED; PG8_LDA(At, 1, 0); PG8_STAGE(PG8_SA(0, 1), a2 + hstep, voffA);
            PG8_WAIT_V(8); PG8_WAIT_L(0); PG8_BAR; PG8_MMA(0, 0, At, B0); PG8_MMA(0, 1, At, B1); PG8_BAR; PG8_SCHED;
            PG8_LDA(At, 1, 1); PG8_STAGE(PG8_SB(1, 0), b3, voffB); PG8_STAGE(PG8_SB(1, 1), b3 + hstep, voffB); PG8_STAGE(PG8_SA(1, 0), a3, voffA);
            PG8_WAIT_V(8); PG8_WAIT_L(0); PG8_BAR; PG8_MMA(1, 0, At, B0); PG8_MMA(1, 1, At, B1); PG8_BAR; PG8_SCHED;
            } else {
            PG8_LDB(B0, 0, 0); PG8_SCHED; PG8_LDA(At, 0, 0); PG8_STAGE(PG8_SA(1, 1), a1 + hstep, voffA);
            PG8_WAIT_L(8); PG8_BAR; PG8_WAIT_L(0); PG8_MMA(0, 0, At, B0); PG8_BAR; PG8_SCHED;
            PG8_LDB(B1, 0, 1); PG8_STAGE(PG8_SB(0, 0), b2, voffB);
            PG8_BAR; PG8_WAIT_L(0); PG8_MMA(0, 1, At, B1); PG8_BAR;
            PG8_LDA(At, 0, 1); PG8_STAGE(PG8_SA(0, 0), a2, voffA);
            PG8_BAR; PG8_WAIT_L(0); PG8_MMA(1, 0, At, B0); PG8_BAR; PG8_SCHED;
            PG8_STAGE(PG8_SB(0, 1), b2 + hstep, voffB);
            PG8_WAIT_V(6); PG8_BAR; PG8_MMA(1, 1, At, B1); PG8_BAR;
            PG8_LDB(B0, 1, 0); PG8_SCHED; PG8_LDA(At, 1, 0); PG8_STAGE(PG8_SA(0, 1), a2 + hstep, voffA);
            PG8_WAIT_L(8); PG8_BAR; PG8_WAIT_L(0); PG8_MMA(0, 0, At, B0); PG8_BAR; PG8_SCHED;
            PG8_LDB(B1, 1, 1); PG8_STAGE(PG8_SB(1, 0), b3, voffB);
            PG8_BAR; PG8_WAIT_L(0); PG8_MMA(0, 1, At, B1); PG8_BAR;
            PG8_LDA(At, 1, 1); PG8_STAGE(PG8_SA(1, 0), a3, voffA);
            PG8_BAR; PG8_WAIT_L(0); PG8_MMA(1, 0, At, B0); PG8_BAR; PG8_SCHED;
            PG8_STAGE(PG8_SB(1, 1), b3 + hstep, voffB);
            PG8_WAIT_V(6); PG8_BAR; PG8_MMA(1, 1, At, B1); PG8_BAR;
            }
        }
        if constexpr (ALIGN_EPI) { if (wr == 0) PG8_BAR; }
        bool keep_acc = false; if constexpr (!Epi::AFTER_DRAIN) { keep_acc = E(acc, cur, wr, wc, fr, fq); S.done(cur); }
        if (!has_next) break;
        if (!keep_acc) {
#pragma unroll
        for (int a = 0; a < 2; ++a)
#pragma unroll
            for (int b = 0; b < 2; ++b)
#pragma unroll
                for (int m = 0; m < 4; ++m)
#pragma unroll
                    for (int n = 0; n < 2; ++n) acc[a][b][m][n] = (f32x4){0.f, 0.f, 0.f, 0.f};
        }
        cur = nxt; cA = nA; cB = nB; ++ui;
        if constexpr (ALIGN_EPI) { if (wr == 1) PG8_BAR; }
    }
    PG8_WAIT_V(0);
    if constexpr (!ALIGN_EPI) { if (wr == 0) PG8_BAR; }
    PG8_BAR;
    if constexpr (Epi::AFTER_DRAIN) { E.fused(acc, cur, wr, wc, fr, fq, lds, wid, lane); S.done(cur); }
#undef PG8_SA
#undef PG8_SB
#undef PG8_STAGE
#undef PG8_LDA
#undef PG8_LDB
#undef PG8_MMA
#undef PG8_WAIT_V
#undef PG8_WAIT_L
#undef PG8_BAR
#undef PG8_SCHED
}
}

#define LAS __attribute__((address_space(3)))
typedef unsigned short bf16;
typedef float f32x4 __attribute__((ext_vector_type(4)));
typedef unsigned v4u __attribute__((ext_vector_type(4)));
constexpr int NWAVES = 8, NTHR = 512;
constexpr int MTOK = 32768, DM = 1024, SEQ = 2048, NBATCH = 16, NIN = 8192, DFF = 4096, HYW = 512, HALF_TOK = 16384;
constexpr size_t MiB = (size_t)1 << 20;
constexpr size_t WS_SSQA = 0, WS_SSQB = 2 * MiB, WS_ROPE = 4 * MiB, WS_BAR = 4 * MiB + 768 * 1024, WS_LSE = 5 * MiB, WS_GF = 8 * MiB, WS_W = 16 * MiB, WS_XB = 52 * MiB,
                 WS_HY = 116 * MiB, WS_UT = 212 * MiB, WS_GATES = 116 * MiB, WS_Q = 244 * MiB, WS_KV = 340 * MiB, WS_YHY = 436 * MiB, WS_YATT = 404 * MiB, WS_X0T = 468 * MiB,
                 WS_MERGED = 340 * MiB, WS_H = 116 * MiB, WS_END = 500 * MiB;
constexpr size_t W_IN = 0, W_PHY = 16 * MiB, W_PATT = 17 * MiB, W_O = 18 * MiB, W_FF1 = 20 * MiB, W_FF2 = 28 * MiB;
constexpr int LDS_ST_OFF = 135168;
constexpr int LDS_BYTES = 139264;

struct Args {
    const float* in[19]; float* out; unsigned char* ws; int pad0, pad1;
};

__device__ __forceinline__ unsigned f2bf(float f) { unsigned u = __float_as_uint(f); return (u + 0x7fffu + ((u >> 16) & 1u)) >> 16; }
__device__ __forceinline__ unsigned pk2(float lo, float hi) { return f2bf(lo) | (f2bf(hi) << 16); }
__device__ __forceinline__ float bf2f(unsigned short b) { return __uint_as_float((unsigned)b << 16); }
__device__ __forceinline__ float wave_sum(float v) {
#pragma unroll
    for (int o = 1; o < 64; o <<= 1) v += __shfl_xor(v, o);
    return v;
}

__device__ __forceinline__ int win_src_col(int n) {
    const int t = n >> 8, j = n & 255;
    if (t < 6) return n;
    if (t >= 24) return 6144 + (n - 6144);
    int g, w, half;
    if (t < 12) { const int i = t - 6; g = i >> 1; w = 0; half = i & 1; }
    else { const int i = t - 12; g = i >> 2; w = 1 + ((i >> 1) & 1); half = i & 1; }
    int hh, d;
    if (w == 2) { hh = j >> 6; d = j & 63; }
    else { hh = (j & 127) >> 5; d = (j & 31) + ((j >> 7) << 5); }
    return 1536 + g * 1536 + w * 512 + (half * 4 + hh) * 64 + d;
}

__device__ __forceinline__ void transpose_item(const float* W, int K, int Nsrc, int s0, bf16* WT, int n0, int k0, const float* gain, LAS float* scr, int lane) {
#pragma unroll 8
    for (int i = 0; i < 32; ++i) { const int kk = 2 * i + (lane >> 5); float v = W[(size_t)(k0 + kk) * Nsrc + s0 + (lane & 31)]; if (gain) v *= gain[k0 + kk]; scr[kk * 33 + (lane & 31)] = v; }
    asm volatile("s_waitcnt lgkmcnt(0)" ::: "memory");
    const int c = lane & 7;
#pragma unroll
    for (int j = 0; j < 4; ++j) { const int n = (lane >> 3) + 8 * j; const LAS float* s = scr + (8 * c) * 33 + n;
        v4u o; o.x = pk2(s[0 * 33], s[1 * 33]); o.y = pk2(s[2 * 33], s[3 * 33]); o.z = pk2(s[4 * 33], s[5 * 33]); o.w = pk2(s[6 * 33], s[7 * 33]);
        *(v4u*)(WT + (size_t)(n0 + n) * K + k0 + 8 * c) = o; }
    asm volatile("s_waitcnt lgkmcnt(0)" ::: "memory");
}

__device__ __forceinline__ void phase_prep_weights(const Args& a, int L, LAS unsigned char* lds, int tid, int lane, int wave, int G) {
    unsigned char* ws = a.ws;
    {
        LAS float* z = (LAS float*)lds; LAS float* h0 = z + 64; LAS float* h1 = z + 128;
        const float* w1 = a.in[5] + (size_t)L * 33 * 64; const float* b1 = a.in[6] + L * 64;
        const float* wi = a.in[7] + (size_t)L * 2 * 64 * 64; const float* bi = a.in[8] + L * 2 * 64;
        const float* wout = a.in[9] + (size_t)L * 64 * 1024; const float* fr = a.in[10] + L * 64; const float* skip = a.in[11] + L * 512;
        bf16* Rg = (bf16*)(ws + WS_GF);
        const float min_decay = logf(1e-2f) / 1.5f, max_decay = logf(1e-2f) / 0.3f;
        for (int n = blockIdx.x; n < SEQ; n += G) {
            const float t = (float)n / 2047.0f;
            if (tid < 33) {
                float v;
                if (tid == 0) v = t;
                else { const int k = (tid - 1) & 15; const float band = 1e-4f + (float)k * ((15.0f - 1e-4f) / 15.0f); const float ang = ((float)(2.0 * 3.14159265358979323846 / 2048.0) * (float)n) * band;
                       v = (tid <= 16) ? cosf(ang) : -sinf(ang); }
                z[tid] = v;
            }
            __syncthreads();
            if (tid < 64) { float s = 0.f;
_Pragma("unroll 3")
 for (int e = 0; e < 33; ++e) s += z[e] * w1[e * 64 + tid]; h0[tid] = sinf(fr[tid] * (s + b1[tid])); }
            __syncthreads();
            if (tid < 64) { float s = 0.f;
_Pragma("unroll 4")
 for (int e = 0; e < 64; ++e) s += h0[e] * wi[e * 64 + tid]; h1[tid] = sinf(fr[tid] * (s + bi[tid])); }
            __syncthreads();
            if (tid < 64) { float s = 0.f;
_Pragma("unroll 4")
 for (int e = 0; e < 64; ++e) s += h1[e] * wi[4096 + e * 64 + tid]; h0[tid] = sinf(fr[tid] * (s + bi[64 + tid])); }
            __syncthreads();
            for (int col = tid; col < 1024; col += NTHR) {
                float s = 0.f;
_Pragma("unroll 4")
 for (int e = 0; e < 64; ++e) s += h0[e] * wout[e * 1024 + col];
                const int c = col & 511, dir = col >> 9;
                const float delta = fabsf(min_decay + (float)c * ((max_decay - min_decay) / 511.0f));
                float val = s * expf(-t * delta);
                int x = -1;
                if (dir == 0) { if (n == 0) val += skip[c]; x = 2048 - n; } else if (n > 0) x = 2048 + n;
                if (x >= 0) { const bf16 hv = (bf16)f2bf(val); Rg[((size_t)c * 2 + 0) * 4096 + x] = hv; Rg[((size_t)c * 2 + 1) * 4096 + x - 1] = hv; }
            }
            __syncthreads();
        }
    }
    {
        LAS float* scr = (LAS float*)(lds + 1024 + wave * 8704);
        const int gw = blockIdx.x * NWAVES + wave, NGW = G * NWAVES;
        bf16* Wb = (bf16*)(ws + WS_W);
        const float* w_in = a.in[2] + (size_t)L * DM * NIN; const float* p_hy = a.in[12] + (size_t)L * 512 * DM; const float* p_att = a.in[13] + (size_t)L * 512 * DM;
        const float* w_o = a.in[14] + (size_t)L * DM * DM; const float* w1 = a.in[16] + (size_t)L * DM * DFF; const float* w2 = a.in[17] + (size_t)L * DFF * DM;
        const float* g_mix = a.in[1] + L * DM; const float* g_ffn = a.in[15] + L * DM;
        constexpr int I_IN = 16 * 256, I_P = 8 * 32, I_O = 16 * 32, I_1 = 16 * 128, I_2 = 64 * 32;
        constexpr int NITEMS = I_IN + 2 * I_P + I_O + I_1 + I_2;
        for (int it = gw; it < NITEMS; it += NGW) {
            int r = it;
            if (r < I_IN) { const int kb = r / 256, nb = r % 256; transpose_item(w_in, DM, NIN, win_src_col(nb * 32), Wb + W_IN / 2, nb * 32, kb * 64, g_mix, scr, lane); continue; } r -= I_IN;
            if (r < I_P) { const int kb = r / 32, nb = r % 32; transpose_item(p_hy, 512, DM, nb * 32, Wb + W_PHY / 2, nb * 32, kb * 64, nullptr, scr, lane); continue; } r -= I_P;
            if (r < I_P) { const int kb = r / 32, nb = r % 32; transpose_item(p_att, 512, DM, nb * 32, Wb + W_PATT / 2, nb * 32, kb * 64, nullptr, scr, lane); continue; } r -= I_P;
            if (r < I_O) { const int kb = r / 32, nb = r % 32; transpose_item(w_o, DM, DM, nb * 32, Wb + W_O / 2, nb * 32, kb * 64, nullptr, scr, lane); continue; } r -= I_O;
            if (r < I_1) { const int kb = r / 128, nb = r % 128; transpose_item(w1, DM, DFF, nb * 32, Wb + W_FF1 / 2, nb * 32, kb * 64, g_ffn, scr, lane); continue; } r -= I_1;
            { const int kb = r / 32, nb = r % 32; transpose_item(w2, DFF, DM, nb * 32, Wb + W_FF2 / 2, nb * 32, kb * 64, nullptr, scr, lane); }
        }
        if (L == 0) {
            const float* x = a.in[0]; bf16* xb = (bf16*)(ws + WS_XB); float* ssq = (float*)(ws + WS_SSQA);
            for (int m = gw; m < MTOK; m += NGW) {
                const f32x4* xr = (const f32x4*)(x + (size_t)m * DM) + lane;
                f32x4 v[4]; float s = 0.f;
#pragma unroll
                for (int j = 0; j < 4; ++j) { v[j] = xr[64 * j]; s += (v[j][0] * v[j][0] + v[j][1] * v[j][1]) + (v[j][2] * v[j][2] + v[j][3] * v[j][3]); }
                s = wave_sum(s);
                unsigned long long* o8 = (unsigned long long*)(xb + (size_t)m * DM) + lane;
#pragma unroll
                for (int j = 0; j < 4; ++j) o8[64 * j] = (unsigned long long)pk2(v[j][0], v[j][1]) | ((unsigned long long)pk2(v[j][2], v[j][3]) << 32);
                if (lane < 16) ssq[(size_t)m * 16 + lane] = (lane == 0) ? s : 0.f;
            }
            float* rc = (float*)(ws + WS_ROPE); float* rsn = rc + 65536;
            for (int i = blockIdx.x * NTHR + tid; i < 65536; i += G * NTHR) {
                const int pos = i >> 5, f = i & 31;
                const float inv = powf(10000.0f, -(float)f / 32.0f);
                const float ang = (float)pos * inv;
                rc[i] = cosf(ang); rsn[i] = sinf(ang);
            }
        }
    }
}

__device__ __forceinline__ void phase_prep_u(const Args& a, int L, LAS unsigned char* lds, int tid, int G) {
    const bf16* hy = (const bf16*)(a.ws + WS_HY); bf16* ut = (bf16*)(a.ws + WS_UT); bf16* x0t = (bf16*)(a.ws + WS_X0T);
    const float* cw = a.in[3] + (size_t)L * 3 * 1536; const float* cb = a.in[4] + L * 1536;
    LAS unsigned short* tile = (LAS unsigned short*)lds;
    for (int item = blockIdx.x; item < 4096; item += G) {
        const int cc = item & 7, mc = (item >> 3) & 31, b = item >> 8;
        const int cl = tid & 63, mr = tid >> 6, c = cc * 64 + cl;
        const float w10 = cw[512 + c], w11 = cw[1536 + 512 + c], w12 = cw[3072 + 512 + c], b1 = cb[512 + c];
        const float wv0 = cw[1024 + c], wv1 = cw[1536 + 1024 + c], wv2 = cw[3072 + 1024 + c], bv = cb[1024 + c];
        const float w00 = cw[c], w01 = cw[1536 + c], w02 = cw[3072 + c], b0 = cb[c];
#pragma unroll
        for (int p = 0; p < 8; ++p) {
            const int ml = p * 8 + mr, m = mc * 64 + ml;
            const bf16* r = hy + (size_t)(b * SEQ + m) * 1536;
            const float x1m = (m > 0) ? bf2f(r[-1536 + 512 + c]) : 0.f, x1c = bf2f(r[512 + c]), x1p = (m < SEQ - 1) ? bf2f(r[1536 + 512 + c]) : 0.f;
            const float vm = (m > 0) ? bf2f(r[-1536 + 1024 + c]) : 0.f, vc = bf2f(r[1024 + c]), vp = (m < SEQ - 1) ? bf2f(r[1536 + 1024 + c]) : 0.f;
            const float u1 = b1 + w10 * x1m + w11 * x1c + w12 * x1p;
            const float uv = bv + wv0 * vm + wv1 * vc + wv2 * vp;
            tile[cl * 72 + ml] = (unsigned short)f2bf(u1 * uv);
            const float x0m = (m > 0) ? bf2f(r[-1536 + c]) : 0.f, x0c = bf2f(r[c]), x0p = (m < SEQ - 1) ? bf2f(r[1536 + c]) : 0.f;
            tile[4608 + cl * 72 + ml] = (unsigned short)f2bf(b0 + w00 * x0m + w01 * x0c + w02 * x0p);
        }
        __syncthreads();
        {
            const int c2 = tid >> 3, ch = tid & 7;
            const LAS unsigned short* s = tile + c2 * 72 + ch * 8;
            v4u o; o.x = s[0] | ((unsigned)s[1] << 16); o.y = s[2] | ((unsigned)s[3] << 16); o.z = s[4] | ((unsigned)s[5] << 16); o.w = s[6] | ((unsigned)s[7] << 16);
            *(v4u*)(ut + ((size_t)(cc * 64 + c2) * NBATCH + b) * SEQ + mc * 64 + ch * 8) = o;
            const LAS unsigned short* s2 = s + 4608;
            v4u o2; o2.x = s2[0] | ((unsigned)s2[1] << 16); o2.y = s2[2] | ((unsigned)s2[3] << 16); o2.z = s2[4] | ((unsigned)s2[5] << 16); o2.w = s2[6] | ((unsigned)s2[7] << 16);
            *(v4u*)(x0t + ((size_t)(cc * 64 + c2) * NBATCH + b) * SEQ + mc * 64 + ch * 8) = o2;
        }
        __syncthreads();
    }
}

__device__ __forceinline__ void phase_hyena_naive(const Args& a, int L, LAS unsigned char* lds, int tid, int G) {
    const bf16* hy = (const bf16*)(a.ws + WS_HY); const bf16* ut = (const bf16*)(a.ws + WS_UT); const float* Gf = (const float*)(a.ws + WS_GF);
    bf16* yhy = (bf16*)(a.ws + WS_YHY);
    const float* cw = a.in[3] + (size_t)L * 3 * 1536; const float* cb = a.in[4] + L * 1536;
    LAS float* Gs = (LAS float*)lds;
    LAS float* Us = Gs + 4096;
    for (int item = blockIdx.x; item < 2048; item += G) {
        const int c = item >> 2, bq = item & 3;
        for (int i = tid; i < 4096; i += NTHR) Gs[i] = (i == 0) ? 0.f : Gf[(size_t)c * 4096 + i];
        for (int i = tid; i < 8192; i += NTHR) { const int bl = i >> 11, m = i & 2047; Us[i] = bf2f(ut[((size_t)c * NBATCH + bq * 4 + bl) * SEQ + m]); }
        __syncthreads();
        const int bl = tid >> 7, tn = tid & 127;
        float acc[16];
#pragma unroll
        for (int i = 0; i < 16; ++i) acc[i] = 0.f;
        const LAS float* up = Us + bl * 2048;
        for (int m = 0; m < SEQ; ++m) {
            const float u = up[m];
            const LAS float* gp = Gs + (tn - m + 2048);
#pragma unroll
            for (int i = 0; i < 16; ++i) acc[i] += gp[128 * i] * u;
        }
        const int b = bq * 4 + bl;
        const float w0 = cw[c], w1 = cw[1536 + c], w2 = cw[3072 + c], b0 = cb[c];
#pragma unroll
        for (int i = 0; i < 16; ++i) {
            const int n = tn + 128 * i;
            const bf16* r = hy + (size_t)(b * SEQ + n) * 1536 + c;
            const float xm = (n > 0) ? bf2f(r[-1536]) : 0.f, xc = bf2f(r[0]), xp = (n < SEQ - 1) ? bf2f(r[1536]) : 0.f;
            const float x0 = b0 + w0 * xm + w1 * xc + w2 * xp;
            yhy[(size_t)(b * SEQ + n) * 512 + c] = (bf16)f2bf(x0 * acc[i]);
        }
        __syncthreads();
    }
}

__device__ __forceinline__ void phase_attn_naive(const Args& a, int half, int tid, int G) {
    bf16* Q = (bf16*)(a.ws + WS_Q); const bf16* KV = (const bf16*)(a.ws + WS_KV); float* lse = (float*)(a.ws + WS_LSE);
    for (int idx = blockIdx.x * NTHR + tid; idx < 3 * 8 * HALF_TOK; idx += G * NTHR) {
        const int g = idx / (8 * HALF_TOK), t = idx % (8 * HALF_TOK), h = t / HALF_TOK, tokl = t % HALF_TOK;
        const int dil = (g == 0) ? 1 : (g == 1 ? 4 : 16);
        const int token = half * HALF_TOK + tokl, s = token & 2047;
        bf16* qp = Q + (size_t)token * 1536 + g * 512 + h * 64;
        float q[64], o[64];
#pragma unroll
        for (int i = 0; i < 8; ++i) { const v4u w = *(const v4u*)(qp + 8 * i);
            q[8 * i + 0] = __uint_as_float(w.x << 16); q[8 * i + 1] = __uint_as_float(w.x & 0xffff0000u); q[8 * i + 2] = __uint_as_float(w.y << 16); q[8 * i + 3] = __uint_as_float(w.y & 0xffff0000u);
            q[8 * i + 4] = __uint_as_float(w.z << 16); q[8 * i + 5] = __uint_as_float(w.z & 0xffff0000u); q[8 * i + 6] = __uint_as_float(w.w << 16); q[8 * i + 7] = __uint_as_float(w.w & 0xffff0000u); }
#pragma unroll
        for (int i = 0; i < 64; ++i) o[i] = 0.f;
        float mx = -1e30f, l = 0.f;
        for (int j = -64; j <= 64; ++j) {
            const int sp = s + j * dil;
            if (sp < 0 || sp >= SEQ) continue;
            const bf16* kp = KV + (size_t)(tokl + j * dil) * 3072 + g * 1024 + h * 64;
            float sc = 0.f;
#pragma unroll
            for (int i = 0; i < 8; ++i) { const v4u w = *(const v4u*)(kp + 8 * i);
                sc += q[8 * i + 0] * __uint_as_float(w.x << 16) + q[8 * i + 1] * __uint_as_float(w.x & 0xffff0000u) + q[8 * i + 2] * __uint_as_float(w.y << 16) + q[8 * i + 3] * __uint_as_float(w.y & 0xffff0000u)
                    + q[8 * i + 4] * __uint_as_float(w.z << 16) + q[8 * i + 5] * __uint_as_float(w.z & 0xffff0000u) + q[8 * i + 6] * __uint_as_float(w.w << 16) + q[8 * i + 7] * __uint_as_float(w.w & 0xffff0000u); }
            const float mn = fmaxf(mx, sc), corr = exp2f(mx - mn), p = exp2f(sc - mn);
            l = l * corr + p; mx = mn;
            const bf16* vp = kp + 512;
#pragma unroll
            for (int i = 0; i < 8; ++i) { const v4u w = *(const v4u*)(vp + 8 * i);
                o[8 * i + 0] = o[8 * i + 0] * corr + p * __uint_as_float(w.x << 16); o[8 * i + 1] = o[8 * i + 1] * corr + p * __uint_as_float(w.x & 0xffff0000u);
                o[8 * i + 2] = o[8 * i + 2] * corr + p * __uint_as_float(w.y << 16); o[8 * i + 3] = o[8 * i + 3] * corr + p * __uint_as_float(w.y & 0xffff0000u);
                o[8 * i + 4] = o[8 * i + 4] * corr + p * __uint_as_float(w.z << 16); o[8 * i + 5] = o[8 * i + 5] * corr + p * __uint_as_float(w.z & 0xffff0000u);
                o[8 * i + 6] = o[8 * i + 6] * corr + p * __uint_as_float(w.w << 16); o[8 * i + 7] = o[8 * i + 7] * corr + p * __uint_as_float(w.w & 0xffff0000u); }
        }
        const float inv = 1.0f / l;
#pragma unroll
        for (int i = 0; i < 8; ++i) { v4u w; w.x = pk2(o[8 * i] * inv, o[8 * i + 1] * inv); w.y = pk2(o[8 * i + 2] * inv, o[8 * i + 3] * inv); w.z = pk2(o[8 * i + 4] * inv, o[8 * i + 5] * inv); w.w = pk2(o[8 * i + 6] * inv, o[8 * i + 7] * inv);
            *(v4u*)(qp + 8 * i) = w; }
        lse[((size_t)g * MTOK + token) * 8 + h] = mx + log2f(l);
    }
}

__device__ __forceinline__ void phase_combine(const Args& a, int tid, int G) {
    const bf16* Q = (const bf16*)(a.ws + WS_Q); const float* lse = (const float*)(a.ws + WS_LSE); bf16* ya = (bf16*)(a.ws + WS_YATT);
    for (int idx = blockIdx.x * NTHR + tid; idx < MTOK * 64; idx += G * NTHR) {
        const int token = idx >> 6, ch = idx & 63, h = ch >> 3;
        const float l0 = lse[((size_t)0 * MTOK + token) * 8 + h], l1 = lse[((size_t)1 * MTOK + token) * 8 + h], l2 = lse[((size_t)2 * MTOK + token) * 8 + h];
        const float mx = fmaxf(l0, fmaxf(l1, l2));
        float w0 = exp2f(l0 - mx), w1 = exp2f(l1 - mx), w2 = exp2f(l2 - mx);
        const float inv = 1.0f / (w0 + w1 + w2); w0 *= inv; w1 *= inv; w2 *= inv;
        const bf16* p = Q + (size_t)token * 1536 + ch * 8;
        const v4u a0 = *(const v4u*)p, a1 = *(const v4u*)(p + 512), a2 = *(const v4u*)(p + 1024);
        v4u o;
#define CMB(f) pk2(w0 * __uint_as_float(a0.f << 16) + w1 * __uint_as_float(a1.f << 16) + w2 * __uint_as_float(a2.f << 16), \
                   w0 * __uint_as_float(a0.f & 0xffff0000u) + w1 * __uint_as_float(a1.f & 0xffff0000u) + w2 * __uint_as_float(a2.f & 0xffff0000u))
        o.x = CMB(x); o.y = CMB(y); o.z = CMB(z); o.w = CMB(w);
#undef CMB
        *(v4u*)(ya + (size_t)token * 512 + ch * 8) = o;
    }
}

__device__ __forceinline__ void phase_final_norm(const Args& a, int lane, int wave, int G) {
    float* x = a.out; const float* gain = a.in[18];
    const int gw = blockIdx.x * NWAVES + wave, NGW = G * NWAVES;
    for (int m = gw; m < MTOK; m += NGW) {
        f32x4* xr = (f32x4*)(x + (size_t)m * DM) + lane;
        f32x4 v[4]; float s = 0.f;
#pragma unroll
        for (int j = 0; j < 4; ++j) { v[j] = xr[64 * j]; s += (v[j][0] * v[j][0] + v[j][1] * v[j][1]) + (v[j][2] * v[j][2] + v[j][3] * v[j][3]); }
        s = wave_sum(s);
        const float rs = 1.0f / sqrtf(s * (1.0f / 1024.0f) + 1e-6f);
#pragma unroll
        for (int j = 0; j < 4; ++j) { const f32x4 gn = *((const f32x4*)gain + lane + 64 * j); xr[64 * j] = v[j] * rs * gn; }
    }
}

typedef short bf16x8 __attribute__((ext_vector_type(8)));
typedef short s16x4 __attribute__((ext_vector_type(4)));
constexpr int HY_UROW = 4112, HY_ROFF = 16 * HY_UROW, HY_RSTRIDE = 8192 + 64;
__device__ __forceinline__ bf16x8 ld_frag4(const LAS unsigned char* p) {
    const LAS unsigned* q = (const LAS unsigned*)p; v4u d; d.x = q[0]; d.y = q[1]; d.z = q[2]; d.w = q[3]; return __builtin_bit_cast(bf16x8, d);
}
__device__ __forceinline__ void phase_hyena_mfma(const Args& a, LAS unsigned char* lds, int tid, int G) {
    const bf16* ut = (const bf16*)(a.ws + WS_UT); const bf16* Rg = (const bf16*)(a.ws + WS_GF); bf16* x0t = (bf16*)(a.ws + WS_X0T);
    const int lane = tid & 63, w = __builtin_amdgcn_readfirstlane(tid >> 6), i16 = lane & 15, kq = lane >> 4;
    const int base = (w >> 1) * 512 + (w & 1) * 16, cp = i16 & 1;
    const int lane_const = (2048 - base - i16 + 8 * kq - cp) >> 1;
    const LAS unsigned char* pA15 = lds + HY_ROFF + cp * HY_RSTRIDE + 4 * (lane_const - 240);
    const LAS unsigned char* pB = lds + i16 * HY_UROW + kq * 16;
    for (int ch = blockIdx.x; ch < HYW; ch += G) {
        for (int i = tid; i < 4096; i += NTHR) { const int b = i >> 8, ck = i & 255; *(LAS v4u*)(lds + b * HY_UROW + ck * 16) = *(const v4u*)(ut + ((size_t)ch * NBATCH + b) * SEQ + ck * 8); }
        for (int i = tid; i < 1024; i += NTHR) { const int c2 = i >> 9, ck = i & 511; *(LAS v4u*)(lds + HY_ROFF + c2 * HY_RSTRIDE + ck * 16) = *(const v4u*)(Rg + ((size_t)ch * 2 + c2) * 4096 + ck * 8); }
        __syncthreads();
        f32x4 acc[16]; bf16x8 W[16];
#pragma unroll
        for (int i = 0; i < 16; ++i) acc[i] = (f32x4){0.f, 0.f, 0.f, 0.f};
#pragma unroll
        for (int j = 1; j < 16; ++j) W[j] = ld_frag4(pA15 + 64 * (15 - j));
        W[0] = W[1];
#pragma unroll 1
        for (int tt = 0; tt < 4; ++tt) {
            const LAS unsigned char* pa = pA15 + 64 * 15 + 1024 * tt; const LAS unsigned char* pb = pB + 1024 * tt;
#pragma unroll
            for (int s = 0; s < 16; ++s) {
                W[(16 - s) & 15] = ld_frag4(pa + 64 * s);
                const bf16x8 Bf = *(const LAS bf16x8*)(pb + 64 * s);
#pragma unroll
                for (int i = 0; i < 16; ++i) acc[i] = __builtin_amdgcn_mfma_f32_16x16x32_bf16(W[(i - s) & 15], Bf, acc[i], 0, 0, 0);
            }
        }
        bf16* xo = x0t + ((size_t)ch * NBATCH + i16) * SEQ + base + 4 * kq;
#pragma unroll
        for (int i = 0; i < 16; ++i) {
            typedef unsigned u32x2v __attribute__((ext_vector_type(2)));
            const u32x2v xv = *(const u32x2v*)(xo + 32 * i);
            u32x2v o; o.x = pk2(__uint_as_float(xv.x << 16) * acc[i][0], __uint_as_float(xv.x & 0xffff0000u) * acc[i][1]);
            o.y = pk2(__uint_as_float(xv.y << 16) * acc[i][2], __uint_as_float(xv.y & 0xffff0000u) * acc[i][3]);
            *(u32x2v*)(xo + 32 * i) = o;
        }
        __syncthreads();
    }
}

__device__ __forceinline__ void phase_transpose_y(const Args& a, LAS unsigned char* lds, int tid, int G) {
    const bf16* yt = (const bf16*)(a.ws + WS_X0T); bf16* yhy = (bf16*)(a.ws + WS_YHY);
    LAS unsigned short* tile = (LAS unsigned short*)lds;
    for (int item = blockIdx.x; item < 4096; item += G) {
        const int cc = item & 7, mc = (item >> 3) & 31, b = item >> 8;
        { const int c2 = tid >> 3, ck = tid & 7;
          const v4u v = *(const v4u*)(yt + ((size_t)(cc * 64 + c2) * NBATCH + b) * SEQ + mc * 64 + ck * 8);
          LAS unsigned* t4 = (LAS unsigned*)(tile + c2 * 72 + ck * 8); t4[0] = v.x; t4[1] = v.y; t4[2] = v.z; t4[3] = v.w; }
        __syncthreads();
        { const int nl = tid >> 3, cg8 = tid & 7; const LAS unsigned short* s = tile + (cg8 * 8) * 72 + nl;
          v4u o; o.x = s[0] | ((unsigned)s[72] << 16); o.y = s[144] | ((unsigned)s[216] << 16); o.z = s[288] | ((unsigned)s[360] << 16); o.w = s[432] | ((unsigned)s[504] << 16);
          *(v4u*)(yhy + (size_t)(b * SEQ + mc * 64 + nl) * 512 + cc * 64 + cg8 * 8) = o; }
        __syncthreads();
    }
}

constexpr int AT_ROWS = 272, AT_RS = 144, AT_VOFF = AT_ROWS * AT_RS;
__device__ __forceinline__ void phase_attn_mfma(const Args& a, int half, LAS unsigned char* lds, int tid, int G) {
    bf16* Q = (bf16*)(a.ws + WS_Q); const bf16* KV = (const bf16*)(a.ws + WS_KV); float* lse = (float*)(a.ws + WS_LSE);
    const int lane = tid & 63, w = __builtin_amdgcn_readfirstlane(tid >> 6), q16 = lane & 15, kq = lane >> 4;
    for (int unit = blockIdx.x; unit < 3072; unit += G) {
        const int g = unit >> 10, u = unit & 1023, sub = u & 15, h = (u >> 4) & 7, bl = u >> 7;
        int dil, n, r, qb;
        if (g == 0) { dil = 1; n = 2048; r = 0; qb = sub; } else if (g == 1) { dil = 4; n = 512; r = sub >> 2; qb = sub & 3; } else { dil = 16; n = 128; r = sub; qb = 0; }
        const int q0 = qb * 128, kb0 = q0 - 64;
        for (int i = tid; i < 2 * AT_ROWS * 8; i += NTHR) {
            const int which = (i >= AT_ROWS * 8) ? 1 : 0, j = i - which * AT_ROWS * 8, rr = j >> 3, ck = j & 7, key = kb0 + rr;
            v4u v = (v4u){0u, 0u, 0u, 0u};
            if (key >= 0 && key < n) v = *(const v4u*)(KV + (size_t)(bl * SEQ + key * dil + r) * 3072 + g * 1024 + which * 512 + h * 64 + ck * 8);
            *(LAS v4u*)(lds + which * AT_VOFF + rr * AT_RS + ck * 16) = v;
        }
        __syncthreads();
        {
            const int i0 = q0 + 16 * w;
            const int token = half * HALF_TOK + bl * SEQ + (i0 + q16) * dil + r;
            bf16* qp = Q + (size_t)token * 1536 + g * 512 + h * 64;
            const bf16x8 Qf0 = *(const bf16x8*)(qp + 8 * kq), Qf1 = *(const bf16x8*)(qp + 32 + 8 * kq);
            f32x4 acc[4];
#pragma unroll
            for (int dt = 0; dt < 4; ++dt) acc[dt] = (f32x4){0.f, 0.f, 0.f, 0.f};
            float mrun = -1e30f, lrun = 0.f;
            const LAS unsigned char* kbase = lds + (16 * w + q16) * AT_RS + 16 * kq;
            const LAS unsigned char* vbase = lds + AT_VOFF + (16 * w + 4 * kq + (q16 >> 2)) * AT_RS + 8 * (q16 & 3);
#pragma unroll 1
            for (int st = 0; st < 5; ++st) {
                f32x4 s[2];
#pragma unroll
                for (int hh = 0; hh < 2; ++hh) {
                    const int kt = 2 * st + hh;
                    const LAS unsigned char* kp = kbase + kt * 16 * AT_RS;
                    const bf16x8 K0 = *(const LAS bf16x8*)kp, K1 = *(const LAS bf16x8*)(kp + 64);
                    f32x4 z = (f32x4){0.f, 0.f, 0.f, 0.f};
                    z = __builtin_amdgcn_mfma_f32_16x16x32_bf16(K0, Qf0, z, 0, 0, 0);
                    z = __builtin_amdgcn_mfma_f32_16x16x32_bf16(K1, Qf1, z, 0, 0, 0);
#pragma unroll
                    for (int e = 0; e < 4; ++e) {
                        const int rel = 16 * kt - 64 + 4 * kq + e - q16, j = i0 + q16 + rel;
                        const bool ok = (rel >= -64) && (rel <= 64) && (j >= 0) && (j < n);
                        z[e] = ok ? z[e] : -1e30f;
                    }
                    s[hh] = z;
                }
                float mx = fmaxf(fmaxf(fmaxf(s[0][0], s[0][1]), fmaxf(s[0][2], s[0][3])), fmaxf(fmaxf(s[1][0], s[1][1]), fmaxf(s[1][2], s[1][3])));
                mx = fmaxf(mx, __shfl_xor(mx, 16)); mx = fmaxf(mx, __shfl_xor(mx, 32));
                const float mn = fmaxf(mrun, mx), corr = exp2f(mrun - mn);
                mrun = mn;
                float p[8], ps = 0.f;
#pragma unroll
                for (int e = 0; e < 4; ++e) { p[e] = exp2f(s[0][e] - mn); p[4 + e] = exp2f(s[1][e] - mn); ps += p[e] + p[4 + e]; }
                lrun = lrun * corr + ps;
                v4u pw; pw.x = pk2(p[0], p[1]); pw.y = pk2(p[2], p[3]); pw.z = pk2(p[4], p[5]); pw.w = pk2(p[6], p[7]);
                const bf16x8 Pf = __builtin_bit_cast(bf16x8, pw);
#pragma unroll
                for (int dt = 0; dt < 4; ++dt) {
                    const LAS unsigned char* vp = vbase + 32 * st * AT_RS + 32 * dt;
                    const s16x4 v0 = __builtin_amdgcn_ds_read_tr16_b64_v4i16((LAS s16x4*)vp);
                    const s16x4 v1 = __builtin_amdgcn_ds_read_tr16_b64_v4i16((LAS s16x4*)(vp + 16 * AT_RS));
                    const bf16x8 Vf = (bf16x8){v0[0], v0[1], v0[2], v0[3], v1[0], v1[1], v1[2], v1[3]};
                    acc[dt] = acc[dt] * corr;
                    acc[dt] = __builtin_amdgcn_mfma_f32_16x16x32_bf16(Vf, Pf, acc[dt], 0, 0, 0);
                }
            }
            lrun += __shfl_xor(lrun, 16); lrun += __shfl_xor(lrun, 32);
            const float inv = 1.0f / lrun;
            typedef unsigned u32x2v __attribute__((ext_vector_type(2)));
#pragma unroll
            for (int dt = 0; dt < 4; ++dt) {
                u32x2v o; o.x = pk2(acc[dt][0] * inv, acc[dt][1] * inv); o.y = pk2(acc[dt][2] * inv, acc[dt][3] * inv);
                *(u32x2v*)(qp + 16 * dt + 4 * kq) = o;
            }
            if (kq == 0) lse[((size_t)g * MTOK + token) * 8 + h] = mrun + log2f(lrun);
        }
        __syncthreads();
    }
}

#define XB_TMO      128
#define XB_XCNT(j)  (256  + 64 * (j))
#define XB_XSUB(j)  (1280 + 64 * (j))
#define XB_XGEN(j)  (2304 + 64 * (j))
#define XB_TOP      3328
#define XB_TOPGEN   3392
#define XCD_BAR_WORDS 3456
#define XB_SPIN_CAP (1u << 18)

__device__ __forceinline__ unsigned xb_ld(unsigned* p)              { return __hip_atomic_load(p, __ATOMIC_RELAXED, __HIP_MEMORY_SCOPE_AGENT); }
__device__ __forceinline__ unsigned xb_add(unsigned* p, unsigned v) { return __hip_atomic_fetch_add(p, v, __ATOMIC_RELAXED, __HIP_MEMORY_SCOPE_AGENT); }
__device__ __forceinline__ unsigned xb_xcc_id() { return (unsigned)__builtin_amdgcn_s_getreg((3 << 11) | 20) & 0xFu; }
#define XB_SPIN(cond, bar) do { unsigned _sp = 0; while (cond) { __builtin_amdgcn_s_sleep(1); \
    if ((++_sp & 255u) == 0u) { if (xb_ld(&(bar)[XB_TMO])) break; if (_sp > XB_SPIN_CAP) { atomicAdd(&(bar)[XB_TMO], 1u); break; } } } } while (0)

struct XcdBarrier {
    unsigned* bar; unsigned x;
    volatile LAS unsigned* st;
};

__device__ __forceinline__ XcdBarrier xcd_barrier_post(unsigned* bar, volatile LAS unsigned* st) {
    XcdBarrier b; b.bar = bar; b.x = xb_xcc_id(); b.st = st;
    if (threadIdx.x == 0) (void)xb_add(&bar[XB_XCNT(b.x)], 1u);
    return b;
}
__device__ __forceinline__ void xcd_barrier_complete(unsigned* bar, unsigned x, unsigned& nloc, unsigned& nx) {
    const unsigned G = gridDim.x * gridDim.y * gridDim.z;
    unsigned sum, cnt, mine, sp = 0u;
    for (;;) {
        sum = 0u; cnt = 0u; mine = 0u;
#pragma unroll
        for (unsigned j = 0; j < 16; ++j) { const unsigned c = xb_ld(&bar[XB_XCNT(j)]); sum += c; cnt += (c > 0u) ? 1u : 0u; mine = (j == x) ? c : mine; }
        if (sum == G) break;
        __builtin_amdgcn_s_sleep(1);
        if ((++sp & 255u) == 0u) { if (xb_ld(&bar[XB_TMO])) break; if (sp > XB_SPIN_CAP) { atomicAdd(&bar[XB_TMO], 1u); break; } }
    }
    nloc = mine > 0u ? mine : 1u; nx = cnt > 0u ? cnt : 1u;
}

__device__ __forceinline__ void xcd_barrier(const XcdBarrier& b) {
    asm volatile("s_waitcnt vmcnt(0)" ::: "memory");
    __syncthreads();
    if (threadIdx.x == 0) {
        unsigned* bar = b.bar;
        __builtin_amdgcn_s_waitcnt(0);
        unsigned nloc = b.st[0], nx = b.st[1];
        if (nloc == 0u) { xcd_barrier_complete(bar, b.x, nloc, nx); b.st[0] = nloc; b.st[1] = nx; }
        const unsigned old = xb_add(&bar[XB_XSUB(b.x)], 1u);
        const unsigned gen = old / nloc;
        if (old + 1u == (gen + 1u) * nloc) {
            __builtin_amdgcn_fence(__ATOMIC_RELEASE, "agent");
            asm volatile("s_waitcnt vmcnt(0)" ::: "memory");
            const unsigned og = xb_add(&bar[XB_TOP], 1u);
            const unsigned tg = og / nx;
            if (og + 1u == (tg + 1u) * nx) xb_add(&bar[XB_TOPGEN], 1u);
            else XB_SPIN(xb_ld(&bar[XB_TOPGEN]) == tg, bar);
            __builtin_amdgcn_fence(__ATOMIC_ACQUIRE, "agent");
            xb_add(&bar[XB_XGEN(b.x)], 1u);
            asm volatile("s_waitcnt vmcnt(0)" ::: "memory");
        } else {
            XB_SPIN(xb_ld(&bar[XB_XGEN(b.x)]) == gen, bar);
            __builtin_amdgcn_fence(__ATOMIC_ACQUIRE, "agent");
            asm volatile("s_waitcnt vmcnt(0)" ::: "memory");
        }
    }
    __syncthreads();
}

#define GEMM_CALL(EPI, SCHED, g, S, E) pg8::gemm_phase<EPI, SCHED, true, true>(lds, g, S, E)

typedef const __attribute__((address_space(4))) Args* KArgs;
__device__ __forceinline__ Args load_args() {
#if defined(__HIP_DEVICE_COMPILE__)
    KArgs p = (KArgs)__builtin_amdgcn_kernarg_segment_ptr();
    asm volatile("" : "+s"(p));
    return *p;
#else
    return Args{};
#endif
}
__global__ void __launch_bounds__(NTHR, 2) fwd_megakernel(Args a_unused) {
    extern __shared__ __attribute__((aligned(16))) unsigned char lds_raw[];
    LAS unsigned char* lds = (LAS unsigned char*)lds_raw;
    cg::grid_group grid = cg::this_grid();
    const int tid0 = threadIdx.x, G0 = gridDim.x, bx0 = blockIdx.x;
    if (tid0 < 2) ((LAS unsigned*)(lds + LDS_ST_OFF))[tid0] = 0u;
    __syncthreads();
    { const Args a0 = load_args(); (void)xcd_barrier_post((unsigned*)(a0.ws + WS_BAR), (volatile LAS unsigned*)(lds + LDS_ST_OFF)); }
#define GSYNC() do { const Args ab = load_args(); XcdBarrier xb_; xb_.bar = (unsigned*)(ab.ws + WS_BAR); xb_.x = xb_xcc_id(); xb_.st = (volatile LAS unsigned*)(lds + LDS_ST_OFF); xcd_barrier(xb_); } while (0)
#define PTRS() const Args a = load_args(); int tid = tid0, G = G0, bx = bx0; asm volatile("" : "+v"(tid), "+s"(G), "+s"(bx)); const int lane = tid & 63, wave = __builtin_amdgcn_readfirstlane(tid >> 6); (void)lane; (void)wave; unsigned char* ws = a.ws; bf16* Wb = (bf16*)(ws + WS_W); const pg8::bf16_t* xb = (const pg8::bf16_t*)(ws + WS_XB); \
    const float* rcos = (const float*)(ws + WS_ROPE); const float* rsin = rcos + 65536; float* ssqA = (float*)(ws + WS_SSQA); float* ssqB = (float*)(ws + WS_SSQB); \
    (void)Wb; (void)xb; (void)rcos; (void)rsin; (void)ssqA; (void)ssqB;
#define GIN() pg8::Gemm gin{xb, (const pg8::bf16_t*)(Wb + W_IN / 2), nullptr, nullptr, MTOK, NIN, DM}; \
    pg8::EpiIn Ein{(pg8::bf16_t*)(ws + WS_HY), (pg8::bf16_t*)(ws + WS_Q), (pg8::bf16_t*)(ws + WS_KV), (pg8::bf16_t*)(ws + WS_GATES), ssqA, rcos, rsin, 0};

#pragma unroll 1
    for (int L = 0; L < 2; ++L) {
        { PTRS(); phase_prep_weights(a, L, lds, tid, lane, wave, G); }
        if (L == 0) grid.sync(); else GSYNC();
        {
            PTRS(); GIN();
            pg8::TwoRect S; S.a.init(128, 12, 0, 0, G, bx); S.b.init(64, 12, 0, 12, G, bx); S.na = S.a.count();
            GEMM_CALL(pg8::EpiIn, pg8::TwoRect, gin, S, Ein);
        }
        GSYNC();
        { PTRS(); phase_attn_mfma(a, 0, lds, tid, G); phase_prep_u(a, L, lds, tid, G); }
        GSYNC();
        {
            PTRS(); GIN();
            pg8::RectOrder S; S.init(64, 12, 64, 12, G, bx);
            Ein.kv_row0 = HALF_TOK;
            GEMM_CALL(pg8::EpiIn, pg8::RectOrder, gin, S, Ein);
        }
        { PTRS(); phase_hyena_mfma(a, lds, tid, G); }
        GSYNC();
        { PTRS(); phase_attn_mfma(a, 1, lds, tid, G); }
        {
            PTRS(); GIN();
            pg8::RectOrder S; S.init(128, 8, 0, 24, G, bx);
            GEMM_CALL(pg8::EpiIn, pg8::RectOrder, gin, S, Ein);
        }
        GSYNC();
        { PTRS(); phase_combine(a, tid, G); phase_transpose_y(a, lds, tid, G); }
        GSYNC();
        {
            PTRS();
            pg8::Gemm g{(const pg8::bf16_t*)(ws + WS_YHY), (const pg8::bf16_t*)(Wb + W_PHY / 2), (const pg8::bf16_t*)(ws + WS_YATT), (const pg8::bf16_t*)(Wb + W_PATT / 2), MTOK, DM, 512};
            pg8::PairOrder S; S.r.init(128, 4, 0, 0, G, bx);
            pg8::EpiGate E{(const pg8::bf16_t*)(ws + WS_GATES), (pg8::bf16_t*)(ws + WS_MERGED)};
            GEMM_CALL(pg8::EpiGate, pg8::PairOrder, g, S, E);
        }
        GSYNC();
        {
            PTRS();
            pg8::Gemm g{(const pg8::bf16_t*)(ws + WS_MERGED), (const pg8::bf16_t*)(Wb + W_O / 2), nullptr, nullptr, MTOK, DM, DM};
            pg8::RectOrder S; S.init(128, 4, 0, 0, G, bx);
            pg8::EpiRes E{L == 0 ? a.in[0] : a.out, a.out, (pg8::bf16_t*)(ws + WS_XB), ssqB};
            GEMM_CALL(pg8::EpiRes, pg8::RectOrder, g, S, E);
        }
        GSYNC();
        {
            PTRS();
            pg8::Gemm g{xb, (const pg8::bf16_t*)(Wb + W_FF1 / 2), nullptr, nullptr, MTOK, DFF, DM};
            pg8::RectOrder S; S.init(128, 16, 0, 0, G, bx);
            pg8::EpiFF1 E{(pg8::bf16_t*)(ws + WS_H), ssqB};
            GEMM_CALL(pg8::EpiFF1, pg8::RectOrder, g, S, E);
        }
        GSYNC();
        {
            PTRS();
            pg8::Gemm g{(const pg8::bf16_t*)(ws + WS_H), (const pg8::bf16_t*)(Wb + W_FF2 / 2), nullptr, nullptr, MTOK, DM, DFF};
            pg8::RectOrder S; S.init(128, 4, 0, 0, G, bx);
            pg8::EpiRes E{a.out, a.out, (pg8::bf16_t*)(ws + WS_XB), ssqA};
            GEMM_CALL(pg8::EpiRes, pg8::RectOrder, g, S, E);
        }
        GSYNC();
    }
    { PTRS(); phase_final_norm(a, lane, wave, G); }
}

extern "C" void kernel_launch(void* const* d_in, const int* in_sizes, int n_in, void* d_out, int out_size, void* d_ws, size_t ws_size, hipStream_t stream) {
    static int grid = 0;
    if (grid == 0) {
        if (n_in != 19 || in_sizes[0] != MTOK * DM || out_size != MTOK * DM || ws_size < WS_END) {
            fprintf(stderr, "kernel_launch: unexpected shapes / workspace (n_in %d, ws %zu, need %zu); nothing launched\n", n_in, ws_size, (size_t)WS_END); grid = -1; return; }
        int dev = 0, cus = 0, per_cu = 0;
        (void)hipGetDevice(&dev); (void)hipDeviceGetAttribute(&cus, hipDeviceAttributeMultiprocessorCount, dev);
        if (hipFuncSetAttribute((const void*)fwd_megakernel, hipFuncAttributeMaxDynamicSharedMemorySize, LDS_BYTES) != hipSuccess) { fprintf(stderr, "kernel_launch: hipFuncSetAttribute failed\n"); grid = -1; return; }
        if (hipOccupancyMaxActiveBlocksPerMultiprocessor(&per_cu, (const void*)fwd_megakernel, NTHR, LDS_BYTES) != hipSuccess || per_cu < 1) { fprintf(stderr, "kernel_launch: occupancy query gives %d\n", per_cu); per_cu = 1; }
        (void)hipGetLastError();
        grid = cus * 1;
        if (grid % 8 != 0 || grid > 256) grid = (grid > 256) ? 256 : (grid / 8) * 8;
    }
    if (grid < 0) return;
    Args a{};
    for (int i = 0; i < 19; ++i) a.in[i] = (const float*)d_in[i];
    a.out = (float*)d_out; a.ws = (unsigned char*)d_ws;
    if (hipMemsetAsync((char*)d_ws + WS_BAR, 0, 16384, stream) != hipSuccess) { fprintf(stderr, "kernel_launch: memset of the barrier words failed\n"); return; }
    void* args[] = {&a};
    hipError_t e = hipLaunchCooperativeKernel((const void*)fwd_megakernel, dim3(grid), dim3(NTHR), args, LDS_BYTES, stream);
    if (e != hipSuccess) fprintf(stderr, "cooperative launch failed: %s (grid %d)\n", hipGetErrorString(e), grid);
}
```

```cpp
#include <hip/hip_runtime.h>
#include <hip/hip_cooperative_groups.h>
#include <cstdio>
#include <cstdint>
namespace cg = cooperative_groups;

namespace pg8 {
#define PG8_LAS __attribute__((address_space(3)))
typedef unsigned short bf16_t;
typedef short bf16x8 __attribute__((ext_vector_type(8)));
typedef float f32x4 __attribute__((ext_vector_type(4)));
typedef unsigned u32x4 __attribute__((ext_vector_type(4)));
constexpr int BM = 256, BK = 64, HALF = 128, HTB = HALF * BK * 2  , STAGE_BYTES = 8 * HTB, NXCD = 8, WGM = 8;

__host__ __device__ __forceinline__ int lds_byte(int r, int c) { const int st = (r >> 4) * 2 + (c >> 5), rr = r & 15, cc = c & 31, ob = rr * 64 + cc * 2; return st * 1024 + (ob ^ (((ob >> 9) & 1) << 5)); }
__host__ __device__ __forceinline__ void stage_rc(int b, int& R, int& C) { const int st = b / 1024, sb = b % 1024, swz = sb ^ (((sb >> 9) & 1) << 5); R = (st >> 1) * 16 + swz / 64; C = (st & 1) * 32 + (swz % 64) / 2; }
__host__ __device__ __forceinline__ int perm32(int rho) { const int n = rho >> 4, i = rho & 15; return 8 * (i >> 2) + 4 * n + (i & 3); }

struct Unit { int pm, pn, z; };
struct Gemm { const bf16_t* A; const bf16_t* Bt; const bf16_t* A1; const bf16_t* Bt1; int M, N, K; };

struct StaticOrder {
    int nM, nN, nwg, G, c;
    __host__ __device__ void init(int M, int N, int G_, int c_) { nM = M / BM; nN = N / BM; nwg = nM * nN; G = G_; c = c_; }
    __host__ __device__ bool next(int i, Unit& u) const {
        const long L = (long)i * G + c; if (L >= nwg) return false;
        int wgid = (int)L; { const int q = nwg / NXCD, r = nwg % NXCD, xcd = wgid % NXCD, off = wgid / NXCD; wgid = (xcd < r ? xcd * (q + 1) : r * (q + 1) + (xcd - r) * q) + off; }
        const int nig = WGM * nN, gid = wgid / nig, fm = gid * WGM, gsz = (nM - fm) < WGM ? (nM - fm) : WGM;
        u.pm = fm + ((wgid % nig) % gsz); u.pn = (wgid % nig) / gsz; return true;
    }
    __device__ __forceinline__ void a_ready(const Unit&) const {}
    __device__ __forceinline__ void done(const Unit&) const {}
};


__device__ __forceinline__ unsigned cvt_pk_bf16(float lo, float hi) { unsigned r; asm volatile("v_cvt_pk_bf16_f32 %0, %1, %2" : "=v"(r) : "v"(lo), "v"(hi)); return r; }
__device__ __forceinline__ float bf_lo(unsigned w) { return __uint_as_float(w << 16); }
__device__ __forceinline__ float bf_hi(unsigned w) { return __uint_as_float(w & 0xffff0000u); }

struct RectOrder {
    int nN, nwg, G, c, pm0, pn0;
    __device__ __forceinline__ void init(int nM_, int nN_, int pm0_, int pn0_, int G_, int c_) { nN = nN_; nwg = nM_ * nN_; G = G_; c = c_; pm0 = pm0_; pn0 = pn0_; }
    __device__ __forceinline__ int count() const { return nwg > c ? (nwg - c + G - 1) / G : 0; }
    __device__ __forceinline__ bool next(int i, Unit& u) const {
        const long L = (long)i * G + c; if (L >= nwg) return false;
        const int w = (int)L, nig = 8 * nN, gid = w / nig, r = w % nig;
        u.pm = pm0 + gid * 8 + (r & 7); u.pn = pn0 + (r >> 3); u.z = 0; return true;
    }
    __device__ __forceinline__ void a_ready(const Unit&) const {}
    __device__ __forceinline__ void done(const Unit&) const {}
};
struct TwoRect {
    RectOrder a, b; int na;
    __device__ __forceinline__ bool next(int i, Unit& u) const { return i < na ? a.next(i, u) : b.next(i - na, u); }
    __device__ __forceinline__ void a_ready(const Unit&) const {}
    __device__ __forceinline__ void done(const Unit&) const {}
};
struct PairOrder {
    RectOrder r;
    __device__ __forceinline__ bool next(int i, Unit& u) const { const bool ok = r.next(i >> 1, u); u.z = i & 1; return ok; }
    __device__ __forceinline__ void a_ready(const Unit&) const {}
    __device__ __forceinline__ void done(const Unit&) const {}
};

constexpr float RMS_EPS = 1e-6f;
constexpr float QSCALE = 0.125f * 1.44269504088896341f;

__device__ __forceinline__ float row_rstd(const float* ssq, int row) {
    const f32x4* p = (const f32x4*)(ssq + (size_t)row * 16);
    const f32x4 a = p[0], b = p[1], c = p[2], d = p[3];
    const float s = ((a[0] + a[1]) + (a[2] + a[3])) + ((b[0] + b[1]) + (b[2] + b[3])) + ((c[0] + c[1]) + (c[2] + c[3])) + ((d[0] + d[1]) + (d[2] + d[3]));
    return 1.0f / sqrtf(s * (1.0f / 1024.0f) + RMS_EPS);
}

struct EpiIn {
    static constexpr bool PERM = true, AFTER_DRAIN = false;
    bf16_t* hy; bf16_t* q; bf16_t* kv; bf16_t* gates; const float* ssq; const float* rcos; const float* rsin; int kv_row0;
    __device__ __forceinline__ bool operator()(f32x4 (&acc)[2][2][4][2], const Unit& u, int wr, int wc, int fr, int fq) const {
        const int pn = u.pn; int type, ldc, colt, rowoff = 0; bf16_t* base;
        if (pn < 6) { type = 0; base = hy; ldc = 1536; colt = pn * 256; }
        else if (pn < 12) { type = 1; base = q; ldc = 1536; colt = (pn - 6) * 256; }
        else if (pn < 24) { const int idx = pn - 12; type = ((idx >> 1) & 1) ? 0 : 2; base = kv; ldc = 3072; colt = idx * 256; rowoff = kv_row0; }
        else { type = 3; base = gates; ldc = 2048; colt = (pn - 24) * 256; }
#pragma unroll
        for (int ai = 0; ai < 2; ++ai)
#pragma unroll
            for (int m = 0; m < 4; ++m) {
                const int row = u.pm * BM + ai * HALF + wr * 64 + m * 16 + fr;
                const float rs = row_rstd(ssq, row);
                bf16_t* rowp = base + (size_t)(row - rowoff) * ldc + colt;
                f32x4 v00 = acc[ai][0][m][0] * rs, v01 = acc[ai][0][m][1] * rs, v10 = acc[ai][1][m][0] * rs, v11 = acc[ai][1][m][1] * rs;
                if (type == 1 || type == 2) {
                    const int pos = row & 2047;
                    const f32x4 c0 = *(const f32x4*)(rcos + pos * 32 + 8 * fq), c1 = *(const f32x4*)(rcos + pos * 32 + 8 * fq + 4);
                    const f32x4 s0 = *(const f32x4*)(rsin + pos * 32 + 8 * fq), s1 = *(const f32x4*)(rsin + pos * 32 + 8 * fq + 4);
                    const float sc = (type == 1) ? QSCALE : 1.0f;
                    const f32x4 o00 = (v00 * c0 - v10 * s0) * sc, o01 = (v01 * c1 - v11 * s1) * sc;
                    const f32x4 o10 = (v10 * c0 + v00 * s0) * sc, o11 = (v11 * c1 + v01 * s1) * sc;
                    u32x4 w0, w1;
                    w0.x = cvt_pk_bf16(o00[0], o00[1]); w0.y = cvt_pk_bf16(o00[2], o00[3]); w0.z = cvt_pk_bf16(o01[0], o01[1]); w0.w = cvt_pk_bf16(o01[2], o01[3]);
                    w1.x = cvt_pk_bf16(o10[0], o10[1]); w1.y = cvt_pk_bf16(o10[2], o10[3]); w1.z = cvt_pk_bf16(o11[0], o11[1]); w1.w = cvt_pk_bf16(o11[2], o11[3]);
                    *(u32x4*)(rowp + wc * 64 + 8 * fq) = w0;
                    *(u32x4*)(rowp + wc * 64 + 8 * fq + 32) = w1;
                } else {
                    if (type == 3) {
#pragma unroll
                        for (int e = 0; e < 4; ++e) {
                            v00[e] = 1.0f / (1.0f + __expf(-v00[e])); v01[e] = 1.0f / (1.0f + __expf(-v01[e]));
                            v10[e] = 1.0f / (1.0f + __expf(-v10[e])); v11[e] = 1.0f / (1.0f + __expf(-v11[e]));
                        }
                    }
                    u32x4 w0, w1;
                    w0.x = cvt_pk_bf16(v00[0], v00[1]); w0.y = cvt_pk_bf16(v00[2], v00[3]); w0.z = cvt_pk_bf16(v01[0], v01[1]); w0.w = cvt_pk_bf16(v01[2], v01[3]);
                    w1.x = cvt_pk_bf16(v10[0], v10[1]); w1.y = cvt_pk_bf16(v10[2], v10[3]); w1.z = cvt_pk_bf16(v11[0], v11[1]); w1.w = cvt_pk_bf16(v11[2], v11[3]);
                    *(u32x4*)(rowp + wc * 32 + 8 * fq) = w0;
                    *(u32x4*)(rowp + wc * 32 + 8 * fq + HALF) = w1;
                }
            }
        return false;
    }
};

struct EpiGate {
    static constexpr bool PERM = true, AFTER_DRAIN = false;
    const bf16_t* gates; bf16_t* merged;
    __device__ __forceinline__ bool operator()(f32x4 (&acc)[2][2][4][2], const Unit& u, int wr, int wc, int fr, int fq) const {
#pragma unroll
        for (int ai = 0; ai < 2; ++ai)
#pragma unroll
            for (int m = 0; m < 4; ++m) {
                const int row = u.pm * BM + ai * HALF + wr * 64 + m * 16 + fr;
                const int col0 = u.pn * BM + wc * 32 + 8 * fq;
#pragma unroll
                for (int bj = 0; bj < 2; ++bj) {
                    const u32x4 ga = *(const u32x4*)(gates + (size_t)row * 2048 + 1024 + col0 + bj * HALF);
                    f32x4 a0 = (f32x4){bf_lo(ga.x), bf_hi(ga.x), bf_lo(ga.y), bf_hi(ga.y)}, a1 = (f32x4){bf_lo(ga.z), bf_hi(ga.z), bf_lo(ga.w), bf_hi(ga.w)};
                    if (u.z == 0) {
                        const u32x4 gh = *(const u32x4*)(gates + (size_t)row * 2048 + col0 + bj * HALF);
                        const f32x4 h0 = (f32x4){bf_lo(gh.x), bf_hi(gh.x), bf_lo(gh.y), bf_hi(gh.y)}, h1 = (f32x4){bf_lo(gh.z), bf_hi(gh.z), bf_lo(gh.w), bf_hi(gh.w)};
#pragma unroll
                        for (int e = 0; e < 4; ++e) { a0[e] = fmaxf(a0[e], 1e-30f); a1[e] = fmaxf(a1[e], 1e-30f); }
                        acc[ai][bj][m][0] = acc[ai][bj][m][0] * (h0 / a0);
                        acc[ai][bj][m][1] = acc[ai][bj][m][1] * (h1 / a1);
                    } else {
                        const f32x4 v0 = acc[ai][bj][m][0] * a0, v1 = acc[ai][bj][m][1] * a1;
                        u32x4 w; w.x = cvt_pk_bf16(v0[0], v0[1]); w.y = cvt_pk_bf16(v0[2], v0[3]); w.z = cvt_pk_bf16(v1[0], v1[1]); w.w = cvt_pk_bf16(v1[2], v1[3]);
                        *(u32x4*)(merged + (size_t)row * 1024 + col0 + bj * HALF) = w;
                    }
                }
            }
        return u.z == 0;
    }
};

struct EpiRes {
    static constexpr bool PERM = false, AFTER_DRAIN = false;
    const float* base; float* out; bf16_t* xb; float* ssq;
    __device__ __forceinline__ bool operator()(f32x4 (&acc)[2][2][4][2], const Unit& u, int wr, int wc, int fr, int fq) const {
        typedef unsigned u32x2v __attribute__((ext_vector_type(2)));
        int rl = wr * 64 + fr, cl = wc * 32 + 4 * fq;
        asm volatile("" : "+v"(rl), "+v"(cl));
#pragma unroll
        for (int ai = 0; ai < 2; ++ai)
#pragma unroll
            for (int m = 0; m < 4; ++m) {
                const int row = u.pm * BM + ai * HALF + m * 16 + rl;
                const size_t off = (size_t)row * 1024 + u.pn * BM + cl;
                float s = 0.f;
#pragma unroll
                for (int bj = 0; bj < 2; ++bj)
#pragma unroll
                    for (int n = 0; n < 2; ++n) {
                        const f32x4 o = *(const f32x4*)(base + off + bj * HALF + n * 16) + acc[ai][bj][m][n];
                        *(f32x4*)(out + off + bj * HALF + n * 16) = o;
                        u32x2v w; w.x = cvt_pk_bf16(o[0], o[1]); w.y = cvt_pk_bf16(o[2], o[3]);
                        *(u32x2v*)(xb + off + bj * HALF + n * 16) = w;
                        s += (o[0] * o[0] + o[1] * o[1]) + (o[2] * o[2] + o[3] * o[3]);
                    }
                s += __shfl_xor(s, 16); s += __shfl_xor(s, 32);
                if (fq == 0) ssq[(size_t)row * 16 + u.pn * 4 + wc] = s;
                asm volatile("" ::: "memory");
            }
        return false;
    }
};

struct EpiFF1 {
    static constexpr bool PERM = true, AFTER_DRAIN = false;
    bf16_t* h; const float* ssq;
    __device__ __forceinline__ bool operator()(f32x4 (&acc)[2][2][4][2], const Unit& u, int wr, int wc, int fr, int fq) const {
#pragma unroll
        for (int ai = 0; ai < 2; ++ai)
#pragma unroll
            for (int m = 0; m < 4; ++m) {
                const int row = u.pm * BM + ai * HALF + wr * 64 + m * 16 + fr;
                const float rs = row_rstd(ssq, row);
                bf16_t* rowp = h + (size_t)row * 4096 + u.pn * BM + wc * 32 + 8 * fq;
#pragma unroll
                for (int bj = 0; bj < 2; ++bj) {
                    f32x4 v0 = acc[ai][bj][m][0] * rs, v1 = acc[ai][bj][m][1] * rs;
#pragma unroll
                    for (int e = 0; e < 4; ++e) { v0[e] = fmaxf(v0[e], 0.f); v1[e] = fmaxf(v1[e], 0.f); }
                    v0 = v0 * v0; v1 = v1 * v1;
                    u32x4 w; w.x = cvt_pk_bf16(v0[0], v0[1]); w.y = cvt_pk_bf16(v0[2], v0[3]); w.z = cvt_pk_bf16(v1[0], v1[1]); w.w = cvt_pk_bf16(v1[2], v1[3]);
                    *(u32x4*)(rowp + bj * HALF) = w;
                }
            }
        return false;
    }
};

template <class Epi, class Sched, bool ALIGN_EPI = false, bool SP2 = false>
__device__ __forceinline__ void gemm_phase(PG8_LAS unsigned char* lds, const Gemm g, const Sched& S, const Epi& E) {
    int tid_ = threadIdx.x; asm volatile("" : "+v"(tid_));
    const int tid = tid_, wid = __builtin_amdgcn_readfirstlane(tid >> 6), lane = tid & 63, wr = wid >> 2, wc = wid & 3, fr = lane & 15, fq = lane >> 4;
    const int K = g.K, nt = K / BK;
    unsigned voffA[2], voffB[2];
#pragma unroll
    for (int i = 0; i < 2; ++i) { int R, C; stage_rc(tid * 16 + i * 8192, R, C); const int Rb = Epi::PERM ? ((R & ~31) + perm32(R & 31)) : R;
        voffA[i] = (unsigned)(R * K + C) * 2u; voffB[i] = (unsigned)(Rb * K + C) * 2u; }
    const size_t kstep = (size_t)(BK * 2);
    const size_t hstep = (size_t)HALF * K * 2;
    const size_t tstep = 2 * hstep;
    const unsigned ldsw = (unsigned)wid * 1024u;
    const int aoff = lds_byte(wr * 64 + fr, fq * 8), boff = lds_byte(wc * 32 + fr, fq * 8);
#define PG8_SA(b, h) (((b) * 2 + (h)) * HTB)
#define PG8_SB(b, h) ((4 + (b) * 2 + (h)) * HTB)
#define PG8_STAGE(bufoff, gbase, voff) do { _Pragma("unroll") for (int _i = 0; _i < 2; ++_i) \
        __builtin_amdgcn_global_load_lds((const unsigned*)((const char*)(gbase) + (voff)[_i]), (PG8_LAS unsigned*)(lds + (bufoff) + ldsw + _i * 8192), 16, 0, 0); } while (0)
#define PG8_LDA(dst, b, h) do { _Pragma("unroll") for (int m = 0; m < 4; ++m) _Pragma("unroll") for (int k = 0; k < 2; ++k) dst[m][k] = *(const PG8_LAS bf16x8*)(lds + PG8_SA(b, h) + aoff + m * 2048 + k * 1024); } while (0)
#define PG8_LDB(dst, b, h) do { _Pragma("unroll") for (int n = 0; n < 2; ++n) _Pragma("unroll") for (int k = 0; k < 2; ++k) dst[n][k] = *(const PG8_LAS bf16x8*)(lds + PG8_SB(b, h) + boff + n * 2048 + k * 1024); } while (0)
#define PG8_MMA(ai, bj, At, Bt) do { __builtin_amdgcn_s_setprio(1); _Pragma("unroll") for (int m = 0; m < 4; ++m) _Pragma("unroll") for (int n = 0; n < 2; ++n) _Pragma("unroll") for (int k = 0; k < 2; ++k) \
        acc[ai][bj][m][n] = __builtin_amdgcn_mfma_f32_16x16x32_bf16(Bt[n][k], At[m][k], acc[ai][bj][m][n], 0, 0, 0); __builtin_amdgcn_s_setprio(0); } while (0)
#define PG8_WAIT_V(n) asm volatile("s_waitcnt vmcnt(" #n ")" ::: "memory")
#define PG8_WAIT_L(n) asm volatile("s_waitcnt lgkmcnt(" #n ")" ::: "memory")
#define PG8_BAR __builtin_amdgcn_s_barrier()
#define PG8_SCHED __builtin_amdgcn_sched_barrier(0)
    Unit cur, nxt; int ui = 0;
    if (!S.next(0, cur)) return;
    f32x4 acc[2][2][4][2];
#pragma unroll
    for (int a = 0; a < 2; ++a)
#pragma unroll
        for (int b = 0; b < 2; ++b)
#pragma unroll
            for (int m = 0; m < 4; ++m)
#pragma unroll
                for (int n = 0; n < 2; ++n) acc[a][b][m][n] = (f32x4){0.f, 0.f, 0.f, 0.f};
    bf16x8 At[4][2], B0[2][2], B1[2][2];
    const char* cA = (const char*)(cur.z ? g.A1 : g.A) + (size_t)cur.pm * tstep; const char* cB = (const char*)(cur.z ? g.Bt1 : g.Bt) + (size_t)cur.pn * tstep;
    S.a_ready(cur);
    if constexpr (SP2) {
        PG8_STAGE(PG8_SB(0, 0), cB, voffB); PG8_STAGE(PG8_SB(0, 1), cB + hstep, voffB); PG8_STAGE(PG8_SA(0, 0), cA, voffA); PG8_STAGE(PG8_SA(0, 1), cA + hstep, voffA);
        if (wr == 1) PG8_BAR;
        PG8_WAIT_V(2); PG8_BAR;
        PG8_STAGE(PG8_SB(1, 0), cB + kstep, voffB); PG8_STAGE(PG8_SA(1, 0), cA + kstep, voffA); PG8_STAGE(PG8_SB(1, 1), cB + hstep + kstep, voffB);
        PG8_WAIT_V(6); PG8_BAR;
    } else {
        PG8_STAGE(PG8_SB(0, 0), cB, voffB); PG8_STAGE(PG8_SA(0, 0), cA, voffA); PG8_STAGE(PG8_SB(0, 1), cB + hstep, voffB); PG8_STAGE(PG8_SA(0, 1), cA + hstep, voffA);
        if (wr == 1) PG8_BAR;
        PG8_WAIT_V(4); PG8_BAR;
        PG8_STAGE(PG8_SB(1, 0), cB + kstep, voffB); PG8_STAGE(PG8_SA(1, 0), cA + kstep, voffA); PG8_STAGE(PG8_SB(1, 1), cB + hstep + kstep, voffB);
        PG8_WAIT_V(6); PG8_BAR;
    }
    for (;;) {
        const bool has_next = S.next(ui + 1, nxt);
        const char* nA = has_next ? (const char*)(nxt.z ? g.A1 : g.A) + (size_t)nxt.pm * tstep : cA; const char* nB = has_next ? (const char*)(nxt.z ? g.Bt1 : g.Bt) + (size_t)nxt.pn * tstep : cB;
        for (int t = 0; t < nt; t += 2) {
            const bool last = (t == nt - 2);
            const char* a1 = cA + (size_t)(t + 1) * kstep;
            const char* a2 = last ? nA : cA + (size_t)(t + 2) * kstep; const char* b2 = last ? nB : cB + (size_t)(t + 2) * kstep;
            const char* a3 = a2 + kstep; const char* b3 = b2 + kstep;
            if (last && has_next) S.a_ready(nxt);
            if constexpr (SP2) {
            PG8_LDB(B0, 0, 0); PG8_LDB(B1, 0, 1); PG8_SCHED; PG8_LDA(At, 0, 0); PG8_STAGE(PG8_SA(1, 1), a1 + hstep, voffA);
            PG8_WAIT_V(8); PG8_WAIT_L(0); PG8_BAR; PG8_MMA(0, 0, At, B0); PG8_MMA(0, 1, At, B1); PG8_BAR; PG8_SCHED;
            PG8_LDA(At, 0, 1); PG8_STAGE(PG8_SB(0, 0), b2, voffB); PG8_STAGE(PG8_SB(0, 1), b2 + hstep, voffB); PG8_STAGE(PG8_SA(0, 0), a2, voffA);
            PG8_WAIT_V(8); PG8_WAIT_L(0); PG8_BAR; PG8_MMA(1, 0, At, B0); PG8_MMA(1, 1, At, B1); PG8_BAR; PG8_SCHED;
            PG8_LDB(B0, 1, 0); PG8_LDB(B1, 1, 1); PG8_SCHED; PG8_LDA(At, 1, 0); PG8_STAGE(PG8_SA(0, 1), a2 + hstep, voffA);
            PG8_WAIT_V(8); PG8_WAIT_L(0); PG8_BAR; PG8_MMA(0, 0, At, B0); PG8_MMA(0, 1, At, B1); PG8_BAR; PG8_SCHED;
            PG8_LDA(At, 1, 1); PG8_STAGE(PG8_SB(1, 0), b3, voffB); PG8_STAGE(PG8_SB(1, 1), b3 + hstep, voffB); PG8_STAGE(PG8_SA(1, 0), a3, voffA);
            PG8_WAIT_V(8); PG8_WAIT_L(0); PG8_BAR; PG8_MMA(1, 0, At, B0); PG8_MMA(1, 1, At, B1); PG8_BAR; PG8_SCHED;
            } else {
            PG8_LDB(B0, 0, 0); PG8_SCHED; PG8_LDA(At, 0, 0); PG8_STAGE(PG8_SA(1, 1), a1 + hstep, voffA);
            PG8_WAIT_L(8); PG8_BAR; PG8_WAIT_L(0); PG8_MMA(0, 0, At, B0); PG8_BAR; PG8_SCHED;
            PG8_LDB(B1, 0, 1); PG8_STAGE(PG8_SB(0, 0), b2, voffB);
            PG8_BAR; PG8_WAIT_L(0); PG8_MMA(0, 1, At, B1); PG8_BAR;
            PG8_LDA(At, 0, 1); PG8_STAGE(PG8_SA(0, 0), a2, voffA);
            PG8_BAR; PG8_WAIT_L(0); PG8_MMA(1, 0, At, B0); PG8_BAR; PG8_SCHED;
            PG8_STAGE(PG8_SB(0, 1), b2 + hstep, voffB);
            PG8_WAIT_V(6); PG8_BAR; PG8_MMA(1, 1, At, B1); PG8_BAR;
            PG8_LDB(B0, 1, 0); PG8_SCHED; PG8_LDA(At, 1, 0); PG8_STAGE(PG8_SA(0, 1), a2 + hstep, voffA);
            PG8_WAIT_L(8); PG8_BAR; PG8_WAIT_L(0); PG8_MMA(0, 0, At, B0); PG8_BAR; PG8_SCHED;
            PG8_LDB(B1, 1, 1); PG8_STAGE(PG8_SB(1, 0), b3, voffB);
            PG8_BAR; PG8_WAIT_L(0); PG8_MMA(0, 1, At, B1); PG8_BAR;
            PG8_LDA(At, 1, 1); PG8_STAGE(PG8_SA(1, 0), a3, voffA);
            PG8_BAR; PG8_WAIT_L(0); PG8_MMA(1, 0, At, B0); PG8_BAR; PG8_SCHED;
            PG8_STAGE(PG8_SB(1, 1), b3 + hstep, voffB);
            PG8_WAIT_V(6); PG8_BAR; PG8_MMA(1, 1, At, B1); PG8_BAR;
            }
        }
        if constexpr (ALIGN_EPI) { if (wr == 0) PG8_BAR; }
        bool keep_acc = false; if constexpr (!Epi::AFTER_DRAIN) { keep_acc = E(acc, cur, wr, wc, fr, fq); S.done(cur); }
        if (!has_next) break;
        if (!keep_acc) {
#pragma unroll
        for (int a = 0; a < 2; ++a)
#pragma unroll
            for (int b = 0; b < 2; ++b)
#pragma unroll
                for (int m = 0; m < 4; ++m)
#pragma unroll
                    for (int n = 0; n < 2; ++n) acc[a][b][m][n] = (f32x4){0.f, 0.f, 0.f, 0.f};
        }
        cur = nxt; cA = nA; cB = nB; ++ui;
        if constexpr (ALIGN_EPI) { if (wr == 1) PG8_BAR; }
    }
    PG8_WAIT_V(0);
    if constexpr (!ALIGN_EPI) { if (wr == 0) PG8_BAR; }
    PG8_BAR;
    if constexpr (Epi::AFTER_DRAIN) { E.fused(acc, cur, wr, wc, fr, fq, lds, wid, lane); S.done(cur); }
#undef PG8_SA
#undef PG8_SB
#undef PG8_STAGE
#undef PG8_LDA
#undef PG8_LDB
#undef PG8_MMA
#undef PG8_WAIT_V
#undef PG8_WAIT_L
#undef PG8_BAR
#undef PG8_SCHED
}
}

#define LAS __attribute__((address_space(3)))
typedef unsigned short bf16;
typedef float f32x4 __attribute__((ext_vector_type(4)));
typedef unsigned v4u __attribute__((ext_vector_type(4)));
constexpr int NWAVES = 8, NTHR = 512;
constexpr int MTOK = 32768, DM = 1024, SEQ = 2048, NBATCH = 16, NIN = 8192, DFF = 4096, HYW = 512, HALF_TOK = 16384;
constexpr size_t MiB = (size_t)1 << 20;
constexpr size_t WS_SSQA = 0, WS_SSQB = 2 * MiB, WS_ROPE = 4 * MiB, WS_BAR = 4 * MiB + 768 * 1024, WS_LSE = 5 * MiB, WS_GF = 8 * MiB, WS_W = 16 * MiB, WS_XB = 52 * MiB,
                 WS_HY = 116 * MiB, WS_UT = 212 * MiB, WS_GATES = 116 * MiB, WS_Q = 244 * MiB, WS_KV = 340 * MiB, WS_YHY = 436 * MiB, WS_YATT = 404 * MiB, WS_X0T = 468 * MiB,
                 WS_MERGED = 340 * MiB, WS_H = 116 * MiB, WS_END = 500 * MiB;
constexpr size_t W_IN = 0, W_PHY = 16 * MiB, W_PATT = 17 * MiB, W_O = 18 * MiB, W_FF1 = 20 * MiB, W_FF2 = 28 * MiB;
constexpr int LDS_ST_OFF = 135168;
constexpr int LDS_BYTES = 139264;

struct Args {
    const float* in[19]; float* out; unsigned char* ws; int pad0, pad1;
};

__device__ __forceinline__ unsigned f2bf(float f) { unsigned u = __float_as_uint(f); return (u + 0x7fffu + ((u >> 16) & 1u)) >> 16; }
__device__ __forceinline__ unsigned pk2(float lo, float hi) { return f2bf(lo) | (f2bf(hi) << 16); }
__device__ __forceinline__ float bf2f(unsigned short b) { return __uint_as_float((unsigned)b << 16); }
__device__ __forceinline__ float wave_sum(float v) {
#pragma unroll
    for (int o = 1; o < 64; o <<= 1) v += __shfl_xor(v, o);
    return v;
}

__device__ __forceinline__ int win_src_col(int n) {
    const int t = n >> 8, j = n & 255;
    if (t < 6) return n;
    if (t >= 24) return 6144 + (n - 6144);
    int g, w, half;
    if (t < 12) { const int i = t - 6; g = i >> 1; w = 0; half = i & 1; }
    else { const int i = t - 12; g = i >> 2; w = 1 + ((i >> 1) & 1); half = i & 1; }
    int hh, d;
    if (w == 2) { hh = j >> 6; d = j & 63; }
    else { hh = (j & 127) >> 5; d = (j & 31) + ((j >> 7) << 5); }
    return 1536 + g * 1536 + w * 512 + (half * 4 + hh) * 64 + d;
}

__device__ __forceinline__ void transpose_item(const float* W, int K, int Nsrc, int s0, bf16* WT, int n0, int k0, const float* gain, LAS float* scr, int lane) {
#pragma unroll 8
    for (int i = 0; i < 32; ++i) { const int kk = 2 * i + (lane >> 5); float v = W[(size_t)(k0 + kk) * Nsrc + s0 + (lane & 31)]; if (gain) v *= gain[k0 + kk]; scr[kk * 33 + (lane & 31)] = v; }
    asm volatile("s_waitcnt lgkmcnt(0)" ::: "memory");
    const int c = lane & 7;
#pragma unroll
    for (int j = 0; j < 4; ++j) { const int n = (lane >> 3) + 8 * j; const LAS float* s = scr + (8 * c) * 33 + n;
        v4u o; o.x = pk2(s[0 * 33], s[1 * 33]); o.y = pk2(s[2 * 33], s[3 * 33]); o.z = pk2(s[4 * 33], s[5 * 33]); o.w = pk2(s[6 * 33], s[7 * 33]);
        *(v4u*)(WT + (size_t)(n0 + n) * K + k0 + 8 * c) = o; }
    asm volatile("s_waitcnt lgkmcnt(0)" ::: "memory");
}

__device__ __forceinline__ void phase_prep_weights(const Args& a, int L, LAS unsigned char* lds, int tid, int lane, int wave, int G) {
    unsigned char* ws = a.ws;
    {
        const float* w1 = a.in[5] + (size_t)L * 33 * 64; const float* b1 = a.in[6] + L * 64;
        const float* wi = a.in[7] + (size_t)L * 2 * 64 * 64; const float* bi = a.in[8] + L * 2 * 64;
        const float* wout = a.in[9] + (size_t)L * 64 * 1024; const float* fr = a.in[10] + L * 64; const float* skip = a.in[11] + L * 512;
        bf16* Rg = (bf16*)(ws + WS_GF);
        const float min_decay = logf(1e-2f) / 1.5f, max_decay = logf(1e-2f) / 0.3f;
        LAS float* hb = (LAS float*)lds + wave * 64;
        LAS float* fbuf = (LAS float*)(lds + 4096);
        const float frl = fr[lane];
        for (int blk = blockIdx.x; blk < 256; blk += G) {
            int n = 8 * blk + wave + 1; if (n == 2048) n = 0;
            const float t = (float)n / 2047.0f;
            {
                float v = 0.f;
                if (lane == 0) v = t;
                else if (lane < 33) { const int k = (lane - 1) & 15; const float band = 1e-4f + (float)k * ((15.0f - 1e-4f) / 15.0f); const float ang = ((float)(2.0 * 3.14159265358979323846 / 2048.0) * (float)n) * band;
                       v = (lane <= 16) ? cosf(ang) : -sinf(ang); }
                hb[lane] = v;
            }
            float s = b1[lane];
#pragma unroll
            for (int e = 0; e < 33; ++e) s += hb[e] * w1[e * 64 + lane];
            float hcur = sinf(frl * s);
#pragma unroll 1
            for (int layer = 0; layer < 2; ++layer) {
                hb[lane] = hcur;
                float s2 = bi[layer * 64 + lane];
#pragma unroll
                for (int e = 0; e < 64; ++e) s2 += hb[e] * wi[layer * 4096 + e * 64 + lane];
                hcur = sinf(frl * s2);
            }
            hb[lane] = hcur;
            float o[16];
#pragma unroll
            for (int k = 0; k < 16; ++k) o[k] = 0.f;
#pragma unroll 4
            for (int e = 0; e < 64; ++e) { const float he = hb[e];
#pragma unroll
                for (int k = 0; k < 16; ++k) o[k] += he * wout[e * 1024 + 64 * k + lane]; }
#pragma unroll
            for (int k = 0; k < 16; ++k) {
                const int col = 64 * k + lane, c = col & 511;
                const float delta = fabsf(min_decay + (float)c * ((max_decay - min_decay) / 511.0f));
                fbuf[wave * 1024 + col] = o[k] * expf(-t * delta);
            }
            __syncthreads();
#pragma unroll
            for (int pp = 0; pp < 2; ++pp) {
                const int p = tid + 512 * pp, c = p & 511, dir = p >> 9;
                bf16* r0 = Rg + ((size_t)c * 2 + 0) * 4096; bf16* r1 = Rg + ((size_t)c * 2 + 1) * 4096;
#pragma unroll
                for (int wv = 0; wv < 8; ++wv) {
                    int nn = 8 * blk + wv + 1; float val = fbuf[wv * 1024 + dir * 512 + c]; int x;
                    if (nn == 2048) { if (dir != 0) continue; val += skip[c]; x = 2048; }
                    else x = dir ? 2048 + nn : 2048 - nn;
                    const bf16 hv = (bf16)f2bf(val); r0[x] = hv; r1[x - 1] = hv;
                }
            }
            __syncthreads();
        }
    }
    {
        LAS float* scr = (LAS float*)(lds + 40960 + wave * 8704);
        const int gw = blockIdx.x * NWAVES + wave, NGW = G * NWAVES;
        bf16* Wb = (bf16*)(ws + WS_W);
        const float* w_in = a.in[2] + (size_t)L * DM * NIN; const float* p_hy = a.in[12] + (size_t)L * 512 * DM; const float* p_att = a.in[13] + (size_t)L * 512 * DM;
        const float* w_o = a.in[14] + (size_t)L * DM * DM; const float* w1 = a.in[16] + (size_t)L * DM * DFF; const float* w2 = a.in[17] + (size_t)L * DFF * DM;
        const float* g_mix = a.in[1] + L * DM; const float* g_ffn = a.in[15] + L * DM;
        constexpr int I_IN = 16 * 256, I_P = 8 * 32, I_O = 16 * 32, I_1 = 16 * 128, I_2 = 64 * 32;
        constexpr int NITEMS = I_IN + 2 * I_P + I_O + I_1 + I_2;
        for (int it = gw; it < NITEMS; it += NGW) {
            int r = it;
            if (r < I_IN) { const int kb = r / 256, nb = r % 256; transpose_item(w_in, DM, NIN, win_src_col(nb * 32), Wb + W_IN / 2, nb * 32, kb * 64, g_mix, scr, lane); continue; } r -= I_IN;
            if (r < I_P) { const int kb = r / 32, nb = r % 32; transpose_item(p_hy, 512, DM, nb * 32, Wb + W_PHY / 2, nb * 32, kb * 64, nullptr, scr, lane); continue; } r -= I_P;
            if (r < I_P) { const int kb = r / 32, nb = r % 32; transpose_item(p_att, 512, DM, nb * 32, Wb + W_PATT / 2, nb * 32, kb * 64, nullptr, scr, lane); continue; } r -= I_P;
            if (r < I_O) { const int kb = r / 32, nb = r % 32; transpose_item(w_o, DM, DM, nb * 32, Wb + W_O / 2, nb * 32, kb * 64, nullptr, scr, lane); continue; } r -= I_O;
            if (r < I_1) { const int kb = r / 128, nb = r % 128; transpose_item(w1, DM, DFF, nb * 32, Wb + W_FF1 / 2, nb * 32, kb * 64, g_ffn, scr, lane); continue; } r -= I_1;
            { const int kb = r / 32, nb = r % 32; transpose_item(w2, DFF, DM, nb * 32, Wb + W_FF2 / 2, nb * 32, kb * 64, nullptr, scr, lane); }
        }
        if (L == 0) {
            const float* x = a.in[0]; bf16* xb = (bf16*)(ws + WS_XB); float* ssq = (float*)(ws + WS_SSQA);
            for (int m = gw; m < MTOK; m += NGW) {
                const f32x4* xr = (const f32x4*)(x + (size_t)m * DM) + lane;
                f32x4 v[4]; float s = 0.f;
#pragma unroll
                for (int j = 0; j < 4; ++j) { v[j] = xr[64 * j]; s += (v[j][0] * v[j][0] + v[j][1] * v[j][1]) + (v[j][2] * v[j][2] + v[j][3] * v[j][3]); }
                s = wave_sum(s);
                unsigned long long* o8 = (unsigned long long*)(xb + (size_t)m * DM) + lane;
#pragma unroll
                for (int j = 0; j < 4; ++j) o8[64 * j] = (unsigned long long)pk2(v[j][0], v[j][1]) | ((unsigned long long)pk2(v[j][2], v[j][3]) << 32);
                if (lane < 16) ssq[(size_t)m * 16 + lane] = (lane == 0) ? s : 0.f;
            }
            float* rc = (float*)(ws + WS_ROPE); float* rsn = rc + 65536;
            for (int i = blockIdx.x * NTHR + tid; i < 65536; i += G * NTHR) {
                const int pos = i >> 5, f = i & 31;
                const float inv = powf(10000.0f, -(float)f / 32.0f);
                const float ang = (float)pos * inv;
                rc[i] = cosf(ang); rsn[i] = sinf(ang);
            }
        }
    }
}

__device__ __forceinline__ float bfe(const v4u& w, int e) { const unsigned d = (e >> 1) == 0 ? w.x : ((e >> 1) == 1 ? w.y : ((e >> 1) == 2 ? w.z : w.w)); return (e & 1) ? __uint_as_float(d & 0xffff0000u) : __uint_as_float(d << 16); }
__device__ __forceinline__ void phase_prep_u(const Args& a, int L, LAS unsigned char* lds, int tid, int G) {
    const bf16* hy = (const bf16*)(a.ws + WS_HY); bf16* ut = (bf16*)(a.ws + WS_UT); bf16* x0t = (bf16*)(a.ws + WS_X0T);
    const float* cw = a.in[3] + (size_t)L * 3 * 1536; const float* cb = a.in[4] + L * 1536;
    LAS unsigned short* tile = (LAS unsigned short*)lds;
    const int cc = blockIdx.x & 7, ml = tid >> 3, cg8 = tid & 7, c0 = cc * 64 + cg8 * 8;
    float wq[3][4][8];
#pragma unroll
    for (int ar = 0; ar < 3; ++ar)
#pragma unroll
        for (int e = 0; e < 8; ++e) { wq[ar][0][e] = cw[ar * 512 + c0 + e]; wq[ar][1][e] = cw[1536 + ar * 512 + c0 + e]; wq[ar][2][e] = cw[3072 + ar * 512 + c0 + e]; wq[ar][3][e] = cb[ar * 512 + c0 + e]; }
    for (int it = blockIdx.x >> 3; it < 512; it += (G >> 3)) {
        const int mc = it & 31, b = it >> 5, m = mc * 64 + ml;
        const bf16* r = hy + (size_t)(b * SEQ + m) * 1536 + c0;
        v4u d[3][3];
        const v4u zero = (v4u){0u, 0u, 0u, 0u};
#pragma unroll
        for (int ar = 0; ar < 3; ++ar) {
            d[ar][0] = (m > 0) ? *(const v4u*)(r - 1536 + ar * 512) : zero;
            d[ar][1] = *(const v4u*)(r + ar * 512);
            d[ar][2] = (m < SEQ - 1) ? *(const v4u*)(r + 1536 + ar * 512) : zero;
        }
#pragma unroll
        for (int e = 0; e < 8; ++e) {
            float cv[3];
#pragma unroll
            for (int ar = 0; ar < 3; ++ar) cv[ar] = wq[ar][3][e] + wq[ar][0][e] * bfe(d[ar][0], e) + wq[ar][1][e] * bfe(d[ar][1], e) + wq[ar][2][e] * bfe(d[ar][2], e);
            tile[(cg8 * 8 + e) * 72 + ml] = (unsigned short)f2bf(cv[1] * cv[2]);
            tile[4608 + (cg8 * 8 + e) * 72 + ml] = (unsigned short)f2bf(cv[0]);
        }
        __syncthreads();
        {
            const int c2 = tid >> 3, ch = tid & 7;
            const LAS unsigned* s = (const LAS unsigned*)(tile + c2 * 72 + ch * 8);
            v4u o; o.x = s[0]; o.y = s[1]; o.z = s[2]; o.w = s[3];
            *(v4u*)(ut + ((size_t)(cc * 64 + c2) * NBATCH + b) * SEQ + mc * 64 + ch * 8) = o;
            const LAS unsigned* s2 = s + 2304;
            v4u o2; o2.x = s2[0]; o2.y = s2[1]; o2.z = s2[2]; o2.w = s2[3];
            *(v4u*)(x0t + ((size_t)(cc * 64 + c2) * NBATCH + b) * SEQ + mc * 64 + ch * 8) = o2;
        }
        __syncthreads();
    }
}

__device__ __forceinline__ void phase_hyena_naive(const Args& a, int L, LAS unsigned char* lds, int tid, int G) {
    const bf16* hy = (const bf16*)(a.ws + WS_HY); const bf16* ut = (const bf16*)(a.ws + WS_UT); const float* Gf = (const float*)(a.ws + WS_GF);
    bf16* yhy = (bf16*)(a.ws + WS_YHY);
    const float* cw = a.in[3] + (size_t)L * 3 * 1536; const float* cb = a.in[4] + L * 1536;
    LAS float* Gs = (LAS float*)lds;
    LAS float* Us = Gs + 4096;
    for (int item = blockIdx.x; item < 2048; item += G) {
        const int c = item >> 2, bq = item & 3;
        for (int i = tid; i < 4096; i += NTHR) Gs[i] = (i == 0) ? 0.f : Gf[(size_t)c * 4096 + i];
        for (int i = tid; i < 8192; i += NTHR) { const int bl = i >> 11, m = i & 2047; Us[i] = bf2f(ut[((size_t)c * NBATCH + bq * 4 + bl) * SEQ + m]); }
        __syncthreads();
        const int bl = tid >> 7, tn = tid & 127;
        float acc[16];
#pragma unroll
        for (int i = 0; i < 16; ++i) acc[i] = 0.f;
        const LAS float* up = Us + bl * 2048;
        for (int m = 0; m < SEQ; ++m) {
            const float u = up[m];
            const LAS float* gp = Gs + (tn - m + 2048);
#pragma unroll
            for (int i = 0; i < 16; ++i) acc[i] += gp[128 * i] * u;
        }
        const int b = bq * 4 + bl;
        const float w0 = cw[c], w1 = cw[1536 + c], w2 = cw[3072 + c], b0 = cb[c];
#pragma unroll
        for (int i = 0; i < 16; ++i) {
            const int n = tn + 128 * i;
            const bf16* r = hy + (size_t)(b * SEQ + n) * 1536 + c;
            const float xm = (n > 0) ? bf2f(r[-1536]) : 0.f, xc = bf2f(r[0]), xp = (n < SEQ - 1) ? bf2f(r[1536]) : 0.f;
            const float x0 = b0 + w0 * xm + w1 * xc + w2 * xp;
            yhy[(size_t)(b * SEQ + n) * 512 + c] = (bf16)f2bf(x0 * acc[i]);
        }
        __syncthreads();
    }
}

__device__ __forceinline__ void phase_attn_naive(const Args& a, int half, int tid, int G) {
    bf16* Q = (bf16*)(a.ws + WS_Q); const bf16* KV = (const bf16*)(a.ws + WS_KV); float* lse = (float*)(a.ws + WS_LSE);
    for (int idx = blockIdx.x * NTHR + tid; idx < 3 * 8 * HALF_TOK; idx += G * NTHR) {
        const int g = idx / (8 * HALF_TOK), t = idx % (8 * HALF_TOK), h = t / HALF_TOK, tokl = t % HALF_TOK;
        const int dil = (g == 0) ? 1 : (g == 1 ? 4 : 16);
        const int token = half * HALF_TOK + tokl, s = token & 2047;
        bf16* qp = Q + (size_t)token * 1536 + g * 512 + h * 64;
        float q[64], o[64];
#pragma unroll
        for (int i = 0; i < 8; ++i) { const v4u w = *(const v4u*)(qp + 8 * i);
            q[8 * i + 0] = __uint_as_float(w.x << 16); q[8 * i + 1] = __uint_as_float(w.x & 0xffff0000u); q[8 * i + 2] = __uint_as_float(w.y << 16); q[8 * i + 3] = __uint_as_float(w.y & 0xffff0000u);
            q[8 * i + 4] = __uint_as_float(w.z << 16); q[8 * i + 5] = __uint_as_float(w.z & 0xffff0000u); q[8 * i + 6] = __uint_as_float(w.w << 16); q[8 * i + 7] = __uint_as_float(w.w & 0xffff0000u); }
#pragma unroll
        for (int i = 0; i < 64; ++i) o[i] = 0.f;
        float mx = -1e30f, l = 0.f;
        for (int j = -64; j <= 64; ++j) {
            const int sp = s + j * dil;
            if (sp < 0 || sp >= SEQ) continue;
            const bf16* kp = KV + (size_t)(tokl + j * dil) * 3072 + g * 1024 + h * 64;
            float sc = 0.f;
#pragma unroll
            for (int i = 0; i < 8; ++i) { const v4u w = *(const v4u*)(kp + 8 * i);
                sc += q[8 * i + 0] * __uint_as_float(w.x << 16) + q[8 * i + 1] * __uint_as_float(w.x & 0xffff0000u) + q[8 * i + 2] * __uint_as_float(w.y << 16) + q[8 * i + 3] * __uint_as_float(w.y & 0xffff0000u)
                    + q[8 * i + 4] * __uint_as_float(w.z << 16) + q[8 * i + 5] * __uint_as_float(w.z & 0xffff0000u) + q[8 * i + 6] * __uint_as_float(w.w << 16) + q[8 * i + 7] * __uint_as_float(w.w & 0xffff0000u); }
            const float mn = fmaxf(mx, sc), corr = exp2f(mx - mn), p = exp2f(sc - mn);
            l = l * corr + p; mx = mn;
            const bf16* vp = kp + 512;
#pragma unroll
            for (int i = 0; i < 8; ++i) { const v4u w = *(const v4u*)(vp + 8 * i);
                o[8 * i + 0] = o[8 * i + 0] * corr + p * __uint_as_float(w.x << 16); o[8 * i + 1] = o[8 * i + 1] * corr + p * __uint_as_float(w.x & 0xffff0000u);
                o[8 * i + 2] = o[8 * i + 2] * corr + p * __uint_as_float(w.y << 16); o[8 * i + 3] = o[8 * i + 3] * corr + p * __uint_as_float(w.y & 0xffff0000u);
                o[8 * i + 4] = o[8 * i + 4] * corr + p * __uint_as_float(w.z << 16); o[8 * i + 5] = o[8 * i + 5] * corr + p * __uint_as_float(w.z & 0xffff0000u);
                o[8 * i + 6] = o[8 * i + 6] * corr + p * __uint_as_float(w.w << 16); o[8 * i + 7] = o[8 * i + 7] * corr + p * __uint_as_float(w.w & 0xffff0000u); }
        }
        const float inv = 1.0f / l;
#pragma unroll
        for (int i = 0; i < 8; ++i) { v4u w; w.x = pk2(o[8 * i] * inv, o[8 * i + 1] * inv); w.y = pk2(o[8 * i + 2] * inv, o[8 * i + 3] * inv); w.z = pk2(o[8 * i + 4] * inv, o[8 * i + 5] * inv); w.w = pk2(o[8 * i + 6] * inv, o[8 * i + 7] * inv);
            *(v4u*)(qp + 8 * i) = w; }
        lse[((size_t)g * MTOK + token) * 8 + h] = mx + log2f(l);
    }
}

__device__ __forceinline__ void phase_combine(const Args& a, int tid, int G) {
    const bf16* Q = (const bf16*)(a.ws + WS_Q); const float* lse = (const float*)(a.ws + WS_LSE); bf16* ya = (bf16*)(a.ws + WS_YATT);
    for (int idx = blockIdx.x * NTHR + tid; idx < MTOK * 64; idx += G * NTHR) {
        const int token = idx >> 6, ch = idx & 63, h = ch >> 3;
        const float l0 = lse[((size_t)0 * MTOK + token) * 8 + h], l1 = lse[((size_t)1 * MTOK + token) * 8 + h], l2 = lse[((size_t)2 * MTOK + token) * 8 + h];
        const float mx = fmaxf(l0, fmaxf(l1, l2));
        float w0 = exp2f(l0 - mx), w1 = exp2f(l1 - mx), w2 = exp2f(l2 - mx);
        const float inv = 1.0f / (w0 + w1 + w2); w0 *= inv; w1 *= inv; w2 *= inv;
        const bf16* p = Q + (size_t)token * 1536 + ch * 8;
        const v4u a0 = *(const v4u*)p, a1 = *(const v4u*)(p + 512), a2 = *(const v4u*)(p + 1024);
        v4u o;
#define CMB(f) pk2(w0 * __uint_as_float(a0.f << 16) + w1 * __uint_as_float(a1.f << 16) + w2 * __uint_as_float(a2.f << 16), \
                   w0 * __uint_as_float(a0.f & 0xffff0000u) + w1 * __uint_as_float(a1.f & 0xffff0000u) + w2 * __uint_as_float(a2.f & 0xffff0000u))
        o.x = CMB(x); o.y = CMB(y); o.z = CMB(z); o.w = CMB(w);
#undef CMB
        *(v4u*)(ya + (size_t)token * 512 + ch * 8) = o;
    }
}

__device__ __forceinline__ void phase_final_norm(const Args& a, int lane, int wave, int G) {
    float* x = a.out; const float* gain = a.in[18];
    const int gw = blockIdx.x * NWAVES + wave, NGW = G * NWAVES;
    for (int m = gw; m < MTOK; m += NGW) {
        f32x4* xr = (f32x4*)(x + (size_t)m * DM) + lane;
        f32x4 v[4]; float s = 0.f;
#pragma unroll
        for (int j = 0; j < 4; ++j) { v[j] = xr[64 * j]; s += (v[j][0] * v[j][0] + v[j][1] * v[j][1]) + (v[j][2] * v[j][2] + v[j][3] * v[j][3]); }
        s = wave_sum(s);
        const float rs = 1.0f / sqrtf(s * (1.0f / 1024.0f) + 1e-6f);
#pragma unroll
        for (int j = 0; j < 4; ++j) { const f32x4 gn = *((const f32x4*)gain + lane + 64 * j); xr[64 * j] = v[j] * rs * gn; }
    }
}

typedef short bf16x8 __attribute__((ext_vector_type(8)));
typedef short s16x4 __attribute__((ext_vector_type(4)));
constexpr int HY_UROW = 4112, HY_ROFF = 16 * HY_UROW, HY_RSTRIDE = 8192 + 64;
__device__ __forceinline__ bf16x8 ld_frag4(const LAS unsigned char* p) {
    const LAS unsigned* q = (const LAS unsigned*)p; v4u d; d.x = q[0]; d.y = q[1]; d.z = q[2]; d.w = q[3]; return __builtin_bit_cast(bf16x8, d);
}
__device__ __forceinline__ void phase_hyena_mfma(const Args& a, LAS unsigned char* lds, int tid, int G) {
    const bf16* ut = (const bf16*)(a.ws + WS_UT); const bf16* Rg = (const bf16*)(a.ws + WS_GF); bf16* x0t = (bf16*)(a.ws + WS_X0T);
    const int lane = tid & 63, w = __builtin_amdgcn_readfirstlane(tid >> 6), i16 = lane & 15, kq = lane >> 4;
    const int base = (w >> 1) * 512 + (w & 1) * 16, cp = i16 & 1;
    const int lane_const = (2048 - base - i16 + 8 * kq - cp) >> 1;
    const LAS unsigned char* pA15 = lds + HY_ROFF + cp * HY_RSTRIDE + 4 * (lane_const - 240);
    const LAS unsigned char* pB = lds + i16 * HY_UROW + kq * 16;
    v4u pre[10];
#define HY_ISSUE(chn) do { _Pragma("unroll") for (int k_ = 0; k_ < 8; ++k_) { const int i_ = tid + NTHR * k_, b_ = i_ >> 8, ck_ = i_ & 255; pre[k_] = *(const v4u*)(ut + ((size_t)(chn) * NBATCH + b_) * SEQ + ck_ * 8); } \
        _Pragma("unroll") for (int k_ = 0; k_ < 2; ++k_) { const int i_ = tid + NTHR * k_, c2_ = i_ >> 9, ck_ = i_ & 511; pre[8 + k_] = *(const v4u*)(Rg + ((size_t)(chn) * 2 + c2_) * 4096 + ck_ * 8); } } while (0)
    for (int ch = blockIdx.x; ch < HYW; ch += G) {
        HY_ISSUE(ch);
#pragma unroll
        for (int k = 0; k < 8; ++k) { const int i = tid + NTHR * k, b = i >> 8, ck = i & 255; *(LAS v4u*)(lds + b * HY_UROW + ck * 16) = pre[k]; }
#pragma unroll
        for (int k = 0; k < 2; ++k) { const int i = tid + NTHR * k, c2 = i >> 9, ck = i & 511; *(LAS v4u*)(lds + HY_ROFF + c2 * HY_RSTRIDE + ck * 16) = pre[8 + k]; }
        __syncthreads();
        f32x4 acc[16]; bf16x8 W[16];
#pragma unroll
        for (int i = 0; i < 16; ++i) acc[i] = (f32x4){0.f, 0.f, 0.f, 0.f};
#pragma unroll
        for (int j = 1; j < 16; ++j) W[j] = ld_frag4(pA15 + 64 * (15 - j));
        W[0] = W[1];
#pragma unroll 1
        for (int tt = 0; tt < 4; ++tt) {
            const LAS unsigned char* pa = pA15 + 64 * 15 + 1024 * tt; const LAS unsigned char* pb = pB + 1024 * tt;
#pragma unroll
            for (int s = 0; s < 16; ++s) {
                W[(16 - s) & 15] = ld_frag4(pa + 64 * s);
                const bf16x8 Bf = *(const LAS bf16x8*)(pb + 64 * s);
#pragma unroll
                for (int i = 0; i < 16; ++i) acc[i] = __builtin_amdgcn_mfma_f32_16x16x32_bf16(W[(i - s) & 15], Bf, acc[i], 0, 0, 0);
            }
        }
        bf16* xo = x0t + ((size_t)ch * NBATCH + i16) * SEQ + base + 4 * kq;
#pragma unroll
        for (int i = 0; i < 16; ++i) {
            typedef unsigned u32x2v __attribute__((ext_vector_type(2)));
            const u32x2v xv = *(const u32x2v*)(xo + 32 * i);
            u32x2v o; o.x = pk2(__uint_as_float(xv.x << 16) * acc[i][0], __uint_as_float(xv.x & 0xffff0000u) * acc[i][1]);
            o.y = pk2(__uint_as_float(xv.y << 16) * acc[i][2], __uint_as_float(xv.y & 0xffff0000u) * acc[i][3]);
            *(u32x2v*)(xo + 32 * i) = o;
        }
        __syncthreads();
    }
}

__device__ __forceinline__ void phase_transpose_y(const Args& a, LAS unsigned char* lds, int tid, int G) {
    const bf16* yt = (const bf16*)(a.ws + WS_X0T); bf16* yhy = (bf16*)(a.ws + WS_YHY);
    LAS unsigned short* tile = (LAS unsigned short*)lds;
    for (int item = blockIdx.x; item < 4096; item += G) {
        const int cc = item & 7, mc = (item >> 3) & 31, b = item >> 8;
        { const int c2 = tid >> 3, ck = tid & 7;
          const v4u v = *(const v4u*)(yt + ((size_t)(cc * 64 + c2) * NBATCH + b) * SEQ + mc * 64 + ck * 8);
          LAS unsigned* t4 = (LAS unsigned*)(tile + c2 * 72 + ck * 8); t4[0] = v.x; t4[1] = v.y; t4[2] = v.z; t4[3] = v.w; }
        __syncthreads();
        { const int nl = tid >> 3, cg8 = tid & 7; const LAS unsigned short* s = tile + (cg8 * 8) * 72 + nl;
          v4u o; o.x = s[0] | ((unsigned)s[72] << 16); o.y = s[144] | ((unsigned)s[216] << 16); o.z = s[288] | ((unsigned)s[360] << 16); o.w = s[432] | ((unsigned)s[504] << 16);
          *(v4u*)(yhy + (size_t)(b * SEQ + mc * 64 + nl) * 512 + cc * 64 + cg8 * 8) = o; }
        __syncthreads();
    }
}

constexpr int AT_ROWS = 272, AT_RS = 144, AT_VOFF = AT_ROWS * AT_RS;
__device__ __forceinline__ void phase_attn_mfma(const Args& a, int half, LAS unsigned char* lds, int tid, int G) {
    bf16* Q = (bf16*)(a.ws + WS_Q); const bf16* KV = (const bf16*)(a.ws + WS_KV); float* lse = (float*)(a.ws + WS_LSE);
    const int lane = tid & 63, w = __builtin_amdgcn_readfirstlane(tid >> 6), q16 = lane & 15, kq = lane >> 4;
    v4u pre[9];
#define AT_DECODE(unit_) const int g = (unit_) >> 10, u = (unit_) & 1023, sub = u & 15, h = (u >> 4) & 7, bl = u >> 7; int dil, n, r, qb; \
        if (g == 0) { dil = 1; n = 2048; r = 0; qb = sub; } else if (g == 1) { dil = 4; n = 512; r = sub >> 2; qb = sub & 3; } else { dil = 16; n = 128; r = sub; qb = 0; } \
        const int q0 = qb * 128, kb0 = q0 - 64; (void)kb0; (void)q0;
#define AT_ISSUE(unit_) do { AT_DECODE(unit_) _Pragma("unroll") for (int k_ = 0; k_ < 9; ++k_) { const int i_ = tid + NTHR * k_; \
            const int which_ = (i_ >= AT_ROWS * 8) ? 1 : 0, j_ = i_ - which_ * AT_ROWS * 8, rr_ = j_ >> 3, ck_ = j_ & 7, key_ = kb0 + rr_; \
            pre[k_] = (v4u){0u, 0u, 0u, 0u}; \
            if (i_ < 2 * AT_ROWS * 8 && key_ >= 0 && key_ < n) pre[k_] = *(const v4u*)(KV + (size_t)(bl * SEQ + key_ * dil + r) * 3072 + g * 1024 + which_ * 512 + h * 64 + ck_ * 8); } } while (0)
    if ((int)blockIdx.x < 3072) AT_ISSUE((int)blockIdx.x);
    for (int unit = blockIdx.x; unit < 3072; unit += G) {
#pragma unroll
        for (int k = 0; k < 9; ++k) { const int i = tid + NTHR * k; const int which = (i >= AT_ROWS * 8) ? 1 : 0, j = i - which * AT_ROWS * 8, rr = j >> 3, ck = j & 7;
            if (i < 2 * AT_ROWS * 8) *(LAS v4u*)(lds + which * AT_VOFF + rr * AT_RS + ck * 16) = pre[k]; }
        __syncthreads();
        if (unit + G < 3072) AT_ISSUE(unit + G);
        AT_DECODE(unit)
        {
            const int i0 = q0 + 16 * w;
            const int token = half * HALF_TOK + bl * SEQ + (i0 + q16) * dil + r;
            bf16* qp = Q + (size_t)token * 1536 + g * 512 + h * 64;
            const bf16x8 Qf0 = *(const bf16x8*)(qp + 8 * kq), Qf1 = *(const bf16x8*)(qp + 32 + 8 * kq);
            f32x4 acc[4];
#pragma unroll
            for (int dt = 0; dt < 4; ++dt) acc[dt] = (f32x4){0.f, 0.f, 0.f, 0.f};
            float mrun = -1e30f, lrun = 0.f;
            const LAS unsigned char* kbase = lds + (16 * w + q16) * AT_RS + 16 * kq;
            const LAS unsigned char* vbase = lds + AT_VOFF + (16 * w + 4 * kq + (q16 >> 2)) * AT_RS + 8 * (q16 & 3);
#pragma unroll 1
            for (int st = 0; st < 5; ++st) {
                f32x4 s[2];
#pragma unroll
                for (int hh = 0; hh < 2; ++hh) {
                    const int kt = 2 * st + hh;
                    const LAS unsigned char* kp = kbase + kt * 16 * AT_RS;
                    const bf16x8 K0 = *(const LAS bf16x8*)kp, K1 = *(const LAS bf16x8*)(kp + 64);
                    f32x4 z = (f32x4){0.f, 0.f, 0.f, 0.f};
                    z = __builtin_amdgcn_mfma_f32_16x16x32_bf16(K0, Qf0, z, 0, 0, 0);
                    z = __builtin_amdgcn_mfma_f32_16x16x32_bf16(K1, Qf1, z, 0, 0, 0);
#pragma unroll
                    for (int e = 0; e < 4; ++e) {
                        const int rel = 16 * kt - 64 + 4 * kq + e - q16, j = i0 + q16 + rel;
                        const bool ok = (rel >= -64) && (rel <= 64) && (j >= 0) && (j < n);
                        z[e] = ok ? z[e] : -1e30f;
                    }
                    s[hh] = z;
                }
                float mx = fmaxf(fmaxf(fmaxf(s[0][0], s[0][1]), fmaxf(s[0][2], s[0][3])), fmaxf(fmaxf(s[1][0], s[1][1]), fmaxf(s[1][2], s[1][3])));
                mx = fmaxf(mx, __shfl_xor(mx, 16)); mx = fmaxf(mx, __shfl_xor(mx, 32));
                const float mn = fmaxf(mrun, mx), corr = exp2f(mrun - mn);
                mrun = mn;
                float p[8], ps = 0.f;
#pragma unroll
                for (int e = 0; e < 4; ++e) { p[e] = exp2f(s[0][e] - mn); p[4 + e] = exp2f(s[1][e] - mn); ps += p[e] + p[4 + e]; }
                lrun = lrun * corr + ps;
                v4u pw; pw.x = pk2(p[0], p[1]); pw.y = pk2(p[2], p[3]); pw.z = pk2(p[4], p[5]); pw.w = pk2(p[6], p[7]);
                const bf16x8 Pf = __builtin_bit_cast(bf16x8, pw);
#pragma unroll
                for (int dt = 0; dt < 4; ++dt) {
                    const LAS unsigned char* vp = vbase + 32 * st * AT_RS + 32 * dt;
                    const s16x4 v0 = __builtin_amdgcn_ds_read_tr16_b64_v4i16((LAS s16x4*)vp);
                    const s16x4 v1 = __builtin_amdgcn_ds_read_tr16_b64_v4i16((LAS s16x4*)(vp + 16 * AT_RS));
                    const bf16x8 Vf = (bf16x8){v0[0], v0[1], v0[2], v0[3], v1[0], v1[1], v1[2], v1[3]};
                    acc[dt] = acc[dt] * corr;
                    acc[dt] = __builtin_amdgcn_mfma_f32_16x16x32_bf16(Vf, Pf, acc[dt], 0, 0, 0);
                }
            }
            lrun += __shfl_xor(lrun, 16); lrun += __shfl_xor(lrun, 32);
            const float inv = 1.0f / lrun;
            typedef unsigned u32x2v __attribute__((ext_vector_type(2)));
#pragma unroll
            for (int dt = 0; dt < 4; ++dt) {
                u32x2v o; o.x = pk2(acc[dt][0] * inv, acc[dt][1] * inv); o.y = pk2(acc[dt][2] * inv, acc[dt][3] * inv);
                *(u32x2v*)(qp + 16 * dt + 4 * kq) = o;
            }
            if (kq == 0) lse[((size_t)g * MTOK + token) * 8 + h] = mrun + log2f(lrun);
        }
        __syncthreads();
    }
}

#define XB_TMO      128
#define XB_XCNT(j)  (256  + 64 * (j))
#define XB_XSUB(j)  (1280 + 64 * (j))
#define XB_XGEN(j)  (2304 + 64 * (j))
#define XB_TOP      3328
#define XB_TOPGEN   3392
#define XCD_BAR_WORDS 3456
#define XB_SPIN_CAP (1u << 18)

__device__ __forceinline__ unsigned xb_ld(unsigned* p)              { return __hip_atomic_load(p, __ATOMIC_RELAXED, __HIP_MEMORY_SCOPE_AGENT); }
__device__ __forceinline__ unsigned xb_add(unsigned* p, unsigned v) { return __hip_atomic_fetch_add(p, v, __ATOMIC_RELAXED, __HIP_MEMORY_SCOPE_AGENT); }
__device__ __forceinline__ unsigned xb_xcc_id() { return (unsigned)__builtin_amdgcn_s_getreg((3 << 11) | 20) & 0xFu; }
#define XB_SPIN(cond, bar) do { unsigned _sp = 0; while (cond) { __builtin_amdgcn_s_sleep(1); \
    if ((++_sp & 255u) == 0u) { if (xb_ld(&(bar)[XB_TMO])) break; if (_sp > XB_SPIN_CAP) { atomicAdd(&(bar)[XB_TMO], 1u); break; } } } } while (0)

struct XcdBarrier {
    unsigned* bar; unsigned x;
    volatile LAS unsigned* st;
};

__device__ __forceinline__ XcdBarrier xcd_barrier_post(unsigned* bar, volatile LAS unsigned* st) {
    XcdBarrier b; b.bar = bar; b.x = xb_xcc_id(); b.st = st;
    if (threadIdx.x == 0) (void)xb_add(&bar[XB_XCNT(b.x)], 1u);
    return b;
}
__device__ __forceinline__ void xcd_barrier_complete(unsigned* bar, unsigned x, unsigned& nloc, unsigned& nx) {
    const unsigned G = gridDim.x * gridDim.y * gridDim.z;
    unsigned sum, cnt, mine, sp = 0u;
    for (;;) {
        sum = 0u; cnt = 0u; mine = 0u;
#pragma unroll
        for (unsigned j = 0; j < 16; ++j) { const unsigned c = xb_ld(&bar[XB_XCNT(j)]); sum += c; cnt += (c > 0u) ? 1u : 0u; mine = (j == x) ? c : mine; }
        if (sum == G) break;
        __builtin_amdgcn_s_sleep(1);
        if ((++sp & 255u) == 0u) { if (xb_ld(&bar[XB_TMO])) break; if (sp > XB_SPIN_CAP) { atomicAdd(&bar[XB_TMO], 1u); break; } }
    }
    nloc = mine > 0u ? mine : 1u; nx = cnt > 0u ? cnt : 1u;
}

__device__ __forceinline__ void xcd_barrier(const XcdBarrier& b) {
    asm volatile("s_waitcnt vmcnt(0)" ::: "memory");
    __syncthreads();
    if (threadIdx.x == 0) {
        unsigned* bar = b.bar;
        __builtin_amdgcn_s_waitcnt(0);
        unsigned nloc = b.st[0], nx = b.st[1];
        if (nloc == 0u) { xcd_barrier_complete(bar, b.x, nloc, nx); b.st[0] = nloc; b.st[1] = nx; }
        const unsigned old = xb_add(&bar[XB_XSUB(b.x)], 1u);
        const unsigned gen = old / nloc;
        if (old + 1u == (gen + 1u) * nloc) {
            __builtin_amdgcn_fence(__ATOMIC_RELEASE, "agent");
            asm volatile("s_waitcnt vmcnt(0)" ::: "memory");
            const unsigned og = xb_add(&bar[XB_TOP], 1u);
            const unsigned tg = og / nx;
            if (og + 1u == (tg + 1u) * nx) xb_add(&bar[XB_TOPGEN], 1u);
            else XB_SPIN(xb_ld(&bar[XB_TOPGEN]) == tg, bar);
            __builtin_amdgcn_fence(__ATOMIC_ACQUIRE, "agent");
            xb_add(&bar[XB_XGEN(b.x)], 1u);
            asm volatile("s_waitcnt vmcnt(0)" ::: "memory");
        } else {
            XB_SPIN(xb_ld(&bar[XB_XGEN(b.x)]) == gen, bar);
            __builtin_amdgcn_fence(__ATOMIC_ACQUIRE, "agent");
            asm volatile("s_waitcnt vmcnt(0)" ::: "memory");
        }
    }
    __syncthreads();
}

#define GEMM_CALL(EPI, SCHED, g, S, E) pg8::gemm_phase<EPI, SCHED, true, true>(lds, g, S, E)
#ifndef PROBE_G
#define PROBE_G 0
#endif
#ifndef PROBE_S
#define PROBE_S 0
#endif
#define GEMM_CALL_P(EPI, SCHED, g, S, E) do { _Pragma("unroll 1") for (int rep_ = 0; rep_ < 1 + PROBE_G; ++rep_) { GEMM_CALL(EPI, SCHED, g, S, E); } } while (0)
#define REP_S _Pragma("unroll 1") for (int rep_ = 0; rep_ < 1 + PROBE_S; ++rep_)

typedef const __attribute__((address_space(4))) Args* KArgs;
__device__ __forceinline__ Args load_args() {
#if defined(__HIP_DEVICE_COMPILE__)
    KArgs p = (KArgs)__builtin_amdgcn_kernarg_segment_ptr();
    asm volatile("" : "+s"(p));
    return *p;
#else
    return Args{};
#endif
}
__global__ void __launch_bounds__(NTHR, 2) fwd_megakernel(Args a_unused) {
    extern __shared__ __attribute__((aligned(16))) unsigned char lds_raw[];
    LAS unsigned char* lds = (LAS unsigned char*)lds_raw;
    cg::grid_group grid = cg::this_grid();
    const int tid0 = threadIdx.x, G0 = gridDim.x, bx0 = blockIdx.x;
    if (tid0 < 2) ((LAS unsigned*)(lds + LDS_ST_OFF))[tid0] = 0u;
    __syncthreads();
    { const Args a0 = load_args(); (void)xcd_barrier_post((unsigned*)(a0.ws + WS_BAR), (volatile LAS unsigned*)(lds + LDS_ST_OFF)); }
#define GSYNC() do { const Args ab = load_args(); XcdBarrier xb_; xb_.bar = (unsigned*)(ab.ws + WS_BAR); xb_.x = xb_xcc_id(); xb_.st = (volatile LAS unsigned*)(lds + LDS_ST_OFF); xcd_barrier(xb_); } while (0)
#define PTRS() const Args a = load_args(); int tid = tid0, G = G0, bx = bx0; asm volatile("" : "+v"(tid), "+s"(G), "+s"(bx)); const int lane = tid & 63, wave = __builtin_amdgcn_readfirstlane(tid >> 6); (void)lane; (void)wave; unsigned char* ws = a.ws; bf16* Wb = (bf16*)(ws + WS_W); const pg8::bf16_t* xb = (const pg8::bf16_t*)(ws + WS_XB); \
    const float* rcos = (const float*)(ws + WS_ROPE); const float* rsin = rcos + 65536; float* ssqA = (float*)(ws + WS_SSQA); float* ssqB = (float*)(ws + WS_SSQB); \
    (void)Wb; (void)xb; (void)rcos; (void)rsin; (void)ssqA; (void)ssqB;
#define GIN() pg8::Gemm gin{xb, (const pg8::bf16_t*)(Wb + W_IN / 2), nullptr, nullptr, MTOK, NIN, DM}; \
    pg8::EpiIn Ein{(pg8::bf16_t*)(ws + WS_HY), (pg8::bf16_t*)(ws + WS_Q), (pg8::bf16_t*)(ws + WS_KV), (pg8::bf16_t*)(ws + WS_GATES), ssqA, rcos, rsin, 0};

#pragma unroll 1
    for (int L = 0; L < 2; ++L) {
        REP_S { PTRS(); phase_prep_weights(a, L, lds, tid, lane, wave, G); }
        if (L == 0) grid.sync(); else GSYNC();
        {
            PTRS(); GIN();
            pg8::TwoRect S; S.a.init(128, 12, 0, 0, G, bx); S.b.init(64, 12, 0, 12, G, bx); S.na = S.a.count();
            GEMM_CALL_P(pg8::EpiIn, pg8::TwoRect, gin, S, Ein);
        }
        GSYNC();
        { PTRS(); phase_attn_mfma(a, 0, lds, tid, G); REP_S { phase_prep_u(a, L, lds, tid, G); } }
        GSYNC();
        {
            PTRS(); GIN();
            pg8::RectOrder S; S.init(64, 12, 64, 12, G, bx);
            Ein.kv_row0 = HALF_TOK;
            GEMM_CALL_P(pg8::EpiIn, pg8::RectOrder, gin, S, Ein);
        }
        { PTRS(); phase_hyena_mfma(a, lds, tid, G); }
        GSYNC();
        { PTRS(); phase_attn_mfma(a, 1, lds, tid, G); }
        {
            PTRS(); GIN();
            pg8::RectOrder S; S.init(128, 8, 0, 24, G, bx);
            GEMM_CALL_P(pg8::EpiIn, pg8::RectOrder, gin, S, Ein);
        }
        GSYNC();
        REP_S { PTRS(); phase_combine(a, tid, G); phase_transpose_y(a, lds, tid, G); }
        GSYNC();
        {
            PTRS();
            pg8::Gemm g{(const pg8::bf16_t*)(ws + WS_YHY), (const pg8::bf16_t*)(Wb + W_PHY / 2), (const pg8::bf16_t*)(ws + WS_YATT), (const pg8::bf16_t*)(Wb + W_PATT / 2), MTOK, DM, 512};
            pg8::PairOrder S; S.r.init(128, 4, 0, 0, G, bx);
            pg8::EpiGate E{(const pg8::bf16_t*)(ws + WS_GATES), (pg8::bf16_t*)(ws + WS_MERGED)};
            GEMM_CALL_P(pg8::EpiGate, pg8::PairOrder, g, S, E);
        }
        GSYNC();
        {
            PTRS();
            pg8::Gemm g{(const pg8::bf16_t*)(ws + WS_MERGED), (const pg8::bf16_t*)(Wb + W_O / 2), nullptr, nullptr, MTOK, DM, DM};
            pg8::RectOrder S; S.init(128, 4, 0, 0, G, bx);
            pg8::EpiRes E{L == 0 ? a.in[0] : a.out, a.out, (pg8::bf16_t*)(ws + WS_XB), ssqB};
            GEMM_CALL(pg8::EpiRes, pg8::RectOrder, g, S, E);
        }
        GSYNC();
        {
            PTRS();
            pg8::Gemm g{xb, (const pg8::bf16_t*)(Wb + W_FF1 / 2), nullptr, nullptr, MTOK, DFF, DM};
            pg8::RectOrder S; S.init(128, 16, 0, 0, G, bx);
            pg8::EpiFF1 E{(pg8::bf16_t*)(ws + WS_H), ssqB};
            GEMM_CALL_P(pg8::EpiFF1, pg8::RectOrder, g, S, E);
        }
        GSYNC();
        {
            PTRS();
            pg8::Gemm g{(const pg8::bf16_t*)(ws + WS_H), (const pg8::bf16_t*)(Wb + W_FF2 / 2), nullptr, nullptr, MTOK, DM, DFF};
            pg8::RectOrder S; S.init(128, 4, 0, 0, G, bx);
            pg8::EpiRes E{a.out, a.out, (pg8::bf16_t*)(ws + WS_XB), ssqA};
            GEMM_CALL(pg8::EpiRes, pg8::RectOrder, g, S, E);
        }
        GSYNC();
    }
    { PTRS(); phase_final_norm(a, lane, wave, G); }
}

extern "C" void kernel_launch(void* const* d_in, const int* in_sizes, int n_in, void* d_out, int out_size, void* d_ws, size_t ws_size, hipStream_t stream) {
    static int grid = 0;
    if (grid == 0) {
        if (n_in != 19 || in_sizes[0] != MTOK * DM || out_size != MTOK * DM || ws_size < WS_END) {
            fprintf(stderr, "kernel_launch: unexpected shapes / workspace (n_in %d, ws %zu, need %zu); nothing launched\n", n_in, ws_size, (size_t)WS_END); grid = -1; return; }
        int dev = 0, cus = 0, per_cu = 0;
        (void)hipGetDevice(&dev); (void)hipDeviceGetAttribute(&cus, hipDeviceAttributeMultiprocessorCount, dev);
        if (hipFuncSetAttribute((const void*)fwd_megakernel, hipFuncAttributeMaxDynamicSharedMemorySize, LDS_BYTES) != hipSuccess) { fprintf(stderr, "kernel_launch: hipFuncSetAttribute failed\n"); grid = -1; return; }
        if (hipOccupancyMaxActiveBlocksPerMultiprocessor(&per_cu, (const void*)fwd_megakernel, NTHR, LDS_BYTES) != hipSuccess || per_cu < 1) { fprintf(stderr, "kernel_launch: occupancy query gives %d\n", per_cu); per_cu = 1; }
        (void)hipGetLastError();
        grid = cus * 1;
        if (grid % 8 != 0 || grid > 256) grid = (grid > 256) ? 256 : (grid / 8) * 8;
    }
    if (grid < 0) return;
    Args a{};
    for (int i = 0; i < 19; ++i) a.in[i] = (const float*)d_in[i];
    a.out = (float*)d_out; a.ws = (unsigned char*)d_ws;
    if (hipMemsetAsync((char*)d_ws + WS_BAR, 0, 16384, stream) != hipSuccess) { fprintf(stderr, "kernel_launch: memset of the barrier words failed\n"); return; }
    void* args[] = {&a};
    hipError_t e = hipLaunchCooperativeKernel((const void*)fwd_megakernel, dim3(grid), dim3(NTHR), args, LDS_BYTES, stream);
    if (e != hipSuccess) fprintf(stderr, "cooperative launch failed: %s (grid %d)\n", hipGetErrorString(e), grid);
}
```

```cpp
#include <hip/hip_runtime.h>
#include <hip/hip_cooperative_groups.h>
#include <cstdio>
#include <cstdint>
namespace cg = cooperative_groups;

namespace pg8 {
#define PG8_LAS __attribute__((address_space(3)))
typedef unsigned short bf16_t;
typedef short bf16x8 __attribute__((ext_vector_type(8)));
typedef float f32x4 __attribute__((ext_vector_type(4)));
typedef unsigned u32x4 __attribute__((ext_vector_type(4)));
constexpr int BM = 256, BK = 64, HALF = 128, HTB = HALF * BK * 2  , STAGE_BYTES = 8 * HTB, NXCD = 8, WGM = 8;

__host__ __device__ __forceinline__ int lds_byte(int r, int c) { const int st = (r >> 4) * 2 + (c >> 5), rr = r & 15, cc = c & 31, ob = rr * 64 + cc * 2; return st * 1024 + (ob ^ (((ob >> 9) & 1) << 5)); }
__host__ __device__ __forceinline__ void stage_rc(int b, int& R, int& C) { const int st = b / 1024, sb = b % 1024, swz = sb ^ (((sb >> 9) & 1) << 5); R = (st >> 1) * 16 + swz / 64; C = (st & 1) * 32 + (swz % 64) / 2; }
__host__ __device__ __forceinline__ int perm32(int rho) { const int n = rho >> 4, i = rho & 15; return 8 * (i >> 2) + 4 * n + (i & 3); }

struct Unit { int pm, pn, z; };
struct Gemm { const bf16_t* A; const bf16_t* Bt; const bf16_t* A1; const bf16_t* Bt1; int M, N, K; };

struct StaticOrder {
    int nM, nN, nwg, G, c;
    __host__ __device__ void init(int M, int N, int G_, int c_) { nM = M / BM; nN = N / BM; nwg = nM * nN; G = G_; c = c_; }
    __host__ __device__ bool next(int i, Unit& u) const {
        const long L = (long)i * G + c; if (L >= nwg) return false;
        int wgid = (int)L; { const int q = nwg / NXCD, r = nwg % NXCD, xcd = wgid % NXCD, off = wgid / NXCD; wgid = (xcd < r ? xcd * (q + 1) : r * (q + 1) + (xcd - r) * q) + off; }
        const int nig = WGM * nN, gid = wgid / nig, fm = gid * WGM, gsz = (nM - fm) < WGM ? (nM - fm) : WGM;
        u.pm = fm + ((wgid % nig) % gsz); u.pn = (wgid % nig) / gsz; return true;
    }
    __device__ __forceinline__ void a_ready(const Unit&) const {}
    __device__ __forceinline__ void done(const Unit&) const {}
};


__device__ __forceinline__ unsigned cvt_pk_bf16(float lo, float hi) { unsigned r; asm volatile("v_cvt_pk_bf16_f32 %0, %1, %2" : "=v"(r) : "v"(lo), "v"(hi)); return r; }
__device__ __forceinline__ float bf_lo(unsigned w) { return __uint_as_float(w << 16); }
__device__ __forceinline__ float bf_hi(unsigned w) { return __uint_as_float(w & 0xffff0000u); }

struct RectOrder {
    int nN, nwg, G, c, pm0, pn0;
    __device__ __forceinline__ void init(int nM_, int nN_, int pm0_, int pn0_, int G_, int c_) { nN = nN_; nwg = nM_ * nN_; G = G_; c = c_; pm0 = pm0_; pn0 = pn0_; }
    __device__ __forceinline__ int count() const { return nwg > c ? (nwg - c + G - 1) / G : 0; }
    __device__ __forceinline__ bool next(int i, Unit& u) const {
        const long L = (long)i * G + c; if (L >= nwg) return false;
        int w = (int)L;
        if ((nwg & 7) == 0 && (G & 7) == 0) w = (c & 7) * (nwg >> 3) + (w >> 3);
        const int nig = 8 * nN, gid = w / nig, r = w % nig;
        u.pm = pm0 + gid * 8 + (r & 7); u.pn = pn0 + (r >> 3); u.z = 0; return true;
    }
    __device__ __forceinline__ void a_ready(const Unit&) const {}
    __device__ __forceinline__ void done(const Unit&) const {}
};
struct TwoRect {
    RectOrder a, b; int na;
    __device__ __forceinline__ bool next(int i, Unit& u) const { return i < na ? a.next(i, u) : b.next(i - na, u); }
    __device__ __forceinline__ void a_ready(const Unit&) const {}
    __device__ __forceinline__ void done(const Unit&) const {}
};
struct PairOrder {
    RectOrder r;
    __device__ __forceinline__ bool next(int i, Unit& u) const { const bool ok = r.next(i >> 1, u); u.z = i & 1; return ok; }
    __device__ __forceinline__ void a_ready(const Unit&) const {}
    __device__ __forceinline__ void done(const Unit&) const {}
};

constexpr float RMS_EPS = 1e-6f;
constexpr float QSCALE = 0.125f * 1.44269504088896341f;

__device__ __forceinline__ float row_rstd(const float* ssq, int row) {
    const f32x4* p = (const f32x4*)(ssq + (size_t)row * 16);
    const f32x4 a = p[0], b = p[1], c = p[2], d = p[3];
    const float s = ((a[0] + a[1]) + (a[2] + a[3])) + ((b[0] + b[1]) + (b[2] + b[3])) + ((c[0] + c[1]) + (c[2] + c[3])) + ((d[0] + d[1]) + (d[2] + d[3]));
    return 1.0f / sqrtf(s * (1.0f / 1024.0f) + RMS_EPS);
}

struct EpiIn {
    static constexpr bool PERM = true, AFTER_DRAIN = false;
    bf16_t* hy; bf16_t* q; bf16_t* kv; bf16_t* gates; const float* ssq; const float* rcos; const float* rsin; int kv_row0;
    __device__ __forceinline__ bool operator()(f32x4 (&acc)[2][2][4][2], const Unit& u, int wr, int wc, int fr, int fq) const {
        const int pn = u.pn; int type, ldc, colt, rowoff = 0; bf16_t* base;
        if (pn < 6) { type = 0; base = hy; ldc = 1536; colt = pn * 256; }
        else if (pn < 12) { type = 1; base = q; ldc = 1536; colt = (pn - 6) * 256; }
        else if (pn < 24) { const int idx = pn - 12; type = ((idx >> 1) & 1) ? 0 : 2; base = kv; ldc = 3072; colt = idx * 256; rowoff = kv_row0; }
        else { type = 3; base = gates; ldc = 2048; colt = (pn - 24) * 256; }
#pragma unroll
        for (int ai = 0; ai < 2; ++ai)
#pragma unroll
            for (int m = 0; m < 4; ++m) {
                const int row = u.pm * BM + ai * HALF + wr * 64 + m * 16 + fr;
                const float rs = row_rstd(ssq, row);
                bf16_t* rowp = base + (size_t)(row - rowoff) * ldc + colt;
                f32x4 v00 = acc[ai][0][m][0] * rs, v01 = acc[ai][0][m][1] * rs, v10 = acc[ai][1][m][0] * rs, v11 = acc[ai][1][m][1] * rs;
                if (type == 1 || type == 2) {
                    const int pos = row & 2047;
                    const f32x4 c0 = *(const f32x4*)(rcos + pos * 32 + 8 * fq), c1 = *(const f32x4*)(rcos + pos * 32 + 8 * fq + 4);
                    const f32x4 s0 = *(const f32x4*)(rsin + pos * 32 + 8 * fq), s1 = *(const f32x4*)(rsin + pos * 32 + 8 * fq + 4);
                    const float sc = (type == 1) ? QSCALE : 1.0f;
                    const f32x4 o00 = (v00 * c0 - v10 * s0) * sc, o01 = (v01 * c1 - v11 * s1) * sc;
                    const f32x4 o10 = (v10 * c0 + v00 * s0) * sc, o11 = (v11 * c1 + v01 * s1) * sc;
                    u32x4 w0, w1;
                    w0.x = cvt_pk_bf16(o00[0], o00[1]); w0.y = cvt_pk_bf16(o00[2], o00[3]); w0.z = cvt_pk_bf16(o01[0], o01[1]); w0.w = cvt_pk_bf16(o01[2], o01[3]);
                    w1.x = cvt_pk_bf16(o10[0], o10[1]); w1.y = cvt_pk_bf16(o10[2], o10[3]); w1.z = cvt_pk_bf16(o11[0], o11[1]); w1.w = cvt_pk_bf16(o11[2], o11[3]);
                    *(u32x4*)(rowp + wc * 64 + 8 * fq) = w0;
                    *(u32x4*)(rowp + wc * 64 + 8 * fq + 32) = w1;
                } else {
                    if (type == 3) {
#pragma unroll
                        for (int e = 0; e < 4; ++e) {
                            v00[e] = 1.0f / (1.0f + __expf(-v00[e])); v01[e] = 1.0f / (1.0f + __expf(-v01[e]));
                            v10[e] = 1.0f / (1.0f + __expf(-v10[e])); v11[e] = 1.0f / (1.0f + __expf(-v11[e]));
                        }
                    }
                    u32x4 w0, w1;
                    w0.x = cvt_pk_bf16(v00[0], v00[1]); w0.y = cvt_pk_bf16(v00[2], v00[3]); w0.z = cvt_pk_bf16(v01[0], v01[1]); w0.w = cvt_pk_bf16(v01[2], v01[3]);
                    w1.x = cvt_pk_bf16(v10[0], v10[1]); w1.y = cvt_pk_bf16(v10[2], v10[3]); w1.z = cvt_pk_bf16(v11[0], v11[1]); w1.w = cvt_pk_bf16(v11[2], v11[3]);
                    *(u32x4*)(rowp + wc * 32 + 8 * fq) = w0;
                    *(u32x4*)(rowp + wc * 32 + 8 * fq + HALF) = w1;
                }
            }
        return false;
    }
};

struct EpiGate {
    static constexpr bool PERM = true, AFTER_DRAIN = false;
    const bf16_t* gates; bf16_t* merged;
    __device__ __forceinline__ bool operator()(f32x4 (&acc)[2][2][4][2], const Unit& u, int wr, int wc, int fr, int fq) const {
#pragma unroll
        for (int ai = 0; ai < 2; ++ai)
#pragma unroll
            for (int m = 0; m < 4; ++m) {
                const int row = u.pm * BM + ai * HALF + wr * 64 + m * 16 + fr;
                const int col0 = u.pn * BM + wc * 32 + 8 * fq;
#pragma unroll
                for (int bj = 0; bj < 2; ++bj) {
                    const u32x4 ga = *(const u32x4*)(gates + (size_t)row * 2048 + 1024 + col0 + bj * HALF);
                    f32x4 a0 = (f32x4){bf_lo(ga.x), bf_hi(ga.x), bf_lo(ga.y), bf_hi(ga.y)}, a1 = (f32x4){bf_lo(ga.z), bf_hi(ga.z), bf_lo(ga.w), bf_hi(ga.w)};
                    if (u.z == 0) {
                        const u32x4 gh = *(const u32x4*)(gates + (size_t)row * 2048 + col0 + bj * HALF);
                        const f32x4 h0 = (f32x4){bf_lo(gh.x), bf_hi(gh.x), bf_lo(gh.y), bf_hi(gh.y)}, h1 = (f32x4){bf_lo(gh.z), bf_hi(gh.z), bf_lo(gh.w), bf_hi(gh.w)};
#pragma unroll
                        for (int e = 0; e < 4; ++e) { a0[e] = fmaxf(a0[e], 1e-30f); a1[e] = fmaxf(a1[e], 1e-30f); }
                        acc[ai][bj][m][0] = acc[ai][bj][m][0] * (h0 / a0);
                        acc[ai][bj][m][1] = acc[ai][bj][m][1] * (h1 / a1);
                    } else {
                        const f32x4 v0 = acc[ai][bj][m][0] * a0, v1 = acc[ai][bj][m][1] * a1;
                        u32x4 w; w.x = cvt_pk_bf16(v0[0], v0[1]); w.y = cvt_pk_bf16(v0[2], v0[3]); w.z = cvt_pk_bf16(v1[0], v1[1]); w.w = cvt_pk_bf16(v1[2], v1[3]);
                        *(u32x4*)(merged + (size_t)row * 1024 + col0 + bj * HALF) = w;
                    }
                }
            }
        return u.z == 0;
    }
};

struct EpiRes {
    static constexpr bool PERM = false, AFTER_DRAIN = false;
    const float* base; float* out; bf16_t* xb; float* ssq;
    __device__ __forceinline__ bool operator()(f32x4 (&acc)[2][2][4][2], const Unit& u, int wr, int wc, int fr, int fq) const {
        typedef unsigned u32x2v __attribute__((ext_vector_type(2)));
        int rl = wr * 64 + fr, cl = wc * 32 + 4 * fq;
        asm volatile("" : "+v"(rl), "+v"(cl));
#pragma unroll
        for (int ai = 0; ai < 2; ++ai)
#pragma unroll
            for (int m = 0; m < 4; ++m) {
                const int row = u.pm * BM + ai * HALF + m * 16 + rl;
                const size_t off = (size_t)row * 1024 + u.pn * BM + cl;
                float s = 0.f;
#pragma unroll
                for (int bj = 0; bj < 2; ++bj)
#pragma unroll
                    for (int n = 0; n < 2; ++n) {
                        const f32x4 o = *(const f32x4*)(base + off + bj * HALF + n * 16) + acc[ai][bj][m][n];
                        *(f32x4*)(out + off + bj * HALF + n * 16) = o;
                        u32x2v w; w.x = cvt_pk_bf16(o[0], o[1]); w.y = cvt_pk_bf16(o[2], o[3]);
                        *(u32x2v*)(xb + off + bj * HALF + n * 16) = w;
                        s += (o[0] * o[0] + o[1] * o[1]) + (o[2] * o[2] + o[3] * o[3]);
                    }
                s += __shfl_xor(s, 16); s += __shfl_xor(s, 32);
                if (fq == 0) ssq[(size_t)row * 16 + u.pn * 4 + wc] = s;
                asm volatile("" ::: "memory");
            }
        return false;
    }
};

struct EpiFF1 {
    static constexpr bool PERM = true, AFTER_DRAIN = false;
    bf16_t* h; const float* ssq;
    __device__ __forceinline__ bool operator()(f32x4 (&acc)[2][2][4][2], const Unit& u, int wr, int wc, int fr, int fq) const {
#pragma unroll
        for (int ai = 0; ai < 2; ++ai)
#pragma unroll
            for (int m = 0; m < 4; ++m) {
                const int row = u.pm * BM + ai * HALF + wr * 64 + m * 16 + fr;
                const float rs = row_rstd(ssq, row);
                bf16_t* rowp = h + (size_t)row * 4096 + u.pn * BM + wc * 32 + 8 * fq;
#pragma unroll
                for (int bj = 0; bj < 2; ++bj) {
                    f32x4 v0 = acc[ai][bj][m][0] * rs, v1 = acc[ai][bj][m][1] * rs;
#pragma unroll
                    for (int e = 0; e < 4; ++e) { v0[e] = fmaxf(v0[e], 0.f); v1[e] = fmaxf(v1[e], 0.f); }
                    v0 = v0 * v0; v1 = v1 * v1;
                    u32x4 w; w.x = cvt_pk_bf16(v0[0], v0[1]); w.y = cvt_pk_bf16(v0[2], v0[3]); w.z = cvt_pk_bf16(v1[0], v1[1]); w.w = cvt_pk_bf16(v1[2], v1[3]);
                    *(u32x4*)(rowp + bj * HALF) = w;
                }
            }
        return false;
    }
};

template <class Epi, class Sched, bool ALIGN_EPI = false, bool SP2 = false>
__device__ __forceinline__ void gemm_phase(PG8_LAS unsigned char* lds, const Gemm g, const Sched& S, const Epi& E) {
    int tid_ = threadIdx.x; asm volatile("" : "+v"(tid_));
    const int tid = tid_, wid = __builtin_amdgcn_readfirstlane(tid >> 6), lane = tid & 63, wr = wid >> 2, wc = wid & 3, fr = lane & 15, fq = lane >> 4;
    const int K = g.K, nt = K / BK;
    unsigned voffA[2], voffB[2];
#pragma unroll
    for (int i = 0; i < 2; ++i) { int R, C; stage_rc(tid * 16 + i * 8192, R, C); const int Rb = Epi::PERM ? ((R & ~31) + perm32(R & 31)) : R;
        voffA[i] = (unsigned)(R * K + C) * 2u; voffB[i] = (unsigned)(Rb * K + C) * 2u; }
    const size_t kstep = (size_t)(BK * 2);
    const size_t hstep = (size_t)HALF * K * 2;
    const size_t tstep = 2 * hstep;
    const unsigned ldsw = (unsigned)wid * 1024u;
    const int aoff = lds_byte(wr * 64 + fr, fq * 8), boff = lds_byte(wc * 32 + fr, fq * 8);
#define PG8_SA(b, h) (((b) * 2 + (h)) * HTB)
#define PG8_SB(b, h) ((4 + (b) * 2 + (h)) * HTB)
#define PG8_STAGE(bufoff, gbase, voff) do { _Pragma("unroll") for (int _i = 0; _i < 2; ++_i) \
        __builtin_amdgcn_global_load_lds((const unsigned*)((const char*)(gbase) + (voff)[_i]), (PG8_LAS unsigned*)(lds + (bufoff) + ldsw + _i * 8192), 16, 0, 0); } while (0)
#define PG8_LDA(dst, b, h) do { _Pragma("unroll") for (int m = 0; m < 4; ++m) _Pragma("unroll") for (int k = 0; k < 2; ++k) dst[m][k] = *(const PG8_LAS bf16x8*)(lds + PG8_SA(b, h) + aoff + m * 2048 + k * 1024); } while (0)
#define PG8_LDB(dst, b, h) do { _Pragma("unroll") for (int n = 0; n < 2; ++n) _Pragma("unroll") for (int k = 0; k < 2; ++k) dst[n][k] = *(const PG8_LAS bf16x8*)(lds + PG8_SB(b, h) + boff + n * 2048 + k * 1024); } while (0)
#define PG8_MMA(ai, bj, At, Bt) do { __builtin_amdgcn_s_setprio(1); _Pragma("unroll") for (int m = 0; m < 4; ++m) _Pragma("unroll") for (int n = 0; n < 2; ++n) _Pragma("unroll") for (int k = 0; k < 2; ++k) \
        acc[ai][bj][m][n] = __builtin_amdgcn_mfma_f32_16x16x32_bf16(Bt[n][k], At[m][k], acc[ai][bj][m][n], 0, 0, 0); __builtin_amdgcn_s_setprio(0); } while (0)
#define PG8_WAIT_V(n) asm volatile("s_waitcnt vmcnt(" #n ")" ::: "memory")
#define PG8_WAIT_L(n) asm volatile("s_waitcnt lgkmcnt(" #n ")" ::: "memory")
#define PG8_BAR __builtin_amdgcn_s_barrier()
#define PG8_SCHED __builtin_amdgcn_sched_barrier(0)
    Unit cur, nxt; int ui = 0;
    if (!S.next(0, cur)) return;
    f32x4 acc[2][2][4][2];
#pragma unroll
    for (int a = 0; a < 2; ++a)
#pragma unroll
        for (int b = 0; b < 2; ++b)
#pragma unroll
            for (int m = 0; m < 4; ++m)
#pragma unroll
                for (int n = 0; n < 2; ++n) acc[a][b][m][n] = (f32x4){0.f, 0.f, 0.f, 0.f};
    bf16x8 At[4][2], B0[2][2], B1[2][2];
    const char* cA = (const char*)(cur.z ? g.A1 : g.A) + (size_t)cur.pm * tstep; const char* cB = (const char*)(cur.z ? g.Bt1 : g.Bt) + (size_t)cur.pn * tstep;
    S.a_ready(cur);
    if constexpr (SP2) {
        PG8_STAGE(PG8_SB(0, 0), cB, voffB); PG8_STAGE(PG8_SB(0, 1), cB + hstep, voffB); PG8_STAGE(PG8_SA(0, 0), cA, voffA); PG8_STAGE(PG8_SA(0, 1), cA + hstep, voffA);
        if (wr == 1) PG8_BAR;
        PG8_WAIT_V(2); PG8_BAR;
        PG8_STAGE(PG8_SB(1, 0), cB + kstep, voffB); PG8_STAGE(PG8_SA(1, 0), cA + kstep, voffA); PG8_STAGE(PG8_SB(1, 1), cB + hstep + kstep, voffB);
        PG8_WAIT_V(6); PG8_BAR;
    } else {
        PG8_STAGE(PG8_SB(0, 0), cB, voffB); PG8_STAGE(PG8_SA(0, 0), cA, voffA); PG8_STAGE(PG8_SB(0, 1), cB + hstep, voffB); PG8_STAGE(PG8_SA(0, 1), cA + hstep, voffA);
        if (wr == 1) PG8_BAR;
        PG8_WAIT_V(4); PG8_BAR;
        PG8_STAGE(PG8_SB(1, 0), cB + kstep, voffB); PG8_STAGE(PG8_SA(1, 0), cA + kstep, voffA); PG8_STAGE(PG8_SB(1, 1), cB + hstep + kstep, voffB);
        PG8_WAIT_V(6); PG8_BAR;
    }
    for (;;) {
        const bool has_next = S.next(ui + 1, nxt);
        const char* nA = has_next ? (const char*)(nxt.z ? g.A1 : g.A) + (size_t)nxt.pm * tstep : cA; const char* nB = has_next ? (const char*)(nxt.z ? g.Bt1 : g.Bt) + (size_t)nxt.pn * tstep : cB;
        for (int t = 0; t < nt; t += 2) {
            const bool last = (t == nt - 2);
            const char* a1 = cA + (size_t)(t + 1) * kstep;
            const char* a2 = last ? nA : cA + (size_t)(t + 2) * kstep; const char* b2 = last ? nB : cB + (size_t)(t + 2) * kstep;
            const char* a3 = a2 + kstep; const char* b3 = b2 + kstep;
            if (last && has_next) S.a_ready(nxt);
            if constexpr (SP2) {
            PG8_LDB(B0, 0, 0); PG8_LDB(B1, 0, 1); PG8_SCHED; PG8_LDA(At, 0, 0); PG8_STAGE(PG8_SA(1, 1), a1 + hstep, voffA);
            PG8_WAIT_V(8); PG8_WAIT_L(0); PG8_BAR; PG8_MMA(0, 0, At, B0); PG8_MMA(0, 1, At, B1); PG8_BAR; PG8_SCHED;
            PG8_LDA(At, 0, 1); PG8_STAGE(PG8_SB(0, 0), b2, voffB); PG8_STAGE(PG8_SB(0, 1), b2 + hstep, voffB); PG8_STAGE(PG8_SA(0, 0), a2, voffA);
            PG8_WAIT_V(8); PG8_WAIT_L(0); PG8_BAR; PG8_MMA(1, 0, At, B0); PG8_MMA(1, 1, At, B1); PG8_BAR; PG8_SCHED;
            PG8_LDB(B0, 1, 0); PG8_LDB(B1, 1, 1); PG8_SCHED; PG8_LDA(At, 1, 0); PG8_STAGE(PG8_SA(0, 1), a2 + hstep, voffA);
            PG8_WAIT_V(8); PG8_WAIT_L(0); PG8_BAR; PG8_MMA(0, 0, At, B0); PG8_MMA(0, 1, At, B1); PG8_BAR; PG8_SCHED;
            PG8_LDA(At, 1, 1); PG8_STAGE(PG8_SB(1, 0), b3, voffB); PG8_STAGE(PG8_SB(1, 1), b3 + hstep, voffB); PG8_STAGE(PG8_SA(1, 0), a3, voffA);
            PG8_WAIT_V(8); PG8_WAIT_L(0); PG8_BAR; PG8_MMA(1, 0, At, B0); PG8_MMA(1, 1, At, B1); PG8_BAR; PG8_SCHED;
            } else {
            PG8_LDB(B0, 0, 0); PG8_SCHED; PG8_LDA(At, 0, 0); PG8_STAGE(PG8_SA(1, 1), a1 + hstep, voffA);
            PG8_WAIT_L(8); PG8_BAR; PG8_WAIT_L(0); PG8_MMA(0, 0, At, B0); PG8_BAR; PG8_SCHED;
            PG8_LDB(B1, 0, 1); PG8_STAGE(PG8_SB(0, 0), b2, voffB);
            PG8_BAR; PG8_WAIT_L(0); PG8_MMA(0, 1, At, B1); PG8_BAR;
            PG8_LDA(At, 0, 1); PG8_STAGE(PG8_SA(0, 0), a2, voffA);
            PG8_BAR; PG8_WAIT_L(0); PG8_MMA(1, 0, At, B0); PG8_BAR; PG8_SCHED;
            PG8_STAGE(PG8_SB(0, 1), b2 + hstep, voffB);
            PG8_WAIT_V(6); PG8_BAR; PG8_MMA(1, 1, At, B1); PG8_BAR;
            PG8_LDB(B0, 1, 0); PG8_SCHED; PG8_LDA(At, 1, 0); PG8_STAGE(PG8_SA(0, 1), a2 + hstep, voffA);
            PG8_WAIT_L(8); PG8_BAR; PG8_WAIT_L(0); PG8_MMA(0, 0, At, B0); PG8_BAR; PG8_SCHED;
            PG8_LDB(B1, 1, 1); PG8_STAGE(PG8_SB(1, 0), b3, voffB);
            PG8_BAR; PG8_WAIT_L(0); PG8_MMA(0, 1, At, B1); PG8_BAR;
            PG8_LDA(At, 1, 1); PG8_STAGE(PG8_SA(1, 0), a3, voffA);
            PG8_BAR; PG8_WAIT_L(0); PG8_MMA(1, 0, At, B0); PG8_BAR; PG8_SCHED;
            PG8_STAGE(PG8_SB(1, 1), b3 + hstep, voffB);
            PG8_WAIT_V(6); PG8_BAR; PG8_MMA(1, 1, At, B1); PG8_BAR;
            }
        }
        if constexpr (ALIGN_EPI) { if (wr == 0) PG8_BAR; }
        bool keep_acc = false; if constexpr (!Epi::AFTER_DRAIN) { keep_acc = E(acc, cur, wr, wc, fr, fq); S.done(cur); }
        if (!has_next) break;
        if (!keep_acc) {
#pragma unroll
        for (int a = 0; a < 2; ++a)
#pragma unroll
            for (int b = 0; b < 2; ++b)
#pragma unroll
                for (int m = 0; m < 4; ++m)
#pragma unroll
                    for (int n = 0; n < 2; ++n) acc[a][b][m][n] = (f32x4){0.f, 0.f, 0.f, 0.f};
        }
        cur = nxt; cA = nA; cB = nB; ++ui;
        if constexpr (ALIGN_EPI) { if (wr == 1) PG8_BAR; }
    }
    PG8_WAIT_V(0);
    if constexpr (!ALIGN_EPI) { if (wr == 0) PG8_BAR; }
    PG8_BAR;
    if constexpr (Epi::AFTER_DRAIN) { E.fused(acc, cur, wr, wc, fr, fq, lds, wid, lane); S.done(cur); }
#undef PG8_SA
#undef PG8_SB
#undef PG8_STAGE
#undef PG8_LDA
#undef PG8_LDB
#undef PG8_MMA
#undef PG8_WAIT_V
#undef PG8_WAIT_L
#undef PG8_BAR
#undef PG8_SCHED
}
}

#define LAS __attribute__((address_space(3)))
typedef unsigned short bf16;
typedef float f32x4 __attribute__((ext_vector_type(4)));
typedef unsigned v4u __attribute__((ext_vector_type(4)));
constexpr int NWAVES = 8, NTHR = 512;
constexpr int MTOK = 32768, DM = 1024, SEQ = 2048, NBATCH = 16, NIN = 8192, DFF = 4096, HYW = 512, HALF_TOK = 16384;
constexpr size_t MiB = (size_t)1 << 20;
constexpr size_t WS_SSQA = 0, WS_SSQB = 2 * MiB, WS_ROPE = 4 * MiB, WS_BAR = 4 * MiB + 768 * 1024, WS_LSE = 5 * MiB, WS_GF = 8 * MiB, WS_W = 16 * MiB, WS_XB = 52 * MiB,
                 WS_HY = 116 * MiB, WS_UT = 212 * MiB, WS_GATES = 116 * MiB, WS_Q = 244 * MiB, WS_KV = 340 * MiB, WS_YHY = 436 * MiB, WS_YATT = 404 * MiB, WS_X0T = 468 * MiB,
                 WS_MERGED = 340 * MiB, WS_H = 116 * MiB, WS_END = 500 * MiB;
constexpr size_t W_IN = 0, W_PHY = 16 * MiB, W_PATT = 17 * MiB, W_O = 18 * MiB, W_FF1 = 20 * MiB, W_FF2 = 28 * MiB;
constexpr int LDS_ST_OFF = 135168;
constexpr int LDS_BYTES = 139264;

struct Args {
    const float* in[19]; float* out; unsigned char* ws; int pad0, pad1;
};

__device__ __forceinline__ unsigned f2bf(float f) { unsigned u = __float_as_uint(f); return (u + 0x7fffu + ((u >> 16) & 1u)) >> 16; }
__device__ __forceinline__ unsigned pk2(float lo, float hi) { return f2bf(lo) | (f2bf(hi) << 16); }
__device__ __forceinline__ float bf2f(unsigned short b) { return __uint_as_float((unsigned)b << 16); }
__device__ __forceinline__ float wave_sum(float v) {
#pragma unroll
    for (int o = 1; o < 64; o <<= 1) v += __shfl_xor(v, o);
    return v;
}

__device__ __forceinline__ int win_src_col(int n) {
    const int t = n >> 8, j = n & 255;
    if (t < 6) return n;
    if (t >= 24) return 6144 + (n - 6144);
    int g, w, half;
    if (t < 12) { const int i = t - 6; g = i >> 1; w = 0; half = i & 1; }
    else { const int i = t - 12; g = i >> 2; w = 1 + ((i >> 1) & 1); half = i & 1; }
    int hh, d;
    if (w == 2) { hh = j >> 6; d = j & 63; }
    else { hh = (j & 127) >> 5; d = (j & 31) + ((j >> 7) << 5); }
    return 1536 + g * 1536 + w * 512 + (half * 4 + hh) * 64 + d;
}

__device__ __forceinline__ void transpose_item(const float* W, int K, int Nsrc, int s0, bf16* WT, int n0, int k0, const float* gain, LAS float* scr, int lane) {
    float tv[32];
#pragma unroll
    for (int i = 0; i < 32; ++i) { const int kk = 2 * i + (lane >> 5); tv[i] = W[(size_t)(k0 + kk) * Nsrc + s0 + (lane & 31)]; }
    const float gl = gain ? gain[k0 + lane] : 1.0f;
#pragma unroll
    for (int i = 0; i < 32; ++i) { const int kk = 2 * i + (lane >> 5); scr[kk * 33 + (lane & 31)] = tv[i] * __shfl(gl, kk); }
    asm volatile("s_waitcnt lgkmcnt(0)" ::: "memory");
    const int c = lane & 7;
#pragma unroll
    for (int j = 0; j < 4; ++j) { const int n = (lane >> 3) + 8 * j; const LAS float* s = scr + (8 * c) * 33 + n;
        v4u o; o.x = pk2(s[0 * 33], s[1 * 33]); o.y = pk2(s[2 * 33], s[3 * 33]); o.z = pk2(s[4 * 33], s[5 * 33]); o.w = pk2(s[6 * 33], s[7 * 33]);
        *(v4u*)(WT + (size_t)(n0 + n) * K + k0 + 8 * c) = o; }
    asm volatile("s_waitcnt lgkmcnt(0)" ::: "memory");
}

__device__ __forceinline__ void phase_prep_weights(const Args& a, int L, LAS unsigned char* lds, int tid, int lane, int wave, int G) {
    unsigned char* ws = a.ws;
    {
        const float* w1 = a.in[5] + (size_t)L * 33 * 64; const float* b1 = a.in[6] + L * 64;
        const float* wi = a.in[7] + (size_t)L * 2 * 64 * 64; const float* bi = a.in[8] + L * 2 * 64;
        const float* wout = a.in[9] + (size_t)L * 64 * 1024; const float* fr = a.in[10] + L * 64; const float* skip = a.in[11] + L * 512;
        bf16* Rg = (bf16*)(ws + WS_GF);
        const float min_decay = logf(1e-2f) / 1.5f, max_decay = logf(1e-2f) / 0.3f;
        LAS float* hb = (LAS float*)lds + wave * 64;
        LAS float* fbuf = (LAS float*)(lds + 4096);
        const float frl = fr[lane];
        for (int blk = blockIdx.x; blk < 256; blk += G) {
            int n = 8 * blk + wave + 1; if (n == 2048) n = 0;
            const float t = (float)n / 2047.0f;
            {
                float v = 0.f;
                if (lane == 0) v = t;
                else if (lane < 33) { const int k = (lane - 1) & 15; const float band = 1e-4f + (float)k * ((15.0f - 1e-4f) / 15.0f); const float ang = ((float)(2.0 * 3.14159265358979323846 / 2048.0) * (float)n) * band;
                       v = (lane <= 16) ? cosf(ang) : -sinf(ang); }
                hb[lane] = v;
            }
            float s = b1[lane];
#pragma unroll
            for (int e = 0; e < 33; ++e) s += hb[e] * w1[e * 64 + lane];
            float hcur = sinf(frl * s);
#pragma unroll 1
            for (int layer = 0; layer < 2; ++layer) {
                hb[lane] = hcur;
                float s2 = bi[layer * 64 + lane];
#pragma unroll
                for (int e = 0; e < 64; ++e) s2 += hb[e] * wi[layer * 4096 + e * 64 + lane];
                hcur = sinf(frl * s2);
            }
            hb[lane] = hcur;
            float o[16];
#pragma unroll
            for (int k = 0; k < 16; ++k) o[k] = 0.f;
#pragma unroll 4
            for (int e = 0; e < 64; ++e) { const float he = hb[e];
#pragma unroll
                for (int k = 0; k < 16; ++k) o[k] += he * wout[e * 1024 + 64 * k + lane]; }
#pragma unroll
            for (int k = 0; k < 16; ++k) {
                const int col = 64 * k + lane, c = col & 511;
                const float delta = fabsf(min_decay + (float)c * ((max_decay - min_decay) / 511.0f));
                fbuf[wave * 1024 + col] = o[k] * expf(-t * delta);
            }
            __syncthreads();
#pragma unroll
            for (int pp = 0; pp < 2; ++pp) {
                const int p = tid + 512 * pp, c = p & 511, dir = p >> 9;
                bf16* r0 = Rg + ((size_t)c * 2 + 0) * 4096; bf16* r1 = Rg + ((size_t)c * 2 + 1) * 4096;
#pragma unroll
                for (int wv = 0; wv < 8; ++wv) {
                    int nn = 8 * blk + wv + 1; float val = fbuf[wv * 1024 + dir * 512 + c]; int x;
                    if (nn == 2048) { if (dir != 0) continue; val += skip[c]; x = 2048; }
                    else x = dir ? 2048 + nn : 2048 - nn;
                    const bf16 hv = (bf16)f2bf(val); r0[x] = hv; r1[x - 1] = hv;
                }
            }
            __syncthreads();
        }
    }
    {
        LAS float* scr = (LAS float*)(lds + 40960 + wave * 8704);
        const int gw = blockIdx.x * NWAVES + wave, NGW = G * NWAVES;
        bf16* Wb = (bf16*)(ws + WS_W);
        const float* w_in = a.in[2] + (size_t)L * DM * NIN; const float* p_hy = a.in[12] + (size_t)L * 512 * DM; const float* p_att = a.in[13] + (size_t)L * 512 * DM;
        const float* w_o = a.in[14] + (size_t)L * DM * DM; const float* w1 = a.in[16] + (size_t)L * DM * DFF; const float* w2 = a.in[17] + (size_t)L * DFF * DM;
        const float* g_mix = a.in[1] + L * DM; const float* g_ffn = a.in[15] + L * DM;
        constexpr int I_IN = 16 * 256, I_P = 8 * 32, I_O = 16 * 32, I_1 = 16 * 128, I_2 = 64 * 32;
        constexpr int NITEMS = I_IN + 2 * I_P + I_O + I_1 + I_2;
        for (int it = gw; it < NITEMS; it += NGW) {
            int r = it;
            if (r < I_IN) { const int kb = r / 256, nb = r % 256; transpose_item(w_in, DM, NIN, win_src_col(nb * 32), Wb + W_IN / 2, nb * 32, kb * 64, g_mix, scr, lane); continue; } r -= I_IN;
            if (r < I_P) { const int kb = r / 32, nb = r % 32; transpose_item(p_hy, 512, DM, nb * 32, Wb + W_PHY / 2, nb * 32, kb * 64, nullptr, scr, lane); continue; } r -= I_P;
            if (r < I_P) { const int kb = r / 32, nb = r % 32; transpose_item(p_att, 512, DM, nb * 32, Wb + W_PATT / 2, nb * 32, kb * 64, nullptr, scr, lane); continue; } r -= I_P;
            if (r < I_O) { const int kb = r / 32, nb = r % 32; transpose_item(w_o, DM, DM, nb * 32, Wb + W_O / 2, nb * 32, kb * 64, nullptr, scr, lane); continue; } r -= I_O;
            if (r < I_1) { const int kb = r / 128, nb = r % 128; transpose_item(w1, DM, DFF, nb * 32, Wb + W_FF1 / 2, nb * 32, kb * 64, g_ffn, scr, lane); continue; } r -= I_1;
            { const int kb = r / 32, nb = r % 32; transpose_item(w2, DFF, DM, nb * 32, Wb + W_FF2 / 2, nb * 32, kb * 64, nullptr, scr, lane); }
        }
        if (L == 0) {
            const float* x = a.in[0]; bf16* xb = (bf16*)(ws + WS_XB); float* ssq = (float*)(ws + WS_SSQA);
            for (int m0 = gw; m0 < MTOK; m0 += 4 * NGW) {
                f32x4 v[4][4];
#pragma unroll
                for (int rr = 0; rr < 4; ++rr) { const f32x4* xr = (const f32x4*)(x + (size_t)(m0 + rr * NGW) * DM) + lane;
#pragma unroll
                    for (int j = 0; j < 4; ++j) v[rr][j] = xr[64 * j]; }
#pragma unroll
                for (int rr = 0; rr < 4; ++rr) { const int m = m0 + rr * NGW; float s = 0.f;
#pragma unroll
                    for (int j = 0; j < 4; ++j) s += (v[rr][j][0] * v[rr][j][0] + v[rr][j][1] * v[rr][j][1]) + (v[rr][j][2] * v[rr][j][2] + v[rr][j][3] * v[rr][j][3]);
                    s = wave_sum(s);
                    unsigned long long* o8 = (unsigned long long*)(xb + (size_t)m * DM) + lane;
#pragma unroll
                    for (int j = 0; j < 4; ++j) o8[64 * j] = (unsigned long long)pk2(v[rr][j][0], v[rr][j][1]) | ((unsigned long long)pk2(v[rr][j][2], v[rr][j][3]) << 32);
                    if (lane < 16) ssq[(size_t)m * 16 + lane] = (lane == 0) ? s : 0.f; }
            }
            float* rc = (float*)(ws + WS_ROPE); float* rsn = rc + 65536;
            for (int i = blockIdx.x * NTHR + tid; i < 65536; i += G * NTHR) {
                const int pos = i >> 5, f = i & 31;
                const float inv = powf(10000.0f, -(float)f / 32.0f);
                const float ang = (float)pos * inv;
                rc[i] = cosf(ang); rsn[i] = sinf(ang);
            }
        }
    }
}

__device__ __forceinline__ float bfe(const v4u& w, int e) { const unsigned d = (e >> 1) == 0 ? w.x : ((e >> 1) == 1 ? w.y : ((e >> 1) == 2 ? w.z : w.w)); return (e & 1) ? __uint_as_float(d & 0xffff0000u) : __uint_as_float(d << 16); }
__device__ __forceinline__ void phase_prep_u(const Args& a, int L, LAS unsigned char* lds, int tid, int G) {
    const bf16* hy = (const bf16*)(a.ws + WS_HY); bf16* ut = (bf16*)(a.ws + WS_UT); bf16* x0t = (bf16*)(a.ws + WS_X0T);
    const float* cw = a.in[3] + (size_t)L * 3 * 1536; const float* cb = a.in[4] + L * 1536;
    LAS unsigned short* tile = (LAS unsigned short*)lds;
    const int cc = blockIdx.x & 7, ml = tid >> 3, cg8 = tid & 7, c0 = cc * 64 + cg8 * 8;
    float wq[3][4][8];
#pragma unroll
    for (int ar = 0; ar < 3; ++ar)
#pragma unroll
        for (int e = 0; e < 8; ++e) { wq[ar][0][e] = cw[ar * 512 + c0 + e]; wq[ar][1][e] = cw[1536 + ar * 512 + c0 + e]; wq[ar][2][e] = cw[3072 + ar * 512 + c0 + e]; wq[ar][3][e] = cb[ar * 512 + c0 + e]; }
    for (int it = blockIdx.x >> 3; it < 512; it += (G >> 3)) {
        const int mc = it & 31, b = it >> 5, m = mc * 64 + ml;
        const bf16* r = hy + (size_t)(b * SEQ + m) * 1536 + c0;
        v4u d[3][3];
        const v4u zero = (v4u){0u, 0u, 0u, 0u};
#pragma unroll
        for (int ar = 0; ar < 3; ++ar) {
            d[ar][0] = (m > 0) ? *(const v4u*)(r - 1536 + ar * 512) : zero;
            d[ar][1] = *(const v4u*)(r + ar * 512);
            d[ar][2] = (m < SEQ - 1) ? *(const v4u*)(r + 1536 + ar * 512) : zero;
        }
#pragma unroll
        for (int e = 0; e < 8; ++e) {
            float cv[3];
#pragma unroll
            for (int ar = 0; ar < 3; ++ar) cv[ar] = wq[ar][3][e] + wq[ar][0][e] * bfe(d[ar][0], e) + wq[ar][1][e] * bfe(d[ar][1], e) + wq[ar][2][e] * bfe(d[ar][2], e);
            tile[(cg8 * 8 + e) * 72 + ml] = (unsigned short)f2bf(cv[1] * cv[2]);
            tile[4608 + (cg8 * 8 + e) * 72 + ml] = (unsigned short)f2bf(cv[0]);
        }
        __syncthreads();
        {
            const int c2 = tid >> 3, ch = tid & 7;
            const LAS unsigned* s = (const LAS unsigned*)(tile + c2 * 72 + ch * 8);
            v4u o; o.x = s[0]; o.y = s[1]; o.z = s[2]; o.w = s[3];
            *(v4u*)(ut + ((size_t)(cc * 64 + c2) * NBATCH + b) * SEQ + mc * 64 + ch * 8) = o;
            const LAS unsigned* s2 = s + 2304;
            v4u o2; o2.x = s2[0]; o2.y = s2[1]; o2.z = s2[2]; o2.w = s2[3];
            *(v4u*)(x0t + ((size_t)(cc * 64 + c2) * NBATCH + b) * SEQ + mc * 64 + ch * 8) = o2;
        }
        __syncthreads();
    }
}

__device__ __forceinline__ void phase_hyena_naive(const Args& a, int L, LAS unsigned char* lds, int tid, int G) {
    const bf16* hy = (const bf16*)(a.ws + WS_HY); const bf16* ut = (const bf16*)(a.ws + WS_UT); const float* Gf = (const float*)(a.ws + WS_GF);
    bf16* yhy = (bf16*)(a.ws + WS_YHY);
    const float* cw = a.in[3] + (size_t)L * 3 * 1536; const float* cb = a.in[4] + L * 1536;
    LAS float* Gs = (LAS float*)lds;
    LAS float* Us = Gs + 4096;
    for (int item = blockIdx.x; item < 2048; item += G) {
        const int c = item >> 2, bq = item & 3;
        for (int i = tid; i < 4096; i += NTHR) Gs[i] = (i == 0) ? 0.f : Gf[(size_t)c * 4096 + i];
        for (int i = tid; i < 8192; i += NTHR) { const int bl = i >> 11, m = i & 2047; Us[i] = bf2f(ut[((size_t)c * NBATCH + bq * 4 + bl) * SEQ + m]); }
        __syncthreads();
        const int bl = tid >> 7, tn = tid & 127;
        float acc[16];
#pragma unroll
        for (int i = 0; i < 16; ++i) acc[i] = 0.f;
        const LAS float* up = Us + bl * 2048;
        for (int m = 0; m < SEQ; ++m) {
            const float u = up[m];
            const LAS float* gp = Gs + (tn - m + 2048);
#pragma unroll
            for (int i = 0; i < 16; ++i) acc[i] += gp[128 * i] * u;
        }
        const int b = bq * 4 + bl;
        const float w0 = cw[c], w1 = cw[1536 + c], w2 = cw[3072 + c], b0 = cb[c];
#pragma unroll
        for (int i = 0; i < 16; ++i) {
            const int n = tn + 128 * i;
            const bf16* r = hy + (size_t)(b * SEQ + n) * 1536 + c;
            const float xm = (n > 0) ? bf2f(r[-1536]) : 0.f, xc = bf2f(r[0]), xp = (n < SEQ - 1) ? bf2f(r[1536]) : 0.f;
            const float x0 = b0 + w0 * xm + w1 * xc + w2 * xp;
            yhy[(size_t)(b * SEQ + n) * 512 + c] = (bf16)f2bf(x0 * acc[i]);
        }
        __syncthreads();
    }
}

__device__ __forceinline__ void phase_attn_naive(const Args& a, int half, int tid, int G) {
    bf16* Q = (bf16*)(a.ws + WS_Q); const bf16* KV = (const bf16*)(a.ws + WS_KV); float* lse = (float*)(a.ws + WS_LSE);
    for (int idx = blockIdx.x * NTHR + tid; idx < 3 * 8 * HALF_TOK; idx += G * NTHR) {
        const int g = idx / (8 * HALF_TOK), t = idx % (8 * HALF_TOK), h = t / HALF_TOK, tokl = t % HALF_TOK;
        const int dil = (g == 0) ? 1 : (g == 1 ? 4 : 16);
        const int token = half * HALF_TOK + tokl, s = token & 2047;
        bf16* qp = Q + (size_t)token * 1536 + g * 512 + h * 64;
        float q[64], o[64];
#pragma unroll
        for (int i = 0; i < 8; ++i) { const v4u w = *(const v4u*)(qp + 8 * i);
            q[8 * i + 0] = __uint_as_float(w.x << 16); q[8 * i + 1] = __uint_as_float(w.x & 0xffff0000u); q[8 * i + 2] = __uint_as_float(w.y << 16); q[8 * i + 3] = __uint_as_float(w.y & 0xffff0000u);
            q[8 * i + 4] = __uint_as_float(w.z << 16); q[8 * i + 5] = __uint_as_float(w.z & 0xffff0000u); q[8 * i + 6] = __uint_as_float(w.w << 16); q[8 * i + 7] = __uint_as_float(w.w & 0xffff0000u); }
#pragma unroll
        for (int i = 0; i < 64; ++i) o[i] = 0.f;
        float mx = -1e30f, l = 0.f;
        for (int j = -64; j <= 64; ++j) {
            const int sp = s + j * dil;
            if (sp < 0 || sp >= SEQ) continue;
            const bf16* kp = KV + (size_t)(tokl + j * dil) * 3072 + g * 1024 + h * 64;
            float sc = 0.f;
#pragma unroll
            for (int i = 0; i < 8; ++i) { const v4u w = *(const v4u*)(kp + 8 * i);
                sc += q[8 * i + 0] * __uint_as_float(w.x << 16) + q[8 * i + 1] * __uint_as_float(w.x & 0xffff0000u) + q[8 * i + 2] * __uint_as_float(w.y << 16) + q[8 * i + 3] * __uint_as_float(w.y & 0xffff0000u)
                    + q[8 * i + 4] * __uint_as_float(w.z << 16) + q[8 * i + 5] * __uint_as_float(w.z & 0xffff0000u) + q[8 * i + 6] * __uint_as_float(w.w << 16) + q[8 * i + 7] * __uint_as_float(w.w & 0xffff0000u); }
            const float mn = fmaxf(mx, sc), corr = exp2f(mx - mn), p = exp2f(sc - mn);
            l = l * corr + p; mx = mn;
            const bf16* vp = kp + 512;
#pragma unroll
            for (int i = 0; i < 8; ++i) { const v4u w = *(const v4u*)(vp + 8 * i);
                o[8 * i + 0] = o[8 * i + 0] * corr + p * __uint_as_float(w.x << 16); o[8 * i + 1] = o[8 * i + 1] * corr + p * __uint_as_float(w.x & 0xffff0000u);
                o[8 * i + 2] = o[8 * i + 2] * corr + p * __uint_as_float(w.y << 16); o[8 * i + 3] = o[8 * i + 3] * corr + p * __uint_as_float(w.y & 0xffff0000u);
                o[8 * i + 4] = o[8 * i + 4] * corr + p * __uint_as_float(w.z << 16); o[8 * i + 5] = o[8 * i + 5] * corr + p * __uint_as_float(w.z & 0xffff0000u);
                o[8 * i + 6] = o[8 * i + 6] * corr + p * __uint_as_float(w.w << 16); o[8 * i + 7] = o[8 * i + 7] * corr + p * __uint_as_float(w.w & 0xffff0000u); }
        }
        const float inv = 1.0f / l;
#pragma unroll
        for (int i = 0; i < 8; ++i) { v4u w; w.x = pk2(o[8 * i] * inv, o[8 * i + 1] * inv); w.y = pk2(o[8 * i + 2] * inv, o[8 * i + 3] * inv); w.z = pk2(o[8 * i + 4] * inv, o[8 * i + 5] * inv); w.w = pk2(o[8 * i + 6] * inv, o[8 * i + 7] * inv);
            *(v4u*)(qp + 8 * i) = w; }
        lse[((size_t)g * MTOK + token) * 8 + h] = mx + log2f(l);
    }
}

__device__ __forceinline__ void phase_combine(const Args& a, int tid, int G) {
    const bf16* Q = (const bf16*)(a.ws + WS_Q); const float* lse = (const float*)(a.ws + WS_LSE); bf16* ya = (bf16*)(a.ws + WS_YATT);
    for (int idx = blockIdx.x * NTHR + tid; idx < MTOK * 64; idx += G * NTHR) {
        const int token = idx >> 6, ch = idx & 63, h = ch >> 3;
        const float l0 = lse[((size_t)0 * MTOK + token) * 8 + h], l1 = lse[((size_t)1 * MTOK + token) * 8 + h], l2 = lse[((size_t)2 * MTOK + token) * 8 + h];
        const float mx = fmaxf(l0, fmaxf(l1, l2));
        float w0 = exp2f(l0 - mx), w1 = exp2f(l1 - mx), w2 = exp2f(l2 - mx);
        const float inv = 1.0f / (w0 + w1 + w2); w0 *= inv; w1 *= inv; w2 *= inv;
        const bf16* p = Q + (size_t)token * 1536 + ch * 8;
        const v4u a0 = *(const v4u*)p, a1 = *(const v4u*)(p + 512), a2 = *(const v4u*)(p + 1024);
        v4u o;
#define CMB(f) pk2(w0 * __uint_as_float(a0.f << 16) + w1 * __uint_as_float(a1.f << 16) + w2 * __uint_as_float(a2.f << 16), \
                   w0 * __uint_as_float(a0.f & 0xffff0000u) + w1 * __uint_as_float(a1.f & 0xffff0000u) + w2 * __uint_as_float(a2.f & 0xffff0000u))
        o.x = CMB(x); o.y = CMB(y); o.z = CMB(z); o.w = CMB(w);
#undef CMB
        *(v4u*)(ya + (size_t)token * 512 + ch * 8) = o;
    }
}

__device__ __forceinline__ void phase_final_norm(const Args& a, int lane, int wave, int G) {
    float* x = a.out; const float* gain = a.in[18];
    const int gw = blockIdx.x * NWAVES + wave, NGW = G * NWAVES;
    for (int m = gw; m < MTOK; m += NGW) {
        f32x4* xr = (f32x4*)(x + (size_t)m * DM) + lane;
        f32x4 v[4]; float s = 0.f;
#pragma unroll
        for (int j = 0; j < 4; ++j) { v[j] = xr[64 * j]; s += (v[j][0] * v[j][0] + v[j][1] * v[j][1]) + (v[j][2] * v[j][2] + v[j][3] * v[j][3]); }
        s = wave_sum(s);
        const float rs = 1.0f / sqrtf(s * (1.0f / 1024.0f) + 1e-6f);
#pragma unroll
        for (int j = 0; j < 4; ++j) { const f32x4 gn = *((const f32x4*)gain + lane + 64 * j); xr[64 * j] = v[j] * rs * gn; }
    }
}

typedef short bf16x8 __attribute__((ext_vector_type(8)));
typedef short s16x4 __attribute__((ext_vector_type(4)));
constexpr int HY_UROW = 4112, HY_ROFF = 16 * HY_UROW, HY_RSTRIDE = 8192 + 64;
__device__ __forceinline__ bf16x8 ld_frag4(const LAS unsigned char* p) {
    const LAS unsigned* q = (const LAS unsigned*)p; v4u d; d.x = q[0]; d.y = q[1]; d.z = q[2]; d.w = q[3]; return __builtin_bit_cast(bf16x8, d);
}
__device__ __forceinline__ void phase_hyena_mfma(const Args& a, LAS unsigned char* lds, int tid, int G, bool dummy = false) {
    const bf16* ut = (const bf16*)(a.ws + WS_UT); const bf16* Rg = (const bf16*)(a.ws + WS_GF); bf16* x0t = (bf16*)(a.ws + WS_X0T);
    const int lane = tid & 63, w = __builtin_amdgcn_readfirstlane(tid >> 6), i16 = lane & 15, kq = lane >> 4;
    const int base = (w >> 1) * 512 + (w & 1) * 16, cp = i16 & 1;
    const int lane_const = (2048 - base - i16 + 8 * kq - cp) >> 1;
    const LAS unsigned char* pA15 = lds + HY_ROFF + cp * HY_RSTRIDE + 4 * (lane_const - 240);
    const LAS unsigned char* pB = lds + i16 * HY_UROW + kq * 16;
    v4u pre[10];
#define HY_ISSUE(chn) do { _Pragma("unroll") for (int k_ = 0; k_ < 8; ++k_) { const int i_ = tid + NTHR * k_, b_ = i_ >> 8, ck_ = i_ & 255; pre[k_] = *(const v4u*)(ut + ((size_t)(chn) * NBATCH + b_) * SEQ + ck_ * 8); } \
        _Pragma("unroll") for (int k_ = 0; k_ < 2; ++k_) { const int i_ = tid + NTHR * k_, c2_ = i_ >> 9, ck_ = i_ & 511; pre[8 + k_] = *(const v4u*)(Rg + ((size_t)(chn) * 2 + c2_) * 4096 + ck_ * 8); } } while (0)
    for (int ch = blockIdx.x; ch < HYW; ch += G) {
        HY_ISSUE(ch);
#pragma unroll
        for (int k = 0; k < 8; ++k) { const int i = tid + NTHR * k, b = i >> 8, ck = i & 255; *(LAS v4u*)(lds + b * HY_UROW + ck * 16) = pre[k]; }
#pragma unroll
        for (int k = 0; k < 2; ++k) { const int i = tid + NTHR * k, c2 = i >> 9, ck = i & 511; *(LAS v4u*)(lds + HY_ROFF + c2 * HY_RSTRIDE + ck * 16) = pre[8 + k]; }
        __syncthreads();
        f32x4 acc[16]; bf16x8 W[16];
#pragma unroll
        for (int i = 0; i < 16; ++i) acc[i] = (f32x4){0.f, 0.f, 0.f, 0.f};
#pragma unroll
        for (int j = 1; j < 16; ++j) W[j] = ld_frag4(pA15 + 64 * (15 - j));
        W[0] = W[1];
#pragma unroll 1
        for (int tt = 0; tt < 4; ++tt) {
            const LAS unsigned char* pa = pA15 + 64 * 15 + 1024 * tt; const LAS unsigned char* pb = pB + 1024 * tt;
#pragma unroll
            for (int s = 0; s < 16; ++s) {
                W[(16 - s) & 15] = ld_frag4(pa + 64 * s);
                const bf16x8 Bf = *(const LAS bf16x8*)(pb + 64 * s);
#pragma unroll
                for (int i = 0; i < 16; ++i) acc[i] = __builtin_amdgcn_mfma_f32_16x16x32_bf16(W[(i - s) & 15], Bf, acc[i], 0, 0, 0);
            }
        }
        bf16* xo = x0t + ((size_t)ch * NBATCH + i16) * SEQ + base + 4 * kq;
#pragma unroll
        for (int i = 0; i < 16; ++i) {
            typedef unsigned u32x2v __attribute__((ext_vector_type(2)));
            const u32x2v xv = *(const u32x2v*)(xo + 32 * i);
            u32x2v o; o.x = pk2(__uint_as_float(xv.x << 16) * acc[i][0], __uint_as_float(xv.x & 0xffff0000u) * acc[i][1]);
            o.y = pk2(__uint_as_float(xv.y << 16) * acc[i][2], __uint_as_float(xv.y & 0xffff0000u) * acc[i][3]);
            if (!dummy) *(u32x2v*)(xo + 32 * i) = o; else *(u32x2v*)((bf16*)(a.ws + WS_YHY) + (size_t)tid * 64 + 4 * i) = o;
        }
        __syncthreads();
    }
}

__device__ __forceinline__ void phase_transpose_y(const Args& a, LAS unsigned char* lds, int tid, int G) {
    const bf16* yt = (const bf16*)(a.ws + WS_X0T); bf16* yhy = (bf16*)(a.ws + WS_YHY);
    LAS unsigned short* tile = (LAS unsigned short*)lds;
    for (int item = blockIdx.x; item < 4096; item += G) {
        const int cc = item & 7, mc = (item >> 3) & 31, b = item >> 8;
        { const int c2 = tid >> 3, ck = tid & 7;
          const v4u v = *(const v4u*)(yt + ((size_t)(cc * 64 + c2) * NBATCH + b) * SEQ + mc * 64 + ck * 8);
          LAS unsigned* t4 = (LAS unsigned*)(tile + c2 * 72 + ck * 8); t4[0] = v.x; t4[1] = v.y; t4[2] = v.z; t4[3] = v.w; }
        __syncthreads();
        { const int nl = tid >> 3, cg8 = tid & 7; const LAS unsigned short* s = tile + (cg8 * 8) * 72 + nl;
          v4u o; o.x = s[0] | ((unsigned)s[72] << 16); o.y = s[144] | ((unsigned)s[216] << 16); o.z = s[288] | ((unsigned)s[360] << 16); o.w = s[432] | ((unsigned)s[504] << 16);
          *(v4u*)(yhy + (size_t)(b * SEQ + mc * 64 + nl) * 512 + cc * 64 + cg8 * 8) = o; }
        __syncthreads();
    }
}

constexpr int AT_ROWS = 272, AT_RS = 144, AT_VOFF = AT_ROWS * AT_RS;
__device__ __forceinline__ void phase_attn_mfma(const Args& a, int half, LAS unsigned char* lds, int tid, int G, bool dummy = false) {
    bf16* Q = (bf16*)(a.ws + WS_Q); const bf16* KV = (const bf16*)(a.ws + WS_KV); float* lse = (float*)(a.ws + WS_LSE);
    const int lane = tid & 63, w = __builtin_amdgcn_readfirstlane(tid >> 6), q16 = lane & 15, kq = lane >> 4;
    v4u pre[9];
#define AT_DECODE(unit_) const int g = (unit_) >> 10, u = (unit_) & 1023, sub = u & 15, h = (u >> 4) & 7, bl = u >> 7; int dil, n, r, qb; \
        if (g == 0) { dil = 1; n = 2048; r = 0; qb = sub; } else if (g == 1) { dil = 4; n = 512; r = sub >> 2; qb = sub & 3; } else { dil = 16; n = 128; r = sub; qb = 0; } \
        const int q0 = qb * 128, kb0 = q0 - 64; (void)kb0; (void)q0;
#define AT_ISSUE(unit_) do { AT_DECODE(unit_) _Pragma("unroll") for (int k_ = 0; k_ < 9; ++k_) { const int i_ = tid + NTHR * k_; \
            const int which_ = (i_ >= AT_ROWS * 8) ? 1 : 0, j_ = i_ - which_ * AT_ROWS * 8, rr_ = j_ >> 3, ck_ = j_ & 7, key_ = kb0 + rr_; \
            pre[k_] = (v4u){0u, 0u, 0u, 0u}; \
            if (i_ < 2 * AT_ROWS * 8 && key_ >= 0 && key_ < n) pre[k_] = *(const v4u*)(KV + (size_t)(bl * SEQ + key_ * dil + r) * 3072 + g * 1024 + which_ * 512 + h * 64 + ck_ * 8); } } while (0)
    if ((int)blockIdx.x < 3072) AT_ISSUE((int)blockIdx.x);
    for (int unit = blockIdx.x; unit < 3072; unit += G) {
#pragma unroll
        for (int k = 0; k < 9; ++k) { const int i = tid + NTHR * k; const int which = (i >= AT_ROWS * 8) ? 1 : 0, j = i - which * AT_ROWS * 8, rr = j >> 3, ck = j & 7;
            if (i < 2 * AT_ROWS * 8) *(LAS v4u*)(lds + which * AT_VOFF + rr * AT_RS + ck * 16) = pre[k]; }
        __syncthreads();
        if (unit + G < 3072) AT_ISSUE(unit + G);
        AT_DECODE(unit)
        {
            const int i0 = q0 + 16 * w;
            const int token = half * HALF_TOK + bl * SEQ + (i0 + q16) * dil + r;
            bf16* qp = Q + (size_t)token * 1536 + g * 512 + h * 64;
            bf16* op = dummy ? (bf16*)(a.ws + WS_YHY) + (size_t)(tid & 511) * 64 : qp;
            const bf16x8 Qf0 = *(const bf16x8*)(qp + 8 * kq), Qf1 = *(const bf16x8*)(qp + 32 + 8 * kq);
            f32x4 acc[4];
#pragma unroll
            for (int dt = 0; dt < 4; ++dt) acc[dt] = (f32x4){0.f, 0.f, 0.f, 0.f};
            float mrun = -1e30f, lrun = 0.f;
            const LAS unsigned char* kbase = lds + (16 * w + q16) * AT_RS + 16 * kq;
            const LAS unsigned char* vbase = lds + AT_VOFF + (16 * w + 4 * kq + (q16 >> 2)) * AT_RS + 8 * (q16 & 3);
#pragma unroll 1
            for (int st = 0; st < 5; ++st) {
                f32x4 s[2];
#pragma unroll
                for (int hh = 0; hh < 2; ++hh) {
                    const int kt = 2 * st + hh;
                    const LAS unsigned char* kp = kbase + kt * 16 * AT_RS;
                    const bf16x8 K0 = *(const LAS bf16x8*)kp, K1 = *(const LAS bf16x8*)(kp + 64);
                    f32x4 z = (f32x4){0.f, 0.f, 0.f, 0.f};
                    z = __builtin_amdgcn_mfma_f32_16x16x32_bf16(K0, Qf0, z, 0, 0, 0);
                    z = __builtin_amdgcn_mfma_f32_16x16x32_bf16(K1, Qf1, z, 0, 0, 0);
#pragma unroll
                    for (int e = 0; e < 4; ++e) {
                        const int rel = 16 * kt - 64 + 4 * kq + e - q16, j = i0 + q16 + rel;
                        const bool ok = (rel >= -64) && (rel <= 64) && (j >= 0) && (j < n);
                        z[e] = ok ? z[e] : -1e30f;
                    }
                    s[hh] = z;
                }
                float mx = fmaxf(fmaxf(fmaxf(s[0][0], s[0][1]), fmaxf(s[0][2], s[0][3])), fmaxf(fmaxf(s[1][0], s[1][1]), fmaxf(s[1][2], s[1][3])));
                mx = fmaxf(mx, __shfl_xor(mx, 16)); mx = fmaxf(mx, __shfl_xor(mx, 32));
                const float mn = fmaxf(mrun, mx), corr = exp2f(mrun - mn);
                mrun = mn;
                float p[8], ps = 0.f;
#pragma unroll
                for (int e = 0; e < 4; ++e) { p[e] = exp2f(s[0][e] - mn); p[4 + e] = exp2f(s[1][e] - mn); ps += p[e] + p[4 + e]; }
                lrun = lrun * corr + ps;
                v4u pw; pw.x = pk2(p[0], p[1]); pw.y = pk2(p[2], p[3]); pw.z = pk2(p[4], p[5]); pw.w = pk2(p[6], p[7]);
                const bf16x8 Pf = __builtin_bit_cast(bf16x8, pw);
#pragma unroll
                for (int dt = 0; dt < 4; ++dt) {
                    const LAS unsigned char* vp = vbase + 32 * st * AT_RS + 32 * dt;
                    const s16x4 v0 = __builtin_amdgcn_ds_read_tr16_b64_v4i16((LAS s16x4*)vp);
                    const s16x4 v1 = __builtin_amdgcn_ds_read_tr16_b64_v4i16((LAS s16x4*)(vp + 16 * AT_RS));
                    const bf16x8 Vf = (bf16x8){v0[0], v0[1], v0[2], v0[3], v1[0], v1[1], v1[2], v1[3]};
                    acc[dt] = acc[dt] * corr;
                    acc[dt] = __builtin_amdgcn_mfma_f32_16x16x32_bf16(Vf, Pf, acc[dt], 0, 0, 0);
                }
            }
            lrun += __shfl_xor(lrun, 16); lrun += __shfl_xor(lrun, 32);
            const float inv = 1.0f / lrun;
            typedef unsigned u32x2v __attribute__((ext_vector_type(2)));
#pragma unroll
            for (int dt = 0; dt < 4; ++dt) {
                u32x2v o; o.x = pk2(acc[dt][0] * inv, acc[dt][1] * inv); o.y = pk2(acc[dt][2] * inv, acc[dt][3] * inv);
                *(u32x2v*)(op + 16 * dt + 4 * kq) = o;
            }
            if (kq == 0 && !dummy) lse[((size_t)g * MTOK + token) * 8 + h] = mrun + log2f(lrun);
        }
        __syncthreads();
    }
}

#define XB_TMO      128
#define XB_XCNT(j)  (256  + 64 * (j))
#define XB_XSUB(j)  (1280 + 64 * (j))
#define XB_XGEN(j)  (2304 + 64 * (j))
#define XB_TOP      3328
#define XB_TOPGEN   3392
#define XCD_BAR_WORDS 3456
#define XB_SPIN_CAP (1u << 18)

__device__ __forceinline__ unsigned xb_ld(unsigned* p)              { return __hip_atomic_load(p, __ATOMIC_RELAXED, __HIP_MEMORY_SCOPE_AGENT); }
__device__ __forceinline__ unsigned xb_add(unsigned* p, unsigned v) { return __hip_atomic_fetch_add(p, v, __ATOMIC_RELAXED, __HIP_MEMORY_SCOPE_AGENT); }
__device__ __forceinline__ unsigned xb_xcc_id() { return (unsigned)__builtin_amdgcn_s_getreg((3 << 11) | 20) & 0xFu; }
#define XB_SPIN(cond, bar) do { unsigned _sp = 0; while (cond) { __builtin_amdgcn_s_sleep(1); \
    if ((++_sp & 255u) == 0u) { if (xb_ld(&(bar)[XB_TMO])) break; if (_sp > XB_SPIN_CAP) { atomicAdd(&(bar)[XB_TMO], 1u); break; } } } } while (0)

struct XcdBarrier {
    unsigned* bar; unsigned x;
    volatile LAS unsigned* st;
};

__device__ __forceinline__ XcdBarrier xcd_barrier_post(unsigned* bar, volatile LAS unsigned* st) {
    XcdBarrier b; b.bar = bar; b.x = xb_xcc_id(); b.st = st;
    if (threadIdx.x == 0) (void)xb_add(&bar[XB_XCNT(b.x)], 1u);
    return b;
}
__device__ __forceinline__ void xcd_barrier_complete(unsigned* bar, unsigned x, unsigned& nloc, unsigned& nx) {
    const unsigned G = gridDim.x * gridDim.y * gridDim.z;
    unsigned sum, cnt, mine, sp = 0u;
    for (;;) {
        sum = 0u; cnt = 0u; mine = 0u;
#pragma unroll
        for (unsigned j = 0; j < 16; ++j) { const unsigned c = xb_ld(&bar[XB_XCNT(j)]); sum += c; cnt += (c > 0u) ? 1u : 0u; mine = (j == x) ? c : mine; }
        if (sum == G) break;
        __builtin_amdgcn_s_sleep(1);
        if ((++sp & 255u) == 0u) { if (xb_ld(&bar[XB_TMO])) break; if (sp > XB_SPIN_CAP) { atomicAdd(&bar[XB_TMO], 1u); break; } }
    }
    nloc = mine > 0u ? mine : 1u; nx = cnt > 0u ? cnt : 1u;
}

__device__ __forceinline__ void xcd_barrier(const XcdBarrier& b) {
    asm volatile("s_waitcnt vmcnt(0)" ::: "memory");
    __syncthreads();
    if (threadIdx.x == 0) {
        unsigned* bar = b.bar;
        __builtin_amdgcn_s_waitcnt(0);
        unsigned nloc = b.st[0], nx = b.st[1];
        if (nloc == 0u) { xcd_barrier_complete(bar, b.x, nloc, nx); b.st[0] = nloc; b.st[1] = nx; }
        const unsigned old = xb_add(&bar[XB_XSUB(b.x)], 1u);
        const unsigned gen = old / nloc;
        if (old + 1u == (gen + 1u) * nloc) {
            __builtin_amdgcn_fence(__ATOMIC_RELEASE, "agent");
            asm volatile("s_waitcnt vmcnt(0)" ::: "memory");
            const unsigned og = xb_add(&bar[XB_TOP], 1u);
            const unsigned tg = og / nx;
            if (og + 1u == (tg + 1u) * nx) xb_add(&bar[XB_TOPGEN], 1u);
            else XB_SPIN(xb_ld(&bar[XB_TOPGEN]) == tg, bar);
            __builtin_amdgcn_fence(__ATOMIC_ACQUIRE, "agent");
            xb_add(&bar[XB_XGEN(b.x)], 1u);
            asm volatile("s_waitcnt vmcnt(0)" ::: "memory");
        } else {
            XB_SPIN(xb_ld(&bar[XB_XGEN(b.x)]) == gen, bar);
            __builtin_amdgcn_fence(__ATOMIC_ACQUIRE, "agent");
            asm volatile("s_waitcnt vmcnt(0)" ::: "memory");
        }
    }
    __syncthreads();
}

#define GEMM_CALL(EPI, SCHED, g, S, E) pg8::gemm_phase<EPI, SCHED, true, true>(lds, g, S, E)
#ifndef PROBE_G
#define PROBE_G 0
#endif
#ifndef PROBE_S
#define PROBE_S 0
#endif
#define GEMM_CALL_P(EPI, SCHED, g, S, E) do { _Pragma("unroll 1") for (int rep_ = 0; rep_ < 1 + PROBE_G; ++rep_) { GEMM_CALL(EPI, SCHED, g, S, E); } } while (0)
#ifndef PROBE_PW
#define PROBE_PW 0
#endif
#ifndef PROBE_PU
#define PROBE_PU 0
#endif
#ifndef PROBE_CT
#define PROBE_CT 0
#endif
#ifndef PROBE_AT
#define PROBE_AT 0
#endif
#ifndef PROBE_HY
#define PROBE_HY 0
#endif
#define REP_N(N_) _Pragma("unroll 1") for (int rep_ = 0; rep_ < 1 + (N_); ++rep_)

typedef const __attribute__((address_space(4))) Args* KArgs;
__device__ __forceinline__ Args load_args() {
#if defined(__HIP_DEVICE_COMPILE__)
    KArgs p = (KArgs)__builtin_amdgcn_kernarg_segment_ptr();
    asm volatile("" : "+s"(p));
    return *p;
#else
    return Args{};
#endif
}
__global__ void __launch_bounds__(NTHR, 2) fwd_megakernel(Args a_unused) {
    extern __shared__ __attribute__((aligned(16))) unsigned char lds_raw[];
    LAS unsigned char* lds = (LAS unsigned char*)lds_raw;
    cg::grid_group grid = cg::this_grid();
    const int tid0 = threadIdx.x, G0 = gridDim.x, bx0 = blockIdx.x;
    if (tid0 < 2) ((LAS unsigned*)(lds + LDS_ST_OFF))[tid0] = 0u;
    __syncthreads();
    { const Args a0 = load_args(); (void)xcd_barrier_post((unsigned*)(a0.ws + WS_BAR), (volatile LAS unsigned*)(lds + LDS_ST_OFF)); }
#define GSYNC() do { const Args ab = load_args(); XcdBarrier xb_; xb_.bar = (unsigned*)(ab.ws + WS_BAR); xb_.x = xb_xcc_id(); xb_.st = (volatile LAS unsigned*)(lds + LDS_ST_OFF); xcd_barrier(xb_); } while (0)
#define PTRS() const Args a = load_args(); int tid = tid0, G = G0, bx = bx0; asm volatile("" : "+v"(tid), "+s"(G), "+s"(bx)); const int lane = tid & 63, wave = __builtin_amdgcn_readfirstlane(tid >> 6); (void)lane; (void)wave; unsigned char* ws = a.ws; bf16* Wb = (bf16*)(ws + WS_W); const pg8::bf16_t* xb = (const pg8::bf16_t*)(ws + WS_XB); \
    const float* rcos = (const float*)(ws + WS_ROPE); const float* rsin = rcos + 65536; float* ssqA = (float*)(ws + WS_SSQA); float* ssqB = (float*)(ws + WS_SSQB); \
    (void)Wb; (void)xb; (void)rcos; (void)rsin; (void)ssqA; (void)ssqB;
#define GIN() pg8::Gemm gin{xb, (const pg8::bf16_t*)(Wb + W_IN / 2), nullptr, nullptr, MTOK, NIN, DM}; \
    pg8::EpiIn Ein{(pg8::bf16_t*)(ws + WS_HY), (pg8::bf16_t*)(ws + WS_Q), (pg8::bf16_t*)(ws + WS_KV), (pg8::bf16_t*)(ws + WS_GATES), ssqA, rcos, rsin, 0};

#pragma unroll 1
    for (int L = 0; L < 2; ++L) {
        REP_N(PROBE_PW) { PTRS(); phase_prep_weights(a, L, lds, tid, lane, wave, G); }
        if (L == 0) grid.sync(); else GSYNC();
        {
            PTRS(); GIN();
            pg8::TwoRect S; S.a.init(128, 12, 0, 0, G, bx); S.b.init(64, 12, 0, 12, G, bx); S.na = S.a.count();
            GEMM_CALL_P(pg8::EpiIn, pg8::TwoRect, gin, S, Ein);
        }
        GSYNC();
        REP_N(PROBE_AT) { PTRS(); phase_attn_mfma(a, 0, lds, tid, G, rep_ < PROBE_AT); } { PTRS(); REP_N(PROBE_PU) { phase_prep_u(a, L, lds, tid, G); } }
        GSYNC();
        {
            PTRS(); GIN();
            pg8::RectOrder S; S.init(64, 12, 64, 12, G, bx);
            Ein.kv_row0 = HALF_TOK;
            GEMM_CALL_P(pg8::EpiIn, pg8::RectOrder, gin, S, Ein);
        }
        REP_N(PROBE_HY) { PTRS(); phase_hyena_mfma(a, lds, tid, G, rep_ < PROBE_HY); }
        GSYNC();
        REP_N(PROBE_AT) { PTRS(); phase_attn_mfma(a, 1, lds, tid, G, rep_ < PROBE_AT); }
        {
            PTRS(); GIN();
            pg8::RectOrder S; S.init(128, 8, 0, 24, G, bx);
            GEMM_CALL_P(pg8::EpiIn, pg8::RectOrder, gin, S, Ein);
        }
        GSYNC();
        REP_N(PROBE_CT) { PTRS(); phase_combine(a, tid, G); phase_transpose_y(a, lds, tid, G); }
        GSYNC();
        {
            PTRS();
            pg8::Gemm g{(const pg8::bf16_t*)(ws + WS_YHY), (const pg8::bf16_t*)(Wb + W_PHY / 2), (const pg8::bf16_t*)(ws + WS_YATT), (const pg8::bf16_t*)(Wb + W_PATT / 2), MTOK, DM, 512};
            pg8::PairOrder S; S.r.init(128, 4, 0, 0, G, bx);
            pg8::EpiGate E{(const pg8::bf16_t*)(ws + WS_GATES), (pg8::bf16_t*)(ws + WS_MERGED)};
            GEMM_CALL_P(pg8::EpiGate, pg8::PairOrder, g, S, E);
        }
        GSYNC();
        {
            PTRS();
            pg8::Gemm g{(const pg8::bf16_t*)(ws + WS_MERGED), (const pg8::bf16_t*)(Wb + W_O / 2), nullptr, nullptr, MTOK, DM, DM};
            pg8::RectOrder S; S.init(128, 4, 0, 0, G, bx);
            pg8::EpiRes E{L == 0 ? a.in[0] : a.out, a.out, (pg8::bf16_t*)(ws + WS_XB), ssqB};
            GEMM_CALL(pg8::EpiRes, pg8::RectOrder, g, S, E);
        }
        GSYNC();
        {
            PTRS();
            pg8::Gemm g{xb, (const pg8::bf16_t*)(Wb + W_FF1 / 2), nullptr, nullptr, MTOK, DFF, DM};
            pg8::RectOrder S; S.init(128, 16, 0, 0, G, bx);
            pg8::EpiFF1 E{(pg8::bf16_t*)(ws + WS_H), ssqB};
            GEMM_CALL_P(pg8::EpiFF1, pg8::RectOrder, g, S, E);
        }
        GSYNC();
        {
            PTRS();
            pg8::Gemm g{(const pg8::bf16_t*)(ws + WS_H), (const pg8::bf16_t*)(Wb + W_FF2 / 2), nullptr, nullptr, MTOK, DM, DFF};
            pg8::RectOrder S; S.init(128, 4, 0, 0, G, bx);
            pg8::EpiRes E{a.out, a.out, (pg8::bf16_t*)(ws + WS_XB), ssqA};
            GEMM_CALL(pg8::EpiRes, pg8::RectOrder, g, S, E);
        }
        GSYNC();
    }
    { PTRS(); phase_final_norm(a, lane, wave, G); }
}

extern "C" void kernel_launch(void* const* d_in, const int* in_sizes, int n_in, void* d_out, int out_size, void* d_ws, size_t ws_size, hipStream_t stream) {
    static int grid = 0;
    if (grid == 0) {
        if (n_in != 19 || in_sizes[0] != MTOK * DM || out_size != MTOK * DM || ws_size < WS_END) {
            fprintf(stderr, "kernel_launch: unexpected shapes / workspace (n_in %d, ws %zu, need %zu); nothing launched\n", n_in, ws_size, (size_t)WS_END); grid = -1; return; }
        int dev = 0, cus = 0, per_cu = 0;
        (void)hipGetDevice(&dev); (void)hipDeviceGetAttribute(&cus, hipDeviceAttributeMultiprocessorCount, dev);
        if (hipFuncSetAttribute((const void*)fwd_megakernel, hipFuncAttributeMaxDynamicSharedMemorySize, LDS_BYTES) != hipSuccess) { fprintf(stderr, "kernel_launch: hipFuncSetAttribute failed\n"); grid = -1; return; }
        if (hipOccupancyMaxActiveBlocksPerMultiprocessor(&per_cu, (const void*)fwd_megakernel, NTHR, LDS_BYTES) != hipSuccess || per_cu < 1) { fprintf(stderr, "kernel_launch: occupancy query gives %d\n", per_cu); per_cu = 1; }
        (void)hipGetLastError();
        grid = cus * 1;
        if (grid % 8 != 0 || grid > 256) grid = (grid > 256) ? 256 : (grid / 8) * 8;
    }
    if (grid < 0) return;
    Args a{};
    for (int i = 0; i < 19; ++i) a.in[i] = (const float*)d_in[i];
    a.out = (float*)d_out; a.ws = (unsigned char*)d_ws;
    if (hipMemsetAsync((char*)d_ws + WS_BAR, 0, 16384, stream) != hipSuccess) { fprintf(stderr, "kernel_launch: memset of the barrier words failed\n"); return; }
    void* args[] = {&a};
    hipError_t e = hipLaunchCooperativeKernel((const void*)fwd_megakernel, dim3(grid), dim3(NTHR), args, LDS_BYTES, stream);
    if (e != hipSuccess) fprintf(stderr, "cooperative launch failed: %s (grid %d)\n", hipGetErrorString(e), grid);
}
```

```cpp
#include <hip/hip_runtime.h>
#include <hip/hip_cooperative_groups.h>
#include <cstdio>
#include <cstdint>
namespace cg = cooperative_groups;

namespace pg8 {
#define PG8_LAS __attribute__((address_space(3)))
typedef unsigned short bf16_t;
typedef short bf16x8 __attribute__((ext_vector_type(8)));
typedef float f32x4 __attribute__((ext_vector_type(4)));
typedef unsigned u32x4 __attribute__((ext_vector_type(4)));
constexpr int BM = 256, BK = 64, HALF = 128, HTB = HALF * BK * 2  , STAGE_BYTES = 8 * HTB, NXCD = 8, WGM = 8;

__host__ __device__ __forceinline__ int lds_byte(int r, int c) { const int st = (r >> 4) * 2 + (c >> 5), rr = r & 15, cc = c & 31, ob = rr * 64 + cc * 2; return st * 1024 + (ob ^ (((ob >> 9) & 1) << 5)); }
__host__ __device__ __forceinline__ void stage_rc(int b, int& R, int& C) { const int st = b / 1024, sb = b % 1024, swz = sb ^ (((sb >> 9) & 1) << 5); R = (st >> 1) * 16 + swz / 64; C = (st & 1) * 32 + (swz % 64) / 2; }
__host__ __device__ __forceinline__ int perm32(int rho) { const int n = rho >> 4, i = rho & 15; return 8 * (i >> 2) + 4 * n + (i & 3); }

struct Unit { int pm, pn, z; };
struct Gemm { const bf16_t* A; const bf16_t* Bt; const bf16_t* A1; const bf16_t* Bt1; int M, N, K; };

struct StaticOrder {
    int nM, nN, nwg, G, c;
    __host__ __device__ void init(int M, int N, int G_, int c_) { nM = M / BM; nN = N / BM; nwg = nM * nN; G = G_; c = c_; }
    __host__ __device__ bool next(int i, Unit& u) const {
        const long L = (long)i * G + c; if (L >= nwg) return false;
        int wgid = (int)L; { const int q = nwg / NXCD, r = nwg % NXCD, xcd = wgid % NXCD, off = wgid / NXCD; wgid = (xcd < r ? xcd * (q + 1) : r * (q + 1) + (xcd - r) * q) + off; }
        const int nig = WGM * nN, gid = wgid / nig, fm = gid * WGM, gsz = (nM - fm) < WGM ? (nM - fm) : WGM;
        u.pm = fm + ((wgid % nig) % gsz); u.pn = (wgid % nig) / gsz; return true;
    }
    __device__ __forceinline__ void a_ready(const Unit&) const {}
    __device__ __forceinline__ void done(const Unit&) const {}
};


__device__ __forceinline__ unsigned cvt_pk_bf16(float lo, float hi) { unsigned r; asm volatile("v_cvt_pk_bf16_f32 %0, %1, %2" : "=v"(r) : "v"(lo), "v"(hi)); return r; }
__device__ __forceinline__ float bf_lo(unsigned w) { return __uint_as_float(w << 16); }
__device__ __forceinline__ float bf_hi(unsigned w) { return __uint_as_float(w & 0xffff0000u); }

struct RectOrder {
    int nN, nwg, G, c, pm0, pn0;
    __device__ __forceinline__ void init(int nM_, int nN_, int pm0_, int pn0_, int G_, int c_) { nN = nN_; nwg = nM_ * nN_; G = G_; c = c_; pm0 = pm0_; pn0 = pn0_; }
    __device__ __forceinline__ int count() const { return nwg > c ? (nwg - c + G - 1) / G : 0; }
    __device__ __forceinline__ bool next(int i, Unit& u) const {
        const long L = (long)i * G + c; if (L >= nwg) return false;
        int w = (int)L;
        if ((nwg & 7) == 0 && (G & 7) == 0) w = (c & 7) * (nwg >> 3) + (w >> 3);
        const int nig = 8 * nN, gid = w / nig, r = w % nig;
        u.pm = pm0 + gid * 8 + (r & 7); u.pn = pn0 + (r >> 3); u.z = 0; return true;
    }
    __device__ __forceinline__ void a_ready(const Unit&) const {}
    __device__ __forceinline__ void done(const Unit&) const {}
};
struct TwoRect {
    RectOrder a, b; int na;
    __device__ __forceinline__ bool next(int i, Unit& u) const { return i < na ? a.next(i, u) : b.next(i - na, u); }
    __device__ __forceinline__ void a_ready(const Unit&) const {}
    __device__ __forceinline__ void done(const Unit&) const {}
};
struct PairOrder {
    RectOrder r;
    __device__ __forceinline__ bool next(int i, Unit& u) const { const bool ok = r.next(i >> 1, u); u.z = i & 1; return ok; }
    __device__ __forceinline__ void a_ready(const Unit&) const {}
    __device__ __forceinline__ void done(const Unit&) const {}
};

constexpr float RMS_EPS = 1e-6f;
constexpr float QSCALE = 0.125f * 1.44269504088896341f;

__device__ __forceinline__ float row_rstd(const float* ssq, int row) {
    const f32x4* p = (const f32x4*)(ssq + (size_t)row * 16);
    const f32x4 a = p[0], b = p[1], c = p[2], d = p[3];
    const float s = ((a[0] + a[1]) + (a[2] + a[3])) + ((b[0] + b[1]) + (b[2] + b[3])) + ((c[0] + c[1]) + (c[2] + c[3])) + ((d[0] + d[1]) + (d[2] + d[3]));
    return 1.0f / sqrtf(s * (1.0f / 1024.0f) + RMS_EPS);
}

struct EpiIn {
    static constexpr bool PERM = true, AFTER_DRAIN = false;
    bf16_t* hy; bf16_t* q; bf16_t* kv; bf16_t* gates; const float* ssq; const float* rcos; const float* rsin; int kv_row0;
    __device__ __forceinline__ bool operator()(f32x4 (&acc)[2][2][4][2], const Unit& u, int wr, int wc, int fr, int fq) const {
        const int pn = u.pn; int type, ldc, colt, rowoff = 0; bf16_t* base;
        if (pn < 6) { type = 0; base = hy; ldc = 1536; colt = pn * 256; }
        else if (pn < 12) { type = 1; base = q; ldc = 1536; colt = (pn - 6) * 256; }
        else if (pn < 24) { const int idx = pn - 12; type = ((idx >> 1) & 1) ? 0 : 2; base = kv; ldc = 3072; colt = idx * 256; rowoff = kv_row0; }
        else { type = 3; base = gates; ldc = 2048; colt = (pn - 24) * 256; }
#pragma unroll
        for (int ai = 0; ai < 2; ++ai)
#pragma unroll
            for (int m = 0; m < 4; ++m) {
                const int row = u.pm * BM + ai * HALF + wr * 64 + m * 16 + fr;
                const float rs = row_rstd(ssq, row);
                bf16_t* rowp = base + (size_t)(row - rowoff) * ldc + colt;
                f32x4 v00 = acc[ai][0][m][0] * rs, v01 = acc[ai][0][m][1] * rs, v10 = acc[ai][1][m][0] * rs, v11 = acc[ai][1][m][1] * rs;
                if (type == 1 || type == 2) {
                    const int pos = row & 2047;
                    const f32x4 c0 = *(const f32x4*)(rcos + pos * 32 + 8 * fq), c1 = *(const f32x4*)(rcos + pos * 32 + 8 * fq + 4);
                    const f32x4 s0 = *(const f32x4*)(rsin + pos * 32 + 8 * fq), s1 = *(const f32x4*)(rsin + pos * 32 + 8 * fq + 4);
                    const float sc = (type == 1) ? QSCALE : 1.0f;
                    const f32x4 o00 = (v00 * c0 - v10 * s0) * sc, o01 = (v01 * c1 - v11 * s1) * sc;
                    const f32x4 o10 = (v10 * c0 + v00 * s0) * sc, o11 = (v11 * c1 + v01 * s1) * sc;
                    u32x4 w0, w1;
                    w0.x = cvt_pk_bf16(o00[0], o00[1]); w0.y = cvt_pk_bf16(o00[2], o00[3]); w0.z = cvt_pk_bf16(o01[0], o01[1]); w0.w = cvt_pk_bf16(o01[2], o01[3]);
                    w1.x = cvt_pk_bf16(o10[0], o10[1]); w1.y = cvt_pk_bf16(o10[2], o10[3]); w1.z = cvt_pk_bf16(o11[0], o11[1]); w1.w = cvt_pk_bf16(o11[2], o11[3]);
                    *(u32x4*)(rowp + wc * 64 + 8 * fq) = w0;
                    *(u32x4*)(rowp + wc * 64 + 8 * fq + 32) = w1;
                } else {
                    if (type == 3) {
#pragma unroll
                        for (int e = 0; e < 4; ++e) {
                            v00[e] = 1.0f / (1.0f + __expf(-v00[e])); v01[e] = 1.0f / (1.0f + __expf(-v01[e]));
                            v10[e] = 1.0f / (1.0f + __expf(-v10[e])); v11[e] = 1.0f / (1.0f + __expf(-v11[e]));
                        }
                    }
                    u32x4 w0, w1;
                    w0.x = cvt_pk_bf16(v00[0], v00[1]); w0.y = cvt_pk_bf16(v00[2], v00[3]); w0.z = cvt_pk_bf16(v01[0], v01[1]); w0.w = cvt_pk_bf16(v01[2], v01[3]);
                    w1.x = cvt_pk_bf16(v10[0], v10[1]); w1.y = cvt_pk_bf16(v10[2], v10[3]); w1.z = cvt_pk_bf16(v11[0], v11[1]); w1.w = cvt_pk_bf16(v11[2], v11[3]);
                    *(u32x4*)(rowp + wc * 32 + 8 * fq) = w0;
                    *(u32x4*)(rowp + wc * 32 + 8 * fq + HALF) = w1;
                }
            }
        return false;
    }
};

struct EpiGate {
    static constexpr bool PERM = true, AFTER_DRAIN = false;
    const bf16_t* gates; bf16_t* merged;
    __device__ __forceinline__ bool operator()(f32x4 (&acc)[2][2][4][2], const Unit& u, int wr, int wc, int fr, int fq) const {
#pragma unroll
        for (int ai = 0; ai < 2; ++ai)
#pragma unroll
            for (int m = 0; m < 4; ++m) {
                const int row = u.pm * BM + ai * HALF + wr * 64 + m * 16 + fr;
                const int col0 = u.pn * BM + wc * 32 + 8 * fq;
#pragma unroll
                for (int bj = 0; bj < 2; ++bj) {
                    const u32x4 ga = *(const u32x4*)(gates + (size_t)row * 2048 + 1024 + col0 + bj * HALF);
                    f32x4 a0 = (f32x4){bf_lo(ga.x), bf_hi(ga.x), bf_lo(ga.y), bf_hi(ga.y)}, a1 = (f32x4){bf_lo(ga.z), bf_hi(ga.z), bf_lo(ga.w), bf_hi(ga.w)};
                    if (u.z == 0) {
                        const u32x4 gh = *(const u32x4*)(gates + (size_t)row * 2048 + col0 + bj * HALF);
                        const f32x4 h0 = (f32x4){bf_lo(gh.x), bf_hi(gh.x), bf_lo(gh.y), bf_hi(gh.y)}, h1 = (f32x4){bf_lo(gh.z), bf_hi(gh.z), bf_lo(gh.w), bf_hi(gh.w)};
#pragma unroll
                        for (int e = 0; e < 4; ++e) { a0[e] = fmaxf(a0[e], 1e-30f); a1[e] = fmaxf(a1[e], 1e-30f); }
                        acc[ai][bj][m][0] = acc[ai][bj][m][0] * (h0 / a0);
                        acc[ai][bj][m][1] = acc[ai][bj][m][1] * (h1 / a1);
                    } else {
                        const f32x4 v0 = acc[ai][bj][m][0] * a0, v1 = acc[ai][bj][m][1] * a1;
                        u32x4 w; w.x = cvt_pk_bf16(v0[0], v0[1]); w.y = cvt_pk_bf16(v0[2], v0[3]); w.z = cvt_pk_bf16(v1[0], v1[1]); w.w = cvt_pk_bf16(v1[2], v1[3]);
                        *(u32x4*)(merged + (size_t)row * 1024 + col0 + bj * HALF) = w;
                    }
                }
            }
        return u.z == 0;
    }
};

struct EpiRes {
    static constexpr bool PERM = false, AFTER_DRAIN = false;
    const float* base; float* out; bf16_t* xb; float* ssq;
    __device__ __forceinline__ bool operator()(f32x4 (&acc)[2][2][4][2], const Unit& u, int wr, int wc, int fr, int fq) const {
        typedef unsigned u32x2v __attribute__((ext_vector_type(2)));
        int rl = wr * 64 + fr, cl = wc * 32 + 4 * fq;
        asm volatile("" : "+v"(rl), "+v"(cl));
#pragma unroll
        for (int ai = 0; ai < 2; ++ai)
#pragma unroll
            for (int m = 0; m < 4; ++m) {
                const int row = u.pm * BM + ai * HALF + m * 16 + rl;
                const size_t off = (size_t)row * 1024 + u.pn * BM + cl;
                float s = 0.f;
#pragma unroll
                for (int bj = 0; bj < 2; ++bj)
#pragma unroll
                    for (int n = 0; n < 2; ++n) {
                        const f32x4 o = *(const f32x4*)(base + off + bj * HALF + n * 16) + acc[ai][bj][m][n];
                        *(f32x4*)(out + off + bj * HALF + n * 16) = o;
                        u32x2v w; w.x = cvt_pk_bf16(o[0], o[1]); w.y = cvt_pk_bf16(o[2], o[3]);
                        *(u32x2v*)(xb + off + bj * HALF + n * 16) = w;
                        s += (o[0] * o[0] + o[1] * o[1]) + (o[2] * o[2] + o[3] * o[3]);
                    }
                s += __shfl_xor(s, 16); s += __shfl_xor(s, 32);
                if (fq == 0) ssq[(size_t)row * 16 + u.pn * 4 + wc] = s;
                asm volatile("" ::: "memory");
            }
        return false;
    }
};

struct EpiFF1 {
    static constexpr bool PERM = true, AFTER_DRAIN = false;
    bf16_t* h; const float* ssq;
    __device__ __forceinline__ bool operator()(f32x4 (&acc)[2][2][4][2], const Unit& u, int wr, int wc, int fr, int fq) const {
#pragma unroll
        for (int ai = 0; ai < 2; ++ai)
#pragma unroll
            for (int m = 0; m < 4; ++m) {
                const int row = u.pm * BM + ai * HALF + wr * 64 + m * 16 + fr;
                const float rs = row_rstd(ssq, row);
                bf16_t* rowp = h + (size_t)row * 4096 + u.pn * BM + wc * 32 + 8 * fq;
#pragma unroll
                for (int bj = 0; bj < 2; ++bj) {
                    f32x4 v0 = acc[ai][bj][m][0] * rs, v1 = acc[ai][bj][m][1] * rs;
#pragma unroll
                    for (int e = 0; e < 4; ++e) { v0[e] = fmaxf(v0[e], 0.f); v1[e] = fmaxf(v1[e], 0.f); }
                    v0 = v0 * v0; v1 = v1 * v1;
                    u32x4 w; w.x = cvt_pk_bf16(v0[0], v0[1]); w.y = cvt_pk_bf16(v0[2], v0[3]); w.z = cvt_pk_bf16(v1[0], v1[1]); w.w = cvt_pk_bf16(v1[2], v1[3]);
                    *(u32x4*)(rowp + bj * HALF) = w;
                }
            }
        return false;
    }
};

template <class Epi, class Sched, bool ALIGN_EPI = false, bool SP2 = false>
__device__ __forceinline__ void gemm_phase(PG8_LAS unsigned char* lds, const Gemm g, const Sched& S, const Epi& E) {
    int tid_ = threadIdx.x; asm volatile("" : "+v"(tid_));
    const int tid = tid_, wid = __builtin_amdgcn_readfirstlane(tid >> 6), lane = tid & 63, wr = wid >> 2, wc = wid & 3, fr = lane & 15, fq = lane >> 4;
    const int K = g.K, nt = K / BK;
    unsigned voffA[2], voffB[2];
#pragma unroll
    for (int i = 0; i < 2; ++i) { int R, C; stage_rc(tid * 16 + i * 8192, R, C); const int Rb = Epi::PERM ? ((R & ~31) + perm32(R & 31)) : R;
        voffA[i] = (unsigned)(R * K + C) * 2u; voffB[i] = (unsigned)(Rb * K + C) * 2u; }
    const size_t kstep = (size_t)(BK * 2);
    const size_t hstep = (size_t)HALF * K * 2;
    const size_t tstep = 2 * hstep;
    const unsigned ldsw = (unsigned)wid * 1024u;
    const int aoff = lds_byte(wr * 64 + fr, fq * 8), boff = lds_byte(wc * 32 + fr, fq * 8);
#define PG8_SA(b, h) (((b) * 2 + (h)) * HTB)
#define PG8_SB(b, h) ((4 + (b) * 2 + (h)) * HTB)
#define PG8_STAGE(bufoff, gbase, voff) do { _Pragma("unroll") for (int _i = 0; _i < 2; ++_i) \
        __builtin_amdgcn_global_load_lds((const unsigned*)((const char*)(gbase) + (voff)[_i]), (PG8_LAS unsigned*)(lds + (bufoff) + ldsw + _i * 8192), 16, 0, 0); } while (0)
#define PG8_LDA(dst, b, h) do { _Pragma("unroll") for (int m = 0; m < 4; ++m) _Pragma("unroll") for (int k = 0; k < 2; ++k) dst[m][k] = *(const PG8_LAS bf16x8*)(lds + PG8_SA(b, h) + aoff + m * 2048 + k * 1024); } while (0)
#define PG8_LDB(dst, b, h) do { _Pragma("unroll") for (int n = 0; n < 2; ++n) _Pragma("unroll") for (int k = 0; k < 2; ++k) dst[n][k] = *(const PG8_LAS bf16x8*)(lds + PG8_SB(b, h) + boff + n * 2048 + k * 1024); } while (0)
#define PG8_MMA(ai, bj, At, Bt) do { __builtin_amdgcn_s_setprio(1); _Pragma("unroll") for (int m = 0; m < 4; ++m) _Pragma("unroll") for (int n = 0; n < 2; ++n) _Pragma("unroll") for (int k = 0; k < 2; ++k) \
        acc[ai][bj][m][n] = __builtin_amdgcn_mfma_f32_16x16x32_bf16(Bt[n][k], At[m][k], acc[ai][bj][m][n], 0, 0, 0); __builtin_amdgcn_s_setprio(0); } while (0)
#define PG8_WAIT_V(n) asm volatile("s_waitcnt vmcnt(" #n ")" ::: "memory")
#define PG8_WAIT_L(n) asm volatile("s_waitcnt lgkmcnt(" #n ")" ::: "memory")
#define PG8_BAR __builtin_amdgcn_s_barrier()
#define PG8_SCHED __builtin_amdgcn_sched_barrier(0)
    Unit cur, nxt; int ui = 0;
    if (!S.next(0, cur)) return;
    f32x4 acc[2][2][4][2];
#pragma unroll
    for (int a = 0; a < 2; ++a)
#pragma unroll
        for (int b = 0; b < 2; ++b)
#pragma unroll
            for (int m = 0; m < 4; ++m)
#pragma unroll
                for (int n = 0; n < 2; ++n) acc[a][b][m][n] = (f32x4){0.f, 0.f, 0.f, 0.f};
    bf16x8 At[4][2], B0[2][2], B1[2][2];
    const char* cA = (const char*)(cur.z ? g.A1 : g.A) + (size_t)cur.pm * tstep; const char* cB = (const char*)(cur.z ? g.Bt1 : g.Bt) + (size_t)cur.pn * tstep;
    S.a_ready(cur);
    if constexpr (SP2) {
        PG8_STAGE(PG8_SB(0, 0), cB, voffB); PG8_STAGE(PG8_SB(0, 1), cB + hstep, voffB); PG8_STAGE(PG8_SA(0, 0), cA, voffA); PG8_STAGE(PG8_SA(0, 1), cA + hstep, voffA);
        if (wr == 1) PG8_BAR;
        PG8_WAIT_V(2); PG8_BAR;
        PG8_STAGE(PG8_SB(1, 0), cB + kstep, voffB); PG8_STAGE(PG8_SA(1, 0), cA + kstep, voffA); PG8_STAGE(PG8_SB(1, 1), cB + hstep + kstep, voffB);
        PG8_WAIT_V(6); PG8_BAR;
    } else {
        PG8_STAGE(PG8_SB(0, 0), cB, voffB); PG8_STAGE(PG8_SA(0, 0), cA, voffA); PG8_STAGE(PG8_SB(0, 1), cB + hstep, voffB); PG8_STAGE(PG8_SA(0, 1), cA + hstep, voffA);
        if (wr == 1) PG8_BAR;
        PG8_WAIT_V(4); PG8_BAR;
        PG8_STAGE(PG8_SB(1, 0), cB + kstep, voffB); PG8_STAGE(PG8_SA(1, 0), cA + kstep, voffA); PG8_STAGE(PG8_SB(1, 1), cB + hstep + kstep, voffB);
        PG8_WAIT_V(6); PG8_BAR;
    }
    for (;;) {
        const bool has_next = S.next(ui + 1, nxt);
        const char* nA = has_next ? (const char*)(nxt.z ? g.A1 : g.A) + (size_t)nxt.pm * tstep : cA; const char* nB = has_next ? (const char*)(nxt.z ? g.Bt1 : g.Bt) + (size_t)nxt.pn * tstep : cB;
        for (int t = 0; t < nt; t += 2) {
            const bool last = (t == nt - 2);
            const char* a1 = cA + (size_t)(t + 1) * kstep;
            const char* a2 = last ? nA : cA + (size_t)(t + 2) * kstep; const char* b2 = last ? nB : cB + (size_t)(t + 2) * kstep;
            const char* a3 = a2 + kstep; const char* b3 = b2 + kstep;
            if (last && has_next) S.a_ready(nxt);
            if constexpr (SP2) {
            PG8_LDB(B0, 0, 0); PG8_LDB(B1, 0, 1); PG8_SCHED; PG8_LDA(At, 0, 0); PG8_STAGE(PG8_SA(1, 1), a1 + hstep, voffA);
            PG8_WAIT_V(8); PG8_WAIT_L(0); PG8_BAR; PG8_MMA(0, 0, At, B0); PG8_MMA(0, 1, At, B1); PG8_BAR; PG8_SCHED;
            PG8_LDA(At, 0, 1); PG8_STAGE(PG8_SB(0, 0), b2, voffB); PG8_STAGE(PG8_SB(0, 1), b2 + hstep, voffB); PG8_STAGE(PG8_SA(0, 0), a2, voffA);
            PG8_WAIT_V(8); PG8_WAIT_L(0); PG8_BAR; PG8_MMA(1, 0, At, B0); PG8_MMA(1, 1, At, B1); PG8_BAR; PG8_SCHED;
            PG8_LDB(B0, 1, 0); PG8_LDB(B1, 1, 1); PG8_SCHED; PG8_LDA(At, 1, 0); PG8_STAGE(PG8_SA(0, 1), a2 + hstep, voffA);
            PG8_WAIT_V(8); PG8_WAIT_L(0); PG8_BAR; PG8_MMA(0, 0, At, B0); PG8_MMA(0, 1, At, B1); PG8_BAR; PG8_SCHED;
            PG8_LDA(At, 1, 1); PG8_STAGE(PG8_SB(1, 0), b3, voffB); PG8_STAGE(PG8_SB(1, 1), b3 + hstep, voffB); PG8_STAGE(PG8_SA(1, 0), a3, voffA);
            PG8_WAIT_V(8); PG8_WAIT_L(0); PG8_BAR; PG8_MMA(1, 0, At, B0); PG8_MMA(1, 1, At, B1); PG8_BAR; PG8_SCHED;
            } else {
            PG8_LDB(B0, 0, 0); PG8_SCHED; PG8_LDA(At, 0, 0); PG8_STAGE(PG8_SA(1, 1), a1 + hstep, voffA);
            PG8_WAIT_L(8); PG8_BAR; PG8_WAIT_L(0); PG8_MMA(0, 0, At, B0); PG8_BAR; PG8_SCHED;
            PG8_LDB(B1, 0, 1); PG8_STAGE(PG8_SB(0, 0), b2, voffB);
            PG8_BAR; PG8_WAIT_L(0); PG8_MMA(0, 1, At, B1); PG8_BAR;
            PG8_LDA(At, 0, 1); PG8_STAGE(PG8_SA(0, 0), a2, voffA);
            PG8_BAR; PG8_WAIT_L(0); PG8_MMA(1, 0, At, B0); PG8_BAR; PG8_SCHED;
            PG8_STAGE(PG8_SB(0, 1), b2 + hstep, voffB);
            PG8_WAIT_V(6); PG8_BAR; PG8_MMA(1, 1, At, B1); PG8_BAR;
            PG8_LDB(B0, 1, 0); PG8_SCHED; PG8_LDA(At, 1, 0); PG8_STAGE(PG8_SA(0, 1), a2 + hstep, voffA);
            PG8_WAIT_L(8); PG8_BAR; PG8_WAIT_L(0); PG8_MMA(0, 0, At, B0); PG8_BAR; PG8_SCHED;
            PG8_LDB(B1, 1, 1); PG8_STAGE(PG8_SB(1, 0), b3, voffB);
            PG8_BAR; PG8_WAIT_L(0); PG8_MMA(0, 1, At, B1); PG8_BAR;
            PG8_LDA(At, 1, 1); PG8_STAGE(PG8_SA(1, 0), a3, voffA);
            PG8_BAR; PG8_WAIT_L(0); PG8_MMA(1, 0, At, B0); PG8_BAR; PG8_SCHED;
            PG8_STAGE(PG8_SB(1, 1), b3 + hstep, voffB);
            PG8_WAIT_V(6); PG8_BAR; PG8_MMA(1, 1, At, B1); PG8_BAR;
            }
        }
        if constexpr (ALIGN_EPI) { if (wr == 0) PG8_BAR; }
        bool keep_acc = false; if constexpr (!Epi::AFTER_DRAIN) { keep_acc = E(acc, cur, wr, wc, fr, fq); S.done(cur); }
        if (!has_next) break;
        if (!keep_acc) {
#pragma unroll
        for (int a = 0; a < 2; ++a)
#pragma unroll
            for (int b = 0; b < 2; ++b)
#pragma unroll
                for (int m = 0; m < 4; ++m)
#pragma unroll
                    for (int n = 0; n < 2; ++n) acc[a][b][m][n] = (f32x4){0.f, 0.f, 0.f, 0.f};
        }
        cur = nxt; cA = nA; cB = nB; ++ui;
        if constexpr (ALIGN_EPI) { if (wr == 1) PG8_BAR; }
    }
    PG8_WAIT_V(0);
    if constexpr (!ALIGN_EPI) { if (wr == 0) PG8_BAR; }
    PG8_BAR;
    if constexpr (Epi::AFTER_DRAIN) { E.fused(acc, cur, wr, wc, fr, fq, lds, wid, lane); S.done(cur); }
#undef PG8_SA
#undef PG8_SB
#undef PG8_STAGE
#undef PG8_LDA
#undef PG8_LDB
#undef PG8_MMA
#undef PG8_WAIT_V
#undef PG8_WAIT_L
#undef PG8_BAR
#undef PG8_SCHED
}
}

#define LAS __attribute__((address_space(3)))
typedef unsigned short bf16;
typedef float f32x4 __attribute__((ext_vector_type(4)));
typedef unsigned v4u __attribute__((ext_vector_type(4)));
constexpr int NWAVES = 8, NTHR = 512;
constexpr int MTOK = 32768, DM = 1024, SEQ = 2048, NBATCH = 16, NIN = 8192, DFF = 4096, HYW = 512, HALF_TOK = 16384;
constexpr size_t MiB = (size_t)1 << 20;
constexpr size_t WS_SSQA = 0, WS_SSQB = 2 * MiB, WS_ROPE = 4 * MiB, WS_BAR = 4 * MiB + 768 * 1024, WS_LSE = 5 * MiB, WS_GF = 8 * MiB, WS_W = 16 * MiB, WS_XB = 52 * MiB,
                 WS_HY = 116 * MiB, WS_UT = 212 * MiB, WS_GATES = 116 * MiB, WS_Q = 244 * MiB, WS_KV = 340 * MiB, WS_YHY = 436 * MiB, WS_YATT = 404 * MiB, WS_X0T = 468 * MiB,
                 WS_MERGED = 340 * MiB, WS_H = 116 * MiB, WS_END = 500 * MiB;
constexpr size_t W_IN = 0, W_PHY = 16 * MiB, W_PATT = 17 * MiB, W_O = 18 * MiB, W_FF1 = 20 * MiB, W_FF2 = 28 * MiB;
constexpr int LDS_ST_OFF = 135168;
constexpr int LDS_BYTES = 139264;

struct Args {
    const float* in[19]; float* out; unsigned char* ws; int pad0, pad1;
};

__device__ __forceinline__ unsigned f2bf(float f) { unsigned u = __float_as_uint(f); return (u + 0x7fffu + ((u >> 16) & 1u)) >> 16; }
__device__ __forceinline__ unsigned pk2(float lo, float hi) { return f2bf(lo) | (f2bf(hi) << 16); }
__device__ __forceinline__ float bf2f(unsigned short b) { return __uint_as_float((unsigned)b << 16); }
__device__ __forceinline__ float wave_sum(float v) {
#pragma unroll
    for (int o = 1; o < 64; o <<= 1) v += __shfl_xor(v, o);
    return v;
}

__device__ __forceinline__ int win_src_col(int n) {
    const int t = n >> 8, j = n & 255;
    if (t < 6) return n;
    if (t >= 24) return 6144 + (n - 6144);
    int g, w, half;
    if (t < 12) { const int i = t - 6; g = i >> 1; w = 0; half = i & 1; }
    else { const int i = t - 12; g = i >> 2; w = 1 + ((i >> 1) & 1); half = i & 1; }
    int hh, d;
    if (w == 2) { hh = j >> 6; d = j & 63; }
    else { hh = (j & 127) >> 5; d = (j & 31) + ((j >> 7) << 5); }
    return 1536 + g * 1536 + w * 512 + (half * 4 + hh) * 64 + d;
}

__device__ __forceinline__ void transpose_item(const float* W, int K, int Nsrc, int s0, bf16* WT, int n0, int k0, const float* gain, LAS float* scr, int lane) {
    float tv[32];
#pragma unroll
    for (int i = 0; i < 32; ++i) { const int kk = 2 * i + (lane >> 5); tv[i] = W[(size_t)(k0 + kk) * Nsrc + s0 + (lane & 31)]; }
    const float gl = gain ? gain[k0 + lane] : 1.0f;
#pragma unroll
    for (int i = 0; i < 32; ++i) { const int kk = 2 * i + (lane >> 5); scr[kk * 33 + (lane & 31)] = tv[i] * __shfl(gl, kk); }
    asm volatile("s_waitcnt lgkmcnt(0)" ::: "memory");
    const int c = lane & 7;
#pragma unroll
    for (int j = 0; j < 4; ++j) { const int n = (lane >> 3) + 8 * j; const LAS float* s = scr + (8 * c) * 33 + n;
        v4u o; o.x = pk2(s[0 * 33], s[1 * 33]); o.y = pk2(s[2 * 33], s[3 * 33]); o.z = pk2(s[4 * 33], s[5 * 33]); o.w = pk2(s[6 * 33], s[7 * 33]);
        *(v4u*)(WT + (size_t)(n0 + n) * K + k0 + 8 * c) = o; }
    asm volatile("s_waitcnt lgkmcnt(0)" ::: "memory");
}

__device__ __forceinline__ void phase_prep_weights(const Args& a, int L, LAS unsigned char* lds, int tid, int lane, int wave, int G) {
    unsigned char* ws = a.ws;
    {
        const float* w1 = a.in[5] + (size_t)L * 33 * 64; const float* b1 = a.in[6] + L * 64;
        const float* wi = a.in[7] + (size_t)L * 2 * 64 * 64; const float* bi = a.in[8] + L * 2 * 64;
        const float* wout = a.in[9] + (size_t)L * 64 * 1024; const float* fr = a.in[10] + L * 64; const float* skip = a.in[11] + L * 512;
        bf16* Rg = (bf16*)(ws + WS_GF);
        const float min_decay = logf(1e-2f) / 1.5f, max_decay = logf(1e-2f) / 0.3f;
        LAS float* hb = (LAS float*)lds + wave * 64;
        LAS float* fbuf = (LAS float*)(lds + 4096);
        const float frl = fr[lane];
#ifndef PROBE_PWF
#define PROBE_PWF 0
#endif
#ifndef PROBE_PWT
#define PROBE_PWT 0
#endif
        _Pragma("unroll 1") for (int repf = 0; repf < 1 + PROBE_PWF; ++repf)
        for (int blk = blockIdx.x; blk < 256; blk += G) {
            int n = 8 * blk + wave + 1; if (n == 2048) n = 0;
            const float t = (float)n / 2047.0f;
            {
                float v = 0.f;
                if (lane == 0) v = t;
                else if (lane < 33) { const int k = (lane - 1) & 15; const float band = 1e-4f + (float)k * ((15.0f - 1e-4f) / 15.0f); const float ang = ((float)(2.0 * 3.14159265358979323846 / 2048.0) * (float)n) * band;
                       v = (lane <= 16) ? cosf(ang) : -sinf(ang); }
                hb[lane] = v;
            }
            float s = b1[lane];
#pragma unroll
            for (int e = 0; e < 33; ++e) s += hb[e] * w1[e * 64 + lane];
            float hcur = sinf(frl * s);
#pragma unroll 1
            for (int layer = 0; layer < 2; ++layer) {
                hb[lane] = hcur;
                float s2 = bi[layer * 64 + lane];
#pragma unroll
                for (int e = 0; e < 64; ++e) s2 += hb[e] * wi[layer * 4096 + e * 64 + lane];
                hcur = sinf(frl * s2);
            }
            LAS float* hT = (LAS float*)(lds + 2048);
            hT[lane * 8 + wave] = hcur;
            __syncthreads();
            float o[8][2];
#pragma unroll
            for (int p = 0; p < 8; ++p) { o[p][0] = 0.f; o[p][1] = 0.f; }
#pragma unroll 8
            for (int e = 0; e < 64; ++e) {
                const f32x4 ha = *(const LAS f32x4*)(hT + e * 8), hc = *(const LAS f32x4*)(hT + e * 8 + 4);
                const float w0 = wout[e * 1024 + 128 * wave + lane], w1v = wout[e * 1024 + 128 * wave + 64 + lane];
#pragma unroll
                for (int p = 0; p < 4; ++p) { o[p][0] += ha[p] * w0; o[p][1] += ha[p] * w1v; o[4 + p][0] += hc[p] * w0; o[4 + p][1] += hc[p] * w1v; }
            }
#pragma unroll
            for (int j = 0; j < 2; ++j) {
                const int col = 128 * wave + 64 * j + lane, c = col & 511;
                const float delta = fabsf(min_decay + (float)c * ((max_decay - min_decay) / 511.0f));
#pragma unroll
                for (int p = 0; p < 8; ++p) { int np = 8 * blk + p + 1; if (np == 2048) np = 0; const float tp = (float)np / 2047.0f; fbuf[p * 1024 + col] = o[p][j] * expf(-tp * delta); }
            }
            __syncthreads();
#pragma unroll
            for (int pp = 0; pp < 2; ++pp) {
                const int p = tid + 512 * pp, c = p & 511, dir = p >> 9;
                bf16* r0 = Rg + ((size_t)c * 2 + 0) * 4096; bf16* r1 = Rg + ((size_t)c * 2 + 1) * 4096;
#pragma unroll
                for (int wv = 0; wv < 8; ++wv) {
                    int nn = 8 * blk + wv + 1; float val = fbuf[wv * 1024 + dir * 512 + c]; int x;
                    if (nn == 2048) { if (dir != 0) continue; val += skip[c]; x = 2048; }
                    else x = dir ? 2048 + nn : 2048 - nn;
                    const bf16 hv = (bf16)f2bf(val); r0[x] = hv; r1[x - 1] = hv;
                }
            }
            __syncthreads();
        }
    }
    {
        LAS float* scr = (LAS float*)(lds + 40960 + wave * 8704);
        const int gw = blockIdx.x * NWAVES + wave, NGW = G * NWAVES;
        bf16* Wb = (bf16*)(ws + WS_W);
        const float* w_in = a.in[2] + (size_t)L * DM * NIN; const float* p_hy = a.in[12] + (size_t)L * 512 * DM; const float* p_att = a.in[13] + (size_t)L * 512 * DM;
        const float* w_o = a.in[14] + (size_t)L * DM * DM; const float* w1 = a.in[16] + (size_t)L * DM * DFF; const float* w2 = a.in[17] + (size_t)L * DFF * DM;
        const float* g_mix = a.in[1] + L * DM; const float* g_ffn = a.in[15] + L * DM;
        constexpr int I_IN = 16 * 256, I_P = 8 * 32, I_O = 16 * 32, I_1 = 16 * 128, I_2 = 64 * 32;
        constexpr int NITEMS = I_IN + 2 * I_P + I_O + I_1 + I_2;
        _Pragma("unroll 1") for (int rept = 0; rept < 1 + PROBE_PWT; ++rept)
        for (int it = gw; it < NITEMS; it += NGW) {
            int r = it;
            if (r < I_IN) { const int kb = r / 256, nb = r % 256; transpose_item(w_in, DM, NIN, win_src_col(nb * 32), Wb + W_IN / 2, nb * 32, kb * 64, g_mix, scr, lane); continue; } r -= I_IN;
            if (r < I_P) { const int kb = r / 32, nb = r % 32; transpose_item(p_hy, 512, DM, nb * 32, Wb + W_PHY / 2, nb * 32, kb * 64, nullptr, scr, lane); continue; } r -= I_P;
            if (r < I_P) { const int kb = r / 32, nb = r % 32; transpose_item(p_att, 512, DM, nb * 32, Wb + W_PATT / 2, nb * 32, kb * 64, nullptr, scr, lane); continue; } r -= I_P;
            if (r < I_O) { const int kb = r / 32, nb = r % 32; transpose_item(w_o, DM, DM, nb * 32, Wb + W_O / 2, nb * 32, kb * 64, nullptr, scr, lane); continue; } r -= I_O;
            if (r < I_1) { const int kb = r / 128, nb = r % 128; transpose_item(w1, DM, DFF, nb * 32, Wb + W_FF1 / 2, nb * 32, kb * 64, g_ffn, scr, lane); continue; } r -= I_1;
            { const int kb = r / 32, nb = r % 32; transpose_item(w2, DFF, DM, nb * 32, Wb + W_FF2 / 2, nb * 32, kb * 64, nullptr, scr, lane); }
        }
        if (L == 0) {
            const float* x = a.in[0]; bf16* xb = (bf16*)(ws + WS_XB); float* ssq = (float*)(ws + WS_SSQA);
            for (int m0 = gw; m0 < MTOK; m0 += 4 * NGW) {
                f32x4 v[4][4];
#pragma unroll
                for (int rr = 0; rr < 4; ++rr) { const f32x4* xr = (const f32x4*)(x + (size_t)(m0 + rr * NGW) * DM) + lane;
#pragma unroll
                    for (int j = 0; j < 4; ++j) v[rr][j] = xr[64 * j]; }
#pragma unroll
                for (int rr = 0; rr < 4; ++rr) { const int m = m0 + rr * NGW; float s = 0.f;
#pragma unroll
                    for (int j = 0; j < 4; ++j) s += (v[rr][j][0] * v[rr][j][0] + v[rr][j][1] * v[rr][j][1]) + (v[rr][j][2] * v[rr][j][2] + v[rr][j][3] * v[rr][j][3]);
                    s = wave_sum(s);
                    unsigned long long* o8 = (unsigned long long*)(xb + (size_t)m * DM) + lane;
#pragma unroll
                    for (int j = 0; j < 4; ++j) o8[64 * j] = (unsigned long long)pk2(v[rr][j][0], v[rr][j][1]) | ((unsigned long long)pk2(v[rr][j][2], v[rr][j][3]) << 32);
                    if (lane < 16) ssq[(size_t)m * 16 + lane] = (lane == 0) ? s : 0.f; }
            }
            float* rc = (float*)(ws + WS_ROPE); float* rsn = rc + 65536;
            for (int i = blockIdx.x * NTHR + tid; i < 65536; i += G * NTHR) {
                const int pos = i >> 5, f = i & 31;
                const float inv = powf(10000.0f, -(float)f / 32.0f);
                const float ang = (float)pos * inv;
                rc[i] = cosf(ang); rsn[i] = sinf(ang);
            }
        }
    }
}

__device__ __forceinline__ float bfe(const v4u& w, int e) { const unsigned d = (e >> 1) == 0 ? w.x : ((e >> 1) == 1 ? w.y : ((e >> 1) == 2 ? w.z : w.w)); return (e & 1) ? __uint_as_float(d & 0xffff0000u) : __uint_as_float(d << 16); }
__device__ __forceinline__ void phase_prep_u(const Args& a, int L, LAS unsigned char* lds, int tid, int G) {
    const bf16* hy = (const bf16*)(a.ws + WS_HY); bf16* ut = (bf16*)(a.ws + WS_UT); bf16* x0t = (bf16*)(a.ws + WS_X0T);
    const float* cw = a.in[3] + (size_t)L * 3 * 1536; const float* cb = a.in[4] + L * 1536;
    LAS unsigned short* tile = (LAS unsigned short*)lds;
    const int cc = blockIdx.x & 7, ml = tid >> 3, cg8 = tid & 7, c0 = cc * 64 + cg8 * 8;
    float wq[3][4][8];
#pragma unroll
    for (int ar = 0; ar < 3; ++ar)
#pragma unroll
        for (int e = 0; e < 8; ++e) { wq[ar][0][e] = cw[ar * 512 + c0 + e]; wq[ar][1][e] = cw[1536 + ar * 512 + c0 + e]; wq[ar][2][e] = cw[3072 + ar * 512 + c0 + e]; wq[ar][3][e] = cb[ar * 512 + c0 + e]; }
    v4u dn[3][3];
    const v4u zero = (v4u){0u, 0u, 0u, 0u};
#define PU_LOAD(it_) do { const int m_ = ((it_) & 31) * 64 + ml; const bf16* r_ = hy + (size_t)(((it_) >> 5) * SEQ + m_) * 1536 + c0; \
        _Pragma("unroll") for (int ar_ = 0; ar_ < 3; ++ar_) { dn[ar_][0] = (m_ > 0) ? *(const v4u*)(r_ - 1536 + ar_ * 512) : zero; dn[ar_][1] = *(const v4u*)(r_ + ar_ * 512); \
            dn[ar_][2] = (m_ < SEQ - 1) ? *(const v4u*)(r_ + 1536 + ar_ * 512) : zero; } } while (0)
    if ((int)(blockIdx.x >> 3) < 512) PU_LOAD((int)(blockIdx.x >> 3));
    for (int it = blockIdx.x >> 3; it < 512; it += (G >> 3)) {
        const int mc = it & 31, b = it >> 5;
        v4u d[3][3];
#pragma unroll
        for (int ar = 0; ar < 3; ++ar) { d[ar][0] = dn[ar][0]; d[ar][1] = dn[ar][1]; d[ar][2] = dn[ar][2]; }
        if (it + (G >> 3) < 512) PU_LOAD(it + (G >> 3));
#pragma unroll
        for (int e = 0; e < 8; ++e) {
            float cv[3];
#pragma unroll
            for (int ar = 0; ar < 3; ++ar) cv[ar] = wq[ar][3][e] + wq[ar][0][e] * bfe(d[ar][0], e) + wq[ar][1][e] * bfe(d[ar][1], e) + wq[ar][2][e] * bfe(d[ar][2], e);
            tile[(cg8 * 8 + e) * 72 + ml] = (unsigned short)f2bf(cv[1] * cv[2]);
            tile[4608 + (cg8 * 8 + e) * 72 + ml] = (unsigned short)f2bf(cv[0]);
        }
        __syncthreads();
        {
            const int c2 = tid >> 3, ch = tid & 7;
            const LAS unsigned* s = (const LAS unsigned*)(tile + c2 * 72 + ch * 8);
            v4u o; o.x = s[0]; o.y = s[1]; o.z = s[2]; o.w = s[3];
            *(v4u*)(ut + ((size_t)(cc * 64 + c2) * NBATCH + b) * SEQ + mc * 64 + ch * 8) = o;
            const LAS unsigned* s2 = s + 2304;
            v4u o2; o2.x = s2[0]; o2.y = s2[1]; o2.z = s2[2]; o2.w = s2[3];
            *(v4u*)(x0t + ((size_t)(cc * 64 + c2) * NBATCH + b) * SEQ + mc * 64 + ch * 8) = o2;
        }
        __syncthreads();
    }
}

__device__ __forceinline__ void phase_hyena_naive(const Args& a, int L, LAS unsigned char* lds, int tid, int G) {
    const bf16* hy = (const bf16*)(a.ws + WS_HY); const bf16* ut = (const bf16*)(a.ws + WS_UT); const float* Gf = (const float*)(a.ws + WS_GF);
    bf16* yhy = (bf16*)(a.ws + WS_YHY);
    const float* cw = a.in[3] + (size_t)L * 3 * 1536; const float* cb = a.in[4] + L * 1536;
    LAS float* Gs = (LAS float*)lds;
    LAS float* Us = Gs + 4096;
    for (int item = blockIdx.x; item < 2048; item += G) {
        const int c = item >> 2, bq = item & 3;
        for (int i = tid; i < 4096; i += NTHR) Gs[i] = (i == 0) ? 0.f : Gf[(size_t)c * 4096 + i];
        for (int i = tid; i < 8192; i += NTHR) { const int bl = i >> 11, m = i & 2047; Us[i] = bf2f(ut[((size_t)c * NBATCH + bq * 4 + bl) * SEQ + m]); }
        __syncthreads();
        const int bl = tid >> 7, tn = tid & 127;
        float acc[16];
#pragma unroll
        for (int i = 0; i < 16; ++i) acc[i] = 0.f;
        const LAS float* up = Us + bl * 2048;
        for (int m = 0; m < SEQ; ++m) {
            const float u = up[m];
            const LAS float* gp = Gs + (tn - m + 2048);
#pragma unroll
            for (int i = 0; i < 16; ++i) acc[i] += gp[128 * i] * u;
        }
        const int b = bq * 4 + bl;
        const float w0 = cw[c], w1 = cw[1536 + c], w2 = cw[3072 + c], b0 = cb[c];
#pragma unroll
        for (int i = 0; i < 16; ++i) {
            const int n = tn + 128 * i;
            const bf16* r = hy + (size_t)(b * SEQ + n) * 1536 + c;
            const float xm = (n > 0) ? bf2f(r[-1536]) : 0.f, xc = bf2f(r[0]), xp = (n < SEQ - 1) ? bf2f(r[1536]) : 0.f;
            const float x0 = b0 + w0 * xm + w1 * xc + w2 * xp;
            yhy[(size_t)(b * SEQ + n) * 512 + c] = (bf16)f2bf(x0 * acc[i]);
        }
        __syncthreads();
    }
}

__device__ __forceinline__ void phase_attn_naive(const Args& a, int half, int tid, int G) {
    bf16* Q = (bf16*)(a.ws + WS_Q); const bf16* KV = (const bf16*)(a.ws + WS_KV); float* lse = (float*)(a.ws + WS_LSE);
    for (int idx = blockIdx.x * NTHR + tid; idx < 3 * 8 * HALF_TOK; idx += G * NTHR) {
        const int g = idx / (8 * HALF_TOK), t = idx % (8 * HALF_TOK), h = t / HALF_TOK, tokl = t % HALF_TOK;
        const int dil = (g == 0) ? 1 : (g == 1 ? 4 : 16);
        const int token = half * HALF_TOK + tokl, s = token & 2047;
        bf16* qp = Q + (size_t)token * 1536 + g * 512 + h * 64;
        float q[64], o[64];
#pragma unroll
        for (int i = 0; i < 8; ++i) { const v4u w = *(const v4u*)(qp + 8 * i);
            q[8 * i + 0] = __uint_as_float(w.x << 16); q[8 * i + 1] = __uint_as_float(w.x & 0xffff0000u); q[8 * i + 2] = __uint_as_float(w.y << 16); q[8 * i + 3] = __uint_as_float(w.y & 0xffff0000u);
            q[8 * i + 4] = __uint_as_float(w.z << 16); q[8 * i + 5] = __uint_as_float(w.z & 0xffff0000u); q[8 * i + 6] = __uint_as_float(w.w << 16); q[8 * i + 7] = __uint_as_float(w.w & 0xffff0000u); }
#pragma unroll
        for (int i = 0; i < 64; ++i) o[i] = 0.f;
        float mx = -1e30f, l = 0.f;
        for (int j = -64; j <= 64; ++j) {
            const int sp = s + j * dil;
            if (sp < 0 || sp >= SEQ) continue;
            const bf16* kp = KV + (size_t)(tokl + j * dil) * 3072 + g * 1024 + h * 64;
            float sc = 0.f;
#pragma unroll
            for (int i = 0; i < 8; ++i) { const v4u w = *(const v4u*)(kp + 8 * i);
                sc += q[8 * i + 0] * __uint_as_float(w.x << 16) + q[8 * i + 1] * __uint_as_float(w.x & 0xffff0000u) + q[8 * i + 2] * __uint_as_float(w.y << 16) + q[8 * i + 3] * __uint_as_float(w.y & 0xffff0000u)
                    + q[8 * i + 4] * __uint_as_float(w.z << 16) + q[8 * i + 5] * __uint_as_float(w.z & 0xffff0000u) + q[8 * i + 6] * __uint_as_float(w.w << 16) + q[8 * i + 7] * __uint_as_float(w.w & 0xffff0000u); }
            const float mn = fmaxf(mx, sc), corr = exp2f(mx - mn), p = exp2f(sc - mn);
            l = l * corr + p; mx = mn;
            const bf16* vp = kp + 512;
#pragma unroll
            for (int i = 0; i < 8; ++i) { const v4u w = *(const v4u*)(vp + 8 * i);
                o[8 * i + 0] = o[8 * i + 0] * corr + p * __uint_as_float(w.x << 16); o[8 * i + 1] = o[8 * i + 1] * corr + p * __uint_as_float(w.x & 0xffff0000u);
                o[8 * i + 2] = o[8 * i + 2] * corr + p * __uint_as_float(w.y << 16); o[8 * i + 3] = o[8 * i + 3] * corr + p * __uint_as_float(w.y & 0xffff0000u);
                o[8 * i + 4] = o[8 * i + 4] * corr + p * __uint_as_float(w.z << 16); o[8 * i + 5] = o[8 * i + 5] * corr + p * __uint_as_float(w.z & 0xffff0000u);
                o[8 * i + 6] = o[8 * i + 6] * corr + p * __uint_as_float(w.w << 16); o[8 * i + 7] = o[8 * i + 7] * corr + p * __uint_as_float(w.w & 0xffff0000u); }
        }
        const float inv = 1.0f / l;
#pragma unroll
        for (int i = 0; i < 8; ++i) { v4u w; w.x = pk2(o[8 * i] * inv, o[8 * i + 1] * inv); w.y = pk2(o[8 * i + 2] * inv, o[8 * i + 3] * inv); w.z = pk2(o[8 * i + 4] * inv, o[8 * i + 5] * inv); w.w = pk2(o[8 * i + 6] * inv, o[8 * i + 7] * inv);
            *(v4u*)(qp + 8 * i) = w; }
        lse[((size_t)g * MTOK + token) * 8 + h] = mx + log2f(l);
    }
}

__device__ __forceinline__ void phase_combine(const Args& a, int tid, int G) {
    const bf16* Q = (const bf16*)(a.ws + WS_Q); const float* lse = (const float*)(a.ws + WS_LSE); bf16* ya = (bf16*)(a.ws + WS_YATT);
#pragma unroll 4
    for (int idx = blockIdx.x * NTHR + tid; idx < MTOK * 64; idx += G * NTHR) {
        const int token = idx >> 6, ch = idx & 63, h = ch >> 3;
        const float l0 = lse[((size_t)0 * MTOK + token) * 8 + h], l1 = lse[((size_t)1 * MTOK + token) * 8 + h], l2 = lse[((size_t)2 * MTOK + token) * 8 + h];
        const float mx = fmaxf(l0, fmaxf(l1, l2));
        float w0 = exp2f(l0 - mx), w1 = exp2f(l1 - mx), w2 = exp2f(l2 - mx);
        const float inv = 1.0f / (w0 + w1 + w2); w0 *= inv; w1 *= inv; w2 *= inv;
        const bf16* p = Q + (size_t)token * 1536 + ch * 8;
        const v4u a0 = *(const v4u*)p, a1 = *(const v4u*)(p + 512), a2 = *(const v4u*)(p + 1024);
        v4u o;
#define CMB(f) pk2(w0 * __uint_as_float(a0.f << 16) + w1 * __uint_as_float(a1.f << 16) + w2 * __uint_as_float(a2.f << 16), \
                   w0 * __uint_as_float(a0.f & 0xffff0000u) + w1 * __uint_as_float(a1.f & 0xffff0000u) + w2 * __uint_as_float(a2.f & 0xffff0000u))
        o.x = CMB(x); o.y = CMB(y); o.z = CMB(z); o.w = CMB(w);
#undef CMB
        *(v4u*)(ya + (size_t)token * 512 + ch * 8) = o;
    }
}

__device__ __forceinline__ void phase_final_norm(const Args& a, int lane, int wave, int G) {
    float* x = a.out; const float* gain = a.in[18];
    const int gw = blockIdx.x * NWAVES + wave, NGW = G * NWAVES;
    for (int m = gw; m < MTOK; m += NGW) {
        f32x4* xr = (f32x4*)(x + (size_t)m * DM) + lane;
        f32x4 v[4]; float s = 0.f;
#pragma unroll
        for (int j = 0; j < 4; ++j) { v[j] = xr[64 * j]; s += (v[j][0] * v[j][0] + v[j][1] * v[j][1]) + (v[j][2] * v[j][2] + v[j][3] * v[j][3]); }
        s = wave_sum(s);
        const float rs = 1.0f / sqrtf(s * (1.0f / 1024.0f) + 1e-6f);
#pragma unroll
        for (int j = 0; j < 4; ++j) { const f32x4 gn = *((const f32x4*)gain + lane + 64 * j); xr[64 * j] = v[j] * rs * gn; }
    }
}

typedef short bf16x8 __attribute__((ext_vector_type(8)));
typedef short s16x4 __attribute__((ext_vector_type(4)));
constexpr int HY_UROW = 4112, HY_ROFF = 16 * HY_UROW, HY_RSTRIDE = 8192 + 64;
__device__ __forceinline__ bf16x8 ld_frag4(const LAS unsigned char* p) {
    const LAS unsigned* q = (const LAS unsigned*)p; v4u d; d.x = q[0]; d.y = q[1]; d.z = q[2]; d.w = q[3]; return __builtin_bit_cast(bf16x8, d);
}
__device__ __forceinline__ void phase_hyena_mfma(const Args& a, LAS unsigned char* lds, int tid, int G, bool dummy = false) {
    const bf16* ut = (const bf16*)(a.ws + WS_UT); const bf16* Rg = (const bf16*)(a.ws + WS_GF); bf16* x0t = (bf16*)(a.ws + WS_X0T);
    const int lane = tid & 63, w = __builtin_amdgcn_readfirstlane(tid >> 6), i16 = lane & 15, kq = lane >> 4;
    const int base = (w >> 1) * 512 + (w & 1) * 16, cp = i16 & 1;
    const int lane_const = (2048 - base - i16 + 8 * kq - cp) >> 1;
    const LAS unsigned char* pA15 = lds + HY_ROFF + cp * HY_RSTRIDE + 4 * (lane_const - 240);
    const LAS unsigned char* pB = lds + i16 * HY_UROW + kq * 16;
    v4u pre[10];
#define HY_ISSUE(chn) do { _Pragma("unroll") for (int k_ = 0; k_ < 8; ++k_) { const int i_ = tid + NTHR * k_, b_ = i_ >> 8, ck_ = i_ & 255; pre[k_] = *(const v4u*)(ut + ((size_t)(chn) * NBATCH + b_) * SEQ + ck_ * 8); } \
        _Pragma("unroll") for (int k_ = 0; k_ < 2; ++k_) { const int i_ = tid + NTHR * k_, c2_ = i_ >> 9, ck_ = i_ & 511; pre[8 + k_] = *(const v4u*)(Rg + ((size_t)(chn) * 2 + c2_) * 4096 + ck_ * 8); } } while (0)
    for (int ch = blockIdx.x; ch < HYW; ch += G) {
        HY_ISSUE(ch);
#pragma unroll
        for (int k = 0; k < 8; ++k) { const int i = tid + NTHR * k, b = i >> 8, ck = i & 255; *(LAS v4u*)(lds + b * HY_UROW + ck * 16) = pre[k]; }
#pragma unroll
        for (int k = 0; k < 2; ++k) { const int i = tid + NTHR * k, c2 = i >> 9, ck = i & 511; *(LAS v4u*)(lds + HY_ROFF + c2 * HY_RSTRIDE + ck * 16) = pre[8 + k]; }
        __syncthreads();
        f32x4 acc[16]; bf16x8 W[16];
#pragma unroll
        for (int i = 0; i < 16; ++i) acc[i] = (f32x4){0.f, 0.f, 0.f, 0.f};
#pragma unroll
        for (int j = 1; j < 16; ++j) W[j] = ld_frag4(pA15 + 64 * (15 - j));
        W[0] = W[1];
#pragma unroll 1
        for (int tt = 0; tt < 4; ++tt) {
            const LAS unsigned char* pa = pA15 + 64 * 15 + 1024 * tt; const LAS unsigned char* pb = pB + 1024 * tt;
#pragma unroll
            for (int s = 0; s < 16; ++s) {
                W[(16 - s) & 15] = ld_frag4(pa + 64 * s);
                const bf16x8 Bf = *(const LAS bf16x8*)(pb + 64 * s);
#pragma unroll
                for (int i = 0; i < 16; ++i) acc[i] = __builtin_amdgcn_mfma_f32_16x16x32_bf16(W[(i - s) & 15], Bf, acc[i], 0, 0, 0);
            }
        }
        bf16* xo = x0t + ((size_t)ch * NBATCH + i16) * SEQ + base + 4 * kq;
#pragma unroll
        for (int i = 0; i < 16; ++i) {
            typedef unsigned u32x2v __attribute__((ext_vector_type(2)));
            const u32x2v xv = *(const u32x2v*)(xo + 32 * i);
            u32x2v o; o.x = pk2(__uint_as_float(xv.x << 16) * acc[i][0], __uint_as_float(xv.x & 0xffff0000u) * acc[i][1]);
            o.y = pk2(__uint_as_float(xv.y << 16) * acc[i][2], __uint_as_float(xv.y & 0xffff0000u) * acc[i][3]);
            if (!dummy) *(u32x2v*)(xo + 32 * i) = o; else *(u32x2v*)((bf16*)(a.ws + WS_YHY) + (size_t)tid * 64 + 4 * i) = o;
        }
        __syncthreads();
    }
}

__device__ __forceinline__ void phase_transpose_y(const Args& a, LAS unsigned char* lds, int tid, int G) {
    const bf16* yt = (const bf16*)(a.ws + WS_X0T); bf16* yhy = (bf16*)(a.ws + WS_YHY);
    LAS unsigned short* tile = (LAS unsigned short*)lds;
#define TY_LOAD(item_) (*(const v4u*)(yt + ((size_t)(((item_) & 7) * 64 + (tid >> 3)) * NBATCH + ((item_) >> 8)) * SEQ + (((item_) >> 3) & 31) * 64 + (tid & 7) * 8))
    v4u vnext = (v4u){0u, 0u, 0u, 0u};
    if ((int)blockIdx.x < 4096) vnext = TY_LOAD((int)blockIdx.x);
    for (int item = blockIdx.x; item < 4096; item += G) {
        const int cc = item & 7, mc = (item >> 3) & 31, b = item >> 8;
        { const int c2 = tid >> 3, ck = tid & 7;
          const v4u v = vnext;
          LAS unsigned* t4 = (LAS unsigned*)(tile + c2 * 72 + ck * 8); t4[0] = v.x; t4[1] = v.y; t4[2] = v.z; t4[3] = v.w; }
        __syncthreads();
        if (item + G < 4096) vnext = TY_LOAD(item + G);
        { const int nl = tid >> 3, cg8 = tid & 7; const LAS unsigned short* s = tile + (cg8 * 8) * 72 + nl;
          v4u o; o.x = s[0] | ((unsigned)s[72] << 16); o.y = s[144] | ((unsigned)s[216] << 16); o.z = s[288] | ((unsigned)s[360] << 16); o.w = s[432] | ((unsigned)s[504] << 16);
          *(v4u*)(yhy + (size_t)(b * SEQ + mc * 64 + nl) * 512 + cc * 64 + cg8 * 8) = o; }
        __syncthreads();
    }
}

constexpr int AT_ROWS = 272, AT_RS = 144, AT_VOFF = AT_ROWS * AT_RS;
__device__ __forceinline__ void phase_attn_mfma(const Args& a, int half, LAS unsigned char* lds, int tid, int G, bool dummy = false) {
    bf16* Q = (bf16*)(a.ws + WS_Q); const bf16* KV = (const bf16*)(a.ws + WS_KV); float* lse = (float*)(a.ws + WS_LSE);
    const int lane = tid & 63, w = __builtin_amdgcn_readfirstlane(tid >> 6), q16 = lane & 15, kq = lane >> 4;
    v4u pre[9]; bf16x8 Qn0, Qn1;
#define AT_DECODE(unit_) const int g = (unit_) >> 10, u = (unit_) & 1023, sub = u & 15, h = (u >> 4) & 7, bl = u >> 7; int dil, n, r, qb; \
        if (g == 0) { dil = 1; n = 2048; r = 0; qb = sub; } else if (g == 1) { dil = 4; n = 512; r = sub >> 2; qb = sub & 3; } else { dil = 16; n = 128; r = sub; qb = 0; } \
        const int q0 = qb * 128, kb0 = q0 - 64; (void)kb0; (void)q0;
#define AT_ISSUE(unit_) do { AT_DECODE(unit_) { const bf16* qn_ = Q + (size_t)(half * HALF_TOK + bl * SEQ + (q0 + 16 * w + q16) * dil + r) * 1536 + g * 512 + h * 64; Qn0 = *(const bf16x8*)(qn_ + 8 * kq); Qn1 = *(const bf16x8*)(qn_ + 32 + 8 * kq); } \
        _Pragma("unroll") for (int k_ = 0; k_ < 9; ++k_) { const int i_ = tid + NTHR * k_; \
            const int which_ = (i_ >= AT_ROWS * 8) ? 1 : 0, j_ = i_ - which_ * AT_ROWS * 8, rr_ = j_ >> 3, ck_ = j_ & 7, key_ = kb0 + rr_; \
            pre[k_] = (v4u){0u, 0u, 0u, 0u}; \
            if (i_ < 2 * AT_ROWS * 8 && key_ >= 0 && key_ < n) pre[k_] = *(const v4u*)(KV + (size_t)(bl * SEQ + key_ * dil + r) * 3072 + g * 1024 + which_ * 512 + h * 64 + ck_ * 8); } } while (0)
    if ((int)blockIdx.x < 3072) AT_ISSUE((int)blockIdx.x);
    for (int unit = blockIdx.x; unit < 3072; unit += G) {
#pragma unroll
        for (int k = 0; k < 9; ++k) { const int i = tid + NTHR * k; const int which = (i >= AT_ROWS * 8) ? 1 : 0, j = i - which * AT_ROWS * 8, rr = j >> 3, ck = j & 7;
            if (i < 2 * AT_ROWS * 8) *(LAS v4u*)(lds + which * AT_VOFF + rr * AT_RS + ck * 16) = pre[k]; }
        const bf16x8 Qf0 = Qn0, Qf1 = Qn1;
        __syncthreads();
        if (unit + G < 3072) AT_ISSUE(unit + G);
        AT_DECODE(unit)
        {
            const int i0 = q0 + 16 * w;
            const int token = half * HALF_TOK + bl * SEQ + (i0 + q16) * dil + r;
            bf16* qp = Q + (size_t)token * 1536 + g * 512 + h * 64;
            bf16* op = dummy ? (bf16*)(a.ws + WS_YHY) + (size_t)(tid & 511) * 64 : qp;
            f32x4 acc[4];
#pragma unroll
            for (int dt = 0; dt < 4; ++dt) acc[dt] = (f32x4){0.f, 0.f, 0.f, 0.f};
            float mrun = -1e30f, lrun = 0.f;
            const bool edge = (i0 < 64) || (i0 + 80 > n);
            const LAS unsigned char* kbase = lds + (16 * w + q16) * AT_RS + 16 * kq;
            const LAS unsigned char* vbase = lds + AT_VOFF + (16 * w + 4 * kq + (q16 >> 2)) * AT_RS + 8 * (q16 & 3);
#pragma unroll 1
            for (int st = 0; st < 5; ++st) {
                f32x4 s[2];
#pragma unroll
                for (int hh = 0; hh < 2; ++hh) {
                    const int kt = 2 * st + hh;
                    if (kt == 9) { s[hh] = (f32x4){-1e30f, -1e30f, -1e30f, -1e30f}; continue; }
                    const LAS unsigned char* kp = kbase + kt * 16 * AT_RS;
                    const bf16x8 K0 = *(const LAS bf16x8*)kp, K1 = *(const LAS bf16x8*)(kp + 64);
                    f32x4 z = (f32x4){0.f, 0.f, 0.f, 0.f};
                    z = __builtin_amdgcn_mfma_f32_16x16x32_bf16(K0, Qf0, z, 0, 0, 0);
                    z = __builtin_amdgcn_mfma_f32_16x16x32_bf16(K1, Qf1, z, 0, 0, 0);
                    if (kt == 0 || kt == 8 || edge) {
#pragma unroll
                    for (int e = 0; e < 4; ++e) {
                        const int rel = 16 * kt - 64 + 4 * kq + e - q16, j = i0 + q16 + rel;
                        const bool ok = (rel >= -64) && (rel <= 64) && (j >= 0) && (j < n);
                        z[e] = ok ? z[e] : -1e30f;
                    } }
                    s[hh] = z;
                }
                float mx = fmaxf(fmaxf(fmaxf(s[0][0], s[0][1]), fmaxf(s[0][2], s[0][3])), fmaxf(fmaxf(s[1][0], s[1][1]), fmaxf(s[1][2], s[1][3])));
                mx = fmaxf(mx, __shfl_xor(mx, 16)); mx = fmaxf(mx, __shfl_xor(mx, 32));
                const float mn = fmaxf(mrun, mx), corr = __builtin_amdgcn_exp2f(mrun - mn);
                mrun = mn;
                float p[8], ps = 0.f;
#pragma unroll
                for (int e = 0; e < 4; ++e) { p[e] = __builtin_amdgcn_exp2f(s[0][e] - mn); p[4 + e] = __builtin_amdgcn_exp2f(s[1][e] - mn); ps += p[e] + p[4 + e]; }
                lrun = lrun * corr + ps;
                v4u pw; pw.x = pg8::cvt_pk_bf16(p[0], p[1]); pw.y = pg8::cvt_pk_bf16(p[2], p[3]); pw.z = pg8::cvt_pk_bf16(p[4], p[5]); pw.w = pg8::cvt_pk_bf16(p[6], p[7]);
                const bf16x8 Pf = __builtin_bit_cast(bf16x8, pw);
#pragma unroll
                for (int dt = 0; dt < 4; ++dt) {
                    const LAS unsigned char* vp = vbase + 32 * st * AT_RS + 32 * dt;
                    const s16x4 v0 = __builtin_amdgcn_ds_read_tr16_b64_v4i16((LAS s16x4*)vp);
                    const s16x4 v1 = __builtin_amdgcn_ds_read_tr16_b64_v4i16((LAS s16x4*)(vp + 16 * AT_RS));
                    const bf16x8 Vf = (bf16x8){v0[0], v0[1], v0[2], v0[3], v1[0], v1[1], v1[2], v1[3]};
                    acc[dt] = acc[dt] * corr;
                    acc[dt] = __builtin_amdgcn_mfma_f32_16x16x32_bf16(Vf, Pf, acc[dt], 0, 0, 0);
                }
            }
            lrun += __shfl_xor(lrun, 16); lrun += __shfl_xor(lrun, 32);
            const float inv = 1.0f / lrun;
            typedef unsigned u32x2v __attribute__((ext_vector_type(2)));
#pragma unroll
            for (int dt = 0; dt < 4; ++dt) {
                u32x2v o; o.x = pg8::cvt_pk_bf16(acc[dt][0] * inv, acc[dt][1] * inv); o.y = pg8::cvt_pk_bf16(acc[dt][2] * inv, acc[dt][3] * inv);
                *(u32x2v*)(op + 16 * dt + 4 * kq) = o;
            }
            if (kq == 0 && !dummy) lse[((size_t)g * MTOK + token) * 8 + h] = mrun + log2f(lrun);
        }
        __syncthreads();
    }
}

#define XB_TMO      128
#define XB_XCNT(j)  (256  + 64 * (j))
#define XB_XSUB(j)  (1280 + 64 * (j))
#define XB_XGEN(j)  (2304 + 64 * (j))
#define XB_TOP      3328
#define XB_TOPGEN   3392
#define XCD_BAR_WORDS 3456
#define XB_SPIN_CAP (1u << 18)

__device__ __forceinline__ unsigned xb_ld(unsigned* p)              { return __hip_atomic_load(p, __ATOMIC_RELAXED, __HIP_MEMORY_SCOPE_AGENT); }
__device__ __forceinline__ unsigned xb_add(unsigned* p, unsigned v) { return __hip_atomic_fetch_add(p, v, __ATOMIC_RELAXED, __HIP_MEMORY_SCOPE_AGENT); }
__device__ __forceinline__ unsigned xb_xcc_id() { return (unsigned)__builtin_amdgcn_s_getreg((3 << 11) | 20) & 0xFu; }
#define XB_SPIN(cond, bar) do { unsigned _sp = 0; while (cond) { __builtin_amdgcn_s_sleep(1); \
    if ((++_sp & 255u) == 0u) { if (xb_ld(&(bar)[XB_TMO])) break; if (_sp > XB_SPIN_CAP) { atomicAdd(&(bar)[XB_TMO], 1u); break; } } } } while (0)

struct XcdBarrier {
    unsigned* bar; unsigned x;
    volatile LAS unsigned* st;
};

__device__ __forceinline__ XcdBarrier xcd_barrier_post(unsigned* bar, volatile LAS unsigned* st) {
    XcdBarrier b; b.bar = bar; b.x = xb_xcc_id(); b.st = st;
    if (threadIdx.x == 0) (void)xb_add(&bar[XB_XCNT(b.x)], 1u);
    return b;
}
__device__ __forceinline__ void xcd_barrier_complete(unsigned* bar, unsigned x, unsigned& nloc, unsigned& nx) {
    const unsigned G = gridDim.x * gridDim.y * gridDim.z;
    unsigned sum, cnt, mine, sp = 0u;
    for (;;) {
        sum = 0u; cnt = 0u; mine = 0u;
#pragma unroll
        for (unsigned j = 0; j < 16; ++j) { const unsigned c = xb_ld(&bar[XB_XCNT(j)]); sum += c; cnt += (c > 0u) ? 1u : 0u; mine = (j == x) ? c : mine; }
        if (sum == G) break;
        __builtin_amdgcn_s_sleep(1);
        if ((++sp & 255u) == 0u) { if (xb_ld(&bar[XB_TMO])) break; if (sp > XB_SPIN_CAP) { atomicAdd(&bar[XB_TMO], 1u); break; } }
    }
    nloc = mine > 0u ? mine : 1u; nx = cnt > 0u ? cnt : 1u;
}

__device__ __forceinline__ void xcd_barrier(const XcdBarrier& b) {
    asm volatile("s_waitcnt vmcnt(0)" ::: "memory");
    __syncthreads();
    if (threadIdx.x == 0) {
        unsigned* bar = b.bar;
        __builtin_amdgcn_s_waitcnt(0);
        unsigned nloc = b.st[0], nx = b.st[1];
        if (nloc == 0u) { xcd_barrier_complete(bar, b.x, nloc, nx); b.st[0] = nloc; b.st[1] = nx; }
        const unsigned old = xb_add(&bar[XB_XSUB(b.x)], 1u);
        const unsigned gen = old / nloc;
        if (old + 1u == (gen + 1u) * nloc) {
            __builtin_amdgcn_fence(__ATOMIC_RELEASE, "agent");
            asm volatile("s_waitcnt vmcnt(0)" ::: "memory");
            const unsigned og = xb_add(&bar[XB_TOP], 1u);
            const unsigned tg = og / nx;
            if (og + 1u == (tg + 1u) * nx) xb_add(&bar[XB_TOPGEN], 1u);
            else XB_SPIN(xb_ld(&bar[XB_TOPGEN]) == tg, bar);
            __builtin_amdgcn_fence(__ATOMIC_ACQUIRE, "agent");
            xb_add(&bar[XB_XGEN(b.x)], 1u);
            asm volatile("s_waitcnt vmcnt(0)" ::: "memory");
        } else {
            XB_SPIN(xb_ld(&bar[XB_XGEN(b.x)]) == gen, bar);
            __builtin_amdgcn_fence(__ATOMIC_ACQUIRE, "agent");
            asm volatile("s_waitcnt vmcnt(0)" ::: "memory");
        }
    }
    __syncthreads();
}

#define GEMM_CALL(EPI, SCHED, g, S, E) pg8::gemm_phase<EPI, SCHED, true, true>(lds, g, S, E)
#ifndef PROBE_G
#define PROBE_G 0
#endif
#ifndef PROBE_S
#define PROBE_S 0
#endif
#define GEMM_CALL_P(EPI, SCHED, g, S, E) do { _Pragma("unroll 1") for (int rep_ = 0; rep_ < 1 + PROBE_G; ++rep_) { GEMM_CALL(EPI, SCHED, g, S, E); } } while (0)
#ifndef PROBE_PW
#define PROBE_PW 0
#endif
#ifndef PROBE_PU
#define PROBE_PU 0
#endif
#ifndef PROBE_CT
#define PROBE_CT 0
#endif
#ifndef PROBE_AT
#define PROBE_AT 0
#endif
#ifndef PROBE_HY
#define PROBE_HY 0
#endif
#define REP_N(N_) _Pragma("unroll 1") for (int rep_ = 0; rep_ < 1 + (N_); ++rep_)

typedef const __attribute__((address_space(4))) Args* KArgs;
__device__ __forceinline__ Args load_args() {
#if defined(__HIP_DEVICE_COMPILE__)
    KArgs p = (KArgs)__builtin_amdgcn_kernarg_segment_ptr();
    asm volatile("" : "+s"(p));
    return *p;
#else
    return Args{};
#endif
}
__global__ void __launch_bounds__(NTHR, 2) fwd_megakernel(Args a_unused) {
    extern __shared__ __attribute__((aligned(16))) unsigned char lds_raw[];
    LAS unsigned char* lds = (LAS unsigned char*)lds_raw;
    cg::grid_group grid = cg::this_grid();
    const int tid0 = threadIdx.x, G0 = gridDim.x, bx0 = blockIdx.x;
    if (tid0 < 2) ((LAS unsigned*)(lds + LDS_ST_OFF))[tid0] = 0u;
    __syncthreads();
    { const Args a0 = load_args(); (void)xcd_barrier_post((unsigned*)(a0.ws + WS_BAR), (volatile LAS unsigned*)(lds + LDS_ST_OFF)); }
#define GSYNC() do { const Args ab = load_args(); XcdBarrier xb_; xb_.bar = (unsigned*)(ab.ws + WS_BAR); xb_.x = xb_xcc_id(); xb_.st = (volatile LAS unsigned*)(lds + LDS_ST_OFF); xcd_barrier(xb_); } while (0)
#define PTRS() const Args a = load_args(); int tid = tid0, G = G0, bx = bx0; asm volatile("" : "+v"(tid), "+s"(G), "+s"(bx)); const int lane = tid & 63, wave = __builtin_amdgcn_readfirstlane(tid >> 6); (void)lane; (void)wave; unsigned char* ws = a.ws; bf16* Wb = (bf16*)(ws + WS_W); const pg8::bf16_t* xb = (const pg8::bf16_t*)(ws + WS_XB); \
    const float* rcos = (const float*)(ws + WS_ROPE); const float* rsin = rcos + 65536; float* ssqA = (float*)(ws + WS_SSQA); float* ssqB = (float*)(ws + WS_SSQB); \
    (void)Wb; (void)xb; (void)rcos; (void)rsin; (void)ssqA; (void)ssqB;
#define GIN() pg8::Gemm gin{xb, (const pg8::bf16_t*)(Wb + W_IN / 2), nullptr, nullptr, MTOK, NIN, DM}; \
    pg8::EpiIn Ein{(pg8::bf16_t*)(ws + WS_HY), (pg8::bf16_t*)(ws + WS_Q), (pg8::bf16_t*)(ws + WS_KV), (pg8::bf16_t*)(ws + WS_GATES), ssqA, rcos, rsin, 0};

#pragma unroll 1
    for (int L = 0; L < 2; ++L) {
        REP_N(PROBE_PW) { PTRS(); phase_prep_weights(a, L, lds, tid, lane, wave, G); }
        if (L == 0) grid.sync(); else GSYNC();
        {
            PTRS(); GIN();
            pg8::TwoRect S; S.a.init(128, 12, 0, 0, G, bx); S.b.init(64, 12, 0, 12, G, bx); S.na = S.a.count();
            GEMM_CALL_P(pg8::EpiIn, pg8::TwoRect, gin, S, Ein);
        }
        GSYNC();
        REP_N(PROBE_AT) { PTRS(); phase_attn_mfma(a, 0, lds, tid, G, rep_ < PROBE_AT); } { PTRS(); REP_N(PROBE_PU) { phase_prep_u(a, L, lds, tid, G); } }
        GSYNC();
        {
            PTRS(); GIN();
            pg8::RectOrder S; S.init(64, 12, 64, 12, G, bx);
            Ein.kv_row0 = HALF_TOK;
            GEMM_CALL_P(pg8::EpiIn, pg8::RectOrder, gin, S, Ein);
        }
        REP_N(PROBE_HY) { PTRS(); phase_hyena_mfma(a, lds, tid, G, rep_ < PROBE_HY); }
        GSYNC();
        REP_N(PROBE_AT) { PTRS(); phase_attn_mfma(a, 1, lds, tid, G, rep_ < PROBE_AT); }
        {
            PTRS(); GIN();
            pg8::RectOrder S; S.init(128, 8, 0, 24, G, bx);
            GEMM_CALL_P(pg8::EpiIn, pg8::RectOrder, gin, S, Ein);
        }
        GSYNC();
        REP_N(PROBE_CT) { PTRS(); phase_combine(a, tid, G); phase_transpose_y(a, lds, tid, G); }
        GSYNC();
        {
            PTRS();
            pg8::Gemm g{(const pg8::bf16_t*)(ws + WS_YHY), (const pg8::bf16_t*)(Wb + W_PHY / 2), (const pg8::bf16_t*)(ws + WS_YATT), (const pg8::bf16_t*)(Wb + W_PATT / 2), MTOK, DM, 512};
            pg8::PairOrder S; S.r.init(128, 4, 0, 0, G, bx);
            pg8::EpiGate E{(const pg8::bf16_t*)(ws + WS_GATES), (pg8::bf16_t*)(ws + WS_MERGED)};
            GEMM_CALL_P(pg8::EpiGate, pg8::PairOrder, g, S, E);
        }
        GSYNC();
        {
            PTRS();
            pg8::Gemm g{(const pg8::bf16_t*)(ws + WS_MERGED), (const pg8::bf16_t*)(Wb + W_O / 2), nullptr, nullptr, MTOK, DM, DM};
            pg8::RectOrder S; S.init(128, 4, 0, 0, G, bx);
            pg8::EpiRes E{L == 0 ? a.in[0] : a.out, a.out, (pg8::bf16_t*)(ws + WS_XB), ssqB};
            GEMM_CALL(pg8::EpiRes, pg8::RectOrder, g, S, E);
        }
        GSYNC();
        {
            PTRS();
            pg8::Gemm g{xb, (const pg8::bf16_t*)(Wb + W_FF1 / 2), nullptr, nullptr, MTOK, DFF, DM};
            pg8::RectOrder S; S.init(128, 16, 0, 0, G, bx);
            pg8::EpiFF1 E{(pg8::bf16_t*)(ws + WS_H), ssqB};
            GEMM_CALL_P(pg8::EpiFF1, pg8::RectOrder, g, S, E);
        }
        GSYNC();
        {
            PTRS();
            pg8::Gemm g{(const pg8::bf16_t*)(ws + WS_H), (const pg8::bf16_t*)(Wb + W_FF2 / 2), nullptr, nullptr, MTOK, DM, DFF};
            pg8::RectOrder S; S.init(128, 4, 0, 0, G, bx);
            pg8::EpiRes E{a.out, a.out, (pg8::bf16_t*)(ws + WS_XB), ssqA};
            GEMM_CALL(pg8::EpiRes, pg8::RectOrder, g, S, E);
        }
        GSYNC();
    }
    { PTRS(); phase_final_norm(a, lane, wave, G); }
}

extern "C" void kernel_launch(void* const* d_in, const int* in_sizes, int n_in, void* d_out, int out_size, void* d_ws, size_t ws_size, hipStream_t stream) {
    static int grid = 0;
    if (grid == 0) {
        if (n_in != 19 || in_sizes[0] != MTOK * DM || out_size != MTOK * DM || ws_size < WS_END) {
            fprintf(stderr, "kernel_launch: unexpected shapes / workspace (n_in %d, ws %zu, need %zu); nothing launched\n", n_in, ws_size, (size_t)WS_END); grid = -1; return; }
        int dev = 0, cus = 0, per_cu = 0;
        (void)hipGetDevice(&dev); (void)hipDeviceGetAttribute(&cus, hipDeviceAttributeMultiprocessorCount, dev);
        if (hipFuncSetAttribute((const void*)fwd_megakernel, hipFuncAttributeMaxDynamicSharedMemorySize, LDS_BYTES) != hipSuccess) { fprintf(stderr, "kernel_launch: hipFuncSetAttribute failed\n"); grid = -1; return; }
        if (hipOccupancyMaxActiveBlocksPerMultiprocessor(&per_cu, (const void*)fwd_megakernel, NTHR, LDS_BYTES) != hipSuccess || per_cu < 1) { fprintf(stderr, "kernel_launch: occupancy query gives %d\n", per_cu); per_cu = 1; }
        (void)hipGetLastError();
        grid = cus * 1;
        if (grid % 8 != 0 || grid > 256) grid = (grid > 256) ? 256 : (grid / 8) * 8;
    }
    if (grid < 0) return;
    Args a{};
    for (int i = 0; i < 19; ++i) a.in[i] = (const float*)d_in[i];
    a.out = (float*)d_out; a.ws = (unsigned char*)d_ws;
    if (hipMemsetAsync((char*)d_ws + WS_BAR, 0, 16384, stream) != hipSuccess) { fprintf(stderr, "kernel_launch: memset of the barrier words failed\n"); return; }
    void* args[] = {&a};
    hipError_t e = hipLaunchCooperativeKernel((const void*)fwd_megakernel, dim3(grid), dim3(NTHR), args, LDS_BYTES, stream);
    if (e != hipSuccess) fprintf(stderr, "cooperative launch failed: %s (grid %d)\n", hipGetErrorString(e), grid);
}
```

```cpp
#include <hip/hip_runtime.h>
#include <hip/hip_cooperative_groups.h>
#include <cstdio>
#include <cstdint>
namespace cg = cooperative_groups;

namespace pg8 {
#define PG8_LAS __attribute__((address_space(3)))
typedef unsigned short bf16_t;
typedef short bf16x8 __attribute__((ext_vector_type(8)));
typedef float f32x4 __attribute__((ext_vector_type(4)));
typedef unsigned u32x4 __attribute__((ext_vector_type(4)));
constexpr int BM = 256, BK = 64, HALF = 128, HTB = HALF * BK * 2  , STAGE_BYTES = 8 * HTB, NXCD = 8, WGM = 8;

__host__ __device__ __forceinline__ int lds_byte(int r, int c) { const int st = (r >> 4) * 2 + (c >> 5), rr = r & 15, cc = c & 31, ob = rr * 64 + cc * 2; return st * 1024 + (ob ^ (((ob >> 9) & 1) << 5)); }
__host__ __device__ __forceinline__ void stage_rc(int b, int& R, int& C) { const int st = b / 1024, sb = b % 1024, swz = sb ^ (((sb >> 9) & 1) << 5); R = (st >> 1) * 16 + swz / 64; C = (st & 1) * 32 + (swz % 64) / 2; }
__host__ __device__ __forceinline__ int perm32(int rho) { const int n = rho >> 4, i = rho & 15; return 8 * (i >> 2) + 4 * n + (i & 3); }

struct Unit { int pm, pn, z; };
struct Gemm { const bf16_t* A; const bf16_t* Bt; const bf16_t* A1; const bf16_t* Bt1; int M, N, K; };

struct StaticOrder {
    int nM, nN, nwg, G, c;
    __host__ __device__ void init(int M, int N, int G_, int c_) { nM = M / BM; nN = N / BM; nwg = nM * nN; G = G_; c = c_; }
    __host__ __device__ bool next(int i, Unit& u) const {
        const long L = (long)i * G + c; if (L >= nwg) return false;
        int wgid = (int)L; { const int q = nwg / NXCD, r = nwg % NXCD, xcd = wgid % NXCD, off = wgid / NXCD; wgid = (xcd < r ? xcd * (q + 1) : r * (q + 1) + (xcd - r) * q) + off; }
        const int nig = WGM * nN, gid = wgid / nig, fm = gid * WGM, gsz = (nM - fm) < WGM ? (nM - fm) : WGM;
        u.pm = fm + ((wgid % nig) % gsz); u.pn = (wgid % nig) / gsz; return true;
    }
    __device__ __forceinline__ void a_ready(const Unit&) const {}
    __device__ __forceinline__ void done(const Unit&) const {}
};


__device__ __forceinline__ unsigned cvt_pk_bf16(float lo, float hi) { unsigned r; asm volatile("v_cvt_pk_bf16_f32 %0, %1, %2" : "=v"(r) : "v"(lo), "v"(hi)); return r; }
__device__ __forceinline__ float bf_lo(unsigned w) { return __uint_as_float(w << 16); }
__device__ __forceinline__ float bf_hi(unsigned w) { return __uint_as_float(w & 0xffff0000u); }

struct RectOrder {
    int nN, nwg, G, c, pm0, pn0;
    __device__ __forceinline__ void init(int nM_, int nN_, int pm0_, int pn0_, int G_, int c_) { nN = nN_; nwg = nM_ * nN_; G = G_; c = c_; pm0 = pm0_; pn0 = pn0_; }
    __device__ __forceinline__ int count() const { return nwg > c ? (nwg - c + G - 1) / G : 0; }
    __device__ __forceinline__ bool next(int i, Unit& u) const {
        const long L = (long)i * G + c; if (L >= nwg) return false;
        int w = (int)L;
        if ((nwg & 7) == 0 && (G & 7) == 0) w = (c & 7) * (nwg >> 3) + (w >> 3);
        const int nig = 8 * nN, gid = w / nig, r = w % nig;
        u.pm = pm0 + gid * 8 + (r & 7); u.pn = pn0 + (r >> 3); u.z = 0; return true;
    }
    __device__ __forceinline__ void a_ready(const Unit&) const {}
    __device__ __forceinline__ void done(const Unit&) const {}
};
struct TwoRect {
    RectOrder a, b; int na;
    __device__ __forceinline__ bool next(int i, Unit& u) const { return i < na ? a.next(i, u) : b.next(i - na, u); }
    __device__ __forceinline__ void a_ready(const Unit&) const {}
    __device__ __forceinline__ void done(const Unit&) const {}
};
struct PairOrder {
    RectOrder r;
    __device__ __forceinline__ bool next(int i, Unit& u) const { const bool ok = r.next(i >> 1, u); u.z = i & 1; return ok; }
    __device__ __forceinline__ void a_ready(const Unit&) const {}
    __device__ __forceinline__ void done(const Unit&) const {}
};

constexpr float RMS_EPS = 1e-6f;
constexpr float QSCALE = 0.125f * 1.44269504088896341f;

__device__ __forceinline__ float row_rstd(const float* ssq, int row) {
    const f32x4* p = (const f32x4*)(ssq + (size_t)row * 16);
    const f32x4 a = p[0], b = p[1], c = p[2], d = p[3];
    const float s = ((a[0] + a[1]) + (a[2] + a[3])) + ((b[0] + b[1]) + (b[2] + b[3])) + ((c[0] + c[1]) + (c[2] + c[3])) + ((d[0] + d[1]) + (d[2] + d[3]));
    return __builtin_amdgcn_rsqf(s * (1.0f / 1024.0f) + RMS_EPS);
}

template <class Sched>
__device__ __forceinline__ void fill_rstd_table(const Sched& S, const float* ssq, PG8_LAS float* rtab, int tid) {
    int q0 = -1, q1 = -1, q2 = -1; Unit u;
#pragma unroll 1
    for (int i = 0; S.next(i, u); ++i) { if (u.pm == q0 || u.pm == q1 || u.pm == q2) continue; if (q0 < 0) q0 = u.pm; else if (q1 < 0) q1 = u.pm; else if (q2 < 0) q2 = u.pm; }
    if (tid == 0) { ((PG8_LAS int*)rtab)[768] = q0; ((PG8_LAS int*)rtab)[769] = q1; ((PG8_LAS int*)rtab)[770] = 0; }
    const int t = tid & 255, half = tid >> 8;
    { const int pm = half ? q1 : q0; if (pm >= 0) { rtab[half * 256 + t] = row_rstd(ssq, pm * BM + t); } }
    if (q2 >= 0 && half == 0) { const float v = row_rstd(ssq, q2 * BM + t); rtab[512 + t] = v; }
    __syncthreads();
}

struct EpiIn {
    static constexpr bool PERM = true, AFTER_DRAIN = false, IDEMPOTENT = true;
    bf16_t* hy; bf16_t* q; bf16_t* kv; bf16_t* gates; const float* ssq; const float* rcos; const float* rsin; int kv_row0;
    __device__ __forceinline__ bool operator()(f32x4 (&acc)[2][2][4][2], const Unit& u, int wr, int wc, int fr, int fq) const {
        const int pn = u.pn; int type, ldc, colt, rowoff = 0; bf16_t* base;
        if (pn < 6) { type = 0; base = hy; ldc = 1536; colt = pn * 256; }
        else if (pn < 12) { type = 1; base = q; ldc = 1536; colt = (pn - 6) * 256; }
        else if (pn < 24) { const int idx = pn - 12; type = ((idx >> 1) & 1) ? 0 : 2; base = kv; ldc = 3072; colt = idx * 256; rowoff = kv_row0; }
        else { type = 3; base = gates; ldc = 2048; colt = (pn - 24) * 256; }
        const bool rot = (type == 1 || type == 2);
        const int row0 = u.pm * BM + wr * 64 + fr;
        f32x4 S[2][4], C[2][4];
#define EPIIN_LOAD(k_, buf_) do { const int row_ = row0 + ((k_) >> 2) * HALF + ((k_) & 3) * 16; const f32x4* p_ = (const f32x4*)(ssq + (size_t)row_ * 16); \
            S[buf_][0] = p_[0]; S[buf_][1] = p_[1]; S[buf_][2] = p_[2]; S[buf_][3] = p_[3]; \
            if (rot) { const int pos_ = row_ & 2047; C[buf_][0] = *(const f32x4*)(rcos + pos_ * 32 + 8 * fq); C[buf_][1] = *(const f32x4*)(rcos + pos_ * 32 + 8 * fq + 4); \
                       C[buf_][2] = *(const f32x4*)(rsin + pos_ * 32 + 8 * fq); C[buf_][3] = *(const f32x4*)(rsin + pos_ * 32 + 8 * fq + 4); } } while (0)
        EPIIN_LOAD(0, 0);
#pragma unroll
        for (int k = 0; k < 8; ++k) {
            const int ai = k >> 2, m = k & 3, cb = k & 1;
            if (k < 7) EPIIN_LOAD(k + 1, cb ^ 1);
            const int row = row0 + ai * HALF + m * 16;
            float rs;
            { const f32x4 a = S[cb][0], b = S[cb][1], c = S[cb][2], d = S[cb][3];
              const float s = ((a[0] + a[1]) + (a[2] + a[3])) + ((b[0] + b[1]) + (b[2] + b[3])) + ((c[0] + c[1]) + (c[2] + c[3])) + ((d[0] + d[1]) + (d[2] + d[3]));
              rs = __builtin_amdgcn_rsqf(s * (1.0f / 1024.0f) + RMS_EPS); }
            bf16_t* rowp = base + (size_t)(row - rowoff) * ldc + colt;
            f32x4 v00 = acc[ai][0][m][0] * rs, v01 = acc[ai][0][m][1] * rs, v10 = acc[ai][1][m][0] * rs, v11 = acc[ai][1][m][1] * rs;
            if (rot) {
                const f32x4 c0 = C[cb][0], c1 = C[cb][1], s0 = C[cb][2], s1 = C[cb][3];
                const float sc = (type == 1) ? QSCALE : 1.0f;
                const f32x4 o00 = (v00 * c0 - v10 * s0) * sc, o01 = (v01 * c1 - v11 * s1) * sc;
                const f32x4 o10 = (v10 * c0 + v00 * s0) * sc, o11 = (v11 * c1 + v01 * s1) * sc;
                u32x4 w0, w1;
                w0.x = cvt_pk_bf16(o00[0], o00[1]); w0.y = cvt_pk_bf16(o00[2], o00[3]); w0.z = cvt_pk_bf16(o01[0], o01[1]); w0.w = cvt_pk_bf16(o01[2], o01[3]);
                w1.x = cvt_pk_bf16(o10[0], o10[1]); w1.y = cvt_pk_bf16(o10[2], o10[3]); w1.z = cvt_pk_bf16(o11[0], o11[1]); w1.w = cvt_pk_bf16(o11[2], o11[3]);
                *(u32x4*)(rowp + wc * 64 + 8 * fq) = w0;
                *(u32x4*)(rowp + wc * 64 + 8 * fq + 32) = w1;
            } else {
                if (type == 3) {
#pragma unroll
                    for (int e = 0; e < 4; ++e) {
                        v00[e] = __builtin_amdgcn_rcpf(1.0f + __expf(-v00[e])); v01[e] = __builtin_amdgcn_rcpf(1.0f + __expf(-v01[e]));
                        v10[e] = __builtin_amdgcn_rcpf(1.0f + __expf(-v10[e])); v11[e] = __builtin_amdgcn_rcpf(1.0f + __expf(-v11[e]));
                    }
                }
                u32x4 w0, w1;
                w0.x = cvt_pk_bf16(v00[0], v00[1]); w0.y = cvt_pk_bf16(v00[2], v00[3]); w0.z = cvt_pk_bf16(v01[0], v01[1]); w0.w = cvt_pk_bf16(v01[2], v01[3]);
                w1.x = cvt_pk_bf16(v10[0], v10[1]); w1.y = cvt_pk_bf16(v10[2], v10[3]); w1.z = cvt_pk_bf16(v11[0], v11[1]); w1.w = cvt_pk_bf16(v11[2], v11[3]);
                *(u32x4*)(rowp + wc * 32 + 8 * fq) = w0;
                *(u32x4*)(rowp + wc * 32 + 8 * fq + HALF) = w1;
            }
        }
#undef EPIIN_LOAD
        return false;
    }
};

struct EpiGate {
    static constexpr bool PERM = true, AFTER_DRAIN = false, IDEMPOTENT = false;
    const bf16_t* gates; bf16_t* merged;
    __device__ __forceinline__ bool operator()(f32x4 (&acc)[2][2][4][2], const Unit& u, int wr, int wc, int fr, int fq) const {
        const int row0 = u.pm * BM + wr * 64 + fr, col0 = u.pn * BM + wc * 32 + 8 * fq;
        const bool first = (u.z == 0);
        u32x4 GA[2][2], GH[2][2];
#define EPIG_LOAD(k_, buf_) do { const bf16_t* gp_ = gates + (size_t)(row0 + ((k_) >> 2) * HALF + ((k_) & 3) * 16) * 2048 + col0; \
            GA[buf_][0] = *(const u32x4*)(gp_ + 1024); GA[buf_][1] = *(const u32x4*)(gp_ + 1024 + HALF); \
            if (first) { GH[buf_][0] = *(const u32x4*)(gp_); GH[buf_][1] = *(const u32x4*)(gp_ + HALF); } } while (0)
        EPIG_LOAD(0, 0);
#pragma unroll
        for (int k = 0; k < 8; ++k) {
            const int ai = k >> 2, m = k & 3, cb = k & 1;
            if (k < 7) EPIG_LOAD(k + 1, cb ^ 1);
            const int row = row0 + ai * HALF + m * 16;
#pragma unroll
            for (int bj = 0; bj < 2; ++bj) {
                const u32x4 ga = GA[cb][bj];
                f32x4 a0 = (f32x4){bf_lo(ga.x), bf_hi(ga.x), bf_lo(ga.y), bf_hi(ga.y)}, a1 = (f32x4){bf_lo(ga.z), bf_hi(ga.z), bf_lo(ga.w), bf_hi(ga.w)};
                if (first) {
                    const u32x4 gh = GH[cb][bj];
                    const f32x4 h0 = (f32x4){bf_lo(gh.x), bf_hi(gh.x), bf_lo(gh.y), bf_hi(gh.y)}, h1 = (f32x4){bf_lo(gh.z), bf_hi(gh.z), bf_lo(gh.w), bf_hi(gh.w)};
#pragma unroll
                    for (int e = 0; e < 4; ++e) { a0[e] = fmaxf(a0[e], 1e-30f); a1[e] = fmaxf(a1[e], 1e-30f); }
#pragma unroll
                    for (int e = 0; e < 4; ++e) { acc[ai][bj][m][0][e] *= h0[e] * __builtin_amdgcn_rcpf(a0[e]); acc[ai][bj][m][1][e] *= h1[e] * __builtin_amdgcn_rcpf(a1[e]); }
                } else {
                    const f32x4 v0 = acc[ai][bj][m][0] * a0, v1 = acc[ai][bj][m][1] * a1;
                    u32x4 w; w.x = cvt_pk_bf16(v0[0], v0[1]); w.y = cvt_pk_bf16(v0[2], v0[3]); w.z = cvt_pk_bf16(v1[0], v1[1]); w.w = cvt_pk_bf16(v1[2], v1[3]);
                    *(u32x4*)(merged + (size_t)row * 1024 + col0 + bj * HALF) = w;
                }
            }
        }
#undef EPIG_LOAD
        return first;
    }
};

struct EpiRes {
    static constexpr bool PERM = false, AFTER_DRAIN = false, IDEMPOTENT = false;
    const float* base32; bf16_t* xb; float* ssq;
    __device__ __forceinline__ bool operator()(f32x4 (&acc)[2][2][4][2], const Unit& u, int wr, int wc, int fr, int fq) const {
        typedef unsigned u32x2v __attribute__((ext_vector_type(2)));
        int rl = wr * 64 + fr, cl = wc * 32 + 4 * fq;
        asm volatile("" : "+v"(rl), "+v"(cl));
        const bool f32base = base32 != nullptr;
        f32x4 Bv[2][4];
#define EPIRES_LOAD(k_, buf_) do { const size_t off_ = (size_t)(u.pm * BM + ((k_) >> 2) * HALF + ((k_) & 3) * 16 + rl) * 1024 + u.pn * BM + cl; \
            if (f32base) { Bv[buf_][0] = *(const f32x4*)(base32 + off_); Bv[buf_][1] = *(const f32x4*)(base32 + off_ + 16); Bv[buf_][2] = *(const f32x4*)(base32 + off_ + HALF); Bv[buf_][3] = *(const f32x4*)(base32 + off_ + HALF + 16); } \
            else { _Pragma("unroll") for (int j_ = 0; j_ < 4; ++j_) { const u32x2v w_ = *(const u32x2v*)(xb + off_ + (j_ >> 1) * HALF + (j_ & 1) * 16); \
                       Bv[buf_][j_] = (f32x4){bf_lo(w_.x), bf_hi(w_.x), bf_lo(w_.y), bf_hi(w_.y)}; } } } while (0)
        EPIRES_LOAD(0, 0);
#pragma unroll
        for (int k = 0; k < 8; ++k) {
            const int ai = k >> 2, m = k & 3, cb = k & 1;
            if (k < 7) EPIRES_LOAD(k + 1, cb ^ 1);
            const int row = u.pm * BM + ai * HALF + m * 16 + rl;
            const size_t off = (size_t)row * 1024 + u.pn * BM + cl;
            float s = 0.f;
#pragma unroll
            for (int bj = 0; bj < 2; ++bj)
#pragma unroll
                for (int n = 0; n < 2; ++n) {
                    const f32x4 o = Bv[cb][bj * 2 + n] + acc[ai][bj][m][n];
                    u32x2v w; w.x = cvt_pk_bf16(o[0], o[1]); w.y = cvt_pk_bf16(o[2], o[3]);
                    *(u32x2v*)(xb + off + bj * HALF + n * 16) = w;
                    s += (o[0] * o[0] + o[1] * o[1]) + (o[2] * o[2] + o[3] * o[3]);
                }
            s += __shfl_xor(s, 16); s += __shfl_xor(s, 32);
            if (fq == 0) ssq[(size_t)row * 16 + u.pn * 4 + wc] = s;
        }
#undef EPIRES_LOAD
        return false;
    }
};

struct EpiFF1 {
    static constexpr bool PERM = true, AFTER_DRAIN = false, IDEMPOTENT = true;
    bf16_t* h; const PG8_LAS float* rtab;
    __device__ __forceinline__ bool operator()(f32x4 (&acc)[2][2][4][2], const Unit& u, int wr, int wc, int fr, int fq) const {
        const int row0 = u.pm * BM + wr * 64 + fr;
        const int p0 = ((const PG8_LAS int*)rtab)[768], p1 = ((const PG8_LAS int*)rtab)[769];
        const PG8_LAS float* rt = rtab + ((u.pm == p0) ? 0 : ((u.pm == p1) ? 256 : 512)) + wr * 64 + fr;
        float rsv[8];
#pragma unroll
        for (int k = 0; k < 8; ++k) rsv[k] = rt[(k >> 2) * HALF + (k & 3) * 16];
#pragma unroll
        for (int ai = 0; ai < 2; ++ai)
#pragma unroll
            for (int m = 0; m < 4; ++m) {
                const int row = row0 + ai * HALF + m * 16;
                const float rs = rsv[ai * 4 + m];
                bf16_t* rowp = h + (size_t)row * 4096 + u.pn * BM + wc * 32 + 8 * fq;
#pragma unroll
                for (int bj = 0; bj < 2; ++bj) {
                    f32x4 v0 = acc[ai][bj][m][0] * rs, v1 = acc[ai][bj][m][1] * rs;
#pragma unroll
                    for (int e = 0; e < 4; ++e) { v0[e] = fmaxf(v0[e], 0.f); v1[e] = fmaxf(v1[e], 0.f); }
                    v0 = v0 * v0; v1 = v1 * v1;
                    u32x4 w; w.x = cvt_pk_bf16(v0[0], v0[1]); w.y = cvt_pk_bf16(v0[2], v0[3]); w.z = cvt_pk_bf16(v1[0], v1[1]); w.w = cvt_pk_bf16(v1[2], v1[3]);
                    *(u32x4*)(rowp + bj * HALF) = w;
                }
            }
        return false;
    }
};

template <class Epi, class Sched, bool ALIGN_EPI = false, bool SP2 = false>
__device__ __forceinline__ void gemm_phase(PG8_LAS unsigned char* lds, const Gemm g, const Sched& S, const Epi& E, int tid_in) {
    int tid_ = tid_in; asm volatile("" : "+v"(tid_));
    const int tid = tid_, wid = __builtin_amdgcn_readfirstlane(tid >> 6), lane = tid & 63, wr = wid >> 2, wc = wid & 3, fr = lane & 15, fq = lane >> 4;
    const int K = g.K, nt = K / BK;
    unsigned voffA[2], voffB[2];
#pragma unroll
    for (int i = 0; i < 2; ++i) { int R, C; stage_rc(tid * 16 + i * 8192, R, C); const int Rb = Epi::PERM ? ((R & ~31) + perm32(R & 31)) : R;
        voffA[i] = (unsigned)(R * K + C) * 2u; voffB[i] = (unsigned)(Rb * K + C) * 2u; }
    const size_t kstep = (size_t)(BK * 2);
    const size_t hstep = (size_t)HALF * K * 2;
    const size_t tstep = 2 * hstep;
    const unsigned ldsw = (unsigned)wid * 1024u;
    const int aoff = lds_byte(wr * 64 + fr, fq * 8), boff = lds_byte(wc * 32 + fr, fq * 8);
#define PG8_SA(b, h) (((b) * 2 + (h)) * HTB)
#define PG8_SB(b, h) ((4 + (b) * 2 + (h)) * HTB)
#define PG8_STAGE(bufoff, gbase, voff) do { _Pragma("unroll") for (int _i = 0; _i < 2; ++_i) \
        __builtin_amdgcn_global_load_lds((const unsigned*)((const char*)(gbase) + (voff)[_i]), (PG8_LAS unsigned*)(lds + (bufoff) + ldsw + _i * 8192), 16, 0, 0); } while (0)
#define PG8_LDA(dst, b, h) do { _Pragma("unroll") for (int m = 0; m < 4; ++m) _Pragma("unroll") for (int k = 0; k < 2; ++k) dst[m][k] = *(const PG8_LAS bf16x8*)(lds + PG8_SA(b, h) + aoff + m * 2048 + k * 1024); } while (0)
#define PG8_LDB(dst, b, h) do { _Pragma("unroll") for (int n = 0; n < 2; ++n) _Pragma("unroll") for (int k = 0; k < 2; ++k) dst[n][k] = *(const PG8_LAS bf16x8*)(lds + PG8_SB(b, h) + boff + n * 2048 + k * 1024); } while (0)
#define PG8_MMA(ai, bj, At, Bt) do { __builtin_amdgcn_s_setprio(1); _Pragma("unroll") for (int m = 0; m < 4; ++m) _Pragma("unroll") for (int n = 0; n < 2; ++n) _Pragma("unroll") for (int k = 0; k < 2; ++k) \
        acc[ai][bj][m][n] = __builtin_amdgcn_mfma_f32_16x16x32_bf16(Bt[n][k], At[m][k], acc[ai][bj][m][n], 0, 0, 0); __builtin_amdgcn_s_setprio(0); } while (0)
#define PG8_WAIT_V(n) asm volatile("s_waitcnt vmcnt(" #n ")" ::: "memory")
#define PG8_WAIT_L(n) asm volatile("s_waitcnt lgkmcnt(" #n ")" ::: "memory")
#define PG8_BAR __builtin_amdgcn_s_barrier()
#define PG8_SCHED __builtin_amdgcn_sched_barrier(0)
    Unit cur, nxt; int ui = 0;
    if (!S.next(0, cur)) return;
    f32x4 acc[2][2][4][2];
#pragma unroll
    for (int a = 0; a < 2; ++a)
#pragma unroll
        for (int b = 0; b < 2; ++b)
#pragma unroll
            for (int m = 0; m < 4; ++m)
#pragma unroll
                for (int n = 0; n < 2; ++n) acc[a][b][m][n] = (f32x4){0.f, 0.f, 0.f, 0.f};
    bf16x8 At[4][2], B0[2][2], B1[2][2];
    const char* cA = (const char*)(cur.z ? g.A1 : g.A) + (size_t)cur.pm * tstep; const char* cB = (const char*)(cur.z ? g.Bt1 : g.Bt) + (size_t)cur.pn * tstep;
    S.a_ready(cur);
    if constexpr (SP2) {
        PG8_STAGE(PG8_SB(0, 0), cB, voffB); PG8_STAGE(PG8_SB(0, 1), cB + hstep, voffB); PG8_STAGE(PG8_SA(0, 0), cA, voffA); PG8_STAGE(PG8_SA(0, 1), cA + hstep, voffA);
        if (wr == 1) PG8_BAR;
        PG8_WAIT_V(2); PG8_BAR;
        PG8_STAGE(PG8_SB(1, 0), cB + kstep, voffB); PG8_STAGE(PG8_SA(1, 0), cA + kstep, voffA); PG8_STAGE(PG8_SB(1, 1), cB + hstep + kstep, voffB);
        PG8_WAIT_V(6); PG8_BAR;
    } else {
        PG8_STAGE(PG8_SB(0, 0), cB, voffB); PG8_STAGE(PG8_SA(0, 0), cA, voffA); PG8_STAGE(PG8_SB(0, 1), cB + hstep, voffB); PG8_STAGE(PG8_SA(0, 1), cA + hstep, voffA);
        if (wr == 1) PG8_BAR;
        PG8_WAIT_V(4); PG8_BAR;
        PG8_STAGE(PG8_SB(1, 0), cB + kstep, voffB); PG8_STAGE(PG8_SA(1, 0), cA + kstep, voffA); PG8_STAGE(PG8_SB(1, 1), cB + hstep + kstep, voffB);
        PG8_WAIT_V(6); PG8_BAR;
    }
    for (;;) {
        const bool has_next = S.next(ui + 1, nxt);
        const char* nA = has_next ? (const char*)(nxt.z ? g.A1 : g.A) + (size_t)nxt.pm * tstep : cA; const char* nB = has_next ? (const char*)(nxt.z ? g.Bt1 : g.Bt) + (size_t)nxt.pn * tstep : cB;
        for (int t = 0; t < nt; t += 2) {
            const bool last = (t == nt - 2);
            const char* a1 = cA + (size_t)(t + 1) * kstep;
            const char* a2 = last ? nA : cA + (size_t)(t + 2) * kstep; const char* b2 = last ? nB : cB + (size_t)(t + 2) * kstep;
            const char* a3 = a2 + kstep; const char* b3 = b2 + kstep;
            if (last && has_next) S.a_ready(nxt);
            if constexpr (SP2) {
            PG8_LDB(B0, 0, 0); PG8_LDB(B1, 0, 1); PG8_SCHED; PG8_LDA(At, 0, 0); PG8_STAGE(PG8_SA(1, 1), a1 + hstep, voffA);
            PG8_WAIT_V(8); PG8_WAIT_L(0); PG8_BAR; PG8_MMA(0, 0, At, B0); PG8_MMA(0, 1, At, B1); PG8_BAR; PG8_SCHED;
            PG8_LDA(At, 0, 1); PG8_STAGE(PG8_SB(0, 0), b2, voffB); PG8_STAGE(PG8_SB(0, 1), b2 + hstep, voffB); PG8_STAGE(PG8_SA(0, 0), a2, voffA);
            PG8_WAIT_V(8); PG8_WAIT_L(0); PG8_BAR; PG8_MMA(1, 0, At, B0); PG8_MMA(1, 1, At, B1); PG8_BAR; PG8_SCHED;
            PG8_LDB(B0, 1, 0); PG8_LDB(B1, 1, 1); PG8_SCHED; PG8_LDA(At, 1, 0); PG8_STAGE(PG8_SA(0, 1), a2 + hstep, voffA);
            PG8_WAIT_V(8); PG8_WAIT_L(0); PG8_BAR; PG8_MMA(0, 0, At, B0); PG8_MMA(0, 1, At, B1); PG8_BAR; PG8_SCHED;
            PG8_LDA(At, 1, 1); PG8_STAGE(PG8_SB(1, 0), b3, voffB); PG8_STAGE(PG8_SB(1, 1), b3 + hstep, voffB); PG8_STAGE(PG8_SA(1, 0), a3, voffA);
            PG8_WAIT_V(8); PG8_WAIT_L(0); PG8_BAR; PG8_MMA(1, 0, At, B0); PG8_MMA(1, 1, At, B1); PG8_BAR; PG8_SCHED;
            } else {
            PG8_LDB(B0, 0, 0); PG8_SCHED; PG8_LDA(At, 0, 0); PG8_STAGE(PG8_SA(1, 1), a1 + hstep, voffA);
            PG8_WAIT_L(8); PG8_BAR; PG8_WAIT_L(0); PG8_MMA(0, 0, At, B0); PG8_BAR; PG8_SCHED;
            PG8_LDB(B1, 0, 1); PG8_STAGE(PG8_SB(0, 0), b2, voffB);
            PG8_BAR; PG8_WAIT_L(0); PG8_MMA(0, 1, At, B1); PG8_BAR;
            PG8_LDA(At, 0, 1); PG8_STAGE(PG8_SA(0, 0), a2, voffA);
            PG8_BAR; PG8_WAIT_L(0); PG8_MMA(1, 0, At, B0); PG8_BAR; PG8_SCHED;
            PG8_STAGE(PG8_SB(0, 1), b2 + hstep, voffB);
            PG8_WAIT_V(6); PG8_BAR; PG8_MMA(1, 1, At, B1); PG8_BAR;
            PG8_LDB(B0, 1, 0); PG8_SCHED; PG8_LDA(At, 1, 0); PG8_STAGE(PG8_SA(0, 1), a2 + hstep, voffA);
            PG8_WAIT_L(8); PG8_BAR; PG8_WAIT_L(0); PG8_MMA(0, 0, At, B0); PG8_BAR; PG8_SCHED;
            PG8_LDB(B1, 1, 1); PG8_STAGE(PG8_SB(1, 0), b3, voffB);
            PG8_BAR; PG8_WAIT_L(0); PG8_MMA(0, 1, At, B1); PG8_BAR;
            PG8_LDA(At, 1, 1); PG8_STAGE(PG8_SA(1, 0), a3, voffA);
            PG8_BAR; PG8_WAIT_L(0); PG8_MMA(1, 0, At, B0); PG8_BAR; PG8_SCHED;
            PG8_STAGE(PG8_SB(1, 1), b3 + hstep, voffB);
            PG8_WAIT_V(6); PG8_BAR; PG8_MMA(1, 1, At, B1); PG8_BAR;
            }
        }
        if constexpr (ALIGN_EPI) { if (wr == 0) PG8_BAR; }
#ifndef PROBE_EPI
#define PROBE_EPI 0
#endif
        bool keep_acc = false; if constexpr (!Epi::AFTER_DRAIN) { keep_acc = E(acc, cur, wr, wc, fr, fq); if constexpr (Epi::IDEMPOTENT && PROBE_EPI) { asm volatile("" ::: "memory"); keep_acc = E(acc, cur, wr, wc, fr, fq); } S.done(cur); }
        if (!has_next) break;
        if (!keep_acc) {
#pragma unroll
        for (int a = 0; a < 2; ++a)
#pragma unroll
            for (int b = 0; b < 2; ++b)
#pragma unroll
                for (int m = 0; m < 4; ++m)
#pragma unroll
                    for (int n = 0; n < 2; ++n) acc[a][b][m][n] = (f32x4){0.f, 0.f, 0.f, 0.f};
        }
        cur = nxt; cA = nA; cB = nB; ++ui;
        if constexpr (ALIGN_EPI) { if (wr == 1) PG8_BAR; }
    }
    PG8_WAIT_V(0);
    if constexpr (!ALIGN_EPI) { if (wr == 0) PG8_BAR; }
    PG8_BAR;
    if constexpr (Epi::AFTER_DRAIN) { E.fused(acc, cur, wr, wc, fr, fq, lds, wid, lane); S.done(cur); }
#undef PG8_SA
#undef PG8_SB
#undef PG8_STAGE
#undef PG8_LDA
#undef PG8_LDB
#undef PG8_MMA
#undef PG8_WAIT_V
#undef PG8_WAIT_L
#undef PG8_BAR
#undef PG8_SCHED
}
}

#define LAS __attribute__((address_space(3)))
typedef unsigned short bf16;
typedef float f32x4 __attribute__((ext_vector_type(4)));
typedef unsigned v4u __attribute__((ext_vector_type(4)));
constexpr int NWAVES = 8, NTHR = 512;
constexpr int MTOK = 32768, DM = 1024, SEQ = 2048, NBATCH = 16, NIN = 8192, DFF = 4096, HYW = 512, HALF_TOK = 16384;
constexpr size_t MiB = (size_t)1 << 20;
constexpr size_t WS_SSQA = 0, WS_SSQB = 2 * MiB, WS_ROPE = 4 * MiB, WS_RSTD = 4 * MiB + 512 * 1024, WS_BAR = 4 * MiB + 768 * 1024, WS_LSE = 5 * MiB, WS_GF = 8 * MiB, WS_W = 16 * MiB, WS_XB = 52 * MiB,
                 WS_HY = 116 * MiB, WS_UT = 212 * MiB, WS_GATES = 116 * MiB, WS_Q = 244 * MiB, WS_KV = 340 * MiB, WS_YHY = 436 * MiB, WS_YATT = 404 * MiB, WS_X0T = 468 * MiB,
                 WS_MERGED = 340 * MiB, WS_H = 116 * MiB, WS_END = 500 * MiB;
constexpr size_t W_IN = 0, W_PHY = 16 * MiB, W_PATT = 17 * MiB, W_O = 18 * MiB, W_FF1 = 20 * MiB, W_FF2 = 28 * MiB;
constexpr int LDS_RTAB = 131072;
constexpr int LDS_ST_OFF = 135168;
constexpr int LDS_BYTES = 139264;

struct Args {
    const float* in[19]; float* out; unsigned char* ws; int pad0, pad1;
};

__device__ __forceinline__ unsigned f2bf(float f) { unsigned u = __float_as_uint(f); return (u + 0x7fffu + ((u >> 16) & 1u)) >> 16; }
__device__ __forceinline__ unsigned pk2(float lo, float hi) { return f2bf(lo) | (f2bf(hi) << 16); }
__device__ __forceinline__ float bf2f(unsigned short b) { return __uint_as_float((unsigned)b << 16); }
__device__ __forceinline__ float wave_sum(float v) {
#pragma unroll
    for (int o = 1; o < 64; o <<= 1) v += __shfl_xor(v, o);
    return v;
}

__device__ __forceinline__ int win_src_col(int n) {
    const int t = n >> 8, j = n & 255;
    if (t < 6) return n;
    if (t >= 24) return 6144 + (n - 6144);
    int g, w, half;
    if (t < 12) { const int i = t - 6; g = i >> 1; w = 0; half = i & 1; }
    else { const int i = t - 12; g = i >> 2; w = 1 + ((i >> 1) & 1); half = i & 1; }
    int hh, d;
    if (w == 2) { hh = j >> 6; d = j & 63; }
    else { hh = (j & 127) >> 5; d = (j & 31) + ((j >> 7) << 5); }
    return 1536 + g * 1536 + w * 512 + (half * 4 + hh) * 64 + d;
}

__device__ __forceinline__ void transpose_item(const float* W, int K, int Nsrc, int s0, bf16* WT, int n0, int k0, const float* gain, LAS float* scr, int lane) {
    float tv[32];
#pragma unroll
    for (int i = 0; i < 32; ++i) { const int kk = 2 * i + (lane >> 5); tv[i] = W[(size_t)(k0 + kk) * Nsrc + s0 + (lane & 31)]; }
    const float gl = gain ? gain[k0 + lane] : 1.0f;
#pragma unroll
    for (int i = 0; i < 32; ++i) { const int kk = 2 * i + (lane >> 5); scr[kk * 33 + (lane & 31)] = tv[i] * __shfl(gl, kk); }
    asm volatile("s_waitcnt lgkmcnt(0)" ::: "memory");
    const int c = lane & 7;
#pragma unroll
    for (int j = 0; j < 4; ++j) { const int n = (lane >> 3) + 8 * j; const LAS float* s = scr + (8 * c) * 33 + n;
        v4u o; o.x = pk2(s[0 * 33], s[1 * 33]); o.y = pk2(s[2 * 33], s[3 * 33]); o.z = pk2(s[4 * 33], s[5 * 33]); o.w = pk2(s[6 * 33], s[7 * 33]);
        *(v4u*)(WT + (size_t)(n0 + n) * K + k0 + 8 * c) = o; }
    asm volatile("s_waitcnt lgkmcnt(0)" ::: "memory");
}

__device__ __forceinline__ void phase_prep_weights(const Args& a, int L, LAS unsigned char* lds, int tid, int lane, int wave, int G) {
    unsigned char* ws = a.ws;
    {
        const float* w1 = a.in[5] + (size_t)L * 33 * 64; const float* b1 = a.in[6] + L * 64;
        const float* wi = a.in[7] + (size_t)L * 2 * 64 * 64; const float* bi = a.in[8] + L * 2 * 64;
        const float* wout = a.in[9] + (size_t)L * 64 * 1024; const float* fr = a.in[10] + L * 64; const float* skip = a.in[11] + L * 512;
        bf16* Rg = (bf16*)(ws + WS_GF);
        const float min_decay = logf(1e-2f) / 1.5f, max_decay = logf(1e-2f) / 0.3f;
        LAS float* hb = (LAS float*)lds + wave * 64;
        LAS float* fbuf = (LAS float*)(lds + 4096);
        const float frl = fr[lane];
#ifndef PROBE_PWF
#define PROBE_PWF 0
#endif
#ifndef PROBE_PWT
#define PROBE_PWT 0
#endif
        _Pragma("unroll 1") for (int repf = 0; repf < 1 + PROBE_PWF; ++repf)
        for (int blk = blockIdx.x; blk < 256; blk += G) {
            int n = 8 * blk + wave + 1; if (n == 2048) n = 0;
            const float t = (float)n / 2047.0f;
            {
                float v = 0.f;
                if (lane == 0) v = t;
                else if (lane < 33) { const int k = (lane - 1) & 15; const float band = 1e-4f + (float)k * ((15.0f - 1e-4f) / 15.0f); const float ang = ((float)(2.0 * 3.14159265358979323846 / 2048.0) * (float)n) * band;
                       v = (lane <= 16) ? cosf(ang) : -sinf(ang); }
                hb[lane] = v;
            }
            float s = b1[lane];
#pragma unroll
            for (int e = 0; e < 33; ++e) s += hb[e] * w1[e * 64 + lane];
            float hcur = sinf(frl * s);
#pragma unroll 1
            for (int layer = 0; layer < 2; ++layer) {
                hb[lane] = hcur;
                float s2 = bi[layer * 64 + lane];
#pragma unroll
                for (int e = 0; e < 64; ++e) s2 += hb[e] * wi[layer * 4096 + e * 64 + lane];
                hcur = sinf(frl * s2);
            }
            LAS float* hT = (LAS float*)(lds + 2048);
            hT[lane * 8 + wave] = hcur;
            __syncthreads();
            float o[8][2];
#pragma unroll
            for (int p = 0; p < 8; ++p) { o[p][0] = 0.f; o[p][1] = 0.f; }
#pragma unroll 8
            for (int e = 0; e < 64; ++e) {
                const f32x4 ha = *(const LAS f32x4*)(hT + e * 8), hc = *(const LAS f32x4*)(hT + e * 8 + 4);
                const float w0 = wout[e * 1024 + 128 * wave + lane], w1v = wout[e * 1024 + 128 * wave + 64 + lane];
#pragma unroll
                for (int p = 0; p < 4; ++p) { o[p][0] += ha[p] * w0; o[p][1] += ha[p] * w1v; o[4 + p][0] += hc[p] * w0; o[4 + p][1] += hc[p] * w1v; }
            }
#pragma unroll
            for (int j = 0; j < 2; ++j) {
                const int col = 128 * wave + 64 * j + lane, c = col & 511;
                const float delta = fabsf(min_decay + (float)c * ((max_decay - min_decay) / 511.0f));
#pragma unroll
                for (int p = 0; p < 8; ++p) { int np = 8 * blk + p + 1; if (np == 2048) np = 0; const float tp = (float)np / 2047.0f; fbuf[p * 1024 + col] = o[p][j] * expf(-tp * delta); }
            }
            __syncthreads();
#pragma unroll
            for (int pp = 0; pp < 2; ++pp) {
                const int p = tid + 512 * pp, c = p & 511, dir = p >> 9;
                bf16* r0 = Rg + ((size_t)c * 2 + 0) * 4096; bf16* r1 = Rg + ((size_t)c * 2 + 1) * 4096;
#pragma unroll
                for (int wv = 0; wv < 8; ++wv) {
                    int nn = 8 * blk + wv + 1; float val = fbuf[wv * 1024 + dir * 512 + c]; int x;
                    if (nn == 2048) { if (dir != 0) continue; val += skip[c]; x = 2048; }
                    else x = dir ? 2048 + nn : 2048 - nn;
                    const bf16 hv = (bf16)f2bf(val); r0[x] = hv; r1[x - 1] = hv;
                }
            }
            __syncthreads();
        }
    }
    {
        LAS float* scr = (LAS float*)(lds + 40960 + wave * 8704);
        const int gw = blockIdx.x * NWAVES + wave, NGW = G * NWAVES;
        bf16* Wb = (bf16*)(ws + WS_W);
        const float* w_in = a.in[2] + (size_t)L * DM * NIN; const float* p_hy = a.in[12] + (size_t)L * 512 * DM; const float* p_att = a.in[13] + (size_t)L * 512 * DM;
        const float* w_o = a.in[14] + (size_t)L * DM * DM; const float* w1 = a.in[16] + (size_t)L * DM * DFF; const float* w2 = a.in[17] + (size_t)L * DFF * DM;
        const float* g_mix = a.in[1] + L * DM; const float* g_ffn = a.in[15] + L * DM;
        constexpr int I_IN = 16 * 256, I_P = 8 * 32, I_O = 16 * 32, I_1 = 16 * 128, I_2 = 64 * 32;
        constexpr int NITEMS = I_IN + 2 * I_P + I_O + I_1 + I_2;
        _Pragma("unroll 1") for (int rept = 0; rept < 1 + PROBE_PWT; ++rept)
        for (int it = gw; it < NITEMS; it += NGW) {
            int r = it;
            if (r < I_IN) { const int kb = r / 256, nb = r % 256; transpose_item(w_in, DM, NIN, win_src_col(nb * 32), Wb + W_IN / 2, nb * 32, kb * 64, g_mix, scr, lane); continue; } r -= I_IN;
            if (r < I_P) { const int kb = r / 32, nb = r % 32; transpose_item(p_hy, 512, DM, nb * 32, Wb + W_PHY / 2, nb * 32, kb * 64, nullptr, scr, lane); continue; } r -= I_P;
            if (r < I_P) { const int kb = r / 32, nb = r % 32; transpose_item(p_att, 512, DM, nb * 32, Wb + W_PATT / 2, nb * 32, kb * 64, nullptr, scr, lane); continue; } r -= I_P;
            if (r < I_O) { const int kb = r / 32, nb = r % 32; transpose_item(w_o, DM, DM, nb * 32, Wb + W_O / 2, nb * 32, kb * 64, nullptr, scr, lane); continue; } r -= I_O;
            if (r < I_1) { const int kb = r / 128, nb = r % 128; transpose_item(w1, DM, DFF, nb * 32, Wb + W_FF1 / 2, nb * 32, kb * 64, g_ffn, scr, lane); continue; } r -= I_1;
            { const int kb = r / 32, nb = r % 32; transpose_item(w2, DFF, DM, nb * 32, Wb + W_FF2 / 2, nb * 32, kb * 64, nullptr, scr, lane); }
        }
        if (L == 0) {
            const float* x = a.in[0]; bf16* xb = (bf16*)(ws + WS_XB); float* ssq = (float*)(ws + WS_SSQA);
            for (int m0 = gw; m0 < MTOK; m0 += 4 * NGW) {
                f32x4 v[4][4];
#pragma unroll
                for (int rr = 0; rr < 4; ++rr) { const f32x4* xr = (const f32x4*)(x + (size_t)(m0 + rr * NGW) * DM) + lane;
#pragma unroll
                    for (int j = 0; j < 4; ++j) v[rr][j] = xr[64 * j]; }
#pragma unroll
                for (int rr = 0; rr < 4; ++rr) { const int m = m0 + rr * NGW; float s = 0.f;
#pragma unroll
                    for (int j = 0; j < 4; ++j) s += (v[rr][j][0] * v[rr][j][0] + v[rr][j][1] * v[rr][j][1]) + (v[rr][j][2] * v[rr][j][2] + v[rr][j][3] * v[rr][j][3]);
                    s = wave_sum(s);
                    unsigned long long* o8 = (unsigned long long*)(xb + (size_t)m * DM) + lane;
#pragma unroll
                    for (int j = 0; j < 4; ++j) o8[64 * j] = (unsigned long long)pk2(v[rr][j][0], v[rr][j][1]) | ((unsigned long long)pk2(v[rr][j][2], v[rr][j][3]) << 32);
                    if (lane < 16) ssq[(size_t)m * 16 + lane] = (lane == 0) ? s : 0.f; }
            }
            float* rc = (float*)(ws + WS_ROPE); float* rsn = rc + 65536;
            for (int i = blockIdx.x * NTHR + tid; i < 65536; i += G * NTHR) {
                const int pos = i >> 5, f = i & 31;
                const float inv = powf(10000.0f, -(float)f / 32.0f);
                const float ang = (float)pos * inv;
                rc[i] = cosf(ang); rsn[i] = sinf(ang);
            }
        }
    }
}

__device__ __forceinline__ float bfe(const v4u& w, int e) { const unsigned d = (e >> 1) == 0 ? w.x : ((e >> 1) == 1 ? w.y : ((e >> 1) == 2 ? w.z : w.w)); return (e & 1) ? __uint_as_float(d & 0xffff0000u) : __uint_as_float(d << 16); }
__device__ __forceinline__ void phase_prep_u(const Args& a, int L, LAS unsigned char* lds, int tid, int G) {
    const bf16* hy = (const bf16*)(a.ws + WS_HY); bf16* ut = (bf16*)(a.ws + WS_UT); bf16* x0t = (bf16*)(a.ws + WS_X0T);
    const float* cw = a.in[3] + (size_t)L * 3 * 1536; const float* cb = a.in[4] + L * 1536;
    LAS unsigned short* tile = (LAS unsigned short*)lds;
    const int cc = blockIdx.x & 7, ml = tid >> 3, cg8 = tid & 7, c0 = cc * 64 + cg8 * 8;
    float wq[3][4][8];
#pragma unroll
    for (int ar = 0; ar < 3; ++ar)
#pragma unroll
        for (int e = 0; e < 8; ++e) { wq[ar][0][e] = cw[ar * 512 + c0 + e]; wq[ar][1][e] = cw[1536 + ar * 512 + c0 + e]; wq[ar][2][e] = cw[3072 + ar * 512 + c0 + e]; wq[ar][3][e] = cb[ar * 512 + c0 + e]; }
    v4u dn[3][3];
    const v4u zero = (v4u){0u, 0u, 0u, 0u};
#define PU_LOAD(it_) do { const int m_ = ((it_) & 31) * 64 + ml; const bf16* r_ = hy + (size_t)(((it_) >> 5) * SEQ + m_) * 1536 + c0; \
        _Pragma("unroll") for (int ar_ = 0; ar_ < 3; ++ar_) { dn[ar_][0] = (m_ > 0) ? *(const v4u*)(r_ - 1536 + ar_ * 512) : zero; dn[ar_][1] = *(const v4u*)(r_ + ar_ * 512); \
            dn[ar_][2] = (m_ < SEQ - 1) ? *(const v4u*)(r_ + 1536 + ar_ * 512) : zero; } } while (0)
    if ((int)(blockIdx.x >> 3) < 512) PU_LOAD((int)(blockIdx.x >> 3));
    for (int it = blockIdx.x >> 3; it < 512; it += (G >> 3)) {
        const int mc = it & 31, b = it >> 5;
        v4u d[3][3];
#pragma unroll
        for (int ar = 0; ar < 3; ++ar) { d[ar][0] = dn[ar][0]; d[ar][1] = dn[ar][1]; d[ar][2] = dn[ar][2]; }
        if (it + (G >> 3) < 512) PU_LOAD(it + (G >> 3));
#pragma unroll
        for (int e = 0; e < 8; ++e) {
            float cv[3];
#pragma unroll
            for (int ar = 0; ar < 3; ++ar) cv[ar] = wq[ar][3][e] + wq[ar][0][e] * bfe(d[ar][0], e) + wq[ar][1][e] * bfe(d[ar][1], e) + wq[ar][2][e] * bfe(d[ar][2], e);
            tile[(cg8 * 8 + e) * 72 + ml] = (unsigned short)f2bf(cv[1] * cv[2]);
            tile[4608 + (cg8 * 8 + e) * 72 + ml] = (unsigned short)f2bf(cv[0]);
        }
        __syncthreads();
        {
            const int c2 = tid >> 3, ch = tid & 7;
            const LAS unsigned* s = (const LAS unsigned*)(tile + c2 * 72 + ch * 8);
            v4u o; o.x = s[0]; o.y = s[1]; o.z = s[2]; o.w = s[3];
            *(v4u*)(ut + ((size_t)(cc * 64 + c2) * NBATCH + b) * SEQ + mc * 64 + ch * 8) = o;
            const LAS unsigned* s2 = s + 2304;
            v4u o2; o2.x = s2[0]; o2.y = s2[1]; o2.z = s2[2]; o2.w = s2[3];
            *(v4u*)(x0t + ((size_t)(cc * 64 + c2) * NBATCH + b) * SEQ + mc * 64 + ch * 8) = o2;
        }
        __syncthreads();
    }
}

__device__ __forceinline__ void phase_hyena_naive(const Args& a, int L, LAS unsigned char* lds, int tid, int G) {
    const bf16* hy = (const bf16*)(a.ws + WS_HY); const bf16* ut = (const bf16*)(a.ws + WS_UT); const float* Gf = (const float*)(a.ws + WS_GF);
    bf16* yhy = (bf16*)(a.ws + WS_YHY);
    const float* cw = a.in[3] + (size_t)L * 3 * 1536; const float* cb = a.in[4] + L * 1536;
    LAS float* Gs = (LAS float*)lds;
    LAS float* Us = Gs + 4096;
    for (int item = blockIdx.x; item < 2048; item += G) {
        const int c = item >> 2, bq = item & 3;
        for (int i = tid; i < 4096; i += NTHR) Gs[i] = (i == 0) ? 0.f : Gf[(size_t)c * 4096 + i];
        for (int i = tid; i < 8192; i += NTHR) { const int bl = i >> 11, m = i & 2047; Us[i] = bf2f(ut[((size_t)c * NBATCH + bq * 4 + bl) * SEQ + m]); }
        __syncthreads();
        const int bl = tid >> 7, tn = tid & 127;
        float acc[16];
#pragma unroll
        for (int i = 0; i < 16; ++i) acc[i] = 0.f;
        const LAS float* up = Us + bl * 2048;
        for (int m = 0; m < SEQ; ++m) {
            const float u = up[m];
            const LAS float* gp = Gs + (tn - m + 2048);
#pragma unroll
            for (int i = 0; i < 16; ++i) acc[i] += gp[128 * i] * u;
        }
        const int b = bq * 4 + bl;
        const float w0 = cw[c], w1 = cw[1536 + c], w2 = cw[3072 + c], b0 = cb[c];
#pragma unroll
        for (int i = 0; i < 16; ++i) {
            const int n = tn + 128 * i;
            const bf16* r = hy + (size_t)(b * SEQ + n) * 1536 + c;
            const float xm = (n > 0) ? bf2f(r[-1536]) : 0.f, xc = bf2f(r[0]), xp = (n < SEQ - 1) ? bf2f(r[1536]) : 0.f;
            const float x0 = b0 + w0 * xm + w1 * xc + w2 * xp;
            yhy[(size_t)(b * SEQ + n) * 512 + c] = (bf16)f2bf(x0 * acc[i]);
        }
        __syncthreads();
    }
}

__device__ __forceinline__ void phase_attn_naive(const Args& a, int half, int tid, int G) {
    bf16* Q = (bf16*)(a.ws + WS_Q); const bf16* KV = (const bf16*)(a.ws + WS_KV); float* lse = (float*)(a.ws + WS_LSE);
    for (int idx = blockIdx.x * NTHR + tid; idx < 3 * 8 * HALF_TOK; idx += G * NTHR) {
        const int g = idx / (8 * HALF_TOK), t = idx % (8 * HALF_TOK), h = t / HALF_TOK, tokl = t % HALF_TOK;
        const int dil = (g == 0) ? 1 : (g == 1 ? 4 : 16);
        const int token = half * HALF_TOK + tokl, s = token & 2047;
        bf16* qp = Q + (size_t)token * 1536 + g * 512 + h * 64;
        float q[64], o[64];
#pragma unroll
        for (int i = 0; i < 8; ++i) { const v4u w = *(const v4u*)(qp + 8 * i);
            q[8 * i + 0] = __uint_as_float(w.x << 16); q[8 * i + 1] = __uint_as_float(w.x & 0xffff0000u); q[8 * i + 2] = __uint_as_float(w.y << 16); q[8 * i + 3] = __uint_as_float(w.y & 0xffff0000u);
            q[8 * i + 4] = __uint_as_float(w.z << 16); q[8 * i + 5] = __uint_as_float(w.z & 0xffff0000u); q[8 * i + 6] = __uint_as_float(w.w << 16); q[8 * i + 7] = __uint_as_float(w.w & 0xffff0000u); }
#pragma unroll
        for (int i = 0; i < 64; ++i) o[i] = 0.f;
        float mx = -1e30f, l = 0.f;
        for (int j = -64; j <= 64; ++j) {
            const int sp = s + j * dil;
            if (sp < 0 || sp >= SEQ) continue;
            const bf16* kp = KV + (size_t)(tokl + j * dil) * 3072 + g * 1024 + h * 64;
            float sc = 0.f;
#pragma unroll
            for (int i = 0; i < 8; ++i) { const v4u w = *(const v4u*)(kp + 8 * i);
                sc += q[8 * i + 0] * __uint_as_float(w.x << 16) + q[8 * i + 1] * __uint_as_float(w.x & 0xffff0000u) + q[8 * i + 2] * __uint_as_float(w.y << 16) + q[8 * i + 3] * __uint_as_float(w.y & 0xffff0000u)
                    + q[8 * i + 4] * __uint_as_float(w.z << 16) + q[8 * i + 5] * __uint_as_float(w.z & 0xffff0000u) + q[8 * i + 6] * __uint_as_float(w.w << 16) + q[8 * i + 7] * __uint_as_float(w.w & 0xffff0000u); }
            const float mn = fmaxf(mx, sc), corr = exp2f(mx - mn), p = exp2f(sc - mn);
            l = l * corr + p; mx = mn;
            const bf16* vp = kp + 512;
#pragma unroll
            for (int i = 0; i < 8; ++i) { const v4u w = *(const v4u*)(vp + 8 * i);
                o[8 * i + 0] = o[8 * i + 0] * corr + p * __uint_as_float(w.x << 16); o[8 * i + 1] = o[8 * i + 1] * corr + p * __uint_as_float(w.x & 0xffff0000u);
                o[8 * i + 2] = o[8 * i + 2] * corr + p * __uint_as_float(w.y << 16); o[8 * i + 3] = o[8 * i + 3] * corr + p * __uint_as_float(w.y & 0xffff0000u);
                o[8 * i + 4] = o[8 * i + 4] * corr + p * __uint_as_float(w.z << 16); o[8 * i + 5] = o[8 * i + 5] * corr + p * __uint_as_float(w.z & 0xffff0000u);
                o[8 * i + 6] = o[8 * i + 6] * corr + p * __uint_as_float(w.w << 16); o[8 * i + 7] = o[8 * i + 7] * corr + p * __uint_as_float(w.w & 0xffff0000u); }
        }
        const float inv = 1.0f / l;
#pragma unroll
        for (int i = 0; i < 8; ++i) { v4u w; w.x = pk2(o[8 * i] * inv, o[8 * i + 1] * inv); w.y = pk2(o[8 * i + 2] * inv, o[8 * i + 3] * inv); w.z = pk2(o[8 * i + 4] * inv, o[8 * i + 5] * inv); w.w = pk2(o[8 * i + 6] * inv, o[8 * i + 7] * inv);
            *(v4u*)(qp + 8 * i) = w; }
        lse[((size_t)g * MTOK + token) * 8 + h] = mx + log2f(l);
    }
}

__device__ __forceinline__ void phase_combine(const Args& a, int tid, int G) {
    const bf16* Q = (const bf16*)(a.ws + WS_Q); const float* lse = (const float*)(a.ws + WS_LSE); bf16* ya = (bf16*)(a.ws + WS_YATT);
    const int stride = G * NTHR;
    for (int idx0 = blockIdx.x * NTHR + tid; idx0 < MTOK * 64; idx0 += 4 * stride) {
        float l0[4], l1[4], l2[4]; v4u a0[4], a1[4], a2[4];
#pragma unroll
        for (int j = 0; j < 4; ++j) { int idx = idx0 + j * stride; if (idx >= MTOK * 64) idx = idx0; const int token = idx >> 6, ch = idx & 63, h = ch >> 3;
            l0[j] = lse[((size_t)0 * MTOK + token) * 8 + h]; l1[j] = lse[((size_t)1 * MTOK + token) * 8 + h]; l2[j] = lse[((size_t)2 * MTOK + token) * 8 + h];
            const bf16* p = Q + (size_t)token * 1536 + ch * 8;
            a0[j] = *(const v4u*)p; a1[j] = *(const v4u*)(p + 512); a2[j] = *(const v4u*)(p + 1024); }
#pragma unroll
        for (int j = 0; j < 4; ++j) { const int idx = idx0 + j * stride; if (idx >= MTOK * 64) continue; const int token = idx >> 6, ch = idx & 63;
            const float mx = fmaxf(l0[j], fmaxf(l1[j], l2[j]));
            float w0 = exp2f(l0[j] - mx), w1 = exp2f(l1[j] - mx), w2 = exp2f(l2[j] - mx);
            const float inv = 1.0f / (w0 + w1 + w2); w0 *= inv; w1 *= inv; w2 *= inv;
            v4u o;
#define CMB(f) pk2(w0 * __uint_as_float(a0[j].f << 16) + w1 * __uint_as_float(a1[j].f << 16) + w2 * __uint_as_float(a2[j].f << 16), \
                   w0 * __uint_as_float(a0[j].f & 0xffff0000u) + w1 * __uint_as_float(a1[j].f & 0xffff0000u) + w2 * __uint_as_float(a2[j].f & 0xffff0000u))
            o.x = CMB(x); o.y = CMB(y); o.z = CMB(z); o.w = CMB(w);
#undef CMB
            *(v4u*)(ya + (size_t)token * 512 + ch * 8) = o; }
    }
}

__device__ __forceinline__ void phase_final_norm(const Args& a, int lane, int wave, int G) {
    float* out = a.out; const float* gain = a.in[18]; const bf16* xb = (const bf16*)(a.ws + WS_XB);
    const int gw = blockIdx.x * NWAVES + wave, NGW = G * NWAVES;
    typedef unsigned u32x2v __attribute__((ext_vector_type(2)));
    f32x4 gn[4];
#pragma unroll
    for (int j = 0; j < 4; ++j) gn[j] = *((const f32x4*)gain + lane + 64 * j);
    for (int m0 = gw; m0 < MTOK; m0 += 4 * NGW) {
        u32x2v w[4][4];
#pragma unroll
        for (int rr = 0; rr < 4; ++rr) { const int m = (m0 + rr * NGW < MTOK) ? m0 + rr * NGW : m0; const u32x2v* xr = (const u32x2v*)(xb + (size_t)m * DM) + lane;
#pragma unroll
            for (int j = 0; j < 4; ++j) w[rr][j] = xr[64 * j]; }
#pragma unroll
        for (int rr = 0; rr < 4; ++rr) { const int m = m0 + rr * NGW; if (m >= MTOK) continue;
            f32x4 v[4]; float s = 0.f;
#pragma unroll
            for (int j = 0; j < 4; ++j) { v[j] = (f32x4){__uint_as_float(w[rr][j].x << 16), __uint_as_float(w[rr][j].x & 0xffff0000u), __uint_as_float(w[rr][j].y << 16), __uint_as_float(w[rr][j].y & 0xffff0000u)};
                s += (v[j][0] * v[j][0] + v[j][1] * v[j][1]) + (v[j][2] * v[j][2] + v[j][3] * v[j][3]); }
            s = wave_sum(s);
            const float rs = 1.0f / sqrtf(s * (1.0f / 1024.0f) + 1e-6f);
            f32x4* orow = (f32x4*)(out + (size_t)m * DM) + lane;
#pragma unroll
            for (int j = 0; j < 4; ++j) orow[64 * j] = v[j] * rs * gn[j]; }
    }
}

typedef short bf16x8 __attribute__((ext_vector_type(8)));
typedef short s16x4 __attribute__((ext_vector_type(4)));
constexpr int HY_UROW = 4112, HY_ROFF = 16 * HY_UROW, HY_RSTRIDE = 8192 + 64;
__device__ __forceinline__ bf16x8 ld_frag4(const LAS unsigned char* p) {
    const LAS unsigned* q = (const LAS unsigned*)p; v4u d; d.x = q[0]; d.y = q[1]; d.z = q[2]; d.w = q[3]; return __builtin_bit_cast(bf16x8, d);
}
__device__ __forceinline__ void phase_hyena_mfma(const Args& a, LAS unsigned char* lds, int tid, int G, bool dummy = false) {
    const bf16* ut = (const bf16*)(a.ws + WS_UT); const bf16* Rg = (const bf16*)(a.ws + WS_GF); bf16* x0t = (bf16*)(a.ws + WS_X0T);
    const int lane = tid & 63, w = __builtin_amdgcn_readfirstlane(tid >> 6), i16 = lane & 15, kq = lane >> 4;
    const int base = (w >> 1) * 512 + (w & 1) * 16, cp = i16 & 1;
    const int lane_const = (2048 - base - i16 + 8 * kq - cp) >> 1;
    const LAS unsigned char* pA15 = lds + HY_ROFF + cp * HY_RSTRIDE + 4 * (lane_const - 240);
    const LAS unsigned char* pB = lds + i16 * HY_UROW + kq * 16;
    v4u pre[10];
#define HY_ISSUE(chn) do { _Pragma("unroll") for (int k_ = 0; k_ < 8; ++k_) { const int i_ = tid + NTHR * k_, b_ = i_ >> 8, ck_ = i_ & 255; pre[k_] = *(const v4u*)(ut + ((size_t)(chn) * NBATCH + b_) * SEQ + ck_ * 8); } \
        _Pragma("unroll") for (int k_ = 0; k_ < 2; ++k_) { const int i_ = tid + NTHR * k_, c2_ = i_ >> 9, ck_ = i_ & 511; pre[8 + k_] = *(const v4u*)(Rg + ((size_t)(chn) * 2 + c2_) * 4096 + ck_ * 8); } } while (0)
    for (int ch = blockIdx.x; ch < HYW; ch += G) {
        HY_ISSUE(ch);
#pragma unroll
        for (int k = 0; k < 8; ++k) { const int i = tid + NTHR * k, b = i >> 8, ck = i & 255; *(LAS v4u*)(lds + b * HY_UROW + ck * 16) = pre[k]; }
#pragma unroll
        for (int k = 0; k < 2; ++k) { const int i = tid + NTHR * k, c2 = i >> 9, ck = i & 511; *(LAS v4u*)(lds + HY_ROFF + c2 * HY_RSTRIDE + ck * 16) = pre[8 + k]; }
        __syncthreads();
        f32x4 acc[16]; bf16x8 W[16];
#pragma unroll
        for (int i = 0; i < 16; ++i) acc[i] = (f32x4){0.f, 0.f, 0.f, 0.f};
#pragma unroll
        for (int j = 1; j < 16; ++j) W[j] = ld_frag4(pA15 + 64 * (15 - j));
        W[0] = W[1];
#pragma unroll 1
        for (int tt = 0; tt < 4; ++tt) {
            const LAS unsigned char* pa = pA15 + 64 * 15 + 1024 * tt; const LAS unsigned char* pb = pB + 1024 * tt;
#pragma unroll
            for (int s = 0; s < 16; ++s) {
                W[(16 - s) & 15] = ld_frag4(pa + 64 * s);
                const bf16x8 Bf = *(const LAS bf16x8*)(pb + 64 * s);
#pragma unroll
                for (int i = 0; i < 16; ++i) acc[i] = __builtin_amdgcn_mfma_f32_16x16x32_bf16(W[(i - s) & 15], Bf, acc[i], 0, 0, 0);
            }
        }
        bf16* xo = x0t + ((size_t)ch * NBATCH + i16) * SEQ + base + 4 * kq;
        typedef unsigned u32x2v __attribute__((ext_vector_type(2)));
        u32x2v xall[16];
#pragma unroll
        for (int i = 0; i < 16; ++i) xall[i] = *(const u32x2v*)(xo + 32 * i);
#pragma unroll
        for (int i = 0; i < 16; ++i) {
            const u32x2v xv = xall[i];
            u32x2v o; o.x = pk2(__uint_as_float(xv.x << 16) * acc[i][0], __uint_as_float(xv.x & 0xffff0000u) * acc[i][1]);
            o.y = pk2(__uint_as_float(xv.y << 16) * acc[i][2], __uint_as_float(xv.y & 0xffff0000u) * acc[i][3]);
            if (!dummy) *(u32x2v*)(xo + 32 * i) = o; else *(u32x2v*)((bf16*)(a.ws + WS_YHY) + (size_t)tid * 64 + 4 * i) = o;
        }
        __syncthreads();
    }
}

__device__ __forceinline__ void phase_transpose_y(const Args& a, LAS unsigned char* lds, int tid, int G) {
    const bf16* yt = (const bf16*)(a.ws + WS_X0T); bf16* yhy = (bf16*)(a.ws + WS_YHY);
    LAS unsigned short* tile = (LAS unsigned short*)lds;
#define TY_LOAD(item_) (*(const v4u*)(yt + ((size_t)(((item_) & 7) * 64 + (tid >> 3)) * NBATCH + ((item_) >> 8)) * SEQ + (((item_) >> 3) & 31) * 64 + (tid & 7) * 8))
    v4u vnext = (v4u){0u, 0u, 0u, 0u};
    if ((int)blockIdx.x < 4096) vnext = TY_LOAD((int)blockIdx.x);
    for (int item = blockIdx.x; item < 4096; item += G) {
        const int cc = item & 7, mc = (item >> 3) & 31, b = item >> 8;
        { const int c2 = tid >> 3, ck = tid & 7;
          const v4u v = vnext;
          LAS unsigned* t4 = (LAS unsigned*)(tile + c2 * 72 + ck * 8); t4[0] = v.x; t4[1] = v.y; t4[2] = v.z; t4[3] = v.w; }
        __syncthreads();
        if (item + G < 4096) vnext = TY_LOAD(item + G);
        { const int nl = tid >> 3, cg8 = tid & 7; const LAS unsigned short* s = tile + (cg8 * 8) * 72 + nl;
          v4u o; o.x = s[0] | ((unsigned)s[72] << 16); o.y = s[144] | ((unsigned)s[216] << 16); o.z = s[288] | ((unsigned)s[360] << 16); o.w = s[432] | ((unsigned)s[504] << 16);
          *(v4u*)(yhy + (size_t)(b * SEQ + mc * 64 + nl) * 512 + cc * 64 + cg8 * 8) = o; }
        __syncthreads();
    }
}

constexpr int AT_ROWS = 272, AT_RS = 144, AT_VOFF = AT_ROWS * AT_RS;
__device__ __forceinline__ void phase_attn_mfma(const Args& a, int half, LAS unsigned char* lds, int tid, int G, bool dummy = false) {
    bf16* Q = (bf16*)(a.ws + WS_Q); const bf16* KV = (const bf16*)(a.ws + WS_KV); float* lse = (float*)(a.ws + WS_LSE);
    const int lane = tid & 63, w = __builtin_amdgcn_readfirstlane(tid >> 6), q16 = lane & 15, kq = lane >> 4;
    v4u pre[9]; bf16x8 Qn0, Qn1;
#define AT_DECODE(unit_) const int g = (unit_) >> 10, u = (unit_) & 1023, sub = u & 15, h = (u >> 4) & 7, bl = u >> 7; int dil, n, r, qb; \
        if (g == 0) { dil = 1; n = 2048; r = 0; qb = sub; } else if (g == 1) { dil = 4; n = 512; r = sub >> 2; qb = sub & 3; } else { dil = 16; n = 128; r = sub; qb = 0; } \
        const int q0 = qb * 128, kb0 = q0 - 64; (void)kb0; (void)q0;
#define AT_ISSUE(unit_) do { AT_DECODE(unit_) { const bf16* qn_ = Q + (size_t)(half * HALF_TOK + bl * SEQ + (q0 + 16 * w + q16) * dil + r) * 1536 + g * 512 + h * 64; Qn0 = *(const bf16x8*)(qn_ + 8 * kq); Qn1 = *(const bf16x8*)(qn_ + 32 + 8 * kq); } \
        _Pragma("unroll") for (int k_ = 0; k_ < 9; ++k_) { const int i_ = tid + NTHR * k_; \
            const int which_ = (i_ >= AT_ROWS * 8) ? 1 : 0, j_ = i_ - which_ * AT_ROWS * 8, rr_ = j_ >> 3, ck_ = j_ & 7, key_ = kb0 + rr_; \
            pre[k_] = (v4u){0u, 0u, 0u, 0u}; \
            if (i_ < 2 * AT_ROWS * 8 && key_ >= 0 && key_ < n) pre[k_] = *(const v4u*)(KV + (size_t)(bl * SEQ + key_ * dil + r) * 3072 + g * 1024 + which_ * 512 + h * 64 + ck_ * 8); } } while (0)
    const int vb = ((G & 7) == 0) ? (int)((blockIdx.x & 7) * (G >> 3) + (blockIdx.x >> 3)) : (int)blockIdx.x;
    if (vb < 3072) AT_ISSUE(vb);
    for (int unit = vb; unit < 3072; unit += G) {
#pragma unroll
        for (int k = 0; k < 9; ++k) { const int i = tid + NTHR * k; const int which = (i >= AT_ROWS * 8) ? 1 : 0, j = i - which * AT_ROWS * 8, rr = j >> 3, ck = j & 7;
            if (i < 2 * AT_ROWS * 8) *(LAS v4u*)(lds + which * AT_VOFF + rr * AT_RS + ck * 16) = pre[k]; }
        const bf16x8 Qf0 = Qn0, Qf1 = Qn1;
        __syncthreads();
        if (unit + G < 3072) AT_ISSUE(unit + G);
        AT_DECODE(unit)
        {
            const int i0 = q0 + 16 * w;
            const int token = half * HALF_TOK + bl * SEQ + (i0 + q16) * dil + r;
            bf16* qp = Q + (size_t)token * 1536 + g * 512 + h * 64;
            bf16* op = dummy ? (bf16*)(a.ws + WS_YHY) + (size_t)(tid & 511) * 64 : qp;
            f32x4 acc[4];
#pragma unroll
            for (int dt = 0; dt < 4; ++dt) acc[dt] = (f32x4){0.f, 0.f, 0.f, 0.f};
            const bool edge = (i0 < 64) || (i0 + 80 > n);
            const LAS unsigned char* kbase = lds + (16 * w + q16) * AT_RS + 16 * kq;
            const LAS unsigned char* vbase = lds + AT_VOFF + (16 * w + 4 * kq + (q16 >> 2)) * AT_RS + 8 * (q16 & 3);
            f32x4 s[9];
#pragma unroll
            for (int kt = 0; kt < 9; ++kt) {
                const LAS unsigned char* kp = kbase + kt * 16 * AT_RS;
                const bf16x8 K0 = *(const LAS bf16x8*)kp, K1 = *(const LAS bf16x8*)(kp + 64);
                f32x4 z = (f32x4){0.f, 0.f, 0.f, 0.f};
                z = __builtin_amdgcn_mfma_f32_16x16x32_bf16(K0, Qf0, z, 0, 0, 0);
                z = __builtin_amdgcn_mfma_f32_16x16x32_bf16(K1, Qf1, z, 0, 0, 0);
                if (kt == 0 || kt == 8 || edge) {
#pragma unroll
                    for (int e = 0; e < 4; ++e) {
                        const int rel = 16 * kt - 64 + 4 * kq + e - q16, j = i0 + q16 + rel;
                        const bool ok = (rel >= -64) && (rel <= 64) && (j >= 0) && (j < n);
                        z[e] = ok ? z[e] : -1e30f;
                    } }
                s[kt] = z;
            }
            float mrun = -1e30f;
#pragma unroll
            for (int kt = 0; kt < 9; ++kt) mrun = fmaxf(mrun, fmaxf(fmaxf(s[kt][0], s[kt][1]), fmaxf(s[kt][2], s[kt][3])));
            mrun = fmaxf(mrun, __shfl_xor(mrun, 16)); mrun = fmaxf(mrun, __shfl_xor(mrun, 32));
            float lrun = 0.f;
#pragma unroll
            for (int kt = 0; kt < 9; ++kt)
#pragma unroll
                for (int e = 0; e < 4; ++e) { s[kt][e] = __builtin_amdgcn_exp2f(s[kt][e] - mrun); lrun += s[kt][e]; }
#pragma unroll
            for (int st = 0; st < 5; ++st) {
                v4u pw; pw.x = pg8::cvt_pk_bf16(s[2 * st][0], s[2 * st][1]); pw.y = pg8::cvt_pk_bf16(s[2 * st][2], s[2 * st][3]);
                if (st < 4) { pw.z = pg8::cvt_pk_bf16(s[2 * st + 1][0], s[2 * st + 1][1]); pw.w = pg8::cvt_pk_bf16(s[2 * st + 1][2], s[2 * st + 1][3]); } else { pw.z = 0u; pw.w = 0u; }
                const bf16x8 Pf = __builtin_bit_cast(bf16x8, pw);
#pragma unroll
                for (int dt = 0; dt < 4; ++dt) {
                    const LAS unsigned char* vp = vbase + 32 * st * AT_RS + 32 * dt;
                    const s16x4 v0 = __builtin_amdgcn_ds_read_tr16_b64_v4i16((LAS s16x4*)vp);
                    const s16x4 v1 = __builtin_amdgcn_ds_read_tr16_b64_v4i16((LAS s16x4*)(vp + 16 * AT_RS));
                    const bf16x8 Vf = (bf16x8){v0[0], v0[1], v0[2], v0[3], v1[0], v1[1], v1[2], v1[3]};
                    acc[dt] = __builtin_amdgcn_mfma_f32_16x16x32_bf16(Vf, Pf, acc[dt], 0, 0, 0);
                }
            }
            lrun += __shfl_xor(lrun, 16); lrun += __shfl_xor(lrun, 32);
            const float inv = 1.0f / lrun;
            typedef unsigned u32x2v __attribute__((ext_vector_type(2)));
#pragma unroll
            for (int dt = 0; dt < 4; ++dt) {
                u32x2v o; o.x = pg8::cvt_pk_bf16(acc[dt][0] * inv, acc[dt][1] * inv); o.y = pg8::cvt_pk_bf16(acc[dt][2] * inv, acc[dt][3] * inv);
                *(u32x2v*)(op + 16 * dt + 4 * kq) = o;
            }
            if (kq == 0 && !dummy) lse[((size_t)g * MTOK + token) * 8 + h] = mrun + log2f(lrun);
        }
        __syncthreads();
    }
}

#define XB_TMO      128
#define XB_XCNT(j)  (256  + 64 * (j))
#define XB_XSUB(j)  (1280 + 64 * (j))
#define XB_XGEN(j)  (2304 + 64 * (j))
#define XB_TOP      3328
#define XB_TOPGEN   3392
#define XCD_BAR_WORDS 3456
#define XB_SPIN_CAP (1u << 18)

__device__ __forceinline__ unsigned xb_ld(unsigned* p)              { return __hip_atomic_load(p, __ATOMIC_RELAXED, __HIP_MEMORY_SCOPE_AGENT); }
__device__ __forceinline__ unsigned xb_add(unsigned* p, unsigned v) { return __hip_atomic_fetch_add(p, v, __ATOMIC_RELAXED, __HIP_MEMORY_SCOPE_AGENT); }
__device__ __forceinline__ unsigned xb_xcc_id() { return (unsigned)__builtin_amdgcn_s_getreg((3 << 11) | 20) & 0xFu; }
#define XB_SPIN(cond, bar) do { unsigned _sp = 0; while (cond) { __builtin_amdgcn_s_sleep(1); \
    if ((++_sp & 255u) == 0u) { if (xb_ld(&(bar)[XB_TMO])) break; if (_sp > XB_SPIN_CAP) { atomicAdd(&(bar)[XB_TMO], 1u); break; } } } } while (0)

struct XcdBarrier {
    unsigned* bar; unsigned x;
    volatile LAS unsigned* st;
};

__device__ __forceinline__ XcdBarrier xcd_barrier_post(unsigned* bar, volatile LAS unsigned* st, bool is_t0) {
    XcdBarrier b; b.bar = bar; b.x = xb_xcc_id(); b.st = st;
    if (is_t0) (void)xb_add(&bar[XB_XCNT(b.x)], 1u);
    return b;
}
__device__ __forceinline__ void xcd_barrier_complete(unsigned* bar, unsigned x, unsigned& nloc, unsigned& nx) {
    const unsigned G = gridDim.x * gridDim.y * gridDim.z;
    unsigned sum, cnt, mine, sp = 0u;
    for (;;) {
        sum = 0u; cnt = 0u; mine = 0u;
#pragma unroll
        for (unsigned j = 0; j < 16; ++j) { const unsigned c = xb_ld(&bar[XB_XCNT(j)]); sum += c; cnt += (c > 0u) ? 1u : 0u; mine = (j == x) ? c : mine; }
        if (sum == G) break;
        __builtin_amdgcn_s_sleep(1);
        if ((++sp & 255u) == 0u) { if (xb_ld(&bar[XB_TMO])) break; if (sp > XB_SPIN_CAP) { atomicAdd(&bar[XB_TMO], 1u); break; } }
    }
    nloc = mine > 0u ? mine : 1u; nx = cnt > 0u ? cnt : 1u;
}

__device__ __forceinline__ void xcd_barrier(const XcdBarrier& b, bool is_t0) {
    asm volatile("s_waitcnt vmcnt(0)" ::: "memory");
    __syncthreads();
    if (is_t0) {
        unsigned* bar = b.bar;
        __builtin_amdgcn_s_waitcnt(0);
        unsigned nloc = b.st[0], nx = b.st[1];
        if (nloc == 0u) { xcd_barrier_complete(bar, b.x, nloc, nx); b.st[0] = nloc; b.st[1] = nx; }
        const unsigned old = xb_add(&bar[XB_XSUB(b.x)], 1u);
        const unsigned gen = old / nloc;
        if (old + 1u == (gen + 1u) * nloc) {
            __builtin_amdgcn_fence(__ATOMIC_RELEASE, "agent");
            asm volatile("s_waitcnt vmcnt(0)" ::: "memory");
            const unsigned og = xb_add(&bar[XB_TOP], 1u);
            const unsigned tg = og / nx;
            if (og + 1u == (tg + 1u) * nx) xb_add(&bar[XB_TOPGEN], 1u);
            else XB_SPIN(xb_ld(&bar[XB_TOPGEN]) == tg, bar);
            __builtin_amdgcn_fence(__ATOMIC_ACQUIRE, "agent");
            xb_add(&bar[XB_XGEN(b.x)], 1u);
            asm volatile("s_waitcnt vmcnt(0)" ::: "memory");
        } else {
            XB_SPIN(xb_ld(&bar[XB_XGEN(b.x)]) == gen, bar);
            __builtin_amdgcn_fence(__ATOMIC_ACQUIRE, "agent");
            asm volatile("s_waitcnt vmcnt(0)" ::: "memory");
        }
    }
    __syncthreads();
}

__device__ __forceinline__ void stagger(int bx, unsigned ticks_per_class) {
    const unsigned q = ((unsigned)bx >> 3) & 3u;
    if (q) { const unsigned long long t0 = __builtin_amdgcn_s_memrealtime(), dt = (unsigned long long)q * ticks_per_class;
             while (__builtin_amdgcn_s_memrealtime() - t0 < dt) __builtin_amdgcn_s_sleep(8); }
}
#ifndef STAG_ON
#define STAG_ON 0
#endif
#ifndef STAG_LIGHT
#define STAG_LIGHT 300u
#endif
#ifndef STAG_HEAVY
#define STAG_HEAVY 1000u
#endif
#define GEMM_CALL(EPI, SCHED, g, S, E) do { if (STAG_ON) stagger(bx, EPI::PERM ? STAG_LIGHT : STAG_HEAVY); pg8::gemm_phase<EPI, SCHED, true, true>(lds, g, S, E, tid); } while (0)
#ifndef PROBE_G
#define PROBE_G 0
#endif
#ifndef PROBE_S
#define PROBE_S 0
#endif
#define GEMM_CALL_P(EPI, SCHED, g, S, E) do { _Pragma("unroll 1") for (int rep_ = 0; rep_ < 1 + PROBE_G; ++rep_) { GEMM_CALL(EPI, SCHED, g, S, E); } } while (0)
#ifndef PROBE_PW
#define PROBE_PW 0
#endif
#ifndef PROBE_PU
#define PROBE_PU 0
#endif
#ifndef PROBE_CT
#define PROBE_CT 0
#endif
#ifndef PROBE_AT
#define PROBE_AT 0
#endif
#ifndef PROBE_HY
#define PROBE_HY 0
#endif
#define REP_N(N_) _Pragma("unroll 1") for (int rep_ = 0; rep_ < 1 + (N_); ++rep_)

__device__ __forceinline__ int lane_id_volatile() { int l; asm volatile("v_mbcnt_lo_u32_b32 %0, -1, 0\n\tv_mbcnt_hi_u32_b32 %0, -1, %0" : "=v"(l)); return l; }
typedef const __attribute__((address_space(4))) Args* KArgs;
__device__ __forceinline__ Args load_args() {
#if defined(__HIP_DEVICE_COMPILE__)
    KArgs p = (KArgs)__builtin_amdgcn_kernarg_segment_ptr();
    asm volatile("" : "+s"(p));
    return *p;
#else
    return Args{};
#endif
}
__global__ void __launch_bounds__(NTHR, 2) fwd_megakernel(Args a_unused) {
    extern __shared__ __attribute__((aligned(16))) unsigned char lds_raw[];
    LAS unsigned char* lds = (LAS unsigned char*)lds_raw;
    cg::grid_group grid = cg::this_grid();
    const int wave0 = __builtin_amdgcn_readfirstlane((int)threadIdx.x >> 6);
    const int G0 = gridDim.x, bx0 = blockIdx.x;
#define TID0() (wave0 * 64 + lane_id_volatile())
    { const int t0_ = TID0(); if (t0_ < 2) ((LAS unsigned*)(lds + LDS_ST_OFF))[t0_] = 0u; }
    __syncthreads();
    { const Args a0 = load_args(); (void)xcd_barrier_post((unsigned*)(a0.ws + WS_BAR), (volatile LAS unsigned*)(lds + LDS_ST_OFF), TID0() == 0); }
#define GSYNC() do { const Args ab = load_args(); XcdBarrier xb_; xb_.bar = (unsigned*)(ab.ws + WS_BAR); xb_.x = xb_xcc_id(); xb_.st = (volatile LAS unsigned*)(lds + LDS_ST_OFF); xcd_barrier(xb_, TID0() == 0); } while (0)
#define PTRS() const Args a = load_args(); int tid = TID0(), G = G0, bx = bx0; asm volatile("" : "+v"(tid), "+s"(G), "+s"(bx)); const int lane = tid & 63, wave = __builtin_amdgcn_readfirstlane(tid >> 6); (void)lane; (void)wave; unsigned char* ws = a.ws; bf16* Wb = (bf16*)(ws + WS_W); const pg8::bf16_t* xb = (const pg8::bf16_t*)(ws + WS_XB); \
    const float* rcos = (const float*)(ws + WS_ROPE); const float* rsin = rcos + 65536; float* ssqA = (float*)(ws + WS_SSQA); float* ssqB = (float*)(ws + WS_SSQB); \
    (void)Wb; (void)xb; (void)rcos; (void)rsin; (void)ssqA; (void)ssqB;
#define GIN() pg8::Gemm gin{xb, (const pg8::bf16_t*)(Wb + W_IN / 2), nullptr, nullptr, MTOK, NIN, DM}; \
    pg8::EpiIn Ein{(pg8::bf16_t*)(ws + WS_HY), (pg8::bf16_t*)(ws + WS_Q), (pg8::bf16_t*)(ws + WS_KV), (pg8::bf16_t*)(ws + WS_GATES), ssqA, rcos, rsin, 0};
#define FILL_RTAB(S_, ssq_, E_) pg8::fill_rstd_table(S_, ssq_, (LAS float*)(lds + LDS_RTAB), tid)

#pragma unroll 1
    for (int L = 0; L < 2; ++L) {
        REP_N(PROBE_PW) { PTRS(); phase_prep_weights(a, L, lds, tid, lane, wave, G); }
        if (L == 0) grid.sync(); else GSYNC();
        {
            PTRS(); GIN();
            pg8::TwoRect S; S.a.init(128, 12, 0, 0, G, bx); S.b.init(64, 12, 0, 12, G, bx); S.na = S.a.count();
            GEMM_CALL_P(pg8::EpiIn, pg8::TwoRect, gin, S, Ein);
        }
        GSYNC();
        REP_N(PROBE_AT) { PTRS(); phase_attn_mfma(a, 0, lds, tid, G, rep_ < PROBE_AT); } { PTRS(); REP_N(PROBE_PU) { phase_prep_u(a, L, lds, tid, G); } }
        GSYNC();
        {
            PTRS(); GIN();
            pg8::RectOrder S; S.init(64, 12, 64, 12, G, bx);
            Ein.kv_row0 = HALF_TOK;
            GEMM_CALL_P(pg8::EpiIn, pg8::RectOrder, gin, S, Ein);
        }
        REP_N(PROBE_HY) { PTRS(); phase_hyena_mfma(a, lds, tid, G, rep_ < PROBE_HY); }
        GSYNC();
        REP_N(PROBE_AT) { PTRS(); phase_attn_mfma(a, 1, lds, tid, G, rep_ < PROBE_AT); }
        {
            PTRS(); GIN();
            pg8::RectOrder S; S.init(128, 8, 0, 24, G, bx);
            GEMM_CALL_P(pg8::EpiIn, pg8::RectOrder, gin, S, Ein);
        }
        GSYNC();
        REP_N(PROBE_CT) { PTRS(); phase_combine(a, tid, G); phase_transpose_y(a, lds, tid, G); }
        GSYNC();
        {
            PTRS();
            pg8::Gemm g{(const pg8::bf16_t*)(ws + WS_YHY), (const pg8::bf16_t*)(Wb + W_PHY / 2), (const pg8::bf16_t*)(ws + WS_YATT), (const pg8::bf16_t*)(Wb + W_PATT / 2), MTOK, DM, 512};
            pg8::PairOrder S; S.r.init(128, 4, 0, 0, G, bx);
            pg8::EpiGate E{(const pg8::bf16_t*)(ws + WS_GATES), (pg8::bf16_t*)(ws + WS_MERGED)};
            GEMM_CALL_P(pg8::EpiGate, pg8::PairOrder, g, S, E);
        }
        GSYNC();
        {
            PTRS();
            pg8::Gemm g{(const pg8::bf16_t*)(ws + WS_MERGED), (const pg8::bf16_t*)(Wb + W_O / 2), nullptr, nullptr, MTOK, DM, DM};
            pg8::RectOrder S; S.init(128, 4, 0, 0, G, bx);
            pg8::EpiRes E{L == 0 ? a.in[0] : nullptr, (pg8::bf16_t*)(ws + WS_XB), ssqB};
            GEMM_CALL(pg8::EpiRes, pg8::RectOrder, g, S, E);
        }
        GSYNC();
        {
            PTRS();
            pg8::Gemm g{xb, (const pg8::bf16_t*)(Wb + W_FF1 / 2), nullptr, nullptr, MTOK, DFF, DM};
            pg8::RectOrder S; S.init(128, 16, 0, 0, G, bx);
            pg8::EpiFF1 E{(pg8::bf16_t*)(ws + WS_H), (const LAS float*)(lds + LDS_RTAB)};
            FILL_RTAB(S, ssqB, E);
            GEMM_CALL_P(pg8::EpiFF1, pg8::RectOrder, g, S, E);
        }
        GSYNC();
        {
            PTRS();
            pg8::Gemm g{(const pg8::bf16_t*)(ws + WS_H), (const pg8::bf16_t*)(Wb + W_FF2 / 2), nullptr, nullptr, MTOK, DM, DFF};
            pg8::RectOrder S; S.init(128, 4, 0, 0, G, bx);
            pg8::EpiRes E{nullptr, (pg8::bf16_t*)(ws + WS_XB), ssqA};
            GEMM_CALL(pg8::EpiRes, pg8::RectOrder, g, S, E);
        }
        GSYNC();
    }
    { PTRS(); phase_final_norm(a, lane, wave, G); }
}

extern "C" void kernel_launch(void* const* d_in, const int* in_sizes, int n_in, void* d_out, int out_size, void* d_ws, size_t ws_size, hipStream_t stream) {
    static int grid = 0;
    if (grid == 0) {
        if (n_in != 19 || in_sizes[0] != MTOK * DM || out_size != MTOK * DM || ws_size < WS_END) {
            fprintf(stderr, "kernel_launch: unexpected shapes / workspace (n_in %d, ws %zu, need %zu); nothing launched\n", n_in, ws_size, (size_t)WS_END); grid = -1; return; }
        int dev = 0, cus = 0, per_cu = 0;
        (void)hipGetDevice(&dev); (void)hipDeviceGetAttribute(&cus, hipDeviceAttributeMultiprocessorCount, dev);
        if (hipFuncSetAttribute((const void*)fwd_megakernel, hipFuncAttributeMaxDynamicSharedMemorySize, LDS_BYTES) != hipSuccess) { fprintf(stderr, "kernel_launch: hipFuncSetAttribute failed\n"); grid = -1; return; }
        if (hipOccupancyMaxActiveBlocksPerMultiprocessor(&per_cu, (const void*)fwd_megakernel, NTHR, LDS_BYTES) != hipSuccess || per_cu < 1) { fprintf(stderr, "kernel_launch: occupancy query gives %d\n", per_cu); per_cu = 1; }
        (void)hipGetLastError();
        grid = cus * 1;
        if (grid % 8 != 0 || grid > 256) grid = (grid > 256) ? 256 : (grid / 8) * 8;
    }
    if (grid < 0) return;
    Args a{};
    for (int i = 0; i < 19; ++i) a.in[i] = (const float*)d_in[i];
    a.out = (float*)d_out; a.ws = (unsigned char*)d_ws;
    if (hipMemsetAsync((char*)d_ws + WS_BAR, 0, 16384, stream) != hipSuccess) { fprintf(stderr, "kernel_launch: memset of the barrier words failed\n"); return; }
    void* args[] = {&a};
    hipError_t e = hipLaunchCooperativeKernel((const void*)fwd_megakernel, dim3(grid), dim3(NTHR), args, LDS_BYTES, stream);
    if (e != hipSuccess) fprintf(stderr, "cooperative launch failed: %s (grid %d)\n", hipGetErrorString(e), grid);
}
```

```cpp
#include <hip/hip_runtime.h>
#include <hip/hip_cooperative_groups.h>
#include <cstdio>
#include <cstdint>
namespace cg = cooperative_groups;

namespace pg8 {
#define PG8_LAS __attribute__((address_space(3)))
typedef unsigned short bf16_t;
typedef short bf16x8 __attribute__((ext_vector_type(8)));
typedef float f32x4 __attribute__((ext_vector_type(4)));
typedef unsigned u32x4 __attribute__((ext_vector_type(4)));
constexpr int BM = 256, BK = 64, HALF = 128, HTB = HALF * BK * 2  , STAGE_BYTES = 8 * HTB, NXCD = 8, WGM = 8;

__host__ __device__ __forceinline__ int lds_byte(int r, int c) { const int st = (r >> 4) * 2 + (c >> 5), rr = r & 15, cc = c & 31, ob = rr * 64 + cc * 2; return st * 1024 + (ob ^ (((ob >> 9) & 1) << 5)); }
__host__ __device__ __forceinline__ void stage_rc(int b, int& R, int& C) { const int st = b / 1024, sb = b % 1024, swz = sb ^ (((sb >> 9) & 1) << 5); R = (st >> 1) * 16 + swz / 64; C = (st & 1) * 32 + (swz % 64) / 2; }
__host__ __device__ __forceinline__ int perm32(int rho) { const int n = rho >> 4, i = rho & 15; return 8 * (i >> 2) + 4 * n + (i & 3); }

struct Unit { int pm, pn, z; };
struct Gemm { const bf16_t* A; const bf16_t* Bt; const bf16_t* A1; const bf16_t* Bt1; int M, N, K; };

struct StaticOrder {
    int nM, nN, nwg, G, c;
    __host__ __device__ void init(int M, int N, int G_, int c_) { nM = M / BM; nN = N / BM; nwg = nM * nN; G = G_; c = c_; }
    __host__ __device__ bool next(int i, Unit& u) const {
        const long L = (long)i * G + c; if (L >= nwg) return false;
        int wgid = (int)L; { const int q = nwg / NXCD, r = nwg % NXCD, xcd = wgid % NXCD, off = wgid / NXCD; wgid = (xcd < r ? xcd * (q + 1) : r * (q + 1) + (xcd - r) * q) + off; }
        const int nig = WGM * nN, gid = wgid / nig, fm = gid * WGM, gsz = (nM - fm) < WGM ? (nM - fm) : WGM;
        u.pm = fm + ((wgid % nig) % gsz); u.pn = (wgid % nig) / gsz; return true;
    }
    __device__ __forceinline__ void a_ready(const Unit&) const {}
    __device__ __forceinline__ void done(const Unit&) const {}
};


__device__ __forceinline__ unsigned cvt_pk_bf16(float lo, float hi) { unsigned r; asm volatile("v_cvt_pk_bf16_f32 %0, %1, %2" : "=v"(r) : "v"(lo), "v"(hi)); return r; }
__device__ __forceinline__ float bf_lo(unsigned w) { return __uint_as_float(w << 16); }
__device__ __forceinline__ float bf_hi(unsigned w) { return __uint_as_float(w & 0xffff0000u); }

struct RectOrder {
    int nN, nwg, G, c, pm0, pn0;
    __device__ __forceinline__ void init(int nM_, int nN_, int pm0_, int pn0_, int G_, int c_) { nN = nN_; nwg = nM_ * nN_; G = G_; c = c_; pm0 = pm0_; pn0 = pn0_; }
    __device__ __forceinline__ int count() const { return nwg > c ? (nwg - c + G - 1) / G : 0; }
    __device__ __forceinline__ bool next(int i, Unit& u) const {
        const long L = (long)i * G + c; if (L >= nwg) return false;
        int w = (int)L;
        if ((nwg & 7) == 0 && (G & 7) == 0) w = (c & 7) * (nwg >> 3) + (w >> 3);
        const int nig = 8 * nN, gid = w / nig, r = w % nig;
        u.pm = pm0 + gid * 8 + (r & 7); u.pn = pn0 + (r >> 3); u.z = 0; return true;
    }
    __device__ __forceinline__ void a_ready(const Unit&) const {}
    __device__ __forceinline__ void done(const Unit&) const {}
};
struct TwoRect {
    RectOrder a, b; int na;
    __device__ __forceinline__ bool next(int i, Unit& u) const { return i < na ? a.next(i, u) : b.next(i - na, u); }
    __device__ __forceinline__ void a_ready(const Unit&) const {}
    __device__ __forceinline__ void done(const Unit&) const {}
};
struct PairOrder {
    RectOrder r;
    __device__ __forceinline__ bool next(int i, Unit& u) const { const bool ok = r.next(i >> 1, u); u.z = i & 1; return ok; }
    __device__ __forceinline__ void a_ready(const Unit&) const {}
    __device__ __forceinline__ void done(const Unit&) const {}
};

constexpr float RMS_EPS = 1e-6f;
constexpr float QSCALE = 0.125f * 1.44269504088896341f;

__device__ __forceinline__ float row_rstd(const float* ssq, int row) {
    const f32x4* p = (const f32x4*)(ssq + (size_t)row * 16);
    const f32x4 a = p[0], b = p[1], c = p[2], d = p[3];
    const float s = ((a[0] + a[1]) + (a[2] + a[3])) + ((b[0] + b[1]) + (b[2] + b[3])) + ((c[0] + c[1]) + (c[2] + c[3])) + ((d[0] + d[1]) + (d[2] + d[3]));
    return __builtin_amdgcn_rsqf(s * (1.0f / 1024.0f) + RMS_EPS);
}

template <class Sched>
__device__ __forceinline__ void fill_rstd_table(const Sched& S, const float* ssq, PG8_LAS float* rtab, int tid) {
    int q0 = -1, q1 = -1, q2 = -1; Unit u;
#pragma unroll 1
    for (int i = 0; S.next(i, u); ++i) { if (u.pm == q0 || u.pm == q1 || u.pm == q2) continue; if (q0 < 0) q0 = u.pm; else if (q1 < 0) q1 = u.pm; else if (q2 < 0) q2 = u.pm; }
    if (tid == 0) { ((PG8_LAS int*)rtab)[768] = q0; ((PG8_LAS int*)rtab)[769] = q1; ((PG8_LAS int*)rtab)[770] = 0; }
    const int t = tid & 255, half = tid >> 8;
    { const int pm = half ? q1 : q0; if (pm >= 0) { rtab[half * 256 + t] = row_rstd(ssq, pm * BM + t); } }
    if (q2 >= 0 && half == 0) { const float v = row_rstd(ssq, q2 * BM + t); rtab[512 + t] = v; }
    __syncthreads();
}

struct EpiIn {
    static constexpr bool PERM = true, AFTER_DRAIN = false, IDEMPOTENT = true;
    bf16_t* hy; bf16_t* q; bf16_t* kv; bf16_t* gates; const float* ssq; const float* rcos; const float* rsin; int kv_row0;
    __device__ __forceinline__ bool operator()(f32x4 (&acc)[2][2][4][2], const Unit& u, int wr, int wc, int fr, int fq) const {
        const int pn = u.pn; int type, ldc, colt, rowoff = 0; bf16_t* base;
        if (pn < 6) { type = 0; base = hy; ldc = 1536; colt = pn * 256; }
        else if (pn < 12) { type = 1; base = q; ldc = 1536; colt = (pn - 6) * 256; }
        else if (pn < 24) { const int idx = pn - 12; type = ((idx >> 1) & 1) ? 0 : 2; base = kv; ldc = 3072; colt = idx * 256; rowoff = kv_row0; }
        else { type = 3; base = gates; ldc = 2048; colt = (pn - 24) * 256; }
        const bool rot = (type == 1 || type == 2);
        const int row0 = u.pm * BM + wr * 64 + fr;
        f32x4 S[2][4], C[2][4];
#define EPIIN_LOAD(k_, buf_) do { const int row_ = row0 + ((k_) >> 2) * HALF + ((k_) & 3) * 16; const f32x4* p_ = (const f32x4*)(ssq + (size_t)row_ * 16); \
            S[buf_][0] = p_[0]; S[buf_][1] = p_[1]; S[buf_][2] = p_[2]; S[buf_][3] = p_[3]; \
            if (rot) { const int pos_ = row_ & 2047; C[buf_][0] = *(const f32x4*)(rcos + pos_ * 32 + 8 * fq); C[buf_][1] = *(const f32x4*)(rcos + pos_ * 32 + 8 * fq + 4); \
                       C[buf_][2] = *(const f32x4*)(rsin + pos_ * 32 + 8 * fq); C[buf_][3] = *(const f32x4*)(rsin + pos_ * 32 + 8 * fq + 4); } } while (0)
        EPIIN_LOAD(0, 0);
#pragma unroll
        for (int k = 0; k < 8; ++k) {
            const int ai = k >> 2, m = k & 3, cb = k & 1;
            if (k < 7) EPIIN_LOAD(k + 1, cb ^ 1);
            const int row = row0 + ai * HALF + m * 16;
            float rs;
            { const f32x4 a = S[cb][0], b = S[cb][1], c = S[cb][2], d = S[cb][3];
              const float s = ((a[0] + a[1]) + (a[2] + a[3])) + ((b[0] + b[1]) + (b[2] + b[3])) + ((c[0] + c[1]) + (c[2] + c[3])) + ((d[0] + d[1]) + (d[2] + d[3]));
              rs = __builtin_amdgcn_rsqf(s * (1.0f / 1024.0f) + RMS_EPS); }
            bf16_t* rowp = base + (size_t)(row - rowoff) * ldc + colt;
            f32x4 v00 = acc[ai][0][m][0] * rs, v01 = acc[ai][0][m][1] * rs, v10 = acc[ai][1][m][0] * rs, v11 = acc[ai][1][m][1] * rs;
            if (rot) {
                const f32x4 c0 = C[cb][0], c1 = C[cb][1], s0 = C[cb][2], s1 = C[cb][3];
                const float sc = (type == 1) ? QSCALE : 1.0f;
                const f32x4 o00 = (v00 * c0 - v10 * s0) * sc, o01 = (v01 * c1 - v11 * s1) * sc;
                const f32x4 o10 = (v10 * c0 + v00 * s0) * sc, o11 = (v11 * c1 + v01 * s1) * sc;
                u32x4 w0, w1;
                w0.x = cvt_pk_bf16(o00[0], o00[1]); w0.y = cvt_pk_bf16(o00[2], o00[3]); w0.z = cvt_pk_bf16(o01[0], o01[1]); w0.w = cvt_pk_bf16(o01[2], o01[3]);
                w1.x = cvt_pk_bf16(o10[0], o10[1]); w1.y = cvt_pk_bf16(o10[2], o10[3]); w1.z = cvt_pk_bf16(o11[0], o11[1]); w1.w = cvt_pk_bf16(o11[2], o11[3]);
                *(u32x4*)(rowp + wc * 64 + 8 * fq) = w0;
                *(u32x4*)(rowp + wc * 64 + 8 * fq + 32) = w1;
            } else {
                if (type == 3) {
#pragma unroll
                    for (int e = 0; e < 4; ++e) {
                        v00[e] = __builtin_amdgcn_rcpf(1.0f + __expf(-v00[e])); v01[e] = __builtin_amdgcn_rcpf(1.0f + __expf(-v01[e]));
                        v10[e] = __builtin_amdgcn_rcpf(1.0f + __expf(-v10[e])); v11[e] = __builtin_amdgcn_rcpf(1.0f + __expf(-v11[e]));
                    }
                }
                u32x4 w0, w1;
                w0.x = cvt_pk_bf16(v00[0], v00[1]); w0.y = cvt_pk_bf16(v00[2], v00[3]); w0.z = cvt_pk_bf16(v01[0], v01[1]); w0.w = cvt_pk_bf16(v01[2], v01[3]);
                w1.x = cvt_pk_bf16(v10[0], v10[1]); w1.y = cvt_pk_bf16(v10[2], v10[3]); w1.z = cvt_pk_bf16(v11[0], v11[1]); w1.w = cvt_pk_bf16(v11[2], v11[3]);
                *(u32x4*)(rowp + wc * 32 + 8 * fq) = w0;
                *(u32x4*)(rowp + wc * 32 + 8 * fq + HALF) = w1;
            }
        }
#undef EPIIN_LOAD
        return false;
    }
};

struct EpiGate {
    static constexpr bool PERM = true, AFTER_DRAIN = false, IDEMPOTENT = false;
    const bf16_t* gates; bf16_t* merged;
    __device__ __forceinline__ bool operator()(f32x4 (&acc)[2][2][4][2], const Unit& u, int wr, int wc, int fr, int fq) const {
        const int row0 = u.pm * BM + wr * 64 + fr, col0 = u.pn * BM + wc * 32 + 8 * fq;
        const bool first = (u.z == 0);
        u32x4 GA[2][2], GH[2][2];
#define EPIG_LOAD(k_, buf_) do { const bf16_t* gp_ = gates + (size_t)(row0 + ((k_) >> 2) * HALF + ((k_) & 3) * 16) * 2048 + col0; \
            GA[buf_][0] = *(const u32x4*)(gp_ + 1024); GA[buf_][1] = *(const u32x4*)(gp_ + 1024 + HALF); \
            if (first) { GH[buf_][0] = *(const u32x4*)(gp_); GH[buf_][1] = *(const u32x4*)(gp_ + HALF); } } while (0)
        EPIG_LOAD(0, 0);
#pragma unroll
        for (int k = 0; k < 8; ++k) {
            const int ai = k >> 2, m = k & 3, cb = k & 1;
            if (k < 7) EPIG_LOAD(k + 1, cb ^ 1);
            const int row = row0 + ai * HALF + m * 16;
#pragma unroll
            for (int bj = 0; bj < 2; ++bj) {
                const u32x4 ga = GA[cb][bj];
                f32x4 a0 = (f32x4){bf_lo(ga.x), bf_hi(ga.x), bf_lo(ga.y), bf_hi(ga.y)}, a1 = (f32x4){bf_lo(ga.z), bf_hi(ga.z), bf_lo(ga.w), bf_hi(ga.w)};
                if (first) {
                    const u32x4 gh = GH[cb][bj];
                    const f32x4 h0 = (f32x4){bf_lo(gh.x), bf_hi(gh.x), bf_lo(gh.y), bf_hi(gh.y)}, h1 = (f32x4){bf_lo(gh.z), bf_hi(gh.z), bf_lo(gh.w), bf_hi(gh.w)};
#pragma unroll
                    for (int e = 0; e < 4; ++e) { a0[e] = fmaxf(a0[e], 1e-30f); a1[e] = fmaxf(a1[e], 1e-30f); }
#pragma unroll
                    for (int e = 0; e < 4; ++e) { acc[ai][bj][m][0][e] *= h0[e] * __builtin_amdgcn_rcpf(a0[e]); acc[ai][bj][m][1][e] *= h1[e] * __builtin_amdgcn_rcpf(a1[e]); }
                } else {
                    const f32x4 v0 = acc[ai][bj][m][0] * a0, v1 = acc[ai][bj][m][1] * a1;
                    u32x4 w; w.x = cvt_pk_bf16(v0[0], v0[1]); w.y = cvt_pk_bf16(v0[2], v0[3]); w.z = cvt_pk_bf16(v1[0], v1[1]); w.w = cvt_pk_bf16(v1[2], v1[3]);
                    *(u32x4*)(merged + (size_t)row * 1024 + col0 + bj * HALF) = w;
                }
            }
        }
#undef EPIG_LOAD
        return first;
    }
};

struct EpiRes {
    static constexpr bool PERM = false, AFTER_DRAIN = false, IDEMPOTENT = false;
    const float* base32; bf16_t* xb; float* ssq;
    __device__ __forceinline__ bool operator()(f32x4 (&acc)[2][2][4][2], const Unit& u, int wr, int wc, int fr, int fq) const {
        typedef unsigned u32x2v __attribute__((ext_vector_type(2)));
        int rl = wr * 64 + fr, cl = wc * 32 + 4 * fq;
        asm volatile("" : "+v"(rl), "+v"(cl));
        const bool f32base = base32 != nullptr;
        f32x4 Bv[2][4];
#define EPIRES_LOAD(k_, buf_) do { const size_t off_ = (size_t)(u.pm * BM + ((k_) >> 2) * HALF + ((k_) & 3) * 16 + rl) * 1024 + u.pn * BM + cl; \
            if (f32base) { Bv[buf_][0] = *(const f32x4*)(base32 + off_); Bv[buf_][1] = *(const f32x4*)(base32 + off_ + 16); Bv[buf_][2] = *(const f32x4*)(base32 + off_ + HALF); Bv[buf_][3] = *(const f32x4*)(base32 + off_ + HALF + 16); } \
            else { _Pragma("unroll") for (int j_ = 0; j_ < 4; ++j_) { const u32x2v w_ = *(const u32x2v*)(xb + off_ + (j_ >> 1) * HALF + (j_ & 1) * 16); \
                       Bv[buf_][j_] = (f32x4){bf_lo(w_.x), bf_hi(w_.x), bf_lo(w_.y), bf_hi(w_.y)}; } } } while (0)
        EPIRES_LOAD(0, 0);
#pragma unroll
        for (int k = 0; k < 8; ++k) {
            const int ai = k >> 2, m = k & 3, cb = k & 1;
            if (k < 7) EPIRES_LOAD(k + 1, cb ^ 1);
            const int row = u.pm * BM + ai * HALF + m * 16 + rl;
            const size_t off = (size_t)row * 1024 + u.pn * BM + cl;
            float s = 0.f;
#pragma unroll
            for (int bj = 0; bj < 2; ++bj)
#pragma unroll
                for (int n = 0; n < 2; ++n) {
                    const f32x4 o = Bv[cb][bj * 2 + n] + acc[ai][bj][m][n];
                    u32x2v w; w.x = cvt_pk_bf16(o[0], o[1]); w.y = cvt_pk_bf16(o[2], o[3]);
                    *(u32x2v*)(xb + off + bj * HALF + n * 16) = w;
                    s += (o[0] * o[0] + o[1] * o[1]) + (o[2] * o[2] + o[3] * o[3]);
                }
            s += __shfl_xor(s, 16); s += __shfl_xor(s, 32);
            if (fq == 0) ssq[(size_t)row * 16 + u.pn * 4 + wc] = s;
        }
#undef EPIRES_LOAD
        return false;
    }
};

struct EpiFF1 {
    static constexpr bool PERM = true, AFTER_DRAIN = false, IDEMPOTENT = true;
    bf16_t* h; const PG8_LAS float* rtab;
    __device__ __forceinline__ bool operator()(f32x4 (&acc)[2][2][4][2], const Unit& u, int wr, int wc, int fr, int fq) const {
        const int row0 = u.pm * BM + wr * 64 + fr;
        const int p0 = ((const PG8_LAS int*)rtab)[768], p1 = ((const PG8_LAS int*)rtab)[769];
        const PG8_LAS float* rt = rtab + ((u.pm == p0) ? 0 : ((u.pm == p1) ? 256 : 512)) + wr * 64 + fr;
        float rsv[8];
#pragma unroll
        for (int k = 0; k < 8; ++k) rsv[k] = rt[(k >> 2) * HALF + (k & 3) * 16];
#pragma unroll
        for (int ai = 0; ai < 2; ++ai)
#pragma unroll
            for (int m = 0; m < 4; ++m) {
                const int row = row0 + ai * HALF + m * 16;
                const float rs = rsv[ai * 4 + m];
                bf16_t* rowp = h + (size_t)row * 4096 + u.pn * BM + wc * 32 + 8 * fq;
#pragma unroll
                for (int bj = 0; bj < 2; ++bj) {
                    f32x4 v0 = acc[ai][bj][m][0] * rs, v1 = acc[ai][bj][m][1] * rs;
#pragma unroll
                    for (int e = 0; e < 4; ++e) { v0[e] = fmaxf(v0[e], 0.f); v1[e] = fmaxf(v1[e], 0.f); }
                    v0 = v0 * v0; v1 = v1 * v1;
                    u32x4 w; w.x = cvt_pk_bf16(v0[0], v0[1]); w.y = cvt_pk_bf16(v0[2], v0[3]); w.z = cvt_pk_bf16(v1[0], v1[1]); w.w = cvt_pk_bf16(v1[2], v1[3]);
                    *(u32x4*)(rowp + bj * HALF) = w;
                }
            }
        return false;
    }
};

template <class Epi, class Sched, bool ALIGN_EPI = false, bool SP2 = false>
__device__ __forceinline__ void gemm_phase(PG8_LAS unsigned char* lds, const Gemm g, const Sched& S, const Epi& E, int tid_in) {
    int tid_ = tid_in; asm volatile("" : "+v"(tid_));
    const int tid = tid_, wid = __builtin_amdgcn_readfirstlane(tid >> 6), lane = tid & 63, wr = wid >> 2, wc = wid & 3, fr = lane & 15, fq = lane >> 4;
    const int K = g.K, nt = K / BK;
    unsigned voffA[2], voffB[2];
#pragma unroll
    for (int i = 0; i < 2; ++i) { int R, C; stage_rc(tid * 16 + i * 8192, R, C); const int Rb = Epi::PERM ? ((R & ~31) + perm32(R & 31)) : R;
        voffA[i] = (unsigned)(R * K + C) * 2u; voffB[i] = (unsigned)(Rb * K + C) * 2u; }
    const size_t kstep = (size_t)(BK * 2);
    const size_t hstep = (size_t)HALF * K * 2;
    const size_t tstep = 2 * hstep;
    const unsigned ldsw = (unsigned)wid * 1024u;
    const int aoff = lds_byte(wr * 64 + fr, fq * 8), boff = lds_byte(wc * 32 + fr, fq * 8);
#define PG8_SA(b, h) (((b) * 2 + (h)) * HTB)
#define PG8_SB(b, h) ((4 + (b) * 2 + (h)) * HTB)
#define PG8_STAGE(bufoff, gbase, voff) do { _Pragma("unroll") for (int _i = 0; _i < 2; ++_i) \
        __builtin_amdgcn_global_load_lds((const unsigned*)((const char*)(gbase) + (voff)[_i]), (PG8_LAS unsigned*)(lds + (bufoff) + ldsw + _i * 8192), 16, 0, 0); } while (0)
#define PG8_LDA(dst, b, h) do { _Pragma("unroll") for (int m = 0; m < 4; ++m) _Pragma("unroll") for (int k = 0; k < 2; ++k) dst[m][k] = *(const PG8_LAS bf16x8*)(lds + PG8_SA(b, h) + aoff + m * 2048 + k * 1024); } while (0)
#define PG8_LDB(dst, b, h) do { _Pragma("unroll") for (int n = 0; n < 2; ++n) _Pragma("unroll") for (int k = 0; k < 2; ++k) dst[n][k] = *(const PG8_LAS bf16x8*)(lds + PG8_SB(b, h) + boff + n * 2048 + k * 1024); } while (0)
#define PG8_MMA(ai, bj, At, Bt) do { __builtin_amdgcn_s_setprio(1); _Pragma("unroll") for (int m = 0; m < 4; ++m) _Pragma("unroll") for (int n = 0; n < 2; ++n) _Pragma("unroll") for (int k = 0; k < 2; ++k) \
        acc[ai][bj][m][n] = __builtin_amdgcn_mfma_f32_16x16x32_bf16(Bt[n][k], At[m][k], acc[ai][bj][m][n], 0, 0, 0); __builtin_amdgcn_s_setprio(0); } while (0)
#define PG8_WAIT_V(n) asm volatile("s_waitcnt vmcnt(" #n ")" ::: "memory")
#define PG8_WAIT_L(n) asm volatile("s_waitcnt lgkmcnt(" #n ")" ::: "memory")
#define PG8_BAR __builtin_amdgcn_s_barrier()
#define PG8_SCHED __builtin_amdgcn_sched_barrier(0)
    Unit cur, nxt; int ui = 0;
    if (!S.next(0, cur)) return;
    f32x4 acc[2][2][4][2];
#pragma unroll
    for (int a = 0; a < 2; ++a)
#pragma unroll
        for (int b = 0; b < 2; ++b)
#pragma unroll
            for (int m = 0; m < 4; ++m)
#pragma unroll
                for (int n = 0; n < 2; ++n) acc[a][b][m][n] = (f32x4){0.f, 0.f, 0.f, 0.f};
    bf16x8 At[4][2], B0[2][2], B1[2][2];
    const char* cA = (const char*)(cur.z ? g.A1 : g.A) + (size_t)cur.pm * tstep; const char* cB = (const char*)(cur.z ? g.Bt1 : g.Bt) + (size_t)cur.pn * tstep;
    S.a_ready(cur);
    if constexpr (SP2) {
        PG8_STAGE(PG8_SB(0, 0), cB, voffB); PG8_STAGE(PG8_SB(0, 1), cB + hstep, voffB); PG8_STAGE(PG8_SA(0, 0), cA, voffA); PG8_STAGE(PG8_SA(0, 1), cA + hstep, voffA);
        if (wr == 1) PG8_BAR;
        PG8_WAIT_V(2); PG8_BAR;
        PG8_STAGE(PG8_SB(1, 0), cB + kstep, voffB); PG8_STAGE(PG8_SA(1, 0), cA + kstep, voffA); PG8_STAGE(PG8_SB(1, 1), cB + hstep + kstep, voffB);
        PG8_WAIT_V(6); PG8_BAR;
    } else {
        PG8_STAGE(PG8_SB(0, 0), cB, voffB); PG8_STAGE(PG8_SA(0, 0), cA, voffA); PG8_STAGE(PG8_SB(0, 1), cB + hstep, voffB); PG8_STAGE(PG8_SA(0, 1), cA + hstep, voffA);
        if (wr == 1) PG8_BAR;
        PG8_WAIT_V(4); PG8_BAR;
        PG8_STAGE(PG8_SB(1, 0), cB + kstep, voffB); PG8_STAGE(PG8_SA(1, 0), cA + kstep, voffA); PG8_STAGE(PG8_SB(1, 1), cB + hstep + kstep, voffB);
        PG8_WAIT_V(6); PG8_BAR;
    }
    for (;;) {
        const bool has_next = S.next(ui + 1, nxt);
        const char* nA = has_next ? (const char*)(nxt.z ? g.A1 : g.A) + (size_t)nxt.pm * tstep : cA; const char* nB = has_next ? (const char*)(nxt.z ? g.Bt1 : g.Bt) + (size_t)nxt.pn * tstep : cB;
        for (int t = 0; t < nt; t += 2) {
            const bool last = (t == nt - 2);
            const char* a1 = cA + (size_t)(t + 1) * kstep;
            const char* a2 = last ? nA : cA + (size_t)(t + 2) * kstep; const char* b2 = last ? nB : cB + (size_t)(t + 2) * kstep;
            const char* a3 = a2 + kstep; const char* b3 = b2 + kstep;
            if (last && has_next) S.a_ready(nxt);
            if constexpr (SP2) {
            PG8_LDB(B0, 0, 0); PG8_LDB(B1, 0, 1); PG8_SCHED; PG8_LDA(At, 0, 0); PG8_STAGE(PG8_SA(1, 1), a1 + hstep, voffA);
            PG8_WAIT_V(8); PG8_WAIT_L(0); PG8_BAR; PG8_MMA(0, 0, At, B0); PG8_MMA(0, 1, At, B1); PG8_BAR; PG8_SCHED;
            PG8_LDA(At, 0, 1); PG8_STAGE(PG8_SB(0, 0), b2, voffB); PG8_STAGE(PG8_SB(0, 1), b2 + hstep, voffB); PG8_STAGE(PG8_SA(0, 0), a2, voffA);
            PG8_WAIT_V(8); PG8_WAIT_L(0); PG8_BAR; PG8_MMA(1, 0, At, B0); PG8_MMA(1, 1, At, B1); PG8_BAR; PG8_SCHED;
            PG8_LDB(B0, 1, 0); PG8_LDB(B1, 1, 1); PG8_SCHED; PG8_LDA(At, 1, 0); PG8_STAGE(PG8_SA(0, 1), a2 + hstep, voffA);
            PG8_WAIT_V(8); PG8_WAIT_L(0); PG8_BAR; PG8_MMA(0, 0, At, B0); PG8_MMA(0, 1, At, B1); PG8_BAR; PG8_SCHED;
            PG8_LDA(At, 1, 1); PG8_STAGE(PG8_SB(1, 0), b3, voffB); PG8_STAGE(PG8_SB(1, 1), b3 + hstep, voffB); PG8_STAGE(PG8_SA(1, 0), a3, voffA);
            PG8_WAIT_V(8); PG8_WAIT_L(0); PG8_BAR; PG8_MMA(1, 0, At, B0); PG8_MMA(1, 1, At, B1); PG8_BAR; PG8_SCHED;
            } else {
            PG8_LDB(B0, 0, 0); PG8_SCHED; PG8_LDA(At, 0, 0); PG8_STAGE(PG8_SA(1, 1), a1 + hstep, voffA);
            PG8_WAIT_L(8); PG8_BAR; PG8_WAIT_L(0); PG8_MMA(0, 0, At, B0); PG8_BAR; PG8_SCHED;
            PG8_LDB(B1, 0, 1); PG8_STAGE(PG8_SB(0, 0), b2, voffB);
            PG8_BAR; PG8_WAIT_L(0); PG8_MMA(0, 1, At, B1); PG8_BAR;
            PG8_LDA(At, 0, 1); PG8_STAGE(PG8_SA(0, 0), a2, voffA);
            PG8_BAR; PG8_WAIT_L(0); PG8_MMA(1, 0, At, B0); PG8_BAR; PG8_SCHED;
            PG8_STAGE(PG8_SB(0, 1), b2 + hstep, voffB);
            PG8_WAIT_V(6); PG8_BAR; PG8_MMA(1, 1, At, B1); PG8_BAR;
            PG8_LDB(B0, 1, 0); PG8_SCHED; PG8_LDA(At, 1, 0); PG8_STAGE(PG8_SA(0, 1), a2 + hstep, voffA);
            PG8_WAIT_L(8); PG8_BAR; PG8_WAIT_L(0); PG8_MMA(0, 0, At, B0); PG8_BAR; PG8_SCHED;
            PG8_LDB(B1, 1, 1); PG8_STAGE(PG8_SB(1, 0), b3, voffB);
            PG8_BAR; PG8_WAIT_L(0); PG8_MMA(0, 1, At, B1); PG8_BAR;
            PG8_LDA(At, 1, 1); PG8_STAGE(PG8_SA(1, 0), a3, voffA);
            PG8_BAR; PG8_WAIT_L(0); PG8_MMA(1, 0, At, B0); PG8_BAR; PG8_SCHED;
            PG8_STAGE(PG8_SB(1, 1), b3 + hstep, voffB);
            PG8_WAIT_V(6); PG8_BAR; PG8_MMA(1, 1, At, B1); PG8_BAR;
            }
        }
        if constexpr (ALIGN_EPI) { if (wr == 0) PG8_BAR; }
#ifndef PROBE_EPI
#define PROBE_EPI 0
#endif
        bool keep_acc = false; if constexpr (!Epi::AFTER_DRAIN) { keep_acc = E(acc, cur, wr, wc, fr, fq); if constexpr (Epi::IDEMPOTENT && PROBE_EPI) { asm volatile("" ::: "memory"); keep_acc = E(acc, cur, wr, wc, fr, fq); } S.done(cur); }
        if (!has_next) break;
        if (!keep_acc) {
#pragma unroll
        for (int a = 0; a < 2; ++a)
#pragma unroll
            for (int b = 0; b < 2; ++b)
#pragma unroll
                for (int m = 0; m < 4; ++m)
#pragma unroll
                    for (int n = 0; n < 2; ++n) acc[a][b][m][n] = (f32x4){0.f, 0.f, 0.f, 0.f};
        }
        cur = nxt; cA = nA; cB = nB; ++ui;
        if constexpr (ALIGN_EPI) { if (wr == 1) PG8_BAR; }
    }
    PG8_WAIT_V(0);
    if constexpr (!ALIGN_EPI) { if (wr == 0) PG8_BAR; }
    PG8_BAR;
    if constexpr (Epi::AFTER_DRAIN) { E.fused(acc, cur, wr, wc, fr, fq, lds, wid, lane); S.done(cur); }
#undef PG8_SA
#undef PG8_SB
#undef PG8_STAGE
#undef PG8_LDA
#undef PG8_LDB
#undef PG8_MMA
#undef PG8_WAIT_V
#undef PG8_WAIT_L
#undef PG8_BAR
#undef PG8_SCHED
}
}

#define LAS __attribute__((address_space(3)))
typedef unsigned short bf16;
typedef float f32x4 __attribute__((ext_vector_type(4)));
typedef unsigned v4u __attribute__((ext_vector_type(4)));
constexpr int NWAVES = 8, NTHR = 512;
constexpr int MTOK = 32768, DM = 1024, SEQ = 2048, NBATCH = 16, NIN = 8192, DFF = 4096, HYW = 512, HALF_TOK = 16384;
constexpr size_t MiB = (size_t)1 << 20;
constexpr size_t WS_SSQA = 0, WS_SSQB = 2 * MiB, WS_ROPE = 4 * MiB, WS_RSTD = 4 * MiB + 512 * 1024, WS_BAR = 4 * MiB + 768 * 1024, WS_LSE = 5 * MiB, WS_GF = 8 * MiB, WS_W = 16 * MiB, WS_XB = 52 * MiB,
                 WS_HY = 116 * MiB, WS_UT = 212 * MiB, WS_GATES = 116 * MiB, WS_Q = 244 * MiB, WS_KV = 340 * MiB, WS_YHY = 436 * MiB, WS_YATT = 404 * MiB, WS_X0T = 468 * MiB,
                 WS_MERGED = 340 * MiB, WS_H = 116 * MiB, WS_END = 500 * MiB;
constexpr size_t W_IN = 0, W_PHY = 16 * MiB, W_PATT = 17 * MiB, W_O = 18 * MiB, W_FF1 = 20 * MiB, W_FF2 = 28 * MiB;
constexpr int LDS_RTAB = 131072;
constexpr int LDS_ST_OFF = 135168;
constexpr int LDS_BYTES = 139264;

struct Args {
    const float* in[19]; float* out; unsigned char* ws; int pad0, pad1;
};

__device__ __forceinline__ unsigned f2bf(float f) { unsigned u = __float_as_uint(f); return (u + 0x7fffu + ((u >> 16) & 1u)) >> 16; }
__device__ __forceinline__ unsigned pk2(float lo, float hi) { return f2bf(lo) | (f2bf(hi) << 16); }
__device__ __forceinline__ float bf2f(unsigned short b) { return __uint_as_float((unsigned)b << 16); }
__device__ __forceinline__ float wave_sum(float v) {
#pragma unroll
    for (int o = 1; o < 64; o <<= 1) v += __shfl_xor(v, o);
    return v;
}

__device__ __forceinline__ int win_src_col(int n) {
    const int t = n >> 8, j = n & 255;
    if (t < 6) return n;
    if (t >= 24) return 6144 + (n - 6144);
    int g, w, half;
    if (t < 12) { const int i = t - 6; g = i >> 1; w = 0; half = i & 1; }
    else { const int i = t - 12; g = i >> 2; w = 1 + ((i >> 1) & 1); half = i & 1; }
    int hh, d;
    if (w == 2) { hh = j >> 6; d = j & 63; }
    else { hh = (j & 127) >> 5; d = (j & 31) + ((j >> 7) << 5); }
    return 1536 + g * 1536 + w * 512 + (half * 4 + hh) * 64 + d;
}

__device__ __forceinline__ void transpose_item(const float* W, int K, int Nsrc, int s0, bf16* WT, int n0, int k0, const float* gain, LAS float* scr, int lane) {
    float tv[32];
#pragma unroll
    for (int i = 0; i < 32; ++i) { const int kk = 2 * i + (lane >> 5); tv[i] = W[(size_t)(k0 + kk) * Nsrc + s0 + (lane & 31)]; }
    const float gl = gain ? gain[k0 + lane] : 1.0f;
#pragma unroll
    for (int i = 0; i < 32; ++i) { const int kk = 2 * i + (lane >> 5); scr[kk * 33 + (lane & 31)] = tv[i] * __shfl(gl, kk); }
    asm volatile("s_waitcnt lgkmcnt(0)" ::: "memory");
    const int c = lane & 7;
#pragma unroll
    for (int j = 0; j < 4; ++j) { const int n = (lane >> 3) + 8 * j; const LAS float* s = scr + (8 * c) * 33 + n;
        v4u o; o.x = pk2(s[0 * 33], s[1 * 33]); o.y = pk2(s[2 * 33], s[3 * 33]); o.z = pk2(s[4 * 33], s[5 * 33]); o.w = pk2(s[6 * 33], s[7 * 33]);
        *(v4u*)(WT + (size_t)(n0 + n) * K + k0 + 8 * c) = o; }
    asm volatile("s_waitcnt lgkmcnt(0)" ::: "memory");
}

__device__ __forceinline__ void phase_prep_weights(const Args& a, int L, LAS unsigned char* lds, int tid, int lane, int wave, int G) {
    unsigned char* ws = a.ws;
    {
        const float* w1 = a.in[5] + (size_t)L * 33 * 64; const float* b1 = a.in[6] + L * 64;
        const float* wi = a.in[7] + (size_t)L * 2 * 64 * 64; const float* bi = a.in[8] + L * 2 * 64;
        const float* wout = a.in[9] + (size_t)L * 64 * 1024; const float* fr = a.in[10] + L * 64; const float* skip = a.in[11] + L * 512;
        bf16* Rg = (bf16*)(ws + WS_GF);
        const float min_decay = logf(1e-2f) / 1.5f, max_decay = logf(1e-2f) / 0.3f;
        LAS float* hb = (LAS float*)lds + wave * 64;
        LAS float* fbuf = (LAS float*)(lds + 4096);
        const float frl = fr[lane];
        LAS float* wl = (LAS float*)(lds + 40960);
        for (int i = tid; i < 528 + 2048; i += NTHR) { const f32x4 v = (i < 528) ? *((const f32x4*)w1 + i) : *((const f32x4*)wi + (i - 528)); *(LAS f32x4*)(wl + 4 * i) = v; }
        __syncthreads();
#ifndef PROBE_PWF
#define PROBE_PWF 0
#endif
#ifndef PROBE_PWT
#define PROBE_PWT 0
#endif
        _Pragma("unroll 1") for (int repf = 0; repf < 1 + PROBE_PWF; ++repf)
        for (int blk = blockIdx.x; blk < 256; blk += G) {
            int n = 8 * blk + wave + 1; if (n == 2048) n = 0;
            const float t = (float)n / 2047.0f;
            {
                float v = 0.f;
                if (lane == 0) v = t;
                else if (lane < 33) { const int k = (lane - 1) & 15; const float band = 1e-4f + (float)k * ((15.0f - 1e-4f) / 15.0f); const float ang = ((float)(2.0 * 3.14159265358979323846 / 2048.0) * (float)n) * band;
                       v = (lane <= 16) ? cosf(ang) : -sinf(ang); }
                hb[lane] = v;
            }
            float s = b1[lane];
#pragma unroll
            for (int e = 0; e < 33; ++e) s += hb[e] * wl[e * 64 + lane];
            float hcur = sinf(frl * s);
#pragma unroll 1
            for (int layer = 0; layer < 2; ++layer) {
                hb[lane] = hcur;
                float s2 = bi[layer * 64 + lane];
#pragma unroll
                for (int e = 0; e < 64; ++e) s2 += hb[e] * wl[2112 + layer * 4096 + e * 64 + lane];
                hcur = sinf(frl * s2);
            }
            LAS float* hT = (LAS float*)(lds + 2048);
            hT[lane * 8 + wave] = hcur;
            __syncthreads();
            float o[8][2];
#pragma unroll
            for (int p = 0; p < 8; ++p) { o[p][0] = 0.f; o[p][1] = 0.f; }
#pragma unroll 16
            for (int e0 = 0; e0 < 64; ++e0) {
                const int e = (e0 + 8 * ((blk >> 3) & 7)) & 63;
                const f32x4 ha = *(const LAS f32x4*)(hT + e * 8), hc = *(const LAS f32x4*)(hT + e * 8 + 4);
                const float w0 = wout[e * 1024 + 128 * wave + lane], w1v = wout[e * 1024 + 128 * wave + 64 + lane];
#pragma unroll
                for (int p = 0; p < 4; ++p) { o[p][0] += ha[p] * w0; o[p][1] += ha[p] * w1v; o[4 + p][0] += hc[p] * w0; o[4 + p][1] += hc[p] * w1v; }
            }
#pragma unroll
            for (int j = 0; j < 2; ++j) {
                const int col = 128 * wave + 64 * j + lane, c = col & 511;
                const float delta = fabsf(min_decay + (float)c * ((max_decay - min_decay) / 511.0f));
#pragma unroll
                for (int p = 0; p < 8; ++p) { int np = 8 * blk + p + 1; if (np == 2048) np = 0; const float tp = (float)np / 2047.0f; fbuf[p * 1024 + col] = o[p][j] * expf(-tp * delta); }
            }
            __syncthreads();
            if (blk != 255) {
                typedef unsigned u32x2v __attribute__((ext_vector_type(2)));
#pragma unroll
                for (int pp = 0; pp < 2; ++pp) {
                    const int p = tid + 512 * pp, c = p & 511, dir = p >> 9;
                    bf16* r0 = Rg + ((size_t)c * 2 + 0) * 4096; bf16* r1 = Rg + ((size_t)c * 2 + 1) * 4096;
                    unsigned e[8];
#pragma unroll
                    for (int j = 0; j < 8; ++j) e[j] = f2bf(fbuf[(dir ? j : 7 - j) * 1024 + dir * 512 + c]);
                    v4u w8; w8.x = e[0] | (e[1] << 16); w8.y = e[2] | (e[3] << 16); w8.z = e[4] | (e[5] << 16); w8.w = e[6] | (e[7] << 16);
                    if (dir == 0) {
                        const int xb0 = 2040 - 8 * blk;
                        *(v4u*)(r0 + xb0) = w8;
                        r1[xb0 - 1] = (bf16)e[0];
                        u32x2v m4; m4.x = e[1] | (e[2] << 16); m4.y = e[3] | (e[4] << 16); *(u32x2v*)(r1 + xb0) = m4;
                        *(unsigned*)(r1 + xb0 + 4) = e[5] | (e[6] << 16);
                        r1[xb0 + 6] = (bf16)e[7];
                    } else {
                        const int xa = 2049 + 8 * blk;
                        *(v4u*)(r1 + xa - 1) = w8;
                        r0[xa] = (bf16)e[0];
                        *(unsigned*)(r0 + xa + 1) = e[1] | (e[2] << 16);
                        u32x2v m4; m4.x = e[3] | (e[4] << 16); m4.y = e[5] | (e[6] << 16); *(u32x2v*)(r0 + xa + 3) = m4;
                        r0[xa + 7] = (bf16)e[7];
                    }
                }
            } else
#pragma unroll
            for (int pp = 0; pp < 2; ++pp) {
                const int p = tid + 512 * pp, c = p & 511, dir = p >> 9;
                bf16* r0 = Rg + ((size_t)c * 2 + 0) * 4096; bf16* r1 = Rg + ((size_t)c * 2 + 1) * 4096;
#pragma unroll
                for (int wv = 0; wv < 8; ++wv) {
                    int nn = 8 * blk + wv + 1; float val = fbuf[wv * 1024 + dir * 512 + c]; int x;
                    if (nn == 2048) { if (dir != 0) continue; val += skip[c]; x = 2048; }
                    else x = dir ? 2048 + nn : 2048 - nn;
                    const bf16 hv = (bf16)f2bf(val); r0[x] = hv; r1[x - 1] = hv;
                }
            }
            __syncthreads();
        }
    }
    {
        LAS float* scr = (LAS float*)(lds + 40960 + wave * 8704);
        const int gw = blockIdx.x * NWAVES + wave, NGW = G * NWAVES;
        bf16* Wb = (bf16*)(ws + WS_W);
        const float* w_in = a.in[2] + (size_t)L * DM * NIN; const float* p_hy = a.in[12] + (size_t)L * 512 * DM; const float* p_att = a.in[13] + (size_t)L * 512 * DM;
        const float* w_o = a.in[14] + (size_t)L * DM * DM; const float* w1 = a.in[16] + (size_t)L * DM * DFF; const float* w2 = a.in[17] + (size_t)L * DFF * DM;
        const float* g_mix = a.in[1] + L * DM; const float* g_ffn = a.in[15] + L * DM;
        constexpr int I_IN = 16 * 256, I_P = 8 * 32, I_O = 16 * 32, I_1 = 16 * 128, I_2 = 64 * 32;
        constexpr int NITEMS = I_IN + 2 * I_P + I_O + I_1 + I_2;
        _Pragma("unroll 1") for (int rept = 0; rept < 1 + PROBE_PWT; ++rept)
        for (int it = gw; it < NITEMS; it += NGW) {
            int r = it;
            if (r < I_IN) { const int kb = r / 256, nb = r % 256; transpose_item(w_in, DM, NIN, win_src_col(nb * 32), Wb + W_IN / 2, nb * 32, kb * 64, g_mix, scr, lane); continue; } r -= I_IN;
            if (r < I_P) { const int kb = r / 32, nb = r % 32; transpose_item(p_hy, 512, DM, nb * 32, Wb + W_PHY / 2, nb * 32, kb * 64, nullptr, scr, lane); continue; } r -= I_P;
            if (r < I_P) { const int kb = r / 32, nb = r % 32; transpose_item(p_att, 512, DM, nb * 32, Wb + W_PATT / 2, nb * 32, kb * 64, nullptr, scr, lane); continue; } r -= I_P;
            if (r < I_O) { const int kb = r / 32, nb = r % 32; transpose_item(w_o, DM, DM, nb * 32, Wb + W_O / 2, nb * 32, kb * 64, nullptr, scr, lane); continue; } r -= I_O;
            if (r < I_1) { const int kb = r / 128, nb = r % 128; transpose_item(w1, DM, DFF, nb * 32, Wb + W_FF1 / 2, nb * 32, kb * 64, g_ffn, scr, lane); continue; } r -= I_1;
            { const int kb = r / 32, nb = r % 32; transpose_item(w2, DFF, DM, nb * 32, Wb + W_FF2 / 2, nb * 32, kb * 64, nullptr, scr, lane); }
        }
        if (L == 0) {
            const float* x = a.in[0]; bf16* xb = (bf16*)(ws + WS_XB); float* ssq = (float*)(ws + WS_SSQA);
            for (int m0 = gw; m0 < MTOK; m0 += 4 * NGW) {
                f32x4 v[4][4];
#pragma unroll
                for (int rr = 0; rr < 4; ++rr) { const f32x4* xr = (const f32x4*)(x + (size_t)(m0 + rr * NGW) * DM) + lane;
#pragma unroll
                    for (int j = 0; j < 4; ++j) v[rr][j] = xr[64 * j]; }
#pragma unroll
                for (int rr = 0; rr < 4; ++rr) { const int m = m0 + rr * NGW; float s = 0.f;
#pragma unroll
                    for (int j = 0; j < 4; ++j) s += (v[rr][j][0] * v[rr][j][0] + v[rr][j][1] * v[rr][j][1]) + (v[rr][j][2] * v[rr][j][2] + v[rr][j][3] * v[rr][j][3]);
                    s = wave_sum(s);
                    unsigned long long* o8 = (unsigned long long*)(xb + (size_t)m * DM) + lane;
#pragma unroll
                    for (int j = 0; j < 4; ++j) o8[64 * j] = (unsigned long long)pk2(v[rr][j][0], v[rr][j][1]) | ((unsigned long long)pk2(v[rr][j][2], v[rr][j][3]) << 32);
                    if (lane < 16) ssq[(size_t)m * 16 + lane] = (lane == 0) ? s : 0.f; }
            }
            float* rc = (float*)(ws + WS_ROPE); float* rsn = rc + 65536;
            for (int i = blockIdx.x * NTHR + tid; i < 65536; i += G * NTHR) {
                const int pos = i >> 5, f = i & 31;
                const float inv = powf(10000.0f, -(float)f / 32.0f);
                const float ang = (float)pos * inv;
                rc[i] = cosf(ang); rsn[i] = sinf(ang);
            }
        }
    }
}

__device__ __forceinline__ float bfe(const v4u& w, int e) { const unsigned d = (e >> 1) == 0 ? w.x : ((e >> 1) == 1 ? w.y : ((e >> 1) == 2 ? w.z : w.w)); return (e & 1) ? __uint_as_float(d & 0xffff0000u) : __uint_as_float(d << 16); }
__device__ __forceinline__ void phase_prep_u(const Args& a, int L, LAS unsigned char* lds, int tid, int G) {
    const bf16* hy = (const bf16*)(a.ws + WS_HY); bf16* ut = (bf16*)(a.ws + WS_UT); bf16* x0t = (bf16*)(a.ws + WS_X0T);
    const float* cw = a.in[3] + (size_t)L * 3 * 1536; const float* cb = a.in[4] + L * 1536;
    LAS unsigned short* tile = (LAS unsigned short*)lds;
    const int cc = blockIdx.x & 7, ml = tid >> 3, cg8 = tid & 7, c0 = cc * 64 + cg8 * 8;
    float wq[3][4][8];
#pragma unroll
    for (int ar = 0; ar < 3; ++ar)
#pragma unroll
        for (int e = 0; e < 8; ++e) { wq[ar][0][e] = cw[ar * 512 + c0 + e]; wq[ar][1][e] = cw[1536 + ar * 512 + c0 + e]; wq[ar][2][e] = cw[3072 + ar * 512 + c0 + e]; wq[ar][3][e] = cb[ar * 512 + c0 + e]; }
    v4u dn[3][3];
    const v4u zero = (v4u){0u, 0u, 0u, 0u};
#define PU_LOAD(it_) do { const int m_ = ((it_) & 31) * 64 + ml; const bf16* r_ = hy + (size_t)(((it_) >> 5) * SEQ + m_) * 1536 + c0; \
        _Pragma("unroll") for (int ar_ = 0; ar_ < 3; ++ar_) { dn[ar_][0] = (m_ > 0) ? *(const v4u*)(r_ - 1536 + ar_ * 512) : zero; dn[ar_][1] = *(const v4u*)(r_ + ar_ * 512); \
            dn[ar_][2] = (m_ < SEQ - 1) ? *(const v4u*)(r_ + 1536 + ar_ * 512) : zero; } } while (0)
    if ((int)(blockIdx.x >> 3) < 512) PU_LOAD((int)(blockIdx.x >> 3));
    for (int it = blockIdx.x >> 3; it < 512; it += (G >> 3)) {
        const int mc = it & 31, b = it >> 5;
        v4u d[3][3];
#pragma unroll
        for (int ar = 0; ar < 3; ++ar) { d[ar][0] = dn[ar][0]; d[ar][1] = dn[ar][1]; d[ar][2] = dn[ar][2]; }
        if (it + (G >> 3) < 512) PU_LOAD(it + (G >> 3));
#pragma unroll
        for (int e = 0; e < 8; ++e) {
            float cv[3];
#pragma unroll
            for (int ar = 0; ar < 3; ++ar) cv[ar] = wq[ar][3][e] + wq[ar][0][e] * bfe(d[ar][0], e) + wq[ar][1][e] * bfe(d[ar][1], e) + wq[ar][2][e] * bfe(d[ar][2], e);
            tile[(cg8 * 8 + e) * 72 + ml] = (unsigned short)f2bf(cv[1] * cv[2]);
            tile[4608 + (cg8 * 8 + e) * 72 + ml] = (unsigned short)f2bf(cv[0]);
        }
        __syncthreads();
        {
            const int c2 = tid >> 3, ch = tid & 7;
            const LAS unsigned* s = (const LAS unsigned*)(tile + c2 * 72 + ch * 8);
            v4u o; o.x = s[0]; o.y = s[1]; o.z = s[2]; o.w = s[3];
            *(v4u*)(ut + ((size_t)(cc * 64 + c2) * NBATCH + b) * SEQ + mc * 64 + ch * 8) = o;
            const LAS unsigned* s2 = s + 2304;
            v4u o2; o2.x = s2[0]; o2.y = s2[1]; o2.z = s2[2]; o2.w = s2[3];
            *(v4u*)(x0t + ((size_t)(cc * 64 + c2) * NBATCH + b) * SEQ + mc * 64 + ch * 8) = o2;
        }
        __syncthreads();
    }
}

__device__ __forceinline__ void phase_hyena_naive(const Args& a, int L, LAS unsigned char* lds, int tid, int G) {
    const bf16* hy = (const bf16*)(a.ws + WS_HY); const bf16* ut = (const bf16*)(a.ws + WS_UT); const float* Gf = (const float*)(a.ws + WS_GF);
    bf16* yhy = (bf16*)(a.ws + WS_YHY);
    const float* cw = a.in[3] + (size_t)L * 3 * 1536; const float* cb = a.in[4] + L * 1536;
    LAS float* Gs = (LAS float*)lds;
    LAS float* Us = Gs + 4096;
    for (int item = blockIdx.x; item < 2048; item += G) {
        const int c = item >> 2, bq = item & 3;
        for (int i = tid; i < 4096; i += NTHR) Gs[i] = (i == 0) ? 0.f : Gf[(size_t)c * 4096 + i];
        for (int i = tid; i < 8192; i += NTHR) { const int bl = i >> 11, m = i & 2047; Us[i] = bf2f(ut[((size_t)c * NBATCH + bq * 4 + bl) * SEQ + m]); }
        __syncthreads();
        const int bl = tid >> 7, tn = tid & 127;
        float acc[16];
#pragma unroll
        for (int i = 0; i < 16; ++i) acc[i] = 0.f;
        const LAS float* up = Us + bl * 2048;
        for (int m = 0; m < SEQ; ++m) {
            const float u = up[m];
            const LAS float* gp = Gs + (tn - m + 2048);
#pragma unroll
            for (int i = 0; i < 16; ++i) acc[i] += gp[128 * i] * u;
        }
        const int b = bq * 4 + bl;
        const float w0 = cw[c], w1 = cw[1536 + c], w2 = cw[3072 + c], b0 = cb[c];
#pragma unroll
        for (int i = 0; i < 16; ++i) {
            const int n = tn + 128 * i;
            const bf16* r = hy + (size_t)(b * SEQ + n) * 1536 + c;
            const float xm = (n > 0) ? bf2f(r[-1536]) : 0.f, xc = bf2f(r[0]), xp = (n < SEQ - 1) ? bf2f(r[1536]) : 0.f;
            const float x0 = b0 + w0 * xm + w1 * xc + w2 * xp;
            yhy[(size_t)(b * SEQ + n) * 512 + c] = (bf16)f2bf(x0 * acc[i]);
        }
        __syncthreads();
    }
}

__device__ __forceinline__ void phase_attn_naive(const Args& a, int half, int tid, int G) {
    bf16* Q = (bf16*)(a.ws + WS_Q); const bf16* KV = (const bf16*)(a.ws + WS_KV); float* lse = (float*)(a.ws + WS_LSE);
    for (int idx = blockIdx.x * NTHR + tid; idx < 3 * 8 * HALF_TOK; idx += G * NTHR) {
        const int g = idx / (8 * HALF_TOK), t = idx % (8 * HALF_TOK), h = t / HALF_TOK, tokl = t % HALF_TOK;
        const int dil = (g == 0) ? 1 : (g == 1 ? 4 : 16);
        const int token = half * HALF_TOK + tokl, s = token & 2047;
        bf16* qp = Q + (size_t)token * 1536 + g * 512 + h * 64;
        float q[64], o[64];
#pragma unroll
        for (int i = 0; i < 8; ++i) { const v4u w = *(const v4u*)(qp + 8 * i);
            q[8 * i + 0] = __uint_as_float(w.x << 16); q[8 * i + 1] = __uint_as_float(w.x & 0xffff0000u); q[8 * i + 2] = __uint_as_float(w.y << 16); q[8 * i + 3] = __uint_as_float(w.y & 0xffff0000u);
            q[8 * i + 4] = __uint_as_float(w.z << 16); q[8 * i + 5] = __uint_as_float(w.z & 0xffff0000u); q[8 * i + 6] = __uint_as_float(w.w << 16); q[8 * i + 7] = __uint_as_float(w.w & 0xffff0000u); }
#pragma unroll
        for (int i = 0; i < 64; ++i) o[i] = 0.f;
        float mx = -1e30f, l = 0.f;
        for (int j = -64; j <= 64; ++j) {
            const int sp = s + j * dil;
            if (sp < 0 || sp >= SEQ) continue;
            const bf16* kp = KV + (size_t)(tokl + j * dil) * 3072 + g * 1024 + h * 64;
            float sc = 0.f;
#pragma unroll
            for (int i = 0; i < 8; ++i) { const v4u w = *(const v4u*)(kp + 8 * i);
                sc += q[8 * i + 0] * __uint_as_float(w.x << 16) + q[8 * i + 1] * __uint_as_float(w.x & 0xffff0000u) + q[8 * i + 2] * __uint_as_float(w.y << 16) + q[8 * i + 3] * __uint_as_float(w.y & 0xffff0000u)
                    + q[8 * i + 4] * __uint_as_float(w.z << 16) + q[8 * i + 5] * __uint_as_float(w.z & 0xffff0000u) + q[8 * i + 6] * __uint_as_float(w.w << 16) + q[8 * i + 7] * __uint_as_float(w.w & 0xffff0000u); }
            const float mn = fmaxf(mx, sc), corr = exp2f(mx - mn), p = exp2f(sc - mn);
            l = l * corr + p; mx = mn;
            const bf16* vp = kp + 512;
#pragma unroll
            for (int i = 0; i < 8; ++i) { const v4u w = *(const v4u*)(vp + 8 * i);
                o[8 * i + 0] = o[8 * i + 0] * corr + p * __uint_as_float(w.x << 16); o[8 * i + 1] = o[8 * i + 1] * corr + p * __uint_as_float(w.x & 0xffff0000u);
                o[8 * i + 2] = o[8 * i + 2] * corr + p * __uint_as_float(w.y << 16); o[8 * i + 3] = o[8 * i + 3] * corr + p * __uint_as_float(w.y & 0xffff0000u);
                o[8 * i + 4] = o[8 * i + 4] * corr + p * __uint_as_float(w.z << 16); o[8 * i + 5] = o[8 * i + 5] * corr + p * __uint_as_float(w.z & 0xffff0000u);
                o[8 * i + 6] = o[8 * i + 6] * corr + p * __uint_as_float(w.w << 16); o[8 * i + 7] = o[8 * i + 7] * corr + p * __uint_as_float(w.w & 0xffff0000u); }
        }
        const float inv = 1.0f / l;
#pragma unroll
        for (int i = 0; i < 8; ++i) { v4u w; w.x = pk2(o[8 * i] * inv, o[8 * i + 1] * inv); w.y = pk2(o[8 * i + 2] * inv, o[8 * i + 3] * inv); w.z = pk2(o[8 * i + 4] * inv, o[8 * i + 5] * inv); w.w = pk2(o[8 * i + 6] * inv, o[8 * i + 7] * inv);
            *(v4u*)(qp + 8 * i) = w; }
        lse[((size_t)g * MTOK + token) * 8 + h] = mx + log2f(l);
    }
}

__device__ __forceinline__ void phase_combine(const Args& a, int tid, int G) {
    const bf16* Q = (const bf16*)(a.ws + WS_Q); const float* lse = (const float*)(a.ws + WS_LSE); bf16* ya = (bf16*)(a.ws + WS_YATT);
    const int stride = G * NTHR;
    for (int idx0 = blockIdx.x * NTHR + tid; idx0 < MTOK * 64; idx0 += 4 * stride) {
        float l0[4], l1[4], l2[4]; v4u a0[4], a1[4], a2[4];
#pragma unroll
        for (int j = 0; j < 4; ++j) { int idx = idx0 + j * stride; if (idx >= MTOK * 64) idx = idx0; const int token = idx >> 6, ch = idx & 63, h = ch >> 3;
            l0[j] = lse[((size_t)0 * MTOK + token) * 8 + h]; l1[j] = lse[((size_t)1 * MTOK + token) * 8 + h]; l2[j] = lse[((size_t)2 * MTOK + token) * 8 + h];
            const bf16* p = Q + (size_t)token * 1536 + ch * 8;
            a0[j] = *(const v4u*)p; a1[j] = *(const v4u*)(p + 512); a2[j] = *(const v4u*)(p + 1024); }
#pragma unroll
        for (int j = 0; j < 4; ++j) { const int idx = idx0 + j * stride; if (idx >= MTOK * 64) continue; const int token = idx >> 6, ch = idx & 63;
            const float mx = fmaxf(l0[j], fmaxf(l1[j], l2[j]));
            float w0 = exp2f(l0[j] - mx), w1 = exp2f(l1[j] - mx), w2 = exp2f(l2[j] - mx);
            const float inv = 1.0f / (w0 + w1 + w2); w0 *= inv; w1 *= inv; w2 *= inv;
            v4u o;
#define CMB(f) pk2(w0 * __uint_as_float(a0[j].f << 16) + w1 * __uint_as_float(a1[j].f << 16) + w2 * __uint_as_float(a2[j].f << 16), \
                   w0 * __uint_as_float(a0[j].f & 0xffff0000u) + w1 * __uint_as_float(a1[j].f & 0xffff0000u) + w2 * __uint_as_float(a2[j].f & 0xffff0000u))
            o.x = CMB(x); o.y = CMB(y); o.z = CMB(z); o.w = CMB(w);
#undef CMB
            *(v4u*)(ya + (size_t)token * 512 + ch * 8) = o; }
    }
}

__device__ __forceinline__ void phase_final_norm(const Args& a, int lane, int wave, int G) {
    float* out = a.out; const float* gain = a.in[18]; const bf16* xb = (const bf16*)(a.ws + WS_XB);
    const int gw = blockIdx.x * NWAVES + wave, NGW = G * NWAVES;
    typedef unsigned u32x2v __attribute__((ext_vector_type(2)));
    f32x4 gn[4];
#pragma unroll
    for (int j = 0; j < 4; ++j) gn[j] = *((const f32x4*)gain + lane + 64 * j);
    for (int m0 = gw; m0 < MTOK; m0 += 4 * NGW) {
        u32x2v w[4][4];
#pragma unroll
        for (int rr = 0; rr < 4; ++rr) { const int m = (m0 + rr * NGW < MTOK) ? m0 + rr * NGW : m0; const u32x2v* xr = (const u32x2v*)(xb + (size_t)m * DM) + lane;
#pragma unroll
            for (int j = 0; j < 4; ++j) w[rr][j] = xr[64 * j]; }
#pragma unroll
        for (int rr = 0; rr < 4; ++rr) { const int m = m0 + rr * NGW; if (m >= MTOK) continue;
            f32x4 v[4]; float s = 0.f;
#pragma unroll
            for (int j = 0; j < 4; ++j) { v[j] = (f32x4){__uint_as_float(w[rr][j].x << 16), __uint_as_float(w[rr][j].x & 0xffff0000u), __uint_as_float(w[rr][j].y << 16), __uint_as_float(w[rr][j].y & 0xffff0000u)};
                s += (v[j][0] * v[j][0] + v[j][1] * v[j][1]) + (v[j][2] * v[j][2] + v[j][3] * v[j][3]); }
            s = wave_sum(s);
            const float rs = 1.0f / sqrtf(s * (1.0f / 1024.0f) + 1e-6f);
            f32x4* orow = (f32x4*)(out + (size_t)m * DM) + lane;
#pragma unroll
            for (int j = 0; j < 4; ++j) orow[64 * j] = v[j] * rs * gn[j]; }
    }
}

typedef short bf16x8 __attribute__((ext_vector_type(8)));
typedef short s16x4 __attribute__((ext_vector_type(4)));
constexpr int HY_UROW = 4112, HY_ROFF = 16 * HY_UROW, HY_RSTRIDE = 8192 + 64;
__device__ __forceinline__ bf16x8 ld_frag4(const LAS unsigned char* p) {
    const LAS unsigned* q = (const LAS unsigned*)p; v4u d; d.x = q[0]; d.y = q[1]; d.z = q[2]; d.w = q[3]; return __builtin_bit_cast(bf16x8, d);
}
__device__ __forceinline__ void phase_hyena_mfma(const Args& a, LAS unsigned char* lds, int tid, int G, bool dummy = false) {
    const bf16* ut = (const bf16*)(a.ws + WS_UT); const bf16* Rg = (const bf16*)(a.ws + WS_GF); bf16* x0t = (bf16*)(a.ws + WS_X0T);
    const int lane = tid & 63, w = __builtin_amdgcn_readfirstlane(tid >> 6), i16 = lane & 15, kq = lane >> 4;
    const int base = (w >> 1) * 512 + (w & 1) * 16, cp = i16 & 1;
    const int lane_const = (2048 - base - i16 + 8 * kq - cp) >> 1;
    const LAS unsigned char* pA15 = lds + HY_ROFF + cp * HY_RSTRIDE + 4 * (lane_const - 240);
    const LAS unsigned char* pB = lds + i16 * HY_UROW + kq * 16;
    v4u pre[10];
#define HY_ISSUE(chn) do { _Pragma("unroll") for (int k_ = 0; k_ < 8; ++k_) { const int i_ = tid + NTHR * k_, b_ = i_ >> 8, ck_ = i_ & 255; pre[k_] = *(const v4u*)(ut + ((size_t)(chn) * NBATCH + b_) * SEQ + ck_ * 8); } \
        _Pragma("unroll") for (int k_ = 0; k_ < 2; ++k_) { const int i_ = tid + NTHR * k_, c2_ = i_ >> 9, ck_ = i_ & 511; pre[8 + k_] = *(const v4u*)(Rg + ((size_t)(chn) * 2 + c2_) * 4096 + ck_ * 8); } } while (0)
    for (int ch = blockIdx.x; ch < HYW; ch += G) {
        HY_ISSUE(ch);
#pragma unroll
        for (int k = 0; k < 8; ++k) { const int i = tid + NTHR * k, b = i >> 8, ck = i & 255; *(LAS v4u*)(lds + b * HY_UROW + ck * 16) = pre[k]; }
#pragma unroll
        for (int k = 0; k < 2; ++k) { const int i = tid + NTHR * k, c2 = i >> 9, ck = i & 511; *(LAS v4u*)(lds + HY_ROFF + c2 * HY_RSTRIDE + ck * 16) = pre[8 + k]; }
        __syncthreads();
        f32x4 acc[16]; bf16x8 W[16];
#pragma unroll
        for (int i = 0; i < 16; ++i) acc[i] = (f32x4){0.f, 0.f, 0.f, 0.f};
#pragma unroll
        for (int j = 1; j < 16; ++j) W[j] = ld_frag4(pA15 + 64 * (15 - j));
        W[0] = W[1];
#pragma unroll 1
        for (int tt = 0; tt < 4; ++tt) {
            const LAS unsigned char* pa = pA15 + 64 * 15 + 1024 * tt; const LAS unsigned char* pb = pB + 1024 * tt;
#pragma unroll
            for (int s = 0; s < 16; ++s) {
                W[(16 - s) & 15] = ld_frag4(pa + 64 * s);
                const bf16x8 Bf = *(const LAS bf16x8*)(pb + 64 * s);
#pragma unroll
                for (int i = 0; i < 16; ++i) acc[i] = __builtin_amdgcn_mfma_f32_16x16x32_bf16(W[(i - s) & 15], Bf, acc[i], 0, 0, 0);
            }
        }
        bf16* xo = x0t + ((size_t)ch * NBATCH + i16) * SEQ + base + 4 * kq;
        typedef unsigned u32x2v __attribute__((ext_vector_type(2)));
        u32x2v xall[16];
#pragma unroll
        for (int i = 0; i < 16; ++i) xall[i] = *(const u32x2v*)(xo + 32 * i);
#pragma unroll
        for (int i = 0; i < 16; ++i) {
            const u32x2v xv = xall[i];
            u32x2v o; o.x = pk2(__uint_as_float(xv.x << 16) * acc[i][0], __uint_as_float(xv.x & 0xffff0000u) * acc[i][1]);
            o.y = pk2(__uint_as_float(xv.y << 16) * acc[i][2], __uint_as_float(xv.y & 0xffff0000u) * acc[i][3]);
            if (!dummy) *(u32x2v*)(xo + 32 * i) = o; else *(u32x2v*)((bf16*)(a.ws + WS_YHY) + (size_t)tid * 64 + 4 * i) = o;
        }
        __syncthreads();
    }
}

__device__ __forceinline__ void phase_transpose_y(const Args& a, LAS unsigned char* lds, int tid, int G) {
    const bf16* yt = (const bf16*)(a.ws + WS_X0T); bf16* yhy = (bf16*)(a.ws + WS_YHY);
    LAS unsigned short* tile = (LAS unsigned short*)lds;
#define TY_LOAD(item_) (*(const v4u*)(yt + ((size_t)(((item_) & 7) * 64 + (tid >> 3)) * NBATCH + ((item_) >> 8)) * SEQ + (((item_) >> 3) & 31) * 64 + (tid & 7) * 8))
    v4u vnext = (v4u){0u, 0u, 0u, 0u};
    if ((int)blockIdx.x < 4096) vnext = TY_LOAD((int)blockIdx.x);
    for (int item = blockIdx.x; item < 4096; item += G) {
        const int cc = item & 7, mc = (item >> 3) & 31, b = item >> 8;
        { const int c2 = tid >> 3, ck = tid & 7;
          const v4u v = vnext;
          LAS unsigned* t4 = (LAS unsigned*)(tile + c2 * 72 + ck * 8); t4[0] = v.x; t4[1] = v.y; t4[2] = v.z; t4[3] = v.w; }
        __syncthreads();
        if (item + G < 4096) vnext = TY_LOAD(item + G);
        { const int nl = tid >> 3, cg8 = tid & 7; const LAS unsigned short* s = tile + (cg8 * 8) * 72 + nl;
          v4u o; o.x = s[0] | ((unsigned)s[72] << 16); o.y = s[144] | ((unsigned)s[216] << 16); o.z = s[288] | ((unsigned)s[360] << 16); o.w = s[432] | ((unsigned)s[504] << 16);
          *(v4u*)(yhy + (size_t)(b * SEQ + mc * 64 + nl) * 512 + cc * 64 + cg8 * 8) = o; }
        __syncthreads();
    }
}

constexpr int AT_ROWS = 272, AT_RS = 144, AT_VOFF = AT_ROWS * AT_RS;
__device__ __forceinline__ void phase_attn_mfma(const Args& a, int half, LAS unsigned char* lds, int tid, int G, bool dummy = false) {
    bf16* Q = (bf16*)(a.ws + WS_Q); const bf16* KV = (const bf16*)(a.ws + WS_KV); float* lse = (float*)(a.ws + WS_LSE);
    const int lane = tid & 63, w = __builtin_amdgcn_readfirstlane(tid >> 6), q16 = lane & 15, kq = lane >> 4;
    v4u pre[9]; bf16x8 Qn0, Qn1;
#define AT_DECODE(unit_) const int g = (unit_) >> 10, u = (unit_) & 1023, sub = u & 15, h = (u >> 4) & 7, bl = u >> 7; int dil, n, r, qb; \
        if (g == 0) { dil = 1; n = 2048; r = 0; qb = sub; } else if (g == 1) { dil = 4; n = 512; r = sub >> 2; qb = sub & 3; } else { dil = 16; n = 128; r = sub; qb = 0; } \
        const int q0 = qb * 128, kb0 = q0 - 64; (void)kb0; (void)q0;
#define AT_ISSUE(unit_) do { AT_DECODE(unit_) { const bf16* qn_ = Q + (size_t)(half * HALF_TOK + bl * SEQ + (q0 + 16 * w + q16) * dil + r) * 1536 + g * 512 + h * 64; Qn0 = *(const bf16x8*)(qn_ + 8 * kq); Qn1 = *(const bf16x8*)(qn_ + 32 + 8 * kq); } \
        _Pragma("unroll") for (int k_ = 0; k_ < 9; ++k_) { const int i_ = tid + NTHR * k_; \
            const int which_ = (i_ >= AT_ROWS * 8) ? 1 : 0, j_ = i_ - which_ * AT_ROWS * 8, rr_ = j_ >> 3, ck_ = j_ & 7, key_ = kb0 + rr_; \
            pre[k_] = (v4u){0u, 0u, 0u, 0u}; \
            if (i_ < 2 * AT_ROWS * 8 && key_ >= 0 && key_ < n) pre[k_] = *(const v4u*)(KV + (size_t)(bl * SEQ + key_ * dil + r) * 3072 + g * 1024 + which_ * 512 + h * 64 + ck_ * 8); } } while (0)
    const int vb = ((G & 7) == 0) ? (int)((blockIdx.x & 7) * (G >> 3) + (blockIdx.x >> 3)) : (int)blockIdx.x;
    if (vb < 3072) AT_ISSUE(vb);
    for (int unit = vb; unit < 3072; unit += G) {
#pragma unroll
        for (int k = 0; k < 9; ++k) { const int i = tid + NTHR * k; const int which = (i >= AT_ROWS * 8) ? 1 : 0, j = i - which * AT_ROWS * 8, rr = j >> 3, ck = j & 7;
            if (i < 2 * AT_ROWS * 8) *(LAS v4u*)(lds + which * AT_VOFF + rr * AT_RS + ck * 16) = pre[k]; }
        const bf16x8 Qf0 = Qn0, Qf1 = Qn1;
        __syncthreads();
        if (unit + G < 3072) AT_ISSUE(unit + G);
        AT_DECODE(unit)
        {
            const int i0 = q0 + 16 * w;
            const int token = half * HALF_TOK + bl * SEQ + (i0 + q16) * dil + r;
            bf16* qp = Q + (size_t)token * 1536 + g * 512 + h * 64;
            bf16* op = dummy ? (bf16*)(a.ws + WS_YHY) + (size_t)(tid & 511) * 64 : qp;
            f32x4 acc[4];
#pragma unroll
            for (int dt = 0; dt < 4; ++dt) acc[dt] = (f32x4){0.f, 0.f, 0.f, 0.f};
            const bool edge = (i0 < 64) || (i0 + 80 > n);
            const LAS unsigned char* kbase = lds + (16 * w + q16) * AT_RS + 16 * kq;
            const LAS unsigned char* vbase = lds + AT_VOFF + (16 * w + 4 * kq + (q16 >> 2)) * AT_RS + 8 * (q16 & 3);
            f32x4 s[9];
#pragma unroll
            for (int kt = 0; kt < 9; ++kt) {
                const LAS unsigned char* kp = kbase + kt * 16 * AT_RS;
                const bf16x8 K0 = *(const LAS bf16x8*)kp, K1 = *(const LAS bf16x8*)(kp + 64);
                f32x4 z = (f32x4){0.f, 0.f, 0.f, 0.f};
                z = __builtin_amdgcn_mfma_f32_16x16x32_bf16(K0, Qf0, z, 0, 0, 0);
                z = __builtin_amdgcn_mfma_f32_16x16x32_bf16(K1, Qf1, z, 0, 0, 0);
                if (kt == 0 || kt == 8 || edge) {
#pragma unroll
                    for (int e = 0; e < 4; ++e) {
                        const int rel = 16 * kt - 64 + 4 * kq + e - q16, j = i0 + q16 + rel;
                        const bool ok = (rel >= -64) && (rel <= 64) && (j >= 0) && (j < n);
                        z[e] = ok ? z[e] : -1e30f;
                    } }
                s[kt] = z;
            }
            float mrun = -1e30f;
#pragma unroll
            for (int kt = 0; kt < 9; ++kt) mrun = fmaxf(mrun, fmaxf(fmaxf(s[kt][0], s[kt][1]), fmaxf(s[kt][2], s[kt][3])));
            mrun = fmaxf(mrun, __shfl_xor(mrun, 16)); mrun = fmaxf(mrun, __shfl_xor(mrun, 32));
            float lrun = 0.f;
#pragma unroll
            for (int kt = 0; kt < 9; ++kt)
#pragma unroll
                for (int e = 0; e < 4; ++e) { s[kt][e] = __builtin_amdgcn_exp2f(s[kt][e] - mrun); lrun += s[kt][e]; }
#pragma unroll
            for (int st = 0; st < 5; ++st) {
                v4u pw; pw.x = pg8::cvt_pk_bf16(s[2 * st][0], s[2 * st][1]); pw.y = pg8::cvt_pk_bf16(s[2 * st][2], s[2 * st][3]);
                if (st < 4) { pw.z = pg8::cvt_pk_bf16(s[2 * st + 1][0], s[2 * st + 1][1]); pw.w = pg8::cvt_pk_bf16(s[2 * st + 1][2], s[2 * st + 1][3]); } else { pw.z = 0u; pw.w = 0u; }
                const bf16x8 Pf = __builtin_bit_cast(bf16x8, pw);
#pragma unroll
                for (int dt = 0; dt < 4; ++dt) {
                    const LAS unsigned char* vp = vbase + 32 * st * AT_RS + 32 * dt;
                    const s16x4 v0 = __builtin_amdgcn_ds_read_tr16_b64_v4i16((LAS s16x4*)vp);
                    const s16x4 v1 = __builtin_amdgcn_ds_read_tr16_b64_v4i16((LAS s16x4*)(vp + 16 * AT_RS));
                    const bf16x8 Vf = (bf16x8){v0[0], v0[1], v0[2], v0[3], v1[0], v1[1], v1[2], v1[3]};
                    acc[dt] = __builtin_amdgcn_mfma_f32_16x16x32_bf16(Vf, Pf, acc[dt], 0, 0, 0);
                }
            }
            lrun += __shfl_xor(lrun, 16); lrun += __shfl_xor(lrun, 32);
            const float inv = 1.0f / lrun;
            typedef unsigned u32x2v __attribute__((ext_vector_type(2)));
#pragma unroll
            for (int dt = 0; dt < 4; ++dt) {
                u32x2v o; o.x = pg8::cvt_pk_bf16(acc[dt][0] * inv, acc[dt][1] * inv); o.y = pg8::cvt_pk_bf16(acc[dt][2] * inv, acc[dt][3] * inv);
                *(u32x2v*)(op + 16 * dt + 4 * kq) = o;
            }
            if (kq == 0 && !dummy) lse[((size_t)g * MTOK + token) * 8 + h] = mrun + log2f(lrun);
        }
        __syncthreads();
    }
}

#define XB_TMO      128
#define XB_XCNT(j)  (256  + 64 * (j))
#define XB_XSUB(j)  (1280 + 64 * (j))
#define XB_XGEN(j)  (2304 + 64 * (j))
#define XB_TOP      3328
#define XB_TOPGEN   3392
#define XCD_BAR_WORDS 3456
#define XB_SPIN_CAP (1u << 18)

__device__ __forceinline__ unsigned xb_ld(unsigned* p)              { return __hip_atomic_load(p, __ATOMIC_RELAXED, __HIP_MEMORY_SCOPE_AGENT); }
__device__ __forceinline__ unsigned xb_add(unsigned* p, unsigned v) { return __hip_atomic_fetch_add(p, v, __ATOMIC_RELAXED, __HIP_MEMORY_SCOPE_AGENT); }
__device__ __forceinline__ unsigned xb_xcc_id() { return (unsigned)__builtin_amdgcn_s_getreg((3 << 11) | 20) & 0xFu; }
#define XB_SPIN(cond, bar) do { unsigned _sp = 0; while (cond) { __builtin_amdgcn_s_sleep(1); \
    if ((++_sp & 255u) == 0u) { if (xb_ld(&(bar)[XB_TMO])) break; if (_sp > XB_SPIN_CAP) { atomicAdd(&(bar)[XB_TMO], 1u); break; } } } } while (0)

struct XcdBarrier {
    unsigned* bar; unsigned x;
    volatile LAS unsigned* st;
};

__device__ __forceinline__ XcdBarrier xcd_barrier_post(unsigned* bar, volatile LAS unsigned* st, bool is_t0) {
    XcdBarrier b; b.bar = bar; b.x = xb_xcc_id(); b.st = st;
    if (is_t0) (void)xb_add(&bar[XB_XCNT(b.x)], 1u);
    return b;
}
__device__ __forceinline__ void xcd_barrier_complete(unsigned* bar, unsigned x, unsigned& nloc, unsigned& nx) {
    const unsigned G = gridDim.x * gridDim.y * gridDim.z;
    unsigned sum, cnt, mine, sp = 0u;
    for (;;) {
        sum = 0u; cnt = 0u; mine = 0u;
#pragma unroll
        for (unsigned j = 0; j < 16; ++j) { const unsigned c = xb_ld(&bar[XB_XCNT(j)]); sum += c; cnt += (c > 0u) ? 1u : 0u; mine = (j == x) ? c : mine; }
        if (sum == G) break;
        __builtin_amdgcn_s_sleep(1);
        if ((++sp & 255u) == 0u) { if (xb_ld(&bar[XB_TMO])) break; if (sp > XB_SPIN_CAP) { atomicAdd(&bar[XB_TMO], 1u); break; } }
    }
    nloc = mine > 0u ? mine : 1u; nx = cnt > 0u ? cnt : 1u;
}

__device__ __forceinline__ void xcd_barrier(const XcdBarrier& b, bool is_t0) {
    asm volatile("s_waitcnt vmcnt(0)" ::: "memory");
    __syncthreads();
    if (is_t0) {
        unsigned* bar = b.bar;
        __builtin_amdgcn_s_waitcnt(0);
        unsigned nloc = b.st[0], nx = b.st[1];
        if (nloc == 0u) { xcd_barrier_complete(bar, b.x, nloc, nx); b.st[0] = nloc; b.st[1] = nx; }
        const unsigned old = xb_add(&bar[XB_XSUB(b.x)], 1u);
        const unsigned gen = old / nloc;
        if (old + 1u == (gen + 1u) * nloc) {
            __builtin_amdgcn_fence(__ATOMIC_RELEASE, "agent");
            asm volatile("s_waitcnt vmcnt(0)" ::: "memory");
            const unsigned og = xb_add(&bar[XB_TOP], 1u);
            const unsigned tg = og / nx;
            if (og + 1u == (tg + 1u) * nx) xb_add(&bar[XB_TOPGEN], 1u);
            else XB_SPIN(xb_ld(&bar[XB_TOPGEN]) == tg, bar);
            __builtin_amdgcn_fence(__ATOMIC_ACQUIRE, "agent");
            xb_add(&bar[XB_XGEN(b.x)], 1u);
            asm volatile("s_waitcnt vmcnt(0)" ::: "memory");
        } else {
            XB_SPIN(xb_ld(&bar[XB_XGEN(b.x)]) == gen, bar);
            __builtin_amdgcn_fence(__ATOMIC_ACQUIRE, "agent");
            asm volatile("s_waitcnt vmcnt(0)" ::: "memory");
        }
    }
    __syncthreads();
}

__device__ __forceinline__ void stagger(int bx, unsigned ticks_per_class) {
    const unsigned q = ((unsigned)bx >> 3) & 3u;
    if (q) { const unsigned long long t0 = __builtin_amdgcn_s_memrealtime(), dt = (unsigned long long)q * ticks_per_class;
             while (__builtin_amdgcn_s_memrealtime() - t0 < dt) __builtin_amdgcn_s_sleep(8); }
}
#ifndef STAG_ON
#define STAG_ON 0
#endif
#ifndef STAG_LIGHT
#define STAG_LIGHT 300u
#endif
#ifndef STAG_HEAVY
#define STAG_HEAVY 1000u
#endif
#define GEMM_CALL(EPI, SCHED, g, S, E) do { if (STAG_ON) stagger(bx, EPI::PERM ? STAG_LIGHT : STAG_HEAVY); pg8::gemm_phase<EPI, SCHED, true, true>(lds, g, S, E, tid); } while (0)
#ifndef PROBE_G
#define PROBE_G 0
#endif
#ifndef PROBE_S
#define PROBE_S 0
#endif
#define GEMM_CALL_P(EPI, SCHED, g, S, E) do { _Pragma("unroll 1") for (int rep_ = 0; rep_ < 1 + PROBE_G; ++rep_) { GEMM_CALL(EPI, SCHED, g, S, E); } } while (0)
#ifndef PROBE_PW
#define PROBE_PW 0
#endif
#ifndef PROBE_PU
#define PROBE_PU 0
#endif
#ifndef PROBE_CT
#define PROBE_CT 0
#endif
#ifndef PROBE_AT
#define PROBE_AT 0
#endif
#ifndef PROBE_HY
#define PROBE_HY 0
#endif
#define REP_N(N_) _Pragma("unroll 1") for (int rep_ = 0; rep_ < 1 + (N_); ++rep_)

__device__ __forceinline__ int lane_id_volatile() { int l; asm volatile("v_mbcnt_lo_u32_b32 %0, -1, 0\n\tv_mbcnt_hi_u32_b32 %0, -1, %0" : "=v"(l)); return l; }
typedef const __attribute__((address_space(4))) Args* KArgs;
__device__ __forceinline__ Args load_args() {
#if defined(__HIP_DEVICE_COMPILE__)
    KArgs p = (KArgs)__builtin_amdgcn_kernarg_segment_ptr();
    asm volatile("" : "+s"(p));
    return *p;
#else
    return Args{};
#endif
}
__global__ void __launch_bounds__(NTHR, 2) fwd_megakernel(Args a_unused) {
    extern __shared__ __attribute__((aligned(16))) unsigned char lds_raw[];
    LAS unsigned char* lds = (LAS unsigned char*)lds_raw;
    cg::grid_group grid = cg::this_grid();
    const int wave0 = __builtin_amdgcn_readfirstlane((int)threadIdx.x >> 6);
    const int G0 = gridDim.x, bx0 = blockIdx.x;
#define TID0() (wave0 * 64 + lane_id_volatile())
    { const int t0_ = TID0(); if (t0_ < 2) ((LAS unsigned*)(lds + LDS_ST_OFF))[t0_] = 0u; }
    __syncthreads();
    { const Args a0 = load_args(); (void)xcd_barrier_post((unsigned*)(a0.ws + WS_BAR), (volatile LAS unsigned*)(lds + LDS_ST_OFF), TID0() == 0); }
#define GSYNC() do { const Args ab = load_args(); XcdBarrier xb_; xb_.bar = (unsigned*)(ab.ws + WS_BAR); xb_.x = xb_xcc_id(); xb_.st = (volatile LAS unsigned*)(lds + LDS_ST_OFF); xcd_barrier(xb_, TID0() == 0); } while (0)
#define PTRS() const Args a = load_args(); int tid = TID0(), G = G0, bx = bx0; asm volatile("" : "+v"(tid), "+s"(G), "+s"(bx)); const int lane = tid & 63, wave = __builtin_amdgcn_readfirstlane(tid >> 6); (void)lane; (void)wave; unsigned char* ws = a.ws; bf16* Wb = (bf16*)(ws + WS_W); const pg8::bf16_t* xb = (const pg8::bf16_t*)(ws + WS_XB); \
    const float* rcos = (const float*)(ws + WS_ROPE); const float* rsin = rcos + 65536; float* ssqA = (float*)(ws + WS_SSQA); float* ssqB = (float*)(ws + WS_SSQB); \
    (void)Wb; (void)xb; (void)rcos; (void)rsin; (void)ssqA; (void)ssqB;
#define GIN() pg8::Gemm gin{xb, (const pg8::bf16_t*)(Wb + W_IN / 2), nullptr, nullptr, MTOK, NIN, DM}; \
    pg8::EpiIn Ein{(pg8::bf16_t*)(ws + WS_HY), (pg8::bf16_t*)(ws + WS_Q), (pg8::bf16_t*)(ws + WS_KV), (pg8::bf16_t*)(ws + WS_GATES), ssqA, rcos, rsin, 0};
#define FILL_RTAB(S_, ssq_, E_) pg8::fill_rstd_table(S_, ssq_, (LAS float*)(lds + LDS_RTAB), tid)

#pragma unroll 1
    for (int L = 0; L < 2; ++L) {
        REP_N(PROBE_PW) { PTRS(); phase_prep_weights(a, L, lds, tid, lane, wave, G); }
        if (L == 0) grid.sync(); else GSYNC();
        {
            PTRS(); GIN();
            pg8::TwoRect S; S.a.init(128, 12, 0, 0, G, bx); S.b.init(64, 12, 0, 12, G, bx); S.na = S.a.count();
            GEMM_CALL_P(pg8::EpiIn, pg8::TwoRect, gin, S, Ein);
        }
        GSYNC();
        REP_N(PROBE_AT) { PTRS(); phase_attn_mfma(a, 0, lds, tid, G, rep_ < PROBE_AT); } { PTRS(); REP_N(PROBE_PU) { phase_prep_u(a, L, lds, tid, G); } }
        GSYNC();
        {
            PTRS(); GIN();
            pg8::RectOrder S; S.init(64, 12, 64, 12, G, bx);
            Ein.kv_row0 = HALF_TOK;
            GEMM_CALL_P(pg8::EpiIn, pg8::RectOrder, gin, S, Ein);
        }
        REP_N(PROBE_HY) { PTRS(); phase_hyena_mfma(a, lds, tid, G, rep_ < PROBE_HY); }
        GSYNC();
        REP_N(PROBE_AT) { PTRS(); phase_attn_mfma(a, 1, lds, tid, G, rep_ < PROBE_AT); }
        {
            PTRS(); GIN();
            pg8::RectOrder S; S.init(128, 8, 0, 24, G, bx);
            GEMM_CALL_P(pg8::EpiIn, pg8::RectOrder, gin, S, Ein);
        }
        GSYNC();
        REP_N(PROBE_CT) { PTRS(); phase_combine(a, tid, G); phase_transpose_y(a, lds, tid, G); }
        GSYNC();
        {
            PTRS();
            pg8::Gemm g{(const pg8::bf16_t*)(ws + WS_YHY), (const pg8::bf16_t*)(Wb + W_PHY / 2), (const pg8::bf16_t*)(ws + WS_YATT), (const pg8::bf16_t*)(Wb + W_PATT / 2), MTOK, DM, 512};
            pg8::PairOrder S; S.r.init(128, 4, 0, 0, G, bx);
            pg8::EpiGate E{(const pg8::bf16_t*)(ws + WS_GATES), (pg8::bf16_t*)(ws + WS_MERGED)};
            GEMM_CALL_P(pg8::EpiGate, pg8::PairOrder, g, S, E);
        }
        GSYNC();
        {
            PTRS();
            pg8::Gemm g{(const pg8::bf16_t*)(ws + WS_MERGED), (const pg8::bf16_t*)(Wb + W_O / 2), nullptr, nullptr, MTOK, DM, DM};
            pg8::RectOrder S; S.init(128, 4, 0, 0, G, bx);
            pg8::EpiRes E{L == 0 ? a.in[0] : nullptr, (pg8::bf16_t*)(ws + WS_XB), ssqB};
            GEMM_CALL(pg8::EpiRes, pg8::RectOrder, g, S, E);
        }
        GSYNC();
        {
            PTRS();
            pg8::Gemm g{xb, (const pg8::bf16_t*)(Wb + W_FF1 / 2), nullptr, nullptr, MTOK, DFF, DM};
            pg8::RectOrder S; S.init(128, 16, 0, 0, G, bx);
            pg8::EpiFF1 E{(pg8::bf16_t*)(ws + WS_H), (const LAS float*)(lds + LDS_RTAB)};
            FILL_RTAB(S, ssqB, E);
            GEMM_CALL_P(pg8::EpiFF1, pg8::RectOrder, g, S, E);
        }
        GSYNC();
        {
            PTRS();
            pg8::Gemm g{(const pg8::bf16_t*)(ws + WS_H), (const pg8::bf16_t*)(Wb + W_FF2 / 2), nullptr, nullptr, MTOK, DM, DFF};
            pg8::RectOrder S; S.init(128, 4, 0, 0, G, bx);
            pg8::EpiRes E{nullptr, (pg8::bf16_t*)(ws + WS_XB), ssqA};
            GEMM_CALL(pg8::EpiRes, pg8::RectOrder, g, S, E);
        }
        GSYNC();
    }
    { PTRS(); phase_final_norm(a, lane, wave, G); }
}

extern "C" void kernel_launch(void* const* d_in, const int* in_sizes, int n_in, void* d_out, int out_size, void* d_ws, size_t ws_size, hipStream_t stream) {
    static int grid = 0;
    if (grid == 0) {
        if (n_in != 19 || in_sizes[0] != MTOK * DM || out_size != MTOK * DM || ws_size < WS_END) {
            fprintf(stderr, "kernel_launch: unexpected shapes / workspace (n_in %d, ws %zu, need %zu); nothing launched\n", n_in, ws_size, (size_t)WS_END); grid = -1; return; }
        int dev = 0, cus = 0, per_cu = 0;
        (void)hipGetDevice(&dev); (void)hipDeviceGetAttribute(&cus, hipDeviceAttributeMultiprocessorCount, dev);
        if (hipFuncSetAttribute((const void*)fwd_megakernel, hipFuncAttributeMaxDynamicSharedMemorySize, LDS_BYTES) != hipSuccess) { fprintf(stderr, "kernel_launch: hipFuncSetAttribute failed\n"); grid = -1; return; }
        if (hipOccupancyMaxActiveBlocksPerMultiprocessor(&per_cu, (const void*)fwd_megakernel, NTHR, LDS_BYTES) != hipSuccess || per_cu < 1) { fprintf(stderr, "kernel_launch: occupancy query gives %d\n", per_cu); per_cu = 1; }
        (void)hipGetLastError();
        grid = cus * 1;
        if (grid % 8 != 0 || grid > 256) grid = (grid > 256) ? 256 : (grid / 8) * 8;
    }
    if (grid < 0) return;
    Args a{};
    for (int i = 0; i < 19; ++i) a.in[i] = (const float*)d_in[i];
    a.out = (float*)d_out; a.ws = (unsigned char*)d_ws;
    if (hipMemsetAsync((char*)d_ws + WS_BAR, 0, 16384, stream) != hipSuccess) { fprintf(stderr, "kernel_launch: memset of the barrier words failed\n"); return; }
    void* args[] = {&a};
    hipError_t e = hipLaunchCooperativeKernel((const void*)fwd_megakernel, dim3(grid), dim3(NTHR), args, LDS_BYTES, stream);
    if (e != hipSuccess) fprintf(stderr, "cooperative launch failed: %s (grid %d)\n", hipGetErrorString(e), grid);
}
```

```cpp
#include <hip/hip_runtime.h>
#include <hip/hip_cooperative_groups.h>
#include <cstdio>
#include <cstdint>
namespace cg = cooperative_groups;

namespace pg8 {
#define PG8_LAS __attribute__((address_space(3)))
typedef unsigned short bf16_t;
typedef short bf16x8 __attribute__((ext_vector_type(8)));
typedef float f32x4 __attribute__((ext_vector_type(4)));
typedef unsigned u32x4 __attribute__((ext_vector_type(4)));
constexpr int BM = 256, BK = 64, HALF = 128, HTB = HALF * BK * 2  , STAGE_BYTES = 8 * HTB, NXCD = 8, WGM = 8;

__host__ __device__ __forceinline__ int lds_byte(int r, int c) { const int st = (r >> 4) * 2 + (c >> 5), rr = r & 15, cc = c & 31, ob = rr * 64 + cc * 2; return st * 1024 + (ob ^ (((ob >> 9) & 1) << 5)); }
__host__ __device__ __forceinline__ void stage_rc(int b, int& R, int& C) { const int st = b / 1024, sb = b % 1024, swz = sb ^ (((sb >> 9) & 1) << 5); R = (st >> 1) * 16 + swz / 64; C = (st & 1) * 32 + (swz % 64) / 2; }
__host__ __device__ __forceinline__ int perm32(int rho) { const int n = rho >> 4, i = rho & 15; return 8 * (i >> 2) + 4 * n + (i & 3); }

struct Unit { int pm, pn, z; };
struct Gemm { const bf16_t* A; const bf16_t* Bt; const bf16_t* A1; const bf16_t* Bt1; int M, N, K; };

struct StaticOrder {
    int nM, nN, nwg, G, c;
    __host__ __device__ void init(int M, int N, int G_, int c_) { nM = M / BM; nN = N / BM; nwg = nM * nN; G = G_; c = c_; }
    __host__ __device__ bool next(int i, Unit& u) const {
        const long L = (long)i * G + c; if (L >= nwg) return false;
        int wgid = (int)L; { const int q = nwg / NXCD, r = nwg % NXCD, xcd = wgid % NXCD, off = wgid / NXCD; wgid = (xcd < r ? xcd * (q + 1) : r * (q + 1) + (xcd - r) * q) + off; }
        const int nig = WGM * nN, gid = wgid / nig, fm = gid * WGM, gsz = (nM - fm) < WGM ? (nM - fm) : WGM;
        u.pm = fm + ((wgid % nig) % gsz); u.pn = (wgid % nig) / gsz; return true;
    }
    __device__ __forceinline__ void a_ready(const Unit&) const {}
    __device__ __forceinline__ void done(const Unit&) const {}
};


__device__ __forceinline__ unsigned cvt_pk_bf16(float lo, float hi) { unsigned r; asm volatile("v_cvt_pk_bf16_f32 %0, %1, %2" : "=v"(r) : "v"(lo), "v"(hi)); return r; }
__device__ __forceinline__ float bf_lo(unsigned w) { return __uint_as_float(w << 16); }
__device__ __forceinline__ float bf_hi(unsigned w) { return __uint_as_float(w & 0xffff0000u); }

struct RectOrder {
    int nN, nwg, G, c, pm0, pn0;
    __device__ __forceinline__ void init(int nM_, int nN_, int pm0_, int pn0_, int G_, int c_) { nN = nN_; nwg = nM_ * nN_; G = G_; c = c_; pm0 = pm0_; pn0 = pn0_; }
    __device__ __forceinline__ int count() const { return nwg > c ? (nwg - c + G - 1) / G : 0; }
    __device__ __forceinline__ bool next(int i, Unit& u) const {
        const long L = (long)i * G + c; if (L >= nwg) return false;
        int w = (int)L;
        if ((nwg & 7) == 0 && (G & 7) == 0) w = (c & 7) * (nwg >> 3) + (w >> 3);
        const int nig = 8 * nN, gid = w / nig, r = w % nig;
        u.pm = pm0 + gid * 8 + (r & 7); u.pn = pn0 + (r >> 3); u.z = 0; return true;
    }
    __device__ __forceinline__ void a_ready(const Unit&) const {}
    __device__ __forceinline__ void done(const Unit&) const {}
};
struct TwoRect {
    RectOrder a, b; int na;
    __device__ __forceinline__ bool next(int i, Unit& u) const { return i < na ? a.next(i, u) : b.next(i - na, u); }
    __device__ __forceinline__ void a_ready(const Unit&) const {}
    __device__ __forceinline__ void done(const Unit&) const {}
};
struct PairOrder {
    RectOrder r;
    __device__ __forceinline__ bool next(int i, Unit& u) const { const bool ok = r.next(i >> 1, u); u.z = i & 1; return ok; }
    __device__ __forceinline__ void a_ready(const Unit&) const {}
    __device__ __forceinline__ void done(const Unit&) const {}
};

constexpr float RMS_EPS = 1e-6f;
constexpr float QSCALE = 0.125f * 1.44269504088896341f;

__device__ __forceinline__ float row_rstd(const float* ssq, int row) {
    const f32x4* p = (const f32x4*)(ssq + (size_t)row * 16);
    const f32x4 a = p[0], b = p[1], c = p[2], d = p[3];
    const float s = ((a[0] + a[1]) + (a[2] + a[3])) + ((b[0] + b[1]) + (b[2] + b[3])) + ((c[0] + c[1]) + (c[2] + c[3])) + ((d[0] + d[1]) + (d[2] + d[3]));
    return __builtin_amdgcn_rsqf(s * (1.0f / 1024.0f) + RMS_EPS);
}

template <class Sched>
__device__ __forceinline__ void fill_rstd_table(const Sched& S, const float* ssq, PG8_LAS float* rtab, int tid) {
    int q0 = -1, q1 = -1, q2 = -1; Unit u;
#pragma unroll 1
    for (int i = 0; S.next(i, u); ++i) { if (u.pm == q0 || u.pm == q1 || u.pm == q2) continue; if (q0 < 0) q0 = u.pm; else if (q1 < 0) q1 = u.pm; else if (q2 < 0) q2 = u.pm; }
    if (tid == 0) { ((PG8_LAS int*)rtab)[768] = q0; ((PG8_LAS int*)rtab)[769] = q1; ((PG8_LAS int*)rtab)[770] = 0; }
    const int t = tid & 255, half = tid >> 8;
    { const int pm = half ? q1 : q0; if (pm >= 0) { rtab[half * 256 + t] = row_rstd(ssq, pm * BM + t); } }
    if (q2 >= 0 && half == 0) { const float v = row_rstd(ssq, q2 * BM + t); rtab[512 + t] = v; }
    __syncthreads();
}

struct EpiIn {
    static constexpr bool PERM = true, AFTER_DRAIN = false, IDEMPOTENT = true;
    bf16_t* hy; bf16_t* q; bf16_t* kv; bf16_t* gates; const float* ssq; const float* rcos; const float* rsin; int kv_row0;
    __device__ __forceinline__ bool operator()(f32x4 (&acc)[2][2][4][2], const Unit& u, int wr, int wc, int fr, int fq) const {
        const int pn = u.pn; int type, ldc, colt, rowoff = 0; bf16_t* base;
        if (pn < 6) { type = 0; base = hy; ldc = 1536; colt = pn * 256; }
        else if (pn < 12) { type = 1; base = q; ldc = 1536; colt = (pn - 6) * 256; }
        else if (pn < 24) { const int idx = pn - 12; type = ((idx >> 1) & 1) ? 0 : 2; base = kv; ldc = 3072; colt = idx * 256; rowoff = kv_row0; }
        else { type = 3; base = gates; ldc = 2048; colt = (pn - 24) * 256; }
        const bool rot = (type == 1 || type == 2);
        const int row0 = u.pm * BM + wr * 64 + fr;
        f32x4 S[2][4], C[2][4];
#define EPIIN_LOAD(k_, buf_) do { const int row_ = row0 + ((k_) >> 2) * HALF + ((k_) & 3) * 16; const f32x4* p_ = (const f32x4*)(ssq + (size_t)row_ * 16); \
            S[buf_][0] = p_[0]; S[buf_][1] = p_[1]; S[buf_][2] = p_[2]; S[buf_][3] = p_[3]; \
            if (rot) { const int pos_ = row_ & 2047; C[buf_][0] = *(const f32x4*)(rcos + pos_ * 32 + 8 * fq); C[buf_][1] = *(const f32x4*)(rcos + pos_ * 32 + 8 * fq + 4); \
                       C[buf_][2] = *(const f32x4*)(rsin + pos_ * 32 + 8 * fq); C[buf_][3] = *(const f32x4*)(rsin + pos_ * 32 + 8 * fq + 4); } } while (0)
        EPIIN_LOAD(0, 0);
#pragma unroll
        for (int k = 0; k < 8; ++k) {
            const int ai = k >> 2, m = k & 3, cb = k & 1;
            if (k < 7) EPIIN_LOAD(k + 1, cb ^ 1);
            const int row = row0 + ai * HALF + m * 16;
            float rs;
            { const f32x4 a = S[cb][0], b = S[cb][1], c = S[cb][2], d = S[cb][3];
              const float s = ((a[0] + a[1]) + (a[2] + a[3])) + ((b[0] + b[1]) + (b[2] + b[3])) + ((c[0] + c[1]) + (c[2] + c[3])) + ((d[0] + d[1]) + (d[2] + d[3]));
              rs = __builtin_amdgcn_rsqf(s * (1.0f / 1024.0f) + RMS_EPS); }
            bf16_t* rowp = base + (size_t)(row - rowoff) * ldc + colt;
            f32x4 v00 = acc[ai][0][m][0] * rs, v01 = acc[ai][0][m][1] * rs, v10 = acc[ai][1][m][0] * rs, v11 = acc[ai][1][m][1] * rs;
            if (rot) {
                const f32x4 c0 = C[cb][0], c1 = C[cb][1], s0 = C[cb][2], s1 = C[cb][3];
                const float sc = (type == 1) ? QSCALE : 1.0f;
                const f32x4 o00 = (v00 * c0 - v10 * s0) * sc, o01 = (v01 * c1 - v11 * s1) * sc;
                const f32x4 o10 = (v10 * c0 + v00 * s0) * sc, o11 = (v11 * c1 + v01 * s1) * sc;
                u32x4 w0, w1;
                w0.x = cvt_pk_bf16(o00[0], o00[1]); w0.y = cvt_pk_bf16(o00[2], o00[3]); w0.z = cvt_pk_bf16(o01[0], o01[1]); w0.w = cvt_pk_bf16(o01[2], o01[3]);
                w1.x = cvt_pk_bf16(o10[0], o10[1]); w1.y = cvt_pk_bf16(o10[2], o10[3]); w1.z = cvt_pk_bf16(o11[0], o11[1]); w1.w = cvt_pk_bf16(o11[2], o11[3]);
                *(u32x4*)(rowp + wc * 64 + 8 * fq) = w0;
                *(u32x4*)(rowp + wc * 64 + 8 * fq + 32) = w1;
            } else {
                if (type == 3) {
#pragma unroll
                    for (int e = 0; e < 4; ++e) {
                        v00[e] = __builtin_amdgcn_rcpf(1.0f + __expf(-v00[e])); v01[e] = __builtin_amdgcn_rcpf(1.0f + __expf(-v01[e]));
                        v10[e] = __builtin_amdgcn_rcpf(1.0f + __expf(-v10[e])); v11[e] = __builtin_amdgcn_rcpf(1.0f + __expf(-v11[e]));
                    }
                }
                u32x4 w0, w1;
                w0.x = cvt_pk_bf16(v00[0], v00[1]); w0.y = cvt_pk_bf16(v00[2], v00[3]); w0.z = cvt_pk_bf16(v01[0], v01[1]); w0.w = cvt_pk_bf16(v01[2], v01[3]);
                w1.x = cvt_pk_bf16(v10[0], v10[1]); w1.y = cvt_pk_bf16(v10[2], v10[3]); w1.z = cvt_pk_bf16(v11[0], v11[1]); w1.w = cvt_pk_bf16(v11[2], v11[3]);
                *(u32x4*)(rowp + wc * 32 + 8 * fq) = w0;
                *(u32x4*)(rowp + wc * 32 + 8 * fq + HALF) = w1;
            }
        }
#undef EPIIN_LOAD
        return false;
    }
};

struct EpiGate {
    static constexpr bool PERM = true, AFTER_DRAIN = false, IDEMPOTENT = false;
    const bf16_t* gates; bf16_t* merged;
    __device__ __forceinline__ bool operator()(f32x4 (&acc)[2][2][4][2], const Unit& u, int wr, int wc, int fr, int fq) const {
        const int row0 = u.pm * BM + wr * 64 + fr, col0 = u.pn * BM + wc * 32 + 8 * fq;
        const bool first = (u.z == 0);
        u32x4 GA[2][2], GH[2][2];
#define EPIG_LOAD(k_, buf_) do { const bf16_t* gp_ = gates + (size_t)(row0 + ((k_) >> 2) * HALF + ((k_) & 3) * 16) * 2048 + col0; \
            GA[buf_][0] = *(const u32x4*)(gp_ + 1024); GA[buf_][1] = *(const u32x4*)(gp_ + 1024 + HALF); \
            if (first) { GH[buf_][0] = *(const u32x4*)(gp_); GH[buf_][1] = *(const u32x4*)(gp_ + HALF); } } while (0)
        EPIG_LOAD(0, 0);
#pragma unroll
        for (int k = 0; k < 8; ++k) {
            const int ai = k >> 2, m = k & 3, cb = k & 1;
            if (k < 7) EPIG_LOAD(k + 1, cb ^ 1);
            const int row = row0 + ai * HALF + m * 16;
#pragma unroll
            for (int bj = 0; bj < 2; ++bj) {
                const u32x4 ga = GA[cb][bj];
                f32x4 a0 = (f32x4){bf_lo(ga.x), bf_hi(ga.x), bf_lo(ga.y), bf_hi(ga.y)}, a1 = (f32x4){bf_lo(ga.z), bf_hi(ga.z), bf_lo(ga.w), bf_hi(ga.w)};
                if (first) {
                    const u32x4 gh = GH[cb][bj];
                    const f32x4 h0 = (f32x4){bf_lo(gh.x), bf_hi(gh.x), bf_lo(gh.y), bf_hi(gh.y)}, h1 = (f32x4){bf_lo(gh.z), bf_hi(gh.z), bf_lo(gh.w), bf_hi(gh.w)};
#pragma unroll
                    for (int e = 0; e < 4; ++e) { a0[e] = fmaxf(a0[e], 1e-30f); a1[e] = fmaxf(a1[e], 1e-30f); }
#pragma unroll
                    for (int e = 0; e < 4; ++e) { acc[ai][bj][m][0][e] *= h0[e] * __builtin_amdgcn_rcpf(a0[e]); acc[ai][bj][m][1][e] *= h1[e] * __builtin_amdgcn_rcpf(a1[e]); }
                } else {
                    const f32x4 v0 = acc[ai][bj][m][0] * a0, v1 = acc[ai][bj][m][1] * a1;
                    u32x4 w; w.x = cvt_pk_bf16(v0[0], v0[1]); w.y = cvt_pk_bf16(v0[2], v0[3]); w.z = cvt_pk_bf16(v1[0], v1[1]); w.w = cvt_pk_bf16(v1[2], v1[3]);
                    *(u32x4*)(merged + (size_t)row * 1024 + col0 + bj * HALF) = w;
                }
            }
        }
#undef EPIG_LOAD
        return first;
    }
};

struct EpiRes {
    static constexpr bool PERM = false, AFTER_DRAIN = false, IDEMPOTENT = false;
    const float* base32; bf16_t* xb; float* ssq;
    __device__ __forceinline__ bool operator()(f32x4 (&acc)[2][2][4][2], const Unit& u, int wr, int wc, int fr, int fq) const {
        typedef unsigned u32x2v __attribute__((ext_vector_type(2)));
        int rl = wr * 64 + fr, cl = wc * 32 + 4 * fq;
        asm volatile("" : "+v"(rl), "+v"(cl));
        const bool f32base = base32 != nullptr;
        f32x4 Bv[2][4];
#define EPIRES_LOAD(k_, buf_) do { const size_t off_ = (size_t)(u.pm * BM + ((k_) >> 2) * HALF + ((k_) & 3) * 16 + rl) * 1024 + u.pn * BM + cl; \
            if (f32base) { Bv[buf_][0] = *(const f32x4*)(base32 + off_); Bv[buf_][1] = *(const f32x4*)(base32 + off_ + 16); Bv[buf_][2] = *(const f32x4*)(base32 + off_ + HALF); Bv[buf_][3] = *(const f32x4*)(base32 + off_ + HALF + 16); } \
            else { _Pragma("unroll") for (int j_ = 0; j_ < 4; ++j_) { const u32x2v w_ = *(const u32x2v*)(xb + off_ + (j_ >> 1) * HALF + (j_ & 1) * 16); \
                       Bv[buf_][j_] = (f32x4){bf_lo(w_.x), bf_hi(w_.x), bf_lo(w_.y), bf_hi(w_.y)}; } } } while (0)
        EPIRES_LOAD(0, 0);
#pragma unroll
        for (int k = 0; k < 8; ++k) {
            const int ai = k >> 2, m = k & 3, cb = k & 1;
            if (k < 7) EPIRES_LOAD(k + 1, cb ^ 1);
            const int row = u.pm * BM + ai * HALF + m * 16 + rl;
            const size_t off = (size_t)row * 1024 + u.pn * BM + cl;
            float s = 0.f;
#pragma unroll
            for (int bj = 0; bj < 2; ++bj)
#pragma unroll
                for (int n = 0; n < 2; ++n) {
                    const f32x4 o = Bv[cb][bj * 2 + n] + acc[ai][bj][m][n];
                    u32x2v w; w.x = cvt_pk_bf16(o[0], o[1]); w.y = cvt_pk_bf16(o[2], o[3]);
                    *(u32x2v*)(xb + off + bj * HALF + n * 16) = w;
                    s += (o[0] * o[0] + o[1] * o[1]) + (o[2] * o[2] + o[3] * o[3]);
                }
            s += __shfl_xor(s, 16); s += __shfl_xor(s, 32);
            if (fq == 0) ssq[(size_t)row * 16 + u.pn * 4 + wc] = s;
        }
#undef EPIRES_LOAD
        return false;
    }
};

struct EpiFF1 {
    static constexpr bool PERM = true, AFTER_DRAIN = false, IDEMPOTENT = true;
    bf16_t* h; const PG8_LAS float* rtab;
    __device__ __forceinline__ bool operator()(f32x4 (&acc)[2][2][4][2], const Unit& u, int wr, int wc, int fr, int fq) const {
        const int row0 = u.pm * BM + wr * 64 + fr;
        const int p0 = ((const PG8_LAS int*)rtab)[768], p1 = ((const PG8_LAS int*)rtab)[769];
        const PG8_LAS float* rt = rtab + ((u.pm == p0) ? 0 : ((u.pm == p1) ? 256 : 512)) + wr * 64 + fr;
        float rsv[8];
#pragma unroll
        for (int k = 0; k < 8; ++k) rsv[k] = rt[(k >> 2) * HALF + (k & 3) * 16];
#pragma unroll
        for (int ai = 0; ai < 2; ++ai)
#pragma unroll
            for (int m = 0; m < 4; ++m) {
                const int row = row0 + ai * HALF + m * 16;
                const float rs = rsv[ai * 4 + m];
                bf16_t* rowp = h + (size_t)row * 4096 + u.pn * BM + wc * 32 + 8 * fq;
#pragma unroll
                for (int bj = 0; bj < 2; ++bj) {
                    f32x4 v0 = acc[ai][bj][m][0] * rs, v1 = acc[ai][bj][m][1] * rs;
#pragma unroll
                    for (int e = 0; e < 4; ++e) { v0[e] = fmaxf(v0[e], 0.f); v1[e] = fmaxf(v1[e], 0.f); }
                    v0 = v0 * v0; v1 = v1 * v1;
                    u32x4 w; w.x = cvt_pk_bf16(v0[0], v0[1]); w.y = cvt_pk_bf16(v0[2], v0[3]); w.z = cvt_pk_bf16(v1[0], v1[1]); w.w = cvt_pk_bf16(v1[2], v1[3]);
                    *(u32x4*)(rowp + bj * HALF) = w;
                }
            }
        return false;
    }
};

template <class Epi, class Sched, bool ALIGN_EPI = false, bool SP2 = false>
__device__ __forceinline__ void gemm_phase(PG8_LAS unsigned char* lds, const Gemm g, const Sched& S, const Epi& E, int tid_in) {
    int tid_ = tid_in; asm volatile("" : "+v"(tid_));
    const int tid = tid_, wid = __builtin_amdgcn_readfirstlane(tid >> 6), lane = tid & 63, wr = wid >> 2, wc = wid & 3, fr = lane & 15, fq = lane >> 4;
    const int K = g.K, nt = K / BK;
    unsigned voffA[2], voffB[2];
#pragma unroll
    for (int i = 0; i < 2; ++i) { int R, C; stage_rc(tid * 16 + i * 8192, R, C); const int Rb = Epi::PERM ? ((R & ~31) + perm32(R & 31)) : R;
        voffA[i] = (unsigned)(R * K + C) * 2u; voffB[i] = (unsigned)(Rb * K + C) * 2u; }
    const size_t kstep = (size_t)(BK * 2);
    const size_t hstep = (size_t)HALF * K * 2;
    const size_t tstep = 2 * hstep;
    const unsigned ldsw = (unsigned)wid * 1024u;
    const int aoff = lds_byte(wr * 64 + fr, fq * 8), boff = lds_byte(wc * 32 + fr, fq * 8);
#define PG8_SA(b, h) (((b) * 2 + (h)) * HTB)
#define PG8_SB(b, h) ((4 + (b) * 2 + (h)) * HTB)
#define PG8_STAGE(bufoff, gbase, voff) do { _Pragma("unroll") for (int _i = 0; _i < 2; ++_i) \
        __builtin_amdgcn_global_load_lds((const unsigned*)((const char*)(gbase) + (voff)[_i]), (PG8_LAS unsigned*)(lds + (bufoff) + ldsw + _i * 8192), 16, 0, 0); } while (0)
#define PG8_LDA(dst, b, h) do { _Pragma("unroll") for (int m = 0; m < 4; ++m) _Pragma("unroll") for (int k = 0; k < 2; ++k) dst[m][k] = *(const PG8_LAS bf16x8*)(lds + PG8_SA(b, h) + aoff + m * 2048 + k * 1024); } while (0)
#define PG8_LDB(dst, b, h) do { _Pragma("unroll") for (int n = 0; n < 2; ++n) _Pragma("unroll") for (int k = 0; k < 2; ++k) dst[n][k] = *(const PG8_LAS bf16x8*)(lds + PG8_SB(b, h) + boff + n * 2048 + k * 1024); } while (0)
#define PG8_MMA(ai, bj, At, Bt) do { __builtin_amdgcn_s_setprio(1); _Pragma("unroll") for (int m = 0; m < 4; ++m) _Pragma("unroll") for (int n = 0; n < 2; ++n) _Pragma("unroll") for (int k = 0; k < 2; ++k) \
        acc[ai][bj][m][n] = __builtin_amdgcn_mfma_f32_16x16x32_bf16(Bt[n][k], At[m][k], acc[ai][bj][m][n], 0, 0, 0); __builtin_amdgcn_s_setprio(0); } while (0)
#define PG8_WAIT_V(n) asm volatile("s_waitcnt vmcnt(" #n ")" ::: "memory")
#define PG8_WAIT_L(n) asm volatile("s_waitcnt lgkmcnt(" #n ")" ::: "memory")
#define PG8_BAR __builtin_amdgcn_s_barrier()
#define PG8_SCHED __builtin_amdgcn_sched_barrier(0)
    Unit cur, nxt; int ui = 0;
    if (!S.next(0, cur)) return;
    f32x4 acc[2][2][4][2];
#pragma unroll
    for (int a = 0; a < 2; ++a)
#pragma unroll
        for (int b = 0; b < 2; ++b)
#pragma unroll
            for (int m = 0; m < 4; ++m)
#pragma unroll
                for (int n = 0; n < 2; ++n) acc[a][b][m][n] = (f32x4){0.f, 0.f, 0.f, 0.f};
    bf16x8 At[4][2], B0[2][2], B1[2][2];
    const char* cA = (const char*)(cur.z ? g.A1 : g.A) + (size_t)cur.pm * tstep; const char* cB = (const char*)(cur.z ? g.Bt1 : g.Bt) + (size_t)cur.pn * tstep;
    S.a_ready(cur);
    if constexpr (SP2) {
        PG8_STAGE(PG8_SB(0, 0), cB, voffB); PG8_STAGE(PG8_SB(0, 1), cB + hstep, voffB); PG8_STAGE(PG8_SA(0, 0), cA, voffA); PG8_STAGE(PG8_SA(0, 1), cA + hstep, voffA);
        if (wr == 1) PG8_BAR;
        PG8_WAIT_V(2); PG8_BAR;
        PG8_STAGE(PG8_SB(1, 0), cB + kstep, voffB); PG8_STAGE(PG8_SA(1, 0), cA + kstep, voffA); PG8_STAGE(PG8_SB(1, 1), cB + hstep + kstep, voffB);
        PG8_WAIT_V(6); PG8_BAR;
    } else {
        PG8_STAGE(PG8_SB(0, 0), cB, voffB); PG8_STAGE(PG8_SA(0, 0), cA, voffA); PG8_STAGE(PG8_SB(0, 1), cB + hstep, voffB); PG8_STAGE(PG8_SA(0, 1), cA + hstep, voffA);
        if (wr == 1) PG8_BAR;
        PG8_WAIT_V(4); PG8_BAR;
        PG8_STAGE(PG8_SB(1, 0), cB + kstep, voffB); PG8_STAGE(PG8_SA(1, 0), cA + kstep, voffA); PG8_STAGE(PG8_SB(1, 1), cB + hstep + kstep, voffB);
        PG8_WAIT_V(6); PG8_BAR;
    }
    for (;;) {
        const bool has_next = S.next(ui + 1, nxt);
        const char* nA = has_next ? (const char*)(nxt.z ? g.A1 : g.A) + (size_t)nxt.pm * tstep : cA; const char* nB = has_next ? (const char*)(nxt.z ? g.Bt1 : g.Bt) + (size_t)nxt.pn * tstep : cB;
        for (int t = 0; t < nt; t += 2) {
            const bool last = (t == nt - 2);
            const char* a1 = cA + (size_t)(t + 1) * kstep;
            const char* a2 = last ? nA : cA + (size_t)(t + 2) * kstep; const char* b2 = last ? nB : cB + (size_t)(t + 2) * kstep;
            const char* a3 = a2 + kstep; const char* b3 = b2 + kstep;
            if (last && has_next) S.a_ready(nxt);
            if constexpr (SP2) {
            PG8_LDB(B0, 0, 0); PG8_LDB(B1, 0, 1); PG8_SCHED; PG8_LDA(At, 0, 0); PG8_STAGE(PG8_SA(1, 1), a1 + hstep, voffA);
            PG8_WAIT_V(8); PG8_WAIT_L(0); PG8_BAR; PG8_MMA(0, 0, At, B0); PG8_MMA(0, 1, At, B1); PG8_BAR; PG8_SCHED;
            PG8_LDA(At, 0, 1); PG8_STAGE(PG8_SB(0, 0), b2, voffB); PG8_STAGE(PG8_SB(0, 1), b2 + hstep, voffB); PG8_STAGE(PG8_SA(0, 0), a2, voffA);
            PG8_WAIT_V(8); PG8_WAIT_L(0); PG8_BAR; PG8_MMA(1, 0, At, B0); PG8_MMA(1, 1, At, B1); PG8_BAR; PG8_SCHED;
            PG8_LDB(B0, 1, 0); PG8_LDB(B1, 1, 1); PG8_SCHED; PG8_LDA(At, 1, 0); PG8_STAGE(PG8_SA(0, 1), a2 + hstep, voffA);
            PG8_WAIT_V(8); PG8_WAIT_L(0); PG8_BAR; PG8_MMA(0, 0, At, B0); PG8_MMA(0, 1, At, B1); PG8_BAR; PG8_SCHED;
            PG8_LDA(At, 1, 1); PG8_STAGE(PG8_SB(1, 0), b3, voffB); PG8_STAGE(PG8_SB(1, 1), b3 + hstep, voffB); PG8_STAGE(PG8_SA(1, 0), a3, voffA);
            PG8_WAIT_V(8); PG8_WAIT_L(0); PG8_BAR; PG8_MMA(1, 0, At, B0); PG8_MMA(1, 1, At, B1); PG8_BAR; PG8_SCHED;
            } else {
            PG8_LDB(B0, 0, 0); PG8_SCHED; PG8_LDA(At, 0, 0); PG8_STAGE(PG8_SA(1, 1), a1 + hstep, voffA);
            PG8_WAIT_L(8); PG8_BAR; PG8_WAIT_L(0); PG8_MMA(0, 0, At, B0); PG8_BAR; PG8_SCHED;
            PG8_LDB(B1, 0, 1); PG8_STAGE(PG8_SB(0, 0), b2, voffB);
            PG8_BAR; PG8_WAIT_L(0); PG8_MMA(0, 1, At, B1); PG8_BAR;
            PG8_LDA(At, 0, 1); PG8_STAGE(PG8_SA(0, 0), a2, voffA);
            PG8_BAR; PG8_WAIT_L(0); PG8_MMA(1, 0, At, B0); PG8_BAR; PG8_SCHED;
            PG8_STAGE(PG8_SB(0, 1), b2 + hstep, voffB);
            PG8_WAIT_V(6); PG8_BAR; PG8_MMA(1, 1, At, B1); PG8_BAR;
            PG8_LDB(B0, 1, 0); PG8_SCHED; PG8_LDA(At, 1, 0); PG8_STAGE(PG8_SA(0, 1), a2 + hstep, voffA);
            PG8_WAIT_L(8); PG8_BAR; PG8_WAIT_L(0); PG8_MMA(0, 0, At, B0); PG8_BAR; PG8_SCHED;
            PG8_LDB(B1, 1, 1); PG8_STAGE(PG8_SB(1, 0), b3, voffB);
            PG8_BAR; PG8_WAIT_L(0); PG8_MMA(0, 1, At, B1); PG8_BAR;
            PG8_LDA(At, 1, 1); PG8_STAGE(PG8_SA(1, 0), a3, voffA);
            PG8_BAR; PG8_WAIT_L(0); PG8_MMA(1, 0, At, B0); PG8_BAR; PG8_SCHED;
            PG8_STAGE(PG8_SB(1, 1), b3 + hstep, voffB);
            PG8_WAIT_V(6); PG8_BAR; PG8_MMA(1, 1, At, B1); PG8_BAR;
            }
        }
        if constexpr (ALIGN_EPI) { if (wr == 0) PG8_BAR; }
#ifndef PROBE_EPI
#define PROBE_EPI 0
#endif
        bool keep_acc = false; if constexpr (!Epi::AFTER_DRAIN) { keep_acc = E(acc, cur, wr, wc, fr, fq); if constexpr (Epi::IDEMPOTENT && PROBE_EPI) { asm volatile("" ::: "memory"); keep_acc = E(acc, cur, wr, wc, fr, fq); } S.done(cur); }
        if (!has_next) break;
        if (!keep_acc) {
#pragma unroll
        for (int a = 0; a < 2; ++a)
#pragma unroll
            for (int b = 0; b < 2; ++b)
#pragma unroll
                for (int m = 0; m < 4; ++m)
#pragma unroll
                    for (int n = 0; n < 2; ++n) acc[a][b][m][n] = (f32x4){0.f, 0.f, 0.f, 0.f};
        }
        cur = nxt; cA = nA; cB = nB; ++ui;
        if constexpr (ALIGN_EPI) { if (wr == 1) PG8_BAR; }
    }
    PG8_WAIT_V(0);
    if constexpr (!ALIGN_EPI) { if (wr == 0) PG8_BAR; }
    PG8_BAR;
    if constexpr (Epi::AFTER_DRAIN) { E.fused(acc, cur, wr, wc, fr, fq, lds, wid, lane); S.done(cur); }
#undef PG8_SA
#undef PG8_SB
#undef PG8_STAGE
#undef PG8_LDA
#undef PG8_LDB
#undef PG8_MMA
#undef PG8_WAIT_V
#undef PG8_WAIT_L
#undef PG8_BAR
#undef PG8_SCHED
}
}

#define LAS __attribute__((address_space(3)))
typedef unsigned short bf16;
typedef float f32x4 __attribute__((ext_vector_type(4)));
typedef unsigned v4u __attribute__((ext_vector_type(4)));
constexpr int NWAVES = 8, NTHR = 512;
constexpr int MTOK = 32768, DM = 1024, SEQ = 2048, NBATCH = 16, NIN = 8192, DFF = 4096, HYW = 512, HALF_TOK = 16384;
constexpr size_t MiB = (size_t)1 << 20;
constexpr size_t WS_SSQA = 0, WS_SSQB = 2 * MiB, WS_ROPE = 4 * MiB, WS_RSTD = 4 * MiB + 512 * 1024, WS_BAR = 4 * MiB + 768 * 1024, WS_LSE = 5 * MiB, WS_GF = 8 * MiB, WS_W = 16 * MiB, WS_XB = 52 * MiB,
                 WS_HY = 116 * MiB, WS_UT = 212 * MiB, WS_GATES = 116 * MiB, WS_Q = 244 * MiB, WS_KV = 340 * MiB, WS_YHY = 436 * MiB, WS_YATT = 404 * MiB, WS_X0T = 468 * MiB,
                 WS_MERGED = 340 * MiB, WS_H = 116 * MiB, WS_END = 500 * MiB;
constexpr size_t W_IN = 0, W_PHY = 16 * MiB, W_PATT = 17 * MiB, W_O = 18 * MiB, W_FF1 = 20 * MiB, W_FF2 = 28 * MiB;
constexpr int LDS_RTAB = 131072;
constexpr int LDS_ST_OFF = 135168;
constexpr int LDS_BYTES = 139264;

struct Args {
    const float* in[19]; float* out; unsigned char* ws; int pad0, pad1;
};

__device__ __forceinline__ unsigned f2bf(float f) { unsigned u = __float_as_uint(f); return (u + 0x7fffu + ((u >> 16) & 1u)) >> 16; }
__device__ __forceinline__ unsigned pk2(float lo, float hi) { return f2bf(lo) | (f2bf(hi) << 16); }
__device__ __forceinline__ float bf2f(unsigned short b) { return __uint_as_float((unsigned)b << 16); }
__device__ __forceinline__ float wave_sum(float v) {
#pragma unroll
    for (int o = 1; o < 64; o <<= 1) v += __shfl_xor(v, o);
    return v;
}

__device__ __forceinline__ int win_src_col(int n) {
    const int t = n >> 8, j = n & 255;
    if (t < 6) return n;
    if (t >= 24) return 6144 + (n - 6144);
    int g, w, half;
    if (t < 12) { const int i = t - 6; g = i >> 1; w = 0; half = i & 1; }
    else { const int i = t - 12; g = i >> 2; w = 1 + ((i >> 1) & 1); half = i & 1; }
    int hh, d;
    if (w == 2) { hh = j >> 6; d = j & 63; }
    else { hh = (j & 127) >> 5; d = (j & 31) + ((j >> 7) << 5); }
    return 1536 + g * 1536 + w * 512 + (half * 4 + hh) * 64 + d;
}

__device__ __forceinline__ void transpose_item(const float* W, int K, int Nsrc, int s0, bf16* WT, int n0, int k0, const float* gain, LAS float* scr, int lane) {
    float tv[32];
#pragma unroll
    for (int i = 0; i < 32; ++i) { const int kk = 2 * i + (lane >> 5); tv[i] = W[(size_t)(k0 + kk) * Nsrc + s0 + (lane & 31)]; }
    const float gl = gain ? gain[k0 + lane] : 1.0f;
#pragma unroll
    for (int i = 0; i < 32; ++i) { const int kk = 2 * i + (lane >> 5); scr[kk * 33 + (lane & 31)] = tv[i] * __shfl(gl, kk); }
    asm volatile("s_waitcnt lgkmcnt(0)" ::: "memory");
    const int c = lane & 7;
#pragma unroll
    for (int j = 0; j < 4; ++j) { const int n = (lane >> 3) + 8 * j; const LAS float* s = scr + (8 * c) * 33 + n;
        v4u o; o.x = pk2(s[0 * 33], s[1 * 33]); o.y = pk2(s[2 * 33], s[3 * 33]); o.z = pk2(s[4 * 33], s[5 * 33]); o.w = pk2(s[6 * 33], s[7 * 33]);
        *(v4u*)(WT + (size_t)(n0 + n) * K + k0 + 8 * c) = o; }
    asm volatile("s_waitcnt lgkmcnt(0)" ::: "memory");
}

__device__ __forceinline__ void phase_prep_weights(const Args& a, int L, LAS unsigned char* lds, int tid, int lane, int wave, int G) {
    unsigned char* ws = a.ws;
    {
        const float* w1 = a.in[5] + (size_t)L * 33 * 64; const float* b1 = a.in[6] + L * 64;
        const float* wi = a.in[7] + (size_t)L * 2 * 64 * 64; const float* bi = a.in[8] + L * 2 * 64;
        const float* wout = a.in[9] + (size_t)L * 64 * 1024; const float* fr = a.in[10] + L * 64; const float* skip = a.in[11] + L * 512;
        bf16* Rg = (bf16*)(ws + WS_GF);
        const float min_decay = logf(1e-2f) / 1.5f, max_decay = logf(1e-2f) / 0.3f;
        LAS float* hb = (LAS float*)lds + wave * 64;
        LAS float* fbuf = (LAS float*)(lds + 4096);
        const float frl = fr[lane];
        LAS float* wl = (LAS float*)(lds + 40960);
        for (int i = tid; i < 528 + 2048; i += NTHR) { const f32x4 v = (i < 528) ? *((const f32x4*)w1 + i) : *((const f32x4*)wi + (i - 528)); *(LAS f32x4*)(wl + 4 * i) = v; }
        __syncthreads();
#ifndef PROBE_PWF
#define PROBE_PWF 0
#endif
#ifndef PROBE_PWT
#define PROBE_PWT 0
#endif
        _Pragma("unroll 1") for (int repf = 0; repf < 1 + PROBE_PWF; ++repf)
        for (int blk = blockIdx.x; blk < 256; blk += G) {
            int n = 8 * blk + wave + 1; if (n == 2048) n = 0;
            const float t = (float)n / 2047.0f;
            {
                float v = 0.f;
                if (lane == 0) v = t;
                else if (lane < 33) { const int k = (lane - 1) & 15; const float band = 1e-4f + (float)k * ((15.0f - 1e-4f) / 15.0f); const float ang = ((float)(2.0 * 3.14159265358979323846 / 2048.0) * (float)n) * band;
                       v = (lane <= 16) ? cosf(ang) : -sinf(ang); }
                hb[lane] = v;
            }
            float s = b1[lane];
#pragma unroll
            for (int e = 0; e < 33; ++e) s += hb[e] * wl[e * 64 + lane];
            float hcur = sinf(frl * s);
#pragma unroll 1
            for (int layer = 0; layer < 2; ++layer) {
                hb[lane] = hcur;
                float s2 = bi[layer * 64 + lane];
#pragma unroll
                for (int e = 0; e < 64; ++e) s2 += hb[e] * wl[2112 + layer * 4096 + e * 64 + lane];
                hcur = sinf(frl * s2);
            }
            LAS float* hT = (LAS float*)(lds + 2048);
            hT[lane * 8 + wave] = hcur;
            __syncthreads();
            float o[8][2];
#pragma unroll
            for (int p = 0; p < 8; ++p) { o[p][0] = 0.f; o[p][1] = 0.f; }
#pragma unroll 16
            for (int e0 = 0; e0 < 64; ++e0) {
                const int e = (e0 + 8 * ((blk >> 3) & 7)) & 63;
                const f32x4 ha = *(const LAS f32x4*)(hT + e * 8), hc = *(const LAS f32x4*)(hT + e * 8 + 4);
                const float w0 = wout[e * 1024 + 128 * wave + lane], w1v = wout[e * 1024 + 128 * wave + 64 + lane];
#pragma unroll
                for (int p = 0; p < 4; ++p) { o[p][0] += ha[p] * w0; o[p][1] += ha[p] * w1v; o[4 + p][0] += hc[p] * w0; o[4 + p][1] += hc[p] * w1v; }
            }
#pragma unroll
            for (int j = 0; j < 2; ++j) {
                const int col = 128 * wave + 64 * j + lane, c = col & 511;
                const float delta = fabsf(min_decay + (float)c * ((max_decay - min_decay) / 511.0f));
#pragma unroll
                for (int p = 0; p < 8; ++p) { int np = 8 * blk + p + 1; if (np == 2048) np = 0; const float tp = (float)np / 2047.0f; fbuf[p * 1024 + col] = o[p][j] * expf(-tp * delta); }
            }
            __syncthreads();
            if (blk != 255) {
                typedef unsigned u32x2v __attribute__((ext_vector_type(2)));
#pragma unroll
                for (int pp = 0; pp < 2; ++pp) {
                    const int p = tid + 512 * pp, c = p & 511, dir = p >> 9;
                    bf16* r0 = Rg + ((size_t)c * 2 + 0) * 4096; bf16* r1 = Rg + ((size_t)c * 2 + 1) * 4096;
                    unsigned e[8];
#pragma unroll
                    for (int j = 0; j < 8; ++j) e[j] = f2bf(fbuf[(dir ? j : 7 - j) * 1024 + dir * 512 + c]);
                    v4u w8; w8.x = e[0] | (e[1] << 16); w8.y = e[2] | (e[3] << 16); w8.z = e[4] | (e[5] << 16); w8.w = e[6] | (e[7] << 16);
                    if (dir == 0) {
                        const int xb0 = 2040 - 8 * blk;
                        *(v4u*)(r0 + xb0) = w8;
                        r1[xb0 - 1] = (bf16)e[0];
                        u32x2v m4; m4.x = e[1] | (e[2] << 16); m4.y = e[3] | (e[4] << 16); *(u32x2v*)(r1 + xb0) = m4;
                        *(unsigned*)(r1 + xb0 + 4) = e[5] | (e[6] << 16);
                        r1[xb0 + 6] = (bf16)e[7];
                    } else {
                        const int xa = 2049 + 8 * blk;
                        *(v4u*)(r1 + xa - 1) = w8;
                        r0[xa] = (bf16)e[0];
                        *(unsigned*)(r0 + xa + 1) = e[1] | (e[2] << 16);
                        u32x2v m4; m4.x = e[3] | (e[4] << 16); m4.y = e[5] | (e[6] << 16); *(u32x2v*)(r0 + xa + 3) = m4;
                        r0[xa + 7] = (bf16)e[7];
                    }
                }
            } else
#pragma unroll
            for (int pp = 0; pp < 2; ++pp) {
                const int p = tid + 512 * pp, c = p & 511, dir = p >> 9;
                bf16* r0 = Rg + ((size_t)c * 2 + 0) * 4096; bf16* r1 = Rg + ((size_t)c * 2 + 1) * 4096;
#pragma unroll
                for (int wv = 0; wv < 8; ++wv) {
                    int nn = 8 * blk + wv + 1; float val = fbuf[wv * 1024 + dir * 512 + c]; int x;
                    if (nn == 2048) { if (dir != 0) continue; val += skip[c]; x = 2048; }
                    else x = dir ? 2048 + nn : 2048 - nn;
                    const bf16 hv = (bf16)f2bf(val); r0[x] = hv; r1[x - 1] = hv;
                }
            }
            __syncthreads();
        }
    }
    {
        LAS float* scr = (LAS float*)(lds + 40960 + wave * 8704);
        const int gw = blockIdx.x * NWAVES + wave, NGW = G * NWAVES;
        bf16* Wb = (bf16*)(ws + WS_W);
        const float* w_in = a.in[2] + (size_t)L * DM * NIN; const float* p_hy = a.in[12] + (size_t)L * 512 * DM; const float* p_att = a.in[13] + (size_t)L * 512 * DM;
        const float* w_o = a.in[14] + (size_t)L * DM * DM; const float* w1 = a.in[16] + (size_t)L * DM * DFF; const float* w2 = a.in[17] + (size_t)L * DFF * DM;
        const float* g_mix = a.in[1] + L * DM; const float* g_ffn = a.in[15] + L * DM;
        constexpr int I_IN = 16 * 256, I_P = 8 * 32, I_O = 16 * 32, I_1 = 16 * 128, I_2 = 64 * 32;
        constexpr int NITEMS = I_IN + 2 * I_P + I_O + I_1 + I_2;
        _Pragma("unroll 1") for (int rept = 0; rept < 1 + PROBE_PWT; ++rept)
        for (int it = gw; it < NITEMS; it += NGW) {
            int r = it;
            if (r < I_IN) { const int kb = r / 256, nb = r % 256; transpose_item(w_in, DM, NIN, win_src_col(nb * 32), Wb + W_IN / 2, nb * 32, kb * 64, g_mix, scr, lane); continue; } r -= I_IN;
            if (r < I_P) { const int kb = r / 32, nb = r % 32; transpose_item(p_hy, 512, DM, nb * 32, Wb + W_PHY / 2, nb * 32, kb * 64, nullptr, scr, lane); continue; } r -= I_P;
            if (r < I_P) { const int kb = r / 32, nb = r % 32; transpose_item(p_att, 512, DM, nb * 32, Wb + W_PATT / 2, nb * 32, kb * 64, nullptr, scr, lane); continue; } r -= I_P;
            if (r < I_O) { const int kb = r / 32, nb = r % 32; transpose_item(w_o, DM, DM, nb * 32, Wb + W_O / 2, nb * 32, kb * 64, nullptr, scr, lane); continue; } r -= I_O;
            if (r < I_1) { const int kb = r / 128, nb = r % 128; transpose_item(w1, DM, DFF, nb * 32, Wb + W_FF1 / 2, nb * 32, kb * 64, g_ffn, scr, lane); continue; } r -= I_1;
            { const int kb = r / 32, nb = r % 32; transpose_item(w2, DFF, DM, nb * 32, Wb + W_FF2 / 2, nb * 32, kb * 64, nullptr, scr, lane); }
        }
        if (L == 0) {
            const float* x = a.in[0]; bf16* xb = (bf16*)(ws + WS_XB); float* ssq = (float*)(ws + WS_SSQA);
            for (int m0 = gw; m0 < MTOK; m0 += 4 * NGW) {
                f32x4 v[4][4];
#pragma unroll
                for (int rr = 0; rr < 4; ++rr) { const f32x4* xr = (const f32x4*)(x + (size_t)(m0 + rr * NGW) * DM) + lane;
#pragma unroll
                    for (int j = 0; j < 4; ++j) v[rr][j] = xr[64 * j]; }
#pragma unroll
                for (int rr = 0; rr < 4; ++rr) { const int m = m0 + rr * NGW; float s = 0.f;
#pragma unroll
                    for (int j = 0; j < 4; ++j) s += (v[rr][j][0] * v[rr][j][0] + v[rr][j][1] * v[rr][j][1]) + (v[rr][j][2] * v[rr][j][2] + v[rr][j][3] * v[rr][j][3]);
                    s = wave_sum(s);
                    unsigned long long* o8 = (unsigned long long*)(xb + (size_t)m * DM) + lane;
#pragma unroll
                    for (int j = 0; j < 4; ++j) o8[64 * j] = (unsigned long long)pk2(v[rr][j][0], v[rr][j][1]) | ((unsigned long long)pk2(v[rr][j][2], v[rr][j][3]) << 32);
                    if (lane < 16) ssq[(size_t)m * 16 + lane] = (lane == 0) ? s : 0.f; }
            }
            float* rc = (float*)(ws + WS_ROPE); float* rsn = rc + 65536;
            for (int i = blockIdx.x * NTHR + tid; i < 65536; i += G * NTHR) {
                const int pos = i >> 5, f = i & 31;
                const float inv = powf(10000.0f, -(float)f / 32.0f);
                const float ang = (float)pos * inv;
                rc[i] = cosf(ang); rsn[i] = sinf(ang);
            }
        }
    }
}

__device__ __forceinline__ float bfe(const v4u& w, int e) { const unsigned d = (e >> 1) == 0 ? w.x : ((e >> 1) == 1 ? w.y : ((e >> 1) == 2 ? w.z : w.w)); return (e & 1) ? __uint_as_float(d & 0xffff0000u) : __uint_as_float(d << 16); }
__device__ __forceinline__ void phase_prep_u(const Args& a, int L, LAS unsigned char* lds, int tid, int G) {
    const bf16* hy = (const bf16*)(a.ws + WS_HY); bf16* ut = (bf16*)(a.ws + WS_UT); bf16* x0t = (bf16*)(a.ws + WS_X0T);
    const float* cw = a.in[3] + (size_t)L * 3 * 1536; const float* cb = a.in[4] + L * 1536;
    LAS unsigned short* tile = (LAS unsigned short*)lds;
    const int cc = blockIdx.x & 7, ml = tid >> 3, cg8 = tid & 7, c0 = cc * 64 + cg8 * 8;
    float wq[3][4][8];
#pragma unroll
    for (int ar = 0; ar < 3; ++ar)
#pragma unroll
        for (int e = 0; e < 8; ++e) { wq[ar][0][e] = cw[ar * 512 + c0 + e]; wq[ar][1][e] = cw[1536 + ar * 512 + c0 + e]; wq[ar][2][e] = cw[3072 + ar * 512 + c0 + e]; wq[ar][3][e] = cb[ar * 512 + c0 + e]; }
    v4u dn[3][3];
    const v4u zero = (v4u){0u, 0u, 0u, 0u};
#define PU_LOAD(it_) do { const int m_ = ((it_) & 31) * 64 + ml; const bf16* r_ = hy + (size_t)(((it_) >> 5) * SEQ + m_) * 1536 + c0; \
        _Pragma("unroll") for (int ar_ = 0; ar_ < 3; ++ar_) { dn[ar_][0] = (m_ > 0) ? *(const v4u*)(r_ - 1536 + ar_ * 512) : zero; dn[ar_][1] = *(const v4u*)(r_ + ar_ * 512); \
            dn[ar_][2] = (m_ < SEQ - 1) ? *(const v4u*)(r_ + 1536 + ar_ * 512) : zero; } } while (0)
    if ((int)(blockIdx.x >> 3) < 512) PU_LOAD((int)(blockIdx.x >> 3));
    for (int it = blockIdx.x >> 3; it < 512; it += (G >> 3)) {
        const int mc = it & 31, b = it >> 5;
        v4u d[3][3];
#pragma unroll
        for (int ar = 0; ar < 3; ++ar) { d[ar][0] = dn[ar][0]; d[ar][1] = dn[ar][1]; d[ar][2] = dn[ar][2]; }
        if (it + (G >> 3) < 512) PU_LOAD(it + (G >> 3));
#pragma unroll
        for (int e = 0; e < 8; ++e) {
            float cv[3];
#pragma unroll
            for (int ar = 0; ar < 3; ++ar) cv[ar] = wq[ar][3][e] + wq[ar][0][e] * bfe(d[ar][0], e) + wq[ar][1][e] * bfe(d[ar][1], e) + wq[ar][2][e] * bfe(d[ar][2], e);
            tile[(cg8 * 8 + e) * 72 + ml] = (unsigned short)f2bf(cv[1] * cv[2]);
            tile[4608 + (cg8 * 8 + e) * 72 + ml] = (unsigned short)f2bf(cv[0]);
        }
        __syncthreads();
        {
            const int c2 = tid >> 3, ch = tid & 7;
            const LAS unsigned* s = (const LAS unsigned*)(tile + c2 * 72 + ch * 8);
            v4u o; o.x = s[0]; o.y = s[1]; o.z = s[2]; o.w = s[3];
            *(v4u*)(ut + ((size_t)(cc * 64 + c2) * NBATCH + b) * SEQ + mc * 64 + ch * 8) = o;
            const LAS unsigned* s2 = s + 2304;
            v4u o2; o2.x = s2[0]; o2.y = s2[1]; o2.z = s2[2]; o2.w = s2[3];
            *(v4u*)(x0t + ((size_t)(cc * 64 + c2) * NBATCH + b) * SEQ + mc * 64 + ch * 8) = o2;
        }
        __syncthreads();
    }
}

__device__ __forceinline__ void phase_hyena_naive(const Args& a, int L, LAS unsigned char* lds, int tid, int G) {
    const bf16* hy = (const bf16*)(a.ws + WS_HY); const bf16* ut = (const bf16*)(a.ws + WS_UT); const float* Gf = (const float*)(a.ws + WS_GF);
    bf16* yhy = (bf16*)(a.ws + WS_YHY);
    const float* cw = a.in[3] + (size_t)L * 3 * 1536; const float* cb = a.in[4] + L * 1536;
    LAS float* Gs = (LAS float*)lds;
    LAS float* Us = Gs + 4096;
    for (int item = blockIdx.x; item < 2048; item += G) {
        const int c = item >> 2, bq = item & 3;
        for (int i = tid; i < 4096; i += NTHR) Gs[i] = (i == 0) ? 0.f : Gf[(size_t)c * 4096 + i];
        for (int i = tid; i < 8192; i += NTHR) { const int bl = i >> 11, m = i & 2047; Us[i] = bf2f(ut[((size_t)c * NBATCH + bq * 4 + bl) * SEQ + m]); }
        __syncthreads();
        const int bl = tid >> 7, tn = tid & 127;
        float acc[16];
#pragma unroll
        for (int i = 0; i < 16; ++i) acc[i] = 0.f;
        const LAS float* up = Us + bl * 2048;
        for (int m = 0; m < SEQ; ++m) {
            const float u = up[m];
            const LAS float* gp = Gs + (tn - m + 2048);
#pragma unroll
            for (int i = 0; i < 16; ++i) acc[i] += gp[128 * i] * u;
        }
        const int b = bq * 4 + bl;
        const float w0 = cw[c], w1 = cw[1536 + c], w2 = cw[3072 + c], b0 = cb[c];
#pragma unroll
        for (int i = 0; i < 16; ++i) {
            const int n = tn + 128 * i;
            const bf16* r = hy + (size_t)(b * SEQ + n) * 1536 + c;
            const float xm = (n > 0) ? bf2f(r[-1536]) : 0.f, xc = bf2f(r[0]), xp = (n < SEQ - 1) ? bf2f(r[1536]) : 0.f;
            const float x0 = b0 + w0 * xm + w1 * xc + w2 * xp;
            yhy[(size_t)(b * SEQ + n) * 512 + c] = (bf16)f2bf(x0 * acc[i]);
        }
        __syncthreads();
    }
}

__device__ __forceinline__ void phase_attn_naive(const Args& a, int half, int tid, int G) {
    bf16* Q = (bf16*)(a.ws + WS_Q); const bf16* KV = (const bf16*)(a.ws + WS_KV); float* lse = (float*)(a.ws + WS_LSE);
    for (int idx = blockIdx.x * NTHR + tid; idx < 3 * 8 * HALF_TOK; idx += G * NTHR) {
        const int g = idx / (8 * HALF_TOK), t = idx % (8 * HALF_TOK), h = t / HALF_TOK, tokl = t % HALF_TOK;
        const int dil = (g == 0) ? 1 : (g == 1 ? 4 : 16);
        const int token = half * HALF_TOK + tokl, s = token & 2047;
        bf16* qp = Q + (size_t)token * 1536 + g * 512 + h * 64;
        float q[64], o[64];
#pragma unroll
        for (int i = 0; i < 8; ++i) { const v4u w = *(const v4u*)(qp + 8 * i);
            q[8 * i + 0] = __uint_as_float(w.x << 16); q[8 * i + 1] = __uint_as_float(w.x & 0xffff0000u); q[8 * i + 2] = __uint_as_float(w.y << 16); q[8 * i + 3] = __uint_as_float(w.y & 0xffff0000u);
            q[8 * i + 4] = __uint_as_float(w.z << 16); q[8 * i + 5] = __uint_as_float(w.z & 0xffff0000u); q[8 * i + 6] = __uint_as_float(w.w << 16); q[8 * i + 7] = __uint_as_float(w.w & 0xffff0000u); }
#pragma unroll
        for (int i = 0; i < 64; ++i) o[i] = 0.f;
        float mx = -1e30f, l = 0.f;
        for (int j = -64; j <= 64; ++j) {
            const int sp = s + j * dil;
            if (sp < 0 || sp >= SEQ) continue;
            const bf16* kp = KV + (size_t)(tokl + j * dil) * 3072 + g * 1024 + h * 64;
            float sc = 0.f;
#pragma unroll
            for (int i = 0; i < 8; ++i) { const v4u w = *(const v4u*)(kp + 8 * i);
                sc += q[8 * i + 0] * __uint_as_float(w.x << 16) + q[8 * i + 1] * __uint_as_float(w.x & 0xffff0000u) + q[8 * i + 2] * __uint_as_float(w.y << 16) + q[8 * i + 3] * __uint_as_float(w.y & 0xffff0000u)
                    + q[8 * i + 4] * __uint_as_float(w.z << 16) + q[8 * i + 5] * __uint_as_float(w.z & 0xffff0000u) + q[8 * i + 6] * __uint_as_float(w.w << 16) + q[8 * i + 7] * __uint_as_float(w.w & 0xffff0000u); }
            const float mn = fmaxf(mx, sc), corr = exp2f(mx - mn), p = exp2f(sc - mn);
            l = l * corr + p; mx = mn;
            const bf16* vp = kp + 512;
#pragma unroll
            for (int i = 0; i < 8; ++i) { const v4u w = *(const v4u*)(vp + 8 * i);
                o[8 * i + 0] = o[8 * i + 0] * corr + p * __uint_as_float(w.x << 16); o[8 * i + 1] = o[8 * i + 1] * corr + p * __uint_as_float(w.x & 0xffff0000u);
                o[8 * i + 2] = o[8 * i + 2] * corr + p * __uint_as_float(w.y << 16); o[8 * i + 3] = o[8 * i + 3] * corr + p * __uint_as_float(w.y & 0xffff0000u);
                o[8 * i + 4] = o[8 * i + 4] * corr + p * __uint_as_float(w.z << 16); o[8 * i + 5] = o[8 * i + 5] * corr + p * __uint_as_float(w.z & 0xffff0000u);
                o[8 * i + 6] = o[8 * i + 6] * corr + p * __uint_as_float(w.w << 16); o[8 * i + 7] = o[8 * i + 7] * corr + p * __uint_as_float(w.w & 0xffff0000u); }
        }
        const float inv = 1.0f / l;
#pragma unroll
        for (int i = 0; i < 8; ++i) { v4u w; w.x = pk2(o[8 * i] * inv, o[8 * i + 1] * inv); w.y = pk2(o[8 * i + 2] * inv, o[8 * i + 3] * inv); w.z = pk2(o[8 * i + 4] * inv, o[8 * i + 5] * inv); w.w = pk2(o[8 * i + 6] * inv, o[8 * i + 7] * inv);
            *(v4u*)(qp + 8 * i) = w; }
        lse[((size_t)g * MTOK + token) * 8 + h] = mx + log2f(l);
    }
}

__device__ __forceinline__ void phase_combine(const Args& a, int tid, int G) {
    const bf16* Q = (const bf16*)(a.ws + WS_Q); const float* lse = (const float*)(a.ws + WS_LSE); bf16* ya = (bf16*)(a.ws + WS_YATT);
    const int stride = G * NTHR;
    for (int idx0 = blockIdx.x * NTHR + tid; idx0 < MTOK * 64; idx0 += 4 * stride) {
        float l0[4], l1[4], l2[4]; v4u a0[4], a1[4], a2[4];
#pragma unroll
        for (int j = 0; j < 4; ++j) { int idx = idx0 + j * stride; if (idx >= MTOK * 64) idx = idx0; const int token = idx >> 6, ch = idx & 63, h = ch >> 3;
            l0[j] = lse[((size_t)0 * MTOK + token) * 8 + h]; l1[j] = lse[((size_t)1 * MTOK + token) * 8 + h]; l2[j] = lse[((size_t)2 * MTOK + token) * 8 + h];
            const bf16* p = Q + (size_t)token * 1536 + ch * 8;
            a0[j] = *(const v4u*)p; a1[j] = *(const v4u*)(p + 512); a2[j] = *(const v4u*)(p + 1024); }
#pragma unroll
        for (int j = 0; j < 4; ++j) { const int idx = idx0 + j * stride; if (idx >= MTOK * 64) continue; const int token = idx >> 6, ch = idx & 63;
            const float mx = fmaxf(l0[j], fmaxf(l1[j], l2[j]));
            float w0 = exp2f(l0[j] - mx), w1 = exp2f(l1[j] - mx), w2 = exp2f(l2[j] - mx);
            const float inv = 1.0f / (w0 + w1 + w2); w0 *= inv; w1 *= inv; w2 *= inv;
            v4u o;
#define CMB(f) pk2(w0 * __uint_as_float(a0[j].f << 16) + w1 * __uint_as_float(a1[j].f << 16) + w2 * __uint_as_float(a2[j].f << 16), \
                   w0 * __uint_as_float(a0[j].f & 0xffff0000u) + w1 * __uint_as_float(a1[j].f & 0xffff0000u) + w2 * __uint_as_float(a2[j].f & 0xffff0000u))
            o.x = CMB(x); o.y = CMB(y); o.z = CMB(z); o.w = CMB(w);
#undef CMB
            *(v4u*)(ya + (size_t)token * 512 + ch * 8) = o; }
    }
}

__device__ __forceinline__ void phase_final_norm(const Args& a, int lane, int wave, int G) {
    float* out = a.out; const float* gain = a.in[18]; const bf16* xb = (const bf16*)(a.ws + WS_XB);
    const int gw = blockIdx.x * NWAVES + wave, NGW = G * NWAVES;
    typedef unsigned u32x2v __attribute__((ext_vector_type(2)));
    f32x4 gn[4];
#pragma unroll
    for (int j = 0; j < 4; ++j) gn[j] = *((const f32x4*)gain + lane + 64 * j);
    for (int m0 = gw; m0 < MTOK; m0 += 4 * NGW) {
        u32x2v w[4][4];
#pragma unroll
        for (int rr = 0; rr < 4; ++rr) { const int m = (m0 + rr * NGW < MTOK) ? m0 + rr * NGW : m0; const u32x2v* xr = (const u32x2v*)(xb + (size_t)m * DM) + lane;
#pragma unroll
            for (int j = 0; j < 4; ++j) w[rr][j] = xr[64 * j]; }
#pragma unroll
        for (int rr = 0; rr < 4; ++rr) { const int m = m0 + rr * NGW; if (m >= MTOK) continue;
            f32x4 v[4]; float s = 0.f;
#pragma unroll
            for (int j = 0; j < 4; ++j) { v[j] = (f32x4){__uint_as_float(w[rr][j].x << 16), __uint_as_float(w[rr][j].x & 0xffff0000u), __uint_as_float(w[rr][j].y << 16), __uint_as_float(w[rr][j].y & 0xffff0000u)};
                s += (v[j][0] * v[j][0] + v[j][1] * v[j][1]) + (v[j][2] * v[j][2] + v[j][3] * v[j][3]); }
            s = wave_sum(s);
            const float rs = 1.0f / sqrtf(s * (1.0f / 1024.0f) + 1e-6f);
            f32x4* orow = (f32x4*)(out + (size_t)m * DM) + lane;
#pragma unroll
            for (int j = 0; j < 4; ++j) orow[64 * j] = v[j] * rs * gn[j]; }
    }
}

typedef short bf16x8 __attribute__((ext_vector_type(8)));
typedef short s16x4 __attribute__((ext_vector_type(4)));
constexpr int HY_UROW = 4112, HY_ROFF = 16 * HY_UROW, HY_RSTRIDE = 8192 + 64;
__device__ __forceinline__ bf16x8 ld_frag4(const LAS unsigned char* p) {
    const LAS unsigned* q = (const LAS unsigned*)p; v4u d; d.x = q[0]; d.y = q[1]; d.z = q[2]; d.w = q[3]; return __builtin_bit_cast(bf16x8, d);
}
__device__ __forceinline__ void phase_hyena_mfma(const Args& a, LAS unsigned char* lds, int tid, int G, bool dummy = false) {
    const bf16* ut = (const bf16*)(a.ws + WS_UT); const bf16* Rg = (const bf16*)(a.ws + WS_GF); bf16* x0t = (bf16*)(a.ws + WS_X0T);
    const int lane = tid & 63, w = __builtin_amdgcn_readfirstlane(tid >> 6), i16 = lane & 15, kq = lane >> 4;
    const int base = (w >> 1) * 512 + (w & 1) * 16, cp = i16 & 1;
    const int lane_const = (2048 - base - i16 + 8 * kq - cp) >> 1;
    const LAS unsigned char* pA15 = lds + HY_ROFF + cp * HY_RSTRIDE + 4 * (lane_const - 240);
    const LAS unsigned char* pB = lds + i16 * HY_UROW + kq * 16;
    v4u pre[10];
#define HY_ISSUE(chn) do { _Pragma("unroll") for (int k_ = 0; k_ < 8; ++k_) { const int i_ = tid + NTHR * k_, b_ = i_ >> 8, ck_ = i_ & 255; pre[k_] = *(const v4u*)(ut + ((size_t)(chn) * NBATCH + b_) * SEQ + ck_ * 8); } \
        _Pragma("unroll") for (int k_ = 0; k_ < 2; ++k_) { const int i_ = tid + NTHR * k_, c2_ = i_ >> 9, ck_ = i_ & 511; pre[8 + k_] = *(const v4u*)(Rg + ((size_t)(chn) * 2 + c2_) * 4096 + ck_ * 8); } } while (0)
    for (int ch = blockIdx.x; ch < HYW; ch += G) {
        HY_ISSUE(ch);
#pragma unroll
        for (int k = 0; k < 8; ++k) { const int i = tid + NTHR * k, b = i >> 8, ck = i & 255; *(LAS v4u*)(lds + b * HY_UROW + ck * 16) = pre[k]; }
#pragma unroll
        for (int k = 0; k < 2; ++k) { const int i = tid + NTHR * k, c2 = i >> 9, ck = i & 511; *(LAS v4u*)(lds + HY_ROFF + c2 * HY_RSTRIDE + ck * 16) = pre[8 + k]; }
        __syncthreads();
        f32x4 acc[16]; bf16x8 W[16];
#pragma unroll
        for (int i = 0; i < 16; ++i) acc[i] = (f32x4){0.f, 0.f, 0.f, 0.f};
#pragma unroll
        for (int j = 1; j < 16; ++j) W[j] = ld_frag4(pA15 + 64 * (15 - j));
        W[0] = W[1];
#pragma unroll 1
        for (int tt = 0; tt < 4; ++tt) {
            const LAS unsigned char* pa = pA15 + 64 * 15 + 1024 * tt; const LAS unsigned char* pb = pB + 1024 * tt;
#pragma unroll
            for (int s = 0; s < 16; ++s) {
                W[(16 - s) & 15] = ld_frag4(pa + 64 * s);
                const bf16x8 Bf = *(const LAS bf16x8*)(pb + 64 * s);
#pragma unroll
                for (int i = 0; i < 16; ++i) acc[i] = __builtin_amdgcn_mfma_f32_16x16x32_bf16(W[(i - s) & 15], Bf, acc[i], 0, 0, 0);
            }
        }
        bf16* xo = x0t + ((size_t)ch * NBATCH + i16) * SEQ + base + 4 * kq;
        typedef unsigned u32x2v __attribute__((ext_vector_type(2)));
        u32x2v xall[16];
#pragma unroll
        for (int i = 0; i < 16; ++i) xall[i] = *(const u32x2v*)(xo + 32 * i);
#pragma unroll
        for (int i = 0; i < 16; ++i) {
            const u32x2v xv = xall[i];
            u32x2v o; o.x = pk2(__uint_as_float(xv.x << 16) * acc[i][0], __uint_as_float(xv.x & 0xffff0000u) * acc[i][1]);
            o.y = pk2(__uint_as_float(xv.y << 16) * acc[i][2], __uint_as_float(xv.y & 0xffff0000u) * acc[i][3]);
            if (!dummy) *(u32x2v*)(xo + 32 * i) = o; else *(u32x2v*)((bf16*)(a.ws + WS_YHY) + (size_t)tid * 64 + 4 * i) = o;
        }
        __syncthreads();
    }
}

__device__ __forceinline__ void phase_transpose_y(const Args& a, LAS unsigned char* lds, int tid, int G) {
    const bf16* yt = (const bf16*)(a.ws + WS_X0T); bf16* yhy = (bf16*)(a.ws + WS_YHY);
    LAS unsigned short* tile = (LAS unsigned short*)lds;
#define TY_LOAD(item_) (*(const v4u*)(yt + ((size_t)(((item_) & 7) * 64 + (tid >> 3)) * NBATCH + ((item_) >> 8)) * SEQ + (((item_) >> 3) & 31) * 64 + (tid & 7) * 8))
    v4u vnext = (v4u){0u, 0u, 0u, 0u};
    if ((int)blockIdx.x < 4096) vnext = TY_LOAD((int)blockIdx.x);
    for (int item = blockIdx.x; item < 4096; item += G) {
        const int cc = item & 7, mc = (item >> 3) & 31, b = item >> 8;
        { const int c2 = tid >> 3, ck = tid & 7;
          const v4u v = vnext;
          LAS unsigned* t4 = (LAS unsigned*)(tile + c2 * 72 + ck * 8); t4[0] = v.x; t4[1] = v.y; t4[2] = v.z; t4[3] = v.w; }
        __syncthreads();
        if (item + G < 4096) vnext = TY_LOAD(item + G);
        { const int nl = tid >> 3, cg8 = tid & 7; const LAS unsigned short* s = tile + (cg8 * 8) * 72 + nl;
          v4u o; o.x = s[0] | ((unsigned)s[72] << 16); o.y = s[144] | ((unsigned)s[216] << 16); o.z = s[288] | ((unsigned)s[360] << 16); o.w = s[432] | ((unsigned)s[504] << 16);
          *(v4u*)(yhy + (size_t)(b * SEQ + mc * 64 + nl) * 512 + cc * 64 + cg8 * 8) = o; }
        __syncthreads();
    }
}

constexpr int AT_ROWS = 272, AT_RS = 144, AT_VOFF = AT_ROWS * AT_RS;
__device__ __forceinline__ void phase_attn_mfma(const Args& a, int half, LAS unsigned char* lds, int tid, int G, bool dummy = false) {
    bf16* Q = (bf16*)(a.ws + WS_Q); const bf16* KV = (const bf16*)(a.ws + WS_KV); float* lse = (float*)(a.ws + WS_LSE);
    const int lane = tid & 63, w = __builtin_amdgcn_readfirstlane(tid >> 6), q16 = lane & 15, kq = lane >> 4;
    v4u pre[9]; bf16x8 Qn0, Qn1;
#define AT_DECODE(unit_) const int g = (unit_) >> 10, u = (unit_) & 1023, sub = u & 15, h = (u >> 4) & 7, bl = u >> 7; int dil, n, r, qb; \
        if (g == 0) { dil = 1; n = 2048; r = 0; qb = sub; } else if (g == 1) { dil = 4; n = 512; r = sub >> 2; qb = sub & 3; } else { dil = 16; n = 128; r = sub; qb = 0; } \
        const int q0 = qb * 128, kb0 = q0 - 64; (void)kb0; (void)q0;
#define AT_ISSUE(unit_, PRE_, QN0_, QN1_) do { AT_DECODE(unit_) { const bf16* qn_ = Q + (size_t)(half * HALF_TOK + bl * SEQ + (q0 + 16 * w + q16) * dil + r) * 1536 + g * 512 + h * 64; QN0_ = *(const bf16x8*)(qn_ + 8 * kq); QN1_ = *(const bf16x8*)(qn_ + 32 + 8 * kq); } \
        _Pragma("unroll") for (int k_ = 0; k_ < 9; ++k_) { const int i_ = tid + NTHR * k_; \
            const int which_ = (i_ >= AT_ROWS * 8) ? 1 : 0, j_ = i_ - which_ * AT_ROWS * 8, rr_ = j_ >> 3, ck_ = j_ & 7, key_ = kb0 + rr_; \
            PRE_[k_] = (v4u){0u, 0u, 0u, 0u}; \
            if (i_ < 2 * AT_ROWS * 8 && key_ >= 0 && key_ < n) PRE_[k_] = *(const v4u*)(KV + (size_t)(bl * SEQ + key_ * dil + r) * 3072 + g * 1024 + which_ * 512 + h * 64 + ck_ * 8); } } while (0)
    const int vb = ((G & 7) == 0) ? (int)((blockIdx.x & 7) * (G >> 3) + (blockIdx.x >> 3)) : (int)blockIdx.x;
#define AT_STEP(UNIT_, PRE_, QN0_, QN1_) do { \
_Pragma("unroll") \
        for (int k = 0; k < 9; ++k) { const int i = tid + NTHR * k; const int which = (i >= AT_ROWS * 8) ? 1 : 0, j = i - which * AT_ROWS * 8, rr = j >> 3, ck = j & 7; \
            if (i < 2 * AT_ROWS * 8) *(LAS v4u*)(lds + which * AT_VOFF + rr * AT_RS + ck * 16) = PRE_[k]; } \
        const bf16x8 Qf0 = QN0_, Qf1 = QN1_; \
        __syncthreads(); \
        if (UNIT_ + 2 * G < 3072) AT_ISSUE(UNIT_ + 2 * G, PRE_, QN0_, QN1_); \
        AT_DECODE(UNIT_) \
        { \
            const int i0 = q0 + 16 * w; \
            const int token = half * HALF_TOK + bl * SEQ + (i0 + q16) * dil + r; \
            bf16* qp = Q + (size_t)token * 1536 + g * 512 + h * 64; \
            bf16* op = dummy ? (bf16*)(a.ws + WS_YHY) + (size_t)(tid & 511) * 64 : qp; \
            f32x4 acc[4]; \
_Pragma("unroll") \
            for (int dt = 0; dt < 4; ++dt) acc[dt] = (f32x4){0.f, 0.f, 0.f, 0.f}; \
            const bool edge = (i0 < 64) || (i0 + 80 > n); \
            const LAS unsigned char* kbase = lds + (16 * w + q16) * AT_RS + 16 * kq; \
            const LAS unsigned char* vbase = lds + AT_VOFF + (16 * w + 4 * kq + (q16 >> 2)) * AT_RS + 8 * (q16 & 3); \
            f32x4 s[9]; \
_Pragma("unroll") \
            for (int kt = 0; kt < 9; ++kt) { \
                const LAS unsigned char* kp = kbase + kt * 16 * AT_RS; \
                const bf16x8 K0 = *(const LAS bf16x8*)kp, K1 = *(const LAS bf16x8*)(kp + 64); \
                f32x4 z = (f32x4){0.f, 0.f, 0.f, 0.f}; \
                z = __builtin_amdgcn_mfma_f32_16x16x32_bf16(K0, Qf0, z, 0, 0, 0); \
                z = __builtin_amdgcn_mfma_f32_16x16x32_bf16(K1, Qf1, z, 0, 0, 0); \
                if (kt == 0 || kt == 8 || edge) { \
_Pragma("unroll") \
                    for (int e = 0; e < 4; ++e) { \
                        const int rel = 16 * kt - 64 + 4 * kq + e - q16, j = i0 + q16 + rel; \
                        const bool ok = (rel >= -64) && (rel <= 64) && (j >= 0) && (j < n); \
                        z[e] = ok ? z[e] : -1e30f; \
                    } } \
                s[kt] = z; \
            } \
            float mrun = -1e30f; \
_Pragma("unroll") \
            for (int kt = 0; kt < 9; ++kt) mrun = fmaxf(mrun, fmaxf(fmaxf(s[kt][0], s[kt][1]), fmaxf(s[kt][2], s[kt][3]))); \
            mrun = fmaxf(mrun, __shfl_xor(mrun, 16)); mrun = fmaxf(mrun, __shfl_xor(mrun, 32)); \
            float lrun = 0.f; \
_Pragma("unroll") \
            for (int kt = 0; kt < 9; ++kt) \
_Pragma("unroll") \
                for (int e = 0; e < 4; ++e) { s[kt][e] = __builtin_amdgcn_exp2f(s[kt][e] - mrun); lrun += s[kt][e]; } \
_Pragma("unroll") \
            for (int st = 0; st < 5; ++st) { \
                v4u pw; pw.x = pg8::cvt_pk_bf16(s[2 * st][0], s[2 * st][1]); pw.y = pg8::cvt_pk_bf16(s[2 * st][2], s[2 * st][3]); \
                if (st < 4) { pw.z = pg8::cvt_pk_bf16(s[2 * st + 1][0], s[2 * st + 1][1]); pw.w = pg8::cvt_pk_bf16(s[2 * st + 1][2], s[2 * st + 1][3]); } else { pw.z = 0u; pw.w = 0u; } \
                const bf16x8 Pf = __builtin_bit_cast(bf16x8, pw); \
_Pragma("unroll") \
                for (int dt = 0; dt < 4; ++dt) { \
                    const LAS unsigned char* vp = vbase + 32 * st * AT_RS + 32 * dt; \
                    const s16x4 v0 = __builtin_amdgcn_ds_read_tr16_b64_v4i16((LAS s16x4*)vp); \
                    const s16x4 v1 = __builtin_amdgcn_ds_read_tr16_b64_v4i16((LAS s16x4*)(vp + 16 * AT_RS)); \
                    const bf16x8 Vf = (bf16x8){v0[0], v0[1], v0[2], v0[3], v1[0], v1[1], v1[2], v1[3]}; \
                    acc[dt] = __builtin_amdgcn_mfma_f32_16x16x32_bf16(Vf, Pf, acc[dt], 0, 0, 0); \
                } \
            } \
            lrun += __shfl_xor(lrun, 16); lrun += __shfl_xor(lrun, 32); \
            const float inv = 1.0f / lrun; \
            typedef unsigned u32x2v __attribute__((ext_vector_type(2))); \
_Pragma("unroll") \
            for (int dt = 0; dt < 4; ++dt) { \
                u32x2v o; o.x = pg8::cvt_pk_bf16(acc[dt][0] * inv, acc[dt][1] * inv); o.y = pg8::cvt_pk_bf16(acc[dt][2] * inv, acc[dt][3] * inv); \
                *(u32x2v*)(op + 16 * dt + 4 * kq) = o; \
            } \
            if (kq == 0 && !dummy) lse[((size_t)g * MTOK + token) * 8 + h] = mrun + log2f(lrun); \
        } \
        __syncthreads(); \
    } while (0)
    v4u preB[9]; bf16x8 QnB0, QnB1;
    if (vb < 3072) AT_ISSUE(vb, pre, Qn0, Qn1);
    if (vb + G < 3072) AT_ISSUE(vb + G, preB, QnB0, QnB1);
    for (int unit = vb; unit < 3072; unit += 2 * G) {
        AT_STEP(unit, pre, Qn0, Qn1);
        if (unit + G < 3072) AT_STEP(unit + G, preB, QnB0, QnB1);
    }
}

#define XB_TMO      128
#define XB_XCNT(j)  (256  + 64 * (j))
#define XB_XSUB(j)  (1280 + 64 * (j))
#define XB_XGEN(j)  (2304 + 64 * (j))
#define XB_TOP      3328
#define XB_TOPGEN   3392
#define XCD_BAR_WORDS 3456
#define XB_SPIN_CAP (1u << 18)

__device__ __forceinline__ unsigned xb_ld(unsigned* p)              { return __hip_atomic_load(p, __ATOMIC_RELAXED, __HIP_MEMORY_SCOPE_AGENT); }
__device__ __forceinline__ unsigned xb_add(unsigned* p, unsigned v) { return __hip_atomic_fetch_add(p, v, __ATOMIC_RELAXED, __HIP_MEMORY_SCOPE_AGENT); }
__device__ __forceinline__ unsigned xb_xcc_id() { return (unsigned)__builtin_amdgcn_s_getreg((3 << 11) | 20) & 0xFu; }
#define XB_SPIN(cond, bar) do { unsigned _sp = 0; while (cond) { __builtin_amdgcn_s_sleep(1); \
    if ((++_sp & 255u) == 0u) { if (xb_ld(&(bar)[XB_TMO])) break; if (_sp > XB_SPIN_CAP) { atomicAdd(&(bar)[XB_TMO], 1u); break; } } } } while (0)

struct XcdBarrier {
    unsigned* bar; unsigned x;
    volatile LAS unsigned* st;
};

__device__ __forceinline__ XcdBarrier xcd_barrier_post(unsigned* bar, volatile LAS unsigned* st, bool is_t0) {
    XcdBarrier b; b.bar = bar; b.x = xb_xcc_id(); b.st = st;
    if (is_t0) (void)xb_add(&bar[XB_XCNT(b.x)], 1u);
    return b;
}
__device__ __forceinline__ void xcd_barrier_complete(unsigned* bar, unsigned x, unsigned& nloc, unsigned& nx) {
    const unsigned G = gridDim.x * gridDim.y * gridDim.z;
    unsigned sum, cnt, mine, sp = 0u;
    for (;;) {
        sum = 0u; cnt = 0u; mine = 0u;
#pragma unroll
        for (unsigned j = 0; j < 16; ++j) { const unsigned c = xb_ld(&bar[XB_XCNT(j)]); sum += c; cnt += (c > 0u) ? 1u : 0u; mine = (j == x) ? c : mine; }
        if (sum == G) break;
        __builtin_amdgcn_s_sleep(1);
        if ((++sp & 255u) == 0u) { if (xb_ld(&bar[XB_TMO])) break; if (sp > XB_SPIN_CAP) { atomicAdd(&bar[XB_TMO], 1u); break; } }
    }
    nloc = mine > 0u ? mine : 1u; nx = cnt > 0u ? cnt : 1u;
}

__device__ __forceinline__ void xcd_barrier(const XcdBarrier& b, bool is_t0) {
    asm volatile("s_waitcnt vmcnt(0)" ::: "memory");
    __syncthreads();
    if (is_t0) {
        unsigned* bar = b.bar;
        __builtin_amdgcn_s_waitcnt(0);
        unsigned nloc = b.st[0], nx = b.st[1];
        if (nloc == 0u) { xcd_barrier_complete(bar, b.x, nloc, nx); b.st[0] = nloc; b.st[1] = nx; }
        const unsigned old = xb_add(&bar[XB_XSUB(b.x)], 1u);
        const unsigned gen = old / nloc;
        if (old + 1u == (gen + 1u) * nloc) {
            __builtin_amdgcn_fence(__ATOMIC_RELEASE, "agent");
            asm volatile("s_waitcnt vmcnt(0)" ::: "memory");
            const unsigned og = xb_add(&bar[XB_TOP], 1u);
            const unsigned tg = og / nx;
            if (og + 1u == (tg + 1u) * nx) xb_add(&bar[XB_TOPGEN], 1u);
            else XB_SPIN(xb_ld(&bar[XB_TOPGEN]) == tg, bar);
            __builtin_amdgcn_fence(__ATOMIC_ACQUIRE, "agent");
            xb_add(&bar[XB_XGEN(b.x)], 1u);
            asm volatile("s_waitcnt vmcnt(0)" ::: "memory");
        } else {
            XB_SPIN(xb_ld(&bar[XB_XGEN(b.x)]) == gen, bar);
            __builtin_amdgcn_fence(__ATOMIC_ACQUIRE, "agent");
            asm volatile("s_waitcnt vmcnt(0)" ::: "memory");
        }
    }
    __syncthreads();
}

__device__ __forceinline__ void stagger(int bx, unsigned ticks_per_class) {
    const unsigned q = ((unsigned)bx >> 3) & 3u;
    if (q) { const unsigned long long t0 = __builtin_amdgcn_s_memrealtime(), dt = (unsigned long long)q * ticks_per_class;
             while (__builtin_amdgcn_s_memrealtime() - t0 < dt) __builtin_amdgcn_s_sleep(8); }
}
#ifndef STAG_ON
#define STAG_ON 0
#endif
#ifndef STAG_LIGHT
#define STAG_LIGHT 300u
#endif
#ifndef STAG_HEAVY
#define STAG_HEAVY 1000u
#endif
#define GEMM_CALL(EPI, SCHED, g, S, E) do { if (STAG_ON) stagger(bx, EPI::PERM ? STAG_LIGHT : STAG_HEAVY); pg8::gemm_phase<EPI, SCHED, true, true>(lds, g, S, E, tid); } while (0)
#ifndef PROBE_G
#define PROBE_G 0
#endif
#ifndef PROBE_S
#define PROBE_S 0
#endif
#define GEMM_CALL_P(EPI, SCHED, g, S, E) do { _Pragma("unroll 1") for (int rep_ = 0; rep_ < 1 + PROBE_G; ++rep_) { GEMM_CALL(EPI, SCHED, g, S, E); } } while (0)
#ifndef PROBE_PW
#define PROBE_PW 0
#endif
#ifndef PROBE_PU
#define PROBE_PU 0
#endif
#ifndef PROBE_CT
#define PROBE_CT 0
#endif
#ifndef PROBE_AT
#define PROBE_AT 0
#endif
#ifndef PROBE_HY
#define PROBE_HY 0
#endif
#define REP_N(N_) _Pragma("unroll 1") for (int rep_ = 0; rep_ < 1 + (N_); ++rep_)

__device__ __forceinline__ int lane_id_volatile() { int l; asm volatile("v_mbcnt_lo_u32_b32 %0, -1, 0\n\tv_mbcnt_hi_u32_b32 %0, -1, %0" : "=v"(l)); return l; }
typedef const __attribute__((address_space(4))) Args* KArgs;
__device__ __forceinline__ Args load_args() {
#if defined(__HIP_DEVICE_COMPILE__)
    KArgs p = (KArgs)__builtin_amdgcn_kernarg_segment_ptr();
    asm volatile("" : "+s"(p));
    return *p;
#else
    return Args{};
#endif
}
__global__ void __launch_bounds__(NTHR, 2) fwd_megakernel(Args a_unused) {
    extern __shared__ __attribute__((aligned(16))) unsigned char lds_raw[];
    LAS unsigned char* lds = (LAS unsigned char*)lds_raw;
    cg::grid_group grid = cg::this_grid();
    const int wave0 = __builtin_amdgcn_readfirstlane((int)threadIdx.x >> 6);
    const int G0 = gridDim.x, bx0 = blockIdx.x;
#define TID0() (wave0 * 64 + lane_id_volatile())
    { const int t0_ = TID0(); if (t0_ < 2) ((LAS unsigned*)(lds + LDS_ST_OFF))[t0_] = 0u; }
    __syncthreads();
    { const Args a0 = load_args(); (void)xcd_barrier_post((unsigned*)(a0.ws + WS_BAR), (volatile LAS unsigned*)(lds + LDS_ST_OFF), TID0() == 0); }
#define GSYNC() do { const Args ab = load_args(); XcdBarrier xb_; xb_.bar = (unsigned*)(ab.ws + WS_BAR); xb_.x = xb_xcc_id(); xb_.st = (volatile LAS unsigned*)(lds + LDS_ST_OFF); xcd_barrier(xb_, TID0() == 0); } while (0)
#define PTRS() const Args a = load_args(); int tid = TID0(), G = G0, bx = bx0; asm volatile("" : "+v"(tid), "+s"(G), "+s"(bx)); const int lane = tid & 63, wave = __builtin_amdgcn_readfirstlane(tid >> 6); (void)lane; (void)wave; unsigned char* ws = a.ws; bf16* Wb = (bf16*)(ws + WS_W); const pg8::bf16_t* xb = (const pg8::bf16_t*)(ws + WS_XB); \
    const float* rcos = (const float*)(ws + WS_ROPE); const float* rsin = rcos + 65536; float* ssqA = (float*)(ws + WS_SSQA); float* ssqB = (float*)(ws + WS_SSQB); \
    (void)Wb; (void)xb; (void)rcos; (void)rsin; (void)ssqA; (void)ssqB;
#define GIN() pg8::Gemm gin{xb, (const pg8::bf16_t*)(Wb + W_IN / 2), nullptr, nullptr, MTOK, NIN, DM}; \
    pg8::EpiIn Ein{(pg8::bf16_t*)(ws + WS_HY), (pg8::bf16_t*)(ws + WS_Q), (pg8::bf16_t*)(ws + WS_KV), (pg8::bf16_t*)(ws + WS_GATES), ssqA, rcos, rsin, 0};
#define FILL_RTAB(S_, ssq_, E_) pg8::fill_rstd_table(S_, ssq_, (LAS float*)(lds + LDS_RTAB), tid)

#pragma unroll 1
    for (int L = 0; L < 2; ++L) {
        REP_N(PROBE_PW) { PTRS(); phase_prep_weights(a, L, lds, tid, lane, wave, G); }
        if (L == 0) grid.sync(); else GSYNC();
        {
            PTRS(); GIN();
            pg8::TwoRect S; S.a.init(128, 12, 0, 0, G, bx); S.b.init(64, 12, 0, 12, G, bx); S.na = S.a.count();
            GEMM_CALL_P(pg8::EpiIn, pg8::TwoRect, gin, S, Ein);
        }
        GSYNC();
        REP_N(PROBE_AT) { PTRS(); phase_attn_mfma(a, 0, lds, tid, G, rep_ < PROBE_AT); } { PTRS(); REP_N(PROBE_PU) { phase_prep_u(a, L, lds, tid, G); } }
        GSYNC();
        {
            PTRS(); GIN();
            pg8::RectOrder S; S.init(64, 12, 64, 12, G, bx);
            Ein.kv_row0 = HALF_TOK;
            GEMM_CALL_P(pg8::EpiIn, pg8::RectOrder, gin, S, Ein);
        }
        REP_N(PROBE_HY) { PTRS(); phase_hyena_mfma(a, lds, tid, G, rep_ < PROBE_HY); }
        GSYNC();
        REP_N(PROBE_AT) { PTRS(); phase_attn_mfma(a, 1, lds, tid, G, rep_ < PROBE_AT); }
        {
            PTRS(); GIN();
            pg8::RectOrder S; S.init(128, 8, 0, 24, G, bx);
            GEMM_CALL_P(pg8::EpiIn, pg8::RectOrder, gin, S, Ein);
        }
        GSYNC();
        REP_N(PROBE_CT) { PTRS(); phase_combine(a, tid, G); phase_transpose_y(a, lds, tid, G); }
        GSYNC();
        {
            PTRS();
            pg8::Gemm g{(const pg8::bf16_t*)(ws + WS_YHY), (const pg8::bf16_t*)(Wb + W_PHY / 2), (const pg8::bf16_t*)(ws + WS_YATT), (const pg8::bf16_t*)(Wb + W_PATT / 2), MTOK, DM, 512};
            pg8::PairOrder S; S.r.init(128, 4, 0, 0, G, bx);
            pg8::EpiGate E{(const pg8::bf16_t*)(ws + WS_GATES), (pg8::bf16_t*)(ws + WS_MERGED)};
            GEMM_CALL_P(pg8::EpiGate, pg8::PairOrder, g, S, E);
        }
        GSYNC();
        {
            PTRS();
            pg8::Gemm g{(const pg8::bf16_t*)(ws + WS_MERGED), (const pg8::bf16_t*)(Wb + W_O / 2), nullptr, nullptr, MTOK, DM, DM};
            pg8::RectOrder S; S.init(128, 4, 0, 0, G, bx);
            pg8::EpiRes E{L == 0 ? a.in[0] : nullptr, (pg8::bf16_t*)(ws + WS_XB), ssqB};
            GEMM_CALL(pg8::EpiRes, pg8::RectOrder, g, S, E);
        }
        GSYNC();
        {
            PTRS();
            pg8::Gemm g{xb, (const pg8::bf16_t*)(Wb + W_FF1 / 2), nullptr, nullptr, MTOK, DFF, DM};
            pg8::RectOrder S; S.init(128, 16, 0, 0, G, bx);
            pg8::EpiFF1 E{(pg8::bf16_t*)(ws + WS_H), (const LAS float*)(lds + LDS_RTAB)};
            FILL_RTAB(S, ssqB, E);
            GEMM_CALL_P(pg8::EpiFF1, pg8::RectOrder, g, S, E);
        }
        GSYNC();
        {
            PTRS();
            pg8::Gemm g{(const pg8::bf16_t*)(ws + WS_H), (const pg8::bf16_t*)(Wb + W_FF2 / 2), nullptr, nullptr, MTOK, DM, DFF};
            pg8::RectOrder S; S.init(128, 4, 0, 0, G, bx);
            pg8::EpiRes E{nullptr, (pg8::bf16_t*)(ws + WS_XB), ssqA};
            GEMM_CALL(pg8::EpiRes, pg8::RectOrder, g, S, E);
        }
        GSYNC();
    }
    { PTRS(); phase_final_norm(a, lane, wave, G); }
}

extern "C" void kernel_launch(void* const* d_in, const int* in_sizes, int n_in, void* d_out, int out_size, void* d_ws, size_t ws_size, hipStream_t stream) {
    static int grid = 0;
    if (grid == 0) {
        if (n_in != 19 || in_sizes[0] != MTOK * DM || out_size != MTOK * DM || ws_size < WS_END) {
            fprintf(stderr, "kernel_launch: unexpected shapes / workspace (n_in %d, ws %zu, need %zu); nothing launched\n", n_in, ws_size, (size_t)WS_END); grid = -1; return; }
        int dev = 0, cus = 0, per_cu = 0;
        (void)hipGetDevice(&dev); (void)hipDeviceGetAttribute(&cus, hipDeviceAttributeMultiprocessorCount, dev);
        if (hipFuncSetAttribute((const void*)fwd_megakernel, hipFuncAttributeMaxDynamicSharedMemorySize, LDS_BYTES) != hipSuccess) { fprintf(stderr, "kernel_launch: hipFuncSetAttribute failed\n"); grid = -1; return; }
        if (hipOccupancyMaxActiveBlocksPerMultiprocessor(&per_cu, (const void*)fwd_megakernel, NTHR, LDS_BYTES) != hipSuccess || per_cu < 1) { fprintf(stderr, "kernel_launch: occupancy query gives %d\n", per_cu); per_cu = 1; }
        (void)hipGetLastError();
        grid = cus * 1;
        if (grid % 8 != 0 || grid > 256) grid = (grid > 256) ? 256 : (grid / 8) * 8;
    }
    if (grid < 0) return;
    Args a{};
    for (int i = 0; i < 19; ++i) a.in[i] = (const float*)d_in[i];
    a.out = (float*)d_out; a.ws = (unsigned char*)d_ws;
    if (hipMemsetAsync((char*)d_ws + WS_BAR, 0, 16384, stream) != hipSuccess) { fprintf(stderr, "kernel_launch: memset of the barrier words failed\n"); return; }
    void* args[] = {&a};
    hipError_t e = hipLaunchCooperativeKernel((const void*)fwd_megakernel, dim3(grid), dim3(NTHR), args, LDS_BYTES, stream);
    if (e != hipSuccess) fprintf(stderr, "cooperative launch failed: %s (grid %d)\n", hipGetErrorString(e), grid);
}
```

```cpp
#include <hip/hip_runtime.h>
#include <hip/hip_cooperative_groups.h>
#include <cstdio>
#include <cstdint>
namespace cg = cooperative_groups;

namespace pg8 {
#define PG8_LAS __attribute__((address_space(3)))
typedef unsigned short bf16_t;
typedef short bf16x8 __attribute__((ext_vector_type(8)));
typedef float f32x4 __attribute__((ext_vector_type(4)));
typedef unsigned u32x4 __attribute__((ext_vector_type(4)));
constexpr int BM = 256, BK = 64, HALF = 128, HTB = HALF * BK * 2  , STAGE_BYTES = 8 * HTB, NXCD = 8, WGM = 8;

__host__ __device__ __forceinline__ int lds_byte(int r, int c) { const int st = (r >> 4) * 2 + (c >> 5), rr = r & 15, cc = c & 31, ob = rr * 64 + cc * 2; return st * 1024 + (ob ^ (((ob >> 9) & 1) << 5)); }
__host__ __device__ __forceinline__ void stage_rc(int b, int& R, int& C) { const int st = b / 1024, sb = b % 1024, swz = sb ^ (((sb >> 9) & 1) << 5); R = (st >> 1) * 16 + swz / 64; C = (st & 1) * 32 + (swz % 64) / 2; }
__host__ __device__ __forceinline__ int perm32(int rho) { const int n = rho >> 4, i = rho & 15; return 8 * (i >> 2) + 4 * n + (i & 3); }

struct Unit { int pm, pn, z; };
struct Gemm { const bf16_t* A; const bf16_t* Bt; const bf16_t* A1; const bf16_t* Bt1; int M, N, K; };

struct StaticOrder {
    int nM, nN, nwg, G, c;
    __host__ __device__ void init(int M, int N, int G_, int c_) { nM = M / BM; nN = N / BM; nwg = nM * nN; G = G_; c = c_; }
    __host__ __device__ bool next(int i, Unit& u) const {
        const long L = (long)i * G + c; if (L >= nwg) return false;
        int wgid = (int)L; { const int q = nwg / NXCD, r = nwg % NXCD, xcd = wgid % NXCD, off = wgid / NXCD; wgid = (xcd < r ? xcd * (q + 1) : r * (q + 1) + (xcd - r) * q) + off; }
        const int nig = WGM * nN, gid = wgid / nig, fm = gid * WGM, gsz = (nM - fm) < WGM ? (nM - fm) : WGM;
        u.pm = fm + ((wgid % nig) % gsz); u.pn = (wgid % nig) / gsz; return true;
    }
    __device__ __forceinline__ void a_ready(const Unit&) const {}
    __device__ __forceinline__ void done(const Unit&) const {}
};


__device__ __forceinline__ unsigned cvt_pk_bf16(float lo, float hi) { unsigned r; asm volatile("v_cvt_pk_bf16_f32 %0, %1, %2" : "=v"(r) : "v"(lo), "v"(hi)); return r; }
__device__ __forceinline__ float bf_lo(unsigned w) { return __uint_as_float(w << 16); }
__device__ __forceinline__ float bf_hi(unsigned w) { return __uint_as_float(w & 0xffff0000u); }

struct RectOrder {
    int nN, nwg, G, c, pm0, pn0;
    __device__ __forceinline__ void init(int nM_, int nN_, int pm0_, int pn0_, int G_, int c_) { nN = nN_; nwg = nM_ * nN_; G = G_; c = c_; pm0 = pm0_; pn0 = pn0_; }
    __device__ __forceinline__ int count() const { return nwg > c ? (nwg - c + G - 1) / G : 0; }
    __device__ __forceinline__ bool next(int i, Unit& u) const {
        const long L = (long)i * G + c; if (L >= nwg) return false;
        int w = (int)L;
        if ((nwg & 7) == 0 && (G & 7) == 0) w = (c & 7) * (nwg >> 3) + (w >> 3);
        const int nig = 8 * nN, gid = w / nig, r = w % nig;
        u.pm = pm0 + gid * 8 + (r & 7); u.pn = pn0 + (r >> 3); u.z = 0; return true;
    }
    __device__ __forceinline__ void a_ready(const Unit&) const {}
    __device__ __forceinline__ void done(const Unit&) const {}
};
struct TwoRect {
    RectOrder a, b; int na;
    __device__ __forceinline__ bool next(int i, Unit& u) const { return i < na ? a.next(i, u) : b.next(i - na, u); }
    __device__ __forceinline__ void a_ready(const Unit&) const {}
    __device__ __forceinline__ void done(const Unit&) const {}
};
struct PairOrder {
    RectOrder r;
    __device__ __forceinline__ bool next(int i, Unit& u) const { const bool ok = r.next(i >> 1, u); u.z = i & 1; return ok; }
    __device__ __forceinline__ void a_ready(const Unit&) const {}
    __device__ __forceinline__ void done(const Unit&) const {}
};

constexpr float RMS_EPS = 1e-6f;
constexpr float QSCALE = 0.125f * 1.44269504088896341f;

__device__ __forceinline__ float row_rstd(const float* ssq, int row) {
    const f32x4* p = (const f32x4*)(ssq + (size_t)row * 16);
    const f32x4 a = p[0], b = p[1], c = p[2], d = p[3];
    const float s = ((a[0] + a[1]) + (a[2] + a[3])) + ((b[0] + b[1]) + (b[2] + b[3])) + ((c[0] + c[1]) + (c[2] + c[3])) + ((d[0] + d[1]) + (d[2] + d[3]));
    return __builtin_amdgcn_rsqf(s * (1.0f / 1024.0f) + RMS_EPS);
}

template <class Sched>
__device__ __forceinline__ void fill_rstd_table(const Sched& S, const float* ssq, PG8_LAS float* rtab, int tid) {
    int q0 = -1, q1 = -1, q2 = -1; Unit u;
#pragma unroll 1
    for (int i = 0; S.next(i, u); ++i) { if (u.pm == q0 || u.pm == q1 || u.pm == q2) continue; if (q0 < 0) q0 = u.pm; else if (q1 < 0) q1 = u.pm; else if (q2 < 0) q2 = u.pm; }
    if (tid == 0) { ((PG8_LAS int*)rtab)[768] = q0; ((PG8_LAS int*)rtab)[769] = q1; ((PG8_LAS int*)rtab)[770] = 0; }
    const int t = tid & 255, half = tid >> 8;
    { const int pm = half ? q1 : q0; if (pm >= 0) { rtab[half * 256 + t] = row_rstd(ssq, pm * BM + t); } }
    if (q2 >= 0 && half == 0) { const float v = row_rstd(ssq, q2 * BM + t); rtab[512 + t] = v; }
    __syncthreads();
}

struct EpiIn {
    static constexpr bool PERM = true, AFTER_DRAIN = false, IDEMPOTENT = true;
    bf16_t* hy; bf16_t* q; bf16_t* kv; bf16_t* gates; const float* ssq; const float* rcos; const float* rsin; int kv_row0;
    __device__ __forceinline__ bool operator()(f32x4 (&acc)[2][2][4][2], const Unit& u, int wr, int wc, int fr, int fq) const {
        const int pn = u.pn; int type, ldc, colt, rowoff = 0; bf16_t* base;
        if (pn < 6) { type = 0; base = hy; ldc = 1536; colt = pn * 256; }
        else if (pn < 12) { type = 1; base = q; ldc = 1536; colt = (pn - 6) * 256; }
        else if (pn < 24) { const int idx = pn - 12; type = ((idx >> 1) & 1) ? 0 : 2; base = kv; ldc = 3072; colt = idx * 256; rowoff = kv_row0; }
        else { type = 3; base = gates; ldc = 2048; colt = (pn - 24) * 256; }
        const bool rot = (type == 1 || type == 2);
        const int row0 = u.pm * BM + wr * 64 + fr;
        f32x4 S[2][4], C[2][4];
#define EPIIN_LOAD(k_, buf_) do { const int row_ = row0 + ((k_) >> 2) * HALF + ((k_) & 3) * 16; const f32x4* p_ = (const f32x4*)(ssq + (size_t)row_ * 16); \
            S[buf_][0] = p_[0]; S[buf_][1] = p_[1]; S[buf_][2] = p_[2]; S[buf_][3] = p_[3]; \
            if (rot) { const int pos_ = row_ & 2047; C[buf_][0] = *(const f32x4*)(rcos + pos_ * 32 + 8 * fq); C[buf_][1] = *(const f32x4*)(rcos + pos_ * 32 + 8 * fq + 4); \
                       C[buf_][2] = *(const f32x4*)(rsin + pos_ * 32 + 8 * fq); C[buf_][3] = *(const f32x4*)(rsin + pos_ * 32 + 8 * fq + 4); } } while (0)
        EPIIN_LOAD(0, 0);
#pragma unroll
        for (int k = 0; k < 8; ++k) {
            const int ai = k >> 2, m = k & 3, cb = k & 1;
            if (k < 7) EPIIN_LOAD(k + 1, cb ^ 1);
            const int row = row0 + ai * HALF + m * 16;
            float rs;
            { const f32x4 a = S[cb][0], b = S[cb][1], c = S[cb][2], d = S[cb][3];
              const float s = ((a[0] + a[1]) + (a[2] + a[3])) + ((b[0] + b[1]) + (b[2] + b[3])) + ((c[0] + c[1]) + (c[2] + c[3])) + ((d[0] + d[1]) + (d[2] + d[3]));
              rs = __builtin_amdgcn_rsqf(s * (1.0f / 1024.0f) + RMS_EPS); }
            bf16_t* rowp = base + (size_t)(row - rowoff) * ldc + colt;
            f32x4 v00 = acc[ai][0][m][0] * rs, v01 = acc[ai][0][m][1] * rs, v10 = acc[ai][1][m][0] * rs, v11 = acc[ai][1][m][1] * rs;
            if (rot) {
                const f32x4 c0 = C[cb][0], c1 = C[cb][1], s0 = C[cb][2], s1 = C[cb][3];
                const float sc = (type == 1) ? QSCALE : 1.0f;
                const f32x4 o00 = (v00 * c0 - v10 * s0) * sc, o01 = (v01 * c1 - v11 * s1) * sc;
                const f32x4 o10 = (v10 * c0 + v00 * s0) * sc, o11 = (v11 * c1 + v01 * s1) * sc;
                u32x4 w0, w1;
                w0.x = cvt_pk_bf16(o00[0], o00[1]); w0.y = cvt_pk_bf16(o00[2], o00[3]); w0.z = cvt_pk_bf16(o01[0], o01[1]); w0.w = cvt_pk_bf16(o01[2], o01[3]);
                w1.x = cvt_pk_bf16(o10[0], o10[1]); w1.y = cvt_pk_bf16(o10[2], o10[3]); w1.z = cvt_pk_bf16(o11[0], o11[1]); w1.w = cvt_pk_bf16(o11[2], o11[3]);
                *(u32x4*)(rowp + wc * 64 + 8 * fq) = w0;
                *(u32x4*)(rowp + wc * 64 + 8 * fq + 32) = w1;
            } else {
                if (type == 3) {
#pragma unroll
                    for (int e = 0; e < 4; ++e) {
                        v00[e] = __builtin_amdgcn_rcpf(1.0f + __expf(-v00[e])); v01[e] = __builtin_amdgcn_rcpf(1.0f + __expf(-v01[e]));
                        v10[e] = __builtin_amdgcn_rcpf(1.0f + __expf(-v10[e])); v11[e] = __builtin_amdgcn_rcpf(1.0f + __expf(-v11[e]));
                    }
                }
                u32x4 w0, w1;
                w0.x = cvt_pk_bf16(v00[0], v00[1]); w0.y = cvt_pk_bf16(v00[2], v00[3]); w0.z = cvt_pk_bf16(v01[0], v01[1]); w0.w = cvt_pk_bf16(v01[2], v01[3]);
                w1.x = cvt_pk_bf16(v10[0], v10[1]); w1.y = cvt_pk_bf16(v10[2], v10[3]); w1.z = cvt_pk_bf16(v11[0], v11[1]); w1.w = cvt_pk_bf16(v11[2], v11[3]);
                *(u32x4*)(rowp + wc * 32 + 8 * fq) = w0;
                *(u32x4*)(rowp + wc * 32 + 8 * fq + HALF) = w1;
            }
        }
#undef EPIIN_LOAD
        return false;
    }
};

struct EpiGate {
    static constexpr bool PERM = true, AFTER_DRAIN = false, IDEMPOTENT = false;
    const bf16_t* gates; bf16_t* merged;
    __device__ __forceinline__ bool operator()(f32x4 (&acc)[2][2][4][2], const Unit& u, int wr, int wc, int fr, int fq) const {
        const int row0 = u.pm * BM + wr * 64 + fr, col0 = u.pn * BM + wc * 32 + 8 * fq;
        const bool first = (u.z == 0);
        u32x4 GA[2][2], GH[2][2];
#define EPIG_LOAD(k_, buf_) do { const bf16_t* gp_ = gates + (size_t)(row0 + ((k_) >> 2) * HALF + ((k_) & 3) * 16) * 2048 + col0; \
            GA[buf_][0] = *(const u32x4*)(gp_ + 1024); GA[buf_][1] = *(const u32x4*)(gp_ + 1024 + HALF); \
            if (first) { GH[buf_][0] = *(const u32x4*)(gp_); GH[buf_][1] = *(const u32x4*)(gp_ + HALF); } } while (0)
        EPIG_LOAD(0, 0);
#pragma unroll
        for (int k = 0; k < 8; ++k) {
            const int ai = k >> 2, m = k & 3, cb = k & 1;
            if (k < 7) EPIG_LOAD(k + 1, cb ^ 1);
            const int row = row0 + ai * HALF + m * 16;
#pragma unroll
            for (int bj = 0; bj < 2; ++bj) {
                const u32x4 ga = GA[cb][bj];
                f32x4 a0 = (f32x4){bf_lo(ga.x), bf_hi(ga.x), bf_lo(ga.y), bf_hi(ga.y)}, a1 = (f32x4){bf_lo(ga.z), bf_hi(ga.z), bf_lo(ga.w), bf_hi(ga.w)};
                if (first) {
                    const u32x4 gh = GH[cb][bj];
                    const f32x4 h0 = (f32x4){bf_lo(gh.x), bf_hi(gh.x), bf_lo(gh.y), bf_hi(gh.y)}, h1 = (f32x4){bf_lo(gh.z), bf_hi(gh.z), bf_lo(gh.w), bf_hi(gh.w)};
#pragma unroll
                    for (int e = 0; e < 4; ++e) { a0[e] = fmaxf(a0[e], 1e-30f); a1[e] = fmaxf(a1[e], 1e-30f); }
#pragma unroll
                    for (int e = 0; e < 4; ++e) { acc[ai][bj][m][0][e] *= h0[e] * __builtin_amdgcn_rcpf(a0[e]); acc[ai][bj][m][1][e] *= h1[e] * __builtin_amdgcn_rcpf(a1[e]); }
                } else {
                    const f32x4 v0 = acc[ai][bj][m][0] * a0, v1 = acc[ai][bj][m][1] * a1;
                    u32x4 w; w.x = cvt_pk_bf16(v0[0], v0[1]); w.y = cvt_pk_bf16(v0[2], v0[3]); w.z = cvt_pk_bf16(v1[0], v1[1]); w.w = cvt_pk_bf16(v1[2], v1[3]);
                    *(u32x4*)(merged + (size_t)row * 1024 + col0 + bj * HALF) = w;
                }
            }
        }
#undef EPIG_LOAD
        return first;
    }
};

struct EpiRes {
    static constexpr bool PERM = true, AFTER_DRAIN = false, IDEMPOTENT = false;
    const float* base32; bf16_t* xb; float* ssq;
    __device__ __forceinline__ bool operator()(f32x4 (&acc)[2][2][4][2], const Unit& u, int wr, int wc, int fr, int fq) const {
        int rl = wr * 64 + fr, cl = wc * 32 + 8 * fq;
        asm volatile("" : "+v"(rl), "+v"(cl));
        const bool f32base = base32 != nullptr;
        f32x4 Bv[2][4];
#define EPIRES_LOAD(k_, buf_) do { const size_t off_ = (size_t)(u.pm * BM + ((k_) >> 2) * HALF + ((k_) & 3) * 16 + rl) * 1024 + u.pn * BM + cl; \
            if (f32base) { Bv[buf_][0] = *(const f32x4*)(base32 + off_); Bv[buf_][1] = *(const f32x4*)(base32 + off_ + 4); Bv[buf_][2] = *(const f32x4*)(base32 + off_ + HALF); Bv[buf_][3] = *(const f32x4*)(base32 + off_ + HALF + 4); } \
            else { _Pragma("unroll") for (int j_ = 0; j_ < 2; ++j_) { const u32x4 w_ = *(const u32x4*)(xb + off_ + j_ * HALF); \
                       Bv[buf_][2 * j_] = (f32x4){bf_lo(w_.x), bf_hi(w_.x), bf_lo(w_.y), bf_hi(w_.y)}; Bv[buf_][2 * j_ + 1] = (f32x4){bf_lo(w_.z), bf_hi(w_.z), bf_lo(w_.w), bf_hi(w_.w)}; } } } while (0)
        EPIRES_LOAD(0, 0);
#pragma unroll
        for (int k = 0; k < 8; ++k) {
            const int ai = k >> 2, m = k & 3, cb = k & 1;
            if (k < 7) EPIRES_LOAD(k + 1, cb ^ 1);
            const int row = u.pm * BM + ai * HALF + m * 16 + rl;
            const size_t off = (size_t)row * 1024 + u.pn * BM + cl;
            float s = 0.f;
#pragma unroll
            for (int bj = 0; bj < 2; ++bj) {
                const f32x4 o0 = Bv[cb][bj * 2] + acc[ai][bj][m][0], o1 = Bv[cb][bj * 2 + 1] + acc[ai][bj][m][1];
                u32x4 w; w.x = cvt_pk_bf16(o0[0], o0[1]); w.y = cvt_pk_bf16(o0[2], o0[3]); w.z = cvt_pk_bf16(o1[0], o1[1]); w.w = cvt_pk_bf16(o1[2], o1[3]);
                *(u32x4*)(xb + off + bj * HALF) = w;
                s += ((o0[0] * o0[0] + o0[1] * o0[1]) + (o0[2] * o0[2] + o0[3] * o0[3])) + ((o1[0] * o1[0] + o1[1] * o1[1]) + (o1[2] * o1[2] + o1[3] * o1[3]));
            }
            s += __shfl_xor(s, 16); s += __shfl_xor(s, 32);
            if (fq == 0) ssq[(size_t)row * 16 + u.pn * 4 + wc] = s;
        }
#undef EPIRES_LOAD
        return false;
    }
};

struct EpiFF1 {
    static constexpr bool PERM = true, AFTER_DRAIN = false, IDEMPOTENT = true;
    bf16_t* h; const PG8_LAS float* rtab;
    __device__ __forceinline__ bool operator()(f32x4 (&acc)[2][2][4][2], const Unit& u, int wr, int wc, int fr, int fq) const {
        const int row0 = u.pm * BM + wr * 64 + fr;
        const int p0 = ((const PG8_LAS int*)rtab)[768], p1 = ((const PG8_LAS int*)rtab)[769];
        const PG8_LAS float* rt = rtab + ((u.pm == p0) ? 0 : ((u.pm == p1) ? 256 : 512)) + wr * 64 + fr;
        float rsv[8];
#pragma unroll
        for (int k = 0; k < 8; ++k) rsv[k] = rt[(k >> 2) * HALF + (k & 3) * 16];
#pragma unroll
        for (int ai = 0; ai < 2; ++ai)
#pragma unroll
            for (int m = 0; m < 4; ++m) {
                const int row = row0 + ai * HALF + m * 16;
                const float rs = rsv[ai * 4 + m];
                bf16_t* rowp = h + (size_t)row * 4096 + u.pn * BM + wc * 32 + 8 * fq;
#pragma unroll
                for (int bj = 0; bj < 2; ++bj) {
                    f32x4 v0 = acc[ai][bj][m][0] * rs, v1 = acc[ai][bj][m][1] * rs;
#pragma unroll
                    for (int e = 0; e < 4; ++e) { v0[e] = fmaxf(v0[e], 0.f); v1[e] = fmaxf(v1[e], 0.f); }
                    v0 = v0 * v0; v1 = v1 * v1;
                    u32x4 w; w.x = cvt_pk_bf16(v0[0], v0[1]); w.y = cvt_pk_bf16(v0[2], v0[3]); w.z = cvt_pk_bf16(v1[0], v1[1]); w.w = cvt_pk_bf16(v1[2], v1[3]);
                    *(u32x4*)(rowp + bj * HALF) = w;
                }
            }
        return false;
    }
};

template <class Epi, class Sched, bool ALIGN_EPI = false, bool SP2 = false>
__device__ __forceinline__ void gemm_phase(PG8_LAS unsigned char* lds, const Gemm g, const Sched& S, const Epi& E, int tid_in) {
    int tid_ = tid_in; asm volatile("" : "+v"(tid_));
    const int tid = tid_, wid = __builtin_amdgcn_readfirstlane(tid >> 6), lane = tid & 63, wr = wid >> 2, wc = wid & 3, fr = lane & 15, fq = lane >> 4;
    const int K = g.K, nt = K / BK;
    unsigned voffA[2], voffB[2];
#pragma unroll
    for (int i = 0; i < 2; ++i) { int R, C; stage_rc(tid * 16 + i * 8192, R, C); const int Rb = Epi::PERM ? ((R & ~31) + perm32(R & 31)) : R;
        voffA[i] = (unsigned)(R * K + C) * 2u; voffB[i] = (unsigned)(Rb * K + C) * 2u; }
    const size_t kstep = (size_t)(BK * 2);
    const size_t hstep = (size_t)HALF * K * 2;
    const size_t tstep = 2 * hstep;
    const unsigned ldsw = (unsigned)wid * 1024u;
    const int aoff = lds_byte(wr * 64 + fr, fq * 8), boff = lds_byte(wc * 32 + fr, fq * 8);
#define PG8_SA(b, h) (((b) * 2 + (h)) * HTB)
#define PG8_SB(b, h) ((4 + (b) * 2 + (h)) * HTB)
#define PG8_STAGE(bufoff, gbase, voff) do { _Pragma("unroll") for (int _i = 0; _i < 2; ++_i) \
        __builtin_amdgcn_global_load_lds((const unsigned*)((const char*)(gbase) + (voff)[_i]), (PG8_LAS unsigned*)(lds + (bufoff) + ldsw + _i * 8192), 16, 0, 0); } while (0)
#define PG8_LDA(dst, b, h) do { _Pragma("unroll") for (int m = 0; m < 4; ++m) _Pragma("unroll") for (int k = 0; k < 2; ++k) dst[m][k] = *(const PG8_LAS bf16x8*)(lds + PG8_SA(b, h) + aoff + m * 2048 + k * 1024); } while (0)
#define PG8_LDB(dst, b, h) do { _Pragma("unroll") for (int n = 0; n < 2; ++n) _Pragma("unroll") for (int k = 0; k < 2; ++k) dst[n][k] = *(const PG8_LAS bf16x8*)(lds + PG8_SB(b, h) + boff + n * 2048 + k * 1024); } while (0)
#define PG8_MMA(ai, bj, At, Bt) do { __builtin_amdgcn_s_setprio(1); _Pragma("unroll") for (int m = 0; m < 4; ++m) _Pragma("unroll") for (int n = 0; n < 2; ++n) _Pragma("unroll") for (int k = 0; k < 2; ++k) \
        acc[ai][bj][m][n] = __builtin_amdgcn_mfma_f32_16x16x32_bf16(Bt[n][k], At[m][k], acc[ai][bj][m][n], 0, 0, 0); __builtin_amdgcn_s_setprio(0); } while (0)
#define PG8_WAIT_V(n) asm volatile("s_waitcnt vmcnt(" #n ")" ::: "memory")
#define PG8_WAIT_L(n) asm volatile("s_waitcnt lgkmcnt(" #n ")" ::: "memory")
#define PG8_BAR __builtin_amdgcn_s_barrier()
#define PG8_SCHED __builtin_amdgcn_sched_barrier(0)
    Unit cur, nxt; int ui = 0;
    if (!S.next(0, cur)) return;
    f32x4 acc[2][2][4][2];
#pragma unroll
    for (int a = 0; a < 2; ++a)
#pragma unroll
        for (int b = 0; b < 2; ++b)
#pragma unroll
            for (int m = 0; m < 4; ++m)
#pragma unroll
                for (int n = 0; n < 2; ++n) acc[a][b][m][n] = (f32x4){0.f, 0.f, 0.f, 0.f};
    bf16x8 At[4][2], B0[2][2], B1[2][2];
    const char* cA = (const char*)(cur.z ? g.A1 : g.A) + (size_t)cur.pm * tstep; const char* cB = (const char*)(cur.z ? g.Bt1 : g.Bt) + (size_t)cur.pn * tstep;
    S.a_ready(cur);
    if constexpr (SP2) {
        PG8_STAGE(PG8_SB(0, 0), cB, voffB); PG8_STAGE(PG8_SB(0, 1), cB + hstep, voffB); PG8_STAGE(PG8_SA(0, 0), cA, voffA); PG8_STAGE(PG8_SA(0, 1), cA + hstep, voffA);
        if (wr == 1) PG8_BAR;
        PG8_WAIT_V(2); PG8_BAR;
        PG8_STAGE(PG8_SB(1, 0), cB + kstep, voffB); PG8_STAGE(PG8_SA(1, 0), cA + kstep, voffA); PG8_STAGE(PG8_SB(1, 1), cB + hstep + kstep, voffB);
        PG8_WAIT_V(6); PG8_BAR;
    } else {
        PG8_STAGE(PG8_SB(0, 0), cB, voffB); PG8_STAGE(PG8_SA(0, 0), cA, voffA); PG8_STAGE(PG8_SB(0, 1), cB + hstep, voffB); PG8_STAGE(PG8_SA(0, 1), cA + hstep, voffA);
        if (wr == 1) PG8_BAR;
        PG8_WAIT_V(4); PG8_BAR;
        PG8_STAGE(PG8_SB(1, 0), cB + kstep, voffB); PG8_STAGE(PG8_SA(1, 0), cA + kstep, voffA); PG8_STAGE(PG8_SB(1, 1), cB + hstep + kstep, voffB);
        PG8_WAIT_V(6); PG8_BAR;
    }
    for (;;) {
        const bool has_next = S.next(ui + 1, nxt);
        const char* nA = has_next ? (const char*)(nxt.z ? g.A1 : g.A) + (size_t)nxt.pm * tstep : cA; const char* nB = has_next ? (const char*)(nxt.z ? g.Bt1 : g.Bt) + (size_t)nxt.pn * tstep : cB;
        for (int t = 0; t < nt; t += 2) {
            const bool last = (t == nt - 2);
            const char* a1 = cA + (size_t)(t + 1) * kstep;
            const char* a2 = last ? nA : cA + (size_t)(t + 2) * kstep; const char* b2 = last ? nB : cB + (size_t)(t + 2) * kstep;
            const char* a3 = a2 + kstep; const char* b3 = b2 + kstep;
            if (last && has_next) S.a_ready(nxt);
            if constexpr (SP2) {
            PG8_LDB(B0, 0, 0); PG8_LDB(B1, 0, 1); PG8_SCHED; PG8_LDA(At, 0, 0); PG8_STAGE(PG8_SA(1, 1), a1 + hstep, voffA);
            PG8_WAIT_V(8); PG8_WAIT_L(0); PG8_BAR; PG8_MMA(0, 0, At, B0); PG8_MMA(0, 1, At, B1); PG8_BAR; PG8_SCHED;
            PG8_LDA(At, 0, 1); PG8_STAGE(PG8_SB(0, 0), b2, voffB); PG8_STAGE(PG8_SB(0, 1), b2 + hstep, voffB); PG8_STAGE(PG8_SA(0, 0), a2, voffA);
            PG8_WAIT_V(8); PG8_WAIT_L(0); PG8_BAR; PG8_MMA(1, 0, At, B0); PG8_MMA(1, 1, At, B1); PG8_BAR; PG8_SCHED;
            PG8_LDB(B0, 1, 0); PG8_LDB(B1, 1, 1); PG8_SCHED; PG8_LDA(At, 1, 0); PG8_STAGE(PG8_SA(0, 1), a2 + hstep, voffA);
            PG8_WAIT_V(8); PG8_WAIT_L(0); PG8_BAR; PG8_MMA(0, 0, At, B0); PG8_MMA(0, 1, At, B1); PG8_BAR; PG8_SCHED;
            PG8_LDA(At, 1, 1); PG8_STAGE(PG8_SB(1, 0), b3, voffB); PG8_STAGE(PG8_SB(1, 1), b3 + hstep, voffB); PG8_STAGE(PG8_SA(1, 0), a3, voffA);
            PG8_WAIT_V(8); PG8_WAIT_L(0); PG8_BAR; PG8_MMA(1, 0, At, B0); PG8_MMA(1, 1, At, B1); PG8_BAR; PG8_SCHED;
            } else {
            PG8_LDB(B0, 0, 0); PG8_SCHED; PG8_LDA(At, 0, 0); PG8_STAGE(PG8_SA(1, 1), a1 + hstep, voffA);
            PG8_WAIT_L(8); PG8_BAR; PG8_WAIT_L(0); PG8_MMA(0, 0, At, B0); PG8_BAR; PG8_SCHED;
            PG8_LDB(B1, 0, 1); PG8_STAGE(PG8_SB(0, 0), b2, voffB);
            PG8_BAR; PG8_WAIT_L(0); PG8_MMA(0, 1, At, B1); PG8_BAR;
            PG8_LDA(At, 0, 1); PG8_STAGE(PG8_SA(0, 0), a2, voffA);
            PG8_BAR; PG8_WAIT_L(0); PG8_MMA(1, 0, At, B0); PG8_BAR; PG8_SCHED;
            PG8_STAGE(PG8_SB(0, 1), b2 + hstep, voffB);
            PG8_WAIT_V(6); PG8_BAR; PG8_MMA(1, 1, At, B1); PG8_BAR;
            PG8_LDB(B0, 1, 0); PG8_SCHED; PG8_LDA(At, 1, 0); PG8_STAGE(PG8_SA(0, 1), a2 + hstep, voffA);
            PG8_WAIT_L(8); PG8_BAR; PG8_WAIT_L(0); PG8_MMA(0, 0, At, B0); PG8_BAR; PG8_SCHED;
            PG8_LDB(B1, 1, 1); PG8_STAGE(PG8_SB(1, 0), b3, voffB);
            PG8_BAR; PG8_WAIT_L(0); PG8_MMA(0, 1, At, B1); PG8_BAR;
            PG8_LDA(At, 1, 1); PG8_STAGE(PG8_SA(1, 0), a3, voffA);
            PG8_BAR; PG8_WAIT_L(0); PG8_MMA(1, 0, At, B0); PG8_BAR; PG8_SCHED;
            PG8_STAGE(PG8_SB(1, 1), b3 + hstep, voffB);
            PG8_WAIT_V(6); PG8_BAR; PG8_MMA(1, 1, At, B1); PG8_BAR;
            }
        }
        if constexpr (ALIGN_EPI) { if (wr == 0) PG8_BAR; }
#ifndef PROBE_EPI
#define PROBE_EPI 0
#endif
        bool keep_acc = false; if constexpr (!Epi::AFTER_DRAIN) { keep_acc = E(acc, cur, wr, wc, fr, fq); if constexpr (Epi::IDEMPOTENT && PROBE_EPI) { asm volatile("" ::: "memory"); keep_acc = E(acc, cur, wr, wc, fr, fq); } S.done(cur); }
        if (!has_next) break;
        if (!keep_acc) {
#pragma unroll
        for (int a = 0; a < 2; ++a)
#pragma unroll
            for (int b = 0; b < 2; ++b)
#pragma unroll
                for (int m = 0; m < 4; ++m)
#pragma unroll
                    for (int n = 0; n < 2; ++n) acc[a][b][m][n] = (f32x4){0.f, 0.f, 0.f, 0.f};
        }
        cur = nxt; cA = nA; cB = nB; ++ui;
        if constexpr (ALIGN_EPI) { if (wr == 1) PG8_BAR; }
    }
    PG8_WAIT_V(0);
    if constexpr (!ALIGN_EPI) { if (wr == 0) PG8_BAR; }
    PG8_BAR;
    if constexpr (Epi::AFTER_DRAIN) { E.fused(acc, cur, wr, wc, fr, fq, lds, wid, lane); S.done(cur); }
#undef PG8_SA
#undef PG8_SB
#undef PG8_STAGE
#undef PG8_LDA
#undef PG8_LDB
#undef PG8_MMA
#undef PG8_WAIT_V
#undef PG8_WAIT_L
#undef PG8_BAR
#undef PG8_SCHED
}
}

#define LAS __attribute__((address_space(3)))
typedef unsigned short bf16;
typedef float f32x4 __attribute__((ext_vector_type(4)));
typedef unsigned v4u __attribute__((ext_vector_type(4)));
constexpr int NWAVES = 8, NTHR = 512;
constexpr int MTOK = 32768, DM = 1024, SEQ = 2048, NBATCH = 16, NIN = 8192, DFF = 4096, HYW = 512, HALF_TOK = 16384;
constexpr size_t MiB = (size_t)1 << 20;
constexpr size_t WS_SSQA = 0, WS_SSQB = 2 * MiB, WS_ROPE = 4 * MiB, WS_RSTD = 4 * MiB + 512 * 1024, WS_BAR = 4 * MiB + 768 * 1024, WS_LSE = 5 * MiB, WS_GF = 8 * MiB, WS_W = 16 * MiB, WS_XB = 52 * MiB,
                 WS_HY = 116 * MiB, WS_UT = 212 * MiB, WS_GATES = 116 * MiB, WS_Q = 244 * MiB, WS_KV = 340 * MiB, WS_YHY = 436 * MiB, WS_YATT = 404 * MiB, WS_X0T = 468 * MiB,
                 WS_MERGED = 340 * MiB, WS_H = 116 * MiB, WS_END = 500 * MiB;
constexpr size_t W_IN = 0, W_PHY = 16 * MiB, W_PATT = 17 * MiB, W_O = 18 * MiB, W_FF1 = 20 * MiB, W_FF2 = 28 * MiB;
constexpr int LDS_RTAB = 131072;
constexpr int LDS_ST_OFF = 135168;
constexpr int LDS_BYTES = 139264;

struct Args {
    const float* in[19]; float* out; unsigned char* ws; int pad0, pad1;
};

__device__ __forceinline__ unsigned f2bf(float f) { unsigned u = __float_as_uint(f); return (u + 0x7fffu + ((u >> 16) & 1u)) >> 16; }
__device__ __forceinline__ unsigned pk2(float lo, float hi) { return f2bf(lo) | (f2bf(hi) << 16); }
__device__ __forceinline__ float bf2f(unsigned short b) { return __uint_as_float((unsigned)b << 16); }
__device__ __forceinline__ float wave_sum(float v) {
#pragma unroll
    for (int o = 1; o < 64; o <<= 1) v += __shfl_xor(v, o);
    return v;
}

__device__ __forceinline__ int win_src_col(int n) {
    const int t = n >> 8, j = n & 255;
    if (t < 6) return n;
    if (t >= 24) return 6144 + (n - 6144);
    int g, w, half;
    if (t < 12) { const int i = t - 6; g = i >> 1; w = 0; half = i & 1; }
    else { const int i = t - 12; g = i >> 2; w = 1 + ((i >> 1) & 1); half = i & 1; }
    int hh, d;
    if (w == 2) { hh = j >> 6; d = j & 63; }
    else { hh = (j & 127) >> 5; d = (j & 31) + ((j >> 7) << 5); }
    return 1536 + g * 1536 + w * 512 + (half * 4 + hh) * 64 + d;
}

__device__ __forceinline__ void transpose_item(const float* W, int K, int Nsrc, int s0, bf16* WT, int n0, int k0, const float* gain, LAS float* scr, int lane) {
    float tv[32];
#pragma unroll
    for (int i = 0; i < 32; ++i) { const int kk = 2 * i + (lane >> 5); tv[i] = W[(size_t)(k0 + kk) * Nsrc + s0 + (lane & 31)]; }
    const float gl = gain ? gain[k0 + lane] : 1.0f;
#pragma unroll
    for (int i = 0; i < 32; ++i) { const int kk = 2 * i + (lane >> 5); scr[kk * 33 + (lane & 31)] = tv[i] * __shfl(gl, kk); }
    asm volatile("s_waitcnt lgkmcnt(0)" ::: "memory");
    const int c = lane & 7;
#pragma unroll
    for (int j = 0; j < 4; ++j) { const int n = (lane >> 3) + 8 * j; const LAS float* s = scr + (8 * c) * 33 + n;
        v4u o; o.x = pk2(s[0 * 33], s[1 * 33]); o.y = pk2(s[2 * 33], s[3 * 33]); o.z = pk2(s[4 * 33], s[5 * 33]); o.w = pk2(s[6 * 33], s[7 * 33]);
        *(v4u*)(WT + (size_t)(n0 + n) * K + k0 + 8 * c) = o; }
    asm volatile("s_waitcnt lgkmcnt(0)" ::: "memory");
}

__device__ __forceinline__ void phase_prep_weights(const Args& a, int L, LAS unsigned char* lds, int tid, int lane, int wave, int G) {
    unsigned char* ws = a.ws;
    {
        const float* w1 = a.in[5] + (size_t)L * 33 * 64; const float* b1 = a.in[6] + L * 64;
        const float* wi = a.in[7] + (size_t)L * 2 * 64 * 64; const float* bi = a.in[8] + L * 2 * 64;
        const float* wout = a.in[9] + (size_t)L * 64 * 1024; const float* fr = a.in[10] + L * 64; const float* skip = a.in[11] + L * 512;
        bf16* Rg = (bf16*)(ws + WS_GF);
        const float min_decay = logf(1e-2f) / 1.5f, max_decay = logf(1e-2f) / 0.3f;
        LAS float* hb = (LAS float*)lds + wave * 64;
        LAS float* fbuf = (LAS float*)(lds + 4096);
        const float frl = fr[lane];
        LAS float* wl = (LAS float*)(lds + 40960);
        for (int i = tid; i < 528 + 2048; i += NTHR) { const f32x4 v = (i < 528) ? *((const f32x4*)w1 + i) : *((const f32x4*)wi + (i - 528)); *(LAS f32x4*)(wl + 4 * i) = v; }
        __syncthreads();
#ifndef PROBE_PWF
#define PROBE_PWF 0
#endif
#ifndef PROBE_PWT
#define PROBE_PWT 0
#endif
        _Pragma("unroll 1") for (int repf = 0; repf < 1 + PROBE_PWF; ++repf)
        for (int blk = blockIdx.x; blk < 256; blk += G) {
            int n = 8 * blk + wave + 1; if (n == 2048) n = 0;
            const float t = (float)n / 2047.0f;
            {
                float v = 0.f;
                if (lane == 0) v = t;
                else if (lane < 33) { const int k = (lane - 1) & 15; const float band = 1e-4f + (float)k * ((15.0f - 1e-4f) / 15.0f); const float ang = ((float)(2.0 * 3.14159265358979323846 / 2048.0) * (float)n) * band;
                       v = (lane <= 16) ? cosf(ang) : -sinf(ang); }
                hb[lane] = v;
            }
            float s = b1[lane];
#pragma unroll
            for (int e = 0; e < 33; ++e) s += hb[e] * wl[e * 64 + lane];
            float hcur = sinf(frl * s);
#pragma unroll 1
            for (int layer = 0; layer < 2; ++layer) {
                hb[lane] = hcur;
                float s2 = bi[layer * 64 + lane];
#pragma unroll
                for (int e = 0; e < 64; ++e) s2 += hb[e] * wl[2112 + layer * 4096 + e * 64 + lane];
                hcur = sinf(frl * s2);
            }
            LAS float* hT = (LAS float*)(lds + 2048);
            hT[lane * 8 + wave] = hcur;
            __syncthreads();
            float o[8][2];
#pragma unroll
            for (int p = 0; p < 8; ++p) { o[p][0] = 0.f; o[p][1] = 0.f; }
#pragma unroll 16
            for (int e0 = 0; e0 < 64; ++e0) {
                const int e = (e0 + 8 * ((blk >> 3) & 7)) & 63;
                const f32x4 ha = *(const LAS f32x4*)(hT + e * 8), hc = *(const LAS f32x4*)(hT + e * 8 + 4);
                const float w0 = wout[e * 1024 + 128 * wave + lane], w1v = wout[e * 1024 + 128 * wave + 64 + lane];
#pragma unroll
                for (int p = 0; p < 4; ++p) { o[p][0] += ha[p] * w0; o[p][1] += ha[p] * w1v; o[4 + p][0] += hc[p] * w0; o[4 + p][1] += hc[p] * w1v; }
            }
#pragma unroll
            for (int j = 0; j < 2; ++j) {
                const int col = 128 * wave + 64 * j + lane, c = col & 511;
                const float delta = fabsf(min_decay + (float)c * ((max_decay - min_decay) / 511.0f));
#pragma unroll
                for (int p = 0; p < 8; ++p) { int np = 8 * blk + p + 1; if (np == 2048) np = 0; const float tp = (float)np / 2047.0f; fbuf[p * 1024 + col] = o[p][j] * expf(-tp * delta); }
            }
            __syncthreads();
            if (blk != 255) {
                typedef unsigned u32x2v __attribute__((ext_vector_type(2)));
#pragma unroll
                for (int pp = 0; pp < 2; ++pp) {
                    const int p = tid + 512 * pp, c = p & 511, dir = p >> 9;
                    bf16* r0 = Rg + ((size_t)c * 2 + 0) * 4096; bf16* r1 = Rg + ((size_t)c * 2 + 1) * 4096;
                    unsigned e[8];
#pragma unroll
                    for (int j = 0; j < 8; ++j) e[j] = f2bf(fbuf[(dir ? j : 7 - j) * 1024 + dir * 512 + c]);
                    v4u w8; w8.x = e[0] | (e[1] << 16); w8.y = e[2] | (e[3] << 16); w8.z = e[4] | (e[5] << 16); w8.w = e[6] | (e[7] << 16);
                    if (dir == 0) {
                        const int xb0 = 2040 - 8 * blk;
                        *(v4u*)(r0 + xb0) = w8;
                        r1[xb0 - 1] = (bf16)e[0];
                        u32x2v m4; m4.x = e[1] | (e[2] << 16); m4.y = e[3] | (e[4] << 16); *(u32x2v*)(r1 + xb0) = m4;
                        *(unsigned*)(r1 + xb0 + 4) = e[5] | (e[6] << 16);
                        r1[xb0 + 6] = (bf16)e[7];
                    } else {
                        const int xa = 2049 + 8 * blk;
                        *(v4u*)(r1 + xa - 1) = w8;
                        r0[xa] = (bf16)e[0];
                        *(unsigned*)(r0 + xa + 1) = e[1] | (e[2] << 16);
                        u32x2v m4; m4.x = e[3] | (e[4] << 16); m4.y = e[5] | (e[6] << 16); *(u32x2v*)(r0 + xa + 3) = m4;
                        r0[xa + 7] = (bf16)e[7];
                    }
                }
            } else
#pragma unroll
            for (int pp = 0; pp < 2; ++pp) {
                const int p = tid + 512 * pp, c = p & 511, dir = p >> 9;
                bf16* r0 = Rg + ((size_t)c * 2 + 0) * 4096; bf16* r1 = Rg + ((size_t)c * 2 + 1) * 4096;
#pragma unroll
                for (int wv = 0; wv < 8; ++wv) {
                    int nn = 8 * blk + wv + 1; float val = fbuf[wv * 1024 + dir * 512 + c]; int x;
                    if (nn == 2048) { if (dir != 0) continue; val += skip[c]; x = 2048; }
                    else x = dir ? 2048 + nn : 2048 - nn;
                    const bf16 hv = (bf16)f2bf(val); r0[x] = hv; r1[x - 1] = hv;
                }
            }
            __syncthreads();
        }
    }
    {
        LAS float* scr = (LAS float*)(lds + 40960 + wave * 8704);
        const int gw = blockIdx.x * NWAVES + wave, NGW = G * NWAVES;
        bf16* Wb = (bf16*)(ws + WS_W);
        const float* w_in = a.in[2] + (size_t)L * DM * NIN; const float* p_hy = a.in[12] + (size_t)L * 512 * DM; const float* p_att = a.in[13] + (size_t)L * 512 * DM;
        const float* w_o = a.in[14] + (size_t)L * DM * DM; const float* w1 = a.in[16] + (size_t)L * DM * DFF; const float* w2 = a.in[17] + (size_t)L * DFF * DM;
        const float* g_mix = a.in[1] + L * DM; const float* g_ffn = a.in[15] + L * DM;
        constexpr int I_IN = 16 * 256, I_P = 8 * 32, I_O = 16 * 32, I_1 = 16 * 128, I_2 = 64 * 32;
        constexpr int NITEMS = I_IN + 2 * I_P + I_O + I_1 + I_2;
        _Pragma("unroll 1") for (int rept = 0; rept < 1 + PROBE_PWT; ++rept)
        for (int it = gw; it < NITEMS; it += NGW) {
            int r = it;
            if (r < I_IN) { const int kb = r / 256, nb = r % 256; transpose_item(w_in, DM, NIN, win_src_col(nb * 32), Wb + W_IN / 2, nb * 32, kb * 64, g_mix, scr, lane); continue; } r -= I_IN;
            if (r < I_P) { const int kb = r / 32, nb = r % 32; transpose_item(p_hy, 512, DM, nb * 32, Wb + W_PHY / 2, nb * 32, kb * 64, nullptr, scr, lane); continue; } r -= I_P;
            if (r < I_P) { const int kb = r / 32, nb = r % 32; transpose_item(p_att, 512, DM, nb * 32, Wb + W_PATT / 2, nb * 32, kb * 64, nullptr, scr, lane); continue; } r -= I_P;
            if (r < I_O) { const int kb = r / 32, nb = r % 32; transpose_item(w_o, DM, DM, nb * 32, Wb + W_O / 2, nb * 32, kb * 64, nullptr, scr, lane); continue; } r -= I_O;
            if (r < I_1) { const int kb = r / 128, nb = r % 128; transpose_item(w1, DM, DFF, nb * 32, Wb + W_FF1 / 2, nb * 32, kb * 64, g_ffn, scr, lane); continue; } r -= I_1;
            { const int kb = r / 32, nb = r % 32; transpose_item(w2, DFF, DM, nb * 32, Wb + W_FF2 / 2, nb * 32, kb * 64, nullptr, scr, lane); }
        }
        if (L == 0) {
            const float* x = a.in[0]; bf16* xb = (bf16*)(ws + WS_XB); float* ssq = (float*)(ws + WS_SSQA);
            for (int m0 = gw; m0 < MTOK; m0 += 4 * NGW) {
                f32x4 v[4][4];
#pragma unroll
                for (int rr = 0; rr < 4; ++rr) { const f32x4* xr = (const f32x4*)(x + (size_t)(m0 + rr * NGW) * DM) + lane;
#pragma unroll
                    for (int j = 0; j < 4; ++j) v[rr][j] = xr[64 * j]; }
#pragma unroll
                for (int rr = 0; rr < 4; ++rr) { const int m = m0 + rr * NGW; float s = 0.f;
#pragma unroll
                    for (int j = 0; j < 4; ++j) s += (v[rr][j][0] * v[rr][j][0] + v[rr][j][1] * v[rr][j][1]) + (v[rr][j][2] * v[rr][j][2] + v[rr][j][3] * v[rr][j][3]);
                    s = wave_sum(s);
                    unsigned long long* o8 = (unsigned long long*)(xb + (size_t)m * DM) + lane;
#pragma unroll
                    for (int j = 0; j < 4; ++j) o8[64 * j] = (unsigned long long)pk2(v[rr][j][0], v[rr][j][1]) | ((unsigned long long)pk2(v[rr][j][2], v[rr][j][3]) << 32);
                    if (lane < 16) ssq[(size_t)m * 16 + lane] = (lane == 0) ? s : 0.f; }
            }
            float* rc = (float*)(ws + WS_ROPE); float* rsn = rc + 65536;
            for (int i = blockIdx.x * NTHR + tid; i < 65536; i += G * NTHR) {
                const int pos = i >> 5, f = i & 31;
                const float inv = powf(10000.0f, -(float)f / 32.0f);
                const float ang = (float)pos * inv;
                rc[i] = cosf(ang); rsn[i] = sinf(ang);
            }
        }
    }
}

__device__ __forceinline__ float bfe(const v4u& w, int e) { const unsigned d = (e >> 1) == 0 ? w.x : ((e >> 1) == 1 ? w.y : ((e >> 1) == 2 ? w.z : w.w)); return (e & 1) ? __uint_as_float(d & 0xffff0000u) : __uint_as_float(d << 16); }
__device__ __forceinline__ void phase_prep_u(const Args& a, int L, LAS unsigned char* lds, int tid, int G) {
    const bf16* hy = (const bf16*)(a.ws + WS_HY); bf16* ut = (bf16*)(a.ws + WS_UT); bf16* x0t = (bf16*)(a.ws + WS_X0T);
    const float* cw = a.in[3] + (size_t)L * 3 * 1536; const float* cb = a.in[4] + L * 1536;
    LAS unsigned short* tile = (LAS unsigned short*)lds;
    const int cc = blockIdx.x & 7, ml = tid >> 3, cg8 = tid & 7, c0 = cc * 64 + cg8 * 8;
    float wq[3][4][8];
#pragma unroll
    for (int ar = 0; ar < 3; ++ar)
#pragma unroll
        for (int e = 0; e < 8; ++e) { wq[ar][0][e] = cw[ar * 512 + c0 + e]; wq[ar][1][e] = cw[1536 + ar * 512 + c0 + e]; wq[ar][2][e] = cw[3072 + ar * 512 + c0 + e]; wq[ar][3][e] = cb[ar * 512 + c0 + e]; }
    v4u dn[3][3];
    const v4u zero = (v4u){0u, 0u, 0u, 0u};
#define PU_LOAD(it_) do { const int m_ = ((it_) & 31) * 64 + ml; const bf16* r_ = hy + (size_t)(((it_) >> 5) * SEQ + m_) * 1536 + c0; \
        _Pragma("unroll") for (int ar_ = 0; ar_ < 3; ++ar_) { dn[ar_][0] = (m_ > 0) ? *(const v4u*)(r_ - 1536 + ar_ * 512) : zero; dn[ar_][1] = *(const v4u*)(r_ + ar_ * 512); \
            dn[ar_][2] = (m_ < SEQ - 1) ? *(const v4u*)(r_ + 1536 + ar_ * 512) : zero; } } while (0)
    if ((int)(blockIdx.x >> 3) < 512) PU_LOAD((int)(blockIdx.x >> 3));
    for (int it = blockIdx.x >> 3; it < 512; it += (G >> 3)) {
        const int mc = it & 31, b = it >> 5;
        v4u d[3][3];
#pragma unroll
        for (int ar = 0; ar < 3; ++ar) { d[ar][0] = dn[ar][0]; d[ar][1] = dn[ar][1]; d[ar][2] = dn[ar][2]; }
        if (it + (G >> 3) < 512) PU_LOAD(it + (G >> 3));
#pragma unroll
        for (int e = 0; e < 8; ++e) {
            float cv[3];
#pragma unroll
            for (int ar = 0; ar < 3; ++ar) cv[ar] = wq[ar][3][e] + wq[ar][0][e] * bfe(d[ar][0], e) + wq[ar][1][e] * bfe(d[ar][1], e) + wq[ar][2][e] * bfe(d[ar][2], e);
            tile[(cg8 * 8 + e) * 72 + ml] = (unsigned short)f2bf(cv[1] * cv[2]);
            tile[4608 + (cg8 * 8 + e) * 72 + ml] = (unsigned short)f2bf(cv[0]);
        }
        __syncthreads();
        {
            const int c2 = tid >> 3, ch = tid & 7;
            const LAS unsigned* s = (const LAS unsigned*)(tile + c2 * 72 + ch * 8);
            v4u o; o.x = s[0]; o.y = s[1]; o.z = s[2]; o.w = s[3];
            *(v4u*)(ut + ((size_t)(cc * 64 + c2) * NBATCH + b) * SEQ + mc * 64 + ch * 8) = o;
            const LAS unsigned* s2 = s + 2304;
            v4u o2; o2.x = s2[0]; o2.y = s2[1]; o2.z = s2[2]; o2.w = s2[3];
            *(v4u*)(x0t + ((size_t)(cc * 64 + c2) * NBATCH + b) * SEQ + mc * 64 + ch * 8) = o2;
        }
        __syncthreads();
    }
}

__device__ __forceinline__ void phase_hyena_naive(const Args& a, int L, LAS unsigned char* lds, int tid, int G) {
    const bf16* hy = (const bf16*)(a.ws + WS_HY); const bf16* ut = (const bf16*)(a.ws + WS_UT); const float* Gf = (const float*)(a.ws + WS_GF);
    bf16* yhy = (bf16*)(a.ws + WS_YHY);
    const float* cw = a.in[3] + (size_t)L * 3 * 1536; const float* cb = a.in[4] + L * 1536;
    LAS float* Gs = (LAS float*)lds;
    LAS float* Us = Gs + 4096;
    for (int item = blockIdx.x; item < 2048; item += G) {
        const int c = item >> 2, bq = item & 3;
        for (int i = tid; i < 4096; i += NTHR) Gs[i] = (i == 0) ? 0.f : Gf[(size_t)c * 4096 + i];
        for (int i = tid; i < 8192; i += NTHR) { const int bl = i >> 11, m = i & 2047; Us[i] = bf2f(ut[((size_t)c * NBATCH + bq * 4 + bl) * SEQ + m]); }
        __syncthreads();
        const int bl = tid >> 7, tn = tid & 127;
        float acc[16];
#pragma unroll
        for (int i = 0; i < 16; ++i) acc[i] = 0.f;
        const LAS float* up = Us + bl * 2048;
        for (int m = 0; m < SEQ; ++m) {
            const float u = up[m];
            const LAS float* gp = Gs + (tn - m + 2048);
#pragma unroll
            for (int i = 0; i < 16; ++i) acc[i] += gp[128 * i] * u;
        }
        const int b = bq * 4 + bl;
        const float w0 = cw[c], w1 = cw[1536 + c], w2 = cw[3072 + c], b0 = cb[c];
#pragma unroll
        for (int i = 0; i < 16; ++i) {
            const int n = tn + 128 * i;
            const bf16* r = hy + (size_t)(b * SEQ + n) * 1536 + c;
            const float xm = (n > 0) ? bf2f(r[-1536]) : 0.f, xc = bf2f(r[0]), xp = (n < SEQ - 1) ? bf2f(r[1536]) : 0.f;
            const float x0 = b0 + w0 * xm + w1 * xc + w2 * xp;
            yhy[(size_t)(b * SEQ + n) * 512 + c] = (bf16)f2bf(x0 * acc[i]);
        }
        __syncthreads();
    }
}

__device__ __forceinline__ void phase_attn_naive(const Args& a, int half, int tid, int G) {
    bf16* Q = (bf16*)(a.ws + WS_Q); const bf16* KV = (const bf16*)(a.ws + WS_KV); float* lse = (float*)(a.ws + WS_LSE);
    for (int idx = blockIdx.x * NTHR + tid; idx < 3 * 8 * HALF_TOK; idx += G * NTHR) {
        const int g = idx / (8 * HALF_TOK), t = idx % (8 * HALF_TOK), h = t / HALF_TOK, tokl = t % HALF_TOK;
        const int dil = (g == 0) ? 1 : (g == 1 ? 4 : 16);
        const int token = half * HALF_TOK + tokl, s = token & 2047;
        bf16* qp = Q + (size_t)token * 1536 + g * 512 + h * 64;
        float q[64], o[64];
#pragma unroll
        for (int i = 0; i < 8; ++i) { const v4u w = *(const v4u*)(qp + 8 * i);
            q[8 * i + 0] = __uint_as_float(w.x << 16); q[8 * i + 1] = __uint_as_float(w.x & 0xffff0000u); q[8 * i + 2] = __uint_as_float(w.y << 16); q[8 * i + 3] = __uint_as_float(w.y & 0xffff0000u);
            q[8 * i + 4] = __uint_as_float(w.z << 16); q[8 * i + 5] = __uint_as_float(w.z & 0xffff0000u); q[8 * i + 6] = __uint_as_float(w.w << 16); q[8 * i + 7] = __uint_as_float(w.w & 0xffff0000u); }
#pragma unroll
        for (int i = 0; i < 64; ++i) o[i] = 0.f;
        float mx = -1e30f, l = 0.f;
        for (int j = -64; j <= 64; ++j) {
            const int sp = s + j * dil;
            if (sp < 0 || sp >= SEQ) continue;
            const bf16* kp = KV + (size_t)(tokl + j * dil) * 3072 + g * 1024 + h * 64;
            float sc = 0.f;
#pragma unroll
            for (int i = 0; i < 8; ++i) { const v4u w = *(const v4u*)(kp + 8 * i);
                sc += q[8 * i + 0] * __uint_as_float(w.x << 16) + q[8 * i + 1] * __uint_as_float(w.x & 0xffff0000u) + q[8 * i + 2] * __uint_as_float(w.y << 16) + q[8 * i + 3] * __uint_as_float(w.y & 0xffff0000u)
                    + q[8 * i + 4] * __uint_as_float(w.z << 16) + q[8 * i + 5] * __uint_as_float(w.z & 0xffff0000u) + q[8 * i + 6] * __uint_as_float(w.w << 16) + q[8 * i + 7] * __uint_as_float(w.w & 0xffff0000u); }
            const float mn = fmaxf(mx, sc), corr = exp2f(mx - mn), p = exp2f(sc - mn);
            l = l * corr + p; mx = mn;
            const bf16* vp = kp + 512;
#pragma unroll
            for (int i = 0; i < 8; ++i) { const v4u w = *(const v4u*)(vp + 8 * i);
                o[8 * i + 0] = o[8 * i + 0] * corr + p * __uint_as_float(w.x << 16); o[8 * i + 1] = o[8 * i + 1] * corr + p * __uint_as_float(w.x & 0xffff0000u);
                o[8 * i + 2] = o[8 * i + 2] * corr + p * __uint_as_float(w.y << 16); o[8 * i + 3] = o[8 * i + 3] * corr + p * __uint_as_float(w.y & 0xffff0000u);
                o[8 * i + 4] = o[8 * i + 4] * corr + p * __uint_as_float(w.z << 16); o[8 * i + 5] = o[8 * i + 5] * corr + p * __uint_as_float(w.z & 0xffff0000u);
                o[8 * i + 6] = o[8 * i + 6] * corr + p * __uint_as_float(w.w << 16); o[8 * i + 7] = o[8 * i + 7] * corr + p * __uint_as_float(w.w & 0xffff0000u); }
        }
        const float inv = 1.0f / l;
#pragma unroll
        for (int i = 0; i < 8; ++i) { v4u w; w.x = pk2(o[8 * i] * inv, o[8 * i + 1] * inv); w.y = pk2(o[8 * i + 2] * inv, o[8 * i + 3] * inv); w.z = pk2(o[8 * i + 4] * inv, o[8 * i + 5] * inv); w.w = pk2(o[8 * i + 6] * inv, o[8 * i + 7] * inv);
            *(v4u*)(qp + 8 * i) = w; }
        lse[((size_t)g * MTOK + token) * 8 + h] = mx + log2f(l);
    }
}

__device__ __forceinline__ void phase_combine(const Args& a, int tid, int G) {
    const bf16* Q = (const bf16*)(a.ws + WS_Q); const float* lse = (const float*)(a.ws + WS_LSE); bf16* ya = (bf16*)(a.ws + WS_YATT);
    const int stride = G * NTHR;
    for (int idx0 = blockIdx.x * NTHR + tid; idx0 < MTOK * 64; idx0 += 4 * stride) {
        float l0[4], l1[4], l2[4]; v4u a0[4], a1[4], a2[4];
#pragma unroll
        for (int j = 0; j < 4; ++j) { int idx = idx0 + j * stride; if (idx >= MTOK * 64) idx = idx0; const int token = idx >> 6, ch = idx & 63, h = ch >> 3;
            l0[j] = lse[((size_t)0 * MTOK + token) * 8 + h]; l1[j] = lse[((size_t)1 * MTOK + token) * 8 + h]; l2[j] = lse[((size_t)2 * MTOK + token) * 8 + h];
            const bf16* p = Q + (size_t)token * 1536 + ch * 8;
            a0[j] = *(const v4u*)p; a1[j] = *(const v4u*)(p + 512); a2[j] = *(const v4u*)(p + 1024); }
#pragma unroll
        for (int j = 0; j < 4; ++j) { const int idx = idx0 + j * stride; if (idx >= MTOK * 64) continue; const int token = idx >> 6, ch = idx & 63;
            const float mx = fmaxf(l0[j], fmaxf(l1[j], l2[j]));
            float w0 = exp2f(l0[j] - mx), w1 = exp2f(l1[j] - mx), w2 = exp2f(l2[j] - mx);
            const float inv = 1.0f / (w0 + w1 + w2); w0 *= inv; w1 *= inv; w2 *= inv;
            v4u o;
#define CMB(f) pk2(w0 * __uint_as_float(a0[j].f << 16) + w1 * __uint_as_float(a1[j].f << 16) + w2 * __uint_as_float(a2[j].f << 16), \
                   w0 * __uint_as_float(a0[j].f & 0xffff0000u) + w1 * __uint_as_float(a1[j].f & 0xffff0000u) + w2 * __uint_as_float(a2[j].f & 0xffff0000u))
            o.x = CMB(x); o.y = CMB(y); o.z = CMB(z); o.w = CMB(w);
#undef CMB
            *(v4u*)(ya + (size_t)token * 512 + ch * 8) = o; }
    }
}

__device__ __forceinline__ void phase_final_norm(const Args& a, int lane, int wave, int G) {
    float* out = a.out; const float* gain = a.in[18]; const bf16* xb = (const bf16*)(a.ws + WS_XB);
    const int gw = blockIdx.x * NWAVES + wave, NGW = G * NWAVES;
    typedef unsigned u32x2v __attribute__((ext_vector_type(2)));
    f32x4 gn[4];
#pragma unroll
    for (int j = 0; j < 4; ++j) gn[j] = *((const f32x4*)gain + lane + 64 * j);
    for (int m0 = gw; m0 < MTOK; m0 += 4 * NGW) {
        u32x2v w[4][4];
#pragma unroll
        for (int rr = 0; rr < 4; ++rr) { const int m = (m0 + rr * NGW < MTOK) ? m0 + rr * NGW : m0; const u32x2v* xr = (const u32x2v*)(xb + (size_t)m * DM) + lane;
#pragma unroll
            for (int j = 0; j < 4; ++j) w[rr][j] = xr[64 * j]; }
#pragma unroll
        for (int rr = 0; rr < 4; ++rr) { const int m = m0 + rr * NGW; if (m >= MTOK) continue;
            f32x4 v[4]; float s = 0.f;
#pragma unroll
            for (int j = 0; j < 4; ++j) { v[j] = (f32x4){__uint_as_float(w[rr][j].x << 16), __uint_as_float(w[rr][j].x & 0xffff0000u), __uint_as_float(w[rr][j].y << 16), __uint_as_float(w[rr][j].y & 0xffff0000u)};
                s += (v[j][0] * v[j][0] + v[j][1] * v[j][1]) + (v[j][2] * v[j][2] + v[j][3] * v[j][3]); }
            s = wave_sum(s);
            const float rs = 1.0f / sqrtf(s * (1.0f / 1024.0f) + 1e-6f);
            f32x4* orow = (f32x4*)(out + (size_t)m * DM) + lane;
#pragma unroll
            for (int j = 0; j < 4; ++j) orow[64 * j] = v[j] * rs * gn[j]; }
    }
}

typedef short bf16x8 __attribute__((ext_vector_type(8)));
typedef short s16x4 __attribute__((ext_vector_type(4)));
constexpr int HY_UROW = 4112, HY_ROFF = 16 * HY_UROW, HY_RSTRIDE = 8192 + 64;
__device__ __forceinline__ bf16x8 ld_frag4(const LAS unsigned char* p) {
    const LAS unsigned* q = (const LAS unsigned*)p; v4u d; d.x = q[0]; d.y = q[1]; d.z = q[2]; d.w = q[3]; return __builtin_bit_cast(bf16x8, d);
}
__device__ __forceinline__ void phase_hyena_mfma(const Args& a, LAS unsigned char* lds, int tid, int G, bool dummy = false) {
    const bf16* ut = (const bf16*)(a.ws + WS_UT); const bf16* Rg = (const bf16*)(a.ws + WS_GF); bf16* x0t = (bf16*)(a.ws + WS_X0T);
    const int lane = tid & 63, w = __builtin_amdgcn_readfirstlane(tid >> 6), i16 = lane & 15, kq = lane >> 4;
    const int base = (w >> 1) * 512 + (w & 1) * 16, cp = i16 & 1;
    const int lane_const = (2048 - base - i16 + 8 * kq - cp) >> 1;
    const LAS unsigned char* pA15 = lds + HY_ROFF + cp * HY_RSTRIDE + 4 * (lane_const - 240);
    const LAS unsigned char* pB = lds + i16 * HY_UROW + kq * 16;
    v4u pre[10];
#define HY_ISSUE(chn) do { _Pragma("unroll") for (int k_ = 0; k_ < 8; ++k_) { const int i_ = tid + NTHR * k_, b_ = i_ >> 8, ck_ = i_ & 255; pre[k_] = *(const v4u*)(ut + ((size_t)(chn) * NBATCH + b_) * SEQ + ck_ * 8); } \
        _Pragma("unroll") for (int k_ = 0; k_ < 2; ++k_) { const int i_ = tid + NTHR * k_, c2_ = i_ >> 9, ck_ = i_ & 511; pre[8 + k_] = *(const v4u*)(Rg + ((size_t)(chn) * 2 + c2_) * 4096 + ck_ * 8); } } while (0)
    for (int ch = blockIdx.x; ch < HYW; ch += G) {
        HY_ISSUE(ch);
#pragma unroll
        for (int k = 0; k < 8; ++k) { const int i = tid + NTHR * k, b = i >> 8, ck = i & 255; *(LAS v4u*)(lds + b * HY_UROW + ck * 16) = pre[k]; }
#pragma unroll
        for (int k = 0; k < 2; ++k) { const int i = tid + NTHR * k, c2 = i >> 9, ck = i & 511; *(LAS v4u*)(lds + HY_ROFF + c2 * HY_RSTRIDE + ck * 16) = pre[8 + k]; }
        __syncthreads();
        f32x4 acc[16]; bf16x8 W[16];
#pragma unroll
        for (int i = 0; i < 16; ++i) acc[i] = (f32x4){0.f, 0.f, 0.f, 0.f};
#pragma unroll
        for (int j = 1; j < 16; ++j) W[j] = ld_frag4(pA15 + 64 * (15 - j));
        W[0] = W[1];
#pragma unroll 1
        for (int tt = 0; tt < 4; ++tt) {
            const LAS unsigned char* pa = pA15 + 64 * 15 + 1024 * tt; const LAS unsigned char* pb = pB + 1024 * tt;
#pragma unroll
            for (int s = 0; s < 16; ++s) {
                W[(16 - s) & 15] = ld_frag4(pa + 64 * s);
                const bf16x8 Bf = *(const LAS bf16x8*)(pb + 64 * s);
                __builtin_amdgcn_s_setprio(1);
#pragma unroll
                for (int i = 0; i < 16; ++i) acc[i] = __builtin_amdgcn_mfma_f32_16x16x32_bf16(W[(i - s) & 15], Bf, acc[i], 0, 0, 0);
                __builtin_amdgcn_s_setprio(0);
            }
        }
        bf16* xo = x0t + ((size_t)ch * NBATCH + i16) * SEQ + base + 4 * kq;
        typedef unsigned u32x2v __attribute__((ext_vector_type(2)));
        u32x2v xall[16];
#pragma unroll
        for (int i = 0; i < 16; ++i) xall[i] = *(const u32x2v*)(xo + 32 * i);
#pragma unroll
        for (int i = 0; i < 16; ++i) {
            const u32x2v xv = xall[i];
            u32x2v o; o.x = pk2(__uint_as_float(xv.x << 16) * acc[i][0], __uint_as_float(xv.x & 0xffff0000u) * acc[i][1]);
            o.y = pk2(__uint_as_float(xv.y << 16) * acc[i][2], __uint_as_float(xv.y & 0xffff0000u) * acc[i][3]);
            if (!dummy) *(u32x2v*)(xo + 32 * i) = o; else *(u32x2v*)((bf16*)(a.ws + WS_YHY) + (size_t)tid * 64 + 4 * i) = o;
        }
        __syncthreads();
    }
}

__device__ __forceinline__ void phase_transpose_y(const Args& a, LAS unsigned char* lds, int tid, int G) {
    const bf16* yt = (const bf16*)(a.ws + WS_X0T); bf16* yhy = (bf16*)(a.ws + WS_YHY);
    LAS unsigned short* tile = (LAS unsigned short*)lds;
#define TY_LOAD(item_) (*(const v4u*)(yt + ((size_t)(((item_) & 7) * 64 + (tid >> 3)) * NBATCH + ((item_) >> 8)) * SEQ + (((item_) >> 3) & 31) * 64 + (tid & 7) * 8))
    v4u vnext = (v4u){0u, 0u, 0u, 0u};
    if ((int)blockIdx.x < 4096) vnext = TY_LOAD((int)blockIdx.x);
    for (int item = blockIdx.x; item < 4096; item += G) {
        const int cc = item & 7, mc = (item >> 3) & 31, b = item >> 8;
        { const int c2 = tid >> 3, ck = tid & 7;
          const v4u v = vnext;
          LAS unsigned* t4 = (LAS unsigned*)(tile + c2 * 72 + ck * 8); t4[0] = v.x; t4[1] = v.y; t4[2] = v.z; t4[3] = v.w; }
        __syncthreads();
        if (item + G < 4096) vnext = TY_LOAD(item + G);
        { const int nl = tid >> 3, cg8 = tid & 7; const LAS unsigned short* s = tile + (cg8 * 8) * 72 + nl;
          v4u o; o.x = s[0] | ((unsigned)s[72] << 16); o.y = s[144] | ((unsigned)s[216] << 16); o.z = s[288] | ((unsigned)s[360] << 16); o.w = s[432] | ((unsigned)s[504] << 16);
          *(v4u*)(yhy + (size_t)(b * SEQ + mc * 64 + nl) * 512 + cc * 64 + cg8 * 8) = o; }
        __syncthreads();
    }
}

constexpr int AT_ROWS = 272, AT_RS = 144, AT_VOFF = AT_ROWS * AT_RS;
__device__ __forceinline__ void phase_attn_mfma(const Args& a, int half, LAS unsigned char* lds, int tid, int G, bool dummy = false) {
    bf16* Q = (bf16*)(a.ws + WS_Q); const bf16* KV = (const bf16*)(a.ws + WS_KV); float* lse = (float*)(a.ws + WS_LSE);
    const int lane = tid & 63, w = __builtin_amdgcn_readfirstlane(tid >> 6), q16 = lane & 15, kq = lane >> 4;
    v4u pre[9]; bf16x8 Qn0, Qn1;
#define AT_DECODE(unit_) const int g = (unit_) >> 10, u = (unit_) & 1023, sub = u & 15, h = (u >> 4) & 7, bl = u >> 7; int dil, n, r, qb; \
        if (g == 0) { dil = 1; n = 2048; r = 0; qb = sub; } else if (g == 1) { dil = 4; n = 512; r = sub >> 2; qb = sub & 3; } else { dil = 16; n = 128; r = sub; qb = 0; } \
        const int q0 = qb * 128, kb0 = q0 - 64; (void)kb0; (void)q0;
#define AT_ISSUE(unit_, PRE_, QN0_, QN1_) do { AT_DECODE(unit_) { const bf16* qn_ = Q + (size_t)(half * HALF_TOK + bl * SEQ + (q0 + 16 * w + q16) * dil + r) * 1536 + g * 512 + h * 64; QN0_ = *(const bf16x8*)(qn_ + 8 * kq); QN1_ = *(const bf16x8*)(qn_ + 32 + 8 * kq); } \
        _Pragma("unroll") for (int k_ = 0; k_ < 9; ++k_) { const int i_ = tid + NTHR * k_; \
            const int which_ = (i_ >= AT_ROWS * 8) ? 1 : 0, j_ = i_ - which_ * AT_ROWS * 8, rr_ = j_ >> 3, ck_ = j_ & 7, key_ = kb0 + rr_; \
            PRE_[k_] = (v4u){0u, 0u, 0u, 0u}; \
            if (i_ < 2 * AT_ROWS * 8 && key_ >= 0 && key_ < n) PRE_[k_] = *(const v4u*)(KV + (size_t)(bl * SEQ + key_ * dil + r) * 3072 + g * 1024 + which_ * 512 + h * 64 + ck_ * 8); } } while (0)
    const int vb = ((G & 7) == 0) ? (int)((blockIdx.x & 7) * (G >> 3) + (blockIdx.x >> 3)) : (int)blockIdx.x;
#define AT_STEP(UNIT_, PRE_, QN0_, QN1_) do { \
_Pragma("unroll") \
        for (int k = 0; k < 9; ++k) { const int i = tid + NTHR * k; const int which = (i >= AT_ROWS * 8) ? 1 : 0, j = i - which * AT_ROWS * 8, rr = j >> 3, ck = j & 7; \
            if (i < 2 * AT_ROWS * 8) *(LAS v4u*)(lds + which * AT_VOFF + rr * AT_RS + ck * 16) = PRE_[k]; } \
        const bf16x8 Qf0 = QN0_, Qf1 = QN1_; \
        __syncthreads(); \
        if (UNIT_ + 2 * G < 3072) AT_ISSUE(UNIT_ + 2 * G, PRE_, QN0_, QN1_); \
        AT_DECODE(UNIT_) \
        { \
            const int i0 = q0 + 16 * w; \
            const int token = half * HALF_TOK + bl * SEQ + (i0 + q16) * dil + r; \
            bf16* qp = Q + (size_t)token * 1536 + g * 512 + h * 64; \
            bf16* op = dummy ? (bf16*)(a.ws + WS_YHY) + (size_t)(tid & 511) * 64 : qp; \
            f32x4 acc[4]; \
_Pragma("unroll") \
            for (int dt = 0; dt < 4; ++dt) acc[dt] = (f32x4){0.f, 0.f, 0.f, 0.f}; \
            const bool edge = (i0 < 64) || (i0 + 80 > n); \
            const LAS unsigned char* kbase = lds + (16 * w + q16) * AT_RS + 16 * kq; \
            const LAS unsigned char* vbase = lds + AT_VOFF + (16 * w + 4 * kq + (q16 >> 2)) * AT_RS + 8 * (q16 & 3); \
            f32x4 s[9]; \
_Pragma("unroll") \
            for (int kt = 0; kt < 9; ++kt) { \
                const LAS unsigned char* kp = kbase + kt * 16 * AT_RS; \
                const bf16x8 K0 = *(const LAS bf16x8*)kp, K1 = *(const LAS bf16x8*)(kp + 64); \
                f32x4 z = (f32x4){0.f, 0.f, 0.f, 0.f}; \
                z = __builtin_amdgcn_mfma_f32_16x16x32_bf16(K0, Qf0, z, 0, 0, 0); \
                z = __builtin_amdgcn_mfma_f32_16x16x32_bf16(K1, Qf1, z, 0, 0, 0); \
                if (kt == 0 || kt == 8 || edge) { \
_Pragma("unroll") \
                    for (int e = 0; e < 4; ++e) { \
                        const int rel = 16 * kt - 64 + 4 * kq + e - q16, j = i0 + q16 + rel; \
                        const bool ok = (rel >= -64) && (rel <= 64) && (j >= 0) && (j < n); \
                        z[e] = ok ? z[e] : -1e30f; \
                    } } \
                s[kt] = z; \
            } \
            float mrun = -1e30f; \
_Pragma("unroll") \
            for (int kt = 0; kt < 9; ++kt) mrun = fmaxf(mrun, fmaxf(fmaxf(s[kt][0], s[kt][1]), fmaxf(s[kt][2], s[kt][3]))); \
            mrun = fmaxf(mrun, __shfl_xor(mrun, 16)); mrun = fmaxf(mrun, __shfl_xor(mrun, 32)); \
            float lrun = 0.f; \
_Pragma("unroll") \
            for (int kt = 0; kt < 9; ++kt) \
_Pragma("unroll") \
                for (int e = 0; e < 4; ++e) { s[kt][e] = __builtin_amdgcn_exp2f(s[kt][e] - mrun); lrun += s[kt][e]; } \
_Pragma("unroll") \
            for (int st = 0; st < 5; ++st) { \
                v4u pw; pw.x = pg8::cvt_pk_bf16(s[2 * st][0], s[2 * st][1]); pw.y = pg8::cvt_pk_bf16(s[2 * st][2], s[2 * st][3]); \
                if (st < 4) { pw.z = pg8::cvt_pk_bf16(s[2 * st + 1][0], s[2 * st + 1][1]); pw.w = pg8::cvt_pk_bf16(s[2 * st + 1][2], s[2 * st + 1][3]); } else { pw.z = 0u; pw.w = 0u; } \
                const bf16x8 Pf = __builtin_bit_cast(bf16x8, pw); \
_Pragma("unroll") \
                for (int dt = 0; dt < 4; ++dt) { \
                    const LAS unsigned char* vp = vbase + 32 * st * AT_RS + 32 * dt; \
                    const s16x4 v0 = __builtin_amdgcn_ds_read_tr16_b64_v4i16((LAS s16x4*)vp); \
                    const s16x4 v1 = __builtin_amdgcn_ds_read_tr16_b64_v4i16((LAS s16x4*)(vp + 16 * AT_RS)); \
                    const bf16x8 Vf = (bf16x8){v0[0], v0[1], v0[2], v0[3], v1[0], v1[1], v1[2], v1[3]}; \
                    acc[dt] = __builtin_amdgcn_mfma_f32_16x16x32_bf16(Vf, Pf, acc[dt], 0, 0, 0); \
                } \
            } \
            lrun += __shfl_xor(lrun, 16); lrun += __shfl_xor(lrun, 32); \
            const float inv = 1.0f / lrun; \
            typedef unsigned u32x2v __attribute__((ext_vector_type(2))); \
_Pragma("unroll") \
            for (int dt = 0; dt < 4; ++dt) { \
                u32x2v o; o.x = pg8::cvt_pk_bf16(acc[dt][0] * inv, acc[dt][1] * inv); o.y = pg8::cvt_pk_bf16(acc[dt][2] * inv, acc[dt][3] * inv); \
                *(u32x2v*)(op + 16 * dt + 4 * kq) = o; \
            } \
            if (kq == 0 && !dummy) lse[((size_t)g * MTOK + token) * 8 + h] = mrun + log2f(lrun); \
        } \
        __syncthreads(); \
    } while (0)
    v4u preB[9]; bf16x8 QnB0, QnB1;
    if (vb < 3072) AT_ISSUE(vb, pre, Qn0, Qn1);
    if (vb + G < 3072) AT_ISSUE(vb + G, preB, QnB0, QnB1);
    for (int unit = vb; unit < 3072; unit += 2 * G) {
        AT_STEP(unit, pre, Qn0, Qn1);
        if (unit + G < 3072) AT_STEP(unit + G, preB, QnB0, QnB1);
    }
}

#define XB_TMO      128
#define XB_XCNT(j)  (256  + 64 * (j))
#define XB_XSUB(j)  (1280 + 64 * (j))
#define XB_XGEN(j)  (2304 + 64 * (j))
#define XB_TOP      3328
#define XB_TOPGEN   3392
#define XCD_BAR_WORDS 3456
#define XB_SPIN_CAP (1u << 18)

__device__ __forceinline__ unsigned xb_ld(unsigned* p)              { return __hip_atomic_load(p, __ATOMIC_RELAXED, __HIP_MEMORY_SCOPE_AGENT); }
__device__ __forceinline__ unsigned xb_add(unsigned* p, unsigned v) { return __hip_atomic_fetch_add(p, v, __ATOMIC_RELAXED, __HIP_MEMORY_SCOPE_AGENT); }
__device__ __forceinline__ unsigned xb_xcc_id() { return (unsigned)__builtin_amdgcn_s_getreg((3 << 11) | 20) & 0xFu; }
#define XB_SPIN(cond, bar) do { unsigned _sp = 0; while (cond) { __builtin_amdgcn_s_sleep(1); \
    if ((++_sp & 255u) == 0u) { if (xb_ld(&(bar)[XB_TMO])) break; if (_sp > XB_SPIN_CAP) { atomicAdd(&(bar)[XB_TMO], 1u); break; } } } } while (0)

struct XcdBarrier {
    unsigned* bar; unsigned x;
    volatile LAS unsigned* st;
};

__device__ __forceinline__ XcdBarrier xcd_barrier_post(unsigned* bar, volatile LAS unsigned* st, bool is_t0) {
    XcdBarrier b; b.bar = bar; b.x = xb_xcc_id(); b.st = st;
    if (is_t0) (void)xb_add(&bar[XB_XCNT(b.x)], 1u);
    return b;
}
__device__ __forceinline__ void xcd_barrier_complete(unsigned* bar, unsigned x, unsigned& nloc, unsigned& nx) {
    const unsigned G = gridDim.x * gridDim.y * gridDim.z;
    unsigned sum, cnt, mine, sp = 0u;
    for (;;) {
        sum = 0u; cnt = 0u; mine = 0u;
#pragma unroll
        for (unsigned j = 0; j < 16; ++j) { const unsigned c = xb_ld(&bar[XB_XCNT(j)]); sum += c; cnt += (c > 0u) ? 1u : 0u; mine = (j == x) ? c : mine; }
        if (sum == G) break;
        __builtin_amdgcn_s_sleep(1);
        if ((++sp & 255u) == 0u) { if (xb_ld(&bar[XB_TMO])) break; if (sp > XB_SPIN_CAP) { atomicAdd(&bar[XB_TMO], 1u); break; } }
    }
    nloc = mine > 0u ? mine : 1u; nx = cnt > 0u ? cnt : 1u;
}

__device__ __forceinline__ void xcd_barrier(const XcdBarrier& b, bool is_t0) {
    asm volatile("s_waitcnt vmcnt(0)" ::: "memory");
    __syncthreads();
    if (is_t0) {
        unsigned* bar = b.bar;
        __builtin_amdgcn_s_waitcnt(0);
        unsigned nloc = b.st[0], nx = b.st[1];
        if (nloc == 0u) { xcd_barrier_complete(bar, b.x, nloc, nx); b.st[0] = nloc; b.st[1] = nx; }
        const unsigned old = xb_add(&bar[XB_XSUB(b.x)], 1u);
        const unsigned gen = old / nloc;
        if (old + 1u == (gen + 1u) * nloc) {
            __builtin_amdgcn_fence(__ATOMIC_RELEASE, "agent");
            asm volatile("s_waitcnt vmcnt(0)" ::: "memory");
            const unsigned og = xb_add(&bar[XB_TOP], 1u);
            const unsigned tg = og / nx;
            if (og + 1u == (tg + 1u) * nx) xb_add(&bar[XB_TOPGEN], 1u);
            else XB_SPIN(xb_ld(&bar[XB_TOPGEN]) == tg, bar);
            __builtin_amdgcn_fence(__ATOMIC_ACQUIRE, "agent");
            xb_add(&bar[XB_XGEN(b.x)], 1u);
            asm volatile("s_waitcnt vmcnt(0)" ::: "memory");
        } else {
            XB_SPIN(xb_ld(&bar[XB_XGEN(b.x)]) == gen, bar);
            __builtin_amdgcn_fence(__ATOMIC_ACQUIRE, "agent");
            asm volatile("s_waitcnt vmcnt(0)" ::: "memory");
        }
    }
    __syncthreads();
}

__device__ __forceinline__ void stagger(int bx, unsigned ticks_per_class) {
    const unsigned q = ((unsigned)bx >> 3) & 3u;
    if (q) { const unsigned long long t0 = __builtin_amdgcn_s_memrealtime(), dt = (unsigned long long)q * ticks_per_class;
             while (__builtin_amdgcn_s_memrealtime() - t0 < dt) __builtin_amdgcn_s_sleep(8); }
}
#ifndef STAG_ON
#define STAG_ON 0
#endif
#ifndef STAG_LIGHT
#define STAG_LIGHT 300u
#endif
#ifndef STAG_HEAVY
#define STAG_HEAVY 1000u
#endif
#define GEMM_CALL(EPI, SCHED, g, S, E) do { if (STAG_ON) stagger(bx, EPI::PERM ? STAG_LIGHT : STAG_HEAVY); pg8::gemm_phase<EPI, SCHED, true, true>(lds, g, S, E, tid); } while (0)
#ifndef PROBE_G
#define PROBE_G 0
#endif
#ifndef PROBE_S
#define PROBE_S 0
#endif
#define GEMM_CALL_P(EPI, SCHED, g, S, E) do { _Pragma("unroll 1") for (int rep_ = 0; rep_ < 1 + PROBE_G; ++rep_) { GEMM_CALL(EPI, SCHED, g, S, E); } } while (0)
#ifndef PROBE_PW
#define PROBE_PW 0
#endif
#ifndef PROBE_PU
#define PROBE_PU 0
#endif
#ifndef PROBE_CT
#define PROBE_CT 0
#endif
#ifndef PROBE_AT
#define PROBE_AT 0
#endif
#ifndef PROBE_HY
#define PROBE_HY 0
#endif
#define REP_N(N_) _Pragma("unroll 1") for (int rep_ = 0; rep_ < 1 + (N_); ++rep_)

__device__ __forceinline__ int lane_id_volatile() { int l; asm volatile("v_mbcnt_lo_u32_b32 %0, -1, 0\n\tv_mbcnt_hi_u32_b32 %0, -1, %0" : "=v"(l)); return l; }
typedef const __attribute__((address_space(4))) Args* KArgs;
__device__ __forceinline__ Args load_args() {
#if defined(__HIP_DEVICE_COMPILE__)
    KArgs p = (KArgs)__builtin_amdgcn_kernarg_segment_ptr();
    asm volatile("" : "+s"(p));
    return *p;
#else
    return Args{};
#endif
}
__global__ void __launch_bounds__(NTHR, 2) fwd_megakernel(Args a_unused) {
    extern __shared__ __attribute__((aligned(16))) unsigned char lds_raw[];
    LAS unsigned char* lds = (LAS unsigned char*)lds_raw;
    cg::grid_group grid = cg::this_grid();
    const int wave0 = __builtin_amdgcn_readfirstlane((int)threadIdx.x >> 6);
    const int G0 = gridDim.x, bx0 = blockIdx.x;
#define TID0() (wave0 * 64 + lane_id_volatile())
    { const int t0_ = TID0(); if (t0_ < 2) ((LAS unsigned*)(lds + LDS_ST_OFF))[t0_] = 0u; }
    __syncthreads();
    { const Args a0 = load_args(); (void)xcd_barrier_post((unsigned*)(a0.ws + WS_BAR), (volatile LAS unsigned*)(lds + LDS_ST_OFF), TID0() == 0); }
#define GSYNC() do { const Args ab = load_args(); XcdBarrier xb_; xb_.bar = (unsigned*)(ab.ws + WS_BAR); xb_.x = xb_xcc_id(); xb_.st = (volatile LAS unsigned*)(lds + LDS_ST_OFF); xcd_barrier(xb_, TID0() == 0); } while (0)
#define PTRS() const Args a = load_args(); int tid = TID0(), G = G0, bx = bx0; asm volatile("" : "+v"(tid), "+s"(G), "+s"(bx)); const int lane = tid & 63, wave = __builtin_amdgcn_readfirstlane(tid >> 6); (void)lane; (void)wave; unsigned char* ws = a.ws; bf16* Wb = (bf16*)(ws + WS_W); const pg8::bf16_t* xb = (const pg8::bf16_t*)(ws + WS_XB); \
    const float* rcos = (const float*)(ws + WS_ROPE); const float* rsin = rcos + 65536; float* ssqA = (float*)(ws + WS_SSQA); float* ssqB = (float*)(ws + WS_SSQB); \
    (void)Wb; (void)xb; (void)rcos; (void)rsin; (void)ssqA; (void)ssqB;
#define GIN() pg8::Gemm gin{xb, (const pg8::bf16_t*)(Wb + W_IN / 2), nullptr, nullptr, MTOK, NIN, DM}; \
    pg8::EpiIn Ein{(pg8::bf16_t*)(ws + WS_HY), (pg8::bf16_t*)(ws + WS_Q), (pg8::bf16_t*)(ws + WS_KV), (pg8::bf16_t*)(ws + WS_GATES), ssqA, rcos, rsin, 0};
#define FILL_RTAB(S_, ssq_, E_) pg8::fill_rstd_table(S_, ssq_, (LAS float*)(lds + LDS_RTAB), tid)

#pragma unroll 1
    for (int L = 0; L < 2; ++L) {
        REP_N(PROBE_PW) { PTRS(); phase_prep_weights(a, L, lds, tid, lane, wave, G); }
        if (L == 0) grid.sync(); else GSYNC();
        {
            PTRS(); GIN();
            pg8::TwoRect S; S.a.init(128, 12, 0, 0, G, bx); S.b.init(64, 12, 0, 12, G, bx); S.na = S.a.count();
            GEMM_CALL_P(pg8::EpiIn, pg8::TwoRect, gin, S, Ein);
        }
        GSYNC();
        REP_N(PROBE_AT) { PTRS(); phase_attn_mfma(a, 0, lds, tid, G, rep_ < PROBE_AT); } { PTRS(); REP_N(PROBE_PU) { phase_prep_u(a, L, lds, tid, G); } }
        GSYNC();
        {
            PTRS(); GIN();
            pg8::RectOrder S; S.init(64, 12, 64, 12, G, bx);
            Ein.kv_row0 = HALF_TOK;
            GEMM_CALL_P(pg8::EpiIn, pg8::RectOrder, gin, S, Ein);
        }
        REP_N(PROBE_HY) { PTRS(); phase_hyena_mfma(a, lds, tid, G, rep_ < PROBE_HY); }
        GSYNC();
        REP_N(PROBE_AT) { PTRS(); phase_attn_mfma(a, 1, lds, tid, G, rep_ < PROBE_AT); }
        {
            PTRS(); GIN();
            pg8::RectOrder S; S.init(128, 8, 0, 24, G, bx);
            GEMM_CALL_P(pg8::EpiIn, pg8::RectOrder, gin, S, Ein);
        }
        GSYNC();
        REP_N(PROBE_CT) { PTRS(); phase_combine(a, tid, G); phase_transpose_y(a, lds, tid, G); }
        GSYNC();
        {
            PTRS();
            pg8::Gemm g{(const pg8::bf16_t*)(ws + WS_YHY), (const pg8::bf16_t*)(Wb + W_PHY / 2), (const pg8::bf16_t*)(ws + WS_YATT), (const pg8::bf16_t*)(Wb + W_PATT / 2), MTOK, DM, 512};
            pg8::PairOrder S; S.r.init(128, 4, 0, 0, G, bx);
            pg8::EpiGate E{(const pg8::bf16_t*)(ws + WS_GATES), (pg8::bf16_t*)(ws + WS_MERGED)};
            GEMM_CALL_P(pg8::EpiGate, pg8::PairOrder, g, S, E);
        }
        GSYNC();
        {
            PTRS();
            pg8::Gemm g{(const pg8::bf16_t*)(ws + WS_MERGED), (const pg8::bf16_t*)(Wb + W_O / 2), nullptr, nullptr, MTOK, DM, DM};
            pg8::RectOrder S; S.init(128, 4, 0, 0, G, bx);
            pg8::EpiRes E{L == 0 ? a.in[0] : nullptr, (pg8::bf16_t*)(ws + WS_XB), ssqB};
            GEMM_CALL(pg8::EpiRes, pg8::RectOrder, g, S, E);
        }
        GSYNC();
        {
            PTRS();
            pg8::Gemm g{xb, (const pg8::bf16_t*)(Wb + W_FF1 / 2), nullptr, nullptr, MTOK, DFF, DM};
            pg8::RectOrder S; S.init(128, 16, 0, 0, G, bx);
            pg8::EpiFF1 E{(pg8::bf16_t*)(ws + WS_H), (const LAS float*)(lds + LDS_RTAB)};
            FILL_RTAB(S, ssqB, E);
            GEMM_CALL_P(pg8::EpiFF1, pg8::RectOrder, g, S, E);
        }
        GSYNC();
        {
            PTRS();
            pg8::Gemm g{(const pg8::bf16_t*)(ws + WS_H), (const pg8::bf16_t*)(Wb + W_FF2 / 2), nullptr, nullptr, MTOK, DM, DFF};
            pg8::RectOrder S; S.init(128, 4, 0, 0, G, bx);
            pg8::EpiRes E{nullptr, (pg8::bf16_t*)(ws + WS_XB), ssqA};
            GEMM_CALL(pg8::EpiRes, pg8::RectOrder, g, S, E);
        }
        GSYNC();
    }
    { PTRS(); phase_final_norm(a, lane, wave, G); }
}

extern "C" void kernel_launch(void* const* d_in, const int* in_sizes, int n_in, void* d_out, int out_size, void* d_ws, size_t ws_size, hipStream_t stream) {
    static int grid = 0;
    if (grid == 0) {
        if (n_in != 19 || in_sizes[0] != MTOK * DM || out_size != MTOK * DM || ws_size < WS_END) {
            fprintf(stderr, "kernel_launch: unexpected shapes / workspace (n_in %d, ws %zu, need %zu); nothing launched\n", n_in, ws_size, (size_t)WS_END); grid = -1; return; }
        int dev = 0, cus = 0, per_cu = 0;
        (void)hipGetDevice(&dev); (void)hipDeviceGetAttribute(&cus, hipDeviceAttributeMultiprocessorCount, dev);
        if (hipFuncSetAttribute((const void*)fwd_megakernel, hipFuncAttributeMaxDynamicSharedMemorySize, LDS_BYTES) != hipSuccess) { fprintf(stderr, "kernel_launch: hipFuncSetAttribute failed\n"); grid = -1; return; }
        if (hipOccupancyMaxActiveBlocksPerMultiprocessor(&per_cu, (const void*)fwd_megakernel, NTHR, LDS_BYTES) != hipSuccess || per_cu < 1) { fprintf(stderr, "kernel_launch: occupancy query gives %d\n", per_cu); per_cu = 1; }
        (void)hipGetLastError();
        grid = cus * 1;
        if (grid % 8 != 0 || grid > 256) grid = (grid > 256) ? 256 : (grid / 8) * 8;
    }
    if (grid < 0) return;
    Args a{};
    for (int i = 0; i < 19; ++i) a.in[i] = (const float*)d_in[i];
    a.out = (float*)d_out; a.ws = (unsigned char*)d_ws;
    if (hipMemsetAsync((char*)d_ws + WS_BAR, 0, 16384, stream) != hipSuccess) { fprintf(stderr, "kernel_launch: memset of the barrier words failed\n"); return; }
    void* args[] = {&a};
    hipError_t e = hipLaunchCooperativeKernel((const void*)fwd_megakernel, dim3(grid), dim3(NTHR), args, LDS_BYTES, stream);
    if (e != hipSuccess) fprintf(stderr, "cooperative launch failed: %s (grid %d)\n", hipGetErrorString(e), grid);
}
```

```cpp
#include <hip/hip_runtime.h>
#include <hip/hip_cooperative_groups.h>
#include <cstdio>
#include <cstdint>
namespace cg = cooperative_groups;

namespace pg8 {
#define PG8_LAS __attribute__((address_space(3)))
typedef unsigned short bf16_t;
typedef short bf16x8 __attribute__((ext_vector_type(8)));
typedef float f32x4 __attribute__((ext_vector_type(4)));
typedef unsigned u32x4 __attribute__((ext_vector_type(4)));
constexpr int BM = 256, BK = 64, HALF = 128, HTB = HALF * BK * 2  , STAGE_BYTES = 8 * HTB, NXCD = 8, WGM = 8;

__host__ __device__ __forceinline__ int lds_byte(int r, int c) { const int st = (r >> 4) * 2 + (c >> 5), rr = r & 15, cc = c & 31, ob = rr * 64 + cc * 2; return st * 1024 + (ob ^ (((ob >> 9) & 1) << 5)); }
__host__ __device__ __forceinline__ void stage_rc(int b, int& R, int& C) { const int st = b / 1024, sb = b % 1024, swz = sb ^ (((sb >> 9) & 1) << 5); R = (st >> 1) * 16 + swz / 64; C = (st & 1) * 32 + (swz % 64) / 2; }
__host__ __device__ __forceinline__ int perm32(int rho) { const int n = rho >> 4, i = rho & 15; return 8 * (i >> 2) + 4 * n + (i & 3); }

struct Unit { int pm, pn, z; };
struct Gemm { const bf16_t* A; const bf16_t* Bt; const bf16_t* A1; const bf16_t* Bt1; int M, N, K; };

struct StaticOrder {
    int nM, nN, nwg, G, c;
    __host__ __device__ void init(int M, int N, int G_, int c_) { nM = M / BM; nN = N / BM; nwg = nM * nN; G = G_; c = c_; }
    __host__ __device__ bool next(int i, Unit& u) const {
        const long L = (long)i * G + c; if (L >= nwg) return false;
        int wgid = (int)L; { const int q = nwg / NXCD, r = nwg % NXCD, xcd = wgid % NXCD, off = wgid / NXCD; wgid = (xcd < r ? xcd * (q + 1) : r * (q + 1) + (xcd - r) * q) + off; }
        const int nig = WGM * nN, gid = wgid / nig, fm = gid * WGM, gsz = (nM - fm) < WGM ? (nM - fm) : WGM;
        u.pm = fm + ((wgid % nig) % gsz); u.pn = (wgid % nig) / gsz; return true;
    }
    __device__ __forceinline__ void a_ready(const Unit&) const {}
    __device__ __forceinline__ void done(const Unit&) const {}
};


__device__ __forceinline__ unsigned cvt_pk_bf16(float lo, float hi) { unsigned r; asm volatile("v_cvt_pk_bf16_f32 %0, %1, %2" : "=v"(r) : "v"(lo), "v"(hi)); return r; }
__device__ __forceinline__ float bf_lo(unsigned w) { return __uint_as_float(w << 16); }
__device__ __forceinline__ float bf_hi(unsigned w) { return __uint_as_float(w & 0xffff0000u); }

struct RectOrder {
    int nN, nwg, G, c, pm0, pn0;
    __device__ __forceinline__ void init(int nM_, int nN_, int pm0_, int pn0_, int G_, int c_) { nN = nN_; nwg = nM_ * nN_; G = G_; c = c_; pm0 = pm0_; pn0 = pn0_; }
    __device__ __forceinline__ int count() const { return nwg > c ? (nwg - c + G - 1) / G : 0; }
    __device__ __forceinline__ bool next(int i, Unit& u) const {
        const long L = (long)i * G + c; if (L >= nwg) return false;
        int w = (int)L;
        if ((nwg & 7) == 0 && (G & 7) == 0) w = (c & 7) * (nwg >> 3) + (w >> 3);
        const int nig = 8 * nN, gid = w / nig, r = w % nig;
        u.pm = pm0 + gid * 8 + (r & 7); u.pn = pn0 + (r >> 3); u.z = 0; return true;
    }
    __device__ __forceinline__ void a_ready(const Unit&) const {}
    __device__ __forceinline__ void done(const Unit&) const {}
};
struct TwoRect {
    RectOrder a, b; int na;
    __device__ __forceinline__ bool next(int i, Unit& u) const { return i < na ? a.next(i, u) : b.next(i - na, u); }
    __device__ __forceinline__ void a_ready(const Unit&) const {}
    __device__ __forceinline__ void done(const Unit&) const {}
};
struct PairOrder {
    RectOrder r;
    __device__ __forceinline__ bool next(int i, Unit& u) const { const bool ok = r.next(i >> 1, u); u.z = i & 1; return ok; }
    __device__ __forceinline__ void a_ready(const Unit&) const {}
    __device__ __forceinline__ void done(const Unit&) const {}
};

constexpr float RMS_EPS = 1e-6f;
constexpr float QSCALE = 0.125f * 1.44269504088896341f;

__device__ __forceinline__ float row_rstd(const float* ssq, int row) {
    const f32x4* p = (const f32x4*)(ssq + (size_t)row * 16);
    const f32x4 a = p[0], b = p[1], c = p[2], d = p[3];
    const float s = ((a[0] + a[1]) + (a[2] + a[3])) + ((b[0] + b[1]) + (b[2] + b[3])) + ((c[0] + c[1]) + (c[2] + c[3])) + ((d[0] + d[1]) + (d[2] + d[3]));
    return __builtin_amdgcn_rsqf(s * (1.0f / 1024.0f) + RMS_EPS);
}

template <class Sched>
__device__ __forceinline__ void fill_rstd_table(const Sched& S, const float* ssq, PG8_LAS float* rtab, int tid) {
    int q0 = -1, q1 = -1, q2 = -1; Unit u;
#pragma unroll 1
    for (int i = 0; S.next(i, u); ++i) { if (u.pm == q0 || u.pm == q1 || u.pm == q2) continue; if (q0 < 0) q0 = u.pm; else if (q1 < 0) q1 = u.pm; else if (q2 < 0) q2 = u.pm; }
    if (tid == 0) { ((PG8_LAS int*)rtab)[768] = q0; ((PG8_LAS int*)rtab)[769] = q1; ((PG8_LAS int*)rtab)[770] = 0; }
    const int t = tid & 255, half = tid >> 8;
    { const int pm = half ? q1 : q0; if (pm >= 0) { rtab[half * 256 + t] = row_rstd(ssq, pm * BM + t); } }
    if (q2 >= 0 && half == 0) { const float v = row_rstd(ssq, q2 * BM + t); rtab[512 + t] = v; }
    __syncthreads();
}

struct EpiIn {
    static constexpr bool PERM = true, AFTER_DRAIN = false, IDEMPOTENT = true;
    bf16_t* hy; bf16_t* q; bf16_t* kv; bf16_t* gates; const float* ssq; const float* rcos; const float* rsin; int kv_row0;
    __device__ __forceinline__ bool operator()(f32x4 (&acc)[2][2][4][2], const Unit& u, int wr, int wc, int fr, int fq) const {
        const int pn = u.pn; int type, ldc, colt, rowoff = 0; bf16_t* base;
        if (pn < 6) { type = 0; base = hy; ldc = 1536; colt = pn * 256; }
        else if (pn < 12) { type = 1; base = q; ldc = 1536; colt = (pn - 6) * 256; }
        else if (pn < 24) { const int idx = pn - 12; type = ((idx >> 1) & 1) ? 0 : 2; base = kv; ldc = 3072; colt = idx * 256; rowoff = kv_row0; }
        else { type = 3; base = gates; ldc = 2048; colt = (pn - 24) * 256; }
        const bool rot = (type == 1 || type == 2);
        const int row0 = u.pm * BM + wr * 64 + fr;
        f32x4 S[2][4];
        float frev[8];
#pragma unroll
        for (int e = 0; e < 8; ++e) frev[e] = __builtin_amdgcn_exp2f(-(float)(8 * fq + e) * (13.287712379549449f / 32.0f)) * 0.15915494309189535f;
#define EPIIN_LOAD(k_, buf_) do { const int row_ = row0 + ((k_) >> 2) * HALF + ((k_) & 3) * 16; const f32x4* p_ = (const f32x4*)(ssq + (size_t)row_ * 16); \
            S[buf_][0] = p_[0]; S[buf_][1] = p_[1]; S[buf_][2] = p_[2]; S[buf_][3] = p_[3]; \
            } while (0)
        EPIIN_LOAD(0, 0);
#pragma unroll
        for (int k = 0; k < 8; ++k) {
            const int ai = k >> 2, m = k & 3, cb = k & 1;
            if (k < 7) EPIIN_LOAD(k + 1, cb ^ 1);
            const int row = row0 + ai * HALF + m * 16;
            float rs;
            { const f32x4 a = S[cb][0], b = S[cb][1], c = S[cb][2], d = S[cb][3];
              const float s = ((a[0] + a[1]) + (a[2] + a[3])) + ((b[0] + b[1]) + (b[2] + b[3])) + ((c[0] + c[1]) + (c[2] + c[3])) + ((d[0] + d[1]) + (d[2] + d[3]));
              rs = __builtin_amdgcn_rsqf(s * (1.0f / 1024.0f) + RMS_EPS); }
            bf16_t* rowp = base + (size_t)(row - rowoff) * ldc + colt;
            f32x4 v00 = acc[ai][0][m][0] * rs, v01 = acc[ai][0][m][1] * rs, v10 = acc[ai][1][m][0] * rs, v11 = acc[ai][1][m][1] * rs;
            if (rot) {
                const float posf = (float)(row & 2047);
                f32x4 c0, c1, s0, s1;
#pragma unroll
                for (int e = 0; e < 4; ++e) { const float r0 = __builtin_amdgcn_fractf(posf * frev[e]), r1 = __builtin_amdgcn_fractf(posf * frev[4 + e]);
                    c0[e] = __builtin_amdgcn_cosf(r0); s0[e] = __builtin_amdgcn_sinf(r0); c1[e] = __builtin_amdgcn_cosf(r1); s1[e] = __builtin_amdgcn_sinf(r1); }
                const float sc = (type == 1) ? QSCALE : 1.0f;
                const f32x4 o00 = (v00 * c0 - v10 * s0) * sc, o01 = (v01 * c1 - v11 * s1) * sc;
                const f32x4 o10 = (v10 * c0 + v00 * s0) * sc, o11 = (v11 * c1 + v01 * s1) * sc;
                u32x4 w0, w1;
                w0.x = cvt_pk_bf16(o00[0], o00[1]); w0.y = cvt_pk_bf16(o00[2], o00[3]); w0.z = cvt_pk_bf16(o01[0], o01[1]); w0.w = cvt_pk_bf16(o01[2], o01[3]);
                w1.x = cvt_pk_bf16(o10[0], o10[1]); w1.y = cvt_pk_bf16(o10[2], o10[3]); w1.z = cvt_pk_bf16(o11[0], o11[1]); w1.w = cvt_pk_bf16(o11[2], o11[3]);
                *(u32x4*)(rowp + wc * 64 + 8 * fq) = w0;
                *(u32x4*)(rowp + wc * 64 + 8 * fq + 32) = w1;
            } else {
                if (type == 3) {
#pragma unroll
                    for (int e = 0; e < 4; ++e) {
                        v00[e] = __builtin_amdgcn_rcpf(1.0f + __expf(-v00[e])); v01[e] = __builtin_amdgcn_rcpf(1.0f + __expf(-v01[e]));
                        v10[e] = __builtin_amdgcn_rcpf(1.0f + __expf(-v10[e])); v11[e] = __builtin_amdgcn_rcpf(1.0f + __expf(-v11[e]));
                    }
                }
                u32x4 w0, w1;
                w0.x = cvt_pk_bf16(v00[0], v00[1]); w0.y = cvt_pk_bf16(v00[2], v00[3]); w0.z = cvt_pk_bf16(v01[0], v01[1]); w0.w = cvt_pk_bf16(v01[2], v01[3]);
                w1.x = cvt_pk_bf16(v10[0], v10[1]); w1.y = cvt_pk_bf16(v10[2], v10[3]); w1.z = cvt_pk_bf16(v11[0], v11[1]); w1.w = cvt_pk_bf16(v11[2], v11[3]);
                *(u32x4*)(rowp + wc * 32 + 8 * fq) = w0;
                *(u32x4*)(rowp + wc * 32 + 8 * fq + HALF) = w1;
            }
        }
#undef EPIIN_LOAD
        return false;
    }
};

struct EpiGate {
    static constexpr bool PERM = true, AFTER_DRAIN = false, IDEMPOTENT = false;
    const bf16_t* gates; bf16_t* merged;
    __device__ __forceinline__ bool operator()(f32x4 (&acc)[2][2][4][2], const Unit& u, int wr, int wc, int fr, int fq) const {
        const int row0 = u.pm * BM + wr * 64 + fr, col0 = u.pn * BM + wc * 32 + 8 * fq;
        const bool first = (u.z == 0);
        u32x4 GA[2][2], GH[2][2];
#define EPIG_LOAD(k_, buf_) do { const bf16_t* gp_ = gates + (size_t)(row0 + ((k_) >> 2) * HALF + ((k_) & 3) * 16) * 2048 + col0; \
            GA[buf_][0] = *(const u32x4*)(gp_ + 1024); GA[buf_][1] = *(const u32x4*)(gp_ + 1024 + HALF); \
            if (first) { GH[buf_][0] = *(const u32x4*)(gp_); GH[buf_][1] = *(const u32x4*)(gp_ + HALF); } } while (0)
        EPIG_LOAD(0, 0);
#pragma unroll
        for (int k = 0; k < 8; ++k) {
            const int ai = k >> 2, m = k & 3, cb = k & 1;
            if (k < 7) EPIG_LOAD(k + 1, cb ^ 1);
            const int row = row0 + ai * HALF + m * 16;
#pragma unroll
            for (int bj = 0; bj < 2; ++bj) {
                const u32x4 ga = GA[cb][bj];
                f32x4 a0 = (f32x4){bf_lo(ga.x), bf_hi(ga.x), bf_lo(ga.y), bf_hi(ga.y)}, a1 = (f32x4){bf_lo(ga.z), bf_hi(ga.z), bf_lo(ga.w), bf_hi(ga.w)};
                if (first) {
                    const u32x4 gh = GH[cb][bj];
                    const f32x4 h0 = (f32x4){bf_lo(gh.x), bf_hi(gh.x), bf_lo(gh.y), bf_hi(gh.y)}, h1 = (f32x4){bf_lo(gh.z), bf_hi(gh.z), bf_lo(gh.w), bf_hi(gh.w)};
#pragma unroll
                    for (int e = 0; e < 4; ++e) { a0[e] = fmaxf(a0[e], 1e-30f); a1[e] = fmaxf(a1[e], 1e-30f); }
#pragma unroll
                    for (int e = 0; e < 4; ++e) { acc[ai][bj][m][0][e] *= h0[e] * __builtin_amdgcn_rcpf(a0[e]); acc[ai][bj][m][1][e] *= h1[e] * __builtin_amdgcn_rcpf(a1[e]); }
                } else {
                    const f32x4 v0 = acc[ai][bj][m][0] * a0, v1 = acc[ai][bj][m][1] * a1;
                    u32x4 w; w.x = cvt_pk_bf16(v0[0], v0[1]); w.y = cvt_pk_bf16(v0[2], v0[3]); w.z = cvt_pk_bf16(v1[0], v1[1]); w.w = cvt_pk_bf16(v1[2], v1[3]);
                    *(u32x4*)(merged + (size_t)row * 1024 + col0 + bj * HALF) = w;
                }
            }
        }
#undef EPIG_LOAD
        return first;
    }
};

struct EpiRes {
    static constexpr bool PERM = true, AFTER_DRAIN = false, IDEMPOTENT = false;
    const float* base32; bf16_t* xb; float* ssq;
    __device__ __forceinline__ bool operator()(f32x4 (&acc)[2][2][4][2], const Unit& u, int wr, int wc, int fr, int fq) const {
        int rl = wr * 64 + fr, cl = wc * 32 + 8 * fq;
        asm volatile("" : "+v"(rl), "+v"(cl));
        const bool f32base = base32 != nullptr;
        f32x4 Bv[2][4];
#define EPIRES_LOAD(k_, buf_) do { const size_t off_ = (size_t)(u.pm * BM + ((k_) >> 2) * HALF + ((k_) & 3) * 16 + rl) * 1024 + u.pn * BM + cl; \
            if (f32base) { Bv[buf_][0] = *(const f32x4*)(base32 + off_); Bv[buf_][1] = *(const f32x4*)(base32 + off_ + 4); Bv[buf_][2] = *(const f32x4*)(base32 + off_ + HALF); Bv[buf_][3] = *(const f32x4*)(base32 + off_ + HALF + 4); } \
            else { _Pragma("unroll") for (int j_ = 0; j_ < 2; ++j_) { const u32x4 w_ = *(const u32x4*)(xb + off_ + j_ * HALF); \
                       Bv[buf_][2 * j_] = (f32x4){bf_lo(w_.x), bf_hi(w_.x), bf_lo(w_.y), bf_hi(w_.y)}; Bv[buf_][2 * j_ + 1] = (f32x4){bf_lo(w_.z), bf_hi(w_.z), bf_lo(w_.w), bf_hi(w_.w)}; } } } while (0)
        EPIRES_LOAD(0, 0);
#pragma unroll
        for (int k = 0; k < 8; ++k) {
            const int ai = k >> 2, m = k & 3, cb = k & 1;
            if (k < 7) EPIRES_LOAD(k + 1, cb ^ 1);
            const int row = u.pm * BM + ai * HALF + m * 16 + rl;
            const size_t off = (size_t)row * 1024 + u.pn * BM + cl;
            float s = 0.f;
#pragma unroll
            for (int bj = 0; bj < 2; ++bj) {
                const f32x4 o0 = Bv[cb][bj * 2] + acc[ai][bj][m][0], o1 = Bv[cb][bj * 2 + 1] + acc[ai][bj][m][1];
                u32x4 w; w.x = cvt_pk_bf16(o0[0], o0[1]); w.y = cvt_pk_bf16(o0[2], o0[3]); w.z = cvt_pk_bf16(o1[0], o1[1]); w.w = cvt_pk_bf16(o1[2], o1[3]);
                *(u32x4*)(xb + off + bj * HALF) = w;
                s += ((o0[0] * o0[0] + o0[1] * o0[1]) + (o0[2] * o0[2] + o0[3] * o0[3])) + ((o1[0] * o1[0] + o1[1] * o1[1]) + (o1[2] * o1[2] + o1[3] * o1[3]));
            }
            s += __shfl_xor(s, 16); s += __shfl_xor(s, 32);
            if (fq == 0) ssq[(size_t)row * 16 + u.pn * 4 + wc] = s;
        }
#undef EPIRES_LOAD
        return false;
    }
};

struct EpiFF1 {
    static constexpr bool PERM = true, AFTER_DRAIN = false, IDEMPOTENT = true;
    bf16_t* h; const PG8_LAS float* rtab;
    __device__ __forceinline__ bool operator()(f32x4 (&acc)[2][2][4][2], const Unit& u, int wr, int wc, int fr, int fq) const {
        const int row0 = u.pm * BM + wr * 64 + fr;
        const int p0 = ((const PG8_LAS int*)rtab)[768], p1 = ((const PG8_LAS int*)rtab)[769];
        const PG8_LAS float* rt = rtab + ((u.pm == p0) ? 0 : ((u.pm == p1) ? 256 : 512)) + wr * 64 + fr;
        float rsv[8];
#pragma unroll
        for (int k = 0; k < 8; ++k) rsv[k] = rt[(k >> 2) * HALF + (k & 3) * 16];
#pragma unroll
        for (int ai = 0; ai < 2; ++ai)
#pragma unroll
            for (int m = 0; m < 4; ++m) {
                const int row = row0 + ai * HALF + m * 16;
                const float rs = rsv[ai * 4 + m];
                bf16_t* rowp = h + (size_t)row * 4096 + u.pn * BM + wc * 32 + 8 * fq;
#pragma unroll
                for (int bj = 0; bj < 2; ++bj) {
                    f32x4 v0 = acc[ai][bj][m][0] * rs, v1 = acc[ai][bj][m][1] * rs;
#pragma unroll
                    for (int e = 0; e < 4; ++e) { v0[e] = fmaxf(v0[e], 0.f); v1[e] = fmaxf(v1[e], 0.f); }
                    v0 = v0 * v0; v1 = v1 * v1;
                    u32x4 w; w.x = cvt_pk_bf16(v0[0], v0[1]); w.y = cvt_pk_bf16(v0[2], v0[3]); w.z = cvt_pk_bf16(v1[0], v1[1]); w.w = cvt_pk_bf16(v1[2], v1[3]);
                    *(u32x4*)(rowp + bj * HALF) = w;
                }
            }
        return false;
    }
};

template <class Epi, class Sched, bool ALIGN_EPI = false, bool SP2 = false>
__device__ __forceinline__ void gemm_phase(PG8_LAS unsigned char* lds, const Gemm g, const Sched& S, const Epi& E, int tid_in) {
    int tid_ = tid_in; asm volatile("" : "+v"(tid_));
    const int tid = tid_, wid = __builtin_amdgcn_readfirstlane(tid >> 6), lane = tid & 63, wr = wid >> 2, wc = wid & 3, fr = lane & 15, fq = lane >> 4;
    const int K = g.K, nt = K / BK;
    unsigned voffA[2], voffB[2];
#pragma unroll
    for (int i = 0; i < 2; ++i) { int R, C; stage_rc(tid * 16 + i * 8192, R, C); const int Rb = Epi::PERM ? ((R & ~31) + perm32(R & 31)) : R;
        voffA[i] = (unsigned)(R * K + C) * 2u; voffB[i] = (unsigned)(Rb * K + C) * 2u; }
    const size_t kstep = (size_t)(BK * 2);
    const size_t hstep = (size_t)HALF * K * 2;
    const size_t tstep = 2 * hstep;
    const unsigned ldsw = (unsigned)wid * 1024u;
    const int aoff = lds_byte(wr * 64 + fr, fq * 8), boff = lds_byte(wc * 32 + fr, fq * 8);
#define PG8_SA(b, h) (((b) * 2 + (h)) * HTB)
#define PG8_SB(b, h) ((4 + (b) * 2 + (h)) * HTB)
#define PG8_STAGE(bufoff, gbase, voff) do { _Pragma("unroll") for (int _i = 0; _i < 2; ++_i) \
        __builtin_amdgcn_global_load_lds((const unsigned*)((const char*)(gbase) + (voff)[_i]), (PG8_LAS unsigned*)(lds + (bufoff) + ldsw + _i * 8192), 16, 0, 0); } while (0)
#define PG8_LDA(dst, b, h) do { _Pragma("unroll") for (int m = 0; m < 4; ++m) _Pragma("unroll") for (int k = 0; k < 2; ++k) dst[m][k] = *(const PG8_LAS bf16x8*)(lds + PG8_SA(b, h) + aoff + m * 2048 + k * 1024); } while (0)
#define PG8_LDB(dst, b, h) do { _Pragma("unroll") for (int n = 0; n < 2; ++n) _Pragma("unroll") for (int k = 0; k < 2; ++k) dst[n][k] = *(const PG8_LAS bf16x8*)(lds + PG8_SB(b, h) + boff + n * 2048 + k * 1024); } while (0)
#define PG8_MMA(ai, bj, At, Bt) do { __builtin_amdgcn_s_setprio(1); _Pragma("unroll") for (int m = 0; m < 4; ++m) _Pragma("unroll") for (int n = 0; n < 2; ++n) _Pragma("unroll") for (int k = 0; k < 2; ++k) \
        acc[ai][bj][m][n] = __builtin_amdgcn_mfma_f32_16x16x32_bf16(Bt[n][k], At[m][k], acc[ai][bj][m][n], 0, 0, 0); __builtin_amdgcn_s_setprio(0); } while (0)
#define PG8_WAIT_V(n) asm volatile("s_waitcnt vmcnt(" #n ")" ::: "memory")
#define PG8_WAIT_L(n) asm volatile("s_waitcnt lgkmcnt(" #n ")" ::: "memory")
#define PG8_BAR __builtin_amdgcn_s_barrier()
#define PG8_SCHED __builtin_amdgcn_sched_barrier(0)
    Unit cur, nxt; int ui = 0;
    if (!S.next(0, cur)) return;
    f32x4 acc[2][2][4][2];
#pragma unroll
    for (int a = 0; a < 2; ++a)
#pragma unroll
        for (int b = 0; b < 2; ++b)
#pragma unroll
            for (int m = 0; m < 4; ++m)
#pragma unroll
                for (int n = 0; n < 2; ++n) acc[a][b][m][n] = (f32x4){0.f, 0.f, 0.f, 0.f};
    bf16x8 At[4][2], B0[2][2], B1[2][2];
    const char* cA = (const char*)(cur.z ? g.A1 : g.A) + (size_t)cur.pm * tstep; const char* cB = (const char*)(cur.z ? g.Bt1 : g.Bt) + (size_t)cur.pn * tstep;
    S.a_ready(cur);
    if constexpr (SP2) {
        PG8_STAGE(PG8_SB(0, 0), cB, voffB); PG8_STAGE(PG8_SB(0, 1), cB + hstep, voffB); PG8_STAGE(PG8_SA(0, 0), cA, voffA); PG8_STAGE(PG8_SA(0, 1), cA + hstep, voffA);
        if (wr == 1) PG8_BAR;
        PG8_WAIT_V(2); PG8_BAR;
        PG8_STAGE(PG8_SB(1, 0), cB + kstep, voffB); PG8_STAGE(PG8_SA(1, 0), cA + kstep, voffA); PG8_STAGE(PG8_SB(1, 1), cB + hstep + kstep, voffB);
        PG8_WAIT_V(6); PG8_BAR;
    } else {
        PG8_STAGE(PG8_SB(0, 0), cB, voffB); PG8_STAGE(PG8_SA(0, 0), cA, voffA); PG8_STAGE(PG8_SB(0, 1), cB + hstep, voffB); PG8_STAGE(PG8_SA(0, 1), cA + hstep, voffA);
        if (wr == 1) PG8_BAR;
        PG8_WAIT_V(4); PG8_BAR;
        PG8_STAGE(PG8_SB(1, 0), cB + kstep, voffB); PG8_STAGE(PG8_SA(1, 0), cA + kstep, voffA); PG8_STAGE(PG8_SB(1, 1), cB + hstep + kstep, voffB);
        PG8_WAIT_V(6); PG8_BAR;
    }
    for (;;) {
        const bool has_next = S.next(ui + 1, nxt);
        const char* nA = has_next ? (const char*)(nxt.z ? g.A1 : g.A) + (size_t)nxt.pm * tstep : cA; const char* nB = has_next ? (const char*)(nxt.z ? g.Bt1 : g.Bt) + (size_t)nxt.pn * tstep : cB;
        for (int t = 0; t < nt; t += 2) {
            const bool last = (t == nt - 2);
            const char* a1 = cA + (size_t)(t + 1) * kstep;
            const char* a2 = last ? nA : cA + (size_t)(t + 2) * kstep; const char* b2 = last ? nB : cB + (size_t)(t + 2) * kstep;
            const char* a3 = a2 + kstep; const char* b3 = b2 + kstep;
            if (last && has_next) S.a_ready(nxt);
            if constexpr (SP2) {
            PG8_LDB(B0, 0, 0); PG8_LDB(B1, 0, 1); PG8_SCHED; PG8_LDA(At, 0, 0); PG8_STAGE(PG8_SA(1, 1), a1 + hstep, voffA);
            PG8_WAIT_V(8); PG8_WAIT_L(0); PG8_BAR; PG8_MMA(0, 0, At, B0); PG8_MMA(0, 1, At, B1); PG8_BAR; PG8_SCHED;
            PG8_LDA(At, 0, 1); PG8_STAGE(PG8_SB(0, 0), b2, voffB); PG8_STAGE(PG8_SB(0, 1), b2 + hstep, voffB); PG8_STAGE(PG8_SA(0, 0), a2, voffA);
            PG8_WAIT_V(8); PG8_WAIT_L(0); PG8_BAR; PG8_MMA(1, 0, At, B0); PG8_MMA(1, 1, At, B1); PG8_BAR; PG8_SCHED;
            PG8_LDB(B0, 1, 0); PG8_LDB(B1, 1, 1); PG8_SCHED; PG8_LDA(At, 1, 0); PG8_STAGE(PG8_SA(0, 1), a2 + hstep, voffA);
            PG8_WAIT_V(8); PG8_WAIT_L(0); PG8_BAR; PG8_MMA(0, 0, At, B0); PG8_MMA(0, 1, At, B1); PG8_BAR; PG8_SCHED;
            PG8_LDA(At, 1, 1); PG8_STAGE(PG8_SB(1, 0), b3, voffB); PG8_STAGE(PG8_SB(1, 1), b3 + hstep, voffB); PG8_STAGE(PG8_SA(1, 0), a3, voffA);
            PG8_WAIT_V(8); PG8_WAIT_L(0); PG8_BAR; PG8_MMA(1, 0, At, B0); PG8_MMA(1, 1, At, B1); PG8_BAR; PG8_SCHED;
            } else {
            PG8_LDB(B0, 0, 0); PG8_SCHED; PG8_LDA(At, 0, 0); PG8_STAGE(PG8_SA(1, 1), a1 + hstep, voffA);
            PG8_WAIT_L(8); PG8_BAR; PG8_WAIT_L(0); PG8_MMA(0, 0, At, B0); PG8_BAR; PG8_SCHED;
            PG8_LDB(B1, 0, 1); PG8_STAGE(PG8_SB(0, 0), b2, voffB);
            PG8_BAR; PG8_WAIT_L(0); PG8_MMA(0, 1, At, B1); PG8_BAR;
            PG8_LDA(At, 0, 1); PG8_STAGE(PG8_SA(0, 0), a2, voffA);
            PG8_BAR; PG8_WAIT_L(0); PG8_MMA(1, 0, At, B0); PG8_BAR; PG8_SCHED;
            PG8_STAGE(PG8_SB(0, 1), b2 + hstep, voffB);
            PG8_WAIT_V(6); PG8_BAR; PG8_MMA(1, 1, At, B1); PG8_BAR;
            PG8_LDB(B0, 1, 0); PG8_SCHED; PG8_LDA(At, 1, 0); PG8_STAGE(PG8_SA(0, 1), a2 + hstep, voffA);
            PG8_WAIT_L(8); PG8_BAR; PG8_WAIT_L(0); PG8_MMA(0, 0, At, B0); PG8_BAR; PG8_SCHED;
            PG8_LDB(B1, 1, 1); PG8_STAGE(PG8_SB(1, 0), b3, voffB);
            PG8_BAR; PG8_WAIT_L(0); PG8_MMA(0, 1, At, B1); PG8_BAR;
            PG8_LDA(At, 1, 1); PG8_STAGE(PG8_SA(1, 0), a3, voffA);
            PG8_BAR; PG8_WAIT_L(0); PG8_MMA(1, 0, At, B0); PG8_BAR; PG8_SCHED;
            PG8_STAGE(PG8_SB(1, 1), b3 + hstep, voffB);
            PG8_WAIT_V(6); PG8_BAR; PG8_MMA(1, 1, At, B1); PG8_BAR;
            }
        }
        if constexpr (ALIGN_EPI) { if (wr == 0) PG8_BAR; }
#ifndef PROBE_EPI
#define PROBE_EPI 0
#endif
        bool keep_acc = false; if constexpr (!Epi::AFTER_DRAIN) { keep_acc = E(acc, cur, wr, wc, fr, fq); if constexpr (Epi::IDEMPOTENT && PROBE_EPI) { asm volatile("" ::: "memory"); keep_acc = E(acc, cur, wr, wc, fr, fq); } S.done(cur); }
        if (!has_next) break;
        if (!keep_acc) {
#pragma unroll
        for (int a = 0; a < 2; ++a)
#pragma unroll
            for (int b = 0; b < 2; ++b)
#pragma unroll
                for (int m = 0; m < 4; ++m)
#pragma unroll
                    for (int n = 0; n < 2; ++n) acc[a][b][m][n] = (f32x4){0.f, 0.f, 0.f, 0.f};
        }
        cur = nxt; cA = nA; cB = nB; ++ui;
        if constexpr (ALIGN_EPI) { if (wr == 1) PG8_BAR; }
    }
    PG8_WAIT_V(0);
    if constexpr (!ALIGN_EPI) { if (wr == 0) PG8_BAR; }
    PG8_BAR;
    if constexpr (Epi::AFTER_DRAIN) { E.fused(acc, cur, wr, wc, fr, fq, lds, wid, lane); S.done(cur); }
#undef PG8_SA
#undef PG8_SB
#undef PG8_STAGE
#undef PG8_LDA
#undef PG8_LDB
#undef PG8_MMA
#undef PG8_WAIT_V
#undef PG8_WAIT_L
#undef PG8_BAR
#undef PG8_SCHED
}
}

#define LAS __attribute__((address_space(3)))
typedef unsigned short bf16;
typedef float f32x4 __attribute__((ext_vector_type(4)));
typedef unsigned v4u __attribute__((ext_vector_type(4)));
constexpr int NWAVES = 8, NTHR = 512;
constexpr int MTOK = 32768, DM = 1024, SEQ = 2048, NBATCH = 16, NIN = 8192, DFF = 4096, HYW = 512, HALF_TOK = 16384;
constexpr size_t MiB = (size_t)1 << 20;
constexpr size_t WS_SSQA = 0, WS_SSQB = 2 * MiB, WS_ROPE = 4 * MiB, WS_RSTD = 4 * MiB + 512 * 1024, WS_BAR = 4 * MiB + 768 * 1024, WS_LSE = 5 * MiB, WS_GF = 8 * MiB, WS_W = 16 * MiB, WS_XB = 52 * MiB,
                 WS_HY = 116 * MiB, WS_UT = 212 * MiB, WS_GATES = 116 * MiB, WS_Q = 244 * MiB, WS_KV = 340 * MiB, WS_YHY = 436 * MiB, WS_YATT = 404 * MiB, WS_X0T = 468 * MiB,
                 WS_MERGED = 340 * MiB, WS_H = 116 * MiB, WS_END = 500 * MiB;
constexpr size_t W_IN = 0, W_PHY = 16 * MiB, W_PATT = 17 * MiB, W_O = 18 * MiB, W_FF1 = 20 * MiB, W_FF2 = 28 * MiB;
constexpr int LDS_RTAB = 131072;
constexpr int LDS_ST_OFF = 135168;
constexpr int LDS_BYTES = 139264;

struct Args {
    const float* in[19]; float* out; unsigned char* ws; int pad0, pad1;
};

__device__ __forceinline__ unsigned f2bf(float f) { unsigned u = __float_as_uint(f); return (u + 0x7fffu + ((u >> 16) & 1u)) >> 16; }
__device__ __forceinline__ unsigned pk2(float lo, float hi) { return f2bf(lo) | (f2bf(hi) << 16); }
__device__ __forceinline__ float bf2f(unsigned short b) { return __uint_as_float((unsigned)b << 16); }
__device__ __forceinline__ float wave_sum(float v) {
#pragma unroll
    for (int o = 1; o < 64; o <<= 1) v += __shfl_xor(v, o);
    return v;
}

__device__ __forceinline__ int win_src_col(int n) {
    const int t = n >> 8, j = n & 255;
    if (t < 6) return n;
    if (t >= 24) return 6144 + (n - 6144);
    int g, w, half;
    if (t < 12) { const int i = t - 6; g = i >> 1; w = 0; half = i & 1; }
    else { const int i = t - 12; g = i >> 2; w = 1 + ((i >> 1) & 1); half = i & 1; }
    int hh, d;
    if (w == 2) { hh = j >> 6; d = j & 63; }
    else { hh = (j & 127) >> 5; d = (j & 31) + ((j >> 7) << 5); }
    return 1536 + g * 1536 + w * 512 + (half * 4 + hh) * 64 + d;
}

__device__ __forceinline__ void transpose_item(const float* W, int K, int Nsrc, int s0, bf16* WT, int n0, int k0, const float* gain, LAS float* scr, int lane) {
    float tv[32];
#pragma unroll
    for (int i = 0; i < 32; ++i) { const int kk = 2 * i + (lane >> 5); tv[i] = W[(size_t)(k0 + kk) * Nsrc + s0 + (lane & 31)]; }
    const float gl = gain ? gain[k0 + lane] : 1.0f;
#pragma unroll
    for (int i = 0; i < 32; ++i) { const int kk = 2 * i + (lane >> 5); scr[kk * 33 + (lane & 31)] = tv[i] * __shfl(gl, kk); }
    asm volatile("s_waitcnt lgkmcnt(0)" ::: "memory");
    const int c = lane & 7;
#pragma unroll
    for (int j = 0; j < 4; ++j) { const int n = (lane >> 3) + 8 * j; const LAS float* s = scr + (8 * c) * 33 + n;
        v4u o; o.x = pk2(s[0 * 33], s[1 * 33]); o.y = pk2(s[2 * 33], s[3 * 33]); o.z = pk2(s[4 * 33], s[5 * 33]); o.w = pk2(s[6 * 33], s[7 * 33]);
        *(v4u*)(WT + (size_t)(n0 + n) * K + k0 + 8 * c) = o; }
    asm volatile("s_waitcnt lgkmcnt(0)" ::: "memory");
}

__device__ __forceinline__ void phase_prep_weights(const Args& a, int L, LAS unsigned char* lds, int tid, int lane, int wave, int G) {
    unsigned char* ws = a.ws;
    {
        const float* w1 = a.in[5] + (size_t)L * 33 * 64; const float* b1 = a.in[6] + L * 64;
        const float* wi = a.in[7] + (size_t)L * 2 * 64 * 64; const float* bi = a.in[8] + L * 2 * 64;
        const float* wout = a.in[9] + (size_t)L * 64 * 1024; const float* fr = a.in[10] + L * 64; const float* skip = a.in[11] + L * 512;
        bf16* Rg = (bf16*)(ws + WS_GF);
        const float min_decay = logf(1e-2f) / 1.5f, max_decay = logf(1e-2f) / 0.3f;
        LAS float* hb = (LAS float*)lds + wave * 64;
        LAS float* fbuf = (LAS float*)(lds + 4096);
        const float frl = fr[lane];
        LAS float* wl = (LAS float*)(lds + 40960);
        for (int i = tid; i < 528 + 2048; i += NTHR) { const f32x4 v = (i < 528) ? *((const f32x4*)w1 + i) : *((const f32x4*)wi + (i - 528)); *(LAS f32x4*)(wl + 4 * i) = v; }
        __syncthreads();
#ifndef PROBE_PWF
#define PROBE_PWF 0
#endif
#ifndef PROBE_PWT
#define PROBE_PWT 0
#endif
        _Pragma("unroll 1") for (int repf = 0; repf < 1 + PROBE_PWF; ++repf)
        for (int blk = blockIdx.x; blk < 256; blk += G) {
            int n = 8 * blk + wave + 1; if (n == 2048) n = 0;
            const float t = (float)n / 2047.0f;
            {
                float v = 0.f;
                if (lane == 0) v = t;
                else if (lane < 33) { const int k = (lane - 1) & 15; const float band = 1e-4f + (float)k * ((15.0f - 1e-4f) / 15.0f); const float ang = ((float)(2.0 * 3.14159265358979323846 / 2048.0) * (float)n) * band;
                       v = (lane <= 16) ? cosf(ang) : -sinf(ang); }
                hb[lane] = v;
            }
            float s = b1[lane];
#pragma unroll
            for (int e = 0; e < 33; ++e) s += hb[e] * wl[e * 64 + lane];
            float hcur = sinf(frl * s);
#pragma unroll 1
            for (int layer = 0; layer < 2; ++layer) {
                hb[lane] = hcur;
                float s2 = bi[layer * 64 + lane];
#pragma unroll
                for (int e = 0; e < 64; ++e) s2 += hb[e] * wl[2112 + layer * 4096 + e * 64 + lane];
                hcur = sinf(frl * s2);
            }
            LAS float* hT = (LAS float*)(lds + 2048);
            hT[lane * 8 + wave] = hcur;
            __syncthreads();
            float o[8][2];
#pragma unroll
            for (int p = 0; p < 8; ++p) { o[p][0] = 0.f; o[p][1] = 0.f; }
#pragma unroll 16
            for (int e0 = 0; e0 < 64; ++e0) {
                const int e = (e0 + 8 * ((blk >> 3) & 7)) & 63;
                const f32x4 ha = *(const LAS f32x4*)(hT + e * 8), hc = *(const LAS f32x4*)(hT + e * 8 + 4);
                const float w0 = wout[e * 1024 + 128 * wave + lane], w1v = wout[e * 1024 + 128 * wave + 64 + lane];
#pragma unroll
                for (int p = 0; p < 4; ++p) { o[p][0] += ha[p] * w0; o[p][1] += ha[p] * w1v; o[4 + p][0] += hc[p] * w0; o[4 + p][1] += hc[p] * w1v; }
            }
#pragma unroll
            for (int j = 0; j < 2; ++j) {
                const int col = 128 * wave + 64 * j + lane, c = col & 511;
                const float delta = fabsf(min_decay + (float)c * ((max_decay - min_decay) / 511.0f));
#pragma unroll
                for (int p = 0; p < 8; ++p) { int np = 8 * blk + p + 1; if (np == 2048) np = 0; const float tp = (float)np / 2047.0f; fbuf[p * 1024 + col] = o[p][j] * expf(-tp * delta); }
            }
            __syncthreads();
            if (blk != 255) {
                typedef unsigned u32x2v __attribute__((ext_vector_type(2)));
#pragma unroll
                for (int pp = 0; pp < 2; ++pp) {
                    const int p = tid + 512 * pp, c = p & 511, dir = p >> 9;
                    bf16* r0 = Rg + ((size_t)c * 2 + 0) * 4096; bf16* r1 = Rg + ((size_t)c * 2 + 1) * 4096;
                    unsigned e[8];
#pragma unroll
                    for (int j = 0; j < 8; ++j) e[j] = f2bf(fbuf[(dir ? j : 7 - j) * 1024 + dir * 512 + c]);
                    v4u w8; w8.x = e[0] | (e[1] << 16); w8.y = e[2] | (e[3] << 16); w8.z = e[4] | (e[5] << 16); w8.w = e[6] | (e[7] << 16);
                    if (dir == 0) {
                        const int xb0 = 2040 - 8 * blk;
                        *(v4u*)(r0 + xb0) = w8;
                        r1[xb0 - 1] = (bf16)e[0];
                        u32x2v m4; m4.x = e[1] | (e[2] << 16); m4.y = e[3] | (e[4] << 16); *(u32x2v*)(r1 + xb0) = m4;
                        *(unsigned*)(r1 + xb0 + 4) = e[5] | (e[6] << 16);
                        r1[xb0 + 6] = (bf16)e[7];
                    } else {
                        const int xa = 2049 + 8 * blk;
                        *(v4u*)(r1 + xa - 1) = w8;
                        r0[xa] = (bf16)e[0];
                        *(unsigned*)(r0 + xa + 1) = e[1] | (e[2] << 16);
                        u32x2v m4; m4.x = e[3] | (e[4] << 16); m4.y = e[5] | (e[6] << 16); *(u32x2v*)(r0 + xa + 3) = m4;
                        r0[xa + 7] = (bf16)e[7];
                    }
                }
            } else
#pragma unroll
            for (int pp = 0; pp < 2; ++pp) {
                const int p = tid + 512 * pp, c = p & 511, dir = p >> 9;
                bf16* r0 = Rg + ((size_t)c * 2 + 0) * 4096; bf16* r1 = Rg + ((size_t)c * 2 + 1) * 4096;
#pragma unroll
                for (int wv = 0; wv < 8; ++wv) {
                    int nn = 8 * blk + wv + 1; float val = fbuf[wv * 1024 + dir * 512 + c]; int x;
                    if (nn == 2048) { if (dir != 0) continue; val += skip[c]; x = 2048; }
                    else x = dir ? 2048 + nn : 2048 - nn;
                    const bf16 hv = (bf16)f2bf(val); r0[x] = hv; r1[x - 1] = hv;
                }
            }
            __syncthreads();
        }
    }
    {
        LAS float* scr = (LAS float*)(lds + 40960 + wave * 8704);
        const int gw = blockIdx.x * NWAVES + wave, NGW = G * NWAVES;
        bf16* Wb = (bf16*)(ws + WS_W);
        const float* w_in = a.in[2] + (size_t)L * DM * NIN; const float* p_hy = a.in[12] + (size_t)L * 512 * DM; const float* p_att = a.in[13] + (size_t)L * 512 * DM;
        const float* w_o = a.in[14] + (size_t)L * DM * DM; const float* w1 = a.in[16] + (size_t)L * DM * DFF; const float* w2 = a.in[17] + (size_t)L * DFF * DM;
        const float* g_mix = a.in[1] + L * DM; const float* g_ffn = a.in[15] + L * DM;
        constexpr int I_IN = 16 * 256, I_P = 8 * 32, I_O = 16 * 32, I_1 = 16 * 128, I_2 = 64 * 32;
        constexpr int NITEMS = I_IN + 2 * I_P + I_O + I_1 + I_2;
        _Pragma("unroll 1") for (int rept = 0; rept < 1 + PROBE_PWT; ++rept)
        for (int it = gw; it < NITEMS; it += NGW) {
            int r = it;
            if (r < I_IN) { const int kb = r / 256, nb = r % 256; transpose_item(w_in, DM, NIN, win_src_col(nb * 32), Wb + W_IN / 2, nb * 32, kb * 64, g_mix, scr, lane); continue; } r -= I_IN;
            if (r < I_P) { const int kb = r / 32, nb = r % 32; transpose_item(p_hy, 512, DM, nb * 32, Wb + W_PHY / 2, nb * 32, kb * 64, nullptr, scr, lane); continue; } r -= I_P;
            if (r < I_P) { const int kb = r / 32, nb = r % 32; transpose_item(p_att, 512, DM, nb * 32, Wb + W_PATT / 2, nb * 32, kb * 64, nullptr, scr, lane); continue; } r -= I_P;
            if (r < I_O) { const int kb = r / 32, nb = r % 32; transpose_item(w_o, DM, DM, nb * 32, Wb + W_O / 2, nb * 32, kb * 64, nullptr, scr, lane); continue; } r -= I_O;
            if (r < I_1) { const int kb = r / 128, nb = r % 128; transpose_item(w1, DM, DFF, nb * 32, Wb + W_FF1 / 2, nb * 32, kb * 64, g_ffn, scr, lane); continue; } r -= I_1;
            { const int kb = r / 32, nb = r % 32; transpose_item(w2, DFF, DM, nb * 32, Wb + W_FF2 / 2, nb * 32, kb * 64, nullptr, scr, lane); }
        }
        if (L == 0) {
            const float* x = a.in[0]; bf16* xb = (bf16*)(ws + WS_XB); float* ssq = (float*)(ws + WS_SSQA);
            for (int m0 = gw; m0 < MTOK; m0 += 4 * NGW) {
                f32x4 v[4][4];
#pragma unroll
                for (int rr = 0; rr < 4; ++rr) { const f32x4* xr = (const f32x4*)(x + (size_t)(m0 + rr * NGW) * DM) + lane;
#pragma unroll
                    for (int j = 0; j < 4; ++j) v[rr][j] = xr[64 * j]; }
#pragma unroll
                for (int rr = 0; rr < 4; ++rr) { const int m = m0 + rr * NGW; float s = 0.f;
#pragma unroll
                    for (int j = 0; j < 4; ++j) s += (v[rr][j][0] * v[rr][j][0] + v[rr][j][1] * v[rr][j][1]) + (v[rr][j][2] * v[rr][j][2] + v[rr][j][3] * v[rr][j][3]);
                    s = wave_sum(s);
                    unsigned long long* o8 = (unsigned long long*)(xb + (size_t)m * DM) + lane;
#pragma unroll
                    for (int j = 0; j < 4; ++j) o8[64 * j] = (unsigned long long)pk2(v[rr][j][0], v[rr][j][1]) | ((unsigned long long)pk2(v[rr][j][2], v[rr][j][3]) << 32);
                    if (lane < 16) ssq[(size_t)m * 16 + lane] = (lane == 0) ? s : 0.f; }
            }
            float* rc = (float*)(ws + WS_ROPE); float* rsn = rc + 65536;
            for (int i = blockIdx.x * NTHR + tid; i < 65536; i += G * NTHR) {
                const int pos = i >> 5, f = i & 31;
                const float inv = powf(10000.0f, -(float)f / 32.0f);
                const float ang = (float)pos * inv;
                rc[i] = cosf(ang); rsn[i] = sinf(ang);
            }
        }
    }
}

__device__ __forceinline__ float bfe(const v4u& w, int e) { const unsigned d = (e >> 1) == 0 ? w.x : ((e >> 1) == 1 ? w.y : ((e >> 1) == 2 ? w.z : w.w)); return (e & 1) ? __uint_as_float(d & 0xffff0000u) : __uint_as_float(d << 16); }
__device__ __forceinline__ void phase_prep_u(const Args& a, int L, LAS unsigned char* lds, int tid, int G) {
    const bf16* hy = (const bf16*)(a.ws + WS_HY); bf16* ut = (bf16*)(a.ws + WS_UT); bf16* x0t = (bf16*)(a.ws + WS_X0T);
    const float* cw = a.in[3] + (size_t)L * 3 * 1536; const float* cb = a.in[4] + L * 1536;
    LAS unsigned short* tile = (LAS unsigned short*)lds;
    const int cc = blockIdx.x & 7, ml = tid >> 3, cg8 = tid & 7, c0 = cc * 64 + cg8 * 8;
    float wq[3][4][8];
#pragma unroll
    for (int ar = 0; ar < 3; ++ar)
#pragma unroll
        for (int e = 0; e < 8; ++e) { wq[ar][0][e] = cw[ar * 512 + c0 + e]; wq[ar][1][e] = cw[1536 + ar * 512 + c0 + e]; wq[ar][2][e] = cw[3072 + ar * 512 + c0 + e]; wq[ar][3][e] = cb[ar * 512 + c0 + e]; }
    v4u dn[3][3];
    const v4u zero = (v4u){0u, 0u, 0u, 0u};
#define PU_LOAD(it_) do { const int m_ = ((it_) & 31) * 64 + ml; const bf16* r_ = hy + (size_t)(((it_) >> 5) * SEQ + m_) * 1536 + c0; \
        _Pragma("unroll") for (int ar_ = 0; ar_ < 3; ++ar_) { dn[ar_][0] = (m_ > 0) ? *(const v4u*)(r_ - 1536 + ar_ * 512) : zero; dn[ar_][1] = *(const v4u*)(r_ + ar_ * 512); \
            dn[ar_][2] = (m_ < SEQ - 1) ? *(const v4u*)(r_ + 1536 + ar_ * 512) : zero; } } while (0)
    if ((int)(blockIdx.x >> 3) < 512) PU_LOAD((int)(blockIdx.x >> 3));
    for (int it = blockIdx.x >> 3; it < 512; it += (G >> 3)) {
        const int mc = it & 31, b = it >> 5;
        v4u d[3][3];
#pragma unroll
        for (int ar = 0; ar < 3; ++ar) { d[ar][0] = dn[ar][0]; d[ar][1] = dn[ar][1]; d[ar][2] = dn[ar][2]; }
        if (it + (G >> 3) < 512) PU_LOAD(it + (G >> 3));
#pragma unroll
        for (int e = 0; e < 8; ++e) {
            float cv[3];
#pragma unroll
            for (int ar = 0; ar < 3; ++ar) cv[ar] = wq[ar][3][e] + wq[ar][0][e] * bfe(d[ar][0], e) + wq[ar][1][e] * bfe(d[ar][1], e) + wq[ar][2][e] * bfe(d[ar][2], e);
            tile[(cg8 * 8 + e) * 72 + ml] = (unsigned short)f2bf(cv[1] * cv[2]);
            tile[4608 + (cg8 * 8 + e) * 72 + ml] = (unsigned short)f2bf(cv[0]);
        }
        __syncthreads();
        {
            const int c2 = tid >> 3, ch = tid & 7;
            const LAS unsigned* s = (const LAS unsigned*)(tile + c2 * 72 + ch * 8);
            v4u o; o.x = s[0]; o.y = s[1]; o.z = s[2]; o.w = s[3];
            *(v4u*)(ut + ((size_t)(cc * 64 + c2) * NBATCH + b) * SEQ + mc * 64 + ch * 8) = o;
            const LAS unsigned* s2 = s + 2304;
            v4u o2; o2.x = s2[0]; o2.y = s2[1]; o2.z = s2[2]; o2.w = s2[3];
            *(v4u*)(x0t + ((size_t)(cc * 64 + c2) * NBATCH + b) * SEQ + mc * 64 + ch * 8) = o2;
        }
        __syncthreads();
    }
}

__device__ __forceinline__ void phase_hyena_naive(const Args& a, int L, LAS unsigned char* lds, int tid, int G) {
    const bf16* hy = (const bf16*)(a.ws + WS_HY); const bf16* ut = (const bf16*)(a.ws + WS_UT); const float* Gf = (const float*)(a.ws + WS_GF);
    bf16* yhy = (bf16*)(a.ws + WS_YHY);
    const float* cw = a.in[3] + (size_t)L * 3 * 1536; const float* cb = a.in[4] + L * 1536;
    LAS float* Gs = (LAS float*)lds;
    LAS float* Us = Gs + 4096;
    for (int item = blockIdx.x; item < 2048; item += G) {
        const int c = item >> 2, bq = item & 3;
        for (int i = tid; i < 4096; i += NTHR) Gs[i] = (i == 0) ? 0.f : Gf[(size_t)c * 4096 + i];
        for (int i = tid; i < 8192; i += NTHR) { const int bl = i >> 11, m = i & 2047; Us[i] = bf2f(ut[((size_t)c * NBATCH + bq * 4 + bl) * SEQ + m]); }
        __syncthreads();
        const int bl = tid >> 7, tn = tid & 127;
        float acc[16];
#pragma unroll
        for (int i = 0; i < 16; ++i) acc[i] = 0.f;
        const LAS float* up = Us + bl * 2048;
        for (int m = 0; m < SEQ; ++m) {
            const float u = up[m];
            const LAS float* gp = Gs + (tn - m + 2048);
#pragma unroll
            for (int i = 0; i < 16; ++i) acc[i] += gp[128 * i] * u;
        }
        const int b = bq * 4 + bl;
        const float w0 = cw[c], w1 = cw[1536 + c], w2 = cw[3072 + c], b0 = cb[c];
#pragma unroll
        for (int i = 0; i < 16; ++i) {
            const int n = tn + 128 * i;
            const bf16* r = hy + (size_t)(b * SEQ + n) * 1536 + c;
            const float xm = (n > 0) ? bf2f(r[-1536]) : 0.f, xc = bf2f(r[0]), xp = (n < SEQ - 1) ? bf2f(r[1536]) : 0.f;
            const float x0 = b0 + w0 * xm + w1 * xc + w2 * xp;
            yhy[(size_t)(b * SEQ + n) * 512 + c] = (bf16)f2bf(x0 * acc[i]);
        }
        __syncthreads();
    }
}

__device__ __forceinline__ void phase_attn_naive(const Args& a, int half, int tid, int G) {
    bf16* Q = (bf16*)(a.ws + WS_Q); const bf16* KV = (const bf16*)(a.ws + WS_KV); float* lse = (float*)(a.ws + WS_LSE);
    for (int idx = blockIdx.x * NTHR + tid; idx < 3 * 8 * HALF_TOK; idx += G * NTHR) {
        const int g = idx / (8 * HALF_TOK), t = idx % (8 * HALF_TOK), h = t / HALF_TOK, tokl = t % HALF_TOK;
        const int dil = (g == 0) ? 1 : (g == 1 ? 4 : 16);
        const int token = half * HALF_TOK + tokl, s = token & 2047;
        bf16* qp = Q + (size_t)token * 1536 + g * 512 + h * 64;
        float q[64], o[64];
#pragma unroll
        for (int i = 0; i < 8; ++i) { const v4u w = *(const v4u*)(qp + 8 * i);
            q[8 * i + 0] = __uint_as_float(w.x << 16); q[8 * i + 1] = __uint_as_float(w.x & 0xffff0000u); q[8 * i + 2] = __uint_as_float(w.y << 16); q[8 * i + 3] = __uint_as_float(w.y & 0xffff0000u);
            q[8 * i + 4] = __uint_as_float(w.z << 16); q[8 * i + 5] = __uint_as_float(w.z & 0xffff0000u); q[8 * i + 6] = __uint_as_float(w.w << 16); q[8 * i + 7] = __uint_as_float(w.w & 0xffff0000u); }
#pragma unroll
        for (int i = 0; i < 64; ++i) o[i] = 0.f;
        float mx = -1e30f, l = 0.f;
        for (int j = -64; j <= 64; ++j) {
            const int sp = s + j * dil;
            if (sp < 0 || sp >= SEQ) continue;
            const bf16* kp = KV + (size_t)(tokl + j * dil) * 3072 + g * 1024 + h * 64;
            float sc = 0.f;
#pragma unroll
            for (int i = 0; i < 8; ++i) { const v4u w = *(const v4u*)(kp + 8 * i);
                sc += q[8 * i + 0] * __uint_as_float(w.x << 16) + q[8 * i + 1] * __uint_as_float(w.x & 0xffff0000u) + q[8 * i + 2] * __uint_as_float(w.y << 16) + q[8 * i + 3] * __uint_as_float(w.y & 0xffff0000u)
                    + q[8 * i + 4] * __uint_as_float(w.z << 16) + q[8 * i + 5] * __uint_as_float(w.z & 0xffff0000u) + q[8 * i + 6] * __uint_as_float(w.w << 16) + q[8 * i + 7] * __uint_as_float(w.w & 0xffff0000u); }
            const float mn = fmaxf(mx, sc), corr = exp2f(mx - mn), p = exp2f(sc - mn);
            l = l * corr + p; mx = mn;
            const bf16* vp = kp + 512;
#pragma unroll
            for (int i = 0; i < 8; ++i) { const v4u w = *(const v4u*)(vp + 8 * i);
                o[8 * i + 0] = o[8 * i + 0] * corr + p * __uint_as_float(w.x << 16); o[8 * i + 1] = o[8 * i + 1] * corr + p * __uint_as_float(w.x & 0xffff0000u);
                o[8 * i + 2] = o[8 * i + 2] * corr + p * __uint_as_float(w.y << 16); o[8 * i + 3] = o[8 * i + 3] * corr + p * __uint_as_float(w.y & 0xffff0000u);
                o[8 * i + 4] = o[8 * i + 4] * corr + p * __uint_as_float(w.z << 16); o[8 * i + 5] = o[8 * i + 5] * corr + p * __uint_as_float(w.z & 0xffff0000u);
                o[8 * i + 6] = o[8 * i + 6] * corr + p * __uint_as_float(w.w << 16); o[8 * i + 7] = o[8 * i + 7] * corr + p * __uint_as_float(w.w & 0xffff0000u); }
        }
        const float inv = 1.0f / l;
#pragma unroll
        for (int i = 0; i < 8; ++i) { v4u w; w.x = pk2(o[8 * i] * inv, o[8 * i + 1] * inv); w.y = pk2(o[8 * i + 2] * inv, o[8 * i + 3] * inv); w.z = pk2(o[8 * i + 4] * inv, o[8 * i + 5] * inv); w.w = pk2(o[8 * i + 6] * inv, o[8 * i + 7] * inv);
            *(v4u*)(qp + 8 * i) = w; }
        lse[((size_t)g * MTOK + token) * 8 + h] = mx + log2f(l);
    }
}

__device__ __forceinline__ void phase_combine(const Args& a, int tid, int G) {
    const bf16* Q = (const bf16*)(a.ws + WS_Q); const float* lse = (const float*)(a.ws + WS_LSE); bf16* ya = (bf16*)(a.ws + WS_YATT);
    const int stride = G * NTHR;
    for (int idx0 = blockIdx.x * NTHR + tid; idx0 < MTOK * 64; idx0 += 4 * stride) {
        float l0[4], l1[4], l2[4]; v4u a0[4], a1[4], a2[4];
#pragma unroll
        for (int j = 0; j < 4; ++j) { int idx = idx0 + j * stride; if (idx >= MTOK * 64) idx = idx0; const int token = idx >> 6, ch = idx & 63, h = ch >> 3;
            l0[j] = lse[((size_t)0 * MTOK + token) * 8 + h]; l1[j] = lse[((size_t)1 * MTOK + token) * 8 + h]; l2[j] = lse[((size_t)2 * MTOK + token) * 8 + h];
            const bf16* p = Q + (size_t)token * 1536 + ch * 8;
            a0[j] = *(const v4u*)p; a1[j] = *(const v4u*)(p + 512); a2[j] = *(const v4u*)(p + 1024); }
#pragma unroll
        for (int j = 0; j < 4; ++j) { const int idx = idx0 + j * stride; if (idx >= MTOK * 64) continue; const int token = idx >> 6, ch = idx & 63;
            const float mx = fmaxf(l0[j], fmaxf(l1[j], l2[j]));
            float w0 = exp2f(l0[j] - mx), w1 = exp2f(l1[j] - mx), w2 = exp2f(l2[j] - mx);
            const float inv = 1.0f / (w0 + w1 + w2); w0 *= inv; w1 *= inv; w2 *= inv;
            v4u o;
#define CMB(f) pk2(w0 * __uint_as_float(a0[j].f << 16) + w1 * __uint_as_float(a1[j].f << 16) + w2 * __uint_as_float(a2[j].f << 16), \
                   w0 * __uint_as_float(a0[j].f & 0xffff0000u) + w1 * __uint_as_float(a1[j].f & 0xffff0000u) + w2 * __uint_as_float(a2[j].f & 0xffff0000u))
            o.x = CMB(x); o.y = CMB(y); o.z = CMB(z); o.w = CMB(w);
#undef CMB
            *(v4u*)(ya + (size_t)token * 512 + ch * 8) = o; }
    }
}

__device__ __forceinline__ void phase_final_norm(const Args& a, int lane, int wave, int G) {
    float* out = a.out; const float* gain = a.in[18]; const bf16* xb = (const bf16*)(a.ws + WS_XB);
    const int gw = blockIdx.x * NWAVES + wave, NGW = G * NWAVES;
    typedef unsigned u32x2v __attribute__((ext_vector_type(2)));
    f32x4 gn[4];
#pragma unroll
    for (int j = 0; j < 4; ++j) gn[j] = *((const f32x4*)gain + lane + 64 * j);
    for (int m0 = gw; m0 < MTOK; m0 += 4 * NGW) {
        u32x2v w[4][4];
#pragma unroll
        for (int rr = 0; rr < 4; ++rr) { const int m = (m0 + rr * NGW < MTOK) ? m0 + rr * NGW : m0; const u32x2v* xr = (const u32x2v*)(xb + (size_t)m * DM) + lane;
#pragma unroll
            for (int j = 0; j < 4; ++j) w[rr][j] = xr[64 * j]; }
#pragma unroll
        for (int rr = 0; rr < 4; ++rr) { const int m = m0 + rr * NGW; if (m >= MTOK) continue;
            f32x4 v[4]; float s = 0.f;
#pragma unroll
            for (int j = 0; j < 4; ++j) { v[j] = (f32x4){__uint_as_float(w[rr][j].x << 16), __uint_as_float(w[rr][j].x & 0xffff0000u), __uint_as_float(w[rr][j].y << 16), __uint_as_float(w[rr][j].y & 0xffff0000u)};
                s += (v[j][0] * v[j][0] + v[j][1] * v[j][1]) + (v[j][2] * v[j][2] + v[j][3] * v[j][3]); }
            s = wave_sum(s);
            const float rs = 1.0f / sqrtf(s * (1.0f / 1024.0f) + 1e-6f);
            f32x4* orow = (f32x4*)(out + (size_t)m * DM) + lane;
#pragma unroll
            for (int j = 0; j < 4; ++j) orow[64 * j] = v[j] * rs * gn[j]; }
    }
}

typedef short bf16x8 __attribute__((ext_vector_type(8)));
typedef short s16x4 __attribute__((ext_vector_type(4)));
constexpr int HY_UROW = 4112, HY_ROFF = 16 * HY_UROW, HY_RSTRIDE = 8192 + 64;
__device__ __forceinline__ bf16x8 ld_frag4(const LAS unsigned char* p) {
    const LAS unsigned* q = (const LAS unsigned*)p; v4u d; d.x = q[0]; d.y = q[1]; d.z = q[2]; d.w = q[3]; return __builtin_bit_cast(bf16x8, d);
}
__device__ __forceinline__ void phase_hyena_mfma(const Args& a, LAS unsigned char* lds, int tid, int G, bool dummy = false) {
    const bf16* ut = (const bf16*)(a.ws + WS_UT); const bf16* Rg = (const bf16*)(a.ws + WS_GF); bf16* x0t = (bf16*)(a.ws + WS_X0T);
    const int lane = tid & 63, w = __builtin_amdgcn_readfirstlane(tid >> 6), i16 = lane & 15, kq = lane >> 4;
    const int base = (w >> 1) * 512 + (w & 1) * 16, cp = i16 & 1;
    const int lane_const = (2048 - base - i16 + 8 * kq - cp) >> 1;
    const LAS unsigned char* pA15 = lds + HY_ROFF + cp * HY_RSTRIDE + 4 * (lane_const - 240);
    const LAS unsigned char* pB = lds + i16 * HY_UROW + kq * 16;
    v4u pre[10];
#define HY_ISSUE(chn) do { _Pragma("unroll") for (int k_ = 0; k_ < 8; ++k_) { const int i_ = tid + NTHR * k_, b_ = i_ >> 8, ck_ = i_ & 255; pre[k_] = *(const v4u*)(ut + ((size_t)(chn) * NBATCH + b_) * SEQ + ck_ * 8); } \
        _Pragma("unroll") for (int k_ = 0; k_ < 2; ++k_) { const int i_ = tid + NTHR * k_, c2_ = i_ >> 9, ck_ = i_ & 511; pre[8 + k_] = *(const v4u*)(Rg + ((size_t)(chn) * 2 + c2_) * 4096 + ck_ * 8); } } while (0)
    for (int ch = blockIdx.x; ch < HYW; ch += G) {
        HY_ISSUE(ch);
#pragma unroll
        for (int k = 0; k < 8; ++k) { const int i = tid + NTHR * k, b = i >> 8, ck = i & 255; *(LAS v4u*)(lds + b * HY_UROW + ck * 16) = pre[k]; }
#pragma unroll
        for (int k = 0; k < 2; ++k) { const int i = tid + NTHR * k, c2 = i >> 9, ck = i & 511; *(LAS v4u*)(lds + HY_ROFF + c2 * HY_RSTRIDE + ck * 16) = pre[8 + k]; }
        __syncthreads();
        f32x4 acc[16]; bf16x8 W[16];
#pragma unroll
        for (int i = 0; i < 16; ++i) acc[i] = (f32x4){0.f, 0.f, 0.f, 0.f};
#pragma unroll
        for (int j = 1; j < 16; ++j) W[j] = ld_frag4(pA15 + 64 * (15 - j));
        W[0] = W[1];
#pragma unroll 1
        for (int tt = 0; tt < 4; ++tt) {
            const LAS unsigned char* pa = pA15 + 64 * 15 + 1024 * tt; const LAS unsigned char* pb = pB + 1024 * tt;
#pragma unroll
            for (int s = 0; s < 16; ++s) {
                W[(16 - s) & 15] = ld_frag4(pa + 64 * s);
                const bf16x8 Bf = *(const LAS bf16x8*)(pb + 64 * s);
                __builtin_amdgcn_s_setprio(1);
#pragma unroll
                for (int i = 0; i < 16; ++i) acc[i] = __builtin_amdgcn_mfma_f32_16x16x32_bf16(W[(i - s) & 15], Bf, acc[i], 0, 0, 0);
                __builtin_amdgcn_s_setprio(0);
            }
        }
        bf16* xo = x0t + ((size_t)ch * NBATCH + i16) * SEQ + base + 4 * kq;
        typedef unsigned u32x2v __attribute__((ext_vector_type(2)));
        u32x2v xall[16];
#pragma unroll
        for (int i = 0; i < 16; ++i) xall[i] = *(const u32x2v*)(xo + 32 * i);
#pragma unroll
        for (int i = 0; i < 16; ++i) {
            const u32x2v xv = xall[i];
            u32x2v o; o.x = pk2(__uint_as_float(xv.x << 16) * acc[i][0], __uint_as_float(xv.x & 0xffff0000u) * acc[i][1]);
            o.y = pk2(__uint_as_float(xv.y << 16) * acc[i][2], __uint_as_float(xv.y & 0xffff0000u) * acc[i][3]);
            if (!dummy) *(u32x2v*)(xo + 32 * i) = o; else *(u32x2v*)((bf16*)(a.ws + WS_YHY) + (size_t)tid * 64 + 4 * i) = o;
        }
        __syncthreads();
    }
}

__device__ __forceinline__ void phase_transpose_y(const Args& a, LAS unsigned char* lds, int tid, int G) {
    const bf16* yt = (const bf16*)(a.ws + WS_X0T); bf16* yhy = (bf16*)(a.ws + WS_YHY);
    LAS unsigned short* tile = (LAS unsigned short*)lds;
#define TY_LOAD(item_) (*(const v4u*)(yt + ((size_t)(((item_) & 7) * 64 + (tid >> 3)) * NBATCH + ((item_) >> 8)) * SEQ + (((item_) >> 3) & 31) * 64 + (tid & 7) * 8))
    v4u vnext = (v4u){0u, 0u, 0u, 0u};
    if ((int)blockIdx.x < 4096) vnext = TY_LOAD((int)blockIdx.x);
    for (int item = blockIdx.x; item < 4096; item += G) {
        const int cc = item & 7, mc = (item >> 3) & 31, b = item >> 8;
        { const int c2 = tid >> 3, ck = tid & 7;
          const v4u v = vnext;
          LAS unsigned* t4 = (LAS unsigned*)(tile + c2 * 72 + ck * 8); t4[0] = v.x; t4[1] = v.y; t4[2] = v.z; t4[3] = v.w; }
        __syncthreads();
        if (item + G < 4096) vnext = TY_LOAD(item + G);
        { const int nl = tid >> 3, cg8 = tid & 7; const LAS unsigned short* s = tile + (cg8 * 8) * 72 + nl;
          v4u o; o.x = s[0] | ((unsigned)s[72] << 16); o.y = s[144] | ((unsigned)s[216] << 16); o.z = s[288] | ((unsigned)s[360] << 16); o.w = s[432] | ((unsigned)s[504] << 16);
          *(v4u*)(yhy + (size_t)(b * SEQ + mc * 64 + nl) * 512 + cc * 64 + cg8 * 8) = o; }
        __syncthreads();
    }
}

constexpr int AT_ROWS = 272, AT_RS = 144, AT_VOFF = AT_ROWS * AT_RS;
__device__ __forceinline__ void phase_attn_mfma(const Args& a, int half, LAS unsigned char* lds, int tid, int G, bool dummy = false) {
    bf16* Q = (bf16*)(a.ws + WS_Q); const bf16* KV = (const bf16*)(a.ws + WS_KV); float* lse = (float*)(a.ws + WS_LSE);
    const int lane = tid & 63, w = __builtin_amdgcn_readfirstlane(tid >> 6), q16 = lane & 15, kq = lane >> 4;
    v4u pre[9]; bf16x8 Qn0, Qn1;
#define AT_DECODE(unit_) const int g = (unit_) >> 10, u = (unit_) & 1023, sub = u & 15, h = (u >> 4) & 7, bl = u >> 7; int dil, n, r, qb; \
        if (g == 0) { dil = 1; n = 2048; r = 0; qb = sub; } else if (g == 1) { dil = 4; n = 512; r = sub >> 2; qb = sub & 3; } else { dil = 16; n = 128; r = sub; qb = 0; } \
        const int q0 = qb * 128, kb0 = q0 - 64; (void)kb0; (void)q0;
#define AT_ISSUE(unit_, PRE_, QN0_, QN1_) do { AT_DECODE(unit_) { const bf16* qn_ = Q + (size_t)(half * HALF_TOK + bl * SEQ + (q0 + 16 * w + q16) * dil + r) * 1536 + g * 512 + h * 64; QN0_ = *(const bf16x8*)(qn_ + 8 * kq); QN1_ = *(const bf16x8*)(qn_ + 32 + 8 * kq); } \
        _Pragma("unroll") for (int k_ = 0; k_ < 9; ++k_) { const int i_ = tid + NTHR * k_; \
            const int which_ = (i_ >= AT_ROWS * 8) ? 1 : 0, j_ = i_ - which_ * AT_ROWS * 8, rr_ = j_ >> 3, ck_ = j_ & 7, key_ = kb0 + rr_; \
            PRE_[k_] = (v4u){0u, 0u, 0u, 0u}; \
            if (i_ < 2 * AT_ROWS * 8 && key_ >= 0 && key_ < n) PRE_[k_] = *(const v4u*)(KV + (size_t)(bl * SEQ + key_ * dil + r) * 3072 + g * 1024 + which_ * 512 + h * 64 + ck_ * 8); } } while (0)
    const int vb = ((G & 7) == 0) ? (int)((blockIdx.x & 7) * (G >> 3) + (blockIdx.x >> 3)) : (int)blockIdx.x;
#define AT_STEP(UNIT_, PRE_, QN0_, QN1_) do { \
_Pragma("unroll") \
        for (int k = 0; k < 9; ++k) { const int i = tid + NTHR * k; const int which = (i >= AT_ROWS * 8) ? 1 : 0, j = i - which * AT_ROWS * 8, rr = j >> 3, ck = j & 7; \
            if (i < 2 * AT_ROWS * 8) *(LAS v4u*)(lds + which * AT_VOFF + rr * AT_RS + ck * 16) = PRE_[k]; } \
        const bf16x8 Qf0 = QN0_, Qf1 = QN1_; \
        __syncthreads(); \
        if (UNIT_ + 2 * G < 3072) AT_ISSUE(UNIT_ + 2 * G, PRE_, QN0_, QN1_); \
        AT_DECODE(UNIT_) \
        { \
            const int i0 = q0 + 16 * w; \
            const int token = half * HALF_TOK + bl * SEQ + (i0 + q16) * dil + r; \
            bf16* qp = Q + (size_t)token * 1536 + g * 512 + h * 64; \
            bf16* op = dummy ? (bf16*)(a.ws + WS_YHY) + (size_t)(tid & 511) * 64 : qp; \
            f32x4 acc[4]; \
_Pragma("unroll") \
            for (int dt = 0; dt < 4; ++dt) acc[dt] = (f32x4){0.f, 0.f, 0.f, 0.f}; \
            const bool edge = (i0 < 64) || (i0 + 80 > n); \
            const LAS unsigned char* kbase = lds + (16 * w + q16) * AT_RS + 16 * kq; \
            const LAS unsigned char* vbase = lds + AT_VOFF + (16 * w + 4 * kq + (q16 >> 2)) * AT_RS + 8 * (q16 & 3); \
            f32x4 s[9]; \
_Pragma("unroll") \
            for (int kt = 0; kt < 9; ++kt) { \
                const LAS unsigned char* kp = kbase + kt * 16 * AT_RS; \
                const bf16x8 K0 = *(const LAS bf16x8*)kp, K1 = *(const LAS bf16x8*)(kp + 64); \
                f32x4 z = (f32x4){0.f, 0.f, 0.f, 0.f}; \
                z = __builtin_amdgcn_mfma_f32_16x16x32_bf16(K0, Qf0, z, 0, 0, 0); \
                z = __builtin_amdgcn_mfma_f32_16x16x32_bf16(K1, Qf1, z, 0, 0, 0); \
                if (kt == 0 || kt == 8 || edge) { \
_Pragma("unroll") \
                    for (int e = 0; e < 4; ++e) { \
                        const int rel = 16 * kt - 64 + 4 * kq + e - q16, j = i0 + q16 + rel; \
                        const bool ok = (rel >= -64) && (rel <= 64) && (j >= 0) && (j < n); \
                        z[e] = ok ? z[e] : -1e30f; \
                    } } \
                s[kt] = z; \
            } \
            float mrun = -1e30f; \
_Pragma("unroll") \
            for (int kt = 0; kt < 9; ++kt) mrun = fmaxf(mrun, fmaxf(fmaxf(s[kt][0], s[kt][1]), fmaxf(s[kt][2], s[kt][3]))); \
            mrun = fmaxf(mrun, __shfl_xor(mrun, 16)); mrun = fmaxf(mrun, __shfl_xor(mrun, 32)); \
            float lrun = 0.f; \
_Pragma("unroll") \
            for (int kt = 0; kt < 9; ++kt) \
_Pragma("unroll") \
                for (int e = 0; e < 4; ++e) { s[kt][e] = __builtin_amdgcn_exp2f(s[kt][e] - mrun); lrun += s[kt][e]; } \
_Pragma("unroll") \
            for (int st = 0; st < 5; ++st) { \
                v4u pw; pw.x = pg8::cvt_pk_bf16(s[2 * st][0], s[2 * st][1]); pw.y = pg8::cvt_pk_bf16(s[2 * st][2], s[2 * st][3]); \
                if (st < 4) { pw.z = pg8::cvt_pk_bf16(s[2 * st + 1][0], s[2 * st + 1][1]); pw.w = pg8::cvt_pk_bf16(s[2 * st + 1][2], s[2 * st + 1][3]); } else { pw.z = 0u; pw.w = 0u; } \
                const bf16x8 Pf = __builtin_bit_cast(bf16x8, pw); \
_Pragma("unroll") \
                for (int dt = 0; dt < 4; ++dt) { \
                    const LAS unsigned char* vp = vbase + 32 * st * AT_RS + 32 * dt; \
                    const s16x4 v0 = __builtin_amdgcn_ds_read_tr16_b64_v4i16((LAS s16x4*)vp); \
                    const s16x4 v1 = __builtin_amdgcn_ds_read_tr16_b64_v4i16((LAS s16x4*)(vp + 16 * AT_RS)); \
                    const bf16x8 Vf = (bf16x8){v0[0], v0[1], v0[2], v0[3], v1[0], v1[1], v1[2], v1[3]}; \
                    acc[dt] = __builtin_amdgcn_mfma_f32_16x16x32_bf16(Vf, Pf, acc[dt], 0, 0, 0); \
                } \
            } \
            lrun += __shfl_xor(lrun, 16); lrun += __shfl_xor(lrun, 32); \
            const float inv = 1.0f / lrun; \
            typedef unsigned u32x2v __attribute__((ext_vector_type(2))); \
_Pragma("unroll") \
            for (int dt = 0; dt < 4; ++dt) { \
                u32x2v o; o.x = pg8::cvt_pk_bf16(acc[dt][0] * inv, acc[dt][1] * inv); o.y = pg8::cvt_pk_bf16(acc[dt][2] * inv, acc[dt][3] * inv); \
                *(u32x2v*)(op + 16 * dt + 4 * kq) = o; \
            } \
            if (kq == 0 && !dummy) lse[((size_t)g * MTOK + token) * 8 + h] = mrun + log2f(lrun); \
        } \
        __syncthreads(); \
    } while (0)
    v4u preB[9]; bf16x8 QnB0, QnB1;
    if (vb < 3072) AT_ISSUE(vb, pre, Qn0, Qn1);
    if (vb + G < 3072) AT_ISSUE(vb + G, preB, QnB0, QnB1);
    for (int unit = vb; unit < 3072; unit += 2 * G) {
        AT_STEP(unit, pre, Qn0, Qn1);
        if (unit + G < 3072) AT_STEP(unit + G, preB, QnB0, QnB1);
    }
}

#define XB_TMO      128
#define XB_XCNT(j)  (256  + 64 * (j))
#define XB_XSUB(j)  (1280 + 64 * (j))
#define XB_XGEN(j)  (2304 + 64 * (j))
#define XB_TOP      3328
#define XB_TOPGEN   3392
#define XCD_BAR_WORDS 3456
#define XB_SPIN_CAP (1u << 18)

__device__ __forceinline__ unsigned xb_ld(unsigned* p)              { return __hip_atomic_load(p, __ATOMIC_RELAXED, __HIP_MEMORY_SCOPE_AGENT); }
__device__ __forceinline__ unsigned xb_add(unsigned* p, unsigned v) { return __hip_atomic_fetch_add(p, v, __ATOMIC_RELAXED, __HIP_MEMORY_SCOPE_AGENT); }
__device__ __forceinline__ unsigned xb_xcc_id() { return (unsigned)__builtin_amdgcn_s_getreg((3 << 11) | 20) & 0xFu; }
#define XB_SPIN(cond, bar) do { unsigned _sp = 0; while (cond) { __builtin_amdgcn_s_sleep(1); \
    if ((++_sp & 255u) == 0u) { if (xb_ld(&(bar)[XB_TMO])) break; if (_sp > XB_SPIN_CAP) { atomicAdd(&(bar)[XB_TMO], 1u); break; } } } } while (0)

struct XcdBarrier {
    unsigned* bar; unsigned x;
    volatile LAS unsigned* st;
};

__device__ __forceinline__ XcdBarrier xcd_barrier_post(unsigned* bar, volatile LAS unsigned* st, bool is_t0) {
    XcdBarrier b; b.bar = bar; b.x = xb_xcc_id(); b.st = st;
    if (is_t0) (void)xb_add(&bar[XB_XCNT(b.x)], 1u);
    return b;
}
__device__ __forceinline__ void xcd_barrier_complete(unsigned* bar, unsigned x, unsigned& nloc, unsigned& nx) {
    const unsigned G = gridDim.x * gridDim.y * gridDim.z;
    unsigned sum, cnt, mine, sp = 0u;
    for (;;) {
        sum = 0u; cnt = 0u; mine = 0u;
#pragma unroll
        for (unsigned j = 0; j < 16; ++j) { const unsigned c = xb_ld(&bar[XB_XCNT(j)]); sum += c; cnt += (c > 0u) ? 1u : 0u; mine = (j == x) ? c : mine; }
        if (sum == G) break;
        __builtin_amdgcn_s_sleep(1);
        if ((++sp & 255u) == 0u) { if (xb_ld(&bar[XB_TMO])) break; if (sp > XB_SPIN_CAP) { atomicAdd(&bar[XB_TMO], 1u); break; } }
    }
    nloc = mine > 0u ? mine : 1u; nx = cnt > 0u ? cnt : 1u;
}

__device__ __forceinline__ void xcd_barrier(const XcdBarrier& b, bool is_t0) {
    asm volatile("s_waitcnt vmcnt(0)" ::: "memory");
    __syncthreads();
    if (is_t0) {
        unsigned* bar = b.bar;
        __builtin_amdgcn_s_waitcnt(0);
        unsigned nloc = b.st[0], nx = b.st[1];
        if (nloc == 0u) { xcd_barrier_complete(bar, b.x, nloc, nx); b.st[0] = nloc; b.st[1] = nx; }
        const unsigned old = xb_add(&bar[XB_XSUB(b.x)], 1u);
        const unsigned gen = old / nloc;
        if (old + 1u == (gen + 1u) * nloc) {
            __builtin_amdgcn_fence(__ATOMIC_RELEASE, "agent");
            asm volatile("s_waitcnt vmcnt(0)" ::: "memory");
            const unsigned og = xb_add(&bar[XB_TOP], 1u);
            const unsigned tg = og / nx;
            if (og + 1u == (tg + 1u) * nx) xb_add(&bar[XB_TOPGEN], 1u);
            else XB_SPIN(xb_ld(&bar[XB_TOPGEN]) == tg, bar);
            __builtin_amdgcn_fence(__ATOMIC_ACQUIRE, "agent");
            xb_add(&bar[XB_XGEN(b.x)], 1u);
            asm volatile("s_waitcnt vmcnt(0)" ::: "memory");
        } else {
            XB_SPIN(xb_ld(&bar[XB_XGEN(b.x)]) == gen, bar);
            __builtin_amdgcn_fence(__ATOMIC_ACQUIRE, "agent");
            asm volatile("s_waitcnt vmcnt(0)" ::: "memory");
        }
    }
    __syncthreads();
}

__device__ __forceinline__ void stagger(int bx, unsigned ticks_per_class) {
    const unsigned q = ((unsigned)bx >> 3) & 3u;
    if (q) { const unsigned long long t0 = __builtin_amdgcn_s_memrealtime(), dt = (unsigned long long)q * ticks_per_class;
             while (__builtin_amdgcn_s_memrealtime() - t0 < dt) __builtin_amdgcn_s_sleep(8); }
}
#ifndef STAG_ON
#define STAG_ON 0
#endif
#ifndef STAG_LIGHT
#define STAG_LIGHT 300u
#endif
#ifndef STAG_HEAVY
#define STAG_HEAVY 1000u
#endif
#define GEMM_CALL(EPI, SCHED, g, S, E) do { if (STAG_ON) stagger(bx, EPI::PERM ? STAG_LIGHT : STAG_HEAVY); pg8::gemm_phase<EPI, SCHED, true, true>(lds, g, S, E, tid); } while (0)
#ifndef PROBE_G
#define PROBE_G 0
#endif
#ifndef PROBE_S
#define PROBE_S 0
#endif
#define GEMM_CALL_P(EPI, SCHED, g, S, E) do { _Pragma("unroll 1") for (int rep_ = 0; rep_ < 1 + PROBE_G; ++rep_) { GEMM_CALL(EPI, SCHED, g, S, E); } } while (0)
#ifndef PROBE_PW
#define PROBE_PW 0
#endif
#ifndef PROBE_PU
#define PROBE_PU 0
#endif
#ifndef PROBE_CT
#define PROBE_CT 0
#endif
#ifndef PROBE_AT
#define PROBE_AT 0
#endif
#ifndef PROBE_HY
#define PROBE_HY 0
#endif
#define REP_N(N_) _Pragma("unroll 1") for (int rep_ = 0; rep_ < 1 + (N_); ++rep_)

__device__ __forceinline__ int lane_id_volatile() { int l; asm volatile("v_mbcnt_lo_u32_b32 %0, -1, 0\n\tv_mbcnt_hi_u32_b32 %0, -1, %0" : "=v"(l)); return l; }
typedef const __attribute__((address_space(4))) Args* KArgs;
__device__ __forceinline__ Args load_args() {
#if defined(__HIP_DEVICE_COMPILE__)
    KArgs p = (KArgs)__builtin_amdgcn_kernarg_segment_ptr();
    asm volatile("" : "+s"(p));
    return *p;
#else
    return Args{};
#endif
}
__global__ void __launch_bounds__(NTHR, 2) fwd_megakernel(Args a_unused) {
    extern __shared__ __attribute__((aligned(16))) unsigned char lds_raw[];
    LAS unsigned char* lds = (LAS unsigned char*)lds_raw;
    cg::grid_group grid = cg::this_grid();
    const int wave0 = __builtin_amdgcn_readfirstlane((int)threadIdx.x >> 6);
    const int G0 = gridDim.x, bx0 = blockIdx.x;
#define TID0() (wave0 * 64 + lane_id_volatile())
    { const int t0_ = TID0(); if (t0_ < 2) ((LAS unsigned*)(lds + LDS_ST_OFF))[t0_] = 0u; }
    __syncthreads();
    { const Args a0 = load_args(); (void)xcd_barrier_post((unsigned*)(a0.ws + WS_BAR), (volatile LAS unsigned*)(lds + LDS_ST_OFF), TID0() == 0); }
#define GSYNC() do { const Args ab = load_args(); XcdBarrier xb_; xb_.bar = (unsigned*)(ab.ws + WS_BAR); xb_.x = xb_xcc_id(); xb_.st = (volatile LAS unsigned*)(lds + LDS_ST_OFF); xcd_barrier(xb_, TID0() == 0); } while (0)
#define PTRS() const Args a = load_args(); int tid = TID0(), G = G0, bx = bx0; asm volatile("" : "+v"(tid), "+s"(G), "+s"(bx)); const int lane = tid & 63, wave = __builtin_amdgcn_readfirstlane(tid >> 6); (void)lane; (void)wave; unsigned char* ws = a.ws; bf16* Wb = (bf16*)(ws + WS_W); const pg8::bf16_t* xb = (const pg8::bf16_t*)(ws + WS_XB); \
    const float* rcos = (const float*)(ws + WS_ROPE); const float* rsin = rcos + 65536; float* ssqA = (float*)(ws + WS_SSQA); float* ssqB = (float*)(ws + WS_SSQB); \
    (void)Wb; (void)xb; (void)rcos; (void)rsin; (void)ssqA; (void)ssqB;
#define GIN() pg8::Gemm gin{xb, (const pg8::bf16_t*)(Wb + W_IN / 2), nullptr, nullptr, MTOK, NIN, DM}; \
    pg8::EpiIn Ein{(pg8::bf16_t*)(ws + WS_HY), (pg8::bf16_t*)(ws + WS_Q), (pg8::bf16_t*)(ws + WS_KV), (pg8::bf16_t*)(ws + WS_GATES), ssqA, rcos, rsin, 0};
#define FILL_RTAB(S_, ssq_, E_) pg8::fill_rstd_table(S_, ssq_, (LAS float*)(lds + LDS_RTAB), tid)

#pragma unroll 1
    for (int L = 0; L < 2; ++L) {
        REP_N(PROBE_PW) { PTRS(); phase_prep_weights(a, L, lds, tid, lane, wave, G); }
        if (L == 0) grid.sync(); else GSYNC();
        {
            PTRS(); GIN();
            pg8::TwoRect S; S.a.init(128, 12, 0, 0, G, bx); S.b.init(64, 12, 0, 12, G, bx); S.na = S.a.count();
            GEMM_CALL_P(pg8::EpiIn, pg8::TwoRect, gin, S, Ein);
        }
        GSYNC();
        REP_N(PROBE_AT) { PTRS(); phase_attn_mfma(a, 0, lds, tid, G, rep_ < PROBE_AT); } { PTRS(); REP_N(PROBE_PU) { phase_prep_u(a, L, lds, tid, G); } }
        GSYNC();
        {
            PTRS(); GIN();
            pg8::RectOrder S; S.init(64, 12, 64, 12, G, bx);
            Ein.kv_row0 = HALF_TOK;
            GEMM_CALL_P(pg8::EpiIn, pg8::RectOrder, gin, S, Ein);
        }
        REP_N(PROBE_HY) { PTRS(); phase_hyena_mfma(a, lds, tid, G, rep_ < PROBE_HY); }
        GSYNC();
        REP_N(PROBE_AT) { PTRS(); phase_attn_mfma(a, 1, lds, tid, G, rep_ < PROBE_AT); }
        {
            PTRS(); GIN();
            pg8::RectOrder S; S.init(128, 8, 0, 24, G, bx);
            GEMM_CALL_P(pg8::EpiIn, pg8::RectOrder, gin, S, Ein);
        }
        GSYNC();
        REP_N(PROBE_CT) { PTRS(); phase_combine(a, tid, G); phase_transpose_y(a, lds, tid, G); }
        GSYNC();
        {
            PTRS();
            pg8::Gemm g{(const pg8::bf16_t*)(ws + WS_YHY), (const pg8::bf16_t*)(Wb + W_PHY / 2), (const pg8::bf16_t*)(ws + WS_YATT), (const pg8::bf16_t*)(Wb + W_PATT / 2), MTOK, DM, 512};
            pg8::PairOrder S; S.r.init(128, 4, 0, 0, G, bx);
            pg8::EpiGate E{(const pg8::bf16_t*)(ws + WS_GATES), (pg8::bf16_t*)(ws + WS_MERGED)};
            GEMM_CALL_P(pg8::EpiGate, pg8::PairOrder, g, S, E);
        }
        GSYNC();
        {
            PTRS();
            pg8::Gemm g{(const pg8::bf16_t*)(ws + WS_MERGED), (const pg8::bf16_t*)(Wb + W_O / 2), nullptr, nullptr, MTOK, DM, DM};
            pg8::RectOrder S; S.init(128, 4, 0, 0, G, bx);
            pg8::EpiRes E{L == 0 ? a.in[0] : nullptr, (pg8::bf16_t*)(ws + WS_XB), ssqB};
            GEMM_CALL(pg8::EpiRes, pg8::RectOrder, g, S, E);
        }
        GSYNC();
        {
            PTRS();
            pg8::Gemm g{xb, (const pg8::bf16_t*)(Wb + W_FF1 / 2), nullptr, nullptr, MTOK, DFF, DM};
            pg8::RectOrder S; S.init(128, 16, 0, 0, G, bx);
            pg8::EpiFF1 E{(pg8::bf16_t*)(ws + WS_H), (const LAS float*)(lds + LDS_RTAB)};
            FILL_RTAB(S, ssqB, E);
            GEMM_CALL_P(pg8::EpiFF1, pg8::RectOrder, g, S, E);
        }
        GSYNC();
        {
            PTRS();
            pg8::Gemm g{(const pg8::bf16_t*)(ws + WS_H), (const pg8::bf16_t*)(Wb + W_FF2 / 2), nullptr, nullptr, MTOK, DM, DFF};
            pg8::RectOrder S; S.init(128, 4, 0, 0, G, bx);
            pg8::EpiRes E{nullptr, (pg8::bf16_t*)(ws + WS_XB), ssqA};
            GEMM_CALL(pg8::EpiRes, pg8::RectOrder, g, S, E);
        }
        GSYNC();
    }
    { PTRS(); phase_final_norm(a, lane, wave, G); }
}

extern "C" void kernel_launch(void* const* d_in, const int* in_sizes, int n_in, void* d_out, int out_size, void* d_ws, size_t ws_size, hipStream_t stream) {
    static int grid = 0;
    if (grid == 0) {
        if (n_in != 19 || in_sizes[0] != MTOK * DM || out_size != MTOK * DM || ws_size < WS_END) {
            fprintf(stderr, "kernel_launch: unexpected shapes / workspace (n_in %d, ws %zu, need %zu); nothing launched\n", n_in, ws_size, (size_t)WS_END); grid = -1; return; }
        int dev = 0, cus = 0, per_cu = 0;
        (void)hipGetDevice(&dev); (void)hipDeviceGetAttribute(&cus, hipDeviceAttributeMultiprocessorCount, dev);
        if (hipFuncSetAttribute((const void*)fwd_megakernel, hipFuncAttributeMaxDynamicSharedMemorySize, LDS_BYTES) != hipSuccess) { fprintf(stderr, "kernel_launch: hipFuncSetAttribute failed\n"); grid = -1; return; }
        if (hipOccupancyMaxActiveBlocksPerMultiprocessor(&per_cu, (const void*)fwd_megakernel, NTHR, LDS_BYTES) != hipSuccess || per_cu < 1) { fprintf(stderr, "kernel_launch: occupancy query gives %d\n", per_cu); per_cu = 1; }
        (void)hipGetLastError();
        grid = cus * 1;
        if (grid % 8 != 0 || grid > 256) grid = (grid > 256) ? 256 : (grid / 8) * 8;
    }
    if (grid < 0) return;
    Args a{};
    for (int i = 0; i < 19; ++i) a.in[i] = (const float*)d_in[i];
    a.out = (float*)d_out; a.ws = (unsigned char*)d_ws;
    if (hipMemsetAsync((char*)d_ws + WS_BAR, 0, 16384, stream) != hipSuccess) { fprintf(stderr, "kernel_launch: memset of the barrier words failed\n"); return; }
    void* args[] = {&a};
    hipError_t e = hipLaunchCooperativeKernel((const void*)fwd_megakernel, dim3(grid), dim3(NTHR), args, LDS_BYTES, stream);
    if (e != hipSuccess) fprintf(stderr, "cooperative launch failed: %s (grid %d)\n", hipGetErrorString(e), grid);
}
```

```cpp
#include <hip/hip_runtime.h>
#include <hip/hip_cooperative_groups.h>
#include <cstdio>
#include <cstdint>
namespace cg = cooperative_groups;

namespace pg8 {
#define PG8_LAS __attribute__((address_space(3)))
typedef unsigned short bf16_t;
typedef short bf16x8 __attribute__((ext_vector_type(8)));
typedef float f32x4 __attribute__((ext_vector_type(4)));
typedef unsigned u32x4 __attribute__((ext_vector_type(4)));
constexpr int BM = 256, BK = 64, HALF = 128, HTB = HALF * BK * 2  , STAGE_BYTES = 8 * HTB, NXCD = 8, WGM = 8;

__host__ __device__ __forceinline__ int lds_byte(int r, int c) { const int st = (r >> 4) * 2 + (c >> 5), rr = r & 15, cc = c & 31, ob = rr * 64 + cc * 2; return st * 1024 + (ob ^ (((ob >> 9) & 1) << 5)); }
__host__ __device__ __forceinline__ void stage_rc(int b, int& R, int& C) { const int st = b / 1024, sb = b % 1024, swz = sb ^ (((sb >> 9) & 1) << 5); R = (st >> 1) * 16 + swz / 64; C = (st & 1) * 32 + (swz % 64) / 2; }
__host__ __device__ __forceinline__ int perm32(int rho) { const int n = rho >> 4, i = rho & 15; return 8 * (i >> 2) + 4 * n + (i & 3); }

struct Unit { int pm, pn, z; };
struct Gemm { const bf16_t* A; const bf16_t* Bt; const bf16_t* A1; const bf16_t* Bt1; int M, N, K; };

struct StaticOrder {
    int nM, nN, nwg, G, c;
    __host__ __device__ void init(int M, int N, int G_, int c_) { nM = M / BM; nN = N / BM; nwg = nM * nN; G = G_; c = c_; }
    __host__ __device__ bool next(int i, Unit& u) const {
        const long L = (long)i * G + c; if (L >= nwg) return false;
        int wgid = (int)L; { const int q = nwg / NXCD, r = nwg % NXCD, xcd = wgid % NXCD, off = wgid / NXCD; wgid = (xcd < r ? xcd * (q + 1) : r * (q + 1) + (xcd - r) * q) + off; }
        const int nig = WGM * nN, gid = wgid / nig, fm = gid * WGM, gsz = (nM - fm) < WGM ? (nM - fm) : WGM;
        u.pm = fm + ((wgid % nig) % gsz); u.pn = (wgid % nig) / gsz; return true;
    }
    __device__ __forceinline__ void a_ready(const Unit&) const {}
    __device__ __forceinline__ void done(const Unit&) const {}
};


__device__ __forceinline__ unsigned cvt_pk_bf16(float lo, float hi) { unsigned r; asm volatile("v_cvt_pk_bf16_f32 %0, %1, %2" : "=v"(r) : "v"(lo), "v"(hi)); return r; }
__device__ __forceinline__ float bf_lo(unsigned w) { return __uint_as_float(w << 16); }
__device__ __forceinline__ float bf_hi(unsigned w) { return __uint_as_float(w & 0xffff0000u); }

struct RectOrder {
    int nN, nwg, G, c, pm0, pn0;
    __device__ __forceinline__ void init(int nM_, int nN_, int pm0_, int pn0_, int G_, int c_) { nN = nN_; nwg = nM_ * nN_; G = G_; c = c_; pm0 = pm0_; pn0 = pn0_; }
    __device__ __forceinline__ int count() const { return nwg > c ? (nwg - c + G - 1) / G : 0; }
    __device__ __forceinline__ bool next(int i, Unit& u) const {
        const long L = (long)i * G + c; if (L >= nwg) return false;
        int w = (int)L;
        if ((nwg & 7) == 0 && (G & 7) == 0) w = (c & 7) * (nwg >> 3) + (w >> 3);
        const int nig = 8 * nN, gid = w / nig, r = w % nig;
        u.pm = pm0 + gid * 8 + (r & 7); u.pn = pn0 + (r >> 3); u.z = 0; return true;
    }
    __device__ __forceinline__ void a_ready(const Unit&) const {}
    __device__ __forceinline__ void done(const Unit&) const {}
};
struct TwoRect {
    RectOrder a, b; int na;
    __device__ __forceinline__ bool next(int i, Unit& u) const { return i < na ? a.next(i, u) : b.next(i - na, u); }
    __device__ __forceinline__ void a_ready(const Unit&) const {}
    __device__ __forceinline__ void done(const Unit&) const {}
};
struct PairOrder {
    RectOrder r;
    __device__ __forceinline__ bool next(int i, Unit& u) const { const bool ok = r.next(i >> 1, u); u.z = i & 1; return ok; }
    __device__ __forceinline__ void a_ready(const Unit&) const {}
    __device__ __forceinline__ void done(const Unit&) const {}
};

constexpr float RMS_EPS = 1e-6f;
constexpr float QSCALE = 0.125f * 1.44269504088896341f;

__device__ __forceinline__ float row_rstd(const float* ssq, int row) {
    const f32x4* p = (const f32x4*)(ssq + (size_t)row * 16);
    const f32x4 a = p[0], b = p[1], c = p[2], d = p[3];
    const float s = ((a[0] + a[1]) + (a[2] + a[3])) + ((b[0] + b[1]) + (b[2] + b[3])) + ((c[0] + c[1]) + (c[2] + c[3])) + ((d[0] + d[1]) + (d[2] + d[3]));
    return __builtin_amdgcn_rsqf(s * (1.0f / 1024.0f) + RMS_EPS);
}

template <class Sched>
__device__ __forceinline__ void fill_rstd_table(const Sched& S, const float* ssq, PG8_LAS float* rtab, int tid) {
    int q0 = -1, q1 = -1, q2 = -1; Unit u;
#pragma unroll 1
    for (int i = 0; S.next(i, u); ++i) { if (u.pm == q0 || u.pm == q1 || u.pm == q2) continue; if (q0 < 0) q0 = u.pm; else if (q1 < 0) q1 = u.pm; else if (q2 < 0) q2 = u.pm; }
    if (tid == 0) { ((PG8_LAS int*)rtab)[768] = q0; ((PG8_LAS int*)rtab)[769] = q1; ((PG8_LAS int*)rtab)[770] = 0; }
    const int t = tid & 255, half = tid >> 8;
    { const int pm = half ? q1 : q0; if (pm >= 0) { rtab[half * 256 + t] = row_rstd(ssq, pm * BM + t); } }
    if (q2 >= 0 && half == 0) { const float v = row_rstd(ssq, q2 * BM + t); rtab[512 + t] = v; }
    __syncthreads();
}

struct EpiIn {
    static constexpr bool PERM = true, AFTER_DRAIN = false, IDEMPOTENT = true;
    bf16_t* hy; bf16_t* q; bf16_t* kv; bf16_t* gates; const PG8_LAS float* rtab; int kv_row0;
    __device__ __forceinline__ bool operator()(f32x4 (&acc)[2][2][4][2], const Unit& u, int wr, int wc, int fr, int fq) const {
        const int pn = u.pn; int type, ldc, colt, rowoff = 0; bf16_t* base;
        if (pn < 6) { type = 0; base = hy; ldc = 1536; colt = pn * 256; }
        else if (pn < 12) { type = 1; base = q; ldc = 1536; colt = (pn - 6) * 256; }
        else if (pn < 24) { const int idx = pn - 12; type = ((idx >> 1) & 1) ? 0 : 2; base = kv; ldc = 3072; colt = idx * 256; rowoff = kv_row0; }
        else { type = 3; base = gates; ldc = 2048; colt = (pn - 24) * 256; }
        const bool rot = (type == 1 || type == 2);
        const int row0 = u.pm * BM + wr * 64 + fr;
        const int p0 = ((const PG8_LAS int*)rtab)[768], p1 = ((const PG8_LAS int*)rtab)[769];
        const PG8_LAS float* rt = rtab + ((u.pm == p0) ? 0 : ((u.pm == p1) ? 256 : 512)) + wr * 64 + fr;
        float frev[8];
#pragma unroll
        for (int e = 0; e < 8; ++e) frev[e] = __builtin_amdgcn_exp2f(-(float)(8 * fq + e) * (13.287712379549449f / 32.0f)) * 0.15915494309189535f;
#pragma unroll
        for (int k = 0; k < 8; ++k) {
            const int ai = k >> 2, m = k & 3, cb = k & 1;
            const int row = row0 + ai * HALF + m * 16;
            const float rs = rt[ai * HALF + m * 16];
            bf16_t* rowp = base + (size_t)(row - rowoff) * ldc + colt;
            f32x4 v00 = acc[ai][0][m][0] * rs, v01 = acc[ai][0][m][1] * rs, v10 = acc[ai][1][m][0] * rs, v11 = acc[ai][1][m][1] * rs;
            if (rot) {
                const float posf = (float)(row & 2047);
                f32x4 c0, c1, s0, s1;
#pragma unroll
                for (int e = 0; e < 4; ++e) { const float r0 = __builtin_amdgcn_fractf(posf * frev[e]), r1 = __builtin_amdgcn_fractf(posf * frev[4 + e]);
                    c0[e] = __builtin_amdgcn_cosf(r0); s0[e] = __builtin_amdgcn_sinf(r0); c1[e] = __builtin_amdgcn_cosf(r1); s1[e] = __builtin_amdgcn_sinf(r1); }
                const float sc = (type == 1) ? QSCALE : 1.0f;
                const f32x4 o00 = (v00 * c0 - v10 * s0) * sc, o01 = (v01 * c1 - v11 * s1) * sc;
                const f32x4 o10 = (v10 * c0 + v00 * s0) * sc, o11 = (v11 * c1 + v01 * s1) * sc;
                u32x4 w0, w1;
                w0.x = cvt_pk_bf16(o00[0], o00[1]); w0.y = cvt_pk_bf16(o00[2], o00[3]); w0.z = cvt_pk_bf16(o01[0], o01[1]); w0.w = cvt_pk_bf16(o01[2], o01[3]);
                w1.x = cvt_pk_bf16(o10[0], o10[1]); w1.y = cvt_pk_bf16(o10[2], o10[3]); w1.z = cvt_pk_bf16(o11[0], o11[1]); w1.w = cvt_pk_bf16(o11[2], o11[3]);
                *(u32x4*)(rowp + wc * 64 + 8 * fq) = w0;
                *(u32x4*)(rowp + wc * 64 + 8 * fq + 32) = w1;
            } else {
                if (type == 3) {
#pragma unroll
                    for (int e = 0; e < 4; ++e) {
                        v00[e] = __builtin_amdgcn_rcpf(1.0f + __expf(-v00[e])); v01[e] = __builtin_amdgcn_rcpf(1.0f + __expf(-v01[e]));
                        v10[e] = __builtin_amdgcn_rcpf(1.0f + __expf(-v10[e])); v11[e] = __builtin_amdgcn_rcpf(1.0f + __expf(-v11[e]));
                    }
                }
                u32x4 w0, w1;
                w0.x = cvt_pk_bf16(v00[0], v00[1]); w0.y = cvt_pk_bf16(v00[2], v00[3]); w0.z = cvt_pk_bf16(v01[0], v01[1]); w0.w = cvt_pk_bf16(v01[2], v01[3]);
                w1.x = cvt_pk_bf16(v10[0], v10[1]); w1.y = cvt_pk_bf16(v10[2], v10[3]); w1.z = cvt_pk_bf16(v11[0], v11[1]); w1.w = cvt_pk_bf16(v11[2], v11[3]);
                *(u32x4*)(rowp + wc * 32 + 8 * fq) = w0;
                *(u32x4*)(rowp + wc * 32 + 8 * fq + HALF) = w1;
            }
        }
        return false;
    }
};

struct EpiGate {
    static constexpr bool PERM = true, AFTER_DRAIN = false, IDEMPOTENT = false;
    const bf16_t* gates; bf16_t* merged;
    __device__ __forceinline__ bool operator()(f32x4 (&acc)[2][2][4][2], const Unit& u, int wr, int wc, int fr, int fq) const {
        const int row0 = u.pm * BM + wr * 64 + fr, col0 = u.pn * BM + wc * 32 + 8 * fq;
        const bool first = (u.z == 0);
        u32x4 GA[2][2], GH[2][2];
#define EPIG_LOAD(k_, buf_) do { const bf16_t* gp_ = gates + (size_t)(row0 + ((k_) >> 2) * HALF + ((k_) & 3) * 16) * 2048 + col0; \
            GA[buf_][0] = *(const u32x4*)(gp_ + 1024); GA[buf_][1] = *(const u32x4*)(gp_ + 1024 + HALF); \
            if (first) { GH[buf_][0] = *(const u32x4*)(gp_); GH[buf_][1] = *(const u32x4*)(gp_ + HALF); } } while (0)
        EPIG_LOAD(0, 0);
#pragma unroll
        for (int k = 0; k < 8; ++k) {
            const int ai = k >> 2, m = k & 3, cb = k & 1;
            if (k < 7) EPIG_LOAD(k + 1, cb ^ 1);
            const int row = row0 + ai * HALF + m * 16;
#pragma unroll
            for (int bj = 0; bj < 2; ++bj) {
                const u32x4 ga = GA[cb][bj];
                f32x4 a0 = (f32x4){bf_lo(ga.x), bf_hi(ga.x), bf_lo(ga.y), bf_hi(ga.y)}, a1 = (f32x4){bf_lo(ga.z), bf_hi(ga.z), bf_lo(ga.w), bf_hi(ga.w)};
                if (first) {
                    const u32x4 gh = GH[cb][bj];
                    const f32x4 h0 = (f32x4){bf_lo(gh.x), bf_hi(gh.x), bf_lo(gh.y), bf_hi(gh.y)}, h1 = (f32x4){bf_lo(gh.z), bf_hi(gh.z), bf_lo(gh.w), bf_hi(gh.w)};
#pragma unroll
                    for (int e = 0; e < 4; ++e) { a0[e] = fmaxf(a0[e], 1e-30f); a1[e] = fmaxf(a1[e], 1e-30f); }
#pragma unroll
                    for (int e = 0; e < 4; ++e) { acc[ai][bj][m][0][e] *= h0[e] * __builtin_amdgcn_rcpf(a0[e]); acc[ai][bj][m][1][e] *= h1[e] * __builtin_amdgcn_rcpf(a1[e]); }
                } else {
                    const f32x4 v0 = acc[ai][bj][m][0] * a0, v1 = acc[ai][bj][m][1] * a1;
                    u32x4 w; w.x = cvt_pk_bf16(v0[0], v0[1]); w.y = cvt_pk_bf16(v0[2], v0[3]); w.z = cvt_pk_bf16(v1[0], v1[1]); w.w = cvt_pk_bf16(v1[2], v1[3]);
                    *(u32x4*)(merged + (size_t)row * 1024 + col0 + bj * HALF) = w;
                }
            }
        }
#undef EPIG_LOAD
        return first;
    }
};

struct EpiRes {
    static constexpr bool PERM = true, AFTER_DRAIN = false, IDEMPOTENT = false;
    const float* base32; bf16_t* xb; float* ssq;
    __device__ __forceinline__ bool operator()(f32x4 (&acc)[2][2][4][2], const Unit& u, int wr, int wc, int fr, int fq) const {
        int rl = wr * 64 + fr, cl = wc * 32 + 8 * fq;
        asm volatile("" : "+v"(rl), "+v"(cl));
        const bool f32base = base32 != nullptr;
        f32x4 Bv[2][4];
#define EPIRES_LOAD(k_, buf_) do { const size_t off_ = (size_t)(u.pm * BM + ((k_) >> 2) * HALF + ((k_) & 3) * 16 + rl) * 1024 + u.pn * BM + cl; \
            if (f32base) { Bv[buf_][0] = *(const f32x4*)(base32 + off_); Bv[buf_][1] = *(const f32x4*)(base32 + off_ + 4); Bv[buf_][2] = *(const f32x4*)(base32 + off_ + HALF); Bv[buf_][3] = *(const f32x4*)(base32 + off_ + HALF + 4); } \
            else { _Pragma("unroll") for (int j_ = 0; j_ < 2; ++j_) { const u32x4 w_ = *(const u32x4*)(xb + off_ + j_ * HALF); \
                       Bv[buf_][2 * j_] = (f32x4){bf_lo(w_.x), bf_hi(w_.x), bf_lo(w_.y), bf_hi(w_.y)}; Bv[buf_][2 * j_ + 1] = (f32x4){bf_lo(w_.z), bf_hi(w_.z), bf_lo(w_.w), bf_hi(w_.w)}; } } } while (0)
        EPIRES_LOAD(0, 0);
#pragma unroll
        for (int k = 0; k < 8; ++k) {
            const int ai = k >> 2, m = k & 3, cb = k & 1;
            if (k < 7) EPIRES_LOAD(k + 1, cb ^ 1);
            const int row = u.pm * BM + ai * HALF + m * 16 + rl;
            const size_t off = (size_t)row * 1024 + u.pn * BM + cl;
            float s = 0.f;
#pragma unroll
            for (int bj = 0; bj < 2; ++bj) {
                const f32x4 o0 = Bv[cb][bj * 2] + acc[ai][bj][m][0], o1 = Bv[cb][bj * 2 + 1] + acc[ai][bj][m][1];
                u32x4 w; w.x = cvt_pk_bf16(o0[0], o0[1]); w.y = cvt_pk_bf16(o0[2], o0[3]); w.z = cvt_pk_bf16(o1[0], o1[1]); w.w = cvt_pk_bf16(o1[2], o1[3]);
                *(u32x4*)(xb + off + bj * HALF) = w;
                s += ((o0[0] * o0[0] + o0[1] * o0[1]) + (o0[2] * o0[2] + o0[3] * o0[3])) + ((o1[0] * o1[0] + o1[1] * o1[1]) + (o1[2] * o1[2] + o1[3] * o1[3]));
            }
            s += __shfl_xor(s, 16); s += __shfl_xor(s, 32);
            if (fq == 0) ssq[(size_t)row * 16 + u.pn * 4 + wc] = s;
        }
#undef EPIRES_LOAD
        return false;
    }
};

struct EpiFF1 {
    static constexpr bool PERM = true, AFTER_DRAIN = false, IDEMPOTENT = true;
    bf16_t* h; const PG8_LAS float* rtab;
    __device__ __forceinline__ bool operator()(f32x4 (&acc)[2][2][4][2], const Unit& u, int wr, int wc, int fr, int fq) const {
        const int row0 = u.pm * BM + wr * 64 + fr;
        const int p0 = ((const PG8_LAS int*)rtab)[768], p1 = ((const PG8_LAS int*)rtab)[769];
        const PG8_LAS float* rt = rtab + ((u.pm == p0) ? 0 : ((u.pm == p1) ? 256 : 512)) + wr * 64 + fr;
        float rsv[8];
#pragma unroll
        for (int k = 0; k < 8; ++k) rsv[k] = rt[(k >> 2) * HALF + (k & 3) * 16];
#pragma unroll
        for (int ai = 0; ai < 2; ++ai)
#pragma unroll
            for (int m = 0; m < 4; ++m) {
                const int row = row0 + ai * HALF + m * 16;
                const float rs = rsv[ai * 4 + m];
                bf16_t* rowp = h + (size_t)row * 4096 + u.pn * BM + wc * 32 + 8 * fq;
#pragma unroll
                for (int bj = 0; bj < 2; ++bj) {
                    f32x4 v0 = acc[ai][bj][m][0] * rs, v1 = acc[ai][bj][m][1] * rs;
#pragma unroll
                    for (int e = 0; e < 4; ++e) { v0[e] = fmaxf(v0[e], 0.f); v1[e] = fmaxf(v1[e], 0.f); }
                    v0 = v0 * v0; v1 = v1 * v1;
                    u32x4 w; w.x = cvt_pk_bf16(v0[0], v0[1]); w.y = cvt_pk_bf16(v0[2], v0[3]); w.z = cvt_pk_bf16(v1[0], v1[1]); w.w = cvt_pk_bf16(v1[2], v1[3]);
                    *(u32x4*)(rowp + bj * HALF) = w;
                }
            }
        return false;
    }
};

template <class Epi, class Sched, bool ALIGN_EPI = false, bool SP2 = false>
__device__ __forceinline__ void gemm_phase(PG8_LAS unsigned char* lds, const Gemm g, const Sched& S, const Epi& E, int tid_in) {
    int tid_ = tid_in; asm volatile("" : "+v"(tid_));
    const int tid = tid_, wid = __builtin_amdgcn_readfirstlane(tid >> 6), lane = tid & 63, wr = wid >> 2, wc = wid & 3, fr = lane & 15, fq = lane >> 4;
    const int K = g.K, nt = K / BK;
    unsigned voffA[2], voffB[2];
#pragma unroll
    for (int i = 0; i < 2; ++i) { int R, C; stage_rc(tid * 16 + i * 8192, R, C); const int Rb = Epi::PERM ? ((R & ~31) + perm32(R & 31)) : R;
        voffA[i] = (unsigned)(R * K + C) * 2u; voffB[i] = (unsigned)(Rb * K + C) * 2u; }
    const size_t kstep = (size_t)(BK * 2);
    const size_t hstep = (size_t)HALF * K * 2;
    const size_t tstep = 2 * hstep;
    const unsigned ldsw = (unsigned)wid * 1024u;
    const int aoff = lds_byte(wr * 64 + fr, fq * 8), boff = lds_byte(wc * 32 + fr, fq * 8);
#define PG8_SA(b, h) (((b) * 2 + (h)) * HTB)
#define PG8_SB(b, h) ((4 + (b) * 2 + (h)) * HTB)
#define PG8_STAGE(bufoff, gbase, voff) do { _Pragma("unroll") for (int _i = 0; _i < 2; ++_i) \
        __builtin_amdgcn_global_load_lds((const unsigned*)((const char*)(gbase) + (voff)[_i]), (PG8_LAS unsigned*)(lds + (bufoff) + ldsw + _i * 8192), 16, 0, 0); } while (0)
#define PG8_LDA(dst, b, h) do { _Pragma("unroll") for (int m = 0; m < 4; ++m) _Pragma("unroll") for (int k = 0; k < 2; ++k) dst[m][k] = *(const PG8_LAS bf16x8*)(lds + PG8_SA(b, h) + aoff + m * 2048 + k * 1024); } while (0)
#define PG8_LDB(dst, b, h) do { _Pragma("unroll") for (int n = 0; n < 2; ++n) _Pragma("unroll") for (int k = 0; k < 2; ++k) dst[n][k] = *(const PG8_LAS bf16x8*)(lds + PG8_SB(b, h) + boff + n * 2048 + k * 1024); } while (0)
#define PG8_MMA(ai, bj, At, Bt) do { __builtin_amdgcn_s_setprio(1); _Pragma("unroll") for (int m = 0; m < 4; ++m) _Pragma("unroll") for (int n = 0; n < 2; ++n) _Pragma("unroll") for (int k = 0; k < 2; ++k) \
        acc[ai][bj][m][n] = __builtin_amdgcn_mfma_f32_16x16x32_bf16(Bt[n][k], At[m][k], acc[ai][bj][m][n], 0, 0, 0); __builtin_amdgcn_s_setprio(0); } while (0)
#define PG8_WAIT_V(n) asm volatile("s_waitcnt vmcnt(" #n ")" ::: "memory")
#define PG8_WAIT_L(n) asm volatile("s_waitcnt lgkmcnt(" #n ")" ::: "memory")
#define PG8_BAR __builtin_amdgcn_s_barrier()
#define PG8_SCHED __builtin_amdgcn_sched_barrier(0)
    Unit cur, nxt; int ui = 0;
    if (!S.next(0, cur)) return;
    f32x4 acc[2][2][4][2];
#pragma unroll
    for (int a = 0; a < 2; ++a)
#pragma unroll
        for (int b = 0; b < 2; ++b)
#pragma unroll
            for (int m = 0; m < 4; ++m)
#pragma unroll
                for (int n = 0; n < 2; ++n) acc[a][b][m][n] = (f32x4){0.f, 0.f, 0.f, 0.f};
    bf16x8 At[4][2], B0[2][2], B1[2][2];
    const char* cA = (const char*)(cur.z ? g.A1 : g.A) + (size_t)cur.pm * tstep; const char* cB = (const char*)(cur.z ? g.Bt1 : g.Bt) + (size_t)cur.pn * tstep;
    S.a_ready(cur);
    if constexpr (SP2) {
        PG8_STAGE(PG8_SB(0, 0), cB, voffB); PG8_STAGE(PG8_SB(0, 1), cB + hstep, voffB); PG8_STAGE(PG8_SA(0, 0), cA, voffA); PG8_STAGE(PG8_SA(0, 1), cA + hstep, voffA);
        if (wr == 1) PG8_BAR;
        PG8_WAIT_V(2); PG8_BAR;
        PG8_STAGE(PG8_SB(1, 0), cB + kstep, voffB); PG8_STAGE(PG8_SA(1, 0), cA + kstep, voffA); PG8_STAGE(PG8_SB(1, 1), cB + hstep + kstep, voffB);
        PG8_WAIT_V(6); PG8_BAR;
    } else {
        PG8_STAGE(PG8_SB(0, 0), cB, voffB); PG8_STAGE(PG8_SA(0, 0), cA, voffA); PG8_STAGE(PG8_SB(0, 1), cB + hstep, voffB); PG8_STAGE(PG8_SA(0, 1), cA + hstep, voffA);
        if (wr == 1) PG8_BAR;
        PG8_WAIT_V(4); PG8_BAR;
        PG8_STAGE(PG8_SB(1, 0), cB + kstep, voffB); PG8_STAGE(PG8_SA(1, 0), cA + kstep, voffA); PG8_STAGE(PG8_SB(1, 1), cB + hstep + kstep, voffB);
        PG8_WAIT_V(6); PG8_BAR;
    }
    for (;;) {
        const bool has_next = S.next(ui + 1, nxt);
        const char* nA = has_next ? (const char*)(nxt.z ? g.A1 : g.A) + (size_t)nxt.pm * tstep : cA; const char* nB = has_next ? (const char*)(nxt.z ? g.Bt1 : g.Bt) + (size_t)nxt.pn * tstep : cB;
        for (int t = 0; t < nt; t += 2) {
            const bool last = (t == nt - 2);
            const char* a1 = cA + (size_t)(t + 1) * kstep;
            const char* a2 = last ? nA : cA + (size_t)(t + 2) * kstep; const char* b2 = last ? nB : cB + (size_t)(t + 2) * kstep;
            const char* a3 = a2 + kstep; const char* b3 = b2 + kstep;
            if (last && has_next) S.a_ready(nxt);
            if constexpr (SP2) {
            PG8_LDB(B0, 0, 0); PG8_LDB(B1, 0, 1); PG8_SCHED; PG8_LDA(At, 0, 0); PG8_STAGE(PG8_SA(1, 1), a1 + hstep, voffA);
            PG8_WAIT_V(8); PG8_WAIT_L(0); PG8_BAR; PG8_MMA(0, 0, At, B0); PG8_MMA(0, 1, At, B1); PG8_BAR; PG8_SCHED;
            PG8_LDA(At, 0, 1); PG8_STAGE(PG8_SB(0, 0), b2, voffB); PG8_STAGE(PG8_SB(0, 1), b2 + hstep, voffB); PG8_STAGE(PG8_SA(0, 0), a2, voffA);
            PG8_WAIT_V(8); PG8_WAIT_L(0); PG8_BAR; PG8_MMA(1, 0, At, B0); PG8_MMA(1, 1, At, B1); PG8_BAR; PG8_SCHED;
            PG8_LDB(B0, 1, 0); PG8_LDB(B1, 1, 1); PG8_SCHED; PG8_LDA(At, 1, 0); PG8_STAGE(PG8_SA(0, 1), a2 + hstep, voffA);
            PG8_WAIT_V(8); PG8_WAIT_L(0); PG8_BAR; PG8_MMA(0, 0, At, B0); PG8_MMA(0, 1, At, B1); PG8_BAR; PG8_SCHED;
            PG8_LDA(At, 1, 1); PG8_STAGE(PG8_SB(1, 0), b3, voffB); PG8_STAGE(PG8_SB(1, 1), b3 + hstep, voffB); PG8_STAGE(PG8_SA(1, 0), a3, voffA);
            PG8_WAIT_V(8); PG8_WAIT_L(0); PG8_BAR; PG8_MMA(1, 0, At, B0); PG8_MMA(1, 1, At, B1); PG8_BAR; PG8_SCHED;
            } else {
            PG8_LDB(B0, 0, 0); PG8_SCHED; PG8_LDA(At, 0, 0); PG8_STAGE(PG8_SA(1, 1), a1 + hstep, voffA);
            PG8_WAIT_L(8); PG8_BAR; PG8_WAIT_L(0); PG8_MMA(0, 0, At, B0); PG8_BAR; PG8_SCHED;
            PG8_LDB(B1, 0, 1); PG8_STAGE(PG8_SB(0, 0), b2, voffB);
            PG8_BAR; PG8_WAIT_L(0); PG8_MMA(0, 1, At, B1); PG8_BAR;
            PG8_LDA(At, 0, 1); PG8_STAGE(PG8_SA(0, 0), a2, voffA);
            PG8_BAR; PG8_WAIT_L(0); PG8_MMA(1, 0, At, B0); PG8_BAR; PG8_SCHED;
            PG8_STAGE(PG8_SB(0, 1), b2 + hstep, voffB);
            PG8_WAIT_V(6); PG8_BAR; PG8_MMA(1, 1, At, B1); PG8_BAR;
            PG8_LDB(B0, 1, 0); PG8_SCHED; PG8_LDA(At, 1, 0); PG8_STAGE(PG8_SA(0, 1), a2 + hstep, voffA);
            PG8_WAIT_L(8); PG8_BAR; PG8_WAIT_L(0); PG8_MMA(0, 0, At, B0); PG8_BAR; PG8_SCHED;
            PG8_LDB(B1, 1, 1); PG8_STAGE(PG8_SB(1, 0), b3, voffB);
            PG8_BAR; PG8_WAIT_L(0); PG8_MMA(0, 1, At, B1); PG8_BAR;
            PG8_LDA(At, 1, 1); PG8_STAGE(PG8_SA(1, 0), a3, voffA);
            PG8_BAR; PG8_WAIT_L(0); PG8_MMA(1, 0, At, B0); PG8_BAR; PG8_SCHED;
            PG8_STAGE(PG8_SB(1, 1), b3 + hstep, voffB);
            PG8_WAIT_V(6); PG8_BAR; PG8_MMA(1, 1, At, B1); PG8_BAR;
            }
        }
        if constexpr (ALIGN_EPI) { if (wr == 0) PG8_BAR; }
#ifndef PROBE_EPI
#define PROBE_EPI 0
#endif
        bool keep_acc = false; if constexpr (!Epi::AFTER_DRAIN) { keep_acc = E(acc, cur, wr, wc, fr, fq); if constexpr (Epi::IDEMPOTENT && PROBE_EPI) { asm volatile("" ::: "memory"); keep_acc = E(acc, cur, wr, wc, fr, fq); } S.done(cur); }
        if (!has_next) break;
        if (!keep_acc) {
#pragma unroll
        for (int a = 0; a < 2; ++a)
#pragma unroll
            for (int b = 0; b < 2; ++b)
#pragma unroll
                for (int m = 0; m < 4; ++m)
#pragma unroll
                    for (int n = 0; n < 2; ++n) acc[a][b][m][n] = (f32x4){0.f, 0.f, 0.f, 0.f};
        }
        cur = nxt; cA = nA; cB = nB; ++ui;
        if constexpr (ALIGN_EPI) { if (wr == 1) PG8_BAR; }
    }
    PG8_WAIT_V(0);
    if constexpr (!ALIGN_EPI) { if (wr == 0) PG8_BAR; }
    PG8_BAR;
    if constexpr (Epi::AFTER_DRAIN) { E.fused(acc, cur, wr, wc, fr, fq, lds, wid, lane); S.done(cur); }
#undef PG8_SA
#undef PG8_SB
#undef PG8_STAGE
#undef PG8_LDA
#undef PG8_LDB
#undef PG8_MMA
#undef PG8_WAIT_V
#undef PG8_WAIT_L
#undef PG8_BAR
#undef PG8_SCHED
}
}

#define LAS __attribute__((address_space(3)))
typedef unsigned short bf16;
typedef float f32x4 __attribute__((ext_vector_type(4)));
typedef unsigned v4u __attribute__((ext_vector_type(4)));
constexpr int NWAVES = 8, NTHR = 512;
constexpr int MTOK = 32768, DM = 1024, SEQ = 2048, NBATCH = 16, NIN = 8192, DFF = 4096, HYW = 512, HALF_TOK = 16384;
constexpr size_t MiB = (size_t)1 << 20;
constexpr size_t WS_SSQA = 0, WS_SSQB = 2 * MiB, WS_ROPE = 4 * MiB, WS_RSTD = 4 * MiB + 512 * 1024, WS_BAR = 4 * MiB + 768 * 1024, WS_LSE = 5 * MiB, WS_GF = 8 * MiB, WS_W = 16 * MiB, WS_XB = 52 * MiB,
                 WS_HY = 116 * MiB, WS_UT = 212 * MiB, WS_GATES = 116 * MiB, WS_Q = 244 * MiB, WS_KV = 340 * MiB, WS_YHY = 436 * MiB, WS_YATT = 404 * MiB, WS_X0T = 468 * MiB,
                 WS_MERGED = 340 * MiB, WS_H = 116 * MiB, WS_END = 500 * MiB;
constexpr size_t W_IN = 0, W_PHY = 16 * MiB, W_PATT = 17 * MiB, W_O = 18 * MiB, W_FF1 = 20 * MiB, W_FF2 = 28 * MiB;
constexpr int LDS_RTAB = 131072;
constexpr int LDS_ST_OFF = 135168;
constexpr int LDS_BYTES = 139264;

struct Args {
    const float* in[19]; float* out; unsigned char* ws; int pad0, pad1;
};

__device__ __forceinline__ unsigned f2bf(float f) { unsigned u = __float_as_uint(f); return (u + 0x7fffu + ((u >> 16) & 1u)) >> 16; }
__device__ __forceinline__ unsigned pk2(float lo, float hi) { return f2bf(lo) | (f2bf(hi) << 16); }
__device__ __forceinline__ float bf2f(unsigned short b) { return __uint_as_float((unsigned)b << 16); }
__device__ __forceinline__ float wave_sum(float v) {
#pragma unroll
    for (int o = 1; o < 64; o <<= 1) v += __shfl_xor(v, o);
    return v;
}

__device__ __forceinline__ int win_src_col(int n) {
    const int t = n >> 8, j = n & 255;
    if (t < 6) return n;
    if (t >= 24) return 6144 + (n - 6144);
    int g, w, half;
    if (t < 12) { const int i = t - 6; g = i >> 1; w = 0; half = i & 1; }
    else { const int i = t - 12; g = i >> 2; w = 1 + ((i >> 1) & 1); half = i & 1; }
    int hh, d;
    if (w == 2) { hh = j >> 6; d = j & 63; }
    else { hh = (j & 127) >> 5; d = (j & 31) + ((j >> 7) << 5); }
    return 1536 + g * 1536 + w * 512 + (half * 4 + hh) * 64 + d;
}

__device__ __forceinline__ void transpose_item(const float* W, int K, int Nsrc, int s0, bf16* WT, int n0, int k0, const float* gain, LAS float* scr, int lane) {
    float tv[32];
#pragma unroll
    for (int i = 0; i < 32; ++i) { const int kk = 2 * i + (lane >> 5); tv[i] = W[(size_t)(k0 + kk) * Nsrc + s0 + (lane & 31)]; }
    const float gl = gain ? gain[k0 + lane] : 1.0f;
#pragma unroll
    for (int i = 0; i < 32; ++i) { const int kk = 2 * i + (lane >> 5); scr[kk * 33 + (lane & 31)] = tv[i] * __shfl(gl, kk); }
    asm volatile("s_waitcnt lgkmcnt(0)" ::: "memory");
    const int c = lane & 7;
#pragma unroll
    for (int j = 0; j < 4; ++j) { const int n = (lane >> 3) + 8 * j; const LAS float* s = scr + (8 * c) * 33 + n;
        v4u o; o.x = pk2(s[0 * 33], s[1 * 33]); o.y = pk2(s[2 * 33], s[3 * 33]); o.z = pk2(s[4 * 33], s[5 * 33]); o.w = pk2(s[6 * 33], s[7 * 33]);
        *(v4u*)(WT + (size_t)(n0 + n) * K + k0 + 8 * c) = o; }
    asm volatile("s_waitcnt lgkmcnt(0)" ::: "memory");
}

__device__ __forceinline__ void phase_prep_weights(const Args& a, int L, LAS unsigned char* lds, int tid, int lane, int wave, int G) {
    unsigned char* ws = a.ws;
    {
        const float* w1 = a.in[5] + (size_t)L * 33 * 64; const float* b1 = a.in[6] + L * 64;
        const float* wi = a.in[7] + (size_t)L * 2 * 64 * 64; const float* bi = a.in[8] + L * 2 * 64;
        const float* wout = a.in[9] + (size_t)L * 64 * 1024; const float* fr = a.in[10] + L * 64; const float* skip = a.in[11] + L * 512;
        bf16* Rg = (bf16*)(ws + WS_GF);
        const float min_decay = logf(1e-2f) / 1.5f, max_decay = logf(1e-2f) / 0.3f;
        LAS float* hb = (LAS float*)lds + wave * 64;
        LAS float* fbuf = (LAS float*)(lds + 4096);
        const float frl = fr[lane];
        LAS float* wl = (LAS float*)(lds + 40960);
        for (int i = tid; i < 528 + 2048; i += NTHR) { const f32x4 v = (i < 528) ? *((const f32x4*)w1 + i) : *((const f32x4*)wi + (i - 528)); *(LAS f32x4*)(wl + 4 * i) = v; }
        __syncthreads();
#ifndef PROBE_PWF
#define PROBE_PWF 0
#endif
#ifndef PROBE_PWT
#define PROBE_PWT 0
#endif
        _Pragma("unroll 1") for (int repf = 0; repf < 1 + PROBE_PWF; ++repf)
        for (int blk = blockIdx.x; blk < 256; blk += G) {
            int n = 8 * blk + wave + 1; if (n == 2048) n = 0;
            const float t = (float)n / 2047.0f;
            {
                float v = 0.f;
                if (lane == 0) v = t;
                else if (lane < 33) { const int k = (lane - 1) & 15; const float band = 1e-4f + (float)k * ((15.0f - 1e-4f) / 15.0f); const float ang = ((float)(2.0 * 3.14159265358979323846 / 2048.0) * (float)n) * band;
                       v = (lane <= 16) ? cosf(ang) : -sinf(ang); }
                hb[lane] = v;
            }
            float s = b1[lane];
#pragma unroll
            for (int e = 0; e < 33; ++e) s += hb[e] * wl[e * 64 + lane];
            float hcur = sinf(frl * s);
#pragma unroll 1
            for (int layer = 0; layer < 2; ++layer) {
                hb[lane] = hcur;
                float s2 = bi[layer * 64 + lane];
#pragma unroll
                for (int e = 0; e < 64; ++e) s2 += hb[e] * wl[2112 + layer * 4096 + e * 64 + lane];
                hcur = sinf(frl * s2);
            }
            LAS float* hT = (LAS float*)(lds + 2048);
            hT[lane * 8 + wave] = hcur;
            __syncthreads();
            float o[8][2];
#pragma unroll
            for (int p = 0; p < 8; ++p) { o[p][0] = 0.f; o[p][1] = 0.f; }
#pragma unroll 16
            for (int e0 = 0; e0 < 64; ++e0) {
                const int e = (e0 + 8 * ((blk >> 3) & 7)) & 63;
                const f32x4 ha = *(const LAS f32x4*)(hT + e * 8), hc = *(const LAS f32x4*)(hT + e * 8 + 4);
                const float w0 = wout[e * 1024 + 128 * wave + lane], w1v = wout[e * 1024 + 128 * wave + 64 + lane];
#pragma unroll
                for (int p = 0; p < 4; ++p) { o[p][0] += ha[p] * w0; o[p][1] += ha[p] * w1v; o[4 + p][0] += hc[p] * w0; o[4 + p][1] += hc[p] * w1v; }
            }
#pragma unroll
            for (int j = 0; j < 2; ++j) {
                const int col = 128 * wave + 64 * j + lane, c = col & 511;
                const float delta = fabsf(min_decay + (float)c * ((max_decay - min_decay) / 511.0f));
#pragma unroll
                for (int p = 0; p < 8; ++p) { int np = 8 * blk + p + 1; if (np == 2048) np = 0; const float tp = (float)np / 2047.0f; fbuf[p * 1024 + col] = o[p][j] * expf(-tp * delta); }
            }
            __syncthreads();
            if (blk != 255) {
                typedef unsigned u32x2v __attribute__((ext_vector_type(2)));
#pragma unroll
                for (int pp = 0; pp < 2; ++pp) {
                    const int p = tid + 512 * pp, c = p & 511, dir = p >> 9;
                    bf16* r0 = Rg + ((size_t)c * 2 + 0) * 4096; bf16* r1 = Rg + ((size_t)c * 2 + 1) * 4096;
                    unsigned e[8];
#pragma unroll
                    for (int j = 0; j < 8; ++j) e[j] = f2bf(fbuf[(dir ? j : 7 - j) * 1024 + dir * 512 + c]);
                    v4u w8; w8.x = e[0] | (e[1] << 16); w8.y = e[2] | (e[3] << 16); w8.z = e[4] | (e[5] << 16); w8.w = e[6] | (e[7] << 16);
                    if (dir == 0) {
                        const int xb0 = 2040 - 8 * blk;
                        *(v4u*)(r0 + xb0) = w8;
                        r1[xb0 - 1] = (bf16)e[0];
                        u32x2v m4; m4.x = e[1] | (e[2] << 16); m4.y = e[3] | (e[4] << 16); *(u32x2v*)(r1 + xb0) = m4;
                        *(unsigned*)(r1 + xb0 + 4) = e[5] | (e[6] << 16);
                        r1[xb0 + 6] = (bf16)e[7];
                    } else {
                        const int xa = 2049 + 8 * blk;
                        *(v4u*)(r1 + xa - 1) = w8;
                        r0[xa] = (bf16)e[0];
                        *(unsigned*)(r0 + xa + 1) = e[1] | (e[2] << 16);
                        u32x2v m4; m4.x = e[3] | (e[4] << 16); m4.y = e[5] | (e[6] << 16); *(u32x2v*)(r0 + xa + 3) = m4;
                        r0[xa + 7] = (bf16)e[7];
                    }
                }
            } else
#pragma unroll
            for (int pp = 0; pp < 2; ++pp) {
                const int p = tid + 512 * pp, c = p & 511, dir = p >> 9;
                bf16* r0 = Rg + ((size_t)c * 2 + 0) * 4096; bf16* r1 = Rg + ((size_t)c * 2 + 1) * 4096;
#pragma unroll
                for (int wv = 0; wv < 8; ++wv) {
                    int nn = 8 * blk + wv + 1; float val = fbuf[wv * 1024 + dir * 512 + c]; int x;
                    if (nn == 2048) { if (dir != 0) continue; val += skip[c]; x = 2048; }
                    else x = dir ? 2048 + nn : 2048 - nn;
                    const bf16 hv = (bf16)f2bf(val); r0[x] = hv; r1[x - 1] = hv;
                }
            }
            __syncthreads();
        }
    }
    {
        LAS float* scr = (LAS float*)(lds + 40960 + wave * 8704);
        const int gw = blockIdx.x * NWAVES + wave, NGW = G * NWAVES;
        bf16* Wb = (bf16*)(ws + WS_W);
        const float* w_in = a.in[2] + (size_t)L * DM * NIN; const float* p_hy = a.in[12] + (size_t)L * 512 * DM; const float* p_att = a.in[13] + (size_t)L * 512 * DM;
        const float* w_o = a.in[14] + (size_t)L * DM * DM; const float* w1 = a.in[16] + (size_t)L * DM * DFF; const float* w2 = a.in[17] + (size_t)L * DFF * DM;
        const float* g_mix = a.in[1] + L * DM; const float* g_ffn = a.in[15] + L * DM;
        constexpr int I_IN = 16 * 256, I_P = 8 * 32, I_O = 16 * 32, I_1 = 16 * 128, I_2 = 64 * 32;
        constexpr int NITEMS = I_IN + 2 * I_P + I_O + I_1 + I_2;
        _Pragma("unroll 1") for (int rept = 0; rept < 1 + PROBE_PWT; ++rept)
        for (int it = gw; it < NITEMS; it += NGW) {
            int r = it;
            if (r < I_IN) { const int kb = r / 256, nb = r % 256; transpose_item(w_in, DM, NIN, win_src_col(nb * 32), Wb + W_IN / 2, nb * 32, kb * 64, g_mix, scr, lane); continue; } r -= I_IN;
            if (r < I_P) { const int kb = r / 32, nb = r % 32; transpose_item(p_hy, 512, DM, nb * 32, Wb + W_PHY / 2, nb * 32, kb * 64, nullptr, scr, lane); continue; } r -= I_P;
            if (r < I_P) { const int kb = r / 32, nb = r % 32; transpose_item(p_att, 512, DM, nb * 32, Wb + W_PATT / 2, nb * 32, kb * 64, nullptr, scr, lane); continue; } r -= I_P;
            if (r < I_O) { const int kb = r / 32, nb = r % 32; transpose_item(w_o, DM, DM, nb * 32, Wb + W_O / 2, nb * 32, kb * 64, nullptr, scr, lane); continue; } r -= I_O;
            if (r < I_1) { const int kb = r / 128, nb = r % 128; transpose_item(w1, DM, DFF, nb * 32, Wb + W_FF1 / 2, nb * 32, kb * 64, g_ffn, scr, lane); continue; } r -= I_1;
            { const int kb = r / 32, nb = r % 32; transpose_item(w2, DFF, DM, nb * 32, Wb + W_FF2 / 2, nb * 32, kb * 64, nullptr, scr, lane); }
        }
        if (L == 0) {
            const float* x = a.in[0]; bf16* xb = (bf16*)(ws + WS_XB); float* ssq = (float*)(ws + WS_SSQA);
            for (int m0 = gw; m0 < MTOK; m0 += 4 * NGW) {
                f32x4 v[4][4];
#pragma unroll
                for (int rr = 0; rr < 4; ++rr) { const f32x4* xr = (const f32x4*)(x + (size_t)(m0 + rr * NGW) * DM) + lane;
#pragma unroll
                    for (int j = 0; j < 4; ++j) v[rr][j] = xr[64 * j]; }
#pragma unroll
                for (int rr = 0; rr < 4; ++rr) { const int m = m0 + rr * NGW; float s = 0.f;
#pragma unroll
                    for (int j = 0; j < 4; ++j) s += (v[rr][j][0] * v[rr][j][0] + v[rr][j][1] * v[rr][j][1]) + (v[rr][j][2] * v[rr][j][2] + v[rr][j][3] * v[rr][j][3]);
                    s = wave_sum(s);
                    unsigned long long* o8 = (unsigned long long*)(xb + (size_t)m * DM) + lane;
#pragma unroll
                    for (int j = 0; j < 4; ++j) o8[64 * j] = (unsigned long long)pk2(v[rr][j][0], v[rr][j][1]) | ((unsigned long long)pk2(v[rr][j][2], v[rr][j][3]) << 32);
                    if (lane < 16) ssq[(size_t)m * 16 + lane] = (lane == 0) ? s : 0.f; }
            }
            float* rc = (float*)(ws + WS_ROPE); float* rsn = rc + 65536;
            for (int i = blockIdx.x * NTHR + tid; i < 65536; i += G * NTHR) {
                const int pos = i >> 5, f = i & 31;
                const float inv = powf(10000.0f, -(float)f / 32.0f);
                const float ang = (float)pos * inv;
                rc[i] = cosf(ang); rsn[i] = sinf(ang);
            }
        }
    }
}

__device__ __forceinline__ float bfe(const v4u& w, int e) { const unsigned d = (e >> 1) == 0 ? w.x : ((e >> 1) == 1 ? w.y : ((e >> 1) == 2 ? w.z : w.w)); return (e & 1) ? __uint_as_float(d & 0xffff0000u) : __uint_as_float(d << 16); }
__device__ __forceinline__ void phase_prep_u(const Args& a, int L, LAS unsigned char* lds, int tid, int G) {
    const bf16* hy = (const bf16*)(a.ws + WS_HY); bf16* ut = (bf16*)(a.ws + WS_UT); bf16* x0t = (bf16*)(a.ws + WS_X0T);
    const float* cw = a.in[3] + (size_t)L * 3 * 1536; const float* cb = a.in[4] + L * 1536;
    LAS unsigned short* tile = (LAS unsigned short*)lds;
    const int cc = blockIdx.x & 7, ml = tid >> 3, cg8 = tid & 7, c0 = cc * 64 + cg8 * 8;
    float wq[3][4][8];
#pragma unroll
    for (int ar = 0; ar < 3; ++ar)
#pragma unroll
        for (int e = 0; e < 8; ++e) { wq[ar][0][e] = cw[ar * 512 + c0 + e]; wq[ar][1][e] = cw[1536 + ar * 512 + c0 + e]; wq[ar][2][e] = cw[3072 + ar * 512 + c0 + e]; wq[ar][3][e] = cb[ar * 512 + c0 + e]; }
    v4u dn[3][3];
    const v4u zero = (v4u){0u, 0u, 0u, 0u};
#define PU_LOAD(it_) do { const int m_ = ((it_) & 31) * 64 + ml; const bf16* r_ = hy + (size_t)(((it_) >> 5) * SEQ + m_) * 1536 + c0; \
        _Pragma("unroll") for (int ar_ = 0; ar_ < 3; ++ar_) { dn[ar_][0] = (m_ > 0) ? *(const v4u*)(r_ - 1536 + ar_ * 512) : zero; dn[ar_][1] = *(const v4u*)(r_ + ar_ * 512); \
            dn[ar_][2] = (m_ < SEQ - 1) ? *(const v4u*)(r_ + 1536 + ar_ * 512) : zero; } } while (0)
    if ((int)(blockIdx.x >> 3) < 512) PU_LOAD((int)(blockIdx.x >> 3));
    for (int it = blockIdx.x >> 3; it < 512; it += (G >> 3)) {
        const int mc = it & 31, b = it >> 5;
        v4u d[3][3];
#pragma unroll
        for (int ar = 0; ar < 3; ++ar) { d[ar][0] = dn[ar][0]; d[ar][1] = dn[ar][1]; d[ar][2] = dn[ar][2]; }
        if (it + (G >> 3) < 512) PU_LOAD(it + (G >> 3));
#pragma unroll
        for (int e = 0; e < 8; ++e) {
            float cv[3];
#pragma unroll
            for (int ar = 0; ar < 3; ++ar) cv[ar] = wq[ar][3][e] + wq[ar][0][e] * bfe(d[ar][0], e) + wq[ar][1][e] * bfe(d[ar][1], e) + wq[ar][2][e] * bfe(d[ar][2], e);
            tile[(cg8 * 8 + e) * 72 + ml] = (unsigned short)f2bf(cv[1] * cv[2]);
            tile[4608 + (cg8 * 8 + e) * 72 + ml] = (unsigned short)f2bf(cv[0]);
        }
        __syncthreads();
        {
            const int c2 = tid >> 3, ch = tid & 7;
            const LAS unsigned* s = (const LAS unsigned*)(tile + c2 * 72 + ch * 8);
            v4u o; o.x = s[0]; o.y = s[1]; o.z = s[2]; o.w = s[3];
            *(v4u*)(ut + ((size_t)(cc * 64 + c2) * NBATCH + b) * SEQ + mc * 64 + ch * 8) = o;
            const LAS unsigned* s2 = s + 2304;
            v4u o2; o2.x = s2[0]; o2.y = s2[1]; o2.z = s2[2]; o2.w = s2[3];
            *(v4u*)(x0t + ((size_t)(cc * 64 + c2) * NBATCH + b) * SEQ + mc * 64 + ch * 8) = o2;
        }
        __syncthreads();
    }
}

__device__ __forceinline__ void phase_hyena_naive(const Args& a, int L, LAS unsigned char* lds, int tid, int G) {
    const bf16* hy = (const bf16*)(a.ws + WS_HY); const bf16* ut = (const bf16*)(a.ws + WS_UT); const float* Gf = (const float*)(a.ws + WS_GF);
    bf16* yhy = (bf16*)(a.ws + WS_YHY);
    const float* cw = a.in[3] + (size_t)L * 3 * 1536; const float* cb = a.in[4] + L * 1536;
    LAS float* Gs = (LAS float*)lds;
    LAS float* Us = Gs + 4096;
    for (int item = blockIdx.x; item < 2048; item += G) {
        const int c = item >> 2, bq = item & 3;
        for (int i = tid; i < 4096; i += NTHR) Gs[i] = (i == 0) ? 0.f : Gf[(size_t)c * 4096 + i];
        for (int i = tid; i < 8192; i += NTHR) { const int bl = i >> 11, m = i & 2047; Us[i] = bf2f(ut[((size_t)c * NBATCH + bq * 4 + bl) * SEQ + m]); }
        __syncthreads();
        const int bl = tid >> 7, tn = tid & 127;
        float acc[16];
#pragma unroll
        for (int i = 0; i < 16; ++i) acc[i] = 0.f;
        const LAS float* up = Us + bl * 2048;
        for (int m = 0; m < SEQ; ++m) {
            const float u = up[m];
            const LAS float* gp = Gs + (tn - m + 2048);
#pragma unroll
            for (int i = 0; i < 16; ++i) acc[i] += gp[128 * i] * u;
        }
        const int b = bq * 4 + bl;
        const float w0 = cw[c], w1 = cw[1536 + c], w2 = cw[3072 + c], b0 = cb[c];
#pragma unroll
        for (int i = 0; i < 16; ++i) {
            const int n = tn + 128 * i;
            const bf16* r = hy + (size_t)(b * SEQ + n) * 1536 + c;
            const float xm = (n > 0) ? bf2f(r[-1536]) : 0.f, xc = bf2f(r[0]), xp = (n < SEQ - 1) ? bf2f(r[1536]) : 0.f;
            const float x0 = b0 + w0 * xm + w1 * xc + w2 * xp;
            yhy[(size_t)(b * SEQ + n) * 512 + c] = (bf16)f2bf(x0 * acc[i]);
        }
        __syncthreads();
    }
}

__device__ __forceinline__ void phase_attn_naive(const Args& a, int half, int tid, int G) {
    bf16* Q = (bf16*)(a.ws + WS_Q); const bf16* KV = (const bf16*)(a.ws + WS_KV); float* lse = (float*)(a.ws + WS_LSE);
    for (int idx = blockIdx.x * NTHR + tid; idx < 3 * 8 * HALF_TOK; idx += G * NTHR) {
        const int g = idx / (8 * HALF_TOK), t = idx % (8 * HALF_TOK), h = t / HALF_TOK, tokl = t % HALF_TOK;
        const int dil = (g == 0) ? 1 : (g == 1 ? 4 : 16);
        const int token = half * HALF_TOK + tokl, s = token & 2047;
        bf16* qp = Q + (size_t)token * 1536 + g * 512 + h * 64;
        float q[64], o[64];
#pragma unroll
        for (int i = 0; i < 8; ++i) { const v4u w = *(const v4u*)(qp + 8 * i);
            q[8 * i + 0] = __uint_as_float(w.x << 16); q[8 * i + 1] = __uint_as_float(w.x & 0xffff0000u); q[8 * i + 2] = __uint_as_float(w.y << 16); q[8 * i + 3] = __uint_as_float(w.y & 0xffff0000u);
            q[8 * i + 4] = __uint_as_float(w.z << 16); q[8 * i + 5] = __uint_as_float(w.z & 0xffff0000u); q[8 * i + 6] = __uint_as_float(w.w << 16); q[8 * i + 7] = __uint_as_float(w.w & 0xffff0000u); }
#pragma unroll
        for (int i = 0; i < 64; ++i) o[i] = 0.f;
        float mx = -1e30f, l = 0.f;
        for (int j = -64; j <= 64; ++j) {
            const int sp = s + j * dil;
            if (sp < 0 || sp >= SEQ) continue;
            const bf16* kp = KV + (size_t)(tokl + j * dil) * 3072 + g * 1024 + h * 64;
            float sc = 0.f;
#pragma unroll
            for (int i = 0; i < 8; ++i) { const v4u w = *(const v4u*)(kp + 8 * i);
                sc += q[8 * i + 0] * __uint_as_float(w.x << 16) + q[8 * i + 1] * __uint_as_float(w.x & 0xffff0000u) + q[8 * i + 2] * __uint_as_float(w.y << 16) + q[8 * i + 3] * __uint_as_float(w.y & 0xffff0000u)
                    + q[8 * i + 4] * __uint_as_float(w.z << 16) + q[8 * i + 5] * __uint_as_float(w.z & 0xffff0000u) + q[8 * i + 6] * __uint_as_float(w.w << 16) + q[8 * i + 7] * __uint_as_float(w.w & 0xffff0000u); }
            const float mn = fmaxf(mx, sc), corr = exp2f(mx - mn), p = exp2f(sc - mn);
            l = l * corr + p; mx = mn;
            const bf16* vp = kp + 512;
#pragma unroll
            for (int i = 0; i < 8; ++i) { const v4u w = *(const v4u*)(vp + 8 * i);
                o[8 * i + 0] = o[8 * i + 0] * corr + p * __uint_as_float(w.x << 16); o[8 * i + 1] = o[8 * i + 1] * corr + p * __uint_as_float(w.x & 0xffff0000u);
                o[8 * i + 2] = o[8 * i + 2] * corr + p * __uint_as_float(w.y << 16); o[8 * i + 3] = o[8 * i + 3] * corr + p * __uint_as_float(w.y & 0xffff0000u);
                o[8 * i + 4] = o[8 * i + 4] * corr + p * __uint_as_float(w.z << 16); o[8 * i + 5] = o[8 * i + 5] * corr + p * __uint_as_float(w.z & 0xffff0000u);
                o[8 * i + 6] = o[8 * i + 6] * corr + p * __uint_as_float(w.w << 16); o[8 * i + 7] = o[8 * i + 7] * corr + p * __uint_as_float(w.w & 0xffff0000u); }
        }
        const float inv = 1.0f / l;
#pragma unroll
        for (int i = 0; i < 8; ++i) { v4u w; w.x = pk2(o[8 * i] * inv, o[8 * i + 1] * inv); w.y = pk2(o[8 * i + 2] * inv, o[8 * i + 3] * inv); w.z = pk2(o[8 * i + 4] * inv, o[8 * i + 5] * inv); w.w = pk2(o[8 * i + 6] * inv, o[8 * i + 7] * inv);
            *(v4u*)(qp + 8 * i) = w; }
        lse[((size_t)g * MTOK + token) * 8 + h] = mx + log2f(l);
    }
}

__device__ __forceinline__ void phase_combine(const Args& a, int tid, int G) {
    const bf16* Q = (const bf16*)(a.ws + WS_Q); const float* lse = (const float*)(a.ws + WS_LSE); bf16* ya = (bf16*)(a.ws + WS_YATT);
    const int stride = G * NTHR;
    for (int idx0 = blockIdx.x * NTHR + tid; idx0 < MTOK * 64; idx0 += 4 * stride) {
        float l0[4], l1[4], l2[4]; v4u a0[4], a1[4], a2[4];
#pragma unroll
        for (int j = 0; j < 4; ++j) { int idx = idx0 + j * stride; if (idx >= MTOK * 64) idx = idx0; const int token = idx >> 6, ch = idx & 63, h = ch >> 3;
            l0[j] = lse[((size_t)0 * MTOK + token) * 8 + h]; l1[j] = lse[((size_t)1 * MTOK + token) * 8 + h]; l2[j] = lse[((size_t)2 * MTOK + token) * 8 + h];
            const bf16* p = Q + (size_t)token * 1536 + ch * 8;
            a0[j] = *(const v4u*)p; a1[j] = *(const v4u*)(p + 512); a2[j] = *(const v4u*)(p + 1024); }
#pragma unroll
        for (int j = 0; j < 4; ++j) { const int idx = idx0 + j * stride; if (idx >= MTOK * 64) continue; const int token = idx >> 6, ch = idx & 63;
            const float mx = fmaxf(l0[j], fmaxf(l1[j], l2[j]));
            float w0 = exp2f(l0[j] - mx), w1 = exp2f(l1[j] - mx), w2 = exp2f(l2[j] - mx);
            const float inv = 1.0f / (w0 + w1 + w2); w0 *= inv; w1 *= inv; w2 *= inv;
            v4u o;
#define CMB(f) pk2(w0 * __uint_as_float(a0[j].f << 16) + w1 * __uint_as_float(a1[j].f << 16) + w2 * __uint_as_float(a2[j].f << 16), \
                   w0 * __uint_as_float(a0[j].f & 0xffff0000u) + w1 * __uint_as_float(a1[j].f & 0xffff0000u) + w2 * __uint_as_float(a2[j].f & 0xffff0000u))
            o.x = CMB(x); o.y = CMB(y); o.z = CMB(z); o.w = CMB(w);
#undef CMB
            *(v4u*)(ya + (size_t)token * 512 + ch * 8) = o; }
    }
}

__device__ __forceinline__ void phase_final_norm(const Args& a, int lane, int wave, int G) {
    float* out = a.out; const float* gain = a.in[18]; const bf16* xb = (const bf16*)(a.ws + WS_XB);
    const int gw = blockIdx.x * NWAVES + wave, NGW = G * NWAVES;
    typedef unsigned u32x2v __attribute__((ext_vector_type(2)));
    f32x4 gn[4];
#pragma unroll
    for (int j = 0; j < 4; ++j) gn[j] = *((const f32x4*)gain + lane + 64 * j);
    for (int m0 = gw; m0 < MTOK; m0 += 4 * NGW) {
        u32x2v w[4][4];
#pragma unroll
        for (int rr = 0; rr < 4; ++rr) { const int m = (m0 + rr * NGW < MTOK) ? m0 + rr * NGW : m0; const u32x2v* xr = (const u32x2v*)(xb + (size_t)m * DM) + lane;
#pragma unroll
            for (int j = 0; j < 4; ++j) w[rr][j] = xr[64 * j]; }
#pragma unroll
        for (int rr = 0; rr < 4; ++rr) { const int m = m0 + rr * NGW; if (m >= MTOK) continue;
            f32x4 v[4]; float s = 0.f;
#pragma unroll
            for (int j = 0; j < 4; ++j) { v[j] = (f32x4){__uint_as_float(w[rr][j].x << 16), __uint_as_float(w[rr][j].x & 0xffff0000u), __uint_as_float(w[rr][j].y << 16), __uint_as_float(w[rr][j].y & 0xffff0000u)};
                s += (v[j][0] * v[j][0] + v[j][1] * v[j][1]) + (v[j][2] * v[j][2] + v[j][3] * v[j][3]); }
            s = wave_sum(s);
            const float rs = 1.0f / sqrtf(s * (1.0f / 1024.0f) + 1e-6f);
            f32x4* orow = (f32x4*)(out + (size_t)m * DM) + lane;
#pragma unroll
            for (int j = 0; j < 4; ++j) orow[64 * j] = v[j] * rs * gn[j]; }
    }
}

typedef short bf16x8 __attribute__((ext_vector_type(8)));
typedef short s16x4 __attribute__((ext_vector_type(4)));
constexpr int HY_UROW = 4112, HY_ROFF = 16 * HY_UROW, HY_RSTRIDE = 8192 + 64;
__device__ __forceinline__ bf16x8 ld_frag4(const LAS unsigned char* p) {
    const LAS unsigned* q = (const LAS unsigned*)p; v4u d; d.x = q[0]; d.y = q[1]; d.z = q[2]; d.w = q[3]; return __builtin_bit_cast(bf16x8, d);
}
__device__ __forceinline__ void phase_hyena_mfma(const Args& a, LAS unsigned char* lds, int tid, int G, bool dummy = false) {
    const bf16* ut = (const bf16*)(a.ws + WS_UT); const bf16* Rg = (const bf16*)(a.ws + WS_GF); bf16* x0t = (bf16*)(a.ws + WS_X0T);
    const int lane = tid & 63, w = __builtin_amdgcn_readfirstlane(tid >> 6), i16 = lane & 15, kq = lane >> 4;
    const int base = (w >> 1) * 512 + (w & 1) * 16, cp = i16 & 1;
    const int lane_const = (2048 - base - i16 + 8 * kq - cp) >> 1;
    const LAS unsigned char* pA15 = lds + HY_ROFF + cp * HY_RSTRIDE + 4 * (lane_const - 240);
    const LAS unsigned char* pB = lds + i16 * HY_UROW + kq * 16;
    v4u pre[10];
#define HY_ISSUE(chn) do { _Pragma("unroll") for (int k_ = 0; k_ < 8; ++k_) { const int i_ = tid + NTHR * k_, b_ = i_ >> 8, ck_ = i_ & 255; pre[k_] = *(const v4u*)(ut + ((size_t)(chn) * NBATCH + b_) * SEQ + ck_ * 8); } \
        _Pragma("unroll") for (int k_ = 0; k_ < 2; ++k_) { const int i_ = tid + NTHR * k_, c2_ = i_ >> 9, ck_ = i_ & 511; pre[8 + k_] = *(const v4u*)(Rg + ((size_t)(chn) * 2 + c2_) * 4096 + ck_ * 8); } } while (0)
    for (int ch = blockIdx.x; ch < HYW; ch += G) {
        HY_ISSUE(ch);
#pragma unroll
        for (int k = 0; k < 8; ++k) { const int i = tid + NTHR * k, b = i >> 8, ck = i & 255; *(LAS v4u*)(lds + b * HY_UROW + ck * 16) = pre[k]; }
#pragma unroll
        for (int k = 0; k < 2; ++k) { const int i = tid + NTHR * k, c2 = i >> 9, ck = i & 511; *(LAS v4u*)(lds + HY_ROFF + c2 * HY_RSTRIDE + ck * 16) = pre[8 + k]; }
        __syncthreads();
        f32x4 acc[16]; bf16x8 W[16];
#pragma unroll
        for (int i = 0; i < 16; ++i) acc[i] = (f32x4){0.f, 0.f, 0.f, 0.f};
#pragma unroll
        for (int j = 1; j < 16; ++j) W[j] = ld_frag4(pA15 + 64 * (15 - j));
        W[0] = W[1];
#pragma unroll 1
        for (int tt = 0; tt < 4; ++tt) {
            const LAS unsigned char* pa = pA15 + 64 * 15 + 1024 * tt; const LAS unsigned char* pb = pB + 1024 * tt;
#pragma unroll
            for (int s = 0; s < 16; ++s) {
                W[(16 - s) & 15] = ld_frag4(pa + 64 * s);
                const bf16x8 Bf = *(const LAS bf16x8*)(pb + 64 * s);
                __builtin_amdgcn_s_setprio(1);
#pragma unroll
                for (int i = 0; i < 16; ++i) acc[i] = __builtin_amdgcn_mfma_f32_16x16x32_bf16(W[(i - s) & 15], Bf, acc[i], 0, 0, 0);
                __builtin_amdgcn_s_setprio(0);
            }
        }
        bf16* xo = x0t + ((size_t)ch * NBATCH + i16) * SEQ + base + 4 * kq;
        typedef unsigned u32x2v __attribute__((ext_vector_type(2)));
        u32x2v xall[16];
#pragma unroll
        for (int i = 0; i < 16; ++i) xall[i] = *(const u32x2v*)(xo + 32 * i);
#pragma unroll
        for (int i = 0; i < 16; ++i) {
            const u32x2v xv = xall[i];
            u32x2v o; o.x = pk2(__uint_as_float(xv.x << 16) * acc[i][0], __uint_as_float(xv.x & 0xffff0000u) * acc[i][1]);
            o.y = pk2(__uint_as_float(xv.y << 16) * acc[i][2], __uint_as_float(xv.y & 0xffff0000u) * acc[i][3]);
            if (!dummy) *(u32x2v*)(xo + 32 * i) = o; else *(u32x2v*)((bf16*)(a.ws + WS_YHY) + (size_t)tid * 64 + 4 * i) = o;
        }
        __syncthreads();
    }
}

__device__ __forceinline__ void phase_transpose_y(const Args& a, LAS unsigned char* lds, int tid, int G) {
    const bf16* yt = (const bf16*)(a.ws + WS_X0T); bf16* yhy = (bf16*)(a.ws + WS_YHY);
    LAS unsigned short* tile = (LAS unsigned short*)lds;
#define TY_LOAD(item_) (*(const v4u*)(yt + ((size_t)(((item_) & 7) * 64 + (tid >> 3)) * NBATCH + ((item_) >> 8)) * SEQ + (((item_) >> 3) & 31) * 64 + (tid & 7) * 8))
    v4u vnext = (v4u){0u, 0u, 0u, 0u};
    if ((int)blockIdx.x < 4096) vnext = TY_LOAD((int)blockIdx.x);
    for (int item = blockIdx.x; item < 4096; item += G) {
        const int cc = item & 7, mc = (item >> 3) & 31, b = item >> 8;
        { const int c2 = tid >> 3, ck = tid & 7;
          const v4u v = vnext;
          LAS unsigned* t4 = (LAS unsigned*)(tile + c2 * 72 + ck * 8); t4[0] = v.x; t4[1] = v.y; t4[2] = v.z; t4[3] = v.w; }
        __syncthreads();
        if (item + G < 4096) vnext = TY_LOAD(item + G);
        { const int nl = tid >> 3, cg8 = tid & 7; const LAS unsigned short* s = tile + (cg8 * 8) * 72 + nl;
          v4u o; o.x = s[0] | ((unsigned)s[72] << 16); o.y = s[144] | ((unsigned)s[216] << 16); o.z = s[288] | ((unsigned)s[360] << 16); o.w = s[432] | ((unsigned)s[504] << 16);
          *(v4u*)(yhy + (size_t)(b * SEQ + mc * 64 + nl) * 512 + cc * 64 + cg8 * 8) = o; }
        __syncthreads();
    }
}

constexpr int AT_ROWS = 272, AT_RS = 144, AT_VOFF = AT_ROWS * AT_RS;
__device__ __forceinline__ void phase_attn_mfma(const Args& a, int half, LAS unsigned char* lds, int tid, int G, bool dummy = false) {
    bf16* Q = (bf16*)(a.ws + WS_Q); const bf16* KV = (const bf16*)(a.ws + WS_KV); float* lse = (float*)(a.ws + WS_LSE);
    const int lane = tid & 63, w = __builtin_amdgcn_readfirstlane(tid >> 6), q16 = lane & 15, kq = lane >> 4;
    v4u pre[9]; bf16x8 Qn0, Qn1;
#define AT_DECODE(unit_) const int g = (unit_) >> 10, u = (unit_) & 1023, sub = u & 15, h = (u >> 4) & 7, bl = u >> 7; int dil, n, r, qb; \
        if (g == 0) { dil = 1; n = 2048; r = 0; qb = sub; } else if (g == 1) { dil = 4; n = 512; r = sub >> 2; qb = sub & 3; } else { dil = 16; n = 128; r = sub; qb = 0; } \
        const int q0 = qb * 128, kb0 = q0 - 64; (void)kb0; (void)q0;
#define AT_ISSUE(unit_, PRE_, QN0_, QN1_) do { AT_DECODE(unit_) { const bf16* qn_ = Q + (size_t)(half * HALF_TOK + bl * SEQ + (q0 + 16 * w + q16) * dil + r) * 1536 + g * 512 + h * 64; QN0_ = *(const bf16x8*)(qn_ + 8 * kq); QN1_ = *(const bf16x8*)(qn_ + 32 + 8 * kq); } \
        _Pragma("unroll") for (int k_ = 0; k_ < 9; ++k_) { const int i_ = tid + NTHR * k_; \
            const int which_ = (i_ >= AT_ROWS * 8) ? 1 : 0, j_ = i_ - which_ * AT_ROWS * 8, rr_ = j_ >> 3, ck_ = j_ & 7, key_ = kb0 + rr_; \
            PRE_[k_] = (v4u){0u, 0u, 0u, 0u}; \
            if (i_ < 2 * AT_ROWS * 8 && key_ >= 0 && key_ < n) PRE_[k_] = *(const v4u*)(KV + (size_t)(bl * SEQ + key_ * dil + r) * 3072 + g * 1024 + which_ * 512 + h * 64 + ck_ * 8); } } while (0)
    const int vb = ((G & 7) == 0) ? (int)((blockIdx.x & 7) * (G >> 3) + (blockIdx.x >> 3)) : (int)blockIdx.x;
#define AT_STEP(UNIT_, PRE_, QN0_, QN1_) do { \
_Pragma("unroll") \
        for (int k = 0; k < 9; ++k) { const int i = tid + NTHR * k; const int which = (i >= AT_ROWS * 8) ? 1 : 0, j = i - which * AT_ROWS * 8, rr = j >> 3, ck = j & 7; \
            if (i < 2 * AT_ROWS * 8) *(LAS v4u*)(lds + which * AT_VOFF + rr * AT_RS + ck * 16) = PRE_[k]; } \
        const bf16x8 Qf0 = QN0_, Qf1 = QN1_; \
        __syncthreads(); \
        if (UNIT_ + 2 * G < 3072) AT_ISSUE(UNIT_ + 2 * G, PRE_, QN0_, QN1_); \
        AT_DECODE(UNIT_) \
        { \
            const int i0 = q0 + 16 * w; \
            const int token = half * HALF_TOK + bl * SEQ + (i0 + q16) * dil + r; \
            bf16* qp = Q + (size_t)token * 1536 + g * 512 + h * 64; \
            bf16* op = dummy ? (bf16*)(a.ws + WS_YHY) + (size_t)(tid & 511) * 64 : qp; \
            f32x4 acc[4]; \
_Pragma("unroll") \
            for (int dt = 0; dt < 4; ++dt) acc[dt] = (f32x4){0.f, 0.f, 0.f, 0.f}; \
            const bool edge = (i0 < 64) || (i0 + 80 > n); \
            const LAS unsigned char* kbase = lds + (16 * w + q16) * AT_RS + 16 * kq; \
            const LAS unsigned char* vbase = lds + AT_VOFF + (16 * w + 4 * kq + (q16 >> 2)) * AT_RS + 8 * (q16 & 3); \
            f32x4 s[9]; \
_Pragma("unroll") \
            for (int kt = 0; kt < 9; ++kt) { \
                const LAS unsigned char* kp = kbase + kt * 16 * AT_RS; \
                const bf16x8 K0 = *(const LAS bf16x8*)kp, K1 = *(const LAS bf16x8*)(kp + 64); \
                f32x4 z = (f32x4){0.f, 0.f, 0.f, 0.f}; \
                z = __builtin_amdgcn_mfma_f32_16x16x32_bf16(K0, Qf0, z, 0, 0, 0); \
                z = __builtin_amdgcn_mfma_f32_16x16x32_bf16(K1, Qf1, z, 0, 0, 0); \
                if (kt == 0 || kt == 8 || edge) { \
_Pragma("unroll") \
                    for (int e = 0; e < 4; ++e) { \
                        const int rel = 16 * kt - 64 + 4 * kq + e - q16, j = i0 + q16 + rel; \
                        const bool ok = (rel >= -64) && (rel <= 64) && (j >= 0) && (j < n); \
                        z[e] = ok ? z[e] : -1e30f; \
                    } } \
                s[kt] = z; \
            } \
            float mrun = -1e30f; \
_Pragma("unroll") \
            for (int kt = 0; kt < 9; ++kt) mrun = fmaxf(mrun, fmaxf(fmaxf(s[kt][0], s[kt][1]), fmaxf(s[kt][2], s[kt][3]))); \
            mrun = fmaxf(mrun, __shfl_xor(mrun, 16)); mrun = fmaxf(mrun, __shfl_xor(mrun, 32)); \
            float lrun = 0.f; \
_Pragma("unroll") \
            for (int kt = 0; kt < 9; ++kt) \
_Pragma("unroll") \
                for (int e = 0; e < 4; ++e) { s[kt][e] = __builtin_amdgcn_exp2f(s[kt][e] - mrun); lrun += s[kt][e]; } \
_Pragma("unroll") \
            for (int st = 0; st < 5; ++st) { \
                v4u pw; pw.x = pg8::cvt_pk_bf16(s[2 * st][0], s[2 * st][1]); pw.y = pg8::cvt_pk_bf16(s[2 * st][2], s[2 * st][3]); \
                if (st < 4) { pw.z = pg8::cvt_pk_bf16(s[2 * st + 1][0], s[2 * st + 1][1]); pw.w = pg8::cvt_pk_bf16(s[2 * st + 1][2], s[2 * st + 1][3]); } else { pw.z = 0u; pw.w = 0u; } \
                const bf16x8 Pf = __builtin_bit_cast(bf16x8, pw); \
_Pragma("unroll") \
                for (int dt = 0; dt < 4; ++dt) { \
                    const LAS unsigned char* vp = vbase + 32 * st * AT_RS + 32 * dt; \
                    const s16x4 v0 = __builtin_amdgcn_ds_read_tr16_b64_v4i16((LAS s16x4*)vp); \
                    const s16x4 v1 = __builtin_amdgcn_ds_read_tr16_b64_v4i16((LAS s16x4*)(vp + 16 * AT_RS)); \
                    const bf16x8 Vf = (bf16x8){v0[0], v0[1], v0[2], v0[3], v1[0], v1[1], v1[2], v1[3]}; \
                    acc[dt] = __builtin_amdgcn_mfma_f32_16x16x32_bf16(Vf, Pf, acc[dt], 0, 0, 0); \
                } \
            } \
            lrun += __shfl_xor(lrun, 16); lrun += __shfl_xor(lrun, 32); \
            const float inv = 1.0f / lrun; \
            typedef unsigned u32x2v __attribute__((ext_vector_type(2))); \
_Pragma("unroll") \
            for (int dt = 0; dt < 4; ++dt) { \
                u32x2v o; o.x = pg8::cvt_pk_bf16(acc[dt][0] * inv, acc[dt][1] * inv); o.y = pg8::cvt_pk_bf16(acc[dt][2] * inv, acc[dt][3] * inv); \
                *(u32x2v*)(op + 16 * dt + 4 * kq) = o; \
            } \
            if (kq == 0 && !dummy) lse[((size_t)g * MTOK + token) * 8 + h] = mrun + log2f(lrun); \
        } \
        __syncthreads(); \
    } while (0)
    v4u preB[9]; bf16x8 QnB0, QnB1;
    if (vb < 3072) AT_ISSUE(vb, pre, Qn0, Qn1);
    if (vb + G < 3072) AT_ISSUE(vb + G, preB, QnB0, QnB1);
    for (int unit = vb; unit < 3072; unit += 2 * G) {
        AT_STEP(unit, pre, Qn0, Qn1);
        if (unit + G < 3072) AT_STEP(unit + G, preB, QnB0, QnB1);
    }
}

#define XB_TMO      128
#define XB_XCNT(j)  (256  + 64 * (j))
#define XB_XSUB(j)  (1280 + 64 * (j))
#define XB_XGEN(j)  (2304 + 64 * (j))
#define XB_TOP      3328
#define XB_TOPGEN   3392
#define XCD_BAR_WORDS 3456
#define XB_SPIN_CAP (1u << 18)

__device__ __forceinline__ unsigned xb_ld(unsigned* p)              { return __hip_atomic_load(p, __ATOMIC_RELAXED, __HIP_MEMORY_SCOPE_AGENT); }
__device__ __forceinline__ unsigned xb_add(unsigned* p, unsigned v) { return __hip_atomic_fetch_add(p, v, __ATOMIC_RELAXED, __HIP_MEMORY_SCOPE_AGENT); }
__device__ __forceinline__ unsigned xb_xcc_id() { return (unsigned)__builtin_amdgcn_s_getreg((3 << 11) | 20) & 0xFu; }
#define XB_SPIN(cond, bar) do { unsigned _sp = 0; while (cond) { __builtin_amdgcn_s_sleep(1); \
    if ((++_sp & 255u) == 0u) { if (xb_ld(&(bar)[XB_TMO])) break; if (_sp > XB_SPIN_CAP) { atomicAdd(&(bar)[XB_TMO], 1u); break; } } } } while (0)

struct XcdBarrier {
    unsigned* bar; unsigned x;
    volatile LAS unsigned* st;
};

__device__ __forceinline__ XcdBarrier xcd_barrier_post(unsigned* bar, volatile LAS unsigned* st, bool is_t0) {
    XcdBarrier b; b.bar = bar; b.x = xb_xcc_id(); b.st = st;
    if (is_t0) (void)xb_add(&bar[XB_XCNT(b.x)], 1u);
    return b;
}
__device__ __forceinline__ void xcd_barrier_complete(unsigned* bar, unsigned x, unsigned& nloc, unsigned& nx) {
    const unsigned G = gridDim.x * gridDim.y * gridDim.z;
    unsigned sum, cnt, mine, sp = 0u;
    for (;;) {
        sum = 0u; cnt = 0u; mine = 0u;
#pragma unroll
        for (unsigned j = 0; j < 16; ++j) { const unsigned c = xb_ld(&bar[XB_XCNT(j)]); sum += c; cnt += (c > 0u) ? 1u : 0u; mine = (j == x) ? c : mine; }
        if (sum == G) break;
        __builtin_amdgcn_s_sleep(1);
        if ((++sp & 255u) == 0u) { if (xb_ld(&bar[XB_TMO])) break; if (sp > XB_SPIN_CAP) { atomicAdd(&bar[XB_TMO], 1u); break; } }
    }
    nloc = mine > 0u ? mine : 1u; nx = cnt > 0u ? cnt : 1u;
}

__device__ __forceinline__ void xcd_barrier(const XcdBarrier& b, bool is_t0) {
    asm volatile("s_waitcnt vmcnt(0)" ::: "memory");
    __syncthreads();
    if (is_t0) {
        unsigned* bar = b.bar;
        __builtin_amdgcn_s_waitcnt(0);
        unsigned nloc = b.st[0], nx = b.st[1];
        if (nloc == 0u) { xcd_barrier_complete(bar, b.x, nloc, nx); b.st[0] = nloc; b.st[1] = nx; }
        const unsigned old = xb_add(&bar[XB_XSUB(b.x)], 1u);
        const unsigned gen = old / nloc;
        if (old + 1u == (gen + 1u) * nloc) {
            __builtin_amdgcn_fence(__ATOMIC_RELEASE, "agent");
            asm volatile("s_waitcnt vmcnt(0)" ::: "memory");
            const unsigned og = xb_add(&bar[XB_TOP], 1u);
            const unsigned tg = og / nx;
            if (og + 1u == (tg + 1u) * nx) xb_add(&bar[XB_TOPGEN], 1u);
            else XB_SPIN(xb_ld(&bar[XB_TOPGEN]) == tg, bar);
            __builtin_amdgcn_fence(__ATOMIC_ACQUIRE, "agent");
            xb_add(&bar[XB_XGEN(b.x)], 1u);
            asm volatile("s_waitcnt vmcnt(0)" ::: "memory");
        } else {
            XB_SPIN(xb_ld(&bar[XB_XGEN(b.x)]) == gen, bar);
            __builtin_amdgcn_fence(__ATOMIC_ACQUIRE, "agent");
            asm volatile("s_waitcnt vmcnt(0)" ::: "memory");
        }
    }
    __syncthreads();
}

__device__ __forceinline__ void stagger(int bx, unsigned ticks_per_class) {
    const unsigned q = ((unsigned)bx >> 3) & 3u;
    if (q) { const unsigned long long t0 = __builtin_amdgcn_s_memrealtime(), dt = (unsigned long long)q * ticks_per_class;
             while (__builtin_amdgcn_s_memrealtime() - t0 < dt) __builtin_amdgcn_s_sleep(8); }
}
#ifndef STAG_ON
#define STAG_ON 0
#endif
#ifndef STAG_LIGHT
#define STAG_LIGHT 300u
#endif
#ifndef STAG_HEAVY
#define STAG_HEAVY 1000u
#endif
#define GEMM_CALL(EPI, SCHED, g, S, E) do { if (STAG_ON) stagger(bx, EPI::PERM ? STAG_LIGHT : STAG_HEAVY); pg8::gemm_phase<EPI, SCHED, true, true>(lds, g, S, E, tid); } while (0)
#ifndef PROBE_G
#define PROBE_G 0
#endif
#ifndef PROBE_S
#define PROBE_S 0
#endif
#define GEMM_CALL_P(EPI, SCHED, g, S, E) do { _Pragma("unroll 1") for (int rep_ = 0; rep_ < 1 + PROBE_G; ++rep_) { GEMM_CALL(EPI, SCHED, g, S, E); } } while (0)
#ifndef PROBE_PW
#define PROBE_PW 0
#endif
#ifndef PROBE_PU
#define PROBE_PU 0
#endif
#ifndef PROBE_CT
#define PROBE_CT 0
#endif
#ifndef PROBE_AT
#define PROBE_AT 0
#endif
#ifndef PROBE_HY
#define PROBE_HY 0
#endif
#define REP_N(N_) _Pragma("unroll 1") for (int rep_ = 0; rep_ < 1 + (N_); ++rep_)

__device__ __forceinline__ int lane_id_volatile() { int l; asm volatile("v_mbcnt_lo_u32_b32 %0, -1, 0\n\tv_mbcnt_hi_u32_b32 %0, -1, %0" : "=v"(l)); return l; }
typedef const __attribute__((address_space(4))) Args* KArgs;
__device__ __forceinline__ Args load_args() {
#if defined(__HIP_DEVICE_COMPILE__)
    KArgs p = (KArgs)__builtin_amdgcn_kernarg_segment_ptr();
    asm volatile("" : "+s"(p));
    return *p;
#else
    return Args{};
#endif
}
__global__ void __launch_bounds__(NTHR, 2) fwd_megakernel(Args a_unused) {
    extern __shared__ __attribute__((aligned(16))) unsigned char lds_raw[];
    LAS unsigned char* lds = (LAS unsigned char*)lds_raw;
    cg::grid_group grid = cg::this_grid();
    const int wave0 = __builtin_amdgcn_readfirstlane((int)threadIdx.x >> 6);
    const int G0 = gridDim.x, bx0 = blockIdx.x;
#define TID0() (wave0 * 64 + lane_id_volatile())
    { const int t0_ = TID0(); if (t0_ < 2) ((LAS unsigned*)(lds + LDS_ST_OFF))[t0_] = 0u; }
    __syncthreads();
    { const Args a0 = load_args(); (void)xcd_barrier_post((unsigned*)(a0.ws + WS_BAR), (volatile LAS unsigned*)(lds + LDS_ST_OFF), TID0() == 0); }
#define GSYNC() do { const Args ab = load_args(); XcdBarrier xb_; xb_.bar = (unsigned*)(ab.ws + WS_BAR); xb_.x = xb_xcc_id(); xb_.st = (volatile LAS unsigned*)(lds + LDS_ST_OFF); xcd_barrier(xb_, TID0() == 0); } while (0)
#define PTRS() const Args a = load_args(); int tid = TID0(), G = G0, bx = bx0; asm volatile("" : "+v"(tid), "+s"(G), "+s"(bx)); const int lane = tid & 63, wave = __builtin_amdgcn_readfirstlane(tid >> 6); (void)lane; (void)wave; unsigned char* ws = a.ws; bf16* Wb = (bf16*)(ws + WS_W); const pg8::bf16_t* xb = (const pg8::bf16_t*)(ws + WS_XB); \
    const float* rcos = (const float*)(ws + WS_ROPE); const float* rsin = rcos + 65536; float* ssqA = (float*)(ws + WS_SSQA); float* ssqB = (float*)(ws + WS_SSQB); \
    (void)Wb; (void)xb; (void)rcos; (void)rsin; (void)ssqA; (void)ssqB;
#define GIN() pg8::Gemm gin{xb, (const pg8::bf16_t*)(Wb + W_IN / 2), nullptr, nullptr, MTOK, NIN, DM}; \
    pg8::EpiIn Ein{(pg8::bf16_t*)(ws + WS_HY), (pg8::bf16_t*)(ws + WS_Q), (pg8::bf16_t*)(ws + WS_KV), (pg8::bf16_t*)(ws + WS_GATES), (const LAS float*)(lds + LDS_RTAB), 0};
#define FILL_RTAB(S_, ssq_, E_) pg8::fill_rstd_table(S_, ssq_, (LAS float*)(lds + LDS_RTAB), tid)

#pragma unroll 1
    for (int L = 0; L < 2; ++L) {
        REP_N(PROBE_PW) { PTRS(); phase_prep_weights(a, L, lds, tid, lane, wave, G); }
        if (L == 0) grid.sync(); else GSYNC();
        {
            PTRS(); GIN();
            pg8::TwoRect S; S.a.init(128, 12, 0, 0, G, bx); S.b.init(64, 12, 0, 12, G, bx); S.na = S.a.count();
            FILL_RTAB(S, ssqA, Ein);
            GEMM_CALL_P(pg8::EpiIn, pg8::TwoRect, gin, S, Ein);
        }
        GSYNC();
        REP_N(PROBE_AT) { PTRS(); phase_attn_mfma(a, 0, lds, tid, G, rep_ < PROBE_AT); } { PTRS(); REP_N(PROBE_PU) { phase_prep_u(a, L, lds, tid, G); } }
        GSYNC();
        {
            PTRS(); GIN();
            pg8::RectOrder S; S.init(64, 12, 64, 12, G, bx);
            Ein.kv_row0 = HALF_TOK;
            FILL_RTAB(S, ssqA, Ein);
            GEMM_CALL_P(pg8::EpiIn, pg8::RectOrder, gin, S, Ein);
        }
        REP_N(PROBE_HY) { PTRS(); phase_hyena_mfma(a, lds, tid, G, rep_ < PROBE_HY); }
        GSYNC();
        REP_N(PROBE_AT) { PTRS(); phase_attn_mfma(a, 1, lds, tid, G, rep_ < PROBE_AT); }
        {
            PTRS(); GIN();
            pg8::RectOrder S; S.init(128, 8, 0, 24, G, bx);
            FILL_RTAB(S, ssqA, Ein);
            GEMM_CALL_P(pg8::EpiIn, pg8::RectOrder, gin, S, Ein);
        }
        GSYNC();
        REP_N(PROBE_CT) { PTRS(); phase_combine(a, tid, G); phase_transpose_y(a, lds, tid, G); }
        GSYNC();
        {
            PTRS();
            pg8::Gemm g{(const pg8::bf16_t*)(ws + WS_YHY), (const pg8::bf16_t*)(Wb + W_PHY / 2), (const pg8::bf16_t*)(ws + WS_YATT), (const pg8::bf16_t*)(Wb + W_PATT / 2), MTOK, DM, 512};
            pg8::PairOrder S; S.r.init(128, 4, 0, 0, G, bx);
            pg8::EpiGate E{(const pg8::bf16_t*)(ws + WS_GATES), (pg8::bf16_t*)(ws + WS_MERGED)};
            GEMM_CALL_P(pg8::EpiGate, pg8::PairOrder, g, S, E);
        }
        GSYNC();
        {
            PTRS();
            pg8::Gemm g{(const pg8::bf16_t*)(ws + WS_MERGED), (const pg8::bf16_t*)(Wb + W_O / 2), nullptr, nullptr, MTOK, DM, DM};
            pg8::RectOrder S; S.init(128, 4, 0, 0, G, bx);
            pg8::EpiRes E{L == 0 ? a.in[0] : nullptr, (pg8::bf16_t*)(ws + WS_XB), ssqB};
            GEMM_CALL(pg8::EpiRes, pg8::RectOrder, g, S, E);
        }
        GSYNC();
        {
            PTRS();
            pg8::Gemm g{xb, (const pg8::bf16_t*)(Wb + W_FF1 / 2), nullptr, nullptr, MTOK, DFF, DM};
            pg8::RectOrder S; S.init(128, 16, 0, 0, G, bx);
            pg8::EpiFF1 E{(pg8::bf16_t*)(ws + WS_H), (const LAS float*)(lds + LDS_RTAB)};
            FILL_RTAB(S, ssqB, E);
            GEMM_CALL_P(pg8::EpiFF1, pg8::RectOrder, g, S, E);
        }
        GSYNC();
        {
            PTRS();
            pg8::Gemm g{(const pg8::bf16_t*)(ws + WS_H), (const pg8::bf16_t*)(Wb + W_FF2 / 2), nullptr, nullptr, MTOK, DM, DFF};
            pg8::RectOrder S; S.init(128, 4, 0, 0, G, bx);
            pg8::EpiRes E{nullptr, (pg8::bf16_t*)(ws + WS_XB), ssqA};
            GEMM_CALL(pg8::EpiRes, pg8::RectOrder, g, S, E);
        }
        GSYNC();
    }
    { PTRS(); phase_final_norm(a, lane, wave, G); }
}

extern "C" void kernel_launch(void* const* d_in, const int* in_sizes, int n_in, void* d_out, int out_size, void* d_ws, size_t ws_size, hipStream_t stream) {
    static int grid = 0;
    if (grid == 0) {
        if (n_in != 19 || in_sizes[0] != MTOK * DM || out_size != MTOK * DM || ws_size < WS_END) {
            fprintf(stderr, "kernel_launch: unexpected shapes / workspace (n_in %d, ws %zu, need %zu); nothing launched\n", n_in, ws_size, (size_t)WS_END); grid = -1; return; }
        int dev = 0, cus = 0, per_cu = 0;
        (void)hipGetDevice(&dev); (void)hipDeviceGetAttribute(&cus, hipDeviceAttributeMultiprocessorCount, dev);
        if (hipFuncSetAttribute((const void*)fwd_megakernel, hipFuncAttributeMaxDynamicSharedMemorySize, LDS_BYTES) != hipSuccess) { fprintf(stderr, "kernel_launch: hipFuncSetAttribute failed\n"); grid = -1; return; }
        if (hipOccupancyMaxActiveBlocksPerMultiprocessor(&per_cu, (const void*)fwd_megakernel, NTHR, LDS_BYTES) != hipSuccess || per_cu < 1) { fprintf(stderr, "kernel_launch: occupancy query gives %d\n", per_cu); per_cu = 1; }
        (void)hipGetLastError();
        grid = cus * 1;
        if (grid % 8 != 0 || grid > 256) grid = (grid > 256) ? 256 : (grid / 8) * 8;
    }
    if (grid < 0) return;
    Args a{};
    for (int i = 0; i < 19; ++i) a.in[i] = (const float*)d_in[i];
    a.out = (float*)d_out; a.ws = (unsigned char*)d_ws;
    if (hipMemsetAsync((char*)d_ws + WS_BAR, 0, 16384, stream) != hipSuccess) { fprintf(stderr, "kernel_launch: memset of the barrier words failed\n"); return; }
    void* args[] = {&a};
    hipError_t e = hipLaunchCooperativeKernel((const void*)fwd_megakernel, dim3(grid), dim3(NTHR), args, LDS_BYTES, stream);
    if (e != hipSuccess) fprintf(stderr, "cooperative launch failed: %s (grid %d)\n", hipGetErrorString(e), grid);
}
```

```cpp
#include <hip/hip_runtime.h>
#include <hip/hip_cooperative_groups.h>
#include <cstdio>
#include <cstdint>
namespace cg = cooperative_groups;

namespace pg8 {
#define PG8_LAS __attribute__((address_space(3)))
typedef unsigned short bf16_t;
typedef short bf16x8 __attribute__((ext_vector_type(8)));
typedef float f32x4 __attribute__((ext_vector_type(4)));
typedef unsigned u32x4 __attribute__((ext_vector_type(4)));
constexpr int BM = 256, BK = 64, HALF = 128, HTB = HALF * BK * 2  , STAGE_BYTES = 8 * HTB, NXCD = 8, WGM = 8;

__host__ __device__ __forceinline__ int lds_byte(int r, int c) { const int st = (r >> 4) * 2 + (c >> 5), rr = r & 15, cc = c & 31, ob = rr * 64 + cc * 2; return st * 1024 + (ob ^ (((ob >> 9) & 1) << 5)); }
__host__ __device__ __forceinline__ void stage_rc(int b, int& R, int& C) { const int st = b / 1024, sb = b % 1024, swz = sb ^ (((sb >> 9) & 1) << 5); R = (st >> 1) * 16 + swz / 64; C = (st & 1) * 32 + (swz % 64) / 2; }
__host__ __device__ __forceinline__ int perm32(int rho) { const int n = rho >> 4, i = rho & 15; return 8 * (i >> 2) + 4 * n + (i & 3); }

struct Unit { int pm, pn, z; };
struct Gemm { const bf16_t* A; const bf16_t* Bt; const bf16_t* A1; const bf16_t* Bt1; int M, N, K; };

struct StaticOrder {
    int nM, nN, nwg, G, c;
    __host__ __device__ void init(int M, int N, int G_, int c_) { nM = M / BM; nN = N / BM; nwg = nM * nN; G = G_; c = c_; }
    __host__ __device__ bool next(int i, Unit& u) const {
        const long L = (long)i * G + c; if (L >= nwg) return false;
        int wgid = (int)L; { const int q = nwg / NXCD, r = nwg % NXCD, xcd = wgid % NXCD, off = wgid / NXCD; wgid = (xcd < r ? xcd * (q + 1) : r * (q + 1) + (xcd - r) * q) + off; }
        const int nig = WGM * nN, gid = wgid / nig, fm = gid * WGM, gsz = (nM - fm) < WGM ? (nM - fm) : WGM;
        u.pm = fm + ((wgid % nig) % gsz); u.pn = (wgid % nig) / gsz; return true;
    }
    __device__ __forceinline__ void a_ready(const Unit&) const {}
    __device__ __forceinline__ void done(const Unit&) const {}
};


__device__ __forceinline__ unsigned cvt_pk_bf16(float lo, float hi) { unsigned r; asm volatile("v_cvt_pk_bf16_f32 %0, %1, %2" : "=v"(r) : "v"(lo), "v"(hi)); return r; }
__device__ __forceinline__ float bf_lo(unsigned w) { return __uint_as_float(w << 16); }
__device__ __forceinline__ float bf_hi(unsigned w) { return __uint_as_float(w & 0xffff0000u); }

struct RectOrder {
    int nN, nwg, G, c, pm0, pn0;
    __device__ __forceinline__ void init(int nM_, int nN_, int pm0_, int pn0_, int G_, int c_) { nN = nN_; nwg = nM_ * nN_; G = G_; c = c_; pm0 = pm0_; pn0 = pn0_; }
    __device__ __forceinline__ int count() const { return nwg > c ? (nwg - c + G - 1) / G : 0; }
    __device__ __forceinline__ bool next(int i, Unit& u) const {
        const long L = (long)i * G + c; if (L >= nwg) return false;
        int w = (int)L;
        if ((nwg & 7) == 0 && (G & 7) == 0) w = (c & 7) * (nwg >> 3) + (w >> 3);
        const int nig = 8 * nN, gid = w / nig, r = w % nig;
        u.pm = pm0 + gid * 8 + (r & 7); u.pn = pn0 + (r >> 3); u.z = 0; return true;
    }
    __device__ __forceinline__ void a_ready(const Unit&) const {}
    __device__ __forceinline__ void done(const Unit&) const {}
};
struct TwoRect {
    RectOrder a, b; int na;
    __device__ __forceinline__ bool next(int i, Unit& u) const { return i < na ? a.next(i, u) : b.next(i - na, u); }
    __device__ __forceinline__ void a_ready(const Unit&) const {}
    __device__ __forceinline__ void done(const Unit&) const {}
};
struct PairOrder {
    RectOrder r;
    __device__ __forceinline__ bool next(int i, Unit& u) const { const bool ok = r.next(i >> 1, u); u.z = i & 1; return ok; }
    __device__ __forceinline__ void a_ready(const Unit&) const {}
    __device__ __forceinline__ void done(const Unit&) const {}
};

constexpr float RMS_EPS = 1e-6f;
constexpr float QSCALE = 0.125f * 1.44269504088896341f;

__device__ __forceinline__ float row_rstd(const float* ssq, int row) {
    const f32x4* p = (const f32x4*)(ssq + (size_t)row * 16);
    const f32x4 a = p[0], b = p[1], c = p[2], d = p[3];
    const float s = ((a[0] + a[1]) + (a[2] + a[3])) + ((b[0] + b[1]) + (b[2] + b[3])) + ((c[0] + c[1]) + (c[2] + c[3])) + ((d[0] + d[1]) + (d[2] + d[3]));
    return __builtin_amdgcn_rsqf(s * (1.0f / 1024.0f) + RMS_EPS);
}

template <class Sched>
__device__ __forceinline__ void fill_rstd_table(const Sched& S, const float* ssq, PG8_LAS float* rtab, int tid) {
    int q0 = -1, q1 = -1, q2 = -1; Unit u;
#pragma unroll 1
    for (int i = 0; S.next(i, u); ++i) { if (u.pm == q0 || u.pm == q1 || u.pm == q2) continue; if (q0 < 0) q0 = u.pm; else if (q1 < 0) q1 = u.pm; else if (q2 < 0) q2 = u.pm; }
    if (tid == 0) { ((PG8_LAS int*)rtab)[768] = q0; ((PG8_LAS int*)rtab)[769] = q1; ((PG8_LAS int*)rtab)[770] = 0; }
    const int t = tid & 255, half = tid >> 8;
    { const int pm = half ? q1 : q0; if (pm >= 0) { rtab[half * 256 + t] = row_rstd(ssq, pm * BM + t); } }
    if (q2 >= 0 && half == 0) { const float v = row_rstd(ssq, q2 * BM + t); rtab[512 + t] = v; }
    __syncthreads();
}

struct EpiIn {
    static constexpr bool PERM = true, AFTER_DRAIN = false, IDEMPOTENT = true;
    bf16_t* hy; bf16_t* q; bf16_t* kv; bf16_t* gates; const PG8_LAS float* rtab; int kv_row0;
    __device__ __forceinline__ bool operator()(f32x4 (&acc)[2][2][4][2], const Unit& u, int wr, int wc, int fr, int fq) const {
        const int pn = u.pn; int type, ldc, colt, rowoff = 0; bf16_t* base;
        if (pn < 6) { type = 0; base = hy; ldc = 1536; colt = pn * 256; }
        else if (pn < 12) { type = 1; base = q; ldc = 1536; colt = (pn - 6) * 256; }
        else if (pn < 24) { const int idx = pn - 12; type = ((idx >> 1) & 1) ? 0 : 2; base = kv; ldc = 3072; colt = idx * 256; rowoff = kv_row0; }
        else { type = 3; base = gates; ldc = 2048; colt = (pn - 24) * 256; }
        const bool rot = (type == 1 || type == 2);
        const int row0 = u.pm * BM + wr * 64 + fr;
        const int p0 = ((const PG8_LAS int*)rtab)[768], p1 = ((const PG8_LAS int*)rtab)[769];
        const PG8_LAS float* rt = rtab + ((u.pm == p0) ? 0 : ((u.pm == p1) ? 256 : 512)) + wr * 64 + fr;
        float frev[8];
#pragma unroll
        for (int e = 0; e < 8; ++e) frev[e] = __builtin_amdgcn_exp2f(-(float)(8 * fq + e) * (13.287712379549449f / 32.0f)) * 0.15915494309189535f;
#pragma unroll
        for (int k = 0; k < 8; ++k) {
            const int ai = k >> 2, m = k & 3, cb = k & 1;
            const int row = row0 + ai * HALF + m * 16;
            const float rs = rt[ai * HALF + m * 16];
            bf16_t* rowp = base + (size_t)(row - rowoff) * ldc + colt;
            f32x4 v00 = acc[ai][0][m][0] * rs, v01 = acc[ai][0][m][1] * rs, v10 = acc[ai][1][m][0] * rs, v11 = acc[ai][1][m][1] * rs;
            if (rot) {
                const float posf = (float)(row & 2047);
                f32x4 c0, c1, s0, s1;
#pragma unroll
                for (int e = 0; e < 4; ++e) { const float r0 = __builtin_amdgcn_fractf(posf * frev[e]), r1 = __builtin_amdgcn_fractf(posf * frev[4 + e]);
                    c0[e] = __builtin_amdgcn_cosf(r0); s0[e] = __builtin_amdgcn_sinf(r0); c1[e] = __builtin_amdgcn_cosf(r1); s1[e] = __builtin_amdgcn_sinf(r1); }
                const float sc = (type == 1) ? QSCALE : 1.0f;
                const f32x4 o00 = (v00 * c0 - v10 * s0) * sc, o01 = (v01 * c1 - v11 * s1) * sc;
                const f32x4 o10 = (v10 * c0 + v00 * s0) * sc, o11 = (v11 * c1 + v01 * s1) * sc;
                u32x4 w0, w1;
                w0.x = cvt_pk_bf16(o00[0], o00[1]); w0.y = cvt_pk_bf16(o00[2], o00[3]); w0.z = cvt_pk_bf16(o01[0], o01[1]); w0.w = cvt_pk_bf16(o01[2], o01[3]);
                w1.x = cvt_pk_bf16(o10[0], o10[1]); w1.y = cvt_pk_bf16(o10[2], o10[3]); w1.z = cvt_pk_bf16(o11[0], o11[1]); w1.w = cvt_pk_bf16(o11[2], o11[3]);
                *(u32x4*)(rowp + wc * 64 + 8 * fq) = w0;
                *(u32x4*)(rowp + wc * 64 + 8 * fq + 32) = w1;
            } else {
                if (type == 3) {
#pragma unroll
                    for (int e = 0; e < 4; ++e) {
                        v00[e] = __builtin_amdgcn_rcpf(1.0f + __expf(-v00[e])); v01[e] = __builtin_amdgcn_rcpf(1.0f + __expf(-v01[e]));
                        v10[e] = __builtin_amdgcn_rcpf(1.0f + __expf(-v10[e])); v11[e] = __builtin_amdgcn_rcpf(1.0f + __expf(-v11[e]));
                    }
                }
                u32x4 w0, w1;
                w0.x = cvt_pk_bf16(v00[0], v00[1]); w0.y = cvt_pk_bf16(v00[2], v00[3]); w0.z = cvt_pk_bf16(v01[0], v01[1]); w0.w = cvt_pk_bf16(v01[2], v01[3]);
                w1.x = cvt_pk_bf16(v10[0], v10[1]); w1.y = cvt_pk_bf16(v10[2], v10[3]); w1.z = cvt_pk_bf16(v11[0], v11[1]); w1.w = cvt_pk_bf16(v11[2], v11[3]);
                *(u32x4*)(rowp + wc * 32 + 8 * fq) = w0;
                *(u32x4*)(rowp + wc * 32 + 8 * fq + HALF) = w1;
            }
        }
        return false;
    }
};

struct EpiGate {
    static constexpr bool PERM = true, AFTER_DRAIN = false, IDEMPOTENT = false;
    const bf16_t* gates; bf16_t* merged;
    __device__ __forceinline__ bool operator()(f32x4 (&acc)[2][2][4][2], const Unit& u, int wr, int wc, int fr, int fq) const {
        const int row0 = u.pm * BM + wr * 64 + fr, col0 = u.pn * BM + wc * 32 + 8 * fq;
        const bool first = (u.z == 0);
        u32x4 GA[2][2], GH[2][2];
#define EPIG_LOAD(k_, buf_) do { const bf16_t* gp_ = gates + (size_t)(row0 + ((k_) >> 2) * HALF + ((k_) & 3) * 16) * 2048 + col0; \
            GA[buf_][0] = *(const u32x4*)(gp_ + 1024); GA[buf_][1] = *(const u32x4*)(gp_ + 1024 + HALF); \
            if (first) { GH[buf_][0] = *(const u32x4*)(gp_); GH[buf_][1] = *(const u32x4*)(gp_ + HALF); } } while (0)
        EPIG_LOAD(0, 0);
#pragma unroll
        for (int k = 0; k < 8; ++k) {
            const int ai = k >> 2, m = k & 3, cb = k & 1;
            if (k < 7) EPIG_LOAD(k + 1, cb ^ 1);
            const int row = row0 + ai * HALF + m * 16;
#pragma unroll
            for (int bj = 0; bj < 2; ++bj) {
                const u32x4 ga = GA[cb][bj];
                f32x4 a0 = (f32x4){bf_lo(ga.x), bf_hi(ga.x), bf_lo(ga.y), bf_hi(ga.y)}, a1 = (f32x4){bf_lo(ga.z), bf_hi(ga.z), bf_lo(ga.w), bf_hi(ga.w)};
                if (first) {
                    const u32x4 gh = GH[cb][bj];
                    const f32x4 h0 = (f32x4){bf_lo(gh.x), bf_hi(gh.x), bf_lo(gh.y), bf_hi(gh.y)}, h1 = (f32x4){bf_lo(gh.z), bf_hi(gh.z), bf_lo(gh.w), bf_hi(gh.w)};
#pragma unroll
                    for (int e = 0; e < 4; ++e) { a0[e] = fmaxf(a0[e], 1e-30f); a1[e] = fmaxf(a1[e], 1e-30f); }
#pragma unroll
                    for (int e = 0; e < 4; ++e) { acc[ai][bj][m][0][e] *= h0[e] * __builtin_amdgcn_rcpf(a0[e]); acc[ai][bj][m][1][e] *= h1[e] * __builtin_amdgcn_rcpf(a1[e]); }
                } else {
                    const f32x4 v0 = acc[ai][bj][m][0] * a0, v1 = acc[ai][bj][m][1] * a1;
                    u32x4 w; w.x = cvt_pk_bf16(v0[0], v0[1]); w.y = cvt_pk_bf16(v0[2], v0[3]); w.z = cvt_pk_bf16(v1[0], v1[1]); w.w = cvt_pk_bf16(v1[2], v1[3]);
                    *(u32x4*)(merged + (size_t)row * 1024 + col0 + bj * HALF) = w;
                }
            }
        }
#undef EPIG_LOAD
        return first;
    }
};

struct EpiRes {
    static constexpr bool PERM = true, AFTER_DRAIN = false, IDEMPOTENT = false;
    const float* base32; bf16_t* xb; float* ssq;
    __device__ __forceinline__ bool operator()(f32x4 (&acc)[2][2][4][2], const Unit& u, int wr, int wc, int fr, int fq) const {
        int rl = wr * 64 + fr, cl = wc * 32 + 8 * fq;
        asm volatile("" : "+v"(rl), "+v"(cl));
        const bool f32base = base32 != nullptr;
        f32x4 Bv[2][4];
#define EPIRES_LOAD(k_, buf_) do { const size_t off_ = (size_t)(u.pm * BM + ((k_) >> 2) * HALF + ((k_) & 3) * 16 + rl) * 1024 + u.pn * BM + cl; \
            if (f32base) { Bv[buf_][0] = *(const f32x4*)(base32 + off_); Bv[buf_][1] = *(const f32x4*)(base32 + off_ + 4); Bv[buf_][2] = *(const f32x4*)(base32 + off_ + HALF); Bv[buf_][3] = *(const f32x4*)(base32 + off_ + HALF + 4); } \
            else { _Pragma("unroll") for (int j_ = 0; j_ < 2; ++j_) { const u32x4 w_ = *(const u32x4*)(xb + off_ + j_ * HALF); \
                       Bv[buf_][2 * j_] = (f32x4){bf_lo(w_.x), bf_hi(w_.x), bf_lo(w_.y), bf_hi(w_.y)}; Bv[buf_][2 * j_ + 1] = (f32x4){bf_lo(w_.z), bf_hi(w_.z), bf_lo(w_.w), bf_hi(w_.w)}; } } } while (0)
        EPIRES_LOAD(0, 0);
#pragma unroll
        for (int k = 0; k < 8; ++k) {
            const int ai = k >> 2, m = k & 3, cb = k & 1;
            if (k < 7) EPIRES_LOAD(k + 1, cb ^ 1);
            const int row = u.pm * BM + ai * HALF + m * 16 + rl;
            const size_t off = (size_t)row * 1024 + u.pn * BM + cl;
            float s = 0.f;
#pragma unroll
            for (int bj = 0; bj < 2; ++bj) {
                const f32x4 o0 = Bv[cb][bj * 2] + acc[ai][bj][m][0], o1 = Bv[cb][bj * 2 + 1] + acc[ai][bj][m][1];
                u32x4 w; w.x = cvt_pk_bf16(o0[0], o0[1]); w.y = cvt_pk_bf16(o0[2], o0[3]); w.z = cvt_pk_bf16(o1[0], o1[1]); w.w = cvt_pk_bf16(o1[2], o1[3]);
                *(u32x4*)(xb + off + bj * HALF) = w;
                s += ((o0[0] * o0[0] + o0[1] * o0[1]) + (o0[2] * o0[2] + o0[3] * o0[3])) + ((o1[0] * o1[0] + o1[1] * o1[1]) + (o1[2] * o1[2] + o1[3] * o1[3]));
            }
            s += __shfl_xor(s, 16); s += __shfl_xor(s, 32);
            if (fq == 0) ssq[(size_t)row * 16 + u.pn * 4 + wc] = s;
        }
#undef EPIRES_LOAD
        return false;
    }
};

struct EpiFF1 {
    static constexpr bool PERM = true, AFTER_DRAIN = false, IDEMPOTENT = true;
    bf16_t* h; const PG8_LAS float* rtab;
    __device__ __forceinline__ bool operator()(f32x4 (&acc)[2][2][4][2], const Unit& u, int wr, int wc, int fr, int fq) const {
        const int row0 = u.pm * BM + wr * 64 + fr;
        const int p0 = ((const PG8_LAS int*)rtab)[768], p1 = ((const PG8_LAS int*)rtab)[769];
        const PG8_LAS float* rt = rtab + ((u.pm == p0) ? 0 : ((u.pm == p1) ? 256 : 512)) + wr * 64 + fr;
        float rsv[8];
#pragma unroll
        for (int k = 0; k < 8; ++k) rsv[k] = rt[(k >> 2) * HALF + (k & 3) * 16];
#pragma unroll
        for (int ai = 0; ai < 2; ++ai)
#pragma unroll
            for (int m = 0; m < 4; ++m) {
                const int row = row0 + ai * HALF + m * 16;
                const float rs = rsv[ai * 4 + m];
                bf16_t* rowp = h + (size_t)row * 4096 + u.pn * BM + wc * 32 + 8 * fq;
#pragma unroll
                for (int bj = 0; bj < 2; ++bj) {
                    f32x4 v0 = acc[ai][bj][m][0] * rs, v1 = acc[ai][bj][m][1] * rs;
#pragma unroll
                    for (int e = 0; e < 4; ++e) { v0[e] = fmaxf(v0[e], 0.f); v1[e] = fmaxf(v1[e], 0.f); }
                    v0 = v0 * v0; v1 = v1 * v1;
                    u32x4 w; w.x = cvt_pk_bf16(v0[0], v0[1]); w.y = cvt_pk_bf16(v0[2], v0[3]); w.z = cvt_pk_bf16(v1[0], v1[1]); w.w = cvt_pk_bf16(v1[2], v1[3]);
                    *(u32x4*)(rowp + bj * HALF) = w;
                }
            }
        return false;
    }
};

template <class Epi, class Sched, bool ALIGN_EPI = false, bool SP2 = false>
__device__ __forceinline__ void gemm_phase(PG8_LAS unsigned char* lds, const Gemm g, const Sched& S, const Epi& E, int tid_in) {
    int tid_ = tid_in; asm volatile("" : "+v"(tid_));
    const int tid = tid_, wid = __builtin_amdgcn_readfirstlane(tid >> 6), lane = tid & 63, wr = wid >> 2, wc = wid & 3, fr = lane & 15, fq = lane >> 4;
    const int K = g.K, nt = K / BK;
    unsigned voffA[2], voffB[2];
#pragma unroll
    for (int i = 0; i < 2; ++i) { int R, C; stage_rc(tid * 16 + i * 8192, R, C); const int Rb = Epi::PERM ? ((R & ~31) + perm32(R & 31)) : R;
        voffA[i] = (unsigned)(R * K + C) * 2u; voffB[i] = (unsigned)(Rb * K + C) * 2u; }
    const size_t kstep = (size_t)(BK * 2);
    const size_t hstep = (size_t)HALF * K * 2;
    const size_t tstep = 2 * hstep;
    const unsigned ldsw = (unsigned)wid * 1024u;
    const int aoff = lds_byte(wr * 64 + fr, fq * 8), boff = lds_byte(wc * 32 + fr, fq * 8);
#define PG8_SA(b, h) (((b) * 2 + (h)) * HTB)
#define PG8_SB(b, h) ((4 + (b) * 2 + (h)) * HTB)
#define PG8_STAGE(bufoff, gbase, voff) do { _Pragma("unroll") for (int _i = 0; _i < 2; ++_i) \
        __builtin_amdgcn_global_load_lds((const unsigned*)((const char*)(gbase) + (voff)[_i]), (PG8_LAS unsigned*)(lds + (bufoff) + ldsw + _i * 8192), 16, 0, 0); } while (0)
#define PG8_LDA(dst, b, h) do { _Pragma("unroll") for (int m = 0; m < 4; ++m) _Pragma("unroll") for (int k = 0; k < 2; ++k) dst[m][k] = *(const PG8_LAS bf16x8*)(lds + PG8_SA(b, h) + aoff + m * 2048 + k * 1024); } while (0)
#define PG8_LDB(dst, b, h) do { _Pragma("unroll") for (int n = 0; n < 2; ++n) _Pragma("unroll") for (int k = 0; k < 2; ++k) dst[n][k] = *(const PG8_LAS bf16x8*)(lds + PG8_SB(b, h) + boff + n * 2048 + k * 1024); } while (0)
#define PG8_MMA(ai, bj, At, Bt) do { __builtin_amdgcn_s_setprio(1); _Pragma("unroll") for (int m = 0; m < 4; ++m) _Pragma("unroll") for (int n = 0; n < 2; ++n) _Pragma("unroll") for (int k = 0; k < 2; ++k) \
        acc[ai][bj][m][n] = __builtin_amdgcn_mfma_f32_16x16x32_bf16(Bt[n][k], At[m][k], acc[ai][bj][m][n], 0, 0, 0); __builtin_amdgcn_s_setprio(0); } while (0)
#define PG8_WAIT_V(n) asm volatile("s_waitcnt vmcnt(" #n ")" ::: "memory")
#define PG8_WAIT_L(n) asm volatile("s_waitcnt lgkmcnt(" #n ")" ::: "memory")
#define PG8_BAR __builtin_amdgcn_s_barrier()
#define PG8_SCHED __builtin_amdgcn_sched_barrier(0)
    Unit cur, nxt; int ui = 0;
    if (!S.next(0, cur)) return;
    f32x4 acc[2][2][4][2];
#pragma unroll
    for (int a = 0; a < 2; ++a)
#pragma unroll
        for (int b = 0; b < 2; ++b)
#pragma unroll
            for (int m = 0; m < 4; ++m)
#pragma unroll
                for (int n = 0; n < 2; ++n) acc[a][b][m][n] = (f32x4){0.f, 0.f, 0.f, 0.f};
    bf16x8 At[4][2], B0[2][2], B1[2][2];
    const char* cA = (const char*)(cur.z ? g.A1 : g.A) + (size_t)cur.pm * tstep; const char* cB = (const char*)(cur.z ? g.Bt1 : g.Bt) + (size_t)cur.pn * tstep;
    S.a_ready(cur);
    if constexpr (SP2) {
        PG8_STAGE(PG8_SB(0, 0), cB, voffB); PG8_STAGE(PG8_SB(0, 1), cB + hstep, voffB); PG8_STAGE(PG8_SA(0, 0), cA, voffA); PG8_STAGE(PG8_SA(0, 1), cA + hstep, voffA);
        if (wr == 1) PG8_BAR;
        PG8_WAIT_V(2); PG8_BAR;
        PG8_STAGE(PG8_SB(1, 0), cB + kstep, voffB); PG8_STAGE(PG8_SA(1, 0), cA + kstep, voffA); PG8_STAGE(PG8_SB(1, 1), cB + hstep + kstep, voffB);
        PG8_WAIT_V(6); PG8_BAR;
    } else {
        PG8_STAGE(PG8_SB(0, 0), cB, voffB); PG8_STAGE(PG8_SA(0, 0), cA, voffA); PG8_STAGE(PG8_SB(0, 1), cB + hstep, voffB); PG8_STAGE(PG8_SA(0, 1), cA + hstep, voffA);
        if (wr == 1) PG8_BAR;
        PG8_WAIT_V(4); PG8_BAR;
        PG8_STAGE(PG8_SB(1, 0), cB + kstep, voffB); PG8_STAGE(PG8_SA(1, 0), cA + kstep, voffA); PG8_STAGE(PG8_SB(1, 1), cB + hstep + kstep, voffB);
        PG8_WAIT_V(6); PG8_BAR;
    }
    for (;;) {
        const bool has_next = S.next(ui + 1, nxt);
        const char* nA = has_next ? (const char*)(nxt.z ? g.A1 : g.A) + (size_t)nxt.pm * tstep : cA; const char* nB = has_next ? (const char*)(nxt.z ? g.Bt1 : g.Bt) + (size_t)nxt.pn * tstep : cB;
        for (int t = 0; t < nt; t += 2) {
            const bool last = (t == nt - 2);
            const char* a1 = cA + (size_t)(t + 1) * kstep;
            const char* a2 = last ? nA : cA + (size_t)(t + 2) * kstep; const char* b2 = last ? nB : cB + (size_t)(t + 2) * kstep;
            const char* a3 = a2 + kstep; const char* b3 = b2 + kstep;
            if (last && has_next) S.a_ready(nxt);
            if constexpr (SP2) {
            PG8_LDB(B0, 0, 0); PG8_LDB(B1, 0, 1); PG8_SCHED; PG8_LDA(At, 0, 0); PG8_STAGE(PG8_SA(1, 1), a1 + hstep, voffA);
            PG8_WAIT_V(8); PG8_WAIT_L(0); PG8_BAR; PG8_MMA(0, 0, At, B0); PG8_MMA(0, 1, At, B1); PG8_BAR; PG8_SCHED;
            PG8_LDA(At, 0, 1); PG8_STAGE(PG8_SB(0, 0), b2, voffB); PG8_STAGE(PG8_SB(0, 1), b2 + hstep, voffB); PG8_STAGE(PG8_SA(0, 0), a2, voffA);
            PG8_WAIT_V(8); PG8_WAIT_L(0); PG8_BAR; PG8_MMA(1, 0, At, B0); PG8_MMA(1, 1, At, B1); PG8_BAR; PG8_SCHED;
            PG8_LDB(B0, 1, 0); PG8_LDB(B1, 1, 1); PG8_SCHED; PG8_LDA(At, 1, 0); PG8_STAGE(PG8_SA(0, 1), a2 + hstep, voffA);
            PG8_WAIT_V(8); PG8_WAIT_L(0); PG8_BAR; PG8_MMA(0, 0, At, B0); PG8_MMA(0, 1, At, B1); PG8_BAR; PG8_SCHED;
            PG8_LDA(At, 1, 1); PG8_STAGE(PG8_SB(1, 0), b3, voffB); PG8_STAGE(PG8_SB(1, 1), b3 + hstep, voffB); PG8_STAGE(PG8_SA(1, 0), a3, voffA);
            PG8_WAIT_V(8); PG8_WAIT_L(0); PG8_BAR; PG8_MMA(1, 0, At, B0); PG8_MMA(1, 1, At, B1); PG8_BAR; PG8_SCHED;
            } else {
            PG8_LDB(B0, 0, 0); PG8_SCHED; PG8_LDA(At, 0, 0); PG8_STAGE(PG8_SA(1, 1), a1 + hstep, voffA);
            PG8_WAIT_L(8); PG8_BAR; PG8_WAIT_L(0); PG8_MMA(0, 0, At, B0); PG8_BAR; PG8_SCHED;
            PG8_LDB(B1, 0, 1); PG8_STAGE(PG8_SB(0, 0), b2, voffB);
            PG8_BAR; PG8_WAIT_L(0); PG8_MMA(0, 1, At, B1); PG8_BAR;
            PG8_LDA(At, 0, 1); PG8_STAGE(PG8_SA(0, 0), a2, voffA);
            PG8_BAR; PG8_WAIT_L(0); PG8_MMA(1, 0, At, B0); PG8_BAR; PG8_SCHED;
            PG8_STAGE(PG8_SB(0, 1), b2 + hstep, voffB);
            PG8_WAIT_V(6); PG8_BAR; PG8_MMA(1, 1, At, B1); PG8_BAR;
            PG8_LDB(B0, 1, 0); PG8_SCHED; PG8_LDA(At, 1, 0); PG8_STAGE(PG8_SA(0, 1), a2 + hstep, voffA);
            PG8_WAIT_L(8); PG8_BAR; PG8_WAIT_L(0); PG8_MMA(0, 0, At, B0); PG8_BAR; PG8_SCHED;
            PG8_LDB(B1, 1, 1); PG8_STAGE(PG8_SB(1, 0), b3, voffB);
            PG8_BAR; PG8_WAIT_L(0); PG8_MMA(0, 1, At, B1); PG8_BAR;
            PG8_LDA(At, 1, 1); PG8_STAGE(PG8_SA(1, 0), a3, voffA);
            PG8_BAR; PG8_WAIT_L(0); PG8_MMA(1, 0, At, B0); PG8_BAR; PG8_SCHED;
            PG8_STAGE(PG8_SB(1, 1), b3 + hstep, voffB);
            PG8_WAIT_V(6); PG8_BAR; PG8_MMA(1, 1, At, B1); PG8_BAR;
            }
        }
        if constexpr (ALIGN_EPI) { if (wr == 0) PG8_BAR; }
#ifndef PROBE_EPI
#define PROBE_EPI 0
#endif
        bool keep_acc = false; if constexpr (!Epi::AFTER_DRAIN) { keep_acc = E(acc, cur, wr, wc, fr, fq); if constexpr (Epi::IDEMPOTENT && PROBE_EPI) { asm volatile("" ::: "memory"); keep_acc = E(acc, cur, wr, wc, fr, fq); } S.done(cur); }
        if (!has_next) break;
        if (!keep_acc) {
#pragma unroll
        for (int a = 0; a < 2; ++a)
#pragma unroll
            for (int b = 0; b < 2; ++b)
#pragma unroll
                for (int m = 0; m < 4; ++m)
#pragma unroll
                    for (int n = 0; n < 2; ++n) acc[a][b][m][n] = (f32x4){0.f, 0.f, 0.f, 0.f};
        }
        cur = nxt; cA = nA; cB = nB; ++ui;
        if constexpr (ALIGN_EPI) { if (wr == 1) PG8_BAR; }
    }
    PG8_WAIT_V(0);
    if constexpr (!ALIGN_EPI) { if (wr == 0) PG8_BAR; }
    PG8_BAR;
    if constexpr (Epi::AFTER_DRAIN) { E.fused(acc, cur, wr, wc, fr, fq, lds, wid, lane); S.done(cur); }
#undef PG8_SA
#undef PG8_SB
#undef PG8_STAGE
#undef PG8_LDA
#undef PG8_LDB
#undef PG8_MMA
#undef PG8_WAIT_V
#undef PG8_WAIT_L
#undef PG8_BAR
#undef PG8_SCHED
}
}

#define LAS __attribute__((address_space(3)))
typedef unsigned short bf16;
typedef float f32x4 __attribute__((ext_vector_type(4)));
typedef unsigned v4u __attribute__((ext_vector_type(4)));
constexpr int NWAVES = 8, NTHR = 512;
constexpr int MTOK = 32768, DM = 1024, SEQ = 2048, NBATCH = 16, NIN = 8192, DFF = 4096, HYW = 512, HALF_TOK = 16384;
constexpr size_t MiB = (size_t)1 << 20;
constexpr size_t WS_SSQA = 0, WS_SSQB = 2 * MiB, WS_ROPE = 4 * MiB, WS_RSTD = 4 * MiB + 512 * 1024, WS_BAR = 4 * MiB + 768 * 1024, WS_LSE = 5 * MiB, WS_GF = 8 * MiB, WS_W = 16 * MiB, WS_XB = 52 * MiB,
                 WS_HY = 116 * MiB, WS_UT = 212 * MiB, WS_GATES = 116 * MiB, WS_Q = 244 * MiB, WS_KV = 340 * MiB, WS_YHY = 436 * MiB, WS_YATT = 404 * MiB, WS_X0T = 468 * MiB,
                 WS_MERGED = 340 * MiB, WS_H = 116 * MiB, WS_END = 500 * MiB;
constexpr size_t W_IN = 0, W_PHY = 16 * MiB, W_PATT = 17 * MiB, W_O = 18 * MiB, W_FF1 = 20 * MiB, W_FF2 = 28 * MiB;
constexpr int LDS_RTAB = 131072;
constexpr int LDS_ST_OFF = 135168;
constexpr int LDS_BYTES = 139264;

struct Args {
    const float* in[19]; float* out; unsigned char* ws; int pad0, pad1;
};

__device__ __forceinline__ unsigned f2bf(float f) { unsigned u = __float_as_uint(f); return (u + 0x7fffu + ((u >> 16) & 1u)) >> 16; }
__device__ __forceinline__ unsigned pk2(float lo, float hi) { return f2bf(lo) | (f2bf(hi) << 16); }
__device__ __forceinline__ float bf2f(unsigned short b) { return __uint_as_float((unsigned)b << 16); }
__device__ __forceinline__ float wave_sum(float v) {
#pragma unroll
    for (int o = 1; o < 64; o <<= 1) v += __shfl_xor(v, o);
    return v;
}

__device__ __forceinline__ int win_src_col(int n) {
    const int t = n >> 8, j = n & 255;
    if (t < 6) return n;
    if (t >= 24) return 6144 + (n - 6144);
    int g, w, half;
    if (t < 12) { const int i = t - 6; g = i >> 1; w = 0; half = i & 1; }
    else { const int i = t - 12; g = i >> 2; w = 1 + ((i >> 1) & 1); half = i & 1; }
    int hh, d;
    if (w == 2) { hh = j >> 6; d = j & 63; }
    else { hh = (j & 127) >> 5; d = (j & 31) + ((j >> 7) << 5); }
    return 1536 + g * 1536 + w * 512 + (half * 4 + hh) * 64 + d;
}

__device__ __forceinline__ void transpose_item(const float* W, int K, int Nsrc, int s0, bf16* WT, int n0, int k0, const float* gain, LAS float* scr, int lane) {
    float tv[32];
#pragma unroll
    for (int i = 0; i < 32; ++i) { const int kk = 2 * i + (lane >> 5); tv[i] = W[(size_t)(k0 + kk) * Nsrc + s0 + (lane & 31)]; }
    const float gl = gain ? gain[k0 + lane] : 1.0f;
#pragma unroll
    for (int i = 0; i < 32; ++i) { const int kk = 2 * i + (lane >> 5); scr[kk * 33 + (lane & 31)] = tv[i] * __shfl(gl, kk); }
    asm volatile("s_waitcnt lgkmcnt(0)" ::: "memory");
    const int c = lane & 7;
#pragma unroll
    for (int j = 0; j < 4; ++j) { const int n = (lane >> 3) + 8 * j; const LAS float* s = scr + (8 * c) * 33 + n;
        v4u o; o.x = pk2(s[0 * 33], s[1 * 33]); o.y = pk2(s[2 * 33], s[3 * 33]); o.z = pk2(s[4 * 33], s[5 * 33]); o.w = pk2(s[6 * 33], s[7 * 33]);
        *(v4u*)(WT + (size_t)(n0 + n) * K + k0 + 8 * c) = o; }
    asm volatile("s_waitcnt lgkmcnt(0)" ::: "memory");
}

__device__ __forceinline__ void phase_prep_weights(const Args& a, int L, LAS unsigned char* lds, int tid, int lane, int wave, int G) {
    unsigned char* ws = a.ws;
    {
        const float* w1 = a.in[5] + (size_t)L * 33 * 64; const float* b1 = a.in[6] + L * 64;
        const float* wi = a.in[7] + (size_t)L * 2 * 64 * 64; const float* bi = a.in[8] + L * 2 * 64;
        const float* wout = a.in[9] + (size_t)L * 64 * 1024; const float* fr = a.in[10] + L * 64; const float* skip = a.in[11] + L * 512;
        bf16* Rg = (bf16*)(ws + WS_GF);
        const float min_decay = logf(1e-2f) / 1.5f, max_decay = logf(1e-2f) / 0.3f;
        LAS float* hb = (LAS float*)lds + wave * 64;
        LAS float* fbuf = (LAS float*)(lds + 4096);
        const float frl = fr[lane];
        LAS float* wl = (LAS float*)(lds + 40960);
        for (int i = tid; i < 528 + 2048; i += NTHR) { const f32x4 v = (i < 528) ? *((const f32x4*)w1 + i) : *((const f32x4*)wi + (i - 528)); *(LAS f32x4*)(wl + 4 * i) = v; }
        __syncthreads();
#ifndef PROBE_PWF
#define PROBE_PWF 0
#endif
#ifndef PROBE_PWT
#define PROBE_PWT 0
#endif
        _Pragma("unroll 1") for (int repf = 0; repf < 1 + PROBE_PWF; ++repf)
        for (int blk = blockIdx.x; blk < 256; blk += G) {
            int n = 8 * blk + wave + 1; if (n == 2048) n = 0;
            const float t = (float)n / 2047.0f;
            {
                float v = 0.f;
                if (lane == 0) v = t;
                else if (lane < 33) { const int k = (lane - 1) & 15; const float band = 1e-4f + (float)k * ((15.0f - 1e-4f) / 15.0f); const float ang = ((float)(2.0 * 3.14159265358979323846 / 2048.0) * (float)n) * band;
                       v = (lane <= 16) ? cosf(ang) : -sinf(ang); }
                hb[lane] = v;
            }
            float s = b1[lane];
#pragma unroll
            for (int e = 0; e < 33; ++e) s += hb[e] * wl[e * 64 + lane];
            float hcur = sinf(frl * s);
#pragma unroll 1
            for (int layer = 0; layer < 2; ++layer) {
                hb[lane] = hcur;
                float s2 = bi[layer * 64 + lane];
#pragma unroll
                for (int e = 0; e < 64; ++e) s2 += hb[e] * wl[2112 + layer * 4096 + e * 64 + lane];
                hcur = sinf(frl * s2);
            }
            LAS float* hT = (LAS float*)(lds + 2048);
            hT[lane * 8 + wave] = hcur;
            __syncthreads();
            float o[8][2];
#pragma unroll
            for (int p = 0; p < 8; ++p) { o[p][0] = 0.f; o[p][1] = 0.f; }
#pragma unroll 16
            for (int e0 = 0; e0 < 64; ++e0) {
                const int e = (e0 + 8 * ((blk >> 3) & 7)) & 63;
                const f32x4 ha = *(const LAS f32x4*)(hT + e * 8), hc = *(const LAS f32x4*)(hT + e * 8 + 4);
                const float w0 = wout[e * 1024 + 128 * wave + lane], w1v = wout[e * 1024 + 128 * wave + 64 + lane];
#pragma unroll
                for (int p = 0; p < 4; ++p) { o[p][0] += ha[p] * w0; o[p][1] += ha[p] * w1v; o[4 + p][0] += hc[p] * w0; o[4 + p][1] += hc[p] * w1v; }
            }
#pragma unroll
            for (int j = 0; j < 2; ++j) {
                const int col = 128 * wave + 64 * j + lane, c = col & 511;
                const float delta = fabsf(min_decay + (float)c * ((max_decay - min_decay) / 511.0f));
#pragma unroll
                for (int p = 0; p < 8; ++p) { int np = 8 * blk + p + 1; if (np == 2048) np = 0; const float tp = (float)np / 2047.0f; fbuf[p * 1024 + col] = o[p][j] * expf(-tp * delta); }
            }
            __syncthreads();
            if (blk != 255) {
                typedef unsigned u32x2v __attribute__((ext_vector_type(2)));
#pragma unroll
                for (int pp = 0; pp < 2; ++pp) {
                    const int p = tid + 512 * pp, c = p & 511, dir = p >> 9;
                    bf16* r0 = Rg + ((size_t)c * 2 + 0) * 4096; bf16* r1 = Rg + ((size_t)c * 2 + 1) * 4096;
                    unsigned e[8];
#pragma unroll
                    for (int j = 0; j < 8; ++j) e[j] = f2bf(fbuf[(dir ? j : 7 - j) * 1024 + dir * 512 + c]);
                    v4u w8; w8.x = e[0] | (e[1] << 16); w8.y = e[2] | (e[3] << 16); w8.z = e[4] | (e[5] << 16); w8.w = e[6] | (e[7] << 16);
                    if (dir == 0) {
                        const int xb0 = 2040 - 8 * blk;
                        *(v4u*)(r0 + xb0) = w8;
                        r1[xb0 - 1] = (bf16)e[0];
                        u32x2v m4; m4.x = e[1] | (e[2] << 16); m4.y = e[3] | (e[4] << 16); *(u32x2v*)(r1 + xb0) = m4;
                        *(unsigned*)(r1 + xb0 + 4) = e[5] | (e[6] << 16);
                        r1[xb0 + 6] = (bf16)e[7];
                    } else {
                        const int xa = 2049 + 8 * blk;
                        *(v4u*)(r1 + xa - 1) = w8;
                        r0[xa] = (bf16)e[0];
                        *(unsigned*)(r0 + xa + 1) = e[1] | (e[2] << 16);
                        u32x2v m4; m4.x = e[3] | (e[4] << 16); m4.y = e[5] | (e[6] << 16); *(u32x2v*)(r0 + xa + 3) = m4;
                        r0[xa + 7] = (bf16)e[7];
                    }
                }
            } else
#pragma unroll
            for (int pp = 0; pp < 2; ++pp) {
                const int p = tid + 512 * pp, c = p & 511, dir = p >> 9;
                bf16* r0 = Rg + ((size_t)c * 2 + 0) * 4096; bf16* r1 = Rg + ((size_t)c * 2 + 1) * 4096;
#pragma unroll
                for (int wv = 0; wv < 8; ++wv) {
                    int nn = 8 * blk + wv + 1; float val = fbuf[wv * 1024 + dir * 512 + c]; int x;
                    if (nn == 2048) { if (dir != 0) continue; val += skip[c]; x = 2048; }
                    else x = dir ? 2048 + nn : 2048 - nn;
                    const bf16 hv = (bf16)f2bf(val); r0[x] = hv; r1[x - 1] = hv;
                }
            }
            __syncthreads();
        }
    }
    {
        LAS float* scr = (LAS float*)(lds + 40960 + wave * 8704);
        const int gw = blockIdx.x * NWAVES + wave, NGW = G * NWAVES;
        bf16* Wb = (bf16*)(ws + WS_W);
        const float* w_in = a.in[2] + (size_t)L * DM * NIN; const float* p_hy = a.in[12] + (size_t)L * 512 * DM; const float* p_att = a.in[13] + (size_t)L * 512 * DM;
        const float* w_o = a.in[14] + (size_t)L * DM * DM; const float* w1 = a.in[16] + (size_t)L * DM * DFF; const float* w2 = a.in[17] + (size_t)L * DFF * DM;
        const float* g_mix = a.in[1] + L * DM; const float* g_ffn = a.in[15] + L * DM;
        constexpr int I_IN = 16 * 256, I_P = 8 * 32, I_O = 16 * 32, I_1 = 16 * 128, I_2 = 64 * 32;
        constexpr int NITEMS = I_IN + 2 * I_P + I_O + I_1 + I_2;
        _Pragma("unroll 1") for (int rept = 0; rept < 1 + PROBE_PWT; ++rept)
        for (int it = gw; it < NITEMS; it += NGW) {
            int r = it;
            if (r < I_IN) { const int kb = r / 256, nb = r % 256; transpose_item(w_in, DM, NIN, win_src_col(nb * 32), Wb + W_IN / 2, nb * 32, kb * 64, g_mix, scr, lane); continue; } r -= I_IN;
            if (r < I_P) { const int kb = r / 32, nb = r % 32; transpose_item(p_hy, 512, DM, nb * 32, Wb + W_PHY / 2, nb * 32, kb * 64, nullptr, scr, lane); continue; } r -= I_P;
            if (r < I_P) { const int kb = r / 32, nb = r % 32; transpose_item(p_att, 512, DM, nb * 32, Wb + W_PATT / 2, nb * 32, kb * 64, nullptr, scr, lane); continue; } r -= I_P;
            if (r < I_O) { const int kb = r / 32, nb = r % 32; transpose_item(w_o, DM, DM, nb * 32, Wb + W_O / 2, nb * 32, kb * 64, nullptr, scr, lane); continue; } r -= I_O;
            if (r < I_1) { const int kb = r / 128, nb = r % 128; transpose_item(w1, DM, DFF, nb * 32, Wb + W_FF1 / 2, nb * 32, kb * 64, g_ffn, scr, lane); continue; } r -= I_1;
            { const int kb = r / 32, nb = r % 32; transpose_item(w2, DFF, DM, nb * 32, Wb + W_FF2 / 2, nb * 32, kb * 64, nullptr, scr, lane); }
        }
        if (L == 0) {
            const float* x = a.in[0]; bf16* xb = (bf16*)(ws + WS_XB); float* ssq = (float*)(ws + WS_SSQA);
            for (int m0 = gw; m0 < MTOK; m0 += 4 * NGW) {
                f32x4 v[4][4];
#pragma unroll
                for (int rr = 0; rr < 4; ++rr) { const f32x4* xr = (const f32x4*)(x + (size_t)(m0 + rr * NGW) * DM) + lane;
#pragma unroll
                    for (int j = 0; j < 4; ++j) v[rr][j] = xr[64 * j]; }
#pragma unroll
                for (int rr = 0; rr < 4; ++rr) { const int m = m0 + rr * NGW; float s = 0.f;
#pragma unroll
                    for (int j = 0; j < 4; ++j) s += (v[rr][j][0] * v[rr][j][0] + v[rr][j][1] * v[rr][j][1]) + (v[rr][j][2] * v[rr][j][2] + v[rr][j][3] * v[rr][j][3]);
                    s = wave_sum(s);
                    unsigned long long* o8 = (unsigned long long*)(xb + (size_t)m * DM) + lane;
#pragma unroll
                    for (int j = 0; j < 4; ++j) o8[64 * j] = (unsigned long long)pk2(v[rr][j][0], v[rr][j][1]) | ((unsigned long long)pk2(v[rr][j][2], v[rr][j][3]) << 32);
                    if (lane < 16) ssq[(size_t)m * 16 + lane] = (lane == 0) ? s : 0.f; }
            }
        }
    }
}

__device__ __forceinline__ float bfe(const v4u& w, int e) { const unsigned d = (e >> 1) == 0 ? w.x : ((e >> 1) == 1 ? w.y : ((e >> 1) == 2 ? w.z : w.w)); return (e & 1) ? __uint_as_float(d & 0xffff0000u) : __uint_as_float(d << 16); }
__device__ __forceinline__ void phase_prep_u(const Args& a, int L, LAS unsigned char* lds, int tid, int G) {
    const bf16* hy = (const bf16*)(a.ws + WS_HY); bf16* ut = (bf16*)(a.ws + WS_UT); bf16* x0t = (bf16*)(a.ws + WS_X0T);
    const float* cw = a.in[3] + (size_t)L * 3 * 1536; const float* cb = a.in[4] + L * 1536;
    LAS unsigned short* tile = (LAS unsigned short*)lds;
    const int cc = blockIdx.x & 7, ml = tid >> 3, cg8 = tid & 7, c0 = cc * 64 + cg8 * 8;
    float wq[3][4][8];
#pragma unroll
    for (int ar = 0; ar < 3; ++ar)
#pragma unroll
        for (int e = 0; e < 8; ++e) { wq[ar][0][e] = cw[ar * 512 + c0 + e]; wq[ar][1][e] = cw[1536 + ar * 512 + c0 + e]; wq[ar][2][e] = cw[3072 + ar * 512 + c0 + e]; wq[ar][3][e] = cb[ar * 512 + c0 + e]; }
    v4u dn[3][3];
    const v4u zero = (v4u){0u, 0u, 0u, 0u};
#define PU_LOAD(it_) do { const int m_ = ((it_) & 31) * 64 + ml; const bf16* r_ = hy + (size_t)(((it_) >> 5) * SEQ + m_) * 1536 + c0; \
        _Pragma("unroll") for (int ar_ = 0; ar_ < 3; ++ar_) { dn[ar_][0] = (m_ > 0) ? *(const v4u*)(r_ - 1536 + ar_ * 512) : zero; dn[ar_][1] = *(const v4u*)(r_ + ar_ * 512); \
            dn[ar_][2] = (m_ < SEQ - 1) ? *(const v4u*)(r_ + 1536 + ar_ * 512) : zero; } } while (0)
    if ((int)(blockIdx.x >> 3) < 512) PU_LOAD((int)(blockIdx.x >> 3));
    for (int it = blockIdx.x >> 3; it < 512; it += (G >> 3)) {
        const int mc = it & 31, b = it >> 5;
        v4u d[3][3];
#pragma unroll
        for (int ar = 0; ar < 3; ++ar) { d[ar][0] = dn[ar][0]; d[ar][1] = dn[ar][1]; d[ar][2] = dn[ar][2]; }
        if (it + (G >> 3) < 512) PU_LOAD(it + (G >> 3));
#pragma unroll
        for (int e = 0; e < 8; ++e) {
            float cv[3];
#pragma unroll
            for (int ar = 0; ar < 3; ++ar) cv[ar] = wq[ar][3][e] + wq[ar][0][e] * bfe(d[ar][0], e) + wq[ar][1][e] * bfe(d[ar][1], e) + wq[ar][2][e] * bfe(d[ar][2], e);
            tile[(cg8 * 8 + e) * 72 + ml] = (unsigned short)f2bf(cv[1] * cv[2]);
            tile[4608 + (cg8 * 8 + e) * 72 + ml] = (unsigned short)f2bf(cv[0]);
        }
        __syncthreads();
        {
            const int c2 = tid >> 3, ch = tid & 7;
            const LAS unsigned* s = (const LAS unsigned*)(tile + c2 * 72 + ch * 8);
            v4u o; o.x = s[0]; o.y = s[1]; o.z = s[2]; o.w = s[3];
            *(v4u*)(ut + ((size_t)(cc * 64 + c2) * NBATCH + b) * SEQ + mc * 64 + ch * 8) = o;
            const LAS unsigned* s2 = s + 2304;
            v4u o2; o2.x = s2[0]; o2.y = s2[1]; o2.z = s2[2]; o2.w = s2[3];
            *(v4u*)(x0t + ((size_t)(cc * 64 + c2) * NBATCH + b) * SEQ + mc * 64 + ch * 8) = o2;
        }
        __syncthreads();
    }
}

__device__ __forceinline__ void phase_hyena_naive(const Args& a, int L, LAS unsigned char* lds, int tid, int G) {
    const bf16* hy = (const bf16*)(a.ws + WS_HY); const bf16* ut = (const bf16*)(a.ws + WS_UT); const float* Gf = (const float*)(a.ws + WS_GF);
    bf16* yhy = (bf16*)(a.ws + WS_YHY);
    const float* cw = a.in[3] + (size_t)L * 3 * 1536; const float* cb = a.in[4] + L * 1536;
    LAS float* Gs = (LAS float*)lds;
    LAS float* Us = Gs + 4096;
    for (int item = blockIdx.x; item < 2048; item += G) {
        const int c = item >> 2, bq = item & 3;
        for (int i = tid; i < 4096; i += NTHR) Gs[i] = (i == 0) ? 0.f : Gf[(size_t)c * 4096 + i];
        for (int i = tid; i < 8192; i += NTHR) { const int bl = i >> 11, m = i & 2047; Us[i] = bf2f(ut[((size_t)c * NBATCH + bq * 4 + bl) * SEQ + m]); }
        __syncthreads();
        const int bl = tid >> 7, tn = tid & 127;
        float acc[16];
#pragma unroll
        for (int i = 0; i < 16; ++i) acc[i] = 0.f;
        const LAS float* up = Us + bl * 2048;
        for (int m = 0; m < SEQ; ++m) {
            const float u = up[m];
            const LAS float* gp = Gs + (tn - m + 2048);
#pragma unroll
            for (int i = 0; i < 16; ++i) acc[i] += gp[128 * i] * u;
        }
        const int b = bq * 4 + bl;
        const float w0 = cw[c], w1 = cw[1536 + c], w2 = cw[3072 + c], b0 = cb[c];
#pragma unroll
        for (int i = 0; i < 16; ++i) {
            const int n = tn + 128 * i;
            const bf16* r = hy + (size_t)(b * SEQ + n) * 1536 + c;
            const float xm = (n > 0) ? bf2f(r[-1536]) : 0.f, xc = bf2f(r[0]), xp = (n < SEQ - 1) ? bf2f(r[1536]) : 0.f;
            const float x0 = b0 + w0 * xm + w1 * xc + w2 * xp;
            yhy[(size_t)(b * SEQ + n) * 512 + c] = (bf16)f2bf(x0 * acc[i]);
        }
        __syncthreads();
    }
}

__device__ __forceinline__ void phase_attn_naive(const Args& a, int half, int tid, int G) {
    bf16* Q = (bf16*)(a.ws + WS_Q); const bf16* KV = (const bf16*)(a.ws + WS_KV); float* lse = (float*)(a.ws + WS_LSE);
    for (int idx = blockIdx.x * NTHR + tid; idx < 3 * 8 * HALF_TOK; idx += G * NTHR) {
        const int g = idx / (8 * HALF_TOK), t = idx % (8 * HALF_TOK), h = t / HALF_TOK, tokl = t % HALF_TOK;
        const int dil = (g == 0) ? 1 : (g == 1 ? 4 : 16);
        const int token = half * HALF_TOK + tokl, s = token & 2047;
        bf16* qp = Q + (size_t)token * 1536 + g * 512 + h * 64;
        float q[64], o[64];
#pragma unroll
        for (int i = 0; i < 8; ++i) { const v4u w = *(const v4u*)(qp + 8 * i);
            q[8 * i + 0] = __uint_as_float(w.x << 16); q[8 * i + 1] = __uint_as_float(w.x & 0xffff0000u); q[8 * i + 2] = __uint_as_float(w.y << 16); q[8 * i + 3] = __uint_as_float(w.y & 0xffff0000u);
            q[8 * i + 4] = __uint_as_float(w.z << 16); q[8 * i + 5] = __uint_as_float(w.z & 0xffff0000u); q[8 * i + 6] = __uint_as_float(w.w << 16); q[8 * i + 7] = __uint_as_float(w.w & 0xffff0000u); }
#pragma unroll
        for (int i = 0; i < 64; ++i) o[i] = 0.f;
        float mx = -1e30f, l = 0.f;
        for (int j = -64; j <= 64; ++j) {
            const int sp = s + j * dil;
            if (sp < 0 || sp >= SEQ) continue;
            const bf16* kp = KV + (size_t)(tokl + j * dil) * 3072 + g * 1024 + h * 64;
            float sc = 0.f;
#pragma unroll
            for (int i = 0; i < 8; ++i) { const v4u w = *(const v4u*)(kp + 8 * i);
                sc += q[8 * i + 0] * __uint_as_float(w.x << 16) + q[8 * i + 1] * __uint_as_float(w.x & 0xffff0000u) + q[8 * i + 2] * __uint_as_float(w.y << 16) + q[8 * i + 3] * __uint_as_float(w.y & 0xffff0000u)
                    + q[8 * i + 4] * __uint_as_float(w.z << 16) + q[8 * i + 5] * __uint_as_float(w.z & 0xffff0000u) + q[8 * i + 6] * __uint_as_float(w.w << 16) + q[8 * i + 7] * __uint_as_float(w.w & 0xffff0000u); }
            const float mn = fmaxf(mx, sc), corr = exp2f(mx - mn), p = exp2f(sc - mn);
            l = l * corr + p; mx = mn;
            const bf16* vp = kp + 512;
#pragma unroll
            for (int i = 0; i < 8; ++i) { const v4u w = *(const v4u*)(vp + 8 * i);
                o[8 * i + 0] = o[8 * i + 0] * corr + p * __uint_as_float(w.x << 16); o[8 * i + 1] = o[8 * i + 1] * corr + p * __uint_as_float(w.x & 0xffff0000u);
                o[8 * i + 2] = o[8 * i + 2] * corr + p * __uint_as_float(w.y << 16); o[8 * i + 3] = o[8 * i + 3] * corr + p * __uint_as_float(w.y & 0xffff0000u);
                o[8 * i + 4] = o[8 * i + 4] * corr + p * __uint_as_float(w.z << 16); o[8 * i + 5] = o[8 * i + 5] * corr + p * __uint_as_float(w.z & 0xffff0000u);
                o[8 * i + 6] = o[8 * i + 6] * corr + p * __uint_as_float(w.w << 16); o[8 * i + 7] = o[8 * i + 7] * corr + p * __uint_as_float(w.w & 0xffff0000u); }
        }
        const float inv = 1.0f / l;
#pragma unroll
        for (int i = 0; i < 8; ++i) { v4u w; w.x = pk2(o[8 * i] * inv, o[8 * i + 1] * inv); w.y = pk2(o[8 * i + 2] * inv, o[8 * i + 3] * inv); w.z = pk2(o[8 * i + 4] * inv, o[8 * i + 5] * inv); w.w = pk2(o[8 * i + 6] * inv, o[8 * i + 7] * inv);
            *(v4u*)(qp + 8 * i) = w; }
        lse[((size_t)g * MTOK + token) * 8 + h] = mx + log2f(l);
    }
}

__device__ __forceinline__ void phase_combine(const Args& a, int tid, int G) {
    const bf16* Q = (const bf16*)(a.ws + WS_Q); const float* lse = (const float*)(a.ws + WS_LSE); bf16* ya = (bf16*)(a.ws + WS_YATT);
    const int stride = G * NTHR;
    for (int idx0 = blockIdx.x * NTHR + tid; idx0 < MTOK * 64; idx0 += 4 * stride) {
        float l0[4], l1[4], l2[4]; v4u a0[4], a1[4], a2[4];
#pragma unroll
        for (int j = 0; j < 4; ++j) { int idx = idx0 + j * stride; if (idx >= MTOK * 64) idx = idx0; const int token = idx >> 6, ch = idx & 63, h = ch >> 3;
            l0[j] = lse[((size_t)0 * MTOK + token) * 8 + h]; l1[j] = lse[((size_t)1 * MTOK + token) * 8 + h]; l2[j] = lse[((size_t)2 * MTOK + token) * 8 + h];
            const bf16* p = Q + (size_t)token * 1536 + ch * 8;
            a0[j] = *(const v4u*)p; a1[j] = *(const v4u*)(p + 512); a2[j] = *(const v4u*)(p + 1024); }
#pragma unroll
        for (int j = 0; j < 4; ++j) { const int idx = idx0 + j * stride; if (idx >= MTOK * 64) continue; const int token = idx >> 6, ch = idx & 63;
            const float mx = fmaxf(l0[j], fmaxf(l1[j], l2[j]));
            float w0 = exp2f(l0[j] - mx), w1 = exp2f(l1[j] - mx), w2 = exp2f(l2[j] - mx);
            const float inv = 1.0f / (w0 + w1 + w2); w0 *= inv; w1 *= inv; w2 *= inv;
            v4u o;
#define CMB(f) pk2(w0 * __uint_as_float(a0[j].f << 16) + w1 * __uint_as_float(a1[j].f << 16) + w2 * __uint_as_float(a2[j].f << 16), \
                   w0 * __uint_as_float(a0[j].f & 0xffff0000u) + w1 * __uint_as_float(a1[j].f & 0xffff0000u) + w2 * __uint_as_float(a2[j].f & 0xffff0000u))
            o.x = CMB(x); o.y = CMB(y); o.z = CMB(z); o.w = CMB(w);
#undef CMB
            *(v4u*)(ya + (size_t)token * 512 + ch * 8) = o; }
    }
}

__device__ __forceinline__ void phase_final_norm(const Args& a, int lane, int wave, int G) {
    float* out = a.out; const float* gain = a.in[18]; const bf16* xb = (const bf16*)(a.ws + WS_XB);
    const int gw = blockIdx.x * NWAVES + wave, NGW = G * NWAVES;
    typedef unsigned u32x2v __attribute__((ext_vector_type(2)));
    f32x4 gn[4];
#pragma unroll
    for (int j = 0; j < 4; ++j) gn[j] = *((const f32x4*)gain + lane + 64 * j);
    for (int m0 = gw; m0 < MTOK; m0 += 4 * NGW) {
        u32x2v w[4][4];
#pragma unroll
        for (int rr = 0; rr < 4; ++rr) { const int m = (m0 + rr * NGW < MTOK) ? m0 + rr * NGW : m0; const u32x2v* xr = (const u32x2v*)(xb + (size_t)m * DM) + lane;
#pragma unroll
            for (int j = 0; j < 4; ++j) w[rr][j] = xr[64 * j]; }
#pragma unroll
        for (int rr = 0; rr < 4; ++rr) { const int m = m0 + rr * NGW; if (m >= MTOK) continue;
            f32x4 v[4]; float s = 0.f;
#pragma unroll
            for (int j = 0; j < 4; ++j) { v[j] = (f32x4){__uint_as_float(w[rr][j].x << 16), __uint_as_float(w[rr][j].x & 0xffff0000u), __uint_as_float(w[rr][j].y << 16), __uint_as_float(w[rr][j].y & 0xffff0000u)};
                s += (v[j][0] * v[j][0] + v[j][1] * v[j][1]) + (v[j][2] * v[j][2] + v[j][3] * v[j][3]); }
            s = wave_sum(s);
            const float rs = 1.0f / sqrtf(s * (1.0f / 1024.0f) + 1e-6f);
            f32x4* orow = (f32x4*)(out + (size_t)m * DM) + lane;
#pragma unroll
            for (int j = 0; j < 4; ++j) orow[64 * j] = v[j] * rs * gn[j]; }
    }
}

typedef short bf16x8 __attribute__((ext_vector_type(8)));
typedef short s16x4 __attribute__((ext_vector_type(4)));
constexpr int HY_UROW = 4112, HY_ROFF = 16 * HY_UROW, HY_RSTRIDE = 8192 + 64;
__device__ __forceinline__ bf16x8 ld_frag4(const LAS unsigned char* p) {
    const LAS unsigned* q = (const LAS unsigned*)p; v4u d; d.x = q[0]; d.y = q[1]; d.z = q[2]; d.w = q[3]; return __builtin_bit_cast(bf16x8, d);
}
__device__ __forceinline__ void phase_hyena_mfma(const Args& a, LAS unsigned char* lds, int tid, int G, bool dummy = false) {
    const bf16* ut = (const bf16*)(a.ws + WS_UT); const bf16* Rg = (const bf16*)(a.ws + WS_GF); bf16* x0t = (bf16*)(a.ws + WS_X0T);
    const int lane = tid & 63, w = __builtin_amdgcn_readfirstlane(tid >> 6), i16 = lane & 15, kq = lane >> 4;
    const int base = (w >> 1) * 512 + (w & 1) * 16, cp = i16 & 1;
    const int lane_const = (2048 - base - i16 + 8 * kq - cp) >> 1;
    const LAS unsigned char* pA15 = lds + HY_ROFF + cp * HY_RSTRIDE + 4 * (lane_const - 240);
    const LAS unsigned char* pB = lds + i16 * HY_UROW + kq * 16;
    v4u pre[10];
#define HY_ISSUE(chn) do { _Pragma("unroll") for (int k_ = 0; k_ < 8; ++k_) { const int i_ = tid + NTHR * k_, b_ = i_ >> 8, ck_ = i_ & 255; pre[k_] = *(const v4u*)(ut + ((size_t)(chn) * NBATCH + b_) * SEQ + ck_ * 8); } \
        _Pragma("unroll") for (int k_ = 0; k_ < 2; ++k_) { const int i_ = tid + NTHR * k_, c2_ = i_ >> 9, ck_ = i_ & 511; pre[8 + k_] = *(const v4u*)(Rg + ((size_t)(chn) * 2 + c2_) * 4096 + ck_ * 8); } } while (0)
    for (int ch = blockIdx.x; ch < HYW; ch += G) {
        HY_ISSUE(ch);
#pragma unroll
        for (int k = 0; k < 8; ++k) { const int i = tid + NTHR * k, b = i >> 8, ck = i & 255; *(LAS v4u*)(lds + b * HY_UROW + ck * 16) = pre[k]; }
#pragma unroll
        for (int k = 0; k < 2; ++k) { const int i = tid + NTHR * k, c2 = i >> 9, ck = i & 511; *(LAS v4u*)(lds + HY_ROFF + c2 * HY_RSTRIDE + ck * 16) = pre[8 + k]; }
        __syncthreads();
        f32x4 acc[16]; bf16x8 W[16];
#pragma unroll
        for (int i = 0; i < 16; ++i) acc[i] = (f32x4){0.f, 0.f, 0.f, 0.f};
#pragma unroll
        for (int j = 1; j < 16; ++j) W[j] = ld_frag4(pA15 + 64 * (15 - j));
        W[0] = W[1];
#pragma unroll 1
        for (int tt = 0; tt < 4; ++tt) {
            const LAS unsigned char* pa = pA15 + 64 * 15 + 1024 * tt; const LAS unsigned char* pb = pB + 1024 * tt;
#pragma unroll
            for (int s = 0; s < 16; ++s) {
                W[(16 - s) & 15] = ld_frag4(pa + 64 * s);
                const bf16x8 Bf = *(const LAS bf16x8*)(pb + 64 * s);
                __builtin_amdgcn_s_setprio(1);
#pragma unroll
                for (int i = 0; i < 16; ++i) acc[i] = __builtin_amdgcn_mfma_f32_16x16x32_bf16(W[(i - s) & 15], Bf, acc[i], 0, 0, 0);
                __builtin_amdgcn_s_setprio(0);
            }
        }
        bf16* xo = x0t + ((size_t)ch * NBATCH + i16) * SEQ + base + 4 * kq;
        typedef unsigned u32x2v __attribute__((ext_vector_type(2)));
        u32x2v xall[16];
#pragma unroll
        for (int i = 0; i < 16; ++i) xall[i] = *(const u32x2v*)(xo + 32 * i);
#pragma unroll
        for (int i = 0; i < 16; ++i) {
            const u32x2v xv = xall[i];
            u32x2v o; o.x = pk2(__uint_as_float(xv.x << 16) * acc[i][0], __uint_as_float(xv.x & 0xffff0000u) * acc[i][1]);
            o.y = pk2(__uint_as_float(xv.y << 16) * acc[i][2], __uint_as_float(xv.y & 0xffff0000u) * acc[i][3]);
            if (!dummy) *(u32x2v*)(xo + 32 * i) = o; else *(u32x2v*)((bf16*)(a.ws + WS_YHY) + (size_t)tid * 64 + 4 * i) = o;
        }
        __syncthreads();
    }
}

__device__ __forceinline__ void phase_transpose_y(const Args& a, LAS unsigned char* lds, int tid, int G) {
    const bf16* yt = (const bf16*)(a.ws + WS_X0T); bf16* yhy = (bf16*)(a.ws + WS_YHY);
    LAS unsigned short* tile = (LAS unsigned short*)lds;
#define TY_LOAD(item_) (*(const v4u*)(yt + ((size_t)(((item_) & 7) * 64 + (tid >> 3)) * NBATCH + ((item_) >> 8)) * SEQ + (((item_) >> 3) & 31) * 64 + (tid & 7) * 8))
    v4u vnext = (v4u){0u, 0u, 0u, 0u};
    if ((int)blockIdx.x < 4096) vnext = TY_LOAD((int)blockIdx.x);
    for (int item = blockIdx.x; item < 4096; item += G) {
        const int cc = item & 7, mc = (item >> 3) & 31, b = item >> 8;
        { const int c2 = tid >> 3, ck = tid & 7;
          const v4u v = vnext;
          LAS unsigned* t4 = (LAS unsigned*)(tile + c2 * 72 + ck * 8); t4[0] = v.x; t4[1] = v.y; t4[2] = v.z; t4[3] = v.w; }
        __syncthreads();
        if (item + G < 4096) vnext = TY_LOAD(item + G);
        { const int nl = tid >> 3, cg8 = tid & 7; const LAS unsigned short* s = tile + (cg8 * 8) * 72 + nl;
          v4u o; o.x = s[0] | ((unsigned)s[72] << 16); o.y = s[144] | ((unsigned)s[216] << 16); o.z = s[288] | ((unsigned)s[360] << 16); o.w = s[432] | ((unsigned)s[504] << 16);
          *(v4u*)(yhy + (size_t)(b * SEQ + mc * 64 + nl) * 512 + cc * 64 + cg8 * 8) = o; }
        __syncthreads();
    }
}

constexpr int AT_ROWS = 272, AT_RS = 144, AT_VOFF = AT_ROWS * AT_RS;
__device__ __forceinline__ void phase_attn_mfma(const Args& a, int half, LAS unsigned char* lds, int tid, int G, bool dummy = false) {
    bf16* Q = (bf16*)(a.ws + WS_Q); const bf16* KV = (const bf16*)(a.ws + WS_KV); float* lse = (float*)(a.ws + WS_LSE);
    const int lane = tid & 63, w = __builtin_amdgcn_readfirstlane(tid >> 6), q16 = lane & 15, kq = lane >> 4;
    v4u pre[9]; bf16x8 Qn0, Qn1;
#define AT_DECODE(unit_) const int g = (unit_) >> 10, u = (unit_) & 1023, sub = u & 15, h = (u >> 4) & 7, bl = u >> 7; int dil, n, r, qb; \
        if (g == 0) { dil = 1; n = 2048; r = 0; qb = sub; } else if (g == 1) { dil = 4; n = 512; r = sub >> 2; qb = sub & 3; } else { dil = 16; n = 128; r = sub; qb = 0; } \
        const int q0 = qb * 128, kb0 = q0 - 64; (void)kb0; (void)q0;
#define AT_ISSUE(unit_, PRE_, QN0_, QN1_) do { AT_DECODE(unit_) { const bf16* qn_ = Q + (size_t)(half * HALF_TOK + bl * SEQ + (q0 + 16 * w + q16) * dil + r) * 1536 + g * 512 + h * 64; QN0_ = *(const bf16x8*)(qn_ + 8 * kq); QN1_ = *(const bf16x8*)(qn_ + 32 + 8 * kq); } \
        _Pragma("unroll") for (int k_ = 0; k_ < 9; ++k_) { const int i_ = tid + NTHR * k_; \
            const int which_ = (i_ >= AT_ROWS * 8) ? 1 : 0, j_ = i_ - which_ * AT_ROWS * 8, rr_ = j_ >> 3, ck_ = j_ & 7, key_ = kb0 + rr_; \
            PRE_[k_] = (v4u){0u, 0u, 0u, 0u}; \
            if (i_ < 2 * AT_ROWS * 8 && key_ >= 0 && key_ < n) PRE_[k_] = *(const v4u*)(KV + (size_t)(bl * SEQ + key_ * dil + r) * 3072 + g * 1024 + which_ * 512 + h * 64 + ck_ * 8); } } while (0)
    const int vb = ((G & 7) == 0) ? (int)((blockIdx.x & 7) * (G >> 3) + (blockIdx.x >> 3)) : (int)blockIdx.x;
#define AT_STEP(UNIT_, PRE_, QN0_, QN1_) do { \
_Pragma("unroll") \
        for (int k = 0; k < 9; ++k) { const int i = tid + NTHR * k; const int which = (i >= AT_ROWS * 8) ? 1 : 0, j = i - which * AT_ROWS * 8, rr = j >> 3, ck = j & 7; \
            if (i < 2 * AT_ROWS * 8) *(LAS v4u*)(lds + which * AT_VOFF + rr * AT_RS + ck * 16) = PRE_[k]; } \
        const bf16x8 Qf0 = QN0_, Qf1 = QN1_; \
        __syncthreads(); \
        if (UNIT_ + 2 * G < 3072) AT_ISSUE(UNIT_ + 2 * G, PRE_, QN0_, QN1_); \
        AT_DECODE(UNIT_) \
        { \
            const int i0 = q0 + 16 * w; \
            const int token = half * HALF_TOK + bl * SEQ + (i0 + q16) * dil + r; \
            bf16* qp = Q + (size_t)token * 1536 + g * 512 + h * 64; \
            bf16* op = dummy ? (bf16*)(a.ws + WS_YHY) + (size_t)(tid & 511) * 64 : qp; \
            f32x4 acc[4]; \
_Pragma("unroll") \
            for (int dt = 0; dt < 4; ++dt) acc[dt] = (f32x4){0.f, 0.f, 0.f, 0.f}; \
            const bool edge = (i0 < 64) || (i0 + 80 > n); \
            const LAS unsigned char* kbase = lds + (16 * w + q16) * AT_RS + 16 * kq; \
            const LAS unsigned char* vbase = lds + AT_VOFF + (16 * w + 4 * kq + (q16 >> 2)) * AT_RS + 8 * (q16 & 3); \
            f32x4 s[9]; \
_Pragma("unroll") \
            for (int kt = 0; kt < 9; ++kt) { \
                const LAS unsigned char* kp = kbase + kt * 16 * AT_RS; \
                const bf16x8 K0 = *(const LAS bf16x8*)kp, K1 = *(const LAS bf16x8*)(kp + 64); \
                f32x4 z = (f32x4){0.f, 0.f, 0.f, 0.f}; \
                __builtin_amdgcn_s_setprio(1); \
                z = __builtin_amdgcn_mfma_f32_16x16x32_bf16(K0, Qf0, z, 0, 0, 0); \
                z = __builtin_amdgcn_mfma_f32_16x16x32_bf16(K1, Qf1, z, 0, 0, 0); \
                __builtin_amdgcn_s_setprio(0); \
                if (kt == 0 || kt == 8 || edge) { \
_Pragma("unroll") \
                    for (int e = 0; e < 4; ++e) { \
                        const int rel = 16 * kt - 64 + 4 * kq + e - q16, j = i0 + q16 + rel; \
                        const bool ok = (rel >= -64) && (rel <= 64) && (j >= 0) && (j < n); \
                        z[e] = ok ? z[e] : -1e30f; \
                    } } \
                s[kt] = z; \
            } \
            float mrun = -1e30f; \
_Pragma("unroll") \
            for (int kt = 0; kt < 9; ++kt) mrun = fmaxf(mrun, fmaxf(fmaxf(s[kt][0], s[kt][1]), fmaxf(s[kt][2], s[kt][3]))); \
            mrun = fmaxf(mrun, __shfl_xor(mrun, 16)); mrun = fmaxf(mrun, __shfl_xor(mrun, 32)); \
            float lrun = 0.f; \
_Pragma("unroll") \
            for (int kt = 0; kt < 9; ++kt) \
_Pragma("unroll") \
                for (int e = 0; e < 4; ++e) { s[kt][e] = __builtin_amdgcn_exp2f(s[kt][e] - mrun); lrun += s[kt][e]; } \
_Pragma("unroll") \
            for (int st = 0; st < 5; ++st) { \
                v4u pw; pw.x = pg8::cvt_pk_bf16(s[2 * st][0], s[2 * st][1]); pw.y = pg8::cvt_pk_bf16(s[2 * st][2], s[2 * st][3]); \
                if (st < 4) { pw.z = pg8::cvt_pk_bf16(s[2 * st + 1][0], s[2 * st + 1][1]); pw.w = pg8::cvt_pk_bf16(s[2 * st + 1][2], s[2 * st + 1][3]); } else { pw.z = 0u; pw.w = 0u; } \
                const bf16x8 Pf = __builtin_bit_cast(bf16x8, pw); \
_Pragma("unroll") \
                for (int dt = 0; dt < 4; ++dt) { \
                    const LAS unsigned char* vp = vbase + 32 * st * AT_RS + 32 * dt; \
                    const s16x4 v0 = __builtin_amdgcn_ds_read_tr16_b64_v4i16((LAS s16x4*)vp); \
                    const s16x4 v1 = __builtin_amdgcn_ds_read_tr16_b64_v4i16((LAS s16x4*)(vp + 16 * AT_RS)); \
                    const bf16x8 Vf = (bf16x8){v0[0], v0[1], v0[2], v0[3], v1[0], v1[1], v1[2], v1[3]}; \
                    __builtin_amdgcn_s_setprio(1); \
                    acc[dt] = __builtin_amdgcn_mfma_f32_16x16x32_bf16(Vf, Pf, acc[dt], 0, 0, 0); \
                    __builtin_amdgcn_s_setprio(0); \
                } \
            } \
            lrun += __shfl_xor(lrun, 16); lrun += __shfl_xor(lrun, 32); \
            const float inv = 1.0f / lrun; \
            typedef unsigned u32x2v __attribute__((ext_vector_type(2))); \
_Pragma("unroll") \
            for (int dt = 0; dt < 4; ++dt) { \
                u32x2v o; o.x = pg8::cvt_pk_bf16(acc[dt][0] * inv, acc[dt][1] * inv); o.y = pg8::cvt_pk_bf16(acc[dt][2] * inv, acc[dt][3] * inv); \
                *(u32x2v*)(op + 16 * dt + 4 * kq) = o; \
            } \
            if (kq == 0 && !dummy) lse[((size_t)g * MTOK + token) * 8 + h] = mrun + log2f(lrun); \
        } \
        __syncthreads(); \
    } while (0)
    v4u preB[9]; bf16x8 QnB0, QnB1;
    if (vb < 3072) AT_ISSUE(vb, pre, Qn0, Qn1);
    if (vb + G < 3072) AT_ISSUE(vb + G, preB, QnB0, QnB1);
    for (int unit = vb; unit < 3072; unit += 2 * G) {
        AT_STEP(unit, pre, Qn0, Qn1);
        if (unit + G < 3072) AT_STEP(unit + G, preB, QnB0, QnB1);
    }
}

#define XB_TMO      128
#define XB_XCNT(j)  (256  + 64 * (j))
#define XB_XSUB(j)  (1280 + 64 * (j))
#define XB_XGEN(j)  (2304 + 64 * (j))
#define XB_TOP      3328
#define XB_TOPGEN   3392
#define XCD_BAR_WORDS 3456
#define XB_SPIN_CAP (1u << 18)

__device__ __forceinline__ unsigned xb_ld(unsigned* p)              { return __hip_atomic_load(p, __ATOMIC_RELAXED, __HIP_MEMORY_SCOPE_AGENT); }
__device__ __forceinline__ unsigned xb_add(unsigned* p, unsigned v) { return __hip_atomic_fetch_add(p, v, __ATOMIC_RELAXED, __HIP_MEMORY_SCOPE_AGENT); }
__device__ __forceinline__ unsigned xb_xcc_id() { return (unsigned)__builtin_amdgcn_s_getreg((3 << 11) | 20) & 0xFu; }
#define XB_SPIN(cond, bar) do { unsigned _sp = 0; while (cond) { __builtin_amdgcn_s_sleep(1); \
    if ((++_sp & 255u) == 0u) { if (xb_ld(&(bar)[XB_TMO])) break; if (_sp > XB_SPIN_CAP) { atomicAdd(&(bar)[XB_TMO], 1u); break; } } } } while (0)

struct XcdBarrier {
    unsigned* bar; unsigned x;
    volatile LAS unsigned* st;
};

__device__ __forceinline__ XcdBarrier xcd_barrier_post(unsigned* bar, volatile LAS unsigned* st, bool is_t0) {
    XcdBarrier b; b.bar = bar; b.x = xb_xcc_id(); b.st = st;
    if (is_t0) (void)xb_add(&bar[XB_XCNT(b.x)], 1u);
    return b;
}
__device__ __forceinline__ void xcd_barrier_complete(unsigned* bar, unsigned x, unsigned& nloc, unsigned& nx) {
    const unsigned G = gridDim.x * gridDim.y * gridDim.z;
    unsigned sum, cnt, mine, sp = 0u;
    for (;;) {
        sum = 0u; cnt = 0u; mine = 0u;
#pragma unroll
        for (unsigned j = 0; j < 16; ++j) { const unsigned c = xb_ld(&bar[XB_XCNT(j)]); sum += c; cnt += (c > 0u) ? 1u : 0u; mine = (j == x) ? c : mine; }
        if (sum == G) break;
        __builtin_amdgcn_s_sleep(1);
        if ((++sp & 255u) == 0u) { if (xb_ld(&bar[XB_TMO])) break; if (sp > XB_SPIN_CAP) { atomicAdd(&bar[XB_TMO], 1u); break; } }
    }
    nloc = mine > 0u ? mine : 1u; nx = cnt > 0u ? cnt : 1u;
}

__device__ __forceinline__ void xcd_barrier(const XcdBarrier& b, bool is_t0) {
    asm volatile("s_waitcnt vmcnt(0)" ::: "memory");
    __syncthreads();
    if (is_t0) {
        unsigned* bar = b.bar;
        __builtin_amdgcn_s_waitcnt(0);
        unsigned nloc = b.st[0], nx = b.st[1];
        if (nloc == 0u) { xcd_barrier_complete(bar, b.x, nloc, nx); b.st[0] = nloc; b.st[1] = nx; }
        const unsigned old = xb_add(&bar[XB_XSUB(b.x)], 1u);
        const unsigned gen = old / nloc;
        if (old + 1u == (gen + 1u) * nloc) {
            __builtin_amdgcn_fence(__ATOMIC_RELEASE, "agent");
            asm volatile("s_waitcnt vmcnt(0)" ::: "memory");
            const unsigned og = xb_add(&bar[XB_TOP], 1u);
            const unsigned tg = og / nx;
            if (og + 1u == (tg + 1u) * nx) xb_add(&bar[XB_TOPGEN], 1u);
            else XB_SPIN(xb_ld(&bar[XB_TOPGEN]) == tg, bar);
            __builtin_amdgcn_fence(__ATOMIC_ACQUIRE, "agent");
            xb_add(&bar[XB_XGEN(b.x)], 1u);
            asm volatile("s_waitcnt vmcnt(0)" ::: "memory");
        } else {
            XB_SPIN(xb_ld(&bar[XB_XGEN(b.x)]) == gen, bar);
            __builtin_amdgcn_fence(__ATOMIC_ACQUIRE, "agent");
            asm volatile("s_waitcnt vmcnt(0)" ::: "memory");
        }
    }
    __syncthreads();
}

__device__ __forceinline__ void stagger(int bx, unsigned ticks_per_class) {
    const unsigned q = ((unsigned)bx >> 3) & 3u;
    if (q) { const unsigned long long t0 = __builtin_amdgcn_s_memrealtime(), dt = (unsigned long long)q * ticks_per_class;
             while (__builtin_amdgcn_s_memrealtime() - t0 < dt) __builtin_amdgcn_s_sleep(8); }
}
#ifndef STAG_ON
#define STAG_ON 0
#endif
#ifndef STAG_LIGHT
#define STAG_LIGHT 300u
#endif
#ifndef STAG_HEAVY
#define STAG_HEAVY 1000u
#endif
#define GEMM_CALL(EPI, SCHED, g, S, E) do { if (STAG_ON) stagger(bx, EPI::PERM ? STAG_LIGHT : STAG_HEAVY); pg8::gemm_phase<EPI, SCHED, true, true>(lds, g, S, E, tid); } while (0)
#ifndef PROBE_G
#define PROBE_G 0
#endif
#ifndef PROBE_S
#define PROBE_S 0
#endif
#define GEMM_CALL_P(EPI, SCHED, g, S, E) do { _Pragma("unroll 1") for (int rep_ = 0; rep_ < 1 + PROBE_G; ++rep_) { GEMM_CALL(EPI, SCHED, g, S, E); } } while (0)
#ifndef PROBE_PW
#define PROBE_PW 0
#endif
#ifndef PROBE_PU
#define PROBE_PU 0
#endif
#ifndef PROBE_CT
#define PROBE_CT 0
#endif
#ifndef PROBE_AT
#define PROBE_AT 0
#endif
#ifndef PROBE_HY
#define PROBE_HY 0
#endif
#define REP_N(N_) _Pragma("unroll 1") for (int rep_ = 0; rep_ < 1 + (N_); ++rep_)

__device__ __forceinline__ int lane_id_volatile() { int l; asm volatile("v_mbcnt_lo_u32_b32 %0, -1, 0\n\tv_mbcnt_hi_u32_b32 %0, -1, %0" : "=v"(l)); return l; }
typedef const __attribute__((address_space(4))) Args* KArgs;
__device__ __forceinline__ Args load_args() {
#if defined(__HIP_DEVICE_COMPILE__)
    KArgs p = (KArgs)__builtin_amdgcn_kernarg_segment_ptr();
    asm volatile("" : "+s"(p));
    return *p;
#else
    return Args{};
#endif
}
__global__ void __launch_bounds__(NTHR, 2) fwd_megakernel(Args a_unused) {
    extern __shared__ __attribute__((aligned(16))) unsigned char lds_raw[];
    LAS unsigned char* lds = (LAS unsigned char*)lds_raw;
    cg::grid_group grid = cg::this_grid();
    const int wave0 = __builtin_amdgcn_readfirstlane((int)threadIdx.x >> 6);
    const int G0 = gridDim.x, bx0 = blockIdx.x;
#define TID0() (wave0 * 64 + lane_id_volatile())
    { const int t0_ = TID0(); if (t0_ < 2) ((LAS unsigned*)(lds + LDS_ST_OFF))[t0_] = 0u; }
    __syncthreads();
    { const Args a0 = load_args(); (void)xcd_barrier_post((unsigned*)(a0.ws + WS_BAR), (volatile LAS unsigned*)(lds + LDS_ST_OFF), TID0() == 0); }
#define GSYNC() do { const Args ab = load_args(); XcdBarrier xb_; xb_.bar = (unsigned*)(ab.ws + WS_BAR); xb_.x = xb_xcc_id(); xb_.st = (volatile LAS unsigned*)(lds + LDS_ST_OFF); xcd_barrier(xb_, TID0() == 0); } while (0)
#define PTRS() const Args a = load_args(); int tid = TID0(), G = G0, bx = bx0; asm volatile("" : "+v"(tid), "+s"(G), "+s"(bx)); const int lane = tid & 63, wave = __builtin_amdgcn_readfirstlane(tid >> 6); (void)lane; (void)wave; unsigned char* ws = a.ws; bf16* Wb = (bf16*)(ws + WS_W); const pg8::bf16_t* xb = (const pg8::bf16_t*)(ws + WS_XB); \
    const float* rcos = (const float*)(ws + WS_ROPE); const float* rsin = rcos + 65536; float* ssqA = (float*)(ws + WS_SSQA); float* ssqB = (float*)(ws + WS_SSQB); \
    (void)Wb; (void)xb; (void)rcos; (void)rsin; (void)ssqA; (void)ssqB;
#define GIN() pg8::Gemm gin{xb, (const pg8::bf16_t*)(Wb + W_IN / 2), nullptr, nullptr, MTOK, NIN, DM}; \
    pg8::EpiIn Ein{(pg8::bf16_t*)(ws + WS_HY), (pg8::bf16_t*)(ws + WS_Q), (pg8::bf16_t*)(ws + WS_KV), (pg8::bf16_t*)(ws + WS_GATES), (const LAS float*)(lds + LDS_RTAB), 0};
#define FILL_RTAB(S_, ssq_, E_) pg8::fill_rstd_table(S_, ssq_, (LAS float*)(lds + LDS_RTAB), tid)

#pragma unroll 1
    for (int L = 0; L < 2; ++L) {
        REP_N(PROBE_PW) { PTRS(); phase_prep_weights(a, L, lds, tid, lane, wave, G); }
        if (L == 0) grid.sync(); else GSYNC();
        {
            PTRS(); GIN();
            pg8::TwoRect S; S.a.init(128, 12, 0, 0, G, bx); S.b.init(64, 12, 0, 12, G, bx); S.na = S.a.count();
            FILL_RTAB(S, ssqA, Ein);
            GEMM_CALL_P(pg8::EpiIn, pg8::TwoRect, gin, S, Ein);
        }
        GSYNC();
        REP_N(PROBE_AT) { PTRS(); phase_attn_mfma(a, 0, lds, tid, G, rep_ < PROBE_AT); } { PTRS(); REP_N(PROBE_PU) { phase_prep_u(a, L, lds, tid, G); } }
        GSYNC();
        {
            PTRS(); GIN();
            pg8::RectOrder S; S.init(64, 12, 64, 12, G, bx);
            Ein.kv_row0 = HALF_TOK;
            FILL_RTAB(S, ssqA, Ein);
            GEMM_CALL_P(pg8::EpiIn, pg8::RectOrder, gin, S, Ein);
        }
        REP_N(PROBE_HY) { PTRS(); phase_hyena_mfma(a, lds, tid, G, rep_ < PROBE_HY); }
        GSYNC();
        REP_N(PROBE_AT) { PTRS(); phase_attn_mfma(a, 1, lds, tid, G, rep_ < PROBE_AT); }
        {
            PTRS(); GIN();
            pg8::RectOrder S; S.init(128, 8, 0, 24, G, bx);
            FILL_RTAB(S, ssqA, Ein);
            GEMM_CALL_P(pg8::EpiIn, pg8::RectOrder, gin, S, Ein);
        }
        GSYNC();
        REP_N(PROBE_CT) { PTRS(); phase_combine(a, tid, G); phase_transpose_y(a, lds, tid, G); }
        GSYNC();
        {
            PTRS();
            pg8::Gemm g{(const pg8::bf16_t*)(ws + WS_YHY), (const pg8::bf16_t*)(Wb + W_PHY / 2), (const pg8::bf16_t*)(ws + WS_YATT), (const pg8::bf16_t*)(Wb + W_PATT / 2), MTOK, DM, 512};
            pg8::PairOrder S; S.r.init(128, 4, 0, 0, G, bx);
            pg8::EpiGate E{(const pg8::bf16_t*)(ws + WS_GATES), (pg8::bf16_t*)(ws + WS_MERGED)};
            GEMM_CALL_P(pg8::EpiGate, pg8::PairOrder, g, S, E);
        }
        GSYNC();
        {
            PTRS();
            pg8::Gemm g{(const pg8::bf16_t*)(ws + WS_MERGED), (const pg8::bf16_t*)(Wb + W_O / 2), nullptr, nullptr, MTOK, DM, DM};
            pg8::RectOrder S; S.init(128, 4, 0, 0, G, bx);
            pg8::EpiRes E{L == 0 ? a.in[0] : nullptr, (pg8::bf16_t*)(ws + WS_XB), ssqB};
            GEMM_CALL(pg8::EpiRes, pg8::RectOrder, g, S, E);
        }
        GSYNC();
        {
            PTRS();
            pg8::Gemm g{xb, (const pg8::bf16_t*)(Wb + W_FF1 / 2), nullptr, nullptr, MTOK, DFF, DM};
            pg8::RectOrder S; S.init(128, 16, 0, 0, G, bx);
            pg8::EpiFF1 E{(pg8::bf16_t*)(ws + WS_H), (const LAS float*)(lds + LDS_RTAB)};
            FILL_RTAB(S, ssqB, E);
            GEMM_CALL_P(pg8::EpiFF1, pg8::RectOrder, g, S, E);
        }
        GSYNC();
        {
            PTRS();
            pg8::Gemm g{(const pg8::bf16_t*)(ws + WS_H), (const pg8::bf16_t*)(Wb + W_FF2 / 2), nullptr, nullptr, MTOK, DM, DFF};
            pg8::RectOrder S; S.init(128, 4, 0, 0, G, bx);
            pg8::EpiRes E{nullptr, (pg8::bf16_t*)(ws + WS_XB), ssqA};
            GEMM_CALL(pg8::EpiRes, pg8::RectOrder, g, S, E);
        }
        GSYNC();
    }
    { PTRS(); phase_final_norm(a, lane, wave, G); }
}

extern "C" void kernel_launch(void* const* d_in, const int* in_sizes, int n_in, void* d_out, int out_size, void* d_ws, size_t ws_size, hipStream_t stream) {
    static int grid = 0;
    if (grid == 0) {
        if (n_in != 19 || in_sizes[0] != MTOK * DM || out_size != MTOK * DM || ws_size < WS_END) {
            fprintf(stderr, "kernel_launch: unexpected shapes / workspace (n_in %d, ws %zu, need %zu); nothing launched\n", n_in, ws_size, (size_t)WS_END); grid = -1; return; }
        int dev = 0, cus = 0, per_cu = 0;
        (void)hipGetDevice(&dev); (void)hipDeviceGetAttribute(&cus, hipDeviceAttributeMultiprocessorCount, dev);
        if (hipFuncSetAttribute((const void*)fwd_megakernel, hipFuncAttributeMaxDynamicSharedMemorySize, LDS_BYTES) != hipSuccess) { fprintf(stderr, "kernel_launch: hipFuncSetAttribute failed\n"); grid = -1; return; }
        if (hipOccupancyMaxActiveBlocksPerMultiprocessor(&per_cu, (const void*)fwd_megakernel, NTHR, LDS_BYTES) != hipSuccess || per_cu < 1) { fprintf(stderr, "kernel_launch: occupancy query gives %d\n", per_cu); per_cu = 1; }
        (void)hipGetLastError();
        grid = cus * 1;
        if (grid % 8 != 0 || grid > 256) grid = (grid > 256) ? 256 : (grid / 8) * 8;
    }
    if (grid < 0) return;
    Args a{};
    for (int i = 0; i < 19; ++i) a.in[i] = (const float*)d_in[i];
    a.out = (float*)d_out; a.ws = (unsigned char*)d_ws;
    if (hipMemsetAsync((char*)d_ws + WS_BAR, 0, 16384, stream) != hipSuccess) { fprintf(stderr, "kernel_launch: memset of the barrier words failed\n"); return; }
    void* args[] = {&a};
    hipError_t e = hipLaunchCooperativeKernel((const void*)fwd_megakernel, dim3(grid), dim3(NTHR), args, LDS_BYTES, stream);
    if (e != hipSuccess) fprintf(stderr, "cooperative launch failed: %s (grid %d)\n", hipGetErrorString(e), grid);
}
```

```cpp
#include <hip/hip_runtime.h>
#include <hip/hip_cooperative_groups.h>
#include <cstdio>
#include <cstdint>
namespace cg = cooperative_groups;

namespace pg8 {
#define PG8_LAS __attribute__((address_space(3)))
typedef unsigned short bf16_t;
typedef short bf16x8 __attribute__((ext_vector_type(8)));
typedef float f32x4 __attribute__((ext_vector_type(4)));
typedef unsigned u32x4 __attribute__((ext_vector_type(4)));
constexpr int BM = 256, BK = 64, HALF = 128, HTB = HALF * BK * 2  , STAGE_BYTES = 8 * HTB, NXCD = 8, WGM = 8;

__host__ __device__ __forceinline__ int lds_byte(int r, int c) { const int st = (r >> 4) * 2 + (c >> 5), rr = r & 15, cc = c & 31, ob = rr * 64 + cc * 2; return st * 1024 + (ob ^ (((ob >> 9) & 1) << 5)); }
__host__ __device__ __forceinline__ void stage_rc(int b, int& R, int& C) { const int st = b / 1024, sb = b % 1024, swz = sb ^ (((sb >> 9) & 1) << 5); R = (st >> 1) * 16 + swz / 64; C = (st & 1) * 32 + (swz % 64) / 2; }
__host__ __device__ __forceinline__ int perm32(int rho) { const int n = rho >> 4, i = rho & 15; return 8 * (i >> 2) + 4 * n + (i & 3); }

struct Unit { int pm, pn, z; };
struct Gemm { const bf16_t* A; const bf16_t* Bt; const bf16_t* A1; const bf16_t* Bt1; int M, N, K; };

struct StaticOrder {
    int nM, nN, nwg, G, c;
    __host__ __device__ void init(int M, int N, int G_, int c_) { nM = M / BM; nN = N / BM; nwg = nM * nN; G = G_; c = c_; }
    __host__ __device__ bool next(int i, Unit& u) const {
        const long L = (long)i * G + c; if (L >= nwg) return false;
        int wgid = (int)L; { const int q = nwg / NXCD, r = nwg % NXCD, xcd = wgid % NXCD, off = wgid / NXCD; wgid = (xcd < r ? xcd * (q + 1) : r * (q + 1) + (xcd - r) * q) + off; }
        const int nig = WGM * nN, gid = wgid / nig, fm = gid * WGM, gsz = (nM - fm) < WGM ? (nM - fm) : WGM;
        u.pm = fm + ((wgid % nig) % gsz); u.pn = (wgid % nig) / gsz; return true;
    }
    __device__ __forceinline__ void a_ready(const Unit&) const {}
    __device__ __forceinline__ void done(const Unit&) const {}
};


__device__ __forceinline__ unsigned cvt_pk_bf16(float lo, float hi) { unsigned r; asm volatile("v_cvt_pk_bf16_f32 %0, %1, %2" : "=v"(r) : "v"(lo), "v"(hi)); return r; }
__device__ __forceinline__ float bf_lo(unsigned w) { return __uint_as_float(w << 16); }
__device__ __forceinline__ float bf_hi(unsigned w) { return __uint_as_float(w & 0xffff0000u); }

struct RectOrder {
    int nN, nwg, G, c, pm0, pn0;
    __device__ __forceinline__ void init(int nM_, int nN_, int pm0_, int pn0_, int G_, int c_) { nN = nN_; nwg = nM_ * nN_; G = G_; c = c_; pm0 = pm0_; pn0 = pn0_; }
    __device__ __forceinline__ int count() const { return nwg > c ? (nwg - c + G - 1) / G : 0; }
    __device__ __forceinline__ bool next(int i, Unit& u) const {
        const long L = (long)i * G + c; if (L >= nwg) return false;
        int w = (int)L;
        if ((nwg & 7) == 0 && (G & 7) == 0) w = (c & 7) * (nwg >> 3) + (w >> 3);
        const int nig = 8 * nN, gid = w / nig, r = w % nig;
        u.pm = pm0 + gid * 8 + (r & 7); u.pn = pn0 + (r >> 3); u.z = 0; return true;
    }
    __device__ __forceinline__ void a_ready(const Unit&) const {}
    __device__ __forceinline__ void done(const Unit&) const {}
};
struct TwoRect {
    RectOrder a, b; int na;
    __device__ __forceinline__ bool next(int i, Unit& u) const { return i < na ? a.next(i, u) : b.next(i - na, u); }
    __device__ __forceinline__ void a_ready(const Unit&) const {}
    __device__ __forceinline__ void done(const Unit&) const {}
};
struct PairOrder {
    RectOrder r;
    __device__ __forceinline__ bool next(int i, Unit& u) const { const bool ok = r.next(i >> 1, u); u.z = i & 1; return ok; }
    __device__ __forceinline__ void a_ready(const Unit&) const {}
    __device__ __forceinline__ void done(const Unit&) const {}
};

constexpr float RMS_EPS = 1e-6f;
constexpr float QSCALE = 0.125f * 1.44269504088896341f;

__device__ __forceinline__ float row_rstd(const float* ssq, int row) {
    const f32x4* p = (const f32x4*)(ssq + (size_t)row * 16);
    const f32x4 a = p[0], b = p[1], c = p[2], d = p[3];
    const float s = ((a[0] + a[1]) + (a[2] + a[3])) + ((b[0] + b[1]) + (b[2] + b[3])) + ((c[0] + c[1]) + (c[2] + c[3])) + ((d[0] + d[1]) + (d[2] + d[3]));
    return __builtin_amdgcn_rsqf(s * (1.0f / 1024.0f) + RMS_EPS);
}

template <class Sched>
__device__ __forceinline__ void fill_rstd_table(const Sched& S, const float* ssq, PG8_LAS float* rtab, int tid) {
    int q0 = -1, q1 = -1, q2 = -1; Unit u;
#pragma unroll 1
    for (int i = 0; S.next(i, u); ++i) { if (u.pm == q0 || u.pm == q1 || u.pm == q2) continue; if (q0 < 0) q0 = u.pm; else if (q1 < 0) q1 = u.pm; else if (q2 < 0) q2 = u.pm; }
    if (tid == 0) { ((PG8_LAS int*)rtab)[768] = q0; ((PG8_LAS int*)rtab)[769] = q1; ((PG8_LAS int*)rtab)[770] = 0; }
    const int t = tid & 255, half = tid >> 8;
    { const int pm = half ? q1 : q0; if (pm >= 0) { rtab[half * 256 + t] = row_rstd(ssq, pm * BM + t); } }
    if (q2 >= 0 && half == 0) { const float v = row_rstd(ssq, q2 * BM + t); rtab[512 + t] = v; }
    __syncthreads();
}

struct EpiIn {
    static constexpr bool PERM = true, AFTER_DRAIN = false, IDEMPOTENT = true;
    bf16_t* hy; bf16_t* q; bf16_t* kv; bf16_t* gates; const PG8_LAS float* rtab; int kv_row0;
    __device__ __forceinline__ bool operator()(f32x4 (&acc)[2][2][4][2], const Unit& u, int wr, int wc, int fr, int fq) const {
        const int pn = u.pn; int type, ldc, colt, rowoff = 0; bf16_t* base;
        if (pn < 6) { type = 0; base = hy; ldc = 1536; colt = pn * 256; }
        else if (pn < 12) { type = 1; base = q; ldc = 1536; colt = (pn - 6) * 256; }
        else if (pn < 24) { const int idx = pn - 12; type = ((idx >> 1) & 1) ? 0 : 2; base = kv; ldc = 3072; colt = idx * 256; rowoff = kv_row0; }
        else { type = 3; base = gates; ldc = 2048; colt = (pn - 24) * 256; }
        const bool rot = (type == 1 || type == 2);
        const int row0 = u.pm * BM + wr * 64 + fr;
        const int p0 = ((const PG8_LAS int*)rtab)[768], p1 = ((const PG8_LAS int*)rtab)[769];
        const PG8_LAS float* rt = rtab + ((u.pm == p0) ? 0 : ((u.pm == p1) ? 256 : 512)) + wr * 64 + fr;
        float frev[8];
#pragma unroll
        for (int e = 0; e < 8; ++e) frev[e] = __builtin_amdgcn_exp2f(-(float)(8 * fq + e) * (13.287712379549449f / 32.0f)) * 0.15915494309189535f;
#pragma unroll
        for (int k = 0; k < 8; ++k) {
            const int ai = k >> 2, m = k & 3, cb = k & 1;
            const int row = row0 + ai * HALF + m * 16;
            const float rs = rt[ai * HALF + m * 16];
            bf16_t* rowp = base + (size_t)(row - rowoff) * ldc + colt;
            f32x4 v00 = acc[ai][0][m][0] * rs, v01 = acc[ai][0][m][1] * rs, v10 = acc[ai][1][m][0] * rs, v11 = acc[ai][1][m][1] * rs;
            if (rot) {
                const float posf = (float)(row & 2047);
                f32x4 c0, c1, s0, s1;
#pragma unroll
                for (int e = 0; e < 4; ++e) { const float r0 = __builtin_amdgcn_fractf(posf * frev[e]), r1 = __builtin_amdgcn_fractf(posf * frev[4 + e]);
                    c0[e] = __builtin_amdgcn_cosf(r0); s0[e] = __builtin_amdgcn_sinf(r0); c1[e] = __builtin_amdgcn_cosf(r1); s1[e] = __builtin_amdgcn_sinf(r1); }
                const float sc = (type == 1) ? QSCALE : 1.0f;
                const f32x4 o00 = (v00 * c0 - v10 * s0) * sc, o01 = (v01 * c1 - v11 * s1) * sc;
                const f32x4 o10 = (v10 * c0 + v00 * s0) * sc, o11 = (v11 * c1 + v01 * s1) * sc;
                u32x4 w0, w1;
                w0.x = cvt_pk_bf16(o00[0], o00[1]); w0.y = cvt_pk_bf16(o00[2], o00[3]); w0.z = cvt_pk_bf16(o01[0], o01[1]); w0.w = cvt_pk_bf16(o01[2], o01[3]);
                w1.x = cvt_pk_bf16(o10[0], o10[1]); w1.y = cvt_pk_bf16(o10[2], o10[3]); w1.z = cvt_pk_bf16(o11[0], o11[1]); w1.w = cvt_pk_bf16(o11[2], o11[3]);
                *(u32x4*)(rowp + wc * 64 + 8 * fq) = w0;
                *(u32x4*)(rowp + wc * 64 + 8 * fq + 32) = w1;
            } else {
                if (type == 3) {
#pragma unroll
                    for (int e = 0; e < 4; ++e) {
                        v00[e] = __builtin_amdgcn_rcpf(1.0f + __expf(-v00[e])); v01[e] = __builtin_amdgcn_rcpf(1.0f + __expf(-v01[e]));
                        v10[e] = __builtin_amdgcn_rcpf(1.0f + __expf(-v10[e])); v11[e] = __builtin_amdgcn_rcpf(1.0f + __expf(-v11[e]));
                    }
                }
                u32x4 w0, w1;
                w0.x = cvt_pk_bf16(v00[0], v00[1]); w0.y = cvt_pk_bf16(v00[2], v00[3]); w0.z = cvt_pk_bf16(v01[0], v01[1]); w0.w = cvt_pk_bf16(v01[2], v01[3]);
                w1.x = cvt_pk_bf16(v10[0], v10[1]); w1.y = cvt_pk_bf16(v10[2], v10[3]); w1.z = cvt_pk_bf16(v11[0], v11[1]); w1.w = cvt_pk_bf16(v11[2], v11[3]);
                *(u32x4*)(rowp + wc * 32 + 8 * fq) = w0;
                *(u32x4*)(rowp + wc * 32 + 8 * fq + HALF) = w1;
            }
        }
        return false;
    }
};

struct EpiGate {
    static constexpr bool PERM = true, AFTER_DRAIN = false, IDEMPOTENT = false;
    const bf16_t* gates; bf16_t* merged;
    __device__ __forceinline__ bool operator()(f32x4 (&acc)[2][2][4][2], const Unit& u, int wr, int wc, int fr, int fq) const {
        const int row0 = u.pm * BM + wr * 64 + fr, col0 = u.pn * BM + wc * 32 + 8 * fq;
        const bool first = (u.z == 0);
        u32x4 GA[2][2], GH[2][2];
#define EPIG_LOAD(k_, buf_) do { const bf16_t* gp_ = gates + (size_t)(row0 + ((k_) >> 2) * HALF + ((k_) & 3) * 16) * 2048 + col0; \
            GA[buf_][0] = *(const u32x4*)(gp_ + 1024); GA[buf_][1] = *(const u32x4*)(gp_ + 1024 + HALF); \
            if (first) { GH[buf_][0] = *(const u32x4*)(gp_); GH[buf_][1] = *(const u32x4*)(gp_ + HALF); } } while (0)
        EPIG_LOAD(0, 0);
#pragma unroll
        for (int k = 0; k < 8; ++k) {
            const int ai = k >> 2, m = k & 3, cb = k & 1;
            if (k < 7) EPIG_LOAD(k + 1, cb ^ 1);
            const int row = row0 + ai * HALF + m * 16;
#pragma unroll
            for (int bj = 0; bj < 2; ++bj) {
                const u32x4 ga = GA[cb][bj];
                f32x4 a0 = (f32x4){bf_lo(ga.x), bf_hi(ga.x), bf_lo(ga.y), bf_hi(ga.y)}, a1 = (f32x4){bf_lo(ga.z), bf_hi(ga.z), bf_lo(ga.w), bf_hi(ga.w)};
                if (first) {
                    const u32x4 gh = GH[cb][bj];
                    const f32x4 h0 = (f32x4){bf_lo(gh.x), bf_hi(gh.x), bf_lo(gh.y), bf_hi(gh.y)}, h1 = (f32x4){bf_lo(gh.z), bf_hi(gh.z), bf_lo(gh.w), bf_hi(gh.w)};
#pragma unroll
                    for (int e = 0; e < 4; ++e) { a0[e] = fmaxf(a0[e], 1e-30f); a1[e] = fmaxf(a1[e], 1e-30f); }
#pragma unroll
                    for (int e = 0; e < 4; ++e) { acc[ai][bj][m][0][e] *= h0[e] * __builtin_amdgcn_rcpf(a0[e]); acc[ai][bj][m][1][e] *= h1[e] * __builtin_amdgcn_rcpf(a1[e]); }
                } else {
                    const f32x4 v0 = acc[ai][bj][m][0] * a0, v1 = acc[ai][bj][m][1] * a1;
                    u32x4 w; w.x = cvt_pk_bf16(v0[0], v0[1]); w.y = cvt_pk_bf16(v0[2], v0[3]); w.z = cvt_pk_bf16(v1[0], v1[1]); w.w = cvt_pk_bf16(v1[2], v1[3]);
                    *(u32x4*)(merged + (size_t)row * 1024 + col0 + bj * HALF) = w;
                }
            }
        }
#undef EPIG_LOAD
        return first;
    }
};

struct EpiRes {
    static constexpr bool PERM = true, AFTER_DRAIN = false, IDEMPOTENT = false;
    const float* base32; bf16_t* xb; float* ssq;
    __device__ __forceinline__ bool operator()(f32x4 (&acc)[2][2][4][2], const Unit& u, int wr, int wc, int fr, int fq) const {
        int rl = wr * 64 + fr, cl = wc * 32 + 8 * fq;
        asm volatile("" : "+v"(rl), "+v"(cl));
        const bool f32base = base32 != nullptr;
        f32x4 Bv[2][4];
#define EPIRES_LOAD(k_, buf_) do { const size_t off_ = (size_t)(u.pm * BM + ((k_) >> 2) * HALF + ((k_) & 3) * 16 + rl) * 1024 + u.pn * BM + cl; \
            if (f32base) { Bv[buf_][0] = *(const f32x4*)(base32 + off_); Bv[buf_][1] = *(const f32x4*)(base32 + off_ + 4); Bv[buf_][2] = *(const f32x4*)(base32 + off_ + HALF); Bv[buf_][3] = *(const f32x4*)(base32 + off_ + HALF + 4); } \
            else { _Pragma("unroll") for (int j_ = 0; j_ < 2; ++j_) { const u32x4 w_ = *(const u32x4*)(xb + off_ + j_ * HALF); \
                       Bv[buf_][2 * j_] = (f32x4){bf_lo(w_.x), bf_hi(w_.x), bf_lo(w_.y), bf_hi(w_.y)}; Bv[buf_][2 * j_ + 1] = (f32x4){bf_lo(w_.z), bf_hi(w_.z), bf_lo(w_.w), bf_hi(w_.w)}; } } } while (0)
        EPIRES_LOAD(0, 0);
#pragma unroll
        for (int k = 0; k < 8; ++k) {
            const int ai = k >> 2, m = k & 3, cb = k & 1;
            if (k < 7) EPIRES_LOAD(k + 1, cb ^ 1);
            const int row = u.pm * BM + ai * HALF + m * 16 + rl;
            const size_t off = (size_t)row * 1024 + u.pn * BM + cl;
            float s = 0.f;
#pragma unroll
            for (int bj = 0; bj < 2; ++bj) {
                const f32x4 o0 = Bv[cb][bj * 2] + acc[ai][bj][m][0], o1 = Bv[cb][bj * 2 + 1] + acc[ai][bj][m][1];
                u32x4 w; w.x = cvt_pk_bf16(o0[0], o0[1]); w.y = cvt_pk_bf16(o0[2], o0[3]); w.z = cvt_pk_bf16(o1[0], o1[1]); w.w = cvt_pk_bf16(o1[2], o1[3]);
                *(u32x4*)(xb + off + bj * HALF) = w;
                s += ((o0[0] * o0[0] + o0[1] * o0[1]) + (o0[2] * o0[2] + o0[3] * o0[3])) + ((o1[0] * o1[0] + o1[1] * o1[1]) + (o1[2] * o1[2] + o1[3] * o1[3]));
            }
            s += __shfl_xor(s, 16); s += __shfl_xor(s, 32);
            if (fq == 0) ssq[(size_t)row * 16 + u.pn * 4 + wc] = s;
        }
#undef EPIRES_LOAD
        return false;
    }
};

struct EpiFF1 {
    static constexpr bool PERM = true, AFTER_DRAIN = false, IDEMPOTENT = true;
    bf16_t* h; const PG8_LAS float* rtab;
    __device__ __forceinline__ bool operator()(f32x4 (&acc)[2][2][4][2], const Unit& u, int wr, int wc, int fr, int fq) const {
        const int row0 = u.pm * BM + wr * 64 + fr;
        const int p0 = ((const PG8_LAS int*)rtab)[768], p1 = ((const PG8_LAS int*)rtab)[769];
        const PG8_LAS float* rt = rtab + ((u.pm == p0) ? 0 : ((u.pm == p1) ? 256 : 512)) + wr * 64 + fr;
        float rsv[8];
#pragma unroll
        for (int k = 0; k < 8; ++k) rsv[k] = rt[(k >> 2) * HALF + (k & 3) * 16];
#pragma unroll
        for (int ai = 0; ai < 2; ++ai)
#pragma unroll
            for (int m = 0; m < 4; ++m) {
                const int row = row0 + ai * HALF + m * 16;
                const float rs = rsv[ai * 4 + m];
                bf16_t* rowp = h + (size_t)row * 4096 + u.pn * BM + wc * 32 + 8 * fq;
#pragma unroll
                for (int bj = 0; bj < 2; ++bj) {
                    f32x4 v0 = acc[ai][bj][m][0] * rs, v1 = acc[ai][bj][m][1] * rs;
#pragma unroll
                    for (int e = 0; e < 4; ++e) { v0[e] = fmaxf(v0[e], 0.f); v1[e] = fmaxf(v1[e], 0.f); }
                    v0 = v0 * v0; v1 = v1 * v1;
                    u32x4 w; w.x = cvt_pk_bf16(v0[0], v0[1]); w.y = cvt_pk_bf16(v0[2], v0[3]); w.z = cvt_pk_bf16(v1[0], v1[1]); w.w = cvt_pk_bf16(v1[2], v1[3]);
                    *(u32x4*)(rowp + bj * HALF) = w;
                }
            }
        return false;
    }
};

template <class Epi, class Sched, bool ALIGN_EPI = false, bool SP2 = false>
__device__ __forceinline__ void gemm_phase(PG8_LAS unsigned char* lds, const Gemm g, const Sched& S, const Epi& E, int tid_in) {
    int tid_ = tid_in; asm volatile("" : "+v"(tid_));
    const int tid = tid_, wid = __builtin_amdgcn_readfirstlane(tid >> 6), lane = tid & 63, wr = wid >> 2, wc = wid & 3, fr = lane & 15, fq = lane >> 4;
    const int K = g.K, nt = K / BK;
    unsigned voffA[2], voffB[2];
#pragma unroll
    for (int i = 0; i < 2; ++i) { int R, C; stage_rc(tid * 16 + i * 8192, R, C); const int Rb = Epi::PERM ? ((R & ~31) + perm32(R & 31)) : R;
        voffA[i] = (unsigned)(R * K + C) * 2u; voffB[i] = (unsigned)(Rb * K + C) * 2u; }
    const size_t kstep = (size_t)(BK * 2);
    const size_t hstep = (size_t)HALF * K * 2;
    const size_t tstep = 2 * hstep;
    const unsigned ldsw = (unsigned)wid * 1024u;
    const int aoff = lds_byte(wr * 64 + fr, fq * 8), boff = lds_byte(wc * 32 + fr, fq * 8);
#define PG8_SA(b, h) (((b) * 2 + (h)) * HTB)
#define PG8_SB(b, h) ((4 + (b) * 2 + (h)) * HTB)
#define PG8_STAGE(bufoff, gbase, voff) do { _Pragma("unroll") for (int _i = 0; _i < 2; ++_i) \
        __builtin_amdgcn_global_load_lds((const unsigned*)((const char*)(gbase) + (voff)[_i]), (PG8_LAS unsigned*)(lds + (bufoff) + ldsw + _i * 8192), 16, 0, 0); } while (0)
#define PG8_LDA(dst, b, h) do { _Pragma("unroll") for (int m = 0; m < 4; ++m) _Pragma("unroll") for (int k = 0; k < 2; ++k) dst[m][k] = *(const PG8_LAS bf16x8*)(lds + PG8_SA(b, h) + aoff + m * 2048 + k * 1024); } while (0)
#define PG8_LDB(dst, b, h) do { _Pragma("unroll") for (int n = 0; n < 2; ++n) _Pragma("unroll") for (int k = 0; k < 2; ++k) dst[n][k] = *(const PG8_LAS bf16x8*)(lds + PG8_SB(b, h) + boff + n * 2048 + k * 1024); } while (0)
#define PG8_MMA(ai, bj, At, Bt) do { __builtin_amdgcn_s_setprio(1); _Pragma("unroll") for (int m = 0; m < 4; ++m) _Pragma("unroll") for (int n = 0; n < 2; ++n) _Pragma("unroll") for (int k = 0; k < 2; ++k) \
        acc[ai][bj][m][n] = __builtin_amdgcn_mfma_f32_16x16x32_bf16(Bt[n][k], At[m][k], acc[ai][bj][m][n], 0, 0, 0); __builtin_amdgcn_s_setprio(0); } while (0)
#define PG8_WAIT_V(n) asm volatile("s_waitcnt vmcnt(" #n ")" ::: "memory")
#define PG8_WAIT_L(n) asm volatile("s_waitcnt lgkmcnt(" #n ")" ::: "memory")
#define PG8_BAR __builtin_amdgcn_s_barrier()
#define PG8_SCHED __builtin_amdgcn_sched_barrier(0)
    Unit cur, nxt; int ui = 0;
    if (!S.next(0, cur)) return;
    f32x4 acc[2][2][4][2];
#pragma unroll
    for (int a = 0; a < 2; ++a)
#pragma unroll
        for (int b = 0; b < 2; ++b)
#pragma unroll
            for (int m = 0; m < 4; ++m)
#pragma unroll
                for (int n = 0; n < 2; ++n) acc[a][b][m][n] = (f32x4){0.f, 0.f, 0.f, 0.f};
    bf16x8 At[4][2], B0[2][2], B1[2][2];
    const char* cA = (const char*)(cur.z ? g.A1 : g.A) + (size_t)cur.pm * tstep; const char* cB = (const char*)(cur.z ? g.Bt1 : g.Bt) + (size_t)cur.pn * tstep;
    S.a_ready(cur);
    if constexpr (SP2) {
        PG8_STAGE(PG8_SB(0, 0), cB, voffB); PG8_STAGE(PG8_SB(0, 1), cB + hstep, voffB); PG8_STAGE(PG8_SA(0, 0), cA, voffA); PG8_STAGE(PG8_SA(0, 1), cA + hstep, voffA);
        if (wr == 1) PG8_BAR;
        PG8_WAIT_V(2); PG8_BAR;
        PG8_STAGE(PG8_SB(1, 0), cB + kstep, voffB); PG8_STAGE(PG8_SA(1, 0), cA + kstep, voffA); PG8_STAGE(PG8_SB(1, 1), cB + hstep + kstep, voffB);
        PG8_WAIT_V(6); PG8_BAR;
    } else {
        PG8_STAGE(PG8_SB(0, 0), cB, voffB); PG8_STAGE(PG8_SA(0, 0), cA, voffA); PG8_STAGE(PG8_SB(0, 1), cB + hstep, voffB); PG8_STAGE(PG8_SA(0, 1), cA + hstep, voffA);
        if (wr == 1) PG8_BAR;
        PG8_WAIT_V(4); PG8_BAR;
        PG8_STAGE(PG8_SB(1, 0), cB + kstep, voffB); PG8_STAGE(PG8_SA(1, 0), cA + kstep, voffA); PG8_STAGE(PG8_SB(1, 1), cB + hstep + kstep, voffB);
        PG8_WAIT_V(6); PG8_BAR;
    }
    for (;;) {
        const bool has_next = S.next(ui + 1, nxt);
        const char* nA = has_next ? (const char*)(nxt.z ? g.A1 : g.A) + (size_t)nxt.pm * tstep : cA; const char* nB = has_next ? (const char*)(nxt.z ? g.Bt1 : g.Bt) + (size_t)nxt.pn * tstep : cB;
        for (int t = 0; t < nt; t += 2) {
            const bool last = (t == nt - 2);
            const char* a1 = cA + (size_t)(t + 1) * kstep;
            const char* a2 = last ? nA : cA + (size_t)(t + 2) * kstep; const char* b2 = last ? nB : cB + (size_t)(t + 2) * kstep;
            const char* a3 = a2 + kstep; const char* b3 = b2 + kstep;
            if (last && has_next) S.a_ready(nxt);
            if constexpr (SP2) {
            PG8_LDB(B0, 0, 0); PG8_LDB(B1, 0, 1); PG8_SCHED; PG8_LDA(At, 0, 0); PG8_STAGE(PG8_SA(1, 1), a1 + hstep, voffA);
            PG8_WAIT_V(8); PG8_WAIT_L(0); PG8_BAR; PG8_MMA(0, 0, At, B0); PG8_MMA(0, 1, At, B1); PG8_BAR; PG8_SCHED;
            PG8_LDA(At, 0, 1); PG8_STAGE(PG8_SB(0, 0), b2, voffB); PG8_STAGE(PG8_SB(0, 1), b2 + hstep, voffB); PG8_STAGE(PG8_SA(0, 0), a2, voffA);
            PG8_WAIT_V(8); PG8_WAIT_L(0); PG8_BAR; PG8_MMA(1, 0, At, B0); PG8_MMA(1, 1, At, B1); PG8_BAR; PG8_SCHED;
            PG8_LDB(B0, 1, 0); PG8_LDB(B1, 1, 1); PG8_SCHED; PG8_LDA(At, 1, 0); PG8_STAGE(PG8_SA(0, 1), a2 + hstep, voffA);
            PG8_WAIT_V(8); PG8_WAIT_L(0); PG8_BAR; PG8_MMA(0, 0, At, B0); PG8_MMA(0, 1, At, B1); PG8_BAR; PG8_SCHED;
            PG8_LDA(At, 1, 1); PG8_STAGE(PG8_SB(1, 0), b3, voffB); PG8_STAGE(PG8_SB(1, 1), b3 + hstep, voffB); PG8_STAGE(PG8_SA(1, 0), a3, voffA);
            PG8_WAIT_V(8); PG8_WAIT_L(0); PG8_BAR; PG8_MMA(1, 0, At, B0); PG8_MMA(1, 1, At, B1); PG8_BAR; PG8_SCHED;
            } else {
            PG8_LDB(B0, 0, 0); PG8_SCHED; PG8_LDA(At, 0, 0); PG8_STAGE(PG8_SA(1, 1), a1 + hstep, voffA);
            PG8_WAIT_L(8); PG8_BAR; PG8_WAIT_L(0); PG8_MMA(0, 0, At, B0); PG8_BAR; PG8_SCHED;
            PG8_LDB(B1, 0, 1); PG8_STAGE(PG8_SB(0, 0), b2, voffB);
            PG8_BAR; PG8_WAIT_L(0); PG8_MMA(0, 1, At, B1); PG8_BAR;
            PG8_LDA(At, 0, 1); PG8_STAGE(PG8_SA(0, 0), a2, voffA);
            PG8_BAR; PG8_WAIT_L(0); PG8_MMA(1, 0, At, B0); PG8_BAR; PG8_SCHED;
            PG8_STAGE(PG8_SB(0, 1), b2 + hstep, voffB);
            PG8_WAIT_V(6); PG8_BAR; PG8_MMA(1, 1, At, B1); PG8_BAR;
            PG8_LDB(B0, 1, 0); PG8_SCHED; PG8_LDA(At, 1, 0); PG8_STAGE(PG8_SA(0, 1), a2 + hstep, voffA);
            PG8_WAIT_L(8); PG8_BAR; PG8_WAIT_L(0); PG8_MMA(0, 0, At, B0); PG8_BAR; PG8_SCHED;
            PG8_LDB(B1, 1, 1); PG8_STAGE(PG8_SB(1, 0), b3, voffB);
            PG8_BAR; PG8_WAIT_L(0); PG8_MMA(0, 1, At, B1); PG8_BAR;
            PG8_LDA(At, 1, 1); PG8_STAGE(PG8_SA(1, 0), a3, voffA);
            PG8_BAR; PG8_WAIT_L(0); PG8_MMA(1, 0, At, B0); PG8_BAR; PG8_SCHED;
            PG8_STAGE(PG8_SB(1, 1), b3 + hstep, voffB);
            PG8_WAIT_V(6); PG8_BAR; PG8_MMA(1, 1, At, B1); PG8_BAR;
            }
        }
        if constexpr (ALIGN_EPI) { if (wr == 0) PG8_BAR; }
#ifndef PROBE_EPI
#define PROBE_EPI 0
#endif
        bool keep_acc = false; if constexpr (!Epi::AFTER_DRAIN) { keep_acc = E(acc, cur, wr, wc, fr, fq); if constexpr (Epi::IDEMPOTENT && PROBE_EPI) { asm volatile("" ::: "memory"); keep_acc = E(acc, cur, wr, wc, fr, fq); } S.done(cur); }
        if (!has_next) break;
        if (!keep_acc) {
#pragma unroll
        for (int a = 0; a < 2; ++a)
#pragma unroll
            for (int b = 0; b < 2; ++b)
#pragma unroll
                for (int m = 0; m < 4; ++m)
#pragma unroll
                    for (int n = 0; n < 2; ++n) acc[a][b][m][n] = (f32x4){0.f, 0.f, 0.f, 0.f};
        }
        cur = nxt; cA = nA; cB = nB; ++ui;
        if constexpr (ALIGN_EPI) { if (wr == 1) PG8_BAR; }
    }
    PG8_WAIT_V(0);
    if constexpr (!ALIGN_EPI) { if (wr == 0) PG8_BAR; }
    PG8_BAR;
    if constexpr (Epi::AFTER_DRAIN) { E.fused(acc, cur, wr, wc, fr, fq, lds, wid, lane); S.done(cur); }
#undef PG8_SA
#undef PG8_SB
#undef PG8_STAGE
#undef PG8_LDA
#undef PG8_LDB
#undef PG8_MMA
#undef PG8_WAIT_V
#undef PG8_WAIT_L
#undef PG8_BAR
#undef PG8_SCHED
}
}

#define LAS __attribute__((address_space(3)))
typedef unsigned short bf16;
typedef float f32x4 __attribute__((ext_vector_type(4)));
typedef unsigned v4u __attribute__((ext_vector_type(4)));
constexpr int NWAVES = 8, NTHR = 512;
constexpr int MTOK = 32768, DM = 1024, SEQ = 2048, NBATCH = 16, NIN = 8192, DFF = 4096, HYW = 512, HALF_TOK = 16384;
constexpr size_t MiB = (size_t)1 << 20;
constexpr size_t WS_SSQA = 0, WS_SSQB = 2 * MiB, WS_ROPE = 4 * MiB, WS_RSTD = 4 * MiB + 512 * 1024, WS_BAR = 4 * MiB + 768 * 1024, WS_LSE = 5 * MiB, WS_GF = 8 * MiB, WS_W = 16 * MiB, WS_XB = 52 * MiB,
                 WS_HY = 116 * MiB, WS_UT = 212 * MiB, WS_GATES = 116 * MiB, WS_Q = 244 * MiB, WS_KV = 340 * MiB, WS_YHY = 436 * MiB, WS_YATT = 404 * MiB, WS_X0T = 468 * MiB,
                 WS_MERGED = 340 * MiB, WS_H = 116 * MiB, WS_END = 500 * MiB;
constexpr size_t W_IN = 0, W_PHY = 16 * MiB, W_PATT = 17 * MiB, W_O = 18 * MiB, W_FF1 = 20 * MiB, W_FF2 = 28 * MiB;
constexpr int LDS_RTAB = 131072;
constexpr int LDS_ST_OFF = 135168;
constexpr int LDS_BYTES = 139264;

struct Args {
    const float* in[19]; float* out; unsigned char* ws; int pad0, pad1;
};

__device__ __forceinline__ unsigned f2bf(float f) { unsigned u = __float_as_uint(f); return (u + 0x7fffu + ((u >> 16) & 1u)) >> 16; }
__device__ __forceinline__ unsigned pk2(float lo, float hi) { return f2bf(lo) | (f2bf(hi) << 16); }
__device__ __forceinline__ float bf2f(unsigned short b) { return __uint_as_float((unsigned)b << 16); }
__device__ __forceinline__ float wave_sum(float v) {
#pragma unroll
    for (int o = 1; o < 64; o <<= 1) v += __shfl_xor(v, o);
    return v;
}

__device__ __forceinline__ int win_src_col(int n) {
    const int t = n >> 8, j = n & 255;
    if (t < 6) return n;
    if (t >= 24) return 6144 + (n - 6144);
    int g, w, half;
    if (t < 12) { const int i = t - 6; g = i >> 1; w = 0; half = i & 1; }
    else { const int i = t - 12; g = i >> 2; w = 1 + ((i >> 1) & 1); half = i & 1; }
    int hh, d;
    if (w == 2) { hh = j >> 6; d = j & 63; }
    else { hh = (j & 127) >> 5; d = (j & 31) + ((j >> 7) << 5); }
    return 1536 + g * 1536 + w * 512 + (half * 4 + hh) * 64 + d;
}

__device__ __forceinline__ void transpose_item(const float* W, int K, int Nsrc, int s0, bf16* WT, int n0, int k0, const float* gain, LAS float* scr, int lane) {
    float tv[32];
#pragma unroll
    for (int i = 0; i < 32; ++i) { const int kk = 2 * i + (lane >> 5); tv[i] = W[(size_t)(k0 + kk) * Nsrc + s0 + (lane & 31)]; }
    const float gl = gain ? gain[k0 + lane] : 1.0f;
#pragma unroll
    for (int i = 0; i < 32; ++i) { const int kk = 2 * i + (lane >> 5); scr[kk * 33 + (lane & 31)] = tv[i] * __shfl(gl, kk); }
    asm volatile("s_waitcnt lgkmcnt(0)" ::: "memory");
    const int c = lane & 7;
#pragma unroll
    for (int j = 0; j < 4; ++j) { const int n = (lane >> 3) + 8 * j; const LAS float* s = scr + (8 * c) * 33 + n;
        v4u o; o.x = pk2(s[0 * 33], s[1 * 33]); o.y = pk2(s[2 * 33], s[3 * 33]); o.z = pk2(s[4 * 33], s[5 * 33]); o.w = pk2(s[6 * 33], s[7 * 33]);
        *(v4u*)(WT + (size_t)(n0 + n) * K + k0 + 8 * c) = o; }
    asm volatile("s_waitcnt lgkmcnt(0)" ::: "memory");
}

__device__ __forceinline__ void phase_prep_weights(const Args& a, int L, LAS unsigned char* lds, int tid, int lane, int wave, int G) {
    unsigned char* ws = a.ws;
    {
        const float* w1 = a.in[5] + (size_t)L * 33 * 64; const float* b1 = a.in[6] + L * 64;
        const float* wi = a.in[7] + (size_t)L * 2 * 64 * 64; const float* bi = a.in[8] + L * 2 * 64;
        const float* wout = a.in[9] + (size_t)L * 64 * 1024; const float* fr = a.in[10] + L * 64; const float* skip = a.in[11] + L * 512;
        bf16* Rg = (bf16*)(ws + WS_GF);
        const float min_decay = logf(1e-2f) / 1.5f, max_decay = logf(1e-2f) / 0.3f;
        LAS float* hb = (LAS float*)lds + wave * 64;
        LAS float* fbuf = (LAS float*)(lds + 4096);
        const float frl = fr[lane];
        LAS float* wl = (LAS float*)(lds + 40960);
        for (int i = tid; i < 528 + 2048; i += NTHR) { const f32x4 v = (i < 528) ? *((const f32x4*)w1 + i) : *((const f32x4*)wi + (i - 528)); *(LAS f32x4*)(wl + 4 * i) = v; }
        __syncthreads();
#ifndef PROBE_PWF
#define PROBE_PWF 0
#endif
#ifndef PROBE_PWT
#define PROBE_PWT 0
#endif
        _Pragma("unroll 1") for (int repf = 0; repf < 1 + PROBE_PWF; ++repf)
        for (int blk = blockIdx.x; blk < 256; blk += G) {
            int n = 8 * blk + wave + 1; if (n == 2048) n = 0;
            const float t = (float)n / 2047.0f;
            {
                float v = 0.f;
                if (lane == 0) v = t;
                else if (lane < 33) { const int k = (lane - 1) & 15; const float band = 1e-4f + (float)k * ((15.0f - 1e-4f) / 15.0f); const float ang = ((float)(2.0 * 3.14159265358979323846 / 2048.0) * (float)n) * band;
                       v = (lane <= 16) ? cosf(ang) : -sinf(ang); }
                hb[lane] = v;
            }
            float s = b1[lane];
#pragma unroll
            for (int e = 0; e < 33; ++e) s += hb[e] * wl[e * 64 + lane];
            float hcur = sinf(frl * s);
#pragma unroll 1
            for (int layer = 0; layer < 2; ++layer) {
                hb[lane] = hcur;
                float s2 = bi[layer * 64 + lane];
#pragma unroll
                for (int e = 0; e < 64; ++e) s2 += hb[e] * wl[2112 + layer * 4096 + e * 64 + lane];
                hcur = sinf(frl * s2);
            }
            LAS float* hT = (LAS float*)(lds + 2048);
            hT[lane * 8 + wave] = hcur;
            __syncthreads();
            float o[8][2];
#pragma unroll
            for (int p = 0; p < 8; ++p) { o[p][0] = 0.f; o[p][1] = 0.f; }
#pragma unroll 16
            for (int e0 = 0; e0 < 64; ++e0) {
                const int e = (e0 + 8 * ((blk >> 3) & 7)) & 63;
                const f32x4 ha = *(const LAS f32x4*)(hT + e * 8), hc = *(const LAS f32x4*)(hT + e * 8 + 4);
                const float w0 = wout[e * 1024 + 128 * wave + lane], w1v = wout[e * 1024 + 128 * wave + 64 + lane];
#pragma unroll
                for (int p = 0; p < 4; ++p) { o[p][0] += ha[p] * w0; o[p][1] += ha[p] * w1v; o[4 + p][0] += hc[p] * w0; o[4 + p][1] += hc[p] * w1v; }
            }
#pragma unroll
            for (int j = 0; j < 2; ++j) {
                const int col = 128 * wave + 64 * j + lane, c = col & 511;
                const float delta = fabsf(min_decay + (float)c * ((max_decay - min_decay) / 511.0f));
#pragma unroll
                for (int p = 0; p < 8; ++p) { int np = 8 * blk + p + 1; if (np == 2048) np = 0; const float tp = (float)np / 2047.0f; fbuf[p * 1024 + col] = o[p][j] * expf(-tp * delta); }
            }
            __syncthreads();
            if (blk != 255) {
                typedef unsigned u32x2v __attribute__((ext_vector_type(2)));
#pragma unroll
                for (int pp = 0; pp < 2; ++pp) {
                    const int p = tid + 512 * pp, c = p & 511, dir = p >> 9;
                    bf16* r0 = Rg + ((size_t)c * 2 + 0) * 4096; bf16* r1 = Rg + ((size_t)c * 2 + 1) * 4096;
                    unsigned e[8];
#pragma unroll
                    for (int j = 0; j < 8; ++j) e[j] = f2bf(fbuf[(dir ? j : 7 - j) * 1024 + dir * 512 + c]);
                    v4u w8; w8.x = e[0] | (e[1] << 16); w8.y = e[2] | (e[3] << 16); w8.z = e[4] | (e[5] << 16); w8.w = e[6] | (e[7] << 16);
                    if (dir == 0) {
                        const int xb0 = 2040 - 8 * blk;
                        *(v4u*)(r0 + xb0) = w8;
                        r1[xb0 - 1] = (bf16)e[0];
                        u32x2v m4; m4.x = e[1] | (e[2] << 16); m4.y = e[3] | (e[4] << 16); *(u32x2v*)(r1 + xb0) = m4;
                        *(unsigned*)(r1 + xb0 + 4) = e[5] | (e[6] << 16);
                        r1[xb0 + 6] = (bf16)e[7];
                    } else {
                        const int xa = 2049 + 8 * blk;
                        *(v4u*)(r1 + xa - 1) = w8;
                        r0[xa] = (bf16)e[0];
                        *(unsigned*)(r0 + xa + 1) = e[1] | (e[2] << 16);
                        u32x2v m4; m4.x = e[3] | (e[4] << 16); m4.y = e[5] | (e[6] << 16); *(u32x2v*)(r0 + xa + 3) = m4;
                        r0[xa + 7] = (bf16)e[7];
                    }
                }
            } else
#pragma unroll
            for (int pp = 0; pp < 2; ++pp) {
                const int p = tid + 512 * pp, c = p & 511, dir = p >> 9;
                bf16* r0 = Rg + ((size_t)c * 2 + 0) * 4096; bf16* r1 = Rg + ((size_t)c * 2 + 1) * 4096;
#pragma unroll
                for (int wv = 0; wv < 8; ++wv) {
                    int nn = 8 * blk + wv + 1; float val = fbuf[wv * 1024 + dir * 512 + c]; int x;
                    if (nn == 2048) { if (dir != 0) continue; val += skip[c]; x = 2048; }
                    else x = dir ? 2048 + nn : 2048 - nn;
                    const bf16 hv = (bf16)f2bf(val); r0[x] = hv; r1[x - 1] = hv;
                }
            }
            __syncthreads();
        }
    }
    {
        LAS float* scr = (LAS float*)(lds + 40960 + wave * 8704);
        const int gw = blockIdx.x * NWAVES + wave, NGW = G * NWAVES;
        bf16* Wb = (bf16*)(ws + WS_W);
        const float* w_in = a.in[2] + (size_t)L * DM * NIN; const float* p_hy = a.in[12] + (size_t)L * 512 * DM; const float* p_att = a.in[13] + (size_t)L * 512 * DM;
        const float* w_o = a.in[14] + (size_t)L * DM * DM; const float* w1 = a.in[16] + (size_t)L * DM * DFF; const float* w2 = a.in[17] + (size_t)L * DFF * DM;
        const float* g_mix = a.in[1] + L * DM; const float* g_ffn = a.in[15] + L * DM;
        constexpr int I_IN = 16 * 256, I_P = 8 * 32, I_O = 16 * 32, I_1 = 16 * 128, I_2 = 64 * 32;
        constexpr int NITEMS = I_IN + 2 * I_P + I_O + I_1 + I_2;
        _Pragma("unroll 1") for (int rept = 0; rept < 1 + PROBE_PWT; ++rept)
        for (int it = gw; it < NITEMS; it += NGW) {
            int r = it;
            if (r < I_IN) { const int kb = r / 256, nb = r % 256; transpose_item(w_in, DM, NIN, win_src_col(nb * 32), Wb + W_IN / 2, nb * 32, kb * 64, g_mix, scr, lane); continue; } r -= I_IN;
            if (r < I_P) { const int kb = r / 32, nb = r % 32; transpose_item(p_hy, 512, DM, nb * 32, Wb + W_PHY / 2, nb * 32, kb * 64, nullptr, scr, lane); continue; } r -= I_P;
            if (r < I_P) { const int kb = r / 32, nb = r % 32; transpose_item(p_att, 512, DM, nb * 32, Wb + W_PATT / 2, nb * 32, kb * 64, nullptr, scr, lane); continue; } r -= I_P;
            if (r < I_O) { const int kb = r / 32, nb = r % 32; transpose_item(w_o, DM, DM, nb * 32, Wb + W_O / 2, nb * 32, kb * 64, nullptr, scr, lane); continue; } r -= I_O;
            if (r < I_1) { const int kb = r / 128, nb = r % 128; transpose_item(w1, DM, DFF, nb * 32, Wb + W_FF1 / 2, nb * 32, kb * 64, g_ffn, scr, lane); continue; } r -= I_1;
            { const int kb = r / 32, nb = r % 32; transpose_item(w2, DFF, DM, nb * 32, Wb + W_FF2 / 2, nb * 32, kb * 64, nullptr, scr, lane); }
        }
        if (L == 0) {
            const float* x = a.in[0]; bf16* xb = (bf16*)(ws + WS_XB); float* ssq = (float*)(ws + WS_SSQA);
            for (int m0 = gw; m0 < MTOK; m0 += 4 * NGW) {
                f32x4 v[4][4];
#pragma unroll
                for (int rr = 0; rr < 4; ++rr) { const f32x4* xr = (const f32x4*)(x + (size_t)(m0 + rr * NGW) * DM) + lane;
#pragma unroll
                    for (int j = 0; j < 4; ++j) v[rr][j] = xr[64 * j]; }
#pragma unroll
                for (int rr = 0; rr < 4; ++rr) { const int m = m0 + rr * NGW; float s = 0.f;
#pragma unroll
                    for (int j = 0; j < 4; ++j) s += (v[rr][j][0] * v[rr][j][0] + v[rr][j][1] * v[rr][j][1]) + (v[rr][j][2] * v[rr][j][2] + v[rr][j][3] * v[rr][j][3]);
                    s = wave_sum(s);
                    unsigned long long* o8 = (unsigned long long*)(xb + (size_t)m * DM) + lane;
#pragma unroll
                    for (int j = 0; j < 4; ++j) o8[64 * j] = (unsigned long long)pk2(v[rr][j][0], v[rr][j][1]) | ((unsigned long long)pk2(v[rr][j][2], v[rr][j][3]) << 32);
                    if (lane < 16) ssq[(size_t)m * 16 + lane] = (lane == 0) ? s : 0.f; }
            }
        }
    }
}

__device__ __forceinline__ float bfe(const v4u& w, int e) { const unsigned d = (e >> 1) == 0 ? w.x : ((e >> 1) == 1 ? w.y : ((e >> 1) == 2 ? w.z : w.w)); return (e & 1) ? __uint_as_float(d & 0xffff0000u) : __uint_as_float(d << 16); }
__device__ __forceinline__ void phase_prep_u(const Args& a, int L, LAS unsigned char* lds, int tid, int G) {
    const bf16* hy = (const bf16*)(a.ws + WS_HY); bf16* ut = (bf16*)(a.ws + WS_UT); bf16* x0t = (bf16*)(a.ws + WS_X0T);
    const float* cw = a.in[3] + (size_t)L * 3 * 1536; const float* cb = a.in[4] + L * 1536;
    LAS unsigned short* tile = (LAS unsigned short*)lds;
    const int cc = blockIdx.x & 7, ml = tid >> 3, cg8 = tid & 7, c0 = cc * 64 + cg8 * 8;
    float wq[3][4][8];
#pragma unroll
    for (int ar = 0; ar < 3; ++ar)
#pragma unroll
        for (int e = 0; e < 8; ++e) { wq[ar][0][e] = cw[ar * 512 + c0 + e]; wq[ar][1][e] = cw[1536 + ar * 512 + c0 + e]; wq[ar][2][e] = cw[3072 + ar * 512 + c0 + e]; wq[ar][3][e] = cb[ar * 512 + c0 + e]; }
    v4u dn[3][3];
    const v4u zero = (v4u){0u, 0u, 0u, 0u};
#define PU_LOAD(it_) do { const int m_ = ((it_) & 31) * 64 + ml; const bf16* r_ = hy + (size_t)(((it_) >> 5) * SEQ + m_) * 1536 + c0; \
        _Pragma("unroll") for (int ar_ = 0; ar_ < 3; ++ar_) { dn[ar_][0] = (m_ > 0) ? *(const v4u*)(r_ - 1536 + ar_ * 512) : zero; dn[ar_][1] = *(const v4u*)(r_ + ar_ * 512); \
            dn[ar_][2] = (m_ < SEQ - 1) ? *(const v4u*)(r_ + 1536 + ar_ * 512) : zero; } } while (0)
    if ((int)(blockIdx.x >> 3) < 512) PU_LOAD((int)(blockIdx.x >> 3));
    for (int it = blockIdx.x >> 3; it < 512; it += (G >> 3)) {
        const int mc = it & 31, b = it >> 5;
        v4u d[3][3];
#pragma unroll
        for (int ar = 0; ar < 3; ++ar) { d[ar][0] = dn[ar][0]; d[ar][1] = dn[ar][1]; d[ar][2] = dn[ar][2]; }
        if (it + (G >> 3) < 512) PU_LOAD(it + (G >> 3));
#pragma unroll
        for (int e = 0; e < 8; ++e) {
            float cv[3];
#pragma unroll
            for (int ar = 0; ar < 3; ++ar) cv[ar] = wq[ar][3][e] + wq[ar][0][e] * bfe(d[ar][0], e) + wq[ar][1][e] * bfe(d[ar][1], e) + wq[ar][2][e] * bfe(d[ar][2], e);
            tile[(cg8 * 8 + e) * 72 + ml] = (unsigned short)f2bf(cv[1] * cv[2]);
            tile[4608 + (cg8 * 8 + e) * 72 + ml] = (unsigned short)f2bf(cv[0]);
        }
        __syncthreads();
        {
            const int c2 = tid >> 3, ch = tid & 7;
            const LAS unsigned* s = (const LAS unsigned*)(tile + c2 * 72 + ch * 8);
            v4u o; o.x = s[0]; o.y = s[1]; o.z = s[2]; o.w = s[3];
            *(v4u*)(ut + ((size_t)(cc * 64 + c2) * NBATCH + b) * SEQ + mc * 64 + ch * 8) = o;
            const LAS unsigned* s2 = s + 2304;
            v4u o2; o2.x = s2[0]; o2.y = s2[1]; o2.z = s2[2]; o2.w = s2[3];
            *(v4u*)(x0t + ((size_t)(cc * 64 + c2) * NBATCH + b) * SEQ + mc * 64 + ch * 8) = o2;
        }
        __syncthreads();
    }
}

__device__ __forceinline__ void phase_hyena_naive(const Args& a, int L, LAS unsigned char* lds, int tid, int G) {
    const bf16* hy = (const bf16*)(a.ws + WS_HY); const bf16* ut = (const bf16*)(a.ws + WS_UT); const float* Gf = (const float*)(a.ws + WS_GF);
    bf16* yhy = (bf16*)(a.ws + WS_YHY);
    const float* cw = a.in[3] + (size_t)L * 3 * 1536; const float* cb = a.in[4] + L * 1536;
    LAS float* Gs = (LAS float*)lds;
    LAS float* Us = Gs + 4096;
    for (int item = blockIdx.x; item < 2048; item += G) {
        const int c = item >> 2, bq = item & 3;
        for (int i = tid; i < 4096; i += NTHR) Gs[i] = (i == 0) ? 0.f : Gf[(size_t)c * 4096 + i];
        for (int i = tid; i < 8192; i += NTHR) { const int bl = i >> 11, m = i & 2047; Us[i] = bf2f(ut[((size_t)c * NBATCH + bq * 4 + bl) * SEQ + m]); }
        __syncthreads();
        const int bl = tid >> 7, tn = tid & 127;
        float acc[16];
#pragma unroll
        for (int i = 0; i < 16; ++i) acc[i] = 0.f;
        const LAS float* up = Us + bl * 2048;
        for (int m = 0; m < SEQ; ++m) {
            const float u = up[m];
            const LAS float* gp = Gs + (tn - m + 2048);
#pragma unroll
            for (int i = 0; i < 16; ++i) acc[i] += gp[128 * i] * u;
        }
        const int b = bq * 4 + bl;
        const float w0 = cw[c], w1 = cw[1536 + c], w2 = cw[3072 + c], b0 = cb[c];
#pragma unroll
        for (int i = 0; i < 16; ++i) {
            const int n = tn + 128 * i;
            const bf16* r = hy + (size_t)(b * SEQ + n) * 1536 + c;
            const float xm = (n > 0) ? bf2f(r[-1536]) : 0.f, xc = bf2f(r[0]), xp = (n < SEQ - 1) ? bf2f(r[1536]) : 0.f;
            const float x0 = b0 + w0 * xm + w1 * xc + w2 * xp;
            yhy[(size_t)(b * SEQ + n) * 512 + c] = (bf16)f2bf(x0 * acc[i]);
        }
        __syncthreads();
    }
}

__device__ __forceinline__ void phase_attn_naive(const Args& a, int half, int tid, int G) {
    bf16* Q = (bf16*)(a.ws + WS_Q); const bf16* KV = (const bf16*)(a.ws + WS_KV); float* lse = (float*)(a.ws + WS_LSE);
    for (int idx = blockIdx.x * NTHR + tid; idx < 3 * 8 * HALF_TOK; idx += G * NTHR) {
        const int g = idx / (8 * HALF_TOK), t = idx % (8 * HALF_TOK), h = t / HALF_TOK, tokl = t % HALF_TOK;
        const int dil = (g == 0) ? 1 : (g == 1 ? 4 : 16);
        const int token = half * HALF_TOK + tokl, s = token & 2047;
        bf16* qp = Q + (size_t)token * 1536 + g * 512 + h * 64;
        float q[64], o[64];
#pragma unroll
        for (int i = 0; i < 8; ++i) { const v4u w = *(const v4u*)(qp + 8 * i);
            q[8 * i + 0] = __uint_as_float(w.x << 16); q[8 * i + 1] = __uint_as_float(w.x & 0xffff0000u); q[8 * i + 2] = __uint_as_float(w.y << 16); q[8 * i + 3] = __uint_as_float(w.y & 0xffff0000u);
            q[8 * i + 4] = __uint_as_float(w.z << 16); q[8 * i + 5] = __uint_as_float(w.z & 0xffff0000u); q[8 * i + 6] = __uint_as_float(w.w << 16); q[8 * i + 7] = __uint_as_float(w.w & 0xffff0000u); }
#pragma unroll
        for (int i = 0; i < 64; ++i) o[i] = 0.f;
        float mx = -1e30f, l = 0.f;
        for (int j = -64; j <= 64; ++j) {
            const int sp = s + j * dil;
            if (sp < 0 || sp >= SEQ) continue;
            const bf16* kp = KV + (size_t)(tokl + j * dil) * 3072 + g * 1024 + h * 64;
            float sc = 0.f;
#pragma unroll
            for (int i = 0; i < 8; ++i) { const v4u w = *(const v4u*)(kp + 8 * i);
                sc += q[8 * i + 0] * __uint_as_float(w.x << 16) + q[8 * i + 1] * __uint_as_float(w.x & 0xffff0000u) + q[8 * i + 2] * __uint_as_float(w.y << 16) + q[8 * i + 3] * __uint_as_float(w.y & 0xffff0000u)
                    + q[8 * i + 4] * __uint_as_float(w.z << 16) + q[8 * i + 5] * __uint_as_float(w.z & 0xffff0000u) + q[8 * i + 6] * __uint_as_float(w.w << 16) + q[8 * i + 7] * __uint_as_float(w.w & 0xffff0000u); }
            const float mn = fmaxf(mx, sc), corr = exp2f(mx - mn), p = exp2f(sc - mn);
            l = l * corr + p; mx = mn;
            const bf16* vp = kp + 512;
#pragma unroll
            for (int i = 0; i < 8; ++i) { const v4u w = *(const v4u*)(vp + 8 * i);
                o[8 * i + 0] = o[8 * i + 0] * corr + p * __uint_as_float(w.x << 16); o[8 * i + 1] = o[8 * i + 1] * corr + p * __uint_as_float(w.x & 0xffff0000u);
                o[8 * i + 2] = o[8 * i + 2] * corr + p * __uint_as_float(w.y << 16); o[8 * i + 3] = o[8 * i + 3] * corr + p * __uint_as_float(w.y & 0xffff0000u);
                o[8 * i + 4] = o[8 * i + 4] * corr + p * __uint_as_float(w.z << 16); o[8 * i + 5] = o[8 * i + 5] * corr + p * __uint_as_float(w.z & 0xffff0000u);
                o[8 * i + 6] = o[8 * i + 6] * corr + p * __uint_as_float(w.w << 16); o[8 * i + 7] = o[8 * i + 7] * corr + p * __uint_as_float(w.w & 0xffff0000u); }
        }
        const float inv = 1.0f / l;
#pragma unroll
        for (int i = 0; i < 8; ++i) { v4u w; w.x = pk2(o[8 * i] * inv, o[8 * i + 1] * inv); w.y = pk2(o[8 * i + 2] * inv, o[8 * i + 3] * inv); w.z = pk2(o[8 * i + 4] * inv, o[8 * i + 5] * inv); w.w = pk2(o[8 * i + 6] * inv, o[8 * i + 7] * inv);
            *(v4u*)(qp + 8 * i) = w; }
        lse[((size_t)g * MTOK + token) * 8 + h] = mx + log2f(l);
    }
}

__device__ __forceinline__ void phase_combine(const Args& a, int tid, int G) {
    const bf16* Q = (const bf16*)(a.ws + WS_Q); const float* lse = (const float*)(a.ws + WS_LSE); bf16* ya = (bf16*)(a.ws + WS_YATT);
    const int stride = G * NTHR;
    for (int idx0 = blockIdx.x * NTHR + tid; idx0 < MTOK * 64; idx0 += 4 * stride) {
        float l0[4], l1[4], l2[4]; v4u a0[4], a1[4], a2[4];
#pragma unroll
        for (int j = 0; j < 4; ++j) { int idx = idx0 + j * stride; if (idx >= MTOK * 64) idx = idx0; const int token = idx >> 6, ch = idx & 63, h = ch >> 3;
            l0[j] = lse[((size_t)0 * MTOK + token) * 8 + h]; l1[j] = lse[((size_t)1 * MTOK + token) * 8 + h]; l2[j] = lse[((size_t)2 * MTOK + token) * 8 + h];
            const bf16* p = Q + (size_t)token * 1536 + ch * 8;
            a0[j] = *(const v4u*)p; a1[j] = *(const v4u*)(p + 512); a2[j] = *(const v4u*)(p + 1024); }
#pragma unroll
        for (int j = 0; j < 4; ++j) { const int idx = idx0 + j * stride; if (idx >= MTOK * 64) continue; const int token = idx >> 6, ch = idx & 63;
            const float mx = fmaxf(l0[j], fmaxf(l1[j], l2[j]));
            float w0 = exp2f(l0[j] - mx), w1 = exp2f(l1[j] - mx), w2 = exp2f(l2[j] - mx);
            const float inv = 1.0f / (w0 + w1 + w2); w0 *= inv; w1 *= inv; w2 *= inv;
            v4u o;
#define CMB(f) pk2(w0 * __uint_as_float(a0[j].f << 16) + w1 * __uint_as_float(a1[j].f << 16) + w2 * __uint_as_float(a2[j].f << 16), \
                   w0 * __uint_as_float(a0[j].f & 0xffff0000u) + w1 * __uint_as_float(a1[j].f & 0xffff0000u) + w2 * __uint_as_float(a2[j].f & 0xffff0000u))
            o.x = CMB(x); o.y = CMB(y); o.z = CMB(z); o.w = CMB(w);
#undef CMB
            *(v4u*)(ya + (size_t)token * 512 + ch * 8) = o; }
    }
}

__device__ __forceinline__ void phase_final_norm(const Args& a, int lane, int wave, int G) {
    float* out = a.out; const float* gain = a.in[18]; const bf16* xb = (const bf16*)(a.ws + WS_XB);
    const int gw = blockIdx.x * NWAVES + wave, NGW = G * NWAVES;
    typedef unsigned u32x2v __attribute__((ext_vector_type(2)));
    f32x4 gn[4];
#pragma unroll
    for (int j = 0; j < 4; ++j) gn[j] = *((const f32x4*)gain + lane + 64 * j);
    for (int m0 = gw; m0 < MTOK; m0 += 4 * NGW) {
        u32x2v w[4][4];
#pragma unroll
        for (int rr = 0; rr < 4; ++rr) { const int m = (m0 + rr * NGW < MTOK) ? m0 + rr * NGW : m0; const u32x2v* xr = (const u32x2v*)(xb + (size_t)m * DM) + lane;
#pragma unroll
            for (int j = 0; j < 4; ++j) w[rr][j] = xr[64 * j]; }
#pragma unroll
        for (int rr = 0; rr < 4; ++rr) { const int m = m0 + rr * NGW; if (m >= MTOK) continue;
            f32x4 v[4]; float s = 0.f;
#pragma unroll
            for (int j = 0; j < 4; ++j) { v[j] = (f32x4){__uint_as_float(w[rr][j].x << 16), __uint_as_float(w[rr][j].x & 0xffff0000u), __uint_as_float(w[rr][j].y << 16), __uint_as_float(w[rr][j].y & 0xffff0000u)};
                s += (v[j][0] * v[j][0] + v[j][1] * v[j][1]) + (v[j][2] * v[j][2] + v[j][3] * v[j][3]); }
            s = wave_sum(s);
            const float rs = 1.0f / sqrtf(s * (1.0f / 1024.0f) + 1e-6f);
            f32x4* orow = (f32x4*)(out + (size_t)m * DM) + lane;
#pragma unroll
            for (int j = 0; j < 4; ++j) orow[64 * j] = v[j] * rs * gn[j]; }
    }
}

typedef short bf16x8 __attribute__((ext_vector_type(8)));
typedef short s16x4 __attribute__((ext_vector_type(4)));
constexpr int HY_UROW = 4112, HY_ROFF = 16 * HY_UROW, HY_RSTRIDE = 8192 + 64;
__device__ __forceinline__ bf16x8 ld_frag4(const LAS unsigned char* p) {
    const LAS unsigned* q = (const LAS unsigned*)p; v4u d; d.x = q[0]; d.y = q[1]; d.z = q[2]; d.w = q[3]; return __builtin_bit_cast(bf16x8, d);
}
__device__ __forceinline__ void phase_hyena_mfma(const Args& a, LAS unsigned char* lds, int tid, int G, bool dummy = false) {
    const bf16* ut = (const bf16*)(a.ws + WS_UT); const bf16* Rg = (const bf16*)(a.ws + WS_GF); bf16* x0t = (bf16*)(a.ws + WS_X0T);
    const int lane = tid & 63, w = __builtin_amdgcn_readfirstlane(tid >> 6), i16 = lane & 15, kq = lane >> 4;
    const int base = (w >> 1) * 512 + (w & 1) * 16, cp = i16 & 1;
    const int lane_const = (2048 - base - i16 + 8 * kq - cp) >> 1;
    const LAS unsigned char* pA15 = lds + HY_ROFF + cp * HY_RSTRIDE + 4 * (lane_const - 240);
    const LAS unsigned char* pB = lds + i16 * HY_UROW + kq * 16;
    v4u pre[10];
#define HY_ISSUE(chn) do { _Pragma("unroll") for (int k_ = 0; k_ < 8; ++k_) { const int i_ = tid + NTHR * k_, b_ = i_ >> 8, ck_ = i_ & 255; pre[k_] = *(const v4u*)(ut + ((size_t)(chn) * NBATCH + b_) * SEQ + ck_ * 8); } \
        _Pragma("unroll") for (int k_ = 0; k_ < 2; ++k_) { const int i_ = tid + NTHR * k_, c2_ = i_ >> 9, ck_ = i_ & 511; pre[8 + k_] = *(const v4u*)(Rg + ((size_t)(chn) * 2 + c2_) * 4096 + ck_ * 8); } } while (0)
    if ((int)blockIdx.x < HYW) HY_ISSUE(blockIdx.x);
    for (int ch = blockIdx.x; ch < HYW; ch += G) {
#pragma unroll
        for (int k = 0; k < 8; ++k) { const int i = tid + NTHR * k, b = i >> 8, ck = i & 255; *(LAS v4u*)(lds + b * HY_UROW + ck * 16) = pre[k]; }
#pragma unroll
        for (int k = 0; k < 2; ++k) { const int i = tid + NTHR * k, c2 = i >> 9, ck = i & 511; *(LAS v4u*)(lds + HY_ROFF + c2 * HY_RSTRIDE + ck * 16) = pre[8 + k]; }
        __syncthreads();
        if (ch + G < HYW) HY_ISSUE(ch + G);
#pragma unroll 1
        for (int pass = 0; pass < 2; ++pass) {
            const LAS unsigned char* pA7 = pA15 + 64 * 8 - 512 * pass;
            f32x4 acc[8]; bf16x8 W[8];
#pragma unroll
            for (int i = 0; i < 8; ++i) acc[i] = (f32x4){0.f, 0.f, 0.f, 0.f};
#pragma unroll
            for (int j = 1; j < 8; ++j) W[j] = ld_frag4(pA7 + 64 * (7 - j));
            W[0] = W[1];
#pragma unroll 1
            for (int tt = 0; tt < 8; ++tt) {
                const LAS unsigned char* pa = pA7 + 64 * 7 + 512 * tt; const LAS unsigned char* pb = pB + 512 * tt;
#pragma unroll
                for (int s = 0; s < 8; ++s) {
                    W[(8 - s) & 7] = ld_frag4(pa + 64 * s);
                    const bf16x8 Bf = *(const LAS bf16x8*)(pb + 64 * s);
                    __builtin_amdgcn_s_setprio(1);
#pragma unroll
                    for (int i = 0; i < 8; ++i) acc[i] = __builtin_amdgcn_mfma_f32_16x16x32_bf16(W[(i - s) & 7], Bf, acc[i], 0, 0, 0);
                    __builtin_amdgcn_s_setprio(0);
                }
            }
            bf16* xo = x0t + ((size_t)ch * NBATCH + i16) * SEQ + base + 256 * pass + 4 * kq;
            typedef unsigned u32x2v __attribute__((ext_vector_type(2)));
            u32x2v xall[8];
#pragma unroll
            for (int i = 0; i < 8; ++i) xall[i] = *(const u32x2v*)(xo + 32 * i);
#pragma unroll
            for (int i = 0; i < 8; ++i) {
                const u32x2v xv = xall[i];
                u32x2v o; o.x = pk2(__uint_as_float(xv.x << 16) * acc[i][0], __uint_as_float(xv.x & 0xffff0000u) * acc[i][1]);
                o.y = pk2(__uint_as_float(xv.y << 16) * acc[i][2], __uint_as_float(xv.y & 0xffff0000u) * acc[i][3]);
                if (!dummy) *(u32x2v*)(xo + 32 * i) = o; else *(u32x2v*)((bf16*)(a.ws + WS_YHY) + (size_t)tid * 64 + 4 * i) = o;
            }
        }
        __syncthreads();
    }
}

__device__ __forceinline__ void phase_transpose_y(const Args& a, LAS unsigned char* lds, int tid, int G) {
    const bf16* yt = (const bf16*)(a.ws + WS_X0T); bf16* yhy = (bf16*)(a.ws + WS_YHY);
    LAS unsigned short* tile = (LAS unsigned short*)lds;
#define TY_LOAD(item_) (*(const v4u*)(yt + ((size_t)(((item_) & 7) * 64 + (tid >> 3)) * NBATCH + ((item_) >> 8)) * SEQ + (((item_) >> 3) & 31) * 64 + (tid & 7) * 8))
    v4u vnext = (v4u){0u, 0u, 0u, 0u};
    if ((int)blockIdx.x < 4096) vnext = TY_LOAD((int)blockIdx.x);
    for (int item = blockIdx.x; item < 4096; item += G) {
        const int cc = item & 7, mc = (item >> 3) & 31, b = item >> 8;
        { const int c2 = tid >> 3, ck = tid & 7;
          const v4u v = vnext;
          LAS unsigned* t4 = (LAS unsigned*)(tile + c2 * 72 + ck * 8); t4[0] = v.x; t4[1] = v.y; t4[2] = v.z; t4[3] = v.w; }
        __syncthreads();
        if (item + G < 4096) vnext = TY_LOAD(item + G);
        { const int nl = tid >> 3, cg8 = tid & 7; const LAS unsigned short* s = tile + (cg8 * 8) * 72 + nl;
          v4u o; o.x = s[0] | ((unsigned)s[72] << 16); o.y = s[144] | ((unsigned)s[216] << 16); o.z = s[288] | ((unsigned)s[360] << 16); o.w = s[432] | ((unsigned)s[504] << 16);
          *(v4u*)(yhy + (size_t)(b * SEQ + mc * 64 + nl) * 512 + cc * 64 + cg8 * 8) = o; }
        __syncthreads();
    }
}

constexpr int AT_ROWS = 272, AT_RS = 144, AT_VOFF = AT_ROWS * AT_RS;
__device__ __forceinline__ void phase_attn_mfma(const Args& a, int half, LAS unsigned char* lds, int tid, int G, bool dummy = false) {
    bf16* Q = (bf16*)(a.ws + WS_Q); const bf16* KV = (const bf16*)(a.ws + WS_KV); float* lse = (float*)(a.ws + WS_LSE);
    const int lane = tid & 63, w = __builtin_amdgcn_readfirstlane(tid >> 6), q16 = lane & 15, kq = lane >> 4;
    v4u pre[9]; bf16x8 Qn0, Qn1;
#define AT_DECODE(unit_) const int g = (unit_) >> 10, u = (unit_) & 1023, sub = u & 15, h = (u >> 4) & 7, bl = u >> 7; int dil, n, r, qb; \
        if (g == 0) { dil = 1; n = 2048; r = 0; qb = sub; } else if (g == 1) { dil = 4; n = 512; r = sub >> 2; qb = sub & 3; } else { dil = 16; n = 128; r = sub; qb = 0; } \
        const int q0 = qb * 128, kb0 = q0 - 64; (void)kb0; (void)q0;
#define AT_ISSUE(unit_, PRE_, QN0_, QN1_) do { AT_DECODE(unit_) { const bf16* qn_ = Q + (size_t)(half * HALF_TOK + bl * SEQ + (q0 + 16 * w + q16) * dil + r) * 1536 + g * 512 + h * 64; QN0_ = *(const bf16x8*)(qn_ + 8 * kq); QN1_ = *(const bf16x8*)(qn_ + 32 + 8 * kq); } \
        _Pragma("unroll") for (int k_ = 0; k_ < 9; ++k_) { const int i_ = tid + NTHR * k_; \
            const int which_ = (i_ >= AT_ROWS * 8) ? 1 : 0, j_ = i_ - which_ * AT_ROWS * 8, rr_ = j_ >> 3, ck_ = j_ & 7, key_ = kb0 + rr_; \
            PRE_[k_] = (v4u){0u, 0u, 0u, 0u}; \
            if (i_ < 2 * AT_ROWS * 8 && key_ >= 0 && key_ < n) PRE_[k_] = *(const v4u*)(KV + (size_t)(bl * SEQ + key_ * dil + r) * 3072 + g * 1024 + which_ * 512 + h * 64 + ck_ * 8); } } while (0)
    const int vb = ((G & 7) == 0) ? (int)((blockIdx.x & 7) * (G >> 3) + (blockIdx.x >> 3)) : (int)blockIdx.x;
#define AT_STEP(UNIT_, PRE_, QN0_, QN1_) do { \
_Pragma("unroll") \
        for (int k = 0; k < 9; ++k) { const int i = tid + NTHR * k; const int which = (i >= AT_ROWS * 8) ? 1 : 0, j = i - which * AT_ROWS * 8, rr = j >> 3, ck = j & 7; \
            if (i < 2 * AT_ROWS * 8) *(LAS v4u*)(lds + which * AT_VOFF + rr * AT_RS + ck * 16) = PRE_[k]; } \
        const bf16x8 Qf0 = QN0_, Qf1 = QN1_; \
        __syncthreads(); \
        if (UNIT_ + 2 * G < 3072) AT_ISSUE(UNIT_ + 2 * G, PRE_, QN0_, QN1_); \
        AT_DECODE(UNIT_) \
        { \
            const int i0 = q0 + 16 * w; \
            const int token = half * HALF_TOK + bl * SEQ + (i0 + q16) * dil + r; \
            bf16* qp = Q + (size_t)token * 1536 + g * 512 + h * 64; \
            bf16* op = dummy ? (bf16*)(a.ws + WS_YHY) + (size_t)(tid & 511) * 64 : qp; \
            f32x4 acc[4]; \
_Pragma("unroll") \
            for (int dt = 0; dt < 4; ++dt) acc[dt] = (f32x4){0.f, 0.f, 0.f, 0.f}; \
            const bool edge = (i0 < 64) || (i0 + 80 > n); \
            const LAS unsigned char* kbase = lds + (16 * w + q16) * AT_RS + 16 * kq; \
            const LAS unsigned char* vbase = lds + AT_VOFF + (16 * w + 4 * kq + (q16 >> 2)) * AT_RS + 8 * (q16 & 3); \
            f32x4 s[9]; \
_Pragma("unroll") \
            for (int kt = 0; kt < 9; ++kt) { \
                const LAS unsigned char* kp = kbase + kt * 16 * AT_RS; \
                const bf16x8 K0 = *(const LAS bf16x8*)kp, K1 = *(const LAS bf16x8*)(kp + 64); \
                f32x4 z = (f32x4){0.f, 0.f, 0.f, 0.f}; \
                __builtin_amdgcn_s_setprio(1); \
                z = __builtin_amdgcn_mfma_f32_16x16x32_bf16(K0, Qf0, z, 0, 0, 0); \
                z = __builtin_amdgcn_mfma_f32_16x16x32_bf16(K1, Qf1, z, 0, 0, 0); \
                __builtin_amdgcn_s_setprio(0); \
                if (kt == 0 || kt == 8 || edge) { \
_Pragma("unroll") \
                    for (int e = 0; e < 4; ++e) { \
                        const int rel = 16 * kt - 64 + 4 * kq + e - q16, j = i0 + q16 + rel; \
                        const bool ok = (rel >= -64) && (rel <= 64) && (j >= 0) && (j < n); \
                        z[e] = ok ? z[e] : -1e30f; \
                    } } \
                s[kt] = z; \
            } \
            float mrun = -1e30f; \
_Pragma("unroll") \
            for (int kt = 0; kt < 9; ++kt) mrun = fmaxf(mrun, fmaxf(fmaxf(s[kt][0], s[kt][1]), fmaxf(s[kt][2], s[kt][3]))); \
            mrun = fmaxf(mrun, __shfl_xor(mrun, 16)); mrun = fmaxf(mrun, __shfl_xor(mrun, 32)); \
            float lrun = 0.f; \
_Pragma("unroll") \
            for (int kt = 0; kt < 9; ++kt) \
_Pragma("unroll") \
                for (int e = 0; e < 4; ++e) { s[kt][e] = __builtin_amdgcn_exp2f(s[kt][e] - mrun); lrun += s[kt][e]; } \
_Pragma("unroll") \
            for (int st = 0; st < 5; ++st) { \
                v4u pw; pw.x = pg8::cvt_pk_bf16(s[2 * st][0], s[2 * st][1]); pw.y = pg8::cvt_pk_bf16(s[2 * st][2], s[2 * st][3]); \
                if (st < 4) { pw.z = pg8::cvt_pk_bf16(s[2 * st + 1][0], s[2 * st + 1][1]); pw.w = pg8::cvt_pk_bf16(s[2 * st + 1][2], s[2 * st + 1][3]); } else { pw.z = 0u; pw.w = 0u; } \
                const bf16x8 Pf = __builtin_bit_cast(bf16x8, pw); \
_Pragma("unroll") \
                for (int dt = 0; dt < 4; ++dt) { \
                    const LAS unsigned char* vp = vbase + 32 * st * AT_RS + 32 * dt; \
                    const s16x4 v0 = __builtin_amdgcn_ds_read_tr16_b64_v4i16((LAS s16x4*)vp); \
                    const s16x4 v1 = __builtin_amdgcn_ds_read_tr16_b64_v4i16((LAS s16x4*)(vp + 16 * AT_RS)); \
                    const bf16x8 Vf = (bf16x8){v0[0], v0[1], v0[2], v0[3], v1[0], v1[1], v1[2], v1[3]}; \
                    __builtin_amdgcn_s_setprio(1); \
                    acc[dt] = __builtin_amdgcn_mfma_f32_16x16x32_bf16(Vf, Pf, acc[dt], 0, 0, 0); \
                    __builtin_amdgcn_s_setprio(0); \
                } \
            } \
            lrun += __shfl_xor(lrun, 16); lrun += __shfl_xor(lrun, 32); \
            const float inv = 1.0f / lrun; \
            typedef unsigned u32x2v __attribute__((ext_vector_type(2))); \
_Pragma("unroll") \
            for (int dt = 0; dt < 4; ++dt) { \
                u32x2v o; o.x = pg8::cvt_pk_bf16(acc[dt][0] * inv, acc[dt][1] * inv); o.y = pg8::cvt_pk_bf16(acc[dt][2] * inv, acc[dt][3] * inv); \
                *(u32x2v*)(op + 16 * dt + 4 * kq) = o; \
            } \
            if (kq == 0 && !dummy) lse[((size_t)g * MTOK + token) * 8 + h] = mrun + log2f(lrun); \
        } \
        __syncthreads(); \
    } while (0)
    v4u preB[9]; bf16x8 QnB0, QnB1;
    if (vb < 3072) AT_ISSUE(vb, pre, Qn0, Qn1);
    if (vb + G < 3072) AT_ISSUE(vb + G, preB, QnB0, QnB1);
    for (int unit = vb; unit < 3072; unit += 2 * G) {
        AT_STEP(unit, pre, Qn0, Qn1);
        if (unit + G < 3072) AT_STEP(unit + G, preB, QnB0, QnB1);
    }
}

#define XB_TMO      128
#define XB_XCNT(j)  (256  + 64 * (j))
#define XB_XSUB(j)  (1280 + 64 * (j))
#define XB_XGEN(j)  (2304 + 64 * (j))
#define XB_TOP      3328
#define XB_TOPGEN   3392
#define XCD_BAR_WORDS 3456
#define XB_SPIN_CAP (1u << 18)

__device__ __forceinline__ unsigned xb_ld(unsigned* p)              { return __hip_atomic_load(p, __ATOMIC_RELAXED, __HIP_MEMORY_SCOPE_AGENT); }
__device__ __forceinline__ unsigned xb_add(unsigned* p, unsigned v) { return __hip_atomic_fetch_add(p, v, __ATOMIC_RELAXED, __HIP_MEMORY_SCOPE_AGENT); }
__device__ __forceinline__ unsigned xb_xcc_id() { return (unsigned)__builtin_amdgcn_s_getreg((3 << 11) | 20) & 0xFu; }
#define XB_SPIN(cond, bar) do { unsigned _sp = 0; while (cond) { __builtin_amdgcn_s_sleep(1); \
    if ((++_sp & 255u) == 0u) { if (xb_ld(&(bar)[XB_TMO])) break; if (_sp > XB_SPIN_CAP) { atomicAdd(&(bar)[XB_TMO], 1u); break; } } } } while (0)

struct XcdBarrier {
    unsigned* bar; unsigned x;
    volatile LAS unsigned* st;
};

__device__ __forceinline__ XcdBarrier xcd_barrier_post(unsigned* bar, volatile LAS unsigned* st, bool is_t0) {
    XcdBarrier b; b.bar = bar; b.x = xb_xcc_id(); b.st = st;
    if (is_t0) (void)xb_add(&bar[XB_XCNT(b.x)], 1u);
    return b;
}
__device__ __forceinline__ void xcd_barrier_complete(unsigned* bar, unsigned x, unsigned& nloc, unsigned& nx) {
    const unsigned G = gridDim.x * gridDim.y * gridDim.z;
    unsigned sum, cnt, mine, sp = 0u;
    for (;;) {
        sum = 0u; cnt = 0u; mine = 0u;
#pragma unroll
        for (unsigned j = 0; j < 16; ++j) { const unsigned c = xb_ld(&bar[XB_XCNT(j)]); sum += c; cnt += (c > 0u) ? 1u : 0u; mine = (j == x) ? c : mine; }
        if (sum == G) break;
        __builtin_amdgcn_s_sleep(1);
        if ((++sp & 255u) == 0u) { if (xb_ld(&bar[XB_TMO])) break; if (sp > XB_SPIN_CAP) { atomicAdd(&bar[XB_TMO], 1u); break; } }
    }
    nloc = mine > 0u ? mine : 1u; nx = cnt > 0u ? cnt : 1u;
}

__device__ __forceinline__ void xcd_barrier(const XcdBarrier& b, bool is_t0) {
    asm volatile("s_waitcnt vmcnt(0)" ::: "memory");
    __syncthreads();
    if (is_t0) {
        unsigned* bar = b.bar;
        __builtin_amdgcn_s_waitcnt(0);
        unsigned nloc = b.st[0], nx = b.st[1];
        if (nloc == 0u) { xcd_barrier_complete(bar, b.x, nloc, nx); b.st[0] = nloc; b.st[1] = nx; }
        const unsigned old = xb_add(&bar[XB_XSUB(b.x)], 1u);
        const unsigned gen = old / nloc;
        if (old + 1u == (gen + 1u) * nloc) {
            __builtin_amdgcn_fence(__ATOMIC_RELEASE, "agent");
            asm volatile("s_waitcnt vmcnt(0)" ::: "memory");
            const unsigned og = xb_add(&bar[XB_TOP], 1u);
            const unsigned tg = og / nx;
            if (og + 1u == (tg + 1u) * nx) xb_add(&bar[XB_TOPGEN], 1u);
            else XB_SPIN(xb_ld(&bar[XB_TOPGEN]) == tg, bar);
            __builtin_amdgcn_fence(__ATOMIC_ACQUIRE, "agent");
            xb_add(&bar[XB_XGEN(b.x)], 1u);
            asm volatile("s_waitcnt vmcnt(0)" ::: "memory");
        } else {
            XB_SPIN(xb_ld(&bar[XB_XGEN(b.x)]) == gen, bar);
            __builtin_amdgcn_fence(__ATOMIC_ACQUIRE, "agent");
            asm volatile("s_waitcnt vmcnt(0)" ::: "memory");
        }
    }
    __syncthreads();
}

__device__ __forceinline__ void stagger(int bx, unsigned ticks_per_class) {
    const unsigned q = ((unsigned)bx >> 3) & 3u;
    if (q) { const unsigned long long t0 = __builtin_amdgcn_s_memrealtime(), dt = (unsigned long long)q * ticks_per_class;
             while (__builtin_amdgcn_s_memrealtime() - t0 < dt) __builtin_amdgcn_s_sleep(8); }
}
#ifndef STAG_ON
#define STAG_ON 0
#endif
#ifndef STAG_LIGHT
#define STAG_LIGHT 300u
#endif
#ifndef STAG_HEAVY
#define STAG_HEAVY 1000u
#endif
#define GEMM_CALL(EPI, SCHED, g, S, E) do { if (STAG_ON) stagger(bx, EPI::PERM ? STAG_LIGHT : STAG_HEAVY); pg8::gemm_phase<EPI, SCHED, true, true>(lds, g, S, E, tid); } while (0)
#ifndef PROBE_G
#define PROBE_G 0
#endif
#ifndef PROBE_S
#define PROBE_S 0
#endif
#define GEMM_CALL_P(EPI, SCHED, g, S, E) do { _Pragma("unroll 1") for (int rep_ = 0; rep_ < 1 + PROBE_G; ++rep_) { GEMM_CALL(EPI, SCHED, g, S, E); } } while (0)
#ifndef PROBE_PW
#define PROBE_PW 0
#endif
#ifndef PROBE_PU
#define PROBE_PU 0
#endif
#ifndef PROBE_CT
#define PROBE_CT 0
#endif
#ifndef PROBE_AT
#define PROBE_AT 0
#endif
#ifndef PROBE_HY
#define PROBE_HY 0
#endif
#define REP_N(N_) _Pragma("unroll 1") for (int rep_ = 0; rep_ < 1 + (N_); ++rep_)

__device__ __forceinline__ int lane_id_volatile() { int l; asm volatile("v_mbcnt_lo_u32_b32 %0, -1, 0\n\tv_mbcnt_hi_u32_b32 %0, -1, %0" : "=v"(l)); return l; }
typedef const __attribute__((address_space(4))) Args* KArgs;
__device__ __forceinline__ Args load_args() {
#if defined(__HIP_DEVICE_COMPILE__)
    KArgs p = (KArgs)__builtin_amdgcn_kernarg_segment_ptr();
    asm volatile("" : "+s"(p));
    return *p;
#else
    return Args{};
#endif
}
__global__ void __launch_bounds__(NTHR, 2) fwd_megakernel(Args a_unused) {
    extern __shared__ __attribute__((aligned(16))) unsigned char lds_raw[];
    LAS unsigned char* lds = (LAS unsigned char*)lds_raw;
    cg::grid_group grid = cg::this_grid();
    const int wave0 = __builtin_amdgcn_readfirstlane((int)threadIdx.x >> 6);
    const int G0 = gridDim.x, bx0 = blockIdx.x;
#define TID0() (wave0 * 64 + lane_id_volatile())
    { const int t0_ = TID0(); if (t0_ < 2) ((LAS unsigned*)(lds + LDS_ST_OFF))[t0_] = 0u; }
    __syncthreads();
    { const Args a0 = load_args(); (void)xcd_barrier_post((unsigned*)(a0.ws + WS_BAR), (volatile LAS unsigned*)(lds + LDS_ST_OFF), TID0() == 0); }
#define GSYNC() do { const Args ab = load_args(); XcdBarrier xb_; xb_.bar = (unsigned*)(ab.ws + WS_BAR); xb_.x = xb_xcc_id(); xb_.st = (volatile LAS unsigned*)(lds + LDS_ST_OFF); xcd_barrier(xb_, TID0() == 0); } while (0)
#define PTRS() const Args a = load_args(); int tid = TID0(), G = G0, bx = bx0; asm volatile("" : "+v"(tid), "+s"(G), "+s"(bx)); const int lane = tid & 63, wave = __builtin_amdgcn_readfirstlane(tid >> 6); (void)lane; (void)wave; unsigned char* ws = a.ws; bf16* Wb = (bf16*)(ws + WS_W); const pg8::bf16_t* xb = (const pg8::bf16_t*)(ws + WS_XB); \
    const float* rcos = (const float*)(ws + WS_ROPE); const float* rsin = rcos + 65536; float* ssqA = (float*)(ws + WS_SSQA); float* ssqB = (float*)(ws + WS_SSQB); \
    (void)Wb; (void)xb; (void)rcos; (void)rsin; (void)ssqA; (void)ssqB;
#define GIN() pg8::Gemm gin{xb, (const pg8::bf16_t*)(Wb + W_IN / 2), nullptr, nullptr, MTOK, NIN, DM}; \
    pg8::EpiIn Ein{(pg8::bf16_t*)(ws + WS_HY), (pg8::bf16_t*)(ws + WS_Q), (pg8::bf16_t*)(ws + WS_KV), (pg8::bf16_t*)(ws + WS_GATES), (const LAS float*)(lds + LDS_RTAB), 0};
#define FILL_RTAB(S_, ssq_, E_) pg8::fill_rstd_table(S_, ssq_, (LAS float*)(lds + LDS_RTAB), tid)

#pragma unroll 1
    for (int L = 0; L < 2; ++L) {
        REP_N(PROBE_PW) { PTRS(); phase_prep_weights(a, L, lds, tid, lane, wave, G); }
        if (L == 0) grid.sync(); else GSYNC();
        {
            PTRS(); GIN();
            pg8::TwoRect S; S.a.init(128, 12, 0, 0, G, bx); S.b.init(64, 12, 0, 12, G, bx); S.na = S.a.count();
            FILL_RTAB(S, ssqA, Ein);
            GEMM_CALL_P(pg8::EpiIn, pg8::TwoRect, gin, S, Ein);
        }
        GSYNC();
        REP_N(PROBE_AT) { PTRS(); phase_attn_mfma(a, 0, lds, tid, G, rep_ < PROBE_AT); } { PTRS(); REP_N(PROBE_PU) { phase_prep_u(a, L, lds, tid, G); } }
        GSYNC();
        {
            PTRS(); GIN();
            pg8::RectOrder S; S.init(64, 12, 64, 12, G, bx);
            Ein.kv_row0 = HALF_TOK;
            FILL_RTAB(S, ssqA, Ein);
            GEMM_CALL_P(pg8::EpiIn, pg8::RectOrder, gin, S, Ein);
        }
        REP_N(PROBE_HY) { PTRS(); phase_hyena_mfma(a, lds, tid, G, rep_ < PROBE_HY); }
        GSYNC();
        REP_N(PROBE_AT) { PTRS(); phase_attn_mfma(a, 1, lds, tid, G, rep_ < PROBE_AT); }
        {
            PTRS(); GIN();
            pg8::RectOrder S; S.init(128, 8, 0, 24, G, bx);
            FILL_RTAB(S, ssqA, Ein);
            GEMM_CALL_P(pg8::EpiIn, pg8::RectOrder, gin, S, Ein);
        }
        GSYNC();
        REP_N(PROBE_CT) { PTRS(); phase_combine(a, tid, G); phase_transpose_y(a, lds, tid, G); }
        GSYNC();
        {
            PTRS();
            pg8::Gemm g{(const pg8::bf16_t*)(ws + WS_YHY), (const pg8::bf16_t*)(Wb + W_PHY / 2), (const pg8::bf16_t*)(ws + WS_YATT), (const pg8::bf16_t*)(Wb + W_PATT / 2), MTOK, DM, 512};
            pg8::PairOrder S; S.r.init(128, 4, 0, 0, G, bx);
            pg8::EpiGate E{(const pg8::bf16_t*)(ws + WS_GATES), (pg8::bf16_t*)(ws + WS_MERGED)};
            GEMM_CALL_P(pg8::EpiGate, pg8::PairOrder, g, S, E);
        }
        GSYNC();
        {
            PTRS();
            pg8::Gemm g{(const pg8::bf16_t*)(ws + WS_MERGED), (const pg8::bf16_t*)(Wb + W_O / 2), nullptr, nullptr, MTOK, DM, DM};
            pg8::RectOrder S; S.init(128, 4, 0, 0, G, bx);
            pg8::EpiRes E{L == 0 ? a.in[0] : nullptr, (pg8::bf16_t*)(ws + WS_XB), ssqB};
            GEMM_CALL(pg8::EpiRes, pg8::RectOrder, g, S, E);
        }
        GSYNC();
        {
            PTRS();
            pg8::Gemm g{xb, (const pg8::bf16_t*)(Wb + W_FF1 / 2), nullptr, nullptr, MTOK, DFF, DM};
            pg8::RectOrder S; S.init(128, 16, 0, 0, G, bx);
            pg8::EpiFF1 E{(pg8::bf16_t*)(ws + WS_H), (const LAS float*)(lds + LDS_RTAB)};
            FILL_RTAB(S, ssqB, E);
            GEMM_CALL_P(pg8::EpiFF1, pg8::RectOrder, g, S, E);
        }
        GSYNC();
        {
            PTRS();
            pg8::Gemm g{(const pg8::bf16_t*)(ws + WS_H), (const pg8::bf16_t*)(Wb + W_FF2 / 2), nullptr, nullptr, MTOK, DM, DFF};
            pg8::RectOrder S; S.init(128, 4, 0, 0, G, bx);
            pg8::EpiRes E{nullptr, (pg8::bf16_t*)(ws + WS_XB), ssqA};
            GEMM_CALL(pg8::EpiRes, pg8::RectOrder, g, S, E);
        }
        GSYNC();
    }
    { PTRS(); phase_final_norm(a, lane, wave, G); }
}

extern "C" void kernel_launch(void* const* d_in, const int* in_sizes, int n_in, void* d_out, int out_size, void* d_ws, size_t ws_size, hipStream_t stream) {
    static int grid = 0;
    if (grid == 0) {
        if (n_in != 19 || in_sizes[0] != MTOK * DM || out_size != MTOK * DM || ws_size < WS_END) {
            fprintf(stderr, "kernel_launch: unexpected shapes / workspace (n_in %d, ws %zu, need %zu); nothing launched\n", n_in, ws_size, (size_t)WS_END); grid = -1; return; }
        int dev = 0, cus = 0, per_cu = 0;
        (void)hipGetDevice(&dev); (void)hipDeviceGetAttribute(&cus, hipDeviceAttributeMultiprocessorCount, dev);
        if (hipFuncSetAttribute((const void*)fwd_megakernel, hipFuncAttributeMaxDynamicSharedMemorySize, LDS_BYTES) != hipSuccess) { fprintf(stderr, "kernel_launch: hipFuncSetAttribute failed\n"); grid = -1; return; }
        if (hipOccupancyMaxActiveBlocksPerMultiprocessor(&per_cu, (const void*)fwd_megakernel, NTHR, LDS_BYTES) != hipSuccess || per_cu < 1) { fprintf(stderr, "kernel_launch: occupancy query gives %d\n", per_cu); per_cu = 1; }
        (void)hipGetLastError();
        grid = cus * 1;
        if (grid % 8 != 0 || grid > 256) grid = (grid > 256) ? 256 : (grid / 8) * 8;
    }
    if (grid < 0) return;
    Args a{};
    for (int i = 0; i < 19; ++i) a.in[i] = (const float*)d_in[i];
    a.out = (float*)d_out; a.ws = (unsigned char*)d_ws;
    if (hipMemsetAsync((char*)d_ws + WS_BAR, 0, 16384, stream) != hipSuccess) { fprintf(stderr, "kernel_launch: memset of the barrier words failed\n"); return; }
    void* args[] = {&a};
    hipError_t e = hipLaunchCooperativeKernel((const void*)fwd_megakernel, dim3(grid), dim3(NTHR), args, LDS_BYTES, stream);
    if (e != hipSuccess) fprintf(stderr, "cooperative launch failed: %s (grid %d)\n", hipGetErrorString(e), grid);
}
```
